# Optimizing an MI355X kernel written in HIP

```python
import math
import jax, jax.numpy as jnp
from jax import lax
import numpy as np

D_MODEL = 1024
BATCH = 8
SEQ = 4096
DEPTH = 2

RET_HEADS = 8
RET_QK = 64
RET_V = 64
RET_WIDTH = RET_HEADS * RET_V
DIFF_HEADS = 4
DIFF_QK = 64
DIFF_V = 2 * DIFF_QK
DIFF_WIDTH = DIFF_HEADS * DIFF_V
MIX_WIDTH = RET_WIDTH + DIFF_WIDTH
W_RQ = RET_HEADS * RET_QK
W_RK = RET_HEADS * RET_QK
W_RV = RET_WIDTH
W_RG = RET_WIDTH
W_DQ = DIFF_HEADS * 2 * DIFF_QK
W_DK = DIFF_HEADS * 2 * DIFF_QK
W_DV = DIFF_WIDTH
IN_WIDTH = W_RQ + W_RK + W_RV + W_RG + W_DQ + W_DK + W_DV
IN_SPLITS = (W_RQ, W_RQ + W_RK, W_RQ + W_RK + W_RV, W_RQ + W_RK + W_RV + W_RG,
             W_RQ + W_RK + W_RV + W_RG + W_DQ, W_RQ + W_RK + W_RV + W_RG + W_DQ + W_DK)
CHUNK = 128
Q_BLOCK = 128
ROPE_BASE = 10000.0
SUBLN_EPS = 1e-5
LN_EPS = 1e-5
N_EXPERTS = 16
N_GROUPS = 4
EXPERTS_PER_GROUP = N_EXPERTS // N_GROUPS
TOP_K = 2
D_EXPERT = 512
ALPHA = (2 * DEPTH) ** 0.25
BETA = (8 * DEPTH) ** -0.25
N_MOD = 6

kernel_name = 'hybrid_retention_diffattn_moe_deepnorm_adaln'


def _layer_norm(x, eps=LN_EPS):
    xf = x.astype(jnp.float32)
    mu = jnp.mean(xf, axis=-1, keepdims=True)
    var = jnp.mean(jnp.square(xf - mu), axis=-1, keepdims=True)
    return ((xf - mu) * lax.rsqrt(var + eps)).astype(x.dtype)


def _layer_norm_affine(x, g, b):
    return _layer_norm(x) * g + b


def _rms_norm(x, g, eps):
    xf = x.astype(jnp.float32)
    y = xf * lax.rsqrt(jnp.mean(jnp.square(xf), axis=-1, keepdims=True) + eps)
    return (y * g.astype(jnp.float32)).astype(x.dtype)


def _rotary(x, pos):
    d = x.shape[-1]
    inv = 1.0 / (ROPE_BASE ** (jnp.arange(0, d, 2, dtype=jnp.float32) / d))
    ang = pos.astype(jnp.float32)[:, None] * inv[None, :]
    cos = jnp.cos(ang)[None, :, None, :]
    sin = jnp.sin(ang)[None, :, None, :]
    xf = x.astype(jnp.float32)
    x1, x2 = xf[..., : d // 2], xf[..., d // 2:]
    return jnp.concatenate([x1 * cos - x2 * sin, x1 * sin + x2 * cos], axis=-1).astype(x.dtype)


def _retention(q, k, v):
    B, S, H, dk = q.shape
    dv = v.shape[-1]
    n = S // CHUNK
    log_g = jnp.log(1.0 - 2.0 ** (-5.0 - jnp.arange(H, dtype=jnp.float32)))
    idx = jnp.arange(CHUNK, dtype=jnp.float32)
    rel = idx[:, None] - idx[None, :]
    decay = jnp.where(rel >= 0, jnp.exp(log_g[:, None, None] * jnp.maximum(rel, 0.0)), 0.0)
    qc = q.reshape(B, n, CHUNK, H, dk) * (dk ** -0.5)
    kc = k.reshape(B, n, CHUNK, H, dk)
    vc = v.reshape(B, n, CHUNK, H, dv)
    scores = jnp.einsum('bnihd,bnjhd->bnhij', qc, kc) * decay[None, None]
    inner = jnp.einsum('bnhij,bnjhe->bnihe', scores, vc)
    k_decay = jnp.exp(log_g[None, :] * (CHUNK - 1 - idx)[:, None])
    chunk_kv = jnp.einsum('bnjhd,jh,bnjhe->nbhde', kc, k_decay, vc).astype(jnp.float32)
    g_chunk = jnp.exp(log_g * CHUNK)[None, :, None, None]

    def step(state, kv):
        return state * g_chunk + kv, state

    _, prev = lax.scan(step, jnp.zeros_like(chunk_kv[0]), chunk_kv)
    q_decay = jnp.exp(log_g[None, :] * (idx + 1.0)[:, None])
    cross = jnp.einsum('bnihd,nbhde,ih->bnihe', qc, prev, q_decay)
    return (inner + cross).reshape(B, S, H, dv).astype(v.dtype)


def _diff_attention(q, k, v, lam, subln_g, lambda_init):
    B, S, H, _, d = q.shape
    nb = S // Q_BLOCK
    qb = (q * (d ** -0.5)).reshape(B, nb, Q_BLOCK, H, 2, d).transpose(1, 0, 2, 3, 4, 5)
    kpos = jnp.arange(S)
    starts = jnp.arange(nb) * Q_BLOCK

    def block(args):
        qi, start = args
        s = jnp.einsum('bqhcd,bkhcd->bhcqk', qi, k).astype(jnp.float32)
        qpos = start + jnp.arange(Q_BLOCK)
        s = jnp.where((kpos[None, :] <= qpos[:, None])[None, None, None], s, -jnp.inf)
        p = jax.nn.softmax(s, axis=-1)
        a = p[:, :, 0] - lam * p[:, :, 1]
        return jnp.einsum('bhqk,bkhe->bqhe', a.astype(v.dtype), v)

    out = lax.map(block, (qb, starts))
    out = out.transpose(1, 0, 2, 3, 4).reshape(B, S, H, 2 * d)
    return _rms_norm(out, subln_g, SUBLN_EPS) * (1.0 - lambda_init)


def _moe(h, router_w, router_b, w_gate, w_up, w_down):
    B, S, D = h.shape
    t = h.reshape(B * S, D)
    logits = jnp.matmul(t, router_w).astype(jnp.float32) + router_b.astype(jnp.float32)
    probs = jax.nn.softmax(logits, axis=-1)
    grouped = probs.reshape(-1, N_GROUPS, EXPERTS_PER_GROUP)
    top_in_group, _ = lax.top_k(grouped, TOP_K)
    _, g_idx = lax.top_k(jnp.sum(top_in_group, axis=-1), 1)
    sel = jnp.einsum('tg,tge->te', jax.nn.one_hot(g_idx[:, 0], N_GROUPS, dtype=jnp.float32), grouped)
    top_p, top_i = lax.top_k(sel, TOP_K)
    gates = top_p / jnp.sum(top_p, axis=-1, keepdims=True)
    expert_idx = g_idx * EXPERTS_PER_GROUP + top_i
    combine = jnp.einsum('tk,tke->te', gates, jax.nn.one_hot(expert_idx, N_EXPERTS, dtype=jnp.float32))
    combine = combine.astype(t.dtype)
    out = jnp.zeros_like(t)
    for e in range(N_EXPERTS):
        he = jax.nn.silu(jnp.matmul(t, w_gate[e])) * jnp.matmul(t, w_up[e])
        out = out + combine[:, e:e + 1] * jnp.matmul(he, w_down[e])
    return out.reshape(B, S, D)


def setup_inputs(seed: int = 0) -> dict:
    key = jax.random.key(seed)
    ks = jax.random.split(key, 20)
    f32 = jnp.float32
    D = D_MODEL
    x = jax.random.normal(ks[0], (BATCH, SEQ, D), f32)
    c = jax.random.normal(ks[1], (BATCH, D), f32)
    w_ada = jax.random.normal(ks[2], (DEPTH, D, N_MOD * D), f32) * (0.2 * D ** -0.5)
    gate_offset = jnp.repeat(jnp.array([0.0, 0.0, 1.0, 0.0, 0.0, 1.0], f32), D)
    b_ada = 0.01 * jax.random.normal(ks[3], (DEPTH, N_MOD * D), f32) + gate_offset[None, :]
    col_scale = jnp.concatenate([
        jnp.ones((W_RQ + W_RK,), f32), jnp.full((W_RV,), BETA, f32), jnp.ones((W_RG + W_DQ + W_DK,), f32),
        jnp.full((W_DV,), BETA, f32)])
    w_in = jax.random.normal(ks[4], (DEPTH, D, IN_WIDTH), f32) * (D ** -0.5) * col_scale[None, None, :]
    w_out = jax.random.normal(ks[5], (DEPTH, MIX_WIDTH, D), f32) * (MIX_WIDTH ** -0.5) * BETA
    lambda_q1 = 0.1 * jax.random.normal(ks[6], (DEPTH, DIFF_QK), f32)
    lambda_k1 = 0.1 * jax.random.normal(ks[7], (DEPTH, DIFF_QK), f32)
    lambda_q2 = 0.1 * jax.random.normal(ks[8], (DEPTH, DIFF_QK), f32)
    lambda_k2 = 0.1 * jax.random.normal(ks[9], (DEPTH, DIFF_QK), f32)
    diff_subln = 1.0 + 0.02 * jax.random.normal(ks[10], (DEPTH, DIFF_V), f32)
    ln_mix_g = 1.0 + 0.02 * jax.random.normal(ks[11], (DEPTH, D), f32)
    ln_mix_b = 0.02 * jax.random.normal(ks[12], (DEPTH, D), f32)
    ln_ffn_g = 1.0 + 0.02 * jax.random.normal(ks[13], (DEPTH, D), f32)
    ln_ffn_b = 0.02 * jax.random.normal(ks[14], (DEPTH, D), f32)
    router_w = jax.random.normal(ks[15], (D, N_EXPERTS), f32) * (D ** -0.5)
    router_b = 0.01 * jax.random.normal(ks[16], (N_EXPERTS,), f32)
    w_gate = jax.random.normal(ks[17], (DEPTH, N_EXPERTS, D, D_EXPERT), f32) * (D ** -0.5) * BETA
    w_up = jax.random.normal(ks[18], (DEPTH, N_EXPERTS, D, D_EXPERT), f32) * (D ** -0.5) * BETA
    w_down = jax.random.normal(ks[19], (DEPTH, N_EXPERTS, D_EXPERT, D), f32) * (D_EXPERT ** -0.5) * BETA
    return {'x': x, 'c': c, 'w_ada': w_ada, 'b_ada': b_ada, 'w_in': w_in, 'w_out': w_out,
            'lambda_q1': lambda_q1, 'lambda_k1': lambda_k1, 'lambda_q2': lambda_q2, 'lambda_k2': lambda_k2,
            'diff_subln': diff_subln, 'ln_mix_g': ln_mix_g, 'ln_mix_b': ln_mix_b,
            'ln_ffn_g': ln_ffn_g, 'ln_ffn_b': ln_ffn_b, 'router_w': router_w, 'router_b': router_b,
            'w_gate': w_gate, 'w_up': w_up, 'w_down': w_down}


def reference(x, c, w_ada, b_ada, w_in, w_out, lambda_q1, lambda_k1, lambda_q2, lambda_k2,
              diff_subln, ln_mix_g, ln_mix_b, ln_ffn_g, ln_ffn_b, router_w, router_b,
              w_gate, w_up, w_down):
    B, S, D = x.shape
    pos = jnp.arange(S)
    cond = jax.nn.silu(c)
    for l in range(DEPTH):
        mod = jnp.matmul(cond, w_ada[l]) + b_ada[l]
        sh1, sc1, g1, sh2, sc2, g2 = jnp.split(mod, N_MOD, axis=-1)
        h = _layer_norm(x) * (1.0 + sc1[:, None, :]) + sh1[:, None, :]
        proj = jnp.matmul(h, w_in[l])
        rq, rk, rv, rg, dq, dk, dv = jnp.split(proj, IN_SPLITS, axis=-1)
        rq = _rotary(rq.reshape(B, S, RET_HEADS, RET_QK), pos)
        rk = _rotary(rk.reshape(B, S, RET_HEADS, RET_QK), pos)
        ret = _retention(rq, rk, rv.reshape(B, S, RET_HEADS, RET_V))
        ret = _layer_norm(ret).reshape(B, S, RET_WIDTH) * jax.nn.silu(rg)
        lambda_init = 0.8 - 0.6 * math.exp(-0.3 * l)
        lam = (jnp.exp(jnp.sum(lambda_q1[l].astype(jnp.float32) * lambda_k1[l].astype(jnp.float32)))
               - jnp.exp(jnp.sum(lambda_q2[l].astype(jnp.float32) * lambda_k2[l].astype(jnp.float32)))
               + lambda_init)
        dif = _diff_attention(dq.reshape(B, S, DIFF_HEADS, 2, DIFF_QK),
                              dk.reshape(B, S, DIFF_HEADS, 2, DIFF_QK),
                              dv.reshape(B, S, DIFF_HEADS, DIFF_V),
                              lam, diff_subln[l], lambda_init).reshape(B, S, DIFF_WIDTH)
        mixed = jnp.matmul(jnp.concatenate([ret, dif], axis=-1), w_out[l])
        x = _layer_norm_affine(ALPHA * x + g1[:, None, :] * mixed, ln_mix_g[l], ln_mix_b[l])
        h = _layer_norm(x) * (1.0 + sc2[:, None, :]) + sh2[:, None, :]
        y = _moe(h, router_w, router_b, w_gate[l], w_up[l], w_down[l])
        x = _layer_norm_affine(ALPHA * x + g2[:, None, :] * y, ln_ffn_g[l], ln_ffn_b[l])
    return x
```

```cpp
#include <hip/hip_runtime.h>
#include <cstdio>
#include <cstdint>
#include <cmath>

typedef unsigned short bf16;
typedef float f32x4 __attribute__((ext_vector_type(4)));
typedef unsigned u32x4 __attribute__((ext_vector_type(4)));
typedef unsigned u32x2 __attribute__((ext_vector_type(2)));

constexpr int NB = 8, SEQ = 4096, DM = 1024, T = NB * SEQ, DEPTH = 2;
constexpr int INW = 3584, NE = 16, DE = 512;
constexpr int C_RQ = 0, C_RK = 512, C_RV = 1024, C_RG = 1536, C_DQ = 2048, C_DK = 2560, C_DV = 3072;
constexpr float ALPHA = 1.41421356237309515f;
constexpr float LN_EPS = 1e-5f;
constexpr float C2 = 0.125f * 1.4426950408889634f;
constexpr int MODW = 6 * DM;
constexpr int PAIR_ROWS = 69632;

constexpr size_t MiB = 1u << 20;
constexpr size_t WS_CTL = 0;
constexpr size_t WS_MOD = 1 * MiB;
constexpr size_t WS_ROT = 2 * MiB;
constexpr size_t WS_TOK = 3 * MiB;
constexpr size_t WS_LIST = 4 * MiB;
constexpr size_t WS_W = 8 * MiB;
constexpr size_t WS_S1 = 122 * MiB;
constexpr size_t WS_S3 = 186 * MiB;
constexpr size_t WS_S2 = 250 * MiB;
constexpr size_t WS_YP = WS_S2, WS_HE = WS_S2 + 136 * MiB, WS_MIXED = WS_HE;
constexpr size_t WS_END = 474 * MiB;
constexpr int CW_CNT = 64;

__device__ __forceinline__ float bf2f(bf16 v) { return __uint_as_float((unsigned)v << 16); }
__device__ __forceinline__ unsigned f2bf(float f) { unsigned u = __float_as_uint(f); return (u + 0x7fffu + ((u >> 16) & 1u)) >> 16; }
__device__ __forceinline__ unsigned pk2(float lo, float hi) { return f2bf(lo) | (f2bf(hi) << 16); }
__device__ __forceinline__ float dpp_add(float v, const int ctrl_tag) { return v; }
#define WS_DPP(v, ctrl) ((v) + __builtin_bit_cast(float, __builtin_amdgcn_update_dpp(0, __builtin_bit_cast(int, (v)), (ctrl), 0xf, 0xf, false)))
__device__ __forceinline__ float wave_sum(float v) {
    v = WS_DPP(v, 0xB1);
    v = WS_DPP(v, 0x4E);
    v = WS_DPP(v, 0x141);
    v = WS_DPP(v, 0x140);
    { auto rr = __builtin_amdgcn_permlane16_swap(__float_as_uint(v), __float_as_uint(v), false, false); v = __uint_as_float(rr[0]) + __uint_as_float(rr[1]); }
    { auto rr = __builtin_amdgcn_permlane32_swap(__float_as_uint(v), __float_as_uint(v), false, false); v = __uint_as_float(rr[0]) + __uint_as_float(rr[1]); }
    return v;
}
__device__ __forceinline__ float row16_sum(float v) {
    v = WS_DPP(v, 0xB1); v = WS_DPP(v, 0x4E); v = WS_DPP(v, 0x141); v = WS_DPP(v, 0x140); return v;
}
__device__ __forceinline__ float silu_f(float v) { return v / (1.f + __expf(-v)); }

__global__ void __launch_bounds__(256) k_mod(const float* c, const float* w_ada, const float* b_ada, const float* lq1, const float* lk1, const float* lq2, const float* lk2, float* mod) {
    __shared__ float cond[8][1024];
    const int l = blockIdx.y, j = blockIdx.x * 256 + threadIdx.x;
    for (int i = threadIdx.x; i < 8192; i += 256) { const float v = c[i]; cond[i >> 10][i & 1023] = v / (1.f + expf(-v)); }
    __syncthreads();
    float acc[8];
#pragma unroll
    for (int b = 0; b < 8; ++b) acc[b] = 0.f;
    const float* w = w_ada + (size_t)l * 1024 * MODW + j;
    for (int k = 0; k < 1024; ++k) { const float wv = w[(size_t)k * MODW];
#pragma unroll
        for (int b = 0; b < 8; ++b) acc[b] += cond[b][k] * wv; }
#pragma unroll
    for (int b = 0; b < 8; ++b) mod[(size_t)(l * 8 + b) * MODW + j] = acc[b] + b_ada[l * MODW + j];
    if (blockIdx.x == 0 && threadIdx.x == 0) {
        float s1 = 0.f, s2 = 0.f;
        for (int i = 0; i < 64; ++i) { s1 += lq1[l * 64 + i] * lk1[l * 64 + i]; s2 += lq2[l * 64 + i] * lk2[l * 64 + i]; }
        const float li = 0.8f - 0.6f * expf(-0.3f * (float)l);
        mod[2 * 8 * MODW + l] = expf(s1) - expf(s2) + li;
        mod[2 * 8 * MODW + 2 + l] = li;
    }
}
__global__ void k_rot(float* rot) {
    const int idx = blockIdx.x * 256 + threadIdx.x; if (idx >= 4096 * 32) return;
    const int pos = idx >> 5, i = idx & 31;
    const double inv = pow(10000.0, -(double)(2 * i) / 64.0), a = (double)pos * inv;
    rot[2 * idx] = (float)cos(a); rot[2 * idx + 1] = (float)sin(a);
}

__global__ void __launch_bounds__(256) k_ln_mod(const float* x, const float* modl, int sh_off, bf16* H) {
    const int row = blockIdx.x * 4 + (threadIdx.x >> 6), lane = threadIdx.x & 63, b = row / SEQ;
    const f32x4* xr = (const f32x4*)(x + (size_t)row * DM) + lane;
    f32x4 v[4]; float s = 0.f;
#pragma unroll
    for (int j = 0; j < 4; ++j) { v[j] = xr[64 * j]; s += (v[j].x + v[j].y) + (v[j].z + v[j].w); }
    const float mean = wave_sum(s) * (1.f / DM); float s2 = 0.f;
#pragma unroll
    for (int j = 0; j < 4; ++j) { v[j] = v[j] - mean; s2 += (v[j].x * v[j].x + v[j].y * v[j].y) + (v[j].z * v[j].z + v[j].w * v[j].w); }
    const float rstd = 1.f / sqrtf(wave_sum(s2) * (1.f / DM) + LN_EPS);
    const f32x4* sh = (const f32x4*)(modl + (size_t)b * MODW + sh_off) + lane; const f32x4* sc = sh + 256;
    u32x2* o = (u32x2*)(H + (size_t)row * DM) + lane;
#pragma unroll
    for (int j = 0; j < 4; ++j) { const f32x4 a = sh[64 * j], m = sc[64 * j]; const f32x4 r = v[j] * rstd * (m + 1.f) + a; u32x2 w; w.x = pk2(r.x, r.y); w.y = pk2(r.z, r.w); o[64 * j] = w; }
}

template <bool DUAL>
__device__ __forceinline__ void ngemm_core(const bf16* arow, const float* W0, const float* W1, int ldw, int K, float (&acc0)[8][4], float (&acc1)[8][4], float* As, float* Ws0, float* Ws1) {
    const int tid = threadIdx.x, tx = tid & 15, ty = tid >> 4;
#pragma unroll
    for (int i = 0; i < 8; ++i)
#pragma unroll
        for (int j = 0; j < 4; ++j) { acc0[i][j] = 0.f; acc1[i][j] = 0.f; }
    const int ar = tid >> 1, ak = (tid & 1) * 8, wk = tid >> 4, wn = (tid & 15) * 4;
    for (int k0 = 0; k0 < K; k0 += 16) {
        const u32x4 av = *(const u32x4*)(arow + k0);
        const f32x4 w0 = *(const f32x4*)(W0 + (size_t)(k0 + wk) * ldw + wn);
        f32x4 w1 = {0.f, 0.f, 0.f, 0.f}; if (DUAL) w1 = *(const f32x4*)(W1 + (size_t)(k0 + wk) * ldw + wn);
        __syncthreads();
        As[(ak + 0) * 129 + ar] = __uint_as_float(av.x << 16); As[(ak + 1) * 129 + ar] = __uint_as_float(av.x & 0xffff0000u);
        As[(ak + 2) * 129 + ar] = __uint_as_float(av.y << 16); As[(ak + 3) * 129 + ar] = __uint_as_float(av.y & 0xffff0000u);
        As[(ak + 4) * 129 + ar] = __uint_as_float(av.z << 16); As[(ak + 5) * 129 + ar] = __uint_as_float(av.z & 0xffff0000u);
        As[(ak + 6) * 129 + ar] = __uint_as_float(av.w << 16); As[(ak + 7) * 129 + ar] = __uint_as_float(av.w & 0xffff0000u);
        *(f32x4*)(Ws0 + wk * 64 + wn) = w0; if (DUAL) *(f32x4*)(Ws1 + wk * 64 + wn) = w1;
        __syncthreads();
#pragma unroll
        for (int k = 0; k < 16; ++k) {
            float a[8], b0[4], b1[4];
#pragma unroll
            for (int i = 0; i < 8; ++i) a[i] = As[k * 129 + ty + 16 * i];
#pragma unroll
            for (int j = 0; j < 4; ++j) { b0[j] = Ws0[k * 64 + tx + 16 * j]; if (DUAL) b1[j] = Ws1[k * 64 + tx + 16 * j]; }
#pragma unroll
            for (int i = 0; i < 8; ++i)
#pragma unroll
                for (int j = 0; j < 4; ++j) { acc0[i][j] += a[i] * b0[j]; if (DUAL) acc1[i][j] += a[i] * b1[j]; }
        }
    }
}

__global__ void __launch_bounds__(256) k_ngemm_inproj(const bf16* H, const float* Win, const float* rot, bf16* PROJ) {
    __shared__ float As[16 * 129], Ws0[16 * 64];
    const int tid = threadIdx.x, tx = tid & 15, ty = tid >> 4, col0 = blockIdx.x * 64, row0 = blockIdx.y * 128;
    float acc[8][4], dummy[8][4];
    ngemm_core<false>(H + (size_t)(row0 + (tid >> 1)) * DM + (tid & 1) * 8, Win + col0, nullptr, INW, DM, acc, dummy, As, Ws0, nullptr);
    const int region = col0 / 512;
#pragma unroll
    for (int i = 0; i < 8; ++i) {
        const int row = row0 + ty + 16 * i, pos = row % SEQ; bf16* o = PROJ + (size_t)row * INW + col0;
        if (region < 2) {
            const float sc = region == 0 ? 0.125f : 1.f;
#pragma unroll
            for (int j = 0; j < 2; ++j) { const int ic = tx + 16 * j; const float cs = rot[(pos * 32 + ic) * 2], sn = rot[(pos * 32 + ic) * 2 + 1];
                const float x1 = acc[i][j], x2 = acc[i][j + 2]; o[ic] = (bf16)f2bf((x1 * cs - x2 * sn) * sc); o[ic + 32] = (bf16)f2bf((x1 * sn + x2 * cs) * sc); }
        } else {
#pragma unroll
            for (int j = 0; j < 4; ++j) { float v = acc[i][j]; if (region == 3) v = silu_f(v); if (region == 4) v *= C2; o[tx + 16 * j] = (bf16)f2bf(v); }
        }
    }
}
__global__ void __launch_bounds__(256) k_ngemm_plain(const bf16* A, int lda, const float* W, int ldw, int K, bf16* C, int ldc) {
    __shared__ float As[16 * 129], Ws0[16 * 64];
    const int tid = threadIdx.x, tx = tid & 15, ty = tid >> 4, col0 = blockIdx.x * 64, row0 = blockIdx.y * 128;
    float acc[8][4], dummy[8][4];
    ngemm_core<false>(A + (size_t)(row0 + (tid >> 1)) * lda + (tid & 1) * 8, W + col0, nullptr, ldw, K, acc, dummy, As, Ws0, nullptr);
#pragma unroll
    for (int i = 0; i < 8; ++i)
#pragma unroll
        for (int j = 0; j < 4; ++j) C[(size_t)(row0 + ty + 16 * i) * ldc + col0 + tx + 16 * j] = (bf16)f2bf(acc[i][j]);
}

__global__ void __launch_bounds__(256) k_nret(const bf16* PROJ, bf16* CAT) {
    __shared__ float Qs[64 * 65], Ks[64 * 65], Vs[64 * 64], st[128]; float* Ss = Ks;
    const int tid = threadIdx.x, tx = tid & 15, ty = tid >> 4;
    const int qt = (gridDim.x - 1) - blockIdx.x, h = blockIdx.y, b = blockIdx.z, q0 = qt * 64;
    const float log_g = logf(1.f - exp2f(-5.f - (float)h));
    const bf16* base = PROJ + (size_t)b * SEQ * INW;
    for (int i = tid; i < 64 * 64; i += 256) { const int r = i >> 6, d = i & 63; Qs[r * 65 + d] = bf2f(base[(size_t)(q0 + r) * INW + C_RQ + h * 64 + d]); }
    float o[4][4];
#pragma unroll
    for (int i = 0; i < 4; ++i)
#pragma unroll
        for (int j = 0; j < 4; ++j) o[i][j] = 0.f;
    for (int kt = 0; kt <= qt; ++kt) {
        const int k0 = kt * 64;
        __syncthreads();
        for (int i = tid; i < 64 * 64; i += 256) { const int r = i >> 6, d = i & 63; Ks[r * 65 + d] = bf2f(base[(size_t)(k0 + r) * INW + C_RK + h * 64 + d]); Vs[r * 64 + d] = bf2f(base[(size_t)(k0 + r) * INW + C_RV + h * 64 + d]); }
        __syncthreads();
        float s[4][4];
#pragma unroll
        for (int i = 0; i < 4; ++i)
#pragma unroll
            for (int j = 0; j < 4; ++j) s[i][j] = 0.f;
        for (int d = 0; d < 64; ++d) { float a[4], k[4];
#pragma unroll
            for (int i = 0; i < 4; ++i) { a[i] = Qs[(ty + 16 * i) * 65 + d]; k[i] = Ks[(tx + 16 * i) * 65 + d]; }
#pragma unroll
            for (int i = 0; i < 4; ++i)
#pragma unroll
                for (int j = 0; j < 4; ++j) s[i][j] += a[i] * k[j]; }
        __syncthreads();
#pragma unroll
        for (int i = 0; i < 4; ++i)
#pragma unroll
            for (int j = 0; j < 4; ++j) { const int t = q0 + ty + 16 * i, m = k0 + tx + 16 * j; Ss[(ty + 16 * i) * 65 + tx + 16 * j] = (m <= t) ? s[i][j] * expf(log_g * (float)(t - m)) : 0.f; }
        __syncthreads();
        for (int m = 0; m < 64; ++m) { float p[4], v[4];
#pragma unroll
            for (int i = 0; i < 4; ++i) { p[i] = Ss[(ty + 16 * i) * 65 + m]; v[i] = Vs[m * 64 + tx + 16 * i]; }
#pragma unroll
            for (int i = 0; i < 4; ++i)
#pragma unroll
                for (int j = 0; j < 4; ++j) o[i][j] += p[i] * v[j]; }
    }
    __syncthreads();
#pragma unroll
    for (int i = 0; i < 4; ++i)
#pragma unroll
        for (int j = 0; j < 4; ++j) Ss[(ty + 16 * i) * 65 + tx + 16 * j] = o[i][j];
    __syncthreads();
    if (tid < 64) { float s = 0.f; for (int d = 0; d < 64; ++d) s += Ss[tid * 65 + d]; const float mean = s * (1.f / 64.f); float q = 0.f; for (int d = 0; d < 64; ++d) { const float e = Ss[tid * 65 + d] - mean; q += e * e; }
        st[tid] = mean; st[64 + tid] = 1.f / sqrtf(q * (1.f / 64.f) + LN_EPS); }
    __syncthreads();
#pragma unroll
    for (int i = 0; i < 4; ++i)
#pragma unroll
        for (int j = 0; j < 4; ++j) { const int r = ty + 16 * i, cc = tx + 16 * j; const size_t row = (size_t)b * SEQ + q0 + r;
            const float g = bf2f(PROJ[row * INW + C_RG + h * 64 + cc]);
            CAT[row * DM + h * 64 + cc] = (bf16)f2bf((o[i][j] - st[r]) * st[64 + r] * g); }
}

__global__ void __launch_bounds__(256) k_ndiff(const bf16* PROJ, const float* modx  , const float* subln, int l, bf16* CAT) {
    __shared__ float Qs[64 * 65], Ks[32 * 65], Vs[32 * 128], Ps[64 * 33], mrow[64], lrow[64], srow[64];
    const int tid = threadIdx.x, tx = tid & 15, ty = tid >> 4;
    const int qt = (gridDim.x - 1) - blockIdx.x, h = blockIdx.y, b = blockIdx.z, q0 = qt * 64;
    const float lam = modx[l], li = modx[2 + l];
    const bf16* base = PROJ + (size_t)b * SEQ * INW;
    float res[4][8];
    for (int c = 0; c < 2; ++c) {
        __syncthreads();
        for (int i = tid; i < 64 * 64; i += 256) { const int r = i >> 6, d = i & 63; Qs[r * 65 + d] = bf2f(base[(size_t)(q0 + r) * INW + C_DQ + h * 128 + c * 64 + d]); }
        if (tid < 64) { mrow[tid] = -INFINITY; lrow[tid] = 0.f; }
        float o[4][8];
#pragma unroll
        for (int i = 0; i < 4; ++i)
#pragma unroll
            for (int j = 0; j < 8; ++j) o[i][j] = 0.f;
        const int nkt = (q0 + 64) / 32;
        for (int kt = 0; kt < nkt; ++kt) {
            const int k0 = kt * 32;
            __syncthreads();
            for (int i = tid; i < 32 * 64; i += 256) { const int r = i >> 6, d = i & 63; Ks[r * 65 + d] = bf2f(base[(size_t)(k0 + r) * INW + C_DK + h * 128 + c * 64 + d]); }
            for (int i = tid; i < 32 * 128; i += 256) { const int r = i >> 7, d = i & 127; Vs[r * 128 + d] = bf2f(base[(size_t)(k0 + r) * INW + C_DV + h * 128 + d]); }
            __syncthreads();
            float s[4][2];
#pragma unroll
            for (int i = 0; i < 4; ++i) { s[i][0] = 0.f; s[i][1] = 0.f; }
            for (int d = 0; d < 64; ++d) { float a[4], k[2];
#pragma unroll
                for (int i = 0; i < 4; ++i) a[i] = Qs[(ty + 16 * i) * 65 + d];
                k[0] = Ks[tx * 65 + d]; k[1] = Ks[(tx + 16) * 65 + d];
#pragma unroll
                for (int i = 0; i < 4; ++i) { s[i][0] += a[i] * k[0]; s[i][1] += a[i] * k[1]; } }
#pragma unroll
            for (int i = 0; i < 4; ++i)
#pragma unroll
                for (int j = 0; j < 2; ++j) { const int t = q0 + ty + 16 * i, m = k0 + tx + 16 * j; Ps[(ty + 16 * i) * 33 + tx + 16 * j] = (m <= t) ? s[i][j] : -INFINITY; }
            __syncthreads();
            if (tid < 64) { float mx = mrow[tid]; for (int m = 0; m < 32; ++m) mx = fmaxf(mx, Ps[tid * 33 + m]);
                const float sc = exp2f(mrow[tid] - mx); float sum = 0.f;
                for (int m = 0; m < 32; ++m) { const float p = exp2f(Ps[tid * 33 + m] - mx); Ps[tid * 33 + m] = p; sum += p; }
                lrow[tid] = lrow[tid] * sc + sum; mrow[tid] = mx; srow[tid] = sc; }
            __syncthreads();
#pragma unroll
            for (int i = 0; i < 4; ++i) { const float sc = srow[ty + 16 * i];
#pragma unroll
                for (int j = 0; j < 8; ++j) o[i][j] *= sc; }
            for (int m = 0; m < 32; ++m) { float p[4], v[8];
#pragma unroll
                for (int i = 0; i < 4; ++i) p[i] = Ps[(ty + 16 * i) * 33 + m];
#pragma unroll
                for (int j = 0; j < 8; ++j) v[j] = Vs[m * 128 + tx + 16 * j];
#pragma unroll
                for (int i = 0; i < 4; ++i)
#pragma unroll
                    for (int j = 0; j < 8; ++j) o[i][j] += p[i] * v[j]; }
        }
        __syncthreads();
#pragma unroll
        for (int i = 0; i < 4; ++i) { const float inv = 1.f / lrow[ty + 16 * i];
#pragma unroll
            for (int j = 0; j < 8; ++j) { if (c == 0) res[i][j] = o[i][j] * inv; else res[i][j] -= lam * o[i][j] * inv; } }
    }
    __syncthreads();
#pragma unroll
    for (int i = 0; i < 4; ++i) { float q = 0.f;
#pragma unroll
        for (int j = 0; j < 8; ++j) q += res[i][j] * res[i][j];
        Ps[(ty + 16 * i) * 33 + tx] = q; }
    __syncthreads();
    if (tid < 64) { float q = 0.f; for (int m = 0; m < 16; ++m) q += Ps[tid * 33 + m]; srow[tid] = 1.f / sqrtf(q * (1.f / 128.f) + LN_EPS); }
    __syncthreads();
#pragma unroll
    for (int i = 0; i < 4; ++i)
#pragma unroll
        for (int j = 0; j < 8; ++j) { const int r = ty + 16 * i, cc = tx + 16 * j; const size_t row = (size_t)b * SEQ + q0 + r;
            CAT[row * DM + 512 + h * 128 + cc] = (bf16)f2bf(res[i][j] * srow[r] * subln[l * 128 + cc] * (1.f - li)); }
}

__global__ void __launch_bounds__(256) k_post_mix(const float* xin, const bf16* MIXED, const float* modl, const float* lng, const float* lnb, const float* rw, const float* rb,
                                                  bf16* X1, bf16* H, int* tok_e, float* tok_g, int* tok_slot, int* lists, int* cnt) {
    const int row = blockIdx.x * 4 + (threadIdx.x >> 6), lane = threadIdx.x & 63, b = row / SEQ;
    const f32x4* xr = (const f32x4*)(xin + (size_t)row * DM) + lane; const u32x2* mr = (const u32x2*)(MIXED + (size_t)row * DM) + lane;
    const f32x4* g1 = (const f32x4*)(modl + (size_t)b * MODW + 2 * DM) + lane; const f32x4* sh2 = g1 + 256; const f32x4* sc2 = g1 + 512;
    f32x4 v[4]; float s = 0.f;
#pragma unroll
    for (int j = 0; j < 4; ++j) { const f32x4 x = xr[64 * j], g = g1[64 * j]; const u32x2 m = mr[64 * j];
        f32x4 mv; mv.x = __uint_as_float(m.x << 16); mv.y = __uint_as_float(m.x & 0xffff0000u); mv.z = __uint_as_float(m.y << 16); mv.w = __uint_as_float(m.y & 0xffff0000u);
        v[j] = x * ALPHA + g * mv; s += (v[j].x + v[j].y) + (v[j].z + v[j].w); }
    float mean = wave_sum(s) * (1.f / DM), s2 = 0.f;
#pragma unroll
    for (int j = 0; j < 4; ++j) { v[j] = v[j] - mean; s2 += (v[j].x * v[j].x + v[j].y * v[j].y) + (v[j].z * v[j].z + v[j].w * v[j].w); }
    float rstd = 1.f / sqrtf(wave_sum(s2) * (1.f / DM) + LN_EPS);
    u32x2* xo = (u32x2*)(X1 + (size_t)row * DM) + lane; s = 0.f;
#pragma unroll
    for (int j = 0; j < 4; ++j) { const f32x4 g = ((const f32x4*)lng)[lane + 64 * j], bb = ((const f32x4*)lnb)[lane + 64 * j]; v[j] = v[j] * rstd * g + bb;
        u32x2 w; w.x = pk2(v[j].x, v[j].y); w.y = pk2(v[j].z, v[j].w); xo[64 * j] = w; s += (v[j].x + v[j].y) + (v[j].z + v[j].w); }
    mean = wave_sum(s) * (1.f / DM); s2 = 0.f;
#pragma unroll
    for (int j = 0; j < 4; ++j) { v[j] = v[j] - mean; s2 += (v[j].x * v[j].x + v[j].y * v[j].y) + (v[j].z * v[j].z + v[j].w * v[j].w); }
    rstd = 1.f / sqrtf(wave_sum(s2) * (1.f / DM) + LN_EPS);
    u32x2* ho = (u32x2*)(H + (size_t)row * DM) + lane;
    float lg[16];
#pragma unroll
    for (int e = 0; e < 16; ++e) lg[e] = 0.f;
#pragma unroll
    for (int j = 0; j < 4; ++j) { const f32x4 a = sh2[64 * j], m = sc2[64 * j]; v[j] = v[j] * rstd * (m + 1.f) + a;
        u32x2 w; w.x = pk2(v[j].x, v[j].y); w.y = pk2(v[j].z, v[j].w); ho[64 * j] = w;
        const f32x4* wr = (const f32x4*)(rw + (size_t)(4 * lane + 256 * j) * 16);
#pragma unroll
        for (int q = 0; q < 4; ++q) { const float hv = q == 0 ? v[j].x : q == 1 ? v[j].y : q == 2 ? v[j].z : v[j].w;
#pragma unroll
            for (int e4 = 0; e4 < 4; ++e4) { const f32x4 w4 = wr[q * 4 + e4]; lg[e4 * 4 + 0] += hv * w4.x; lg[e4 * 4 + 1] += hv * w4.y; lg[e4 * 4 + 2] += hv * w4.z; lg[e4 * 4 + 3] += hv * w4.w; } } }
    float mx = -INFINITY;
#pragma unroll
    for (int e = 0; e < 16; ++e) { lg[e] = wave_sum(lg[e]) + rb[e]; mx = fmaxf(mx, lg[e]); }
    float p[16], sum = 0.f;
#pragma unroll
    for (int e = 0; e < 16; ++e) { p[e] = expf(lg[e] - mx); sum += p[e]; }
    const float rs = 1.f / sum;
#pragma unroll
    for (int e = 0; e < 16; ++e) p[e] *= rs;
    int bg = 0; float bgs = -1.f;
#pragma unroll
    for (int g = 0; g < 4; ++g) { float m1 = p[4 * g]; int i1 = 0;
#pragma unroll
        for (int i = 1; i < 4; ++i) if (p[4 * g + i] > m1) { m1 = p[4 * g + i]; i1 = i; }
        float m2 = -1.f;
#pragma unroll
        for (int i = 0; i < 4; ++i) if (i != i1 && p[4 * g + i] > m2) m2 = p[4 * g + i];
        const float gs = m1 + m2; if (gs > bgs) { bgs = gs; bg = g; } }
    float q0 = 0.f, q1 = 0.f, q2 = 0.f, q3 = 0.f;
#pragma unroll
    for (int g = 0; g < 4; ++g) if (bg == g) { q0 = p[4 * g]; q1 = p[4 * g + 1]; q2 = p[4 * g + 2]; q3 = p[4 * g + 3]; }
    float m1 = q0; int i1 = 0; if (q1 > m1) { m1 = q1; i1 = 1; } if (q2 > m1) { m1 = q2; i1 = 2; } if (q3 > m1) { m1 = q3; i1 = 3; }
    float m2 = -1.f; int i2 = 0;
    if (i1 != 0 && q0 > m2) { m2 = q0; i2 = 0; } if (i1 != 1 && q1 > m2) { m2 = q1; i2 = 1; } if (i1 != 2 && q2 > m2) { m2 = q2; i2 = 2; } if (i1 != 3 && q3 > m2) { m2 = q3; i2 = 3; }
    if (lane == 0) {
        const int e1 = bg * 4 + i1, e2 = bg * 4 + i2; const float den = 1.f / (m1 + m2);
        const int s1 = atomicAdd(cnt + e1, 1), s2_ = atomicAdd(cnt + e2, 1);
        lists[(size_t)e1 * T + s1] = row; lists[(size_t)e2 * T + s2_] = row;
        tok_e[2 * row] = e1; tok_e[2 * row + 1] = e2; tok_g[2 * row] = m1 * den; tok_g[2 * row + 1] = m2 * den; tok_slot[2 * row] = s1; tok_slot[2 * row + 1] = s2_;
    }
}

__device__ __forceinline__ int expert_base(const int* cnt, int e) { int bs = 0; for (int i = 0; i < 16; ++i) if (i < e) bs += (cnt[i] + 255) & ~255; return bs; }
__global__ void __launch_bounds__(256) k_moe1(const bf16* H, const float* wg, const float* wu, const int* cnt, const int* lists, bf16* HE) {
    __shared__ float As[16 * 129], Ws0[16 * 64], Ws1[16 * 64];
    const int e = blockIdx.z, rt = blockIdx.y, ct = blockIdx.x, n = cnt[e]; if (rt * 128 >= n) return;
    const int tid = threadIdx.x, tx = tid & 15, ty = tid >> 4, base = expert_base(cnt, e);
    const int sl = rt * 128 + (tid >> 1), tok = lists[(size_t)e * T + (sl < n ? sl : 0)];
    float g[8][4], u[8][4];
    ngemm_core<true>(H + (size_t)tok * DM + (tid & 1) * 8, wg + (size_t)e * DM * DE + ct * 64, wu + (size_t)e * DM * DE + ct * 64, DE, DM, g, u, As, Ws0, Ws1);
#pragma unroll
    for (int i = 0; i < 8; ++i) { const int s = rt * 128 + ty + 16 * i; if (s < n) {
#pragma unroll
        for (int j = 0; j < 4; ++j) HE[(size_t)(base + s) * DE + ct * 64 + tx + 16 * j] = (bf16)f2bf(silu_f(g[i][j]) * u[i][j]); } }
}
__global__ void __launch_bounds__(256) k_moe2(const bf16* HE, const float* wd, const int* cnt, bf16* YP) {
    __shared__ float As[16 * 129], Ws0[16 * 64];
    const int e = blockIdx.z, rt = blockIdx.y, ct = blockIdx.x, n = cnt[e]; if (rt * 128 >= n) return;
    const int tid = threadIdx.x, tx = tid & 15, ty = tid >> 4, base = expert_base(cnt, e);
    const int sl = rt * 128 + (tid >> 1);
    float acc[8][4], dummy[8][4];
    ngemm_core<false>(HE + (size_t)(base + (sl < n ? sl : 0)) * DE + (tid & 1) * 8, wd + (size_t)e * DE * DM + ct * 64, nullptr, DM, DE, acc, dummy, As, Ws0, nullptr);
#pragma unroll
    for (int i = 0; i < 8; ++i) { const int s = rt * 128 + ty + 16 * i; if (s < n) {
#pragma unroll
        for (int j = 0; j < 4; ++j) YP[(size_t)(base + s) * DM + ct * 64 + tx + 16 * j] = (bf16)f2bf(acc[i][j]); } }
}

__global__ void __launch_bounds__(256) k_post_ffn(const bf16* X1, const bf16* YP, const float* modl, const float* lng, const float* lnb, const int* tok_e, const float* tok_g, const int* tok_slot, const int* cnt,
                                                  float* out, const float* modn, bf16* H) {
    const int row = blockIdx.x * 4 + (threadIdx.x >> 6), lane = threadIdx.x & 63, b = row / SEQ;
    const int e0 = tok_e[2 * row], e1 = tok_e[2 * row + 1]; const float w0 = tok_g[2 * row], w1 = tok_g[2 * row + 1];
    const size_t r0 = (size_t)expert_base(cnt, e0) + tok_slot[2 * row], r1 = (size_t)expert_base(cnt, e1) + tok_slot[2 * row + 1];
    const u32x2* xr = (const u32x2*)(X1 + (size_t)row * DM) + lane; const u32x2* y0 = (const u32x2*)(YP + r0 * DM) + lane; const u32x2* y1 = (const u32x2*)(YP + r1 * DM) + lane;
    const f32x4* g2 = (const f32x4*)(modl + (size_t)b * MODW + 5 * DM) + lane;
    f32x4 v[4]; float s = 0.f;
#pragma unroll
    for (int j = 0; j < 4; ++j) { const u32x2 x = xr[64 * j], a = y0[64 * j], c = y1[64 * j]; const f32x4 g = g2[64 * j];
        f32x4 xv, av, cv; xv.x = __uint_as_float(x.x << 16); xv.y = __uint_as_float(x.x & 0xffff0000u); xv.z = __uint_as_float(x.y << 16); xv.w = __uint_as_float(x.y & 0xffff0000u);
        av.x = __uint_as_float(a.x << 16); av.y = __uint_as_float(a.x & 0xffff0000u); av.z = __uint_as_float(a.y << 16); av.w = __uint_as_float(a.y & 0xffff0000u);
        cv.x = __uint_as_float(c.x << 16); cv.y = __uint_as_float(c.x & 0xffff0000u); cv.z = __uint_as_float(c.y << 16); cv.w = __uint_as_float(c.y & 0xffff0000u);
        v[j] = xv * ALPHA + g * (av * w0 + cv * w1); s += (v[j].x + v[j].y) + (v[j].z + v[j].w); }
    float mean = wave_sum(s) * (1.f / DM), s2 = 0.f;
#pragma unroll
    for (int j = 0; j < 4; ++j) { v[j] = v[j] - mean; s2 += (v[j].x * v[j].x + v[j].y * v[j].y) + (v[j].z * v[j].z + v[j].w * v[j].w); }
    float rstd = 1.f / sqrtf(wave_sum(s2) * (1.f / DM) + LN_EPS);
    f32x4* o = (f32x4*)(out + (size_t)row * DM) + lane; s = 0.f;
#pragma unroll
    for (int j = 0; j < 4; ++j) { const f32x4 g = ((const f32x4*)lng)[lane + 64 * j], bb = ((const f32x4*)lnb)[lane + 64 * j]; v[j] = v[j] * rstd * g + bb; o[64 * j] = v[j]; s += (v[j].x + v[j].y) + (v[j].z + v[j].w); }
    if (modn) {
        mean = wave_sum(s) * (1.f / DM); s2 = 0.f;
#pragma unroll
        for (int j = 0; j < 4; ++j) { v[j] = v[j] - mean; s2 += (v[j].x * v[j].x + v[j].y * v[j].y) + (v[j].z * v[j].z + v[j].w * v[j].w); }
        rstd = 1.f / sqrtf(wave_sum(s2) * (1.f / DM) + LN_EPS);
        const f32x4* sh = (const f32x4*)(modn + (size_t)b * MODW) + lane; const f32x4* sc = sh + 256; u32x2* ho = (u32x2*)(H + (size_t)row * DM) + lane;
#pragma unroll
        for (int j = 0; j < 4; ++j) { const f32x4 a = sh[64 * j], m = sc[64 * j]; const f32x4 r = v[j] * rstd * (m + 1.f) + a; u32x2 w; w.x = pk2(r.x, r.y); w.y = pk2(r.z, r.w); ho[64 * j] = w; }
    }
}

#include <hip/hip_bf16.h>
#ifndef RET_FAST
#define RET_FAST 1
#endif
#ifndef ATTN128
#define ATTN128 1
#endif
#ifndef ATTN_THRL
#define ATTN_THRL 8
#endif
#define LAS __attribute__((address_space(3)))
#define GAS __attribute__((address_space(1)))
typedef short bf16x8 __attribute__((ext_vector_type(8)));
typedef GAS unsigned gu32;
#define RLX_AGENT __ATOMIC_RELAXED, __HIP_MEMORY_SCOPE_AGENT
#define LDS_WAIT() asm volatile("s_waitcnt lgkmcnt(0)" ::: "memory")
#define VM_WAIT() asm volatile("s_waitcnt vmcnt(0)" ::: "memory")

constexpr size_t WL_IN = 0, WL_OUT = (size_t)INW * DM, WL_GU = WL_OUT + (size_t)DM * DM, WL_D = WL_GU + (size_t)NE * 1024 * DM, WL_STRIDE = WL_D + (size_t)NE * DM * DE;
static_assert(WL_STRIDE * 2 * 2 <= 114 * MiB, "weights fit");

namespace pg8 {
constexpr int BM = 256, BK = 64, HALF = 128, HTB = HALF * BK * 2, STAGE_BYTES = 8 * HTB, NXCD = 8, WGM = 8;
__host__ __device__ __forceinline__ int lds_byte(int r, int c) { const int st = (r >> 4) * 2 + (c >> 5), rr = r & 15, cc = c & 31, ob = rr * 64 + cc * 2; return st * 1024 + (ob ^ (((ob >> 9) & 1) << 5)); }
__host__ __device__ __forceinline__ void stage_rc(int b, int& R, int& C) { const int st = b / 1024, sb = b % 1024, swz = sb ^ (((sb >> 9) & 1) << 5); R = (st >> 1) * 16 + swz / 64; C = (st & 1) * 32 + (swz % 64) / 2; }
__host__ __device__ __forceinline__ int perm32(int rho) { const int n = rho >> 4, i = rho & 15; return 8 * (i >> 2) + 4 * n + (i & 3); }
struct Unit { int pm, pn; };

struct OrderBase {
    int nM, nN, nwg, G, c;
    __device__ __forceinline__ void init(int nM_, int nN_, int G_, int c_) { nM = nM_; nN = nN_; nwg = nM * nN; G = G_; c = c_; }
    __device__ __forceinline__ bool next(int i, Unit& u) const {
        const long L = (long)i * G + c; if (L >= nwg) return false;
        int wgid = (int)L; { const int q = nwg / NXCD, r = nwg % NXCD, xcd = wgid % NXCD, off = wgid / NXCD; wgid = (xcd < r ? xcd * (q + 1) : r * (q + 1) + (xcd - r) * q) + off; }
        const int nig = WGM * nN, gid = wgid / nig, fm = gid * WGM, gsz = (nM - fm) < WGM ? (nM - fm) : WGM;
        u.pm = fm + ((wgid % nig) % gsz); u.pn = (wgid % nig) / gsz; return true;
    }
    __device__ __forceinline__ void a_ready(const Unit&) const {}
    __device__ __forceinline__ void done(const Unit&) const {}
};
struct PlainSched : OrderBase {
    const bf16* Bt; int K;
    __device__ __forceinline__ void setup(const Unit& u, const int (&Rl)[2], const int (&Cb)[2], unsigned (&off)[2][2], const char*& bptr) const {
#pragma unroll
        for (int h = 0; h < 2; ++h)
#pragma unroll
            for (int i = 0; i < 2; ++i) off[h][i] = (unsigned)((u.pm * 256 + h * 128 + Rl[i]) * K * 2 + Cb[i]);
        bptr = (const char*)Bt + (size_t)u.pn * 256 * K * 2;
    }
};
struct MoeSched : OrderBase {
    const bf16* Bt; int K; const LAS int* tab; const int* cnt; const int* lists; bool gather;
    __device__ __forceinline__ void setup(const Unit& u, const int (&Rl)[2], const int (&Cb)[2], unsigned (&off)[2][2], const char*& bptr) const {
        const int te = tab[1 + u.pm], e = te & 255, s0 = (te >> 8) * 256;
        if (gather) { const int n = cnt[e];
#pragma unroll
            for (int h = 0; h < 2; ++h)
#pragma unroll
                for (int i = 0; i < 2; ++i) { const int s = s0 + h * 128 + Rl[i]; const int tok = lists[(size_t)e * T + (s < n ? s : 0)]; off[h][i] = (unsigned)(tok * K * 2 + Cb[i]); }
        } else {
#pragma unroll
            for (int h = 0; h < 2; ++h)
#pragma unroll
                for (int i = 0; i < 2; ++i) off[h][i] = (unsigned)((u.pm * 256 + h * 128 + Rl[i]) * K * 2 + Cb[i]);
        }
        bptr = (const char*)Bt + (size_t)(e * 4 + u.pn) * 256 * K * 2;
    }
};

__device__ __forceinline__ unsigned cvt_pk_bf16(float lo, float hi) { unsigned r; asm volatile("v_cvt_pk_bf16_f32 %0, %1, %2" : "=v"(r) : "v"(lo), "v"(hi)); return r; }
__device__ __forceinline__ float fsilu(float v) { return v * __builtin_amdgcn_rcpf(1.f + __expf(-v)); }

struct EpiInProj {
    static constexpr bool PERM = true, AFTER_DRAIN = false;
    bf16* P; const float* rot; const float* dtab;
    __device__ __forceinline__ void operator()(const f32x4 (&acc)[2][2][4][2], const Unit& u, int wr, int wc, int fr, int fq) const {
        const int row0 = u.pm * BM + wr * 64 + fr;
        if (u.pn < 4) {
            const float sc0 = u.pn < 2 ? 0.125f : 1.f; const float* dt = dtab ? dtab + (u.pn >> 1) * 1024 + ((u.pn & 1) * 4 + wc) * 128 : nullptr;
#pragma unroll
            for (int ai = 0; ai < 2; ++ai) {
                f32x4 tt[4][4]; float scv[4];
#pragma unroll
                for (int m = 0; m < 4; ++m) { const int pos = (row0 + ai * HALF + m * 16) & (SEQ - 1); const f32x4* rt = (const f32x4*)(rot + (size_t)(pos * 32 + 8 * fq) * 2);
                    tt[m][0] = rt[0]; tt[m][1] = rt[1]; tt[m][2] = rt[2]; tt[m][3] = rt[3]; scv[m] = dt ? dt[pos & 127] : sc0; }
#pragma unroll
                for (int m = 0; m < 4; ++m) { const int row = row0 + ai * HALF + m * 16; const float sc = scv[m];
                    const f32x4 t0 = tt[m][0], t1 = tt[m][1], t2 = tt[m][2], t3 = tt[m][3];
                    const f32x4 xa = acc[ai][0][m][0], xb = acc[ai][0][m][1], ya = acc[ai][1][m][0], yb = acc[ai][1][m][1];
                    u32x4 w1, w2;
                    w1.x = cvt_pk_bf16((xa[0] * t0.x - ya[0] * t0.y) * sc, (xa[1] * t0.z - ya[1] * t0.w) * sc); w1.y = cvt_pk_bf16((xa[2] * t1.x - ya[2] * t1.y) * sc, (xa[3] * t1.z - ya[3] * t1.w) * sc);
                    w1.z = cvt_pk_bf16((xb[0] * t2.x - yb[0] * t2.y) * sc, (xb[1] * t2.z - yb[1] * t2.w) * sc); w1.w = cvt_pk_bf16((xb[2] * t3.x - yb[2] * t3.y) * sc, (xb[3] * t3.z - yb[3] * t3.w) * sc);
                    w2.x = cvt_pk_bf16((xa[0] * t0.y + ya[0] * t0.x) * sc, (xa[1] * t0.w + ya[1] * t0.z) * sc); w2.y = cvt_pk_bf16((xa[2] * t1.y + ya[2] * t1.x) * sc, (xa[3] * t1.w + ya[3] * t1.z) * sc);
                    w2.z = cvt_pk_bf16((xb[0] * t2.y + yb[0] * t2.x) * sc, (xb[1] * t2.w + yb[1] * t2.z) * sc); w2.w = cvt_pk_bf16((xb[2] * t3.y + yb[2] * t3.x) * sc, (xb[3] * t3.w + yb[3] * t3.z) * sc);
                    bf16* o = P + (size_t)row * INW + u.pn * BM + 64 * wc + 8 * fq;
                    *(u32x4*)o = w1; *(u32x4*)(o + 32) = w2; }
            }
        } else {
            const int region = u.pn >> 1;
#pragma unroll
            for (int ai = 0; ai < 2; ++ai)
#pragma unroll
                for (int m = 0; m < 4; ++m) { bf16* o = P + (size_t)(row0 + ai * HALF + m * 16) * INW + u.pn * BM + wc * 32 + 8 * fq;
#pragma unroll
                    for (int bj = 0; bj < 2; ++bj) { f32x4 v0 = acc[ai][bj][m][0], v1 = acc[ai][bj][m][1];
                        if (region == 3) { v0[0] = fsilu(v0[0]); v0[1] = fsilu(v0[1]); v0[2] = fsilu(v0[2]); v0[3] = fsilu(v0[3]); v1[0] = fsilu(v1[0]); v1[1] = fsilu(v1[1]); v1[2] = fsilu(v1[2]); v1[3] = fsilu(v1[3]); }
                        if (region == 4) { v0 = v0 * C2; v1 = v1 * C2; }
                        u32x4 w; w.x = cvt_pk_bf16(v0[0], v0[1]); w.y = cvt_pk_bf16(v0[2], v0[3]); w.z = cvt_pk_bf16(v1[0], v1[1]); w.w = cvt_pk_bf16(v1[2], v1[3]);
                        *(u32x4*)(o + bj * HALF) = w; } }
        }
    }
};
struct EpiPlain {
    static constexpr bool PERM = true, AFTER_DRAIN = false;
    bf16* O; int ldc;
    __device__ __forceinline__ void operator()(const f32x4 (&acc)[2][2][4][2], const Unit& u, int wr, int wc, int fr, int fq) const {
        const int row0 = u.pm * BM + wr * 64 + fr, col0 = u.pn * BM + wc * 32 + 8 * fq;
#pragma unroll
        for (int ai = 0; ai < 2; ++ai)
#pragma unroll
            for (int m = 0; m < 4; ++m) { bf16* o = O + (size_t)(row0 + ai * HALF + m * 16) * ldc + col0;
#pragma unroll
                for (int bj = 0; bj < 2; ++bj) { const f32x4 v0 = acc[ai][bj][m][0], v1 = acc[ai][bj][m][1];
                    u32x4 w; w.x = cvt_pk_bf16(v0[0], v0[1]); w.y = cvt_pk_bf16(v0[2], v0[3]); w.z = cvt_pk_bf16(v1[0], v1[1]); w.w = cvt_pk_bf16(v1[2], v1[3]);
                    *(u32x4*)(o + bj * HALF) = w; } }
    }
};
struct EpiGateUp {
    static constexpr bool PERM = true, AFTER_DRAIN = false;
    bf16* HE;
    __device__ __forceinline__ void operator()(const f32x4 (&acc)[2][2][4][2], const Unit& u, int wr, int wc, int fr, int fq) const {
        const int row0 = u.pm * BM + wr * 64 + fr, col0 = u.pn * 128 + wc * 32 + 8 * fq;
#pragma unroll
        for (int ai = 0; ai < 2; ++ai)
#pragma unroll
            for (int m = 0; m < 4; ++m) { const f32x4 g0 = acc[ai][0][m][0], g1 = acc[ai][0][m][1], u0 = acc[ai][1][m][0], u1 = acc[ai][1][m][1];
                u32x4 w; w.x = cvt_pk_bf16(fsilu(g0[0]) * u0[0], fsilu(g0[1]) * u0[1]); w.y = cvt_pk_bf16(fsilu(g0[2]) * u0[2], fsilu(g0[3]) * u0[3]);
                w.z = cvt_pk_bf16(fsilu(g1[0]) * u1[0], fsilu(g1[1]) * u1[1]); w.w = cvt_pk_bf16(fsilu(g1[2]) * u1[2], fsilu(g1[3]) * u1[3]);
                *(u32x4*)(HE + (size_t)(row0 + ai * HALF + m * 16) * DE + col0) = w; }
    }
};

template <class Epi, class Sched, bool ALIGN_EPI>
__device__ __forceinline__ void gemm_phase(LAS unsigned char* lds, const char* gA, int K, const Sched& S, const Epi& E) {
    int tid_ = threadIdx.x; asm volatile("" : "+v"(tid_));
    const int tid = tid_, wid = __builtin_amdgcn_readfirstlane(tid >> 6), lane = tid & 63, wr = wid >> 2, wc = wid & 3, fr = lane & 15, fq = lane >> 4;
    const int nt = K / BK;
    unsigned voffB[2]; int Rl[2], Cb[2];
#pragma unroll
    for (int i = 0; i < 2; ++i) { int R, C; stage_rc(tid * 16 + i * 8192, R, C); const int Rb = Epi::PERM ? ((R & ~31) + perm32(R & 31)) : R;
        voffB[i] = (unsigned)(Rb * K + C) * 2u; Rl[i] = R; Cb[i] = C * 2; }
    const size_t kstep = (size_t)(BK * 2), hstep = (size_t)HALF * K * 2;
    const unsigned ldsw = (unsigned)wid * 1024u;
    const int aoff = lds_byte(wr * 64 + fr, fq * 8), boff = lds_byte(wc * 32 + fr, fq * 8);
#define PG8_SA(b, h) (((b) * 2 + (h)) * HTB)
#define PG8_SB(b, h) ((4 + (b) * 2 + (h)) * HTB)
#define PG8_STAGE(bufoff, gbase, voff) do { _Pragma("unroll") for (int _i = 0; _i < 2; ++_i) \
        __builtin_amdgcn_global_load_lds((const unsigned*)((const char*)(gbase) + (voff)[_i]), (LAS unsigned*)(lds + (bufoff) + ldsw + _i * 8192), 16, 0, 0); } while (0)
#define PG8_LDA(dst, b, h) do { _Pragma("unroll") for (int m = 0; m < 4; ++m) _Pragma("unroll") for (int k = 0; k < 2; ++k) dst[m][k] = *(const LAS bf16x8*)(lds + PG8_SA(b, h) + aoff + m * 2048 + k * 1024); } while (0)
#define PG8_LDB(dst, b, h) do { _Pragma("unroll") for (int n = 0; n < 2; ++n) _Pragma("unroll") for (int k = 0; k < 2; ++k) dst[n][k] = *(const LAS bf16x8*)(lds + PG8_SB(b, h) + boff + n * 2048 + k * 1024); } while (0)
#define PG8_MMA(ai, bj, At, Bt) do { __builtin_amdgcn_s_setprio(1); _Pragma("unroll") for (int m = 0; m < 4; ++m) _Pragma("unroll") for (int n = 0; n < 2; ++n) _Pragma("unroll") for (int k = 0; k < 2; ++k) \
        acc[ai][bj][m][n] = __builtin_amdgcn_mfma_f32_16x16x32_bf16(Bt[n][k], At[m][k], acc[ai][bj][m][n], 0, 0, 0); __builtin_amdgcn_s_setprio(0); } while (0)
#define PG8_WAIT_V(n) asm volatile("s_waitcnt vmcnt(" #n ")" ::: "memory")
#define PG8_WAIT_L(n) asm volatile("s_waitcnt lgkmcnt(" #n ")" ::: "memory")
#define PG8_BAR __builtin_amdgcn_s_barrier()
#define PG8_SCHED __builtin_amdgcn_sched_barrier(0)
    Unit cur, nxt; int ui = 0;
    if (!S.next(0, cur)) return;
    f32x4 acc[2][2][4][2];
#pragma unroll
    for (int a = 0; a < 2; ++a)
#pragma unroll
        for (int b = 0; b < 2; ++b)
#pragma unroll
            for (int m = 0; m < 4; ++m)
#pragma unroll
                for (int n = 0; n < 2; ++n) acc[a][b][m][n] = (f32x4){0.f, 0.f, 0.f, 0.f};
    bf16x8 At[4][2], B0[2][2], B1[2][2];
    unsigned oc[2][2], on[2][2]; const char* cB; const char* nB;
    S.setup(cur, Rl, Cb, oc, cB);
    S.a_ready(cur);
    PG8_STAGE(PG8_SB(0, 0), cB, voffB); PG8_STAGE(PG8_SB(0, 1), cB + hstep, voffB); PG8_STAGE(PG8_SA(0, 0), gA, oc[0]); PG8_STAGE(PG8_SA(0, 1), gA, oc[1]);
    if (wr == 1) PG8_BAR;
    PG8_WAIT_V(2); PG8_BAR;
    PG8_STAGE(PG8_SB(1, 0), cB + kstep, voffB); PG8_STAGE(PG8_SA(1, 0), gA + kstep, oc[0]); PG8_STAGE(PG8_SB(1, 1), cB + hstep + kstep, voffB);
    PG8_WAIT_V(6); PG8_BAR;
    for (;;) {
        const bool has_next = S.next(ui + 1, nxt);
        if (has_next) S.setup(nxt, Rl, Cb, on, nB);
        else { nB = cB;
#pragma unroll
            for (int h = 0; h < 2; ++h)
#pragma unroll
                for (int i = 0; i < 2; ++i) on[h][i] = oc[h][i]; }
        for (int t = 0; t < nt; t += 2) {
            const bool last = (t == nt - 2);
            const char* a1 = gA + (size_t)(t + 1) * kstep;
            const char* a2 = last ? gA : gA + (size_t)(t + 2) * kstep; const char* b2 = last ? nB : cB + (size_t)(t + 2) * kstep;
            const char* a3 = a2 + kstep; const char* b3 = b2 + kstep;
            unsigned o2[2][2];
#pragma unroll
            for (int h = 0; h < 2; ++h)
#pragma unroll
                for (int i = 0; i < 2; ++i) o2[h][i] = last ? on[h][i] : oc[h][i];
            if (last && has_next) S.a_ready(nxt);
            PG8_LDB(B0, 0, 0); PG8_LDB(B1, 0, 1); PG8_SCHED; PG8_LDA(At, 0, 0); PG8_STAGE(PG8_SA(1, 1), a1, oc[1]);
            PG8_WAIT_V(8); PG8_WAIT_L(0); PG8_BAR; PG8_MMA(0, 0, At, B0); PG8_MMA(0, 1, At, B1); PG8_BAR; PG8_SCHED;
            PG8_LDA(At, 0, 1); PG8_STAGE(PG8_SB(0, 0), b2, voffB); PG8_STAGE(PG8_SB(0, 1), b2 + hstep, voffB); PG8_STAGE(PG8_SA(0, 0), a2, o2[0]);
            PG8_WAIT_V(8); PG8_WAIT_L(0); PG8_BAR; PG8_MMA(1, 0, At, B0); PG8_MMA(1, 1, At, B1); PG8_BAR; PG8_SCHED;
            PG8_LDB(B0, 1, 0); PG8_LDB(B1, 1, 1); PG8_SCHED; PG8_LDA(At, 1, 0); PG8_STAGE(PG8_SA(0, 1), a2, o2[1]);
            PG8_WAIT_V(8); PG8_WAIT_L(0); PG8_BAR; PG8_MMA(0, 0, At, B0); PG8_MMA(0, 1, At, B1); PG8_BAR; PG8_SCHED;
            PG8_LDA(At, 1, 1); PG8_STAGE(PG8_SB(1, 0), b3, voffB); PG8_STAGE(PG8_SB(1, 1), b3 + hstep, voffB); PG8_STAGE(PG8_SA(1, 0), a3, o2[0]);
            PG8_WAIT_V(8); PG8_WAIT_L(0); PG8_BAR; PG8_MMA(1, 0, At, B0); PG8_MMA(1, 1, At, B1); PG8_BAR; PG8_SCHED;
        }
        if constexpr (ALIGN_EPI) { if (wr == 0) PG8_BAR; }
        E(acc, cur, wr, wc, fr, fq); S.done(cur);
        if (!has_next) break;
#pragma unroll
        for (int a = 0; a < 2; ++a)
#pragma unroll
            for (int b = 0; b < 2; ++b)
#pragma unroll
                for (int m = 0; m < 4; ++m)
#pragma unroll
                    for (int n = 0; n < 2; ++n) acc[a][b][m][n] = (f32x4){0.f, 0.f, 0.f, 0.f};
        cur = nxt; cB = nB; ++ui;
#pragma unroll
        for (int h = 0; h < 2; ++h)
#pragma unroll
            for (int i = 0; i < 2; ++i) oc[h][i] = on[h][i];
        if constexpr (ALIGN_EPI) { if (wr == 1) PG8_BAR; }
    }
    PG8_WAIT_V(0);
    if constexpr (!ALIGN_EPI) { if (wr == 0) PG8_BAR; }
    PG8_BAR;
#undef PG8_SA
#undef PG8_SB
#undef PG8_STAGE
#undef PG8_LDA
#undef PG8_LDB
#undef PG8_MMA
#undef PG8_WAIT_V
#undef PG8_WAIT_L
#undef PG8_BAR
#undef PG8_SCHED
}
}
#ifndef RS1
#define RS1 13
#define RS2 22
#define RS3 28
#endif
namespace ret {
constexpr int QB0 = 0, KB0 = 32768, VB0 = 65536, ST0 = 98304;
constexpr int RET_LDS_BYTES = ST0 + 2 * 8192;
__device__ __forceinline__ int toff(int row, int c16) { return row * 128 + ((c16 ^ (row & 7)) << 4); }
typedef short v4i16_t __attribute__((ext_vector_type(4)));
__device__ __forceinline__ v4i16_t trd(const LAS unsigned char* p) { return __builtin_amdgcn_ds_read_tr16_b64_v4i16((LAS v4i16_t*)p); }
__device__ __forceinline__ bf16x8 cat8(v4i16_t a, v4i16_t b) { return (bf16x8){a[0], a[1], a[2], a[3], b[0], b[1], b[2], b[3]}; }

__device__ __forceinline__ float xsum_16_32(float v) {
    { auto rr = __builtin_amdgcn_permlane16_swap(__float_as_uint(v), __float_as_uint(v), false, false); v = __uint_as_float(rr[0]) + __uint_as_float(rr[1]); }
    { auto rr = __builtin_amdgcn_permlane32_swap(__float_as_uint(v), __float_as_uint(v), false, false); v = __uint_as_float(rr[0]) + __uint_as_float(rr[1]); }
    return v;
}
__device__ __forceinline__ void ret_unit(int b, int h, int seg, const bf16* PROJ, bf16* CAT, float gC, LAS unsigned char* lds) {
    int tid_ = threadIdx.x; asm volatile("" : "+v"(tid_));
    const int tid = tid_, lane = tid & 63, w = __builtin_amdgcn_readfirstlane(tid >> 6), g = lane >> 4, c15 = lane & 15;
    const int blk = w < 4 ? w : 11 - w;
    const bf16* base = PROJ + (size_t)b * SEQ * INW;
    const int nfirst = seg == 0 ? 0 : seg == 1 ? RS1 : seg == 2 ? RS2 : RS3, nend = seg == 0 ? RS1 : seg == 1 ? RS2 : seg == 2 ? RS3 : 32;
    const int dr = lane >> 3, dc = (lane & 7) ^ dr;
#define RET_DMA(tileoff, colbase, m) do { _Pragma("unroll") for (int _p = 0; _p < 2; ++_p) { const int pc = w + 8 * _p; \
        __builtin_amdgcn_global_load_lds((const unsigned*)(base + (size_t)((m) * 128 + 8 * pc + dr) * INW + (colbase) + h * 64 + dc * 8), (LAS unsigned*)(lds + (tileoff) + pc * 1024), 16, 0, 0); } } while (0)
    f32x4 sacc[2]; sacc[0] = (f32x4){0.f, 0.f, 0.f, 0.f}; sacc[1] = (f32x4){0.f, 0.f, 0.f, 0.f};
    const int et_s = w >> 1, dt0 = 2 * (w & 1);
    for (int i = tid; i < 8192 / 16; i += 512) *(LAS u32x4*)(lds + ST0 + i * 16) = (u32x4){0u, 0u, 0u, 0u};
    RET_DMA(KB0, C_RK, 0); RET_DMA(VB0, C_RV, 0); if (nfirst == 0) RET_DMA(QB0, C_RQ, 0);
    __syncthreads();
#define RET_STATE_UPDATE() do { if (m + 1 < nend) { sacc[0] = sacc[0] * gC; sacc[1] = sacc[1] * gC; _Pragma("unroll") for (int ks = 0; ks < 4; ++ks) { const int q = c15 >> 2, p = c15 & 3, r0 = 32 * ks + 8 * g + q; const bf16x8 vf = cat8(trd(Vt + toff(r0, 2 * et_s + (p >> 1)) + (p & 1) * 8), trd(Vt + toff(r0 + 4, 2 * et_s + (p >> 1)) + (p & 1) * 8)); _Pragma("unroll") for (int dd = 0; dd < 2; ++dd) { const int c16 = 2 * (dt0 + dd) + (p >> 1); const bf16x8 kf = cat8(trd(Kt + toff(r0, c16) + (p & 1) * 8), trd(Kt + toff(r0 + 4, c16) + (p & 1) * 8)); sacc[dd] = __builtin_amdgcn_mfma_f32_16x16x32_bf16(vf, kf, sacc[dd], 0, 0, 0); } } _Pragma("unroll") for (int dd = 0; dd < 2; ++dd) _Pragma("unroll") for (int r = 0; r < 4; ++r) { const int e = 16 * et_s + 4 * g + r, d = 16 * (dt0 + dd) + c15; *(LAS unsigned short*)(STn + toff(e, d >> 3) + (d & 7) * 2) = (unsigned short)f2bf(sacc[dd][r]); } } } while (0)
#pragma unroll 1
    for (int m = 0; m < nend; ++m) {
        const int cur = m & 1, nx = cur ^ 1; const bool full = m >= nfirst;
        if (m + 1 < nend) { RET_DMA(KB0 + nx * 16384, C_RK, m + 1); RET_DMA(VB0 + nx * 16384, C_RV, m + 1); if (m + 1 >= nfirst) RET_DMA(QB0 + nx * 16384, C_RQ, m + 1); }
        const LAS unsigned char* Qt = lds + QB0 + cur * 16384; const LAS unsigned char* Kt = lds + KB0 + cur * 16384; const LAS unsigned char* Vt = lds + VB0 + cur * 16384;
        const LAS unsigned char* STc = lds + ST0 + cur * 8192; LAS unsigned char* STn = lds + ST0 + nx * 8192;
        if (full) {
            const size_t row = (size_t)b * SEQ + m * 128 + 16 * blk + c15;
            u32x2 gg[4];
#pragma unroll
            for (int et = 0; et < 4; ++et) gg[et] = *(const GAS u32x2*)(PROJ + row * INW + C_RG + h * 64 + 16 * et + 4 * g);
            bf16x8 qf[2];
#pragma unroll
            for (int ks = 0; ks < 2; ++ks) qf[ks] = *(const LAS bf16x8*)(Qt + toff(16 * blk + c15, 4 * ks + g));
            bf16x8 pf[4];
#pragma unroll
            for (int ks = 0; ks < 4; ++ks) {
                f32x4 s0 = (f32x4){0.f, 0.f, 0.f, 0.f}, s1 = (f32x4){0.f, 0.f, 0.f, 0.f};
                if (2 * ks <= blk) {
#pragma unroll
                    for (int kk = 0; kk < 2; ++kk) s0 = __builtin_amdgcn_mfma_f32_16x16x32_bf16(*(const LAS bf16x8*)(Kt + toff(32 * ks + c15, 4 * kk + g)), qf[kk], s0, 0, 0, 0);
                    if (2 * ks == blk) {
#pragma unroll
                        for (int r = 0; r < 4; ++r) if (4 * g + r > c15) s0[r] = 0.f; }
                }
                if (2 * ks + 1 <= blk) {
#pragma unroll
                    for (int kk = 0; kk < 2; ++kk) s1 = __builtin_amdgcn_mfma_f32_16x16x32_bf16(*(const LAS bf16x8*)(Kt + toff(32 * ks + 16 + c15, 4 * kk + g)), qf[kk], s1, 0, 0, 0);
                    if (2 * ks + 1 == blk) {
#pragma unroll
                        for (int r = 0; r < 4; ++r) if (4 * g + r > c15) s1[r] = 0.f; }
                }
                u32x4 pk; pk.x = pk2(s0[0], s0[1]); pk.y = pk2(s0[2], s0[3]); pk.z = pk2(s1[0], s1[1]); pk.w = pk2(s1[2], s1[3]);
                pf[ks] = __builtin_bit_cast(bf16x8, pk);
            }
            f32x4 o[4];
#pragma unroll
            for (int et = 0; et < 4; ++et) {
                f32x4 a = (f32x4){0.f, 0.f, 0.f, 0.f};
#pragma unroll
                for (int kk = 0; kk < 2; ++kk) a = __builtin_amdgcn_mfma_f32_16x16x32_bf16(*(const LAS bf16x8*)(STc + toff(16 * et + c15, 4 * kk + g)), qf[kk], a, 0, 0, 0);
                a = a * gC;
#pragma unroll
                for (int ks = 0; ks < 4; ++ks) if (2 * ks <= blk) {
                    const int q = c15 >> 2, p = c15 & 3, r0 = 32 * ks + 4 * g + q, c16 = 2 * et + (p >> 1);
                    const v4i16_t v0 = trd(Vt + toff(r0, c16) + (p & 1) * 8), v1 = trd(Vt + toff(r0 + 16, c16) + (p & 1) * 8);
                    a = __builtin_amdgcn_mfma_f32_16x16x32_bf16(cat8(v0, v1), pf[ks], a, 0, 0, 0);
                }
                o[et] = a;
            }
            RET_STATE_UPDATE();
            float s = 0.f;
#pragma unroll
            for (int et = 0; et < 4; ++et) s += (o[et][0] + o[et][1]) + (o[et][2] + o[et][3]);
            s = xsum_16_32(s);
            const float mean = s * (1.f / 64.f); float q2 = 0.f;
#pragma unroll
            for (int et = 0; et < 4; ++et) { o[et] = o[et] - mean; q2 += (o[et][0] * o[et][0] + o[et][1] * o[et][1]) + (o[et][2] * o[et][2] + o[et][3] * o[et][3]); }
            q2 = xsum_16_32(q2);
            const float rstd = 1.f / sqrtf(q2 * (1.f / 64.f) + LN_EPS);
#pragma unroll
            for (int et = 0; et < 4; ++et) {
                const float g0 = __uint_as_float(gg[et].x << 16), g1 = __uint_as_float(gg[et].x & 0xffff0000u), g2 = __uint_as_float(gg[et].y << 16), g3 = __uint_as_float(gg[et].y & 0xffff0000u);
                u32x2 wv; wv.x = pk2(o[et][0] * rstd * g0, o[et][1] * rstd * g1); wv.y = pk2(o[et][2] * rstd * g2, o[et][3] * rstd * g3);
                *(GAS u32x2*)(CAT + row * DM + h * 64 + 16 * et + 4 * g) = wv; asm volatile("s_nop 1" :: "v"(wv.x), "v"(wv.y) : "memory"); }
        }
        else { RET_STATE_UPDATE(); }
        __syncthreads();
    }
#undef RET_DMA
#undef RET_STATE_UPDATE
}
}
namespace attn_body {
using bf16=__hip_bfloat16;
using bf16x8=__attribute__((ext_vector_type(8)))short;
using s16x4=__attribute__((ext_vector_type(4)))short;
using f32x16=__attribute__((ext_vector_type(16)))float;
using u32x4=__attribute__((ext_vector_type(4)))unsigned;
constexpr int SEQ=4096,D=64,PQ=3584,PO=1024;
constexpr int NW=8,QBLK=32,QB=QBLK*NW,KVBLK=64,NQB=SEQ/QB;
constexpr int ATTN_UNIT_ROWS=QB;
__device__ __forceinline__ int crow(int r,int hi){return (r&3)+8*(r>>2)+4*hi;}
#define SBAR() __builtin_amdgcn_sched_barrier(0)
__device__ __forceinline__ void cmask(f32x16&p0,f32x16&p1,int jb,int qrel,int hi){
  const float NEG=-INFINITY; int kb=64*jb+4*hi;
  #pragma unroll
  for(int r=0;r<16;++r){int kv=kb+(r&3)+8*(r>>2); if(kv>qrel)p0[r]=NEG; if(kv+32>qrel)p1[r]=NEG;}
}

constexpr int NSLOT=3, SLOTB=8192;
constexpr int LDS_K=0, LDS_V=NSLOT*SLOTB, LDS_WS=2*NSLOT*SLOTB, LDS_OST=LDS_WS+NW*64*4, LDS_BYTES=LDS_OST+NW*4096;
constexpr float C2=0.125f*1.4426950408889634f;
__device__ __forceinline__ void glds16(const void*gsrc,unsigned lds_dst){unsigned keep;
  asm volatile("s_mov_b32 %0, m0\n\ts_mov_b32 m0, %2\n\ts_nop 0\n\tglobal_load_lds_dwordx4 %1, off\n\ts_mov_b32 m0, %0":"=&s"(keep):"v"(gsrc),"s"(lds_dst):"memory");}
__device__ __forceinline__ float max3f(float a,float b,float c){float r;asm("v_max3_f32 %0, %1, %2, %3":"=v"(r):"v"(a),"v"(b),"v"(c));return r;}
__device__ __forceinline__ float max2f(float a,float b){float r;asm("v_max_f32_e32 %0, %1, %2":"=v"(r):"v"(a),"v"(b));return r;}
__device__ __forceinline__ float fadd_s(float a,float b){float r;asm("v_add_f32_e32 %0, %1, %2":"=v"(r):"v"(a),"v"(b));return r;}
__device__ __forceinline__ float fsub_s(float a,float b){float r;asm("v_sub_f32_e32 %0, %1, %2":"=v"(r):"v"(a),"v"(b));return r;}
typedef float f32x2_t __attribute__((ext_vector_type(2))); typedef __bf16 bf16x2_t __attribute__((ext_vector_type(2)));
__device__ __forceinline__ unsigned cvtpk_s(float lo,float hi){f32x2_t v={lo,hi};bf16x2_t b=__builtin_convertvector(v,bf16x2_t);return __builtin_bit_cast(unsigned,b);}
#define WAIT_BAR(N) asm volatile("s_waitcnt vmcnt(" #N ") lgkmcnt(0)\n\ts_barrier":::"memory")

__device__ __forceinline__ void qkt(f32x16&p0,f32x16&p1,const char*Kslot,const bf16x8*qr,const f32x16&negm,int r32,int hi){
  const char*kb=Kslot+hi*1024+r32*16;
  #pragma unroll
  for(int d0=0;d0<4;++d0){
    const bf16x8 b0=*reinterpret_cast<const bf16x8*>(kb+d0*2048);
    const bf16x8 b1=*reinterpret_cast<const bf16x8*>(kb+d0*2048+512);
    if(d0==0){p0=__builtin_amdgcn_mfma_f32_32x32x16_bf16(b0,qr[0],negm,0,0,0);p1=__builtin_amdgcn_mfma_f32_32x32x16_bf16(b1,qr[0],negm,0,0,0);}
    else{p0=__builtin_amdgcn_mfma_f32_32x32x16_bf16(b0,qr[d0],p0,0,0,0);p1=__builtin_amdgcn_mfma_f32_32x32x16_bf16(b1,qr[d0],p1,0,0,0);}}
}
typedef __attribute__((address_space(3))) const char* lds_cptr;
typedef short v4i16_t __attribute__((ext_vector_type(4)));
__device__ __forceinline__ void kload8(bf16x8*kf,lds_cptr kp){
  kf[0]=*(const __attribute__((address_space(3))) bf16x8*)(kp);      kf[1]=*(const __attribute__((address_space(3))) bf16x8*)(kp+512);
  kf[2]=*(const __attribute__((address_space(3))) bf16x8*)(kp+2048); kf[3]=*(const __attribute__((address_space(3))) bf16x8*)(kp+2560);
  kf[4]=*(const __attribute__((address_space(3))) bf16x8*)(kp+4096); kf[5]=*(const __attribute__((address_space(3))) bf16x8*)(kp+4608);
  kf[6]=*(const __attribute__((address_space(3))) bf16x8*)(kp+6144); kf[7]=*(const __attribute__((address_space(3))) bf16x8*)(kp+6656);
}
__device__ __forceinline__ void kload2(bf16x8*kf,lds_cptr kp,int j){ kf[2*j]=*(const __attribute__((address_space(3))) bf16x8*)(kp+j*2048); kf[2*j+1]=*(const __attribute__((address_space(3))) bf16x8*)(kp+j*2048+512); }
__device__ __forceinline__ s16x4 vtr(lds_cptr p){ return __builtin_bit_cast(s16x4,__builtin_amdgcn_ds_read_tr16_b64_v4i16((__attribute__((address_space(3))) v4i16_t*)p)); }
__device__ __forceinline__ float rowmax(const f32x16&p0,const f32x16&p1){
  float a=max3f(p0[0],p0[1],p1[0]),b=max3f(p0[2],p0[3],p1[1]);a=max3f(a,p1[2],p1[3]);
  #pragma unroll
  for(int r=4;r<16;r+=4){a=max3f(a,p0[r],p0[r+1]);b=max3f(b,p0[r+2],p0[r+3]);a=max3f(a,p1[r],p1[r+1]);b=max3f(b,p1[r+2],p1[r+3]);}
  const float m=max2f(a,b);
  auto rr=__builtin_amdgcn_permlane32_swap(__float_as_uint(m),__float_as_uint(m),false,false);
  return max2f(__uint_as_float(rr[0]),__uint_as_float(rr[1]));
}
__device__ __forceinline__ void pv(f32x16*o,int vb,bf16x8 pa0,bf16x8 pa1,bf16x8 pa2,bf16x8 pa3){
  #pragma unroll
  for(int d0=0;d0<2;++d0){s16x4 lo[4],hi[4];
    #pragma unroll
    for(int ks=0;ks<4;++ks){
      asm volatile("ds_read_b64_tr_b16 %0,%1 offset:%c2":"=&v"(lo[ks]):"v"(vb),"i"(d0*4096+ks*1024):"memory");
      asm volatile("ds_read_b64_tr_b16 %0,%1 offset:%c2":"=&v"(hi[ks]):"v"(vb),"i"(d0*4096+ks*1024+512):"memory");}
    asm volatile("s_waitcnt lgkmcnt(0)":::"memory");SBAR();
    #define PK(k) (bf16x8){lo[k][0],lo[k][1],lo[k][2],lo[k][3],hi[k][0],hi[k][1],hi[k][2],hi[k][3]}
    o[d0]=__builtin_amdgcn_mfma_f32_32x32x16_bf16(pa0,PK(0),o[d0],0,0,0);
    o[d0]=__builtin_amdgcn_mfma_f32_32x32x16_bf16(pa1,PK(1),o[d0],0,0,0);
    o[d0]=__builtin_amdgcn_mfma_f32_32x32x16_bf16(pa2,PK(2),o[d0],0,0,0);
    o[d0]=__builtin_amdgcn_mfma_f32_32x32x16_bf16(pa3,PK(3),o[d0],0,0,0);
    #undef PK
  }
}

#ifndef ATTN_STORE16
#define ATTN_STORE16(p,v) (*(u32x4*)(p)=(v))
#endif
template<int THRL> __device__ __forceinline__ void attn_unit(int qb,const bf16*Qh,const bf16*__restrict__ Kh,const bf16*__restrict__ Vh,bf16*Oh,char*shm){
  int tid_=threadIdx.x; asm volatile("":"+v"(tid_));
  const int tid=tid_,lane=tid&63,r32=lane&31,hi=lane>>5; const int wid=__builtin_amdgcn_readfirstlane(tid>>6);
  const int q0=qb*QB;
  const bf16*Qw=Qh+(long)(q0+wid*QBLK)*PQ;
  const unsigned lds0=(unsigned)(uintptr_t)shm;
  float*wsf=(float*)(shm+LDS_WS)+wid*64;
  const bf16*ksrc=Kh+(long)lane*PQ+wid*8;
  const bf16*vsrc=Vh+(long)(16*(wid&3)+(lane>>2))*PQ+(wid>>2)*32+(lane&3)*8;
  const unsigned kdst=lds0+LDS_K+wid*1024, vdst=lds0+LDS_V+wid*1024;
  #define DMA_K(t,slot) glds16(ksrc+(long)(t)*KVBLK*PQ,(unsigned)__builtin_amdgcn_readfirstlane(kdst+(slot)))
  #define DMA_V(t,slot) glds16(vsrc+(long)(t)*KVBLK*PQ,(unsigned)__builtin_amdgcn_readfirstlane(vdst+(slot)))
  const int vb0=(int)(lds0+LDS_V)+((lane>>4)&1)*32+(lane&3)*8+(4*hi+((lane&15)>>2))*64;
  const char*Kbase=shm+LDS_K; bf16x8 kf[8];
  const lds_cptr shm3=(lds_cptr)shm; const lds_cptr kp0=shm3+LDS_K+hi*1024+r32*16; const lds_cptr vp0=shm3+LDS_V+((lane>>4)&1)*32+(lane&3)*8+(4*hi+((lane&15)>>2))*64;
  const int NT=(q0+QB)/KVBLK;
  DMA_K(0,0);DMA_V(0,0);DMA_K(1,SLOTB);
  bf16x8 qr[4];
  #pragma unroll
  for(int d0=0;d0<4;++d0)qr[d0]=*reinterpret_cast<const bf16x8*>(&Qw[(long)r32*PQ+d0*16+hi*8]);
  float mhat=0.f,l_reg=0.f;f32x16 o[2];o[0]=f32x16{};o[1]=f32x16{};f32x16 negm=f32x16{};asm volatile("":"+v"(negm));
  const int qrel=wid*QBLK+r32;
  #define CMASK(P0,P1,t) do{int jb_=(t)-(NT-4); if(jb_>=0)cmask(P0,P1,jb_,qrel,hi);}while(0)
  bool resc=false;
  #define START(P0,P1) do{ const float rm=rowmax(P0,P1); resc=false; \
    { const float dl=rm; mhat=fadd_s(mhat,dl); \
      _Pragma("unroll") for(int r=0;r<16;++r){P0[r]=fsub_s(P0[r],dl);P1[r]=fsub_s(P1[r],dl);} \
      _Pragma("unroll") for(int r=0;r<16;++r)negm[r]=-mhat; asm volatile("":"+v"(negm)); } \
    _Pragma("unroll") for(int r=0;r<16;++r)P0[r]=__builtin_amdgcn_exp2f(P0[r]); }while(0)
  #define RESC() do{ if(resc){ asm volatile("s_waitcnt lgkmcnt(0)":::"memory"); \
      _Pragma("unroll") for(int d_=0;d_<2;++d_) _Pragma("unroll") for(int r=0;r<16;++r)o[d_][r]*=wsf[crow(r,hi)]; } }while(0)
  f32x16 pA0,pA1,pB0,pB1;
  int sl_prev=0,sl_cur=0,sl_next=SLOTB;
  #define ROT() do{sl_prev=sl_cur;sl_cur=sl_next;sl_next=(sl_next==(NSLOT-1)*SLOTB)?0:sl_next+SLOTB;}while(0)
  DMA_K(2,2*SLOTB);
  WAIT_BAR(3);
  qkt(pA0,pA1,Kbase,qr,negm,r32,hi);asm volatile("s_nop 15\n\ts_nop 7":"+v"(pA0),"+v"(pA1));CMASK(pA0,pA1,0);
  START(pA0,pA1);
  _Pragma("unroll") for(int r=0;r<16;++r)pA1[r]=__builtin_amdgcn_exp2f(pA1[r]);
  WAIT_BAR(0);
  DMA_K(3,0);DMA_V(1,SLOTB);
  ROT();
  kload8(kf,kp0+sl_cur);
  WAIT_BAR(2);
  s16x4 vlo[8],vhi[8]; u32x4 pw0,pw1,pw2,pw3;
  #define PKW(P,B) cvtpk_s(P[B],P[B+1])
  #define PAF(k) __builtin_bit_cast(bf16x8,pw##k)
  #define VFR(i) (bf16x8){vlo[i][0],vlo[i][1],vlo[i][2],vlo[i][3],vhi[i][0],vhi[i][1],vhi[i][2],vhi[i][3]}
  #define PIN(x) asm volatile("":"+v"(x))
  #define MX3(a,b,c) __builtin_fmaxf(__builtin_fmaxf((a),(b)),(c))
  #define GAPA(MF,A0,A1,A2,A3,W0,W1,PW) do{ MF; sacc+=A0; sacc+=A1; sacc+=A2; sacc+=A3; PIN(sacc); W0; W1; PIN(PW); SBAR(); }while(0)
  #define EX(v) __builtin_amdgcn_exp2f(v)
  #define GAPB(MF,X,B) do{ MF; X[B]=EX(X[B]); X[B+1]=EX(X[B+1]); X[B+2]=EX(X[B+2]); X[B+3]=EX(X[B+3]); PIN(X); SBAR(); }while(0)
  #define VRD(i) do{ vlo[i]=vtr(vp_+(((i)>>2)*4096+((i)&3)*1024)); vhi[i]=vtr(vp_+(((i)>>2)*4096+((i)&3)*1024+512)); }while(0)
  #define KRD(G,j) do{ if(G){ kload2(kf,kp0+sl_next,j); SBAR(); } }while(0)
  #define STEP(C0,C1,P0,P1,t,GK,GV,GL) do{ SBAR(); \
    const lds_cptr vp_=vp0+sl_prev; \
    VRD(0); SBAR(); float sacc=(P0[0]+P0[1]); \
    GAPA(C0=__builtin_amdgcn_mfma_f32_32x32x16_bf16(kf[0],qr[0],negm,0,0,0), P0[2],P0[3],P0[4],P0[5],     pw0[0]=PKW(P0,0), pw0[1]=PKW(P0,2), pw0); \
    VRD(4); SBAR(); GAPA(C1=__builtin_amdgcn_mfma_f32_32x32x16_bf16(kf[1],qr[0],negm,0,0,0), P0[6],P0[7],P0[8],P0[9],     pw0[2]=PKW(P0,4), pw0[3]=PKW(P0,6), pw0); \
    VRD(1); SBAR(); GAPA(C0=__builtin_amdgcn_mfma_f32_32x32x16_bf16(kf[2],qr[1],C0,0,0,0),   P0[10],P0[11],P0[12],P0[13], pw1[0]=PKW(P0,8), pw1[1]=PKW(P0,10), pw1); \
    VRD(5); SBAR(); GAPA(C1=__builtin_amdgcn_mfma_f32_32x32x16_bf16(kf[3],qr[1],C1,0,0,0),   P0[14],P0[15],P1[0],P1[1],   pw1[2]=PKW(P0,12),pw1[3]=PKW(P0,14), pw1); \
    VRD(2); SBAR(); GAPA(C0=__builtin_amdgcn_mfma_f32_32x32x16_bf16(kf[4],qr[2],C0,0,0,0),   P1[2],P1[3],P1[4],P1[5],     pw2[0]=PKW(P1,0), pw2[1]=PKW(P1,2), pw2); \
    VRD(6); SBAR(); GAPA(C1=__builtin_amdgcn_mfma_f32_32x32x16_bf16(kf[5],qr[2],C1,0,0,0),   P1[6],P1[7],P1[8],P1[9],     pw2[2]=PKW(P1,4), pw2[3]=PKW(P1,6), pw2); \
    VRD(3); SBAR(); GAPA(C0=__builtin_amdgcn_mfma_f32_32x32x16_bf16(kf[6],qr[3],C0,0,0,0),   P1[10],P1[11],P1[12],P1[13], pw3[0]=PKW(P1,8), pw3[1]=PKW(P1,10), pw3); \
    VRD(7); SBAR(); GAPA(C1=__builtin_amdgcn_mfma_f32_32x32x16_bf16(kf[7],qr[3],C1,0,0,0),   P1[14],P1[15],0.f,0.f,       pw3[2]=PKW(P1,12),pw3[3]=PKW(P1,14), pw3); \
    l_reg+=sacc; \
    if(GK){DMA_K((t)+3,sl_cur);} if(GV){DMA_V((t)+1,sl_next);} \
    CMASK(C0,C1,t); \
    { float a=MX3(C0[0],C0[1],C1[0]),b=MX3(C0[2],C0[3],C1[1]); a=MX3(a,C1[2],C1[3]); \
      _Pragma("unroll") for(int r=4;r<16;r+=4){a=MX3(a,C0[r],C0[r+1]);b=MX3(b,C0[r+2],C0[r+3]);a=MX3(a,C1[r],C1[r+1]);b=MX3(b,C1[r+2],C1[r+3]);} \
      float rm=__builtin_fmaxf(a,b); { auto rr=__builtin_amdgcn_permlane32_swap(__float_as_uint(rm),__float_as_uint(rm),false,false); rm=__builtin_fmaxf(__uint_as_float(rr[0]),__uint_as_float(rr[1])); } \
      resc=false; \
      if(__builtin_expect(__any(rm>(float)THRL),0)){ const float dl=__builtin_fmaxf(rm,0.f); mhat+=dl; \
        _Pragma("unroll") for(int r=0;r<16;++r){C0[r]-=dl;C1[r]-=dl;} \
        _Pragma("unroll") for(int r=0;r<16;++r)negm[r]=-mhat; asm volatile("":"+v"(negm)); \
        const float f=__builtin_amdgcn_exp2f(-dl); l_reg*=f; if(hi==0)wsf[r32]=f; resc=true; } } \
    SBAR(); \
    GAPB(o[0]=__builtin_amdgcn_mfma_f32_32x32x16_bf16(PAF(0),VFR(0),o[0],0,0,0), C0,0); \
    GAPB(o[1]=__builtin_amdgcn_mfma_f32_32x32x16_bf16(PAF(0),VFR(4),o[1],0,0,0), C0,4); \
    KRD(GL,0); GAPB(o[0]=__builtin_amdgcn_mfma_f32_32x32x16_bf16(PAF(1),VFR(1),o[0],0,0,0), C0,8); \
    KRD(GL,1); GAPB(o[1]=__builtin_amdgcn_mfma_f32_32x32x16_bf16(PAF(1),VFR(5),o[1],0,0,0), C0,12); \
    KRD(GL,2); GAPB(o[0]=__builtin_amdgcn_mfma_f32_32x32x16_bf16(PAF(2),VFR(2),o[0],0,0,0), C1,0); \
    KRD(GL,3); GAPB(o[1]=__builtin_amdgcn_mfma_f32_32x32x16_bf16(PAF(2),VFR(6),o[1],0,0,0), C1,4); \
    GAPB(o[0]=__builtin_amdgcn_mfma_f32_32x32x16_bf16(PAF(3),VFR(3),o[0],0,0,0), C1,8); \
    GAPB(o[1]=__builtin_amdgcn_mfma_f32_32x32x16_bf16(PAF(3),VFR(7),o[1],0,0,0), C1,12); \
    }while(0)
  int t=1;
  #undef CMASK
  #define CMASK(P0,P1,t) do{}while(0)
  for(;t+5<NT;t+=2){
    STEP(pB0,pB1,pA0,pA1,t,true,true,true);     WAIT_BAR(2); RESC(); ROT();
    STEP(pA0,pA1,pB0,pB1,t+1,true,true,true);   WAIT_BAR(2); RESC(); ROT();
  }
  #undef CMASK
  #define CMASK(P0,P1,t) do{int jb_=(t)-(NT-4); if(jb_>=0)cmask(P0,P1,jb_,qrel,hi);}while(0)
  #define ENDW(tt) do{ if((tt)+3<NT){WAIT_BAR(2);} else if((tt)+2<NT){WAIT_BAR(1);} else {WAIT_BAR(0);} }while(0)
  for(;t+1<NT;t+=2){
    STEP(pB0,pB1,pA0,pA1,t,(t+3<NT),(t+1<NT),(t+1<NT));       ENDW(t);   RESC(); ROT();
    STEP(pA0,pA1,pB0,pB1,t+1,(t+4<NT),(t+2<NT),(t+2<NT));     ENDW(t+1); RESC(); ROT();
  }
  STEP(pB0,pB1,pA0,pA1,NT-1,false,false,false); RESC();
  { float sacc=pB0[0]+pB0[1]; _Pragma("unroll") for(int r=2;r<16;++r)sacc+=pB0[r]; _Pragma("unroll") for(int r=0;r<16;++r)sacc+=pB1[r]; l_reg+=sacc;
    pw0=(u32x4){PKW(pB0,0),PKW(pB0,2),PKW(pB0,4),PKW(pB0,6)};pw1=(u32x4){PKW(pB0,8),PKW(pB0,10),PKW(pB0,12),PKW(pB0,14)};pw2=(u32x4){PKW(pB1,0),PKW(pB1,2),PKW(pB1,4),PKW(pB1,6)};pw3=(u32x4){PKW(pB1,8),PKW(pB1,10),PKW(pB1,12),PKW(pB1,14)};
    SBAR(); pv(o,vb0+sl_cur,PAF(0),PAF(1),PAF(2),PAF(3)); }
  #undef PKW
  #undef PAF
  #undef VFR
  #undef PIN
  #undef MX3
  #undef GAPA
  #undef GAPB
  #undef EX
  #undef VRD
  #undef KRD
  #undef STEP
  #undef ENDW
  {auto rr=__builtin_amdgcn_permlane32_swap(__float_as_uint(l_reg),__float_as_uint(l_reg),false,false);l_reg=__uint_as_float(rr[0])+__uint_as_float(rr[1]);}
  if(hi==0)wsf[32+r32]=l_reg;asm volatile("s_waitcnt lgkmcnt(0)":::"memory");
  float rli[16];
  #pragma unroll
  for(int r=0;r<16;++r)rli[r]=__builtin_amdgcn_rcpf(wsf[32+crow(r,hi)]);
  bf16*Ow=Oh+(long)(q0+wid*QBLK)*PO;
  { bf16*stg=(bf16*)(shm+LDS_OST)+wid*2048;
    #pragma unroll
    for(int r=0;r<16;++r){const int orow=crow(r,hi);
      #pragma unroll
      for(int d0=0;d0<2;++d0)stg[orow*64+d0*32+r32]=__float2bfloat16(o[d0][r]*rli[r]);}
    asm volatile("s_waitcnt lgkmcnt(0)":::"memory");
    #pragma unroll
    for(int i=0;i<4;++i){const int row=i*8+(lane>>3),ch=lane&7; const u32x4 v=*(const u32x4*)(stg+row*64+ch*8); ATTN_STORE16(Ow+(long)row*PO+ch*8,v);} }
  asm volatile("s_waitcnt lgkmcnt(0)\n\ts_barrier":::"memory");
  #undef DMA_K
  #undef DMA_V
  #undef CMASK
  #undef START
  #undef RESC
  #undef ROT
}
constexpr int ATTN_LDS_BYTES=LDS_BYTES;
#undef SBAR
#undef WAIT_BAR
}
namespace attn128 {
using bf16=__hip_bfloat16;
using bf16x8=__attribute__((ext_vector_type(8)))short;
using s16x4=__attribute__((ext_vector_type(4)))short;
using f32x16=__attribute__((ext_vector_type(16)))float;
using u32x4=__attribute__((ext_vector_type(4)))unsigned;
constexpr int SEQ=4096,D=64,PQ=3584,PO=1024;
constexpr int NW=8,QBLK=32,QB=QBLK*NW,KVBLK=64,NQB=SEQ/QB;
constexpr int ATTN_UNIT_ROWS=QB;
__device__ __forceinline__ int crow(int r,int hi){return (r&3)+8*(r>>2)+4*hi;}
#define SBAR() __builtin_amdgcn_sched_barrier(0)
__device__ __forceinline__ void cmask(f32x16&p0,f32x16&p1,int jb,int qrel,int hi){
  const float NEG=-INFINITY; int kb=64*jb+4*hi;
  #pragma unroll
  for(int r=0;r<16;++r){int kv=kb+(r&3)+8*(r>>2); if(kv>qrel)p0[r]=NEG; if(kv+32>qrel)p1[r]=NEG;}
}

constexpr int NSLOT=3, SLOTB=8192;
constexpr int LDS_K=0, LDS_V=NSLOT*SLOTB, LDS_WS=LDS_V+NSLOT*2*SLOTB, LDS_OST=LDS_WS+NW*64*4, LDS_BYTES=LDS_OST+NW*4096;
constexpr float C2=0.125f*1.4426950408889634f;
__device__ __forceinline__ void glds16(const void*gsrc,unsigned lds_dst){unsigned keep;
  asm volatile("s_mov_b32 %0, m0\n\ts_mov_b32 m0, %2\n\ts_nop 0\n\tglobal_load_lds_dwordx4 %1, off\n\ts_mov_b32 m0, %0":"=&s"(keep):"v"(gsrc),"s"(lds_dst):"memory");}
__device__ __forceinline__ float max3f(float a,float b,float c){float r;asm("v_max3_f32 %0, %1, %2, %3":"=v"(r):"v"(a),"v"(b),"v"(c));return r;}
__device__ __forceinline__ float max2f(float a,float b){float r;asm("v_max_f32_e32 %0, %1, %2":"=v"(r):"v"(a),"v"(b));return r;}
__device__ __forceinline__ float fadd_s(float a,float b){float r;asm("v_add_f32_e32 %0, %1, %2":"=v"(r):"v"(a),"v"(b));return r;}
__device__ __forceinline__ float fsub_s(float a,float b){float r;asm("v_sub_f32_e32 %0, %1, %2":"=v"(r):"v"(a),"v"(b));return r;}
typedef float f32x2_t __attribute__((ext_vector_type(2))); typedef __bf16 bf16x2_t __attribute__((ext_vector_type(2)));
__device__ __forceinline__ unsigned cvtpk_s(float lo,float hi){f32x2_t v={lo,hi};bf16x2_t b=__builtin_convertvector(v,bf16x2_t);return __builtin_bit_cast(unsigned,b);}
#define WAIT_BAR(N) asm volatile("s_waitcnt vmcnt(" #N ") lgkmcnt(0)\n\ts_barrier":::"memory")

__device__ __forceinline__ void qkt(f32x16&p0,f32x16&p1,const char*Kslot,const bf16x8*qr,int r32,int hi){ const f32x16 negm=f32x16{};
  const char*kb=Kslot+hi*1024+r32*16;
  #pragma unroll
  for(int d0=0;d0<4;++d0){
    const bf16x8 b0=*reinterpret_cast<const bf16x8*>(kb+d0*2048);
    const bf16x8 b1=*reinterpret_cast<const bf16x8*>(kb+d0*2048+512);
    if(d0==0){p0=__builtin_amdgcn_mfma_f32_32x32x16_bf16(b0,qr[0],negm,0,0,0);p1=__builtin_amdgcn_mfma_f32_32x32x16_bf16(b1,qr[0],negm,0,0,0);}
    else{p0=__builtin_amdgcn_mfma_f32_32x32x16_bf16(b0,qr[d0],p0,0,0,0);p1=__builtin_amdgcn_mfma_f32_32x32x16_bf16(b1,qr[d0],p1,0,0,0);}}
}
typedef __attribute__((address_space(3))) const char* lds_cptr;
typedef short v4i16_t __attribute__((ext_vector_type(4)));
__device__ __forceinline__ void kload8(bf16x8*kf,lds_cptr kp){
  kf[0]=*(const __attribute__((address_space(3))) bf16x8*)(kp);      kf[1]=*(const __attribute__((address_space(3))) bf16x8*)(kp+512);
  kf[2]=*(const __attribute__((address_space(3))) bf16x8*)(kp+2048); kf[3]=*(const __attribute__((address_space(3))) bf16x8*)(kp+2560);
  kf[4]=*(const __attribute__((address_space(3))) bf16x8*)(kp+4096); kf[5]=*(const __attribute__((address_space(3))) bf16x8*)(kp+4608);
  kf[6]=*(const __attribute__((address_space(3))) bf16x8*)(kp+6144); kf[7]=*(const __attribute__((address_space(3))) bf16x8*)(kp+6656);
}
__device__ __forceinline__ void kload2(bf16x8*kf,lds_cptr kp,int j){ kf[2*j]=*(const __attribute__((address_space(3))) bf16x8*)(kp+j*2048); kf[2*j+1]=*(const __attribute__((address_space(3))) bf16x8*)(kp+j*2048+512); }
__device__ __forceinline__ s16x4 vtr(lds_cptr p){ return __builtin_bit_cast(s16x4,__builtin_amdgcn_ds_read_tr16_b64_v4i16((__attribute__((address_space(3))) v4i16_t*)p)); }
__device__ __forceinline__ float rowmax(const f32x16&p0,const f32x16&p1){
  float a=max3f(p0[0],p0[1],p1[0]),b=max3f(p0[2],p0[3],p1[1]);a=max3f(a,p1[2],p1[3]);
  #pragma unroll
  for(int r=4;r<16;r+=4){a=max3f(a,p0[r],p0[r+1]);b=max3f(b,p0[r+2],p0[r+3]);a=max3f(a,p1[r],p1[r+1]);b=max3f(b,p1[r+2],p1[r+3]);}
  const float m=max2f(a,b);
  auto rr=__builtin_amdgcn_permlane32_swap(__float_as_uint(m),__float_as_uint(m),false,false);
  return max2f(__uint_as_float(rr[0]),__uint_as_float(rr[1]));
}
__device__ __forceinline__ void pv(f32x16*o,int vb,bf16x8 pa0,bf16x8 pa1,bf16x8 pa2,bf16x8 pa3){
  #pragma unroll
  for(int d0=0;d0<4;++d0){s16x4 lo[4],hi[4];
    #pragma unroll
    for(int ks=0;ks<4;++ks){
      asm volatile("ds_read_b64_tr_b16 %0,%1 offset:%c2":"=&v"(lo[ks]):"v"(vb),"i"(d0*4096+ks*1024):"memory");
      asm volatile("ds_read_b64_tr_b16 %0,%1 offset:%c2":"=&v"(hi[ks]):"v"(vb),"i"(d0*4096+ks*1024+512):"memory");}
    asm volatile("s_waitcnt lgkmcnt(0)":::"memory");SBAR();
    #define PK(k) (bf16x8){lo[k][0],lo[k][1],lo[k][2],lo[k][3],hi[k][0],hi[k][1],hi[k][2],hi[k][3]}
    o[d0]=__builtin_amdgcn_mfma_f32_32x32x16_bf16(pa0,PK(0),o[d0],0,0,0);
    o[d0]=__builtin_amdgcn_mfma_f32_32x32x16_bf16(pa1,PK(1),o[d0],0,0,0);
    o[d0]=__builtin_amdgcn_mfma_f32_32x32x16_bf16(pa2,PK(2),o[d0],0,0,0);
    o[d0]=__builtin_amdgcn_mfma_f32_32x32x16_bf16(pa3,PK(3),o[d0],0,0,0);
    #undef PK
  }
}

#if 0
#define ATTN_STORE16(p,v) (*(u32x4*)(p)=(v))
#endif
template<int THRL> __device__ __forceinline__ void attn_unit(int qb,const bf16*Qh,const bf16*__restrict__ Kh,const bf16*__restrict__ Vh,bf16*Oh,char*shm){
  int tid_=threadIdx.x; asm volatile("":"+v"(tid_));
  const int tid=tid_,lane=tid&63,r32=lane&31,hi=lane>>5; const int wid=__builtin_amdgcn_readfirstlane(tid>>6);
  const int q0=qb*QB;
  const bf16*Qw=Qh+(long)(q0+wid*QBLK)*PQ;
  const unsigned lds0=(unsigned)(uintptr_t)shm;
  float*wsf=(float*)(shm+LDS_WS)+wid*64;
  const bf16*ksrc=Kh+(long)lane*PQ+wid*8;
  const bf16*vsrc=Vh+(long)(16*(wid&3)+(lane>>2))*PQ+(wid>>2)*32+(lane&3)*8;
  const unsigned kdst=lds0+LDS_K+wid*1024, vdst=lds0+LDS_V+wid*1024;
  #define DMA_K(t,slot) glds16(ksrc+(long)(t)*KVBLK*PQ,(unsigned)__builtin_amdgcn_readfirstlane(kdst+(slot)))
  #define DMA_V(t,slot) do{ glds16(vsrc+(long)(t)*KVBLK*PQ,(unsigned)__builtin_amdgcn_readfirstlane(vdst+2*(slot))); glds16(vsrc+64+(long)(t)*KVBLK*PQ,(unsigned)__builtin_amdgcn_readfirstlane(vdst+2*(slot)+8192)); }while(0)
  const int vb0=(int)(lds0+LDS_V)+((lane>>4)&1)*32+(lane&3)*8+(4*hi+((lane&15)>>2))*64;
  const char*Kbase=shm+LDS_K; bf16x8 kf[8];
  const lds_cptr shm3=(lds_cptr)shm; const lds_cptr kp0=shm3+LDS_K+hi*1024+r32*16; const lds_cptr vp0=shm3+LDS_V+((lane>>4)&1)*32+(lane&3)*8+(4*hi+((lane&15)>>2))*64;
  const int NT=(q0+QB)/KVBLK;
  DMA_K(0,0);DMA_V(0,0);DMA_K(1,SLOTB);
  bf16x8 qr[4];
  #pragma unroll
  for(int d0=0;d0<4;++d0)qr[d0]=*reinterpret_cast<const bf16x8*>(&Qw[(long)r32*PQ+d0*16+hi*8]);
  { bf16x8* qst=(bf16x8*)(shm+LDS_OST+wid*4096);
    #pragma unroll
    for(int d0=0;d0<4;++d0)qst[(d0*2+hi)*32+r32]=qr[d0]; }
  const lds_cptr qp0=shm3+LDS_OST+wid*4096+(hi*32+r32)*16;
  #define QLD(d0) (*(const __attribute__((address_space(3))) bf16x8*)(qp0+(d0)*1024))
  float mhat=0.f,l_reg=0.f;f32x16 o[4];o[0]=f32x16{};o[1]=f32x16{};o[2]=f32x16{};o[3]=f32x16{};
  const int qrel=wid*QBLK+r32;
  #define CMASK(P0,P1,t) do{int jb_=(t)-(NT-4); if(jb_>=0)cmask(P0,P1,jb_,qrel,hi);}while(0)
  bool resc=false;
  #define START(P0,P1) do{ const float rm=rowmax(P0,P1); resc=false; \
    { const float dl=rm; mhat=fadd_s(mhat,dl); \
      _Pragma("unroll") for(int r=0;r<16;++r){P0[r]=fsub_s(P0[r],dl);P1[r]=fsub_s(P1[r],dl);} \
      } \
    _Pragma("unroll") for(int r=0;r<16;++r)P0[r]=__builtin_amdgcn_exp2f(P0[r]); }while(0)
  #define RESC() do{ if(resc){ asm volatile("s_waitcnt lgkmcnt(0)":::"memory"); \
      _Pragma("unroll") for(int d_=0;d_<4;++d_) _Pragma("unroll") for(int r=0;r<16;++r)o[d_][r]*=wsf[crow(r,hi)]; } }while(0)
  f32x16 pA0,pA1,pB0,pB1;
  int sl_prev=0,sl_cur=0,sl_next=SLOTB;
  #define ROT() do{sl_prev=sl_cur;sl_cur=sl_next;sl_next=(sl_next==(NSLOT-1)*SLOTB)?0:sl_next+SLOTB;}while(0)
  DMA_K(2,2*SLOTB);
  WAIT_BAR(4);
  qkt(pA0,pA1,Kbase,qr,r32,hi);asm volatile("s_nop 15\n\ts_nop 7":"+v"(pA0),"+v"(pA1));CMASK(pA0,pA1,0);
  START(pA0,pA1);
  _Pragma("unroll") for(int r=0;r<16;++r)pA1[r]=__builtin_amdgcn_exp2f(pA1[r]);
  WAIT_BAR(0);
  DMA_K(3,0);DMA_V(1,SLOTB);
  ROT();
  kload8(kf,kp0+sl_cur);
  WAIT_BAR(3);
  s16x4 vlo[8],vhi[8]; u32x4 pw0,pw1,pw2,pw3;
  #define PKW(P,B) cvtpk_s(P[B],P[B+1])
  #define PAF(k) __builtin_bit_cast(bf16x8,pw##k)
  #define VFR(i) (bf16x8){vlo[i][0],vlo[i][1],vlo[i][2],vlo[i][3],vhi[i][0],vhi[i][1],vhi[i][2],vhi[i][3]}
  #define PIN(x) asm volatile("":"+v"(x))
  #define MX3(a,b,c) __builtin_fmaxf(__builtin_fmaxf((a),(b)),(c))
  #define GAPA(MF,A0,A1,A2,A3,W0,W1,PW) do{ MF; sacc+=A0; sacc+=A1; sacc+=A2; sacc+=A3; PIN(sacc); W0; W1; PIN(PW); SBAR(); }while(0)
  #define EX(v) __builtin_amdgcn_exp2f(v)
  #define GAPB(MF,X,B) do{ MF; X[B]=X[B]-mhat; X[B+1]=X[B+1]-mhat; PIN(X); X[B]=EX(X[B]); X[B+1]=EX(X[B+1]); PIN(X); SBAR(); }while(0)
  #define VRD2(i) do{ vlo[i]=vtr(vp_+((((i)>>2)+2)*4096+((i)&3)*1024)); vhi[i]=vtr(vp_+((((i)>>2)+2)*4096+((i)&3)*1024+512)); SBAR(); }while(0)
  #define VRD(i) do{ vlo[i]=vtr(vp_+(((i)>>2)*4096+((i)&3)*1024)); vhi[i]=vtr(vp_+(((i)>>2)*4096+((i)&3)*1024+512)); }while(0)
  #define KRD(G,j) do{ if(G){ kload2(kf,kp0+sl_next,j); SBAR(); } }while(0)
  #define STEP(C0,C1,P0,P1,t,GK,GV,GL) do{ SBAR(); const f32x16 zero16=f32x16{}; const bf16x8 ql0=QLD(0),ql1=QLD(1),ql2=QLD(2),ql3=QLD(3); \
    const lds_cptr vp_=vp0+2*sl_prev; \
    VRD(0); SBAR(); float sacc=(P0[0]+P0[1]); \
    GAPA(C0=__builtin_amdgcn_mfma_f32_32x32x16_bf16(kf[0],ql0,zero16,0,0,0), P0[2],P0[3],P0[4],P0[5],     pw0[0]=PKW(P0,0), pw0[1]=PKW(P0,2), pw0); \
    VRD(4); SBAR(); GAPA(C1=__builtin_amdgcn_mfma_f32_32x32x16_bf16(kf[1],ql0,zero16,0,0,0), P0[6],P0[7],P0[8],P0[9],     pw0[2]=PKW(P0,4), pw0[3]=PKW(P0,6), pw0); \
    VRD(1); SBAR(); GAPA(C0=__builtin_amdgcn_mfma_f32_32x32x16_bf16(kf[2],ql1,C0,0,0,0),   P0[10],P0[11],P0[12],P0[13], pw1[0]=PKW(P0,8), pw1[1]=PKW(P0,10), pw1); \
    VRD(5); SBAR(); GAPA(C1=__builtin_amdgcn_mfma_f32_32x32x16_bf16(kf[3],ql1,C1,0,0,0),   P0[14],P0[15],P1[0],P1[1],   pw1[2]=PKW(P0,12),pw1[3]=PKW(P0,14), pw1); \
    VRD(2); SBAR(); GAPA(C0=__builtin_amdgcn_mfma_f32_32x32x16_bf16(kf[4],ql2,C0,0,0,0),   P1[2],P1[3],P1[4],P1[5],     pw2[0]=PKW(P1,0), pw2[1]=PKW(P1,2), pw2); \
    VRD(6); SBAR(); GAPA(C1=__builtin_amdgcn_mfma_f32_32x32x16_bf16(kf[5],ql2,C1,0,0,0),   P1[6],P1[7],P1[8],P1[9],     pw2[2]=PKW(P1,4), pw2[3]=PKW(P1,6), pw2); \
    VRD(3); SBAR(); GAPA(C0=__builtin_amdgcn_mfma_f32_32x32x16_bf16(kf[6],ql3,C0,0,0,0),   P1[10],P1[11],P1[12],P1[13], pw3[0]=PKW(P1,8), pw3[1]=PKW(P1,10), pw3); \
    VRD(7); SBAR(); GAPA(C1=__builtin_amdgcn_mfma_f32_32x32x16_bf16(kf[7],ql3,C1,0,0,0),   P1[14],P1[15],0.f,0.f,       pw3[2]=PKW(P1,12),pw3[3]=PKW(P1,14), pw3); \
    l_reg+=sacc; \
    if(GK){DMA_K((t)+3,sl_cur);} if(GV){DMA_V((t)+1,sl_next);} \
    CMASK(C0,C1,t); \
    { float a=MX3(C0[0],C0[1],C1[0]),b=MX3(C0[2],C0[3],C1[1]); a=MX3(a,C1[2],C1[3]); \
      _Pragma("unroll") for(int r=4;r<16;r+=4){a=MX3(a,C0[r],C0[r+1]);b=MX3(b,C0[r+2],C0[r+3]);a=MX3(a,C1[r],C1[r+1]);b=MX3(b,C1[r+2],C1[r+3]);} \
      float rm=__builtin_fmaxf(a,b); { auto rr=__builtin_amdgcn_permlane32_swap(__float_as_uint(rm),__float_as_uint(rm),false,false); rm=__builtin_fmaxf(__uint_as_float(rr[0]),__uint_as_float(rr[1])); } \
      resc=false; \
      rm-=mhat; \
      if(__builtin_expect(__any(rm>(float)THRL),0)){ const float dl=__builtin_fmaxf(rm,0.f); mhat+=dl; \
        const float f=__builtin_amdgcn_exp2f(-dl); l_reg*=f; if(hi==0)wsf[r32]=f; resc=true; } } \
    SBAR(); \
    GAPB(o[0]=__builtin_amdgcn_mfma_f32_32x32x16_bf16(PAF(0),VFR(0),o[0],0,0,0), C0,0); VRD2(0); \
    GAPB(o[1]=__builtin_amdgcn_mfma_f32_32x32x16_bf16(PAF(0),VFR(4),o[1],0,0,0), C0,2); VRD2(4); \
    KRD(GL,0); GAPB(o[0]=__builtin_amdgcn_mfma_f32_32x32x16_bf16(PAF(1),VFR(1),o[0],0,0,0), C0,4); VRD2(1); \
    KRD(GL,1); GAPB(o[1]=__builtin_amdgcn_mfma_f32_32x32x16_bf16(PAF(1),VFR(5),o[1],0,0,0), C0,6); VRD2(5); \
    KRD(GL,2); GAPB(o[0]=__builtin_amdgcn_mfma_f32_32x32x16_bf16(PAF(2),VFR(2),o[0],0,0,0), C0,8); VRD2(2); \
    KRD(GL,3); GAPB(o[1]=__builtin_amdgcn_mfma_f32_32x32x16_bf16(PAF(2),VFR(6),o[1],0,0,0), C0,10); VRD2(6); \
    GAPB(o[0]=__builtin_amdgcn_mfma_f32_32x32x16_bf16(PAF(3),VFR(3),o[0],0,0,0), C0,12); VRD2(3); \
    GAPB(o[1]=__builtin_amdgcn_mfma_f32_32x32x16_bf16(PAF(3),VFR(7),o[1],0,0,0), C0,14); VRD2(7); \
    GAPB(o[2]=__builtin_amdgcn_mfma_f32_32x32x16_bf16(PAF(0),VFR(0),o[2],0,0,0), C1,0); \
    GAPB(o[3]=__builtin_amdgcn_mfma_f32_32x32x16_bf16(PAF(0),VFR(4),o[3],0,0,0), C1,2); \
    GAPB(o[2]=__builtin_amdgcn_mfma_f32_32x32x16_bf16(PAF(1),VFR(1),o[2],0,0,0), C1,4); \
    GAPB(o[3]=__builtin_amdgcn_mfma_f32_32x32x16_bf16(PAF(1),VFR(5),o[3],0,0,0), C1,6); \
    GAPB(o[2]=__builtin_amdgcn_mfma_f32_32x32x16_bf16(PAF(2),VFR(2),o[2],0,0,0), C1,8); \
    GAPB(o[3]=__builtin_amdgcn_mfma_f32_32x32x16_bf16(PAF(2),VFR(6),o[3],0,0,0), C1,10); \
    GAPB(o[2]=__builtin_amdgcn_mfma_f32_32x32x16_bf16(PAF(3),VFR(3),o[2],0,0,0), C1,12); \
    GAPB(o[3]=__builtin_amdgcn_mfma_f32_32x32x16_bf16(PAF(3),VFR(7),o[3],0,0,0), C1,14); \
    }while(0)
  int t=1;
  #undef CMASK
  #define CMASK(P0,P1,t) do{}while(0)
  for(;t+5<NT;t+=2){
    STEP(pB0,pB1,pA0,pA1,t,true,true,true);     WAIT_BAR(3); RESC(); ROT();
    STEP(pA0,pA1,pB0,pB1,t+1,true,true,true);   WAIT_BAR(3); RESC(); ROT();
  }
  #undef CMASK
  #define CMASK(P0,P1,t) do{int jb_=(t)-(NT-4); if(jb_>=0)cmask(P0,P1,jb_,qrel,hi);}while(0)
  #define ENDW(tt) do{ if((tt)+3<NT){WAIT_BAR(3);} else if((tt)+2<NT){WAIT_BAR(2);} else {WAIT_BAR(0);} }while(0)
  for(;t+1<NT;t+=2){
    STEP(pB0,pB1,pA0,pA1,t,(t+3<NT),(t+1<NT),(t+1<NT));       ENDW(t);   RESC(); ROT();
    STEP(pA0,pA1,pB0,pB1,t+1,(t+4<NT),(t+2<NT),(t+2<NT));     ENDW(t+1); RESC(); ROT();
  }
  STEP(pB0,pB1,pA0,pA1,NT-1,false,false,false); RESC();
  { float sacc=pB0[0]+pB0[1]; _Pragma("unroll") for(int r=2;r<16;++r)sacc+=pB0[r]; _Pragma("unroll") for(int r=0;r<16;++r)sacc+=pB1[r]; l_reg+=sacc;
    pw0=(u32x4){PKW(pB0,0),PKW(pB0,2),PKW(pB0,4),PKW(pB0,6)};pw1=(u32x4){PKW(pB0,8),PKW(pB0,10),PKW(pB0,12),PKW(pB0,14)};pw2=(u32x4){PKW(pB1,0),PKW(pB1,2),PKW(pB1,4),PKW(pB1,6)};pw3=(u32x4){PKW(pB1,8),PKW(pB1,10),PKW(pB1,12),PKW(pB1,14)};
    SBAR(); pv(o,vb0+2*sl_cur,PAF(0),PAF(1),PAF(2),PAF(3)); }
  #undef PKW
  #undef PAF
  #undef VFR
  #undef PIN
  #undef MX3
  #undef GAPA
  #undef GAPB
  #undef EX
  #undef VRD
  #undef VRD2
  #undef KRD
  #undef STEP
  #undef ENDW
  {auto rr=__builtin_amdgcn_permlane32_swap(__float_as_uint(l_reg),__float_as_uint(l_reg),false,false);l_reg=__uint_as_float(rr[0])+__uint_as_float(rr[1]);}
  if(hi==0)wsf[32+r32]=l_reg;asm volatile("s_waitcnt lgkmcnt(0)":::"memory");
  float rli[16];
  #pragma unroll
  for(int r=0;r<16;++r)rli[r]=__builtin_amdgcn_rcpf(wsf[32+crow(r,hi)]);
  bf16*Ow=Oh+(long)(q0+wid*QBLK)*PO;
  { bf16*stg=(bf16*)(shm+LDS_OST)+wid*2048;
    #pragma unroll
    for(int hf=0;hf<2;++hf){
    #pragma unroll
    for(int r=0;r<16;++r){const int orow=crow(r,hi);
      #pragma unroll
      for(int d0=0;d0<2;++d0)stg[orow*64+d0*32+r32]=__float2bfloat16(o[2*hf+d0][r]*rli[r]);}
    asm volatile("s_waitcnt lgkmcnt(0)":::"memory");
    #pragma unroll
    for(int i=0;i<4;++i){const int row=i*8+(lane>>3),ch=lane&7; const u32x4 v=*(const u32x4*)(stg+row*64+ch*8); ATTN_STORE16(Ow+(long)row*PO+hf*64+ch*8,v);}
    asm volatile("s_waitcnt lgkmcnt(0)":::"memory"); } }
  asm volatile("s_waitcnt lgkmcnt(0)\n\ts_barrier":::"memory");
  #undef DMA_K
  #undef QLD
  #undef DMA_V
  #undef CMASK
  #undef START
  #undef RESC
  #undef ROT
}
constexpr int ATTN_LDS_BYTES=LDS_BYTES;
#undef SBAR
#undef WAIT_BAR
}
#define ST8(ptr, w) do { *(ptr) = (w); asm volatile("s_nop 1" :: "v"((w).x), "v"((w).y) : "memory"); } while (0)
#define ST4(ptr, w) do { *(ptr) = (w); asm volatile("s_nop 1" :: "v"(w) : "memory"); } while (0)
constexpr int NWAVES = 8;
constexpr int RING_OFF = 0, RING_BYTES = 131072;
constexpr int LDSCTL_OFF = RING_BYTES, MISC_OFF = LDSCTL_OFF;
constexpr int TAB_OFF = LDSCTL_OFF + 512;
constexpr int EB_OFF = LDSCTL_OFF + 2048;
constexpr int LCNT_OFF = LDSCTL_OFF + 2304;
constexpr int LDS_BYTES = 147456;
constexpr int CW_BAR = 4096;
constexpr int NPHASE = 18;

#define XB_TMO      128
#define XB_XCNT(j)  (256  + 64 * (j))
#define XB_XSUB(j)  (1280 + 64 * (j))
#define XB_XGEN(j)  (2304 + 64 * (j))
#define XB_TOP      3328
#define XB_TOPGEN   3392
#define XCD_BAR_WORDS 3456
#define XB_SPIN_CAP (1u << 18)

__device__ __forceinline__ unsigned xb_ld(unsigned* p)              { return __hip_atomic_load(p, __ATOMIC_RELAXED, __HIP_MEMORY_SCOPE_AGENT); }
__device__ __forceinline__ unsigned xb_add(unsigned* p, unsigned v) { return __hip_atomic_fetch_add(p, v, __ATOMIC_RELAXED, __HIP_MEMORY_SCOPE_AGENT); }
__device__ __forceinline__ unsigned xb_xcc_id() { return (unsigned)__builtin_amdgcn_s_getreg((3 << 11) | 20) & 0xFu; }
#define XB_SPIN(cond, bar) do { unsigned _sp = 0; while (cond) { __builtin_amdgcn_s_sleep(1); \
    if ((++_sp & 255u) == 0u) { if (xb_ld(&(bar)[XB_TMO])) break; if (_sp > XB_SPIN_CAP) { atomicAdd(&(bar)[XB_TMO], 1u); break; } } } } while (0)

struct XcdBarrier {
    unsigned* bar; unsigned x;
    volatile LAS unsigned* st;
};

__device__ __forceinline__ XcdBarrier xcd_barrier_post(unsigned* bar, volatile LAS unsigned* st) {
    XcdBarrier b; b.bar = bar; b.x = xb_xcc_id(); b.st = st;
    if (threadIdx.x == 0) (void)xb_add(&bar[XB_XCNT(b.x)], 1u);
    return b;
}
__device__ __forceinline__ void xcd_barrier_complete(unsigned* bar, unsigned x, unsigned& nloc, unsigned& nx) {
    const unsigned G = gridDim.x * gridDim.y * gridDim.z;
    unsigned sum, cnt, mine, sp = 0u;
    for (;;) {
        sum = 0u; cnt = 0u; mine = 0u;
#pragma unroll
        for (unsigned j = 0; j < 16; ++j) { const unsigned c = xb_ld(&bar[XB_XCNT(j)]); sum += c; cnt += (c > 0u) ? 1u : 0u; mine = (j == x) ? c : mine; }
        if (sum == G) break;
        __builtin_amdgcn_s_sleep(1);
        if ((++sp & 255u) == 0u) { if (xb_ld(&bar[XB_TMO])) break; if (sp > XB_SPIN_CAP) { atomicAdd(&bar[XB_TMO], 1u); break; } }
    }
    nloc = mine > 0u ? mine : 1u; nx = cnt > 0u ? cnt : 1u;
}

__device__ __forceinline__ void xcd_barrier(const XcdBarrier& b) {
    asm volatile("s_waitcnt vmcnt(0)" ::: "memory");
    __syncthreads();
    if (threadIdx.x == 0) {
        unsigned* bar = b.bar;
        __builtin_amdgcn_s_waitcnt(0);
        unsigned nloc = b.st[0], nx = b.st[1];
        if (nloc == 0u) { xcd_barrier_complete(bar, b.x, nloc, nx); b.st[0] = nloc; b.st[1] = nx; }
        const unsigned old = xb_add(&bar[XB_XSUB(b.x)], 1u);
        const unsigned gen = old / nloc;
        if (old + 1u == (gen + 1u) * nloc) {
            __builtin_amdgcn_fence(__ATOMIC_RELEASE, "agent");
            asm volatile("s_waitcnt vmcnt(0)" ::: "memory");
            const unsigned og = xb_add(&bar[XB_TOP], 1u);
            const unsigned tg = og / nx;
            if (og + 1u == (tg + 1u) * nx) xb_add(&bar[XB_TOPGEN], 1u);
            else XB_SPIN(xb_ld(&bar[XB_TOPGEN]) == tg, bar);
            __builtin_amdgcn_fence(__ATOMIC_ACQUIRE, "agent");
            xb_add(&bar[XB_XGEN(b.x)], 1u);
            asm volatile("s_waitcnt vmcnt(0)" ::: "memory");
        } else {
            XB_SPIN(xb_ld(&bar[XB_XGEN(b.x)]) == gen, bar);
            __builtin_amdgcn_fence(__ATOMIC_ACQUIRE, "agent");
            asm volatile("s_waitcnt vmcnt(0)" ::: "memory");
        }
    }
    __syncthreads();
}


struct Frame {
    LAS unsigned char* lds; volatile LAS unsigned* MISC; gu32* ctl;
    int tid, lane, wave, vcu, G;
    const float *x, *c, *w_ada, *b_ada, *w_in, *w_out, *lq1, *lk1, *lq2, *lk2, *subln, *ln_mix_g, *ln_mix_b, *ln_ffn_g, *ln_ffn_b, *router_w, *router_b, *w_gate, *w_up, *w_down;
    float* out; unsigned char* ws;
    float* mod; float* rot; int* tok_e; float* tok_g; int* tok_slot; int* lists; bf16* Wbf;
    bf16 *S1, *S3, *PROJ, *YP, *HE, *MIXED;
};

__device__ __forceinline__ void transpose_item(const float* W, int ldw, int k0, int n0, bf16* WT, int Kdst, int drow0, LAS float* scr, int lane) {
#pragma unroll 8
    for (int i = 0; i < 32; ++i) { const int kk = 2 * i + (lane >> 5); scr[kk * 33 + (lane & 31)] = W[(size_t)(k0 + kk) * ldw + n0 + (lane & 31)]; }
    LDS_WAIT(); asm volatile("" ::: "memory");
    const int c = lane & 7;
#pragma unroll
    for (int j = 0; j < 4; ++j) { const int n = (lane >> 3) + 8 * j; const LAS float* s = scr + (8 * c) * 33 + n;
        u32x4 o; o.x = pk2(s[0 * 33], s[1 * 33]); o.y = pk2(s[2 * 33], s[3 * 33]); o.z = pk2(s[4 * 33], s[5 * 33]); o.w = pk2(s[6 * 33], s[7 * 33]);
        *(GAS u32x4*)(WT + (size_t)(drow0 + n) * Kdst + k0 + 8 * c) = o; }
    LDS_WAIT(); asm volatile("" ::: "memory");
}
constexpr int IT_IN = 16 * 112, IT_OUT = 16 * 32, IT_E = 256, IT_LAYER = IT_IN + IT_OUT + 3 * 16 * IT_E;
__device__ __forceinline__ void p0_weight_item(const Frame& F, int it, LAS float* scr) {
    const int l = it / IT_LAYER; int r = it - l * IT_LAYER; bf16* wl = F.Wbf + (size_t)l * WL_STRIDE;
    if (r < IT_IN) { const int kb = r / 112, c0 = (r % 112) * 32; int drow = c0;
        if (c0 < 1024) drow = (c0 & ~255) + ((c0 >> 5) & 1) * 128 + ((c0 >> 6) & 3) * 32;
        transpose_item(F.w_in + (size_t)l * DM * INW, INW, kb * 64, c0, wl + WL_IN, DM, drow, scr, F.lane); return; }
    r -= IT_IN;
    if (r < IT_OUT) { const int kb = r / 32, c0 = (r % 32) * 32; transpose_item(F.w_out + (size_t)l * DM * DM, DM, kb * 64, c0, wl + WL_OUT, DM, c0, scr, F.lane); return; }
    r -= IT_OUT;
    const int which = r / (16 * IT_E), rr = r % (16 * IT_E), e = rr / IT_E, q = rr % IT_E;
    if (which < 2) { const int kb = q / 16, c0 = (q % 16) * 32; const float* W = (which == 0 ? F.w_gate : F.w_up) + (size_t)(l * NE + e) * DM * DE;
        transpose_item(W, DE, kb * 64, c0, wl + WL_GU, DM, e * 1024 + (c0 >> 7) * 256 + which * 128 + (c0 & 127), scr, F.lane); }
    else { const int kb = q / 32, c0 = (q % 32) * 32; transpose_item(F.w_down + (size_t)(l * NE + e) * DE * DM, DM, kb * 64, c0, wl + WL_D, DE, e * 1024 + c0, scr, F.lane); }
}

#ifndef DEFER_W1
#define DEFER_W1 0
#endif
#ifndef W1_CAP1
#define W1_CAP1 4
#endif
#ifndef W1_CAP2
#define W1_CAP2 2
#endif
__device__ __forceinline__ void deferred_weights(Frame& F, int nwg, int stage) {
    LAS float* scr = (LAS float*)(F.lds + RING_OFF + F.wave * 8704);
    const int rem = nwg % F.G, I = rem ? F.G - rem : 0, slots = I * NWAVES, base1 = slots * W1_CAP1, base2 = base1 + slots * W1_CAP2;
    if (stage < 2) { if (!rem || (int)blockIdx.x < rem) return;
        const int r = ((int)blockIdx.x - rem) * NWAVES + F.wave, cap = stage == 0 ? W1_CAP1 : W1_CAP2, base = stage == 0 ? 0 : base1;
        for (int k = 0; k < cap; ++k) { const int idx = base + r + k * slots; if (idx < IT_LAYER) p0_weight_item(F, IT_LAYER + idx, scr); }
    } else { for (int idx = base2 + F.vcu * NWAVES + F.wave; idx < IT_LAYER; idx += F.G * NWAVES) p0_weight_item(F, IT_LAYER + idx, scr); }
}
__device__ __forceinline__ void ph_prologue(Frame& F) {
    LAS float* scr = (LAS float*)(F.lds + RING_OFF + F.wave * 8704);
    LAS float* cond = (LAS float*)(F.lds + RING_OFF + 69632);
    LAS float* part = (LAS float*)(F.lds + RING_OFF + 69632 + 32768);
    if ((int)blockIdx.x < 192) {
        { float cv[16];
#pragma unroll
          for (int j = 0; j < 16; ++j) cv[j] = F.c[F.tid + 512 * j];
#pragma unroll
          for (int j = 0; j < 16; ++j) cond[F.tid + 512 * j] = cv[j] / (1.f + expf(-cv[j])); }
        __syncthreads();
        for (int item = blockIdx.x; item < 192; item += F.G) {
            const int l = item / 96, j0 = (item % 96) * 64;
            float acc[8];
#pragma unroll
            for (int b = 0; b < 8; ++b) acc[b] = 0.f;
            const float* w = F.w_ada + (size_t)l * DM * MODW + (size_t)(F.wave * 128) * MODW + j0 + F.lane;
#pragma unroll 4
            for (int k = 0; k < 128; ++k) { const float wv = w[(size_t)k * MODW];
#pragma unroll
                for (int b = 0; b < 8; ++b) acc[b] += cond[b * 1024 + F.wave * 128 + k] * wv; }
#pragma unroll
            for (int b = 0; b < 8; ++b) part[(F.wave * 8 + b) * 64 + F.lane] = acc[b];
            __syncthreads();
            { const int b = F.tid >> 6, ln = F.tid & 63; float s = 0.f;
#pragma unroll
                for (int w8 = 0; w8 < 8; ++w8) s += part[(w8 * 8 + b) * 64 + ln];
                const float mv = s + F.b_ada[l * MODW + j0 + ln]; ST4(&F.mod[(size_t)(l * 8 + b) * MODW + j0 + ln], mv); }
            __syncthreads();
        }
    }
    if ((int)blockIdx.x == F.G - 1 && F.tid < 2) { const int l = F.tid; float s1 = 0.f, s2 = 0.f;
        for (int i = 0; i < 64; ++i) { s1 += F.lq1[l * 64 + i] * F.lk1[l * 64 + i]; s2 += F.lq2[l * 64 + i] * F.lk2[l * 64 + i]; }
        const float li = 0.8f - 0.6f * expf(-0.3f * (float)l);
        F.mod[2 * 8 * MODW + l] = expf(s1) - expf(s2) + li; F.mod[2 * 8 * MODW + 2 + l] = li; }
    if ((int)blockIdx.x == F.G - 2) {
        float* dt = F.mod + 2 * 8 * MODW + 16;
        for (int i = F.tid; i < 1024; i += NWAVES * 64) { const int hh = i >> 7, pp = i & 127; const double gm = 1.0 - exp2(-5.0 - (double)hh);
            dt[i] = (float)(0.125 * pow(gm, (double)(pp - 127))); dt[1024 + i] = (float)pow(gm, (double)(127 - pp)); if (pp == 0) dt[2048 + hh] = (float)pow(gm, 128.0); }
    }
    for (int idx = blockIdx.x * (NWAVES * 64) + F.tid; idx < 4096 * 32; idx += F.G * NWAVES * 64) { const int pos = idx >> 5, i = idx & 31;
        const double inv = pow(10000.0, -(double)(2 * i) / 64.0), a = (double)pos * inv; F.rot[2 * idx] = (float)cos(a); F.rot[2 * idx + 1] = (float)sin(a); }
    const int gw = F.vcu * NWAVES + F.wave, NGW = F.G * NWAVES;
    for (int it = gw; it < (DEFER_W1 ? 1 : 2) * IT_LAYER; it += NGW) p0_weight_item(F, it, scr);
}
__device__ __forceinline__ void ln_mod_row(const float* xrow, const float* sh_, bf16* orow, int lane) {
    const GAS f32x4* xr = (const GAS f32x4*)xrow + lane;
    f32x4 v[4]; float s = 0.f;
#pragma unroll
    for (int j = 0; j < 4; ++j) { v[j] = xr[64 * j]; s += (v[j].x + v[j].y) + (v[j].z + v[j].w); }
    const float mean = wave_sum(s) * (1.f / DM); float s2 = 0.f;
#pragma unroll
    for (int j = 0; j < 4; ++j) { v[j] = v[j] - mean; s2 += (v[j].x * v[j].x + v[j].y * v[j].y) + (v[j].z * v[j].z + v[j].w * v[j].w); }
    const float rstd = 1.f / sqrtf(wave_sum(s2) * (1.f / DM) + LN_EPS);
    const GAS f32x4* sh = (const GAS f32x4*)sh_ + lane; const GAS f32x4* sc = sh + 256; GAS u32x2* o = (GAS u32x2*)orow + lane;
#pragma unroll
    for (int j = 0; j < 4; ++j) { const f32x4 a = sh[64 * j], m = sc[64 * j]; const f32x4 r = v[j] * rstd * (m + 1.f) + a; u32x2 w; w.x = pk2(r.x, r.y); w.y = pk2(r.z, r.w); ST8(&o[64 * j], w); }
}
__device__ __forceinline__ void ln_mod_regs(f32x4 (&v)[4], const float* sh_, bf16* orow, int lane) {
    float s = 0.f;
#pragma unroll
    for (int j = 0; j < 4; ++j) s += (v[j].x + v[j].y) + (v[j].z + v[j].w);
    const float mean = wave_sum(s) * (1.f / DM); float s2 = 0.f;
#pragma unroll
    for (int j = 0; j < 4; ++j) { v[j] = v[j] - mean; s2 += (v[j].x * v[j].x + v[j].y * v[j].y) + (v[j].z * v[j].z + v[j].w * v[j].w); }
    const float rstd = 1.f / sqrtf(wave_sum(s2) * (1.f / DM) + LN_EPS);
    const GAS f32x4* sh = (const GAS f32x4*)sh_ + lane; const GAS f32x4* sc = sh + 256; GAS u32x2* o = (GAS u32x2*)orow + lane;
    f32x4 a[4], mm[4];
#pragma unroll
    for (int j = 0; j < 4; ++j) { a[j] = sh[64 * j]; mm[j] = sc[64 * j]; }
#pragma unroll
    for (int j = 0; j < 4; ++j) { const f32x4 r = v[j] * rstd * (mm[j] + 1.f) + a[j]; u32x2 w; w.x = pk2(r.x, r.y); w.y = pk2(r.z, r.w); ST8(&o[64 * j], w); }
}
__device__ __forceinline__ void ph_ln0(Frame& F) {
    const int gw = F.vcu * NWAVES + F.wave, NGW = F.G * NWAVES;
#pragma unroll 1
    for (int m = gw; m < T; m += 2 * NGW) { int lane = F.lane; asm volatile("" : "+v"(lane));
        const int m2 = m + NGW;
        const GAS f32x4* xa = (const GAS f32x4*)(F.x + (size_t)m * DM) + lane; const GAS f32x4* xb = (const GAS f32x4*)(F.x + (size_t)m2 * DM) + lane;
        f32x4 va[4], vb[4];
#pragma unroll
        for (int j = 0; j < 4; ++j) { va[j] = xa[64 * j]; vb[j] = xb[64 * j]; }
        ln_mod_regs(va, F.mod + (size_t)(m / SEQ) * MODW, F.S1 + (size_t)m * DM, lane);
        ln_mod_regs(vb, F.mod + (size_t)(m2 / SEQ) * MODW, F.S1 + (size_t)m2 * DM, lane); }
}
__device__ __forceinline__ float sane_c(float v) { return (fabsf(v) < 1e4f) ? v : 0.f; }
__device__ __forceinline__ void ph_combine(Frame& F, int l) {
    const int gw = F.vcu * NWAVES + F.wave, NGW = F.G * NWAVES, lane = F.lane;
    const float lam = F.mod[2 * 8 * MODW + l], li = F.mod[2 * 8 * MODW + 2 + l];
#if ATTN128
    const int h = lane >> 4, q = lane & 15, vh0 = (h * 2 + 0) * 2, vh1 = (h * 2 + 1) * 2, d = 8 * q;
#else
    const int h = lane >> 4, q = lane & 15, vh0 = (h * 2 + 0) * 2 + (q >> 3), vh1 = (h * 2 + 1) * 2 + (q >> 3), d = 8 * (q & 7);
#endif
    const f32x4 g0 = *(const f32x4*)(F.subln + l * 128 + 8 * q), g1 = *(const f32x4*)(F.subln + l * 128 + 8 * q + 4);
#pragma unroll 1
    for (int m0 = gw; m0 < T; m0 += 2 * NGW) {
        u32x4 av[2], bv[2];
#pragma unroll
        for (int t = 0; t < 2; ++t) { const int m = m0 + t * NGW; av[t] = *(const GAS u32x4*)(F.S3 + (size_t)m * DM + vh0 * 64 + d); bv[t] = *(const GAS u32x4*)(F.S3 + (size_t)m * DM + vh1 * 64 + d); }
#pragma unroll
        for (int t = 0; t < 2; ++t) { const int m = m0 + t * NGW; const u32x4 a = av[t], b = bv[t];
        float v[8];
        v[0] = __uint_as_float(a.x << 16) - lam * __uint_as_float(b.x << 16); v[1] = __uint_as_float(a.x & 0xffff0000u) - lam * __uint_as_float(b.x & 0xffff0000u);
        v[2] = __uint_as_float(a.y << 16) - lam * __uint_as_float(b.y << 16); v[3] = __uint_as_float(a.y & 0xffff0000u) - lam * __uint_as_float(b.y & 0xffff0000u);
        v[4] = __uint_as_float(a.z << 16) - lam * __uint_as_float(b.z << 16); v[5] = __uint_as_float(a.z & 0xffff0000u) - lam * __uint_as_float(b.z & 0xffff0000u);
        v[6] = __uint_as_float(a.w << 16) - lam * __uint_as_float(b.w << 16); v[7] = __uint_as_float(a.w & 0xffff0000u) - lam * __uint_as_float(b.w & 0xffff0000u);
#pragma unroll
        for (int i = 0; i < 8; ++i) v[i] = sane_c(v[i]);
        float ss = 0.f;
#pragma unroll
        for (int i = 0; i < 8; ++i) ss += v[i] * v[i];
        ss = row16_sum(ss);
        const float r = (1.f - li) / sqrtf(ss * (1.f / 128.f) + LN_EPS);
        u32x4 w; w.x = pk2(v[0] * r * g0.x, v[1] * r * g0.y); w.y = pk2(v[2] * r * g0.z, v[3] * r * g0.w); w.z = pk2(v[4] * r * g1.x, v[5] * r * g1.y); w.w = pk2(v[6] * r * g1.z, v[7] * r * g1.w);
        *(GAS u32x4*)(F.S1 + (size_t)m * DM + 512 + h * 128 + 8 * q) = w; }
    }
}
__device__ __forceinline__ f32x4 bf4(u32x2 m) { f32x4 r; r.x = __uint_as_float(m.x << 16); r.y = __uint_as_float(m.x & 0xffff0000u); r.z = __uint_as_float(m.y << 16); r.w = __uint_as_float(m.y & 0xffff0000u); return r; }
__device__ __forceinline__ float sane(float v, float lim) { return (fabsf(v) < lim) ? v : 0.f; }
__device__ __forceinline__ f32x4 sane4(f32x4 v, float lim) { v.x = sane(v.x, lim); v.y = sane(v.y, lim); v.z = sane(v.z, lim); v.w = sane(v.w, lim); return v; }
struct PmRaw { f32x4 x[4]; u32x2 m[4]; };
__device__ __forceinline__ void pm_load(PmRaw& R, const float* xin, const bf16* MIXED, int row, int lane) {
    const GAS f32x4* xr = (const GAS f32x4*)(xin + (size_t)row * DM) + lane; const GAS u32x2* mr = (const GAS u32x2*)(MIXED + (size_t)row * DM) + lane;
#pragma unroll
    for (int j = 0; j < 4; ++j) { R.x[j] = xr[64 * j]; R.m[j] = mr[64 * j]; }
}
__device__ __forceinline__ void pm_row(const PmRaw& R, const f32x4 (&g1)[4], const f32x4 (&lg)[4], const f32x4 (&lb)[4], const f32x4 (&sc2)[4], const f32x4 (&sh2)[4],
                                       bf16* X1, bf16* H, const LAS float* rwT, LAS float* lgs, int row, int r, int lane, bool norouter) {
    f32x4 v[4];
    float s = 0.f;
#pragma unroll
    for (int j = 0; j < 4; ++j) { v[j] = R.x[j] * ALPHA + g1[j] * sane4(bf4(R.m[j]), 1e4f); s += (v[j].x + v[j].y) + (v[j].z + v[j].w); }
    float mean = wave_sum(s) * (1.f / DM), s2 = 0.f;
#pragma unroll
    for (int j = 0; j < 4; ++j) { v[j] = v[j] - mean; s2 += (v[j].x * v[j].x + v[j].y * v[j].y) + (v[j].z * v[j].z + v[j].w * v[j].w); }
    float rstd = 1.f / sqrtf(wave_sum(s2) * (1.f / DM) + LN_EPS);
    GAS u32x2* xo = (GAS u32x2*)(X1 + (size_t)row * DM) + lane; s = 0.f;
#pragma unroll
    for (int j = 0; j < 4; ++j) { v[j] = v[j] * rstd * lg[j] + lb[j];
        u32x2 w; w.x = pk2(v[j].x, v[j].y); w.y = pk2(v[j].z, v[j].w); ST8(&xo[64 * j], w); s += (v[j].x + v[j].y) + (v[j].z + v[j].w); }
    mean = wave_sum(s) * (1.f / DM); s2 = 0.f;
#pragma unroll
    for (int j = 0; j < 4; ++j) { v[j] = v[j] - mean; s2 += (v[j].x * v[j].x + v[j].y * v[j].y) + (v[j].z * v[j].z + v[j].w * v[j].w); }
    rstd = 1.f / sqrtf(wave_sum(s2) * (1.f / DM) + LN_EPS);
    GAS u32x2* ho = (GAS u32x2*)(H + (size_t)row * DM) + lane;
#pragma unroll
    for (int j = 0; j < 4; ++j) { v[j] = v[j] * rstd * (sc2[j] + 1.f) + sh2[j]; u32x2 w; w.x = pk2(v[j].x, v[j].y); w.y = pk2(v[j].z, v[j].w); ST8(&ho[64 * j], w); }
    if (norouter) return;
    float a[16];
#pragma unroll
    for (int e = 0; e < 16; ++e) {
        float s0 = 0.f;
#pragma unroll
        for (int j = 0; j < 4; ++j) { const f32x4 w4 = *(const LAS f32x4*)(rwT + e * 1024 + 4 * lane + 256 * j); s0 += (v[j].x * w4.x + v[j].y * w4.y) + (v[j].z * w4.z + v[j].w * w4.w); }
        a[e] = s0;
    }
    const bool h5 = (lane & 32) != 0, h4 = (lane & 16) != 0, h3 = (lane & 8) != 0, h2 = (lane & 4) != 0;
    float c8[8], d4[4], f2[2];
#pragma unroll
    for (int i = 0; i < 8; ++i) { const float mine = h5 ? a[8 + i] : a[i], send = h5 ? a[i] : a[8 + i]; c8[i] = mine + __shfl_xor(send, 32); }
#pragma unroll
    for (int i = 0; i < 4; ++i) { const float mine = h4 ? c8[4 + i] : c8[i], send = h4 ? c8[i] : c8[4 + i]; d4[i] = mine + __shfl_xor(send, 16); }
#pragma unroll
    for (int i = 0; i < 2; ++i) { const float mine = h3 ? d4[2 + i] : d4[i], send = h3 ? d4[i] : d4[2 + i]; f2[i] = mine + __shfl_xor(send, 8); }
    float gsum; { const float mine = h2 ? f2[1] : f2[0], send = h2 ? f2[0] : f2[1]; gsum = mine + __shfl_xor(send, 4); }
    gsum += __shfl_xor(gsum, 2); gsum += __shfl_xor(gsum, 1);
    if ((lane & 3) == 0) lgs[r * 16 + (lane >> 2)] = gsum;
}
#ifndef DRY_SKIP
#define DRY_SKIP 0
#endif
__device__ __forceinline__ void ph_postmix(Frame& F, int l, bool dry = false) {
    LAS float* rwT = (LAS float*)(F.lds + RING_OFF);
    LAS float* lgs = (LAS float*)(F.lds + RING_OFF + 65536) + F.wave * 256;
    LAS int* lcnt = (LAS int*)(F.lds + LCNT_OFF);
    const float* xin = l == 0 ? F.x : F.out; const float* modl = F.mod + (size_t)l * 8 * MODW; int* cnt = (int*)F.ctl + CW_CNT + 64 * l;
    const float* lng = F.ln_mix_g + l * DM; const float* lnb = F.ln_mix_b + l * DM; const int lane = F.lane;
    const bool norouter = dry && (DRY_SKIP & 1);
    { f32x4 t4[8];
#pragma unroll
      for (int j = 0; j < 8; ++j) t4[j] = ((const GAS f32x4*)F.router_w)[F.tid + 512 * j];
#pragma unroll
      for (int j = 0; j < 8; ++j) { const int i4 = F.tid + 512 * j, k = i4 >> 2, e0 = (i4 & 3) * 4; rwT[(e0 + 0) * 1024 + k] = t4[j].x; rwT[(e0 + 1) * 1024 + k] = t4[j].y; rwT[(e0 + 2) * 1024 + k] = t4[j].z; rwT[(e0 + 3) * 1024 + k] = t4[j].w; } }
#pragma unroll 1
    for (int base = blockIdx.x * 128; base < T; base += F.G * 128) {
        if (F.tid < 16) lcnt[F.tid] = 0;
        __syncthreads();
        const int b = base / SEQ, wrow = base + F.wave * 16;
        f32x4 g1[4], lg[4], lb[4], sc2[4], sh2[4];
        { const GAS f32x4* g1p = (const GAS f32x4*)(modl + (size_t)b * MODW + 2 * DM) + lane; const GAS f32x4* lgp = (const GAS f32x4*)lng + lane; const GAS f32x4* lbp = (const GAS f32x4*)lnb + lane;
#pragma unroll
          for (int j = 0; j < 4; ++j) { g1[j] = g1p[64 * j]; sh2[j] = g1p[256 + 64 * j]; sc2[j] = g1p[512 + 64 * j]; lg[j] = lgp[64 * j]; lb[j] = lbp[64 * j]; } }
        PmRaw A, B, C;
        pm_load(A, xin, F.MIXED, wrow, lane); pm_load(B, xin, F.MIXED, wrow + 1, lane);
#pragma unroll 1
        for (int it = 0; it < 5; ++it) {
            const int r0 = 3 * it;
            pm_load(C, xin, F.MIXED, wrow + r0 + 2, lane);
            pm_row(A, g1, lg, lb, sc2, sh2, F.S3, F.S1, rwT, lgs, wrow + r0, r0, lane, norouter);
            pm_load(A, xin, F.MIXED, wrow + r0 + 3, lane);
            pm_row(B, g1, lg, lb, sc2, sh2, F.S3, F.S1, rwT, lgs, wrow + r0 + 1, r0 + 1, lane, norouter);
            if (it < 4) pm_load(B, xin, F.MIXED, wrow + r0 + 4, lane);
            pm_row(C, g1, lg, lb, sc2, sh2, F.S3, F.S1, rwT, lgs, wrow + r0 + 2, r0 + 2, lane, norouter);
        }
        pm_row(A, g1, lg, lb, sc2, sh2, F.S3, F.S1, rwT, lgs, wrow + 15, 15, lane, norouter);
        LDS_WAIT(); asm volatile("" ::: "memory");
        int my_e1 = 0, my_e2 = 0, my_l1 = 0, my_l2 = 0;
        if (lane < 16) {
            float p[16];
#pragma unroll
            for (int q = 0; q < 4; ++q) { const f32x4 t = *(const LAS f32x4*)(lgs + lane * 16 + 4 * q); p[4 * q] = t.x; p[4 * q + 1] = t.y; p[4 * q + 2] = t.z; p[4 * q + 3] = t.w; }
            float mx = -INFINITY, sum = 0.f;
#pragma unroll
            for (int e = 0; e < 16; ++e) { p[e] += F.router_b[e]; mx = fmaxf(mx, p[e]); }
#pragma unroll
            for (int e = 0; e < 16; ++e) { p[e] = expf(p[e] - mx); sum += p[e]; }
            const float rs = 1.f / sum;
#pragma unroll
            for (int e = 0; e < 16; ++e) p[e] *= rs;
            int bg = 0; float bgs = -1.f;
#pragma unroll
            for (int g = 0; g < 4; ++g) { float m1 = p[4 * g]; int i1 = 0;
#pragma unroll
                for (int i = 1; i < 4; ++i) if (p[4 * g + i] > m1) { m1 = p[4 * g + i]; i1 = i; }
                float m2 = -1.f;
#pragma unroll
                for (int i = 0; i < 4; ++i) if (i != i1 && p[4 * g + i] > m2) m2 = p[4 * g + i];
                const float gs = m1 + m2; if (gs > bgs) { bgs = gs; bg = g; } }
            float q0 = 0.f, q1 = 0.f, q2 = 0.f, q3 = 0.f;
#pragma unroll
            for (int g = 0; g < 4; ++g) if (bg == g) { q0 = p[4 * g]; q1 = p[4 * g + 1]; q2 = p[4 * g + 2]; q3 = p[4 * g + 3]; }
            float m1 = q0; int i1 = 0; if (q1 > m1) { m1 = q1; i1 = 1; } if (q2 > m1) { m1 = q2; i1 = 2; } if (q3 > m1) { m1 = q3; i1 = 3; }
            float m2 = -1.f; int i2 = 0;
            if (i1 != 0 && q0 > m2) { m2 = q0; i2 = 0; } if (i1 != 1 && q1 > m2) { m2 = q1; i2 = 1; } if (i1 != 2 && q2 > m2) { m2 = q2; i2 = 2; } if (i1 != 3 && q3 > m2) { m2 = q3; i2 = 3; }
            my_e1 = bg * 4 + i1; my_e2 = bg * 4 + i2; const int row = wrow + lane; const float den = 1.f / (m1 + m2);
            my_l1 = __hip_atomic_fetch_add(lcnt + my_e1, 1, __ATOMIC_RELAXED, __HIP_MEMORY_SCOPE_WORKGROUP); my_l2 = __hip_atomic_fetch_add(lcnt + my_e2, 1, __ATOMIC_RELAXED, __HIP_MEMORY_SCOPE_WORKGROUP);
            const float gw1 = m1 * den, gw2 = m2 * den; ST4(&F.tok_e[2 * row], my_e1); ST4(&F.tok_e[2 * row + 1], my_e2); ST4(&F.tok_g[2 * row], gw1); ST4(&F.tok_g[2 * row + 1], gw2);
        }
        __syncthreads();
        if (F.tid < 16 && !dry) lcnt[16 + F.tid] = atomicAdd(cnt + F.tid, lcnt[F.tid]);
        __syncthreads();
        if (lane < 16 && !dry) { const int row = wrow + lane, s1 = lcnt[16 + my_e1] + my_l1, s2 = lcnt[16 + my_e2] + my_l2;
            ST4(&F.tok_slot[2 * row], s1); ST4(&F.tok_slot[2 * row + 1], s2); ST4(&F.lists[(size_t)my_e1 * T + s1], row); ST4(&F.lists[(size_t)my_e2 * T + s2], row); }
        __syncthreads();
    }
}
__device__ __forceinline__ void moe_table(Frame& F, int l) {
    LAS int* tab = (LAS int*)(F.lds + TAB_OFF); LAS int* eb = (LAS int*)(F.lds + EB_OFF); const int* cnt = (const int*)F.ctl + CW_CNT + 64 * l;
    __syncthreads();
    if (F.tid < 272 || F.tid == 511) {
        int pref = 0, mine = -1;
#pragma unroll
        for (int e = 0; e < 16; ++e) { const int n = __hip_atomic_load(cnt + e, RLX_AGENT), nt = (n + 255) >> 8; if (F.tid < 272 && F.tid >= pref && F.tid < pref + nt) mine = e | ((F.tid - pref) << 8);
            if (F.tid == 511) eb[e] = pref * 256; pref += nt; }
        if (F.tid < 272) tab[1 + F.tid] = mine;
        if (F.tid == 511) tab[0] = pref;
    }
    __syncthreads();
}
struct PfRaw { u32x2 x[4], y0[4], y1[4]; };
__device__ __forceinline__ void pf_load(PfRaw& R, const bf16* X1, const bf16* YP, int row, size_t r0, size_t r1, int lane) {
    const GAS u32x2* xr = (const GAS u32x2*)(X1 + (size_t)row * DM) + lane; const GAS u32x2* y0 = (const GAS u32x2*)(YP + r0 * DM) + lane; const GAS u32x2* y1 = (const GAS u32x2*)(YP + r1 * DM) + lane;
#pragma unroll
    for (int j = 0; j < 4; ++j) { R.x[j] = xr[64 * j]; R.y0[j] = y0[64 * j]; R.y1[j] = y1[64 * j]; }
}
template <bool NEXT>
__device__ __forceinline__ void pf_row(const PfRaw& R, float w0, float w1, const f32x4 (&g2)[4], const f32x4 (&lg)[4], const f32x4 (&lb)[4], const f32x4 (&sh)[4], const f32x4 (&sc)[4], float* out, bf16* H, int row, int lane, bool store_h) {
    f32x4 v[4]; float s = 0.f;
#pragma unroll
    for (int j = 0; j < 4; ++j) { v[j] = sane4(bf4(R.x[j]), 1e4f) * ALPHA + g2[j] * sane4(bf4(R.y0[j]) * w0 + bf4(R.y1[j]) * w1, 1e4f);
        s += (v[j].x + v[j].y) + (v[j].z + v[j].w); }
    float mean = wave_sum(s) * (1.f / DM), s2 = 0.f;
#pragma unroll
    for (int j = 0; j < 4; ++j) { v[j] = v[j] - mean; s2 += (v[j].x * v[j].x + v[j].y * v[j].y) + (v[j].z * v[j].z + v[j].w * v[j].w); }
    float rstd = 1.f / sqrtf(wave_sum(s2) * (1.f / DM) + LN_EPS);
    GAS f32x4* o = (GAS f32x4*)(out + (size_t)row * DM) + lane; s = 0.f;
#pragma unroll
    for (int j = 0; j < 4; ++j) { v[j] = v[j] * rstd * lg[j] + lb[j]; o[64 * j] = v[j]; s += (v[j].x + v[j].y) + (v[j].z + v[j].w); }
    if (NEXT) {
        mean = wave_sum(s) * (1.f / DM); s2 = 0.f;
#pragma unroll
        for (int j = 0; j < 4; ++j) { v[j] = v[j] - mean; s2 += (v[j].x * v[j].x + v[j].y * v[j].y) + (v[j].z * v[j].z + v[j].w * v[j].w); }
        rstd = 1.f / sqrtf(wave_sum(s2) * (1.f / DM) + LN_EPS);
        GAS u32x2* ho = (GAS u32x2*)(H + (size_t)row * DM) + lane;
#pragma unroll
        for (int j = 0; j < 4; ++j) { const f32x4 r = v[j] * rstd * (sc[j] + 1.f) + sh[j]; u32x2 w; w.x = pk2(r.x, r.y); w.y = pk2(r.z, r.w); if (store_h) ST8(&ho[64 * j], w); }
    }
}
template <bool NEXT>
__device__ __forceinline__ void ph_postffn_t(Frame& F, int l) {
    const LAS int* eb = (const LAS int*)(F.lds + EB_OFF); const float* modl = F.mod + (size_t)l * 8 * MODW; const float* modn = F.mod + (size_t)(l + 1 < DEPTH ? l + 1 : l) * 8 * MODW;
    const float* lng = F.ln_ffn_g + l * DM; const float* lnb = F.ln_ffn_b + l * DM; const int lane = F.lane;
#pragma unroll 1
    for (int base = (F.vcu * NWAVES + F.wave) * 16; base < T; base += F.G * NWAVES * 16) {
        const int b = base / SEQ;
        const int mrow = base + (lane & 15);
        const int e0 = F.tok_e[2 * mrow], e1 = F.tok_e[2 * mrow + 1]; const float mw0 = F.tok_g[2 * mrow], mw1 = F.tok_g[2 * mrow + 1];
        const int mr0 = eb[e0] + F.tok_slot[2 * mrow], mr1 = eb[e1] + F.tok_slot[2 * mrow + 1];
        f32x4 g2[4], lg[4], lb[4], sh[4], sc[4];
        { const GAS f32x4* g2p = (const GAS f32x4*)(modl + (size_t)b * MODW + 5 * DM) + lane; const GAS f32x4* lgp = (const GAS f32x4*)lng + lane; const GAS f32x4* lbp = (const GAS f32x4*)lnb + lane;
          const GAS f32x4* shp = (const GAS f32x4*)(modn + (size_t)b * MODW) + lane;
#pragma unroll
          for (int j = 0; j < 4; ++j) { g2[j] = g2p[64 * j]; lg[j] = lgp[64 * j]; lb[j] = lbp[64 * j]; if (NEXT) { sh[j] = shp[64 * j]; sc[j] = shp[256 + 64 * j]; } else { sh[j] = (f32x4){0.f, 0.f, 0.f, 0.f}; sc[j] = sh[j]; } } }
        PfRaw A, B;
#define PF_LOAD2(R, r) pf_load(R, F.S3, F.YP, base + (r), (size_t)__shfl(mr0, (r)), (size_t)__shfl(mr1, (r)), lane)
#define PF_ROW2(R, r) pf_row<NEXT>(R, __shfl(mw0, (r)), __shfl(mw1, (r)), g2, lg, lb, sh, sc, F.out, F.S1, base + (r), lane, l + 1 < DEPTH)
        PF_LOAD2(A, 0);
#pragma unroll 1
        for (int it = 0; it < 8; ++it) {
            PF_LOAD2(B, 2 * it + 1);
            PF_ROW2(A, 2 * it);
            if (it < 7) PF_LOAD2(A, 2 * it + 2);
            PF_ROW2(B, 2 * it + 1);
        }
#undef PF_LOAD2
#undef PF_ROW2
    }
}
#ifndef PF_ALWAYS_NEXT
#define PF_ALWAYS_NEXT 1
#endif
__device__ __forceinline__ void ph_postffn(Frame& F, int l) { if (PF_ALWAYS_NEXT || l + 1 < DEPTH) ph_postffn_t<true>(F, l); else ph_postffn_t<false>(F, l); }

typedef __attribute__((address_space(4))) const unsigned char* kaptr_t;
__device__ __forceinline__ void frame_ptrs(Frame& F, kaptr_t ka) {
#define KA_IN(i) (*(const float* __attribute__((address_space(4))) const*)(ka + 8 * (i)))
    F.x = KA_IN(0); F.c = KA_IN(1); F.w_ada = KA_IN(2); F.b_ada = KA_IN(3); F.w_in = KA_IN(4); F.w_out = KA_IN(5); F.lq1 = KA_IN(6); F.lk1 = KA_IN(7); F.lq2 = KA_IN(8); F.lk2 = KA_IN(9);
    F.subln = KA_IN(10); F.ln_mix_g = KA_IN(11); F.ln_mix_b = KA_IN(12); F.ln_ffn_g = KA_IN(13); F.ln_ffn_b = KA_IN(14); F.router_w = KA_IN(15); F.router_b = KA_IN(16);
    F.w_gate = KA_IN(17); F.w_up = KA_IN(18); F.w_down = KA_IN(19);
    F.out = *(float* __attribute__((address_space(4))) const*)(ka + 160);
    unsigned char* ws = *(unsigned char* __attribute__((address_space(4))) const*)(ka + 168);
#undef KA_IN
    F.ws = ws; F.ctl = (gu32*)(ws + WS_CTL);
    F.mod = (float*)(ws + WS_MOD); F.rot = (float*)(ws + WS_ROT); F.tok_e = (int*)(ws + WS_TOK); F.tok_g = (float*)(ws + WS_TOK + 256 * 1024); F.tok_slot = (int*)(ws + WS_TOK + 512 * 1024);
    F.lists = (int*)(ws + WS_LIST); F.Wbf = (bf16*)(ws + WS_W);
    F.S1 = (bf16*)(ws + WS_S1); F.S3 = (bf16*)(ws + WS_S3); F.PROJ = (bf16*)(ws + WS_S2); F.YP = (bf16*)(ws + WS_YP); F.HE = (bf16*)(ws + WS_HE); F.MIXED = (bf16*)(ws + WS_MIXED);
}
struct Args { const float* in[20]; float* out; unsigned char* ws; int ph_lo, ph_hi, li, pad; };
__global__ void __launch_bounds__(NWAVES * 64, 2) mega(Args args) {
    extern __shared__ __attribute__((aligned(16))) unsigned char lds[];
    Frame F;
    F.lds = (LAS unsigned char*)lds; F.MISC = (volatile LAS unsigned*)(F.lds + MISC_OFF);
    F.tid = threadIdx.x; F.lane = F.tid & 63; F.wave = __builtin_amdgcn_readfirstlane(F.tid >> 6);
    F.G = gridDim.x; { const int bx = blockIdx.x; F.vcu = (F.G % 8 == 0) ? (bx % 8) * (F.G / 8) + bx / 8 : bx; }
    F.ctl = (gu32*)(args.ws + WS_CTL);
    for (int u = F.tid; u < (LDS_BYTES - LDSCTL_OFF) / 4; u += NWAVES * 64) ((LAS unsigned*)(F.lds + LDSCTL_OFF))[u] = 0u;
    __syncthreads();
    const int lo = args.ph_lo, hi = args.ph_hi;
    XcdBarrier bar; bar.bar = (unsigned*)(F.ctl + CW_BAR) + args.li * XCD_BAR_WORDS; bar.x = 0; bar.st = nullptr;
    if (hi - lo > 1) bar = xcd_barrier_post((unsigned*)(F.ctl + CW_BAR) + args.li * XCD_BAR_WORDS, F.MISC + 8);
#ifndef KIND_MASK
#define KIND_MASK 0x3ffu
#endif
#define KEN(k) ((KIND_MASK >> (k)) & 1u)
#ifndef REP_KIND
#define REP_KIND -1
#endif
#ifndef REP_N
#define REP_N 1
#endif
#define REPS(k) for (int rep_ = 0; rep_ < ((REP_KIND == (k)) ? REP_N : 1); ++rep_)
#define IN(k) (lo <= (k) && (k) < hi)
#define FRESH() do { int t_ = threadIdx.x; asm volatile("" : "+v"(t_)); F.tid = t_; F.lane = t_ & 63; kaptr_t ka_ = (kaptr_t)__builtin_amdgcn_kernarg_segment_ptr(); asm volatile("" : "+s"(ka_)); frame_ptrs(F, ka_); } while (0)
#ifndef BAR_REP
#define BAR_REP 1
#endif
#define SEAM(k) do { if (IN(k) && IN((k) + 1)) for (int br_ = 0; br_ < BAR_REP; ++br_) xcd_barrier(bar); } while (0)

    if (KEN(8) && IN(0)) REPS(8) { FRESH(); ph_prologue(F); } SEAM(0);
    if (KEN(9) && IN(1)) REPS(9) { FRESH(); ph_ln0(F); } SEAM(1);
    for (int l = 0; l < DEPTH; ++l) {
        const int pb = 2 + 8 * l;
#define wl (F.Wbf + (size_t)l * WL_STRIDE)
        if (KEN(0) && IN(pb + 0)) REPS(0) { FRESH();
            pg8::PlainSched S; S.init(T / 256, INW / 256, F.G, (int)blockIdx.x); S.Bt = wl + WL_IN; S.K = DM;
            pg8::EpiInProj E{F.PROJ, F.rot, RET_FAST ? F.mod + 2 * 8 * MODW + 16 : nullptr};
            pg8::gemm_phase<pg8::EpiInProj, pg8::PlainSched, true>(F.lds + RING_OFF, (const char*)F.S1, DM, S, E);
        }
        SEAM(pb + 0);
        if (KEN(1) && IN(pb + 1)) REPS(1) { FRESH();
            if (RET_FAST) REPS(10) { const int bh = F.vcu >> 2, hh = bh & 7; ret::ret_unit(bh >> 3, hh, F.vcu & 3, F.PROJ, F.S1, F.mod[2 * 8 * MODW + 16 + 2048 + hh], F.lds + RING_OFF); }
#if ATTN128
            { const int bhc = F.vcu >> 2, b = bhc >> 3, hc = bhc & 7, h = hc >> 1, c = hc & 1, s = F.vcu & 3;
              const attn128::bf16* base = (const attn128::bf16*)(F.PROJ + (size_t)b * SEQ * INW);
#pragma unroll 1
              for (int i = 0; i < 4; ++i) { const int qb = i == 0 ? s : i == 1 ? 7 - s : i == 2 ? 8 + s : 15 - s;
                  attn128::attn_unit<ATTN_THRL>(qb, base + C_DQ + h * 128 + c * 64, base + C_DK + h * 128 + c * 64, base + C_DV + h * 128,
                                        (attn128::bf16*)(F.S3 + (size_t)b * SEQ * DM + hc * 128), (char*)lds + RING_OFF); } }
        }
#else
            const int pr = F.vcu >> 1, b = pr >> 4, vh = pr & 15, h = vh >> 2, c = (vh >> 1) & 1, vhalf = vh & 1;
            const attn_body::bf16* base = (const attn_body::bf16*)(F.PROJ + (size_t)b * SEQ * INW);
#pragma unroll 1
            for (int i = 0; i < 8; ++i) { const int s = 2 * (i >> 1) + (F.vcu & 1), qb = (i & 1) ? 15 - s : s;
                attn_body::attn_unit<8>(qb, base + C_DQ + h * 128 + c * 64, base + C_DK + h * 128 + c * 64, base + C_DV + h * 128 + vhalf * 64,
                                        (attn_body::bf16*)(F.S3 + (size_t)b * SEQ * DM + vh * 64), (char*)lds + RING_OFF); }
        }
#endif
        SEAM(pb + 1);
        if (KEN(2) && IN(pb + 2)) REPS(2) { FRESH(); ph_combine(F, l); }
        SEAM(pb + 2);
        if (KEN(3) && IN(pb + 3)) REPS(3) { FRESH();
            pg8::PlainSched S; S.init(T / 256, DM / 256, F.G, (int)blockIdx.x); S.Bt = wl + WL_OUT; S.K = DM;
            pg8::EpiPlain E{F.MIXED, DM};
            pg8::gemm_phase<pg8::EpiPlain, pg8::PlainSched, true>(F.lds + RING_OFF, (const char*)F.S1, DM, S, E);
        }
        SEAM(pb + 3);
        if (KEN(4) && IN(pb + 4)) REPS(4) { FRESH(); ph_postmix(F, l, rep_ > 0); }
        SEAM(pb + 4);
        if (KEN(5) && IN(pb + 5)) REPS(5) {
            FRESH(); moe_table(F, l);
            pg8::MoeSched S; S.init(((const LAS int*)(F.lds + TAB_OFF))[0], 4, F.G, (int)blockIdx.x); S.Bt = wl + WL_GU; S.K = DM; S.tab = (const LAS int*)(F.lds + TAB_OFF);
            S.cnt = (const int*)F.ctl + CW_CNT + 64 * l; S.lists = F.lists; S.gather = true;
            pg8::EpiGateUp E{F.HE};
            pg8::gemm_phase<pg8::EpiGateUp, pg8::MoeSched, true>(F.lds + RING_OFF, (const char*)F.S1, DM, S, E);
            if (DEFER_W1 && l == 0) deferred_weights(F, S.nwg, 0);
        }
        SEAM(pb + 5);
        if (KEN(6) && IN(pb + 6)) REPS(6) {
            FRESH(); moe_table(F, l);
            pg8::MoeSched S; S.init(((const LAS int*)(F.lds + TAB_OFF))[0], 4, F.G, (int)blockIdx.x); S.Bt = wl + WL_D; S.K = DE; S.tab = (const LAS int*)(F.lds + TAB_OFF);
            S.cnt = (const int*)F.ctl + CW_CNT + 64 * l; S.lists = F.lists; S.gather = false;
            pg8::EpiPlain E{F.YP, DM};
            pg8::gemm_phase<pg8::EpiPlain, pg8::MoeSched, true>(F.lds + RING_OFF, (const char*)F.HE, DE, S, E);
            if (DEFER_W1 && l == 0) deferred_weights(F, S.nwg, 1);
        }
        SEAM(pb + 6);
        if (KEN(7) && IN(pb + 7)) REPS(7) { FRESH(); moe_table(F, l); if (DEFER_W1 && l == 0) { deferred_weights(F, 4 * ((const LAS int*)(F.lds + TAB_OFF))[0], 2); } ph_postffn(F, l); }
        SEAM(pb + 7);
#undef wl
    }
#undef IN
#undef SEAM
}
#ifndef FAST_MASK
#define FAST_MASK 0x3ffffu
#endif
extern "C" void kernel_launch(void* const* d_in, const int* in_sizes, int n_in, void* d_out, int out_size, void* d_ws, size_t ws_size, hipStream_t stream) {
    static int grid = 0;
    if (grid == 0) {
        if (n_in != 20 || out_size != T * DM || ws_size < WS_END) { fprintf(stderr, "kernel_launch: unexpected shapes (n_in %d out %d ws %zu)\n", n_in, out_size, ws_size); grid = -1; return; }
        int dev = 0, cus = 0, per_cu = 0;
        if (hipGetDevice(&dev) != hipSuccess || hipDeviceGetAttribute(&cus, hipDeviceAttributeMultiprocessorCount, dev) != hipSuccess) { grid = -1; return; }
        if (hipFuncSetAttribute((const void*)mega, hipFuncAttributeMaxDynamicSharedMemorySize, LDS_BYTES) != hipSuccess) { fprintf(stderr, "kernel_launch: hipFuncSetAttribute failed\n"); grid = -1; return; }
        if (hipOccupancyMaxActiveBlocksPerMultiprocessor(&per_cu, (const void*)mega, NWAVES * 64, LDS_BYTES) != hipSuccess || per_cu < 1) fprintf(stderr, "kernel_launch: occupancy query says %d\n", per_cu);
        (void)hipGetLastError();
        grid = cus;
        if (grid != 256) { fprintf(stderr, "kernel_launch: built for 256 CUs, found %d\n", grid); grid = -1; return; }
    }
    if (grid < 0) return;
    const float* x = (const float*)d_in[0];
    const float* w_in = (const float*)d_in[4]; const float* w_out = (const float*)d_in[5];
    const float* subln = (const float*)d_in[10]; const float* ln_mix_g = (const float*)d_in[11]; const float* ln_mix_b = (const float*)d_in[12];
    const float* ln_ffn_g = (const float*)d_in[13]; const float* ln_ffn_b = (const float*)d_in[14]; const float* router_w = (const float*)d_in[15]; const float* router_b = (const float*)d_in[16];
    const float* w_gate = (const float*)d_in[17]; const float* w_up = (const float*)d_in[18]; const float* w_down = (const float*)d_in[19];
    unsigned char* ws = (unsigned char*)d_ws; float* out = (float*)d_out;
    float* mod = (float*)(ws + WS_MOD); float* rot = (float*)(ws + WS_ROT);
    int* tok_e = (int*)(ws + WS_TOK); float* tok_g = (float*)(ws + WS_TOK + 256 * 1024); int* tok_slot = (int*)(ws + WS_TOK + 512 * 1024); int* lists = (int*)(ws + WS_LIST);
    bf16* S1 = (bf16*)(ws + WS_S1); bf16* X1 = (bf16*)(ws + WS_S3); bf16* PROJ = (bf16*)(ws + WS_S2); bf16* YP = (bf16*)(ws + WS_YP); bf16* HE = (bf16*)(ws + WS_HE); bf16* MIXED = (bf16*)(ws + WS_MIXED);
    int* ctl = (int*)(ws + WS_CTL);
    (void)hipMemsetAsync(ws + WS_CTL, 0, 1 * MiB, stream);
    Args a{};
    for (int i = 0; i < 20; ++i) a.in[i] = (const float*)d_in[i];
    a.out = out; a.ws = ws;
    int li = 0, lo = -1;
    auto flush = [&](int hi) { if (lo >= 0) { a.ph_lo = lo; a.ph_hi = hi; a.li = li++; hipLaunchKernelGGL(mega, dim3(grid), dim3(NWAVES * 64), LDS_BYTES, stream, a); lo = -1; } };
    for (int p = 0; p < NPHASE; ++p) {
        const bool fast = (FAST_MASK >> p) & 1u;
        const int l = p < 2 ? 0 : (p - 2) / 8, k = p < 2 ? -1 : (p - 2) % 8;
        const float* modl = mod + (size_t)l * 8 * MODW; int* cnt = ctl + CW_CNT + 64 * l;
        if (fast) { if (lo < 0) lo = p; }
        else {
            flush(p);
            if (p == 0) { k_mod<<<dim3(MODW / 256, 2), 256, 0, stream>>>((const float*)d_in[1], (const float*)d_in[2], (const float*)d_in[3], (const float*)d_in[6], (const float*)d_in[7], (const float*)d_in[8], (const float*)d_in[9], mod);
                          k_rot<<<512, 256, 0, stream>>>(rot); }
            else if (p == 1) k_ln_mod<<<T / 4, 256, 0, stream>>>(x, mod, 0, S1);
            else if (k == 0) k_ngemm_inproj<<<dim3(INW / 64, T / 128), 256, 0, stream>>>(S1, w_in + (size_t)l * DM * INW, rot, PROJ);
            else if (k == 1) k_ndiff<<<dim3(SEQ / 64, 4, NB), 256, 0, stream>>>(PROJ, mod + 2 * 8 * MODW, subln, l, S1);
            else if (k == 2) {   }
            else if (k == 3) k_ngemm_plain<<<dim3(DM / 64, T / 128), 256, 0, stream>>>(S1, DM, w_out + (size_t)l * DM * DM, DM, DM, MIXED, DM);
            else if (k == 4) k_post_mix<<<T / 4, 256, 0, stream>>>(l == 0 ? x : out, MIXED, modl, ln_mix_g + l * DM, ln_mix_b + l * DM, router_w, router_b, X1, S1, tok_e, tok_g, tok_slot, lists, cnt);
            else if (k == 5) k_moe1<<<dim3(DE / 64, T / 128, NE), 256, 0, stream>>>(S1, w_gate + (size_t)l * NE * DM * DE, w_up + (size_t)l * NE * DM * DE, cnt, lists, HE);
            else if (k == 6) k_moe2<<<dim3(DM / 64, T / 128, NE), 256, 0, stream>>>(HE, w_down + (size_t)l * NE * DE * DM, cnt, YP);
            else if (k == 7) k_post_ffn<<<T / 4, 256, 0, stream>>>(X1, YP, modl, ln_ffn_g + l * DM, ln_ffn_b + l * DM, tok_e, tok_g, tok_slot, cnt, out, l + 1 < DEPTH ? mod + (size_t)(l + 1) * 8 * MODW : nullptr, S1);
        }
        if (!RET_FAST && k == 2) { flush(p + 1); k_nret<<<dim3(SEQ / 64, 8, NB), 256, 0, stream>>>(PROJ, S1); }
    }
    flush(NPHASE);
}
```

```cpp
#include <hip/hip_runtime.h>
#include <cstdio>
#include <cstdint>
#include <cmath>

typedef unsigned short bf16;
typedef float f32x4 __attribute__((ext_vector_type(4)));
typedef unsigned u32x4 __attribute__((ext_vector_type(4)));
typedef unsigned u32x2 __attribute__((ext_vector_type(2)));

constexpr int NB = 8, SEQ = 4096, DM = 1024, T = NB * SEQ, DEPTH = 2;
constexpr int INW = 3584, NE = 16, DE = 512;
constexpr int C_RQ = 0, C_RK = 512, C_RV = 1024, C_RG = 1536, C_DQ = 2048, C_DK = 2560, C_DV = 3072;
constexpr float ALPHA = 1.41421356237309515f;
constexpr float LN_EPS = 1e-5f;
constexpr float C2 = 0.125f * 1.4426950408889634f;
constexpr int MODW = 6 * DM;
constexpr int PAIR_ROWS = 69632;

constexpr size_t MiB = 1u << 20;
constexpr size_t WS_CTL = 0;
constexpr size_t WS_MOD = 1 * MiB;
constexpr size_t WS_ROT = 2 * MiB;
constexpr size_t WS_TOK = 3 * MiB;
constexpr size_t WS_LIST = 4 * MiB;
constexpr size_t WS_W = 8 * MiB;
constexpr size_t WS_S1 = 122 * MiB;
constexpr size_t WS_S3 = 186 * MiB;
constexpr size_t WS_S2 = 250 * MiB;
constexpr size_t WS_YP = WS_S2, WS_HE = WS_S2 + 136 * MiB, WS_MIXED = WS_HE;
constexpr size_t WS_END = 474 * MiB;
constexpr int CW_CNT = 64;

__device__ __forceinline__ float bf2f(bf16 v) { return __uint_as_float((unsigned)v << 16); }
__device__ __forceinline__ unsigned f2bf(float f) { unsigned u = __float_as_uint(f); return (u + 0x7fffu + ((u >> 16) & 1u)) >> 16; }
__device__ __forceinline__ unsigned pk2(float lo, float hi) { return f2bf(lo) | (f2bf(hi) << 16); }
__device__ __forceinline__ float dpp_add(float v, const int ctrl_tag) { return v; }
#define WS_DPP(v, ctrl) ((v) + __builtin_bit_cast(float, __builtin_amdgcn_update_dpp(0, __builtin_bit_cast(int, (v)), (ctrl), 0xf, 0xf, false)))
__device__ __forceinline__ float wave_sum(float v) {
    v = WS_DPP(v, 0xB1);
    v = WS_DPP(v, 0x4E);
    v = WS_DPP(v, 0x141);
    v = WS_DPP(v, 0x140);
    { auto rr = __builtin_amdgcn_permlane16_swap(__float_as_uint(v), __float_as_uint(v), false, false); v = __uint_as_float(rr[0]) + __uint_as_float(rr[1]); }
    { auto rr = __builtin_amdgcn_permlane32_swap(__float_as_uint(v), __float_as_uint(v), false, false); v = __uint_as_float(rr[0]) + __uint_as_float(rr[1]); }
    return v;
}
__device__ __forceinline__ float row16_sum(float v) {
    v = WS_DPP(v, 0xB1); v = WS_DPP(v, 0x4E); v = WS_DPP(v, 0x141); v = WS_DPP(v, 0x140); return v;
}
__device__ __forceinline__ float silu_f(float v) { return v / (1.f + __expf(-v)); }

__global__ void __launch_bounds__(256) k_mod(const float* c, const float* w_ada, const float* b_ada, const float* lq1, const float* lk1, const float* lq2, const float* lk2, float* mod) {
    __shared__ float cond[8][1024];
    const int l = blockIdx.y, j = blockIdx.x * 256 + threadIdx.x;
    for (int i = threadIdx.x; i < 8192; i += 256) { const float v = c[i]; cond[i >> 10][i & 1023] = v / (1.f + expf(-v)); }
    __syncthreads();
    float acc[8];
#pragma unroll
    for (int b = 0; b < 8; ++b) acc[b] = 0.f;
    const float* w = w_ada + (size_t)l * 1024 * MODW + j;
    for (int k = 0; k < 1024; ++k) { const float wv = w[(size_t)k * MODW];
#pragma unroll
        for (int b = 0; b < 8; ++b) acc[b] += cond[b][k] * wv; }
#pragma unroll
    for (int b = 0; b < 8; ++b) mod[(size_t)(l * 8 + b) * MODW + j] = acc[b] + b_ada[l * MODW + j];
    if (blockIdx.x == 0 && threadIdx.x == 0) {
        float s1 = 0.f, s2 = 0.f;
        for (int i = 0; i < 64; ++i) { s1 += lq1[l * 64 + i] * lk1[l * 64 + i]; s2 += lq2[l * 64 + i] * lk2[l * 64 + i]; }
        const float li = 0.8f - 0.6f * expf(-0.3f * (float)l);
        mod[2 * 8 * MODW + l] = expf(s1) - expf(s2) + li;
        mod[2 * 8 * MODW + 2 + l] = li;
    }
}
__global__ void k_rot(float* rot) {
    const int idx = blockIdx.x * 256 + threadIdx.x; if (idx >= 4096 * 32) return;
    const int pos = idx >> 5, i = idx & 31;
    const double inv = pow(10000.0, -(double)(2 * i) / 64.0), a = (double)pos * inv;
    rot[2 * idx] = (float)cos(a); rot[2 * idx + 1] = (float)sin(a);
}

__global__ void __launch_bounds__(256) k_ln_mod(const float* x, const float* modl, int sh_off, bf16* H) {
    const int row = blockIdx.x * 4 + (threadIdx.x >> 6), lane = threadIdx.x & 63, b = row / SEQ;
    const f32x4* xr = (const f32x4*)(x + (size_t)row * DM) + lane;
    f32x4 v[4]; float s = 0.f;
#pragma unroll
    for (int j = 0; j < 4; ++j) { v[j] = xr[64 * j]; s += (v[j].x + v[j].y) + (v[j].z + v[j].w); }
    const float mean = wave_sum(s) * (1.f / DM); float s2 = 0.f;
#pragma unroll
    for (int j = 0; j < 4; ++j) { v[j] = v[j] - mean; s2 += (v[j].x * v[j].x + v[j].y * v[j].y) + (v[j].z * v[j].z + v[j].w * v[j].w); }
    const float rstd = 1.f / sqrtf(wave_sum(s2) * (1.f / DM) + LN_EPS);
    const f32x4* sh = (const f32x4*)(modl + (size_t)b * MODW + sh_off) + lane; const f32x4* sc = sh + 256;
    u32x2* o = (u32x2*)(H + (size_t)row * DM) + lane;
#pragma unroll
    for (int j = 0; j < 4; ++j) { const f32x4 a = sh[64 * j], m = sc[64 * j]; const f32x4 r = v[j] * rstd * (m + 1.f) + a; u32x2 w; w.x = pk2(r.x, r.y); w.y = pk2(r.z, r.w); o[64 * j] = w; }
}

template <bool DUAL>
__device__ __forceinline__ void ngemm_core(const bf16* arow, const float* W0, const float* W1, int ldw, int K, float (&acc0)[8][4], float (&acc1)[8][4], float* As, float* Ws0, float* Ws1) {
    const int tid = threadIdx.x, tx = tid & 15, ty = tid >> 4;
#pragma unroll
    for (int i = 0; i < 8; ++i)
#pragma unroll
        for (int j = 0; j < 4; ++j) { acc0[i][j] = 0.f; acc1[i][j] = 0.f; }
    const int ar = tid >> 1, ak = (tid & 1) * 8, wk = tid >> 4, wn = (tid & 15) * 4;
    for (int k0 = 0; k0 < K; k0 += 16) {
        const u32x4 av = *(const u32x4*)(arow + k0);
        const f32x4 w0 = *(const f32x4*)(W0 + (size_t)(k0 + wk) * ldw + wn);
        f32x4 w1 = {0.f, 0.f, 0.f, 0.f}; if (DUAL) w1 = *(const f32x4*)(W1 + (size_t)(k0 + wk) * ldw + wn);
        __syncthreads();
        As[(ak + 0) * 129 + ar] = __uint_as_float(av.x << 16); As[(ak + 1) * 129 + ar] = __uint_as_float(av.x & 0xffff0000u);
        As[(ak + 2) * 129 + ar] = __uint_as_float(av.y << 16); As[(ak + 3) * 129 + ar] = __uint_as_float(av.y & 0xffff0000u);
        As[(ak + 4) * 129 + ar] = __uint_as_float(av.z << 16); As[(ak + 5) * 129 + ar] = __uint_as_float(av.z & 0xffff0000u);
        As[(ak + 6) * 129 + ar] = __uint_as_float(av.w << 16); As[(ak + 7) * 129 + ar] = __uint_as_float(av.w & 0xffff0000u);
        *(f32x4*)(Ws0 + wk * 64 + wn) = w0; if (DUAL) *(f32x4*)(Ws1 + wk * 64 + wn) = w1;
        __syncthreads();
#pragma unroll
        for (int k = 0; k < 16; ++k) {
            float a[8], b0[4], b1[4];
#pragma unroll
            for (int i = 0; i < 8; ++i) a[i] = As[k * 129 + ty + 16 * i];
#pragma unroll
            for (int j = 0; j < 4; ++j) { b0[j] = Ws0[k * 64 + tx + 16 * j]; if (DUAL) b1[j] = Ws1[k * 64 + tx + 16 * j]; }
#pragma unroll
            for (int i = 0; i < 8; ++i)
#pragma unroll
                for (int j = 0; j < 4; ++j) { acc0[i][j] += a[i] * b0[j]; if (DUAL) acc1[i][j] += a[i] * b1[j]; }
        }
    }
}

__global__ void __launch_bounds__(256) k_ngemm_inproj(const bf16* H, const float* Win, const float* rot, bf16* PROJ) {
    __shared__ float As[16 * 129], Ws0[16 * 64];
    const int tid = threadIdx.x, tx = tid & 15, ty = tid >> 4, col0 = blockIdx.x * 64, row0 = blockIdx.y * 128;
    float acc[8][4], dummy[8][4];
    ngemm_core<false>(H + (size_t)(row0 + (tid >> 1)) * DM + (tid & 1) * 8, Win + col0, nullptr, INW, DM, acc, dummy, As, Ws0, nullptr);
    const int region = col0 / 512;
#pragma unroll
    for (int i = 0; i < 8; ++i) {
        const int row = row0 + ty + 16 * i, pos = row % SEQ; bf16* o = PROJ + (size_t)row * INW + col0;
        if (region < 2) {
            const float sc = region == 0 ? 0.125f : 1.f;
#pragma unroll
            for (int j = 0; j < 2; ++j) { const int ic = tx + 16 * j; const float cs = rot[(pos * 32 + ic) * 2], sn = rot[(pos * 32 + ic) * 2 + 1];
                const float x1 = acc[i][j], x2 = acc[i][j + 2]; o[ic] = (bf16)f2bf((x1 * cs - x2 * sn) * sc); o[ic + 32] = (bf16)f2bf((x1 * sn + x2 * cs) * sc); }
        } else {
#pragma unroll
            for (int j = 0; j < 4; ++j) { float v = acc[i][j]; if (region == 3) v = silu_f(v); if (region == 4) v *= C2; o[tx + 16 * j] = (bf16)f2bf(v); }
        }
    }
}
__global__ void __launch_bounds__(256) k_ngemm_plain(const bf16* A, int lda, const float* W, int ldw, int K, bf16* C, int ldc) {
    __shared__ float As[16 * 129], Ws0[16 * 64];
    const int tid = threadIdx.x, tx = tid & 15, ty = tid >> 4, col0 = blockIdx.x * 64, row0 = blockIdx.y * 128;
    float acc[8][4], dummy[8][4];
    ngemm_core<false>(A + (size_t)(row0 + (tid >> 1)) * lda + (tid & 1) * 8, W + col0, nullptr, ldw, K, acc, dummy, As, Ws0, nullptr);
#pragma unroll
    for (int i = 0; i < 8; ++i)
#pragma unroll
        for (int j = 0; j < 4; ++j) C[(size_t)(row0 + ty + 16 * i) * ldc + col0 + tx + 16 * j] = (bf16)f2bf(acc[i][j]);
}

__global__ void __launch_bounds__(256) k_nret(const bf16* PROJ, bf16* CAT) {
    __shared__ float Qs[64 * 65], Ks[64 * 65], Vs[64 * 64], st[128]; float* Ss = Ks;
    const int tid = threadIdx.x, tx = tid & 15, ty = tid >> 4;
    const int qt = (gridDim.x - 1) - blockIdx.x, h = blockIdx.y, b = blockIdx.z, q0 = qt * 64;
    const float log_g = logf(1.f - exp2f(-5.f - (float)h));
    const bf16* base = PROJ + (size_t)b * SEQ * INW;
    for (int i = tid; i < 64 * 64; i += 256) { const int r = i >> 6, d = i & 63; Qs[r * 65 + d] = bf2f(base[(size_t)(q0 + r) * INW + C_RQ + h * 64 + d]); }
    float o[4][4];
#pragma unroll
    for (int i = 0; i < 4; ++i)
#pragma unroll
        for (int j = 0; j < 4; ++j) o[i][j] = 0.f;
    for (int kt = 0; kt <= qt; ++kt) {
        const int k0 = kt * 64;
        __syncthreads();
        for (int i = tid; i < 64 * 64; i += 256) { const int r = i >> 6, d = i & 63; Ks[r * 65 + d] = bf2f(base[(size_t)(k0 + r) * INW + C_RK + h * 64 + d]); Vs[r * 64 + d] = bf2f(base[(size_t)(k0 + r) * INW + C_RV + h * 64 + d]); }
        __syncthreads();
        float s[4][4];
#pragma unroll
        for (int i = 0; i < 4; ++i)
#pragma unroll
            for (int j = 0; j < 4; ++j) s[i][j] = 0.f;
        for (int d = 0; d < 64; ++d) { float a[4], k[4];
#pragma unroll
            for (int i = 0; i < 4; ++i) { a[i] = Qs[(ty + 16 * i) * 65 + d]; k[i] = Ks[(tx + 16 * i) * 65 + d]; }
#pragma unroll
            for (int i = 0; i < 4; ++i)
#pragma unroll
                for (int j = 0; j < 4; ++j) s[i][j] += a[i] * k[j]; }
        __syncthreads();
#pragma unroll
        for (int i = 0; i < 4; ++i)
#pragma unroll
            for (int j = 0; j < 4; ++j) { const int t = q0 + ty + 16 * i, m = k0 + tx + 16 * j; Ss[(ty + 16 * i) * 65 + tx + 16 * j] = (m <= t) ? s[i][j] * expf(log_g * (float)(t - m)) : 0.f; }
        __syncthreads();
        for (int m = 0; m < 64; ++m) { float p[4], v[4];
#pragma unroll
            for (int i = 0; i < 4; ++i) { p[i] = Ss[(ty + 16 * i) * 65 + m]; v[i] = Vs[m * 64 + tx + 16 * i]; }
#pragma unroll
            for (int i = 0; i < 4; ++i)
#pragma unroll
                for (int j = 0; j < 4; ++j) o[i][j] += p[i] * v[j]; }
    }
    __syncthreads();
#pragma unroll
    for (int i = 0; i < 4; ++i)
#pragma unroll
        for (int j = 0; j < 4; ++j) Ss[(ty + 16 * i) * 65 + tx + 16 * j] = o[i][j];
    __syncthreads();
    if (tid < 64) { float s = 0.f; for (int d = 0; d < 64; ++d) s += Ss[tid * 65 + d]; const float mean = s * (1.f / 64.f); float q = 0.f; for (int d = 0; d < 64; ++d) { const float e = Ss[tid * 65 + d] - mean; q += e * e; }
        st[tid] = mean; st[64 + tid] = 1.f / sqrtf(q * (1.f / 64.f) + LN_EPS); }
    __syncthreads();
#pragma unroll
    for (int i = 0; i < 4; ++i)
#pragma unroll
        for (int j = 0; j < 4; ++j) { const int r = ty + 16 * i, cc = tx + 16 * j; const size_t row = (size_t)b * SEQ + q0 + r;
            const float g = bf2f(PROJ[row * INW + C_RG + h * 64 + cc]);
            CAT[row * DM + h * 64 + cc] = (bf16)f2bf((o[i][j] - st[r]) * st[64 + r] * g); }
}

__global__ void __launch_bounds__(256) k_ndiff(const bf16* PROJ, const float* modx  , const float* subln, int l, bf16* CAT) {
    __shared__ float Qs[64 * 65], Ks[32 * 65], Vs[32 * 128], Ps[64 * 33], mrow[64], lrow[64], srow[64];
    const int tid = threadIdx.x, tx = tid & 15, ty = tid >> 4;
    const int qt = (gridDim.x - 1) - blockIdx.x, h = blockIdx.y, b = blockIdx.z, q0 = qt * 64;
    const float lam = modx[l], li = modx[2 + l];
    const bf16* base = PROJ + (size_t)b * SEQ * INW;
    float res[4][8];
    for (int c = 0; c < 2; ++c) {
        __syncthreads();
        for (int i = tid; i < 64 * 64; i += 256) { const int r = i >> 6, d = i & 63; Qs[r * 65 + d] = bf2f(base[(size_t)(q0 + r) * INW + C_DQ + h * 128 + c * 64 + d]); }
        if (tid < 64) { mrow[tid] = -INFINITY; lrow[tid] = 0.f; }
        float o[4][8];
#pragma unroll
        for (int i = 0; i < 4; ++i)
#pragma unroll
            for (int j = 0; j < 8; ++j) o[i][j] = 0.f;
        const int nkt = (q0 + 64) / 32;
        for (int kt = 0; kt < nkt; ++kt) {
            const int k0 = kt * 32;
            __syncthreads();
            for (int i = tid; i < 32 * 64; i += 256) { const int r = i >> 6, d = i & 63; Ks[r * 65 + d] = bf2f(base[(size_t)(k0 + r) * INW + C_DK + h * 128 + c * 64 + d]); }
            for (int i = tid; i < 32 * 128; i += 256) { const int r = i >> 7, d = i & 127; Vs[r * 128 + d] = bf2f(base[(size_t)(k0 + r) * INW + C_DV + h * 128 + d]); }
            __syncthreads();
            float s[4][2];
#pragma unroll
            for (int i = 0; i < 4; ++i) { s[i][0] = 0.f; s[i][1] = 0.f; }
            for (int d = 0; d < 64; ++d) { float a[4], k[2];
#pragma unroll
                for (int i = 0; i < 4; ++i) a[i] = Qs[(ty + 16 * i) * 65 + d];
                k[0] = Ks[tx * 65 + d]; k[1] = Ks[(tx + 16) * 65 + d];
#pragma unroll
                for (int i = 0; i < 4; ++i) { s[i][0] += a[i] * k[0]; s[i][1] += a[i] * k[1]; } }
#pragma unroll
            for (int i = 0; i < 4; ++i)
#pragma unroll
                for (int j = 0; j < 2; ++j) { const int t = q0 + ty + 16 * i, m = k0 + tx + 16 * j; Ps[(ty + 16 * i) * 33 + tx + 16 * j] = (m <= t) ? s[i][j] : -INFINITY; }
            __syncthreads();
            if (tid < 64) { float mx = mrow[tid]; for (int m = 0; m < 32; ++m) mx = fmaxf(mx, Ps[tid * 33 + m]);
                const float sc = exp2f(mrow[tid] - mx); float sum = 0.f;
                for (int m = 0; m < 32; ++m) { const float p = exp2f(Ps[tid * 33 + m] - mx); Ps[tid * 33 + m] = p; sum += p; }
                lrow[tid] = lrow[tid] * sc + sum; mrow[tid] = mx; srow[tid] = sc; }
            __syncthreads();
#pragma unroll
            for (int i = 0; i < 4; ++i) { const float sc = srow[ty + 16 * i];
#pragma unroll
                for (int j = 0; j < 8; ++j) o[i][j] *= sc; }
            for (int m = 0; m < 32; ++m) { float p[4], v[8];
#pragma unroll
                for (int i = 0; i < 4; ++i) p[i] = Ps[(ty + 16 * i) * 33 + m];
#pragma unroll
                for (int j = 0; j < 8; ++j) v[j] = Vs[m * 128 + tx + 16 * j];
#pragma unroll
                for (int i = 0; i < 4; ++i)
#pragma unroll
                    for (int j = 0; j < 8; ++j) o[i][j] += p[i] * v[j]; }
        }
        __syncthreads();
#pragma unroll
        for (int i = 0; i < 4; ++i) { const float inv = 1.f / lrow[ty + 16 * i];
#pragma unroll
            for (int j = 0; j < 8; ++j) { if (c == 0) res[i][j] = o[i][j] * inv; else res[i][j] -= lam * o[i][j] * inv; } }
    }
    __syncthreads();
#pragma unroll
    for (int i = 0; i < 4; ++i) { float q = 0.f;
#pragma unroll
        for (int j = 0; j < 8; ++j) q += res[i][j] * res[i][j];
        Ps[(ty + 16 * i) * 33 + tx] = q; }
    __syncthreads();
    if (tid < 64) { float q = 0.f; for (int m = 0; m < 16; ++m) q += Ps[tid * 33 + m]; srow[tid] = 1.f / sqrtf(q * (1.f / 128.f) + LN_EPS); }
    __syncthreads();
#pragma unroll
    for (int i = 0; i < 4; ++i)
#pragma unroll
        for (int j = 0; j < 8; ++j) { const int r = ty + 16 * i, cc = tx + 16 * j; const size_t row = (size_t)b * SEQ + q0 + r;
            CAT[row * DM + 512 + h * 128 + cc] = (bf16)f2bf(res[i][j] * srow[r] * subln[l * 128 + cc] * (1.f - li)); }
}

__global__ void __launch_bounds__(256) k_post_mix(const float* xin, const bf16* MIXED, const float* modl, const float* lng, const float* lnb, const float* rw, const float* rb,
                                                  bf16* X1, bf16* H, int* tok_e, float* tok_g, int* tok_slot, int* lists, int* cnt) {
    const int row = blockIdx.x * 4 + (threadIdx.x >> 6), lane = threadIdx.x & 63, b = row / SEQ;
    const f32x4* xr = (const f32x4*)(xin + (size_t)row * DM) + lane; const u32x2* mr = (const u32x2*)(MIXED + (size_t)row * DM) + lane;
    const f32x4* g1 = (const f32x4*)(modl + (size_t)b * MODW + 2 * DM) + lane; const f32x4* sh2 = g1 + 256; const f32x4* sc2 = g1 + 512;
    f32x4 v[4]; float s = 0.f;
#pragma unroll
    for (int j = 0; j < 4; ++j) { const f32x4 x = xr[64 * j], g = g1[64 * j]; const u32x2 m = mr[64 * j];
        f32x4 mv; mv.x = __uint_as_float(m.x << 16); mv.y = __uint_as_float(m.x & 0xffff0000u); mv.z = __uint_as_float(m.y << 16); mv.w = __uint_as_float(m.y & 0xffff0000u);
        v[j] = x * ALPHA + g * mv; s += (v[j].x + v[j].y) + (v[j].z + v[j].w); }
    float mean = wave_sum(s) * (1.f / DM), s2 = 0.f;
#pragma unroll
    for (int j = 0; j < 4; ++j) { v[j] = v[j] - mean; s2 += (v[j].x * v[j].x + v[j].y * v[j].y) + (v[j].z * v[j].z + v[j].w * v[j].w); }
    float rstd = 1.f / sqrtf(wave_sum(s2) * (1.f / DM) + LN_EPS);
    u32x2* xo = (u32x2*)(X1 + (size_t)row * DM) + lane; s = 0.f;
#pragma unroll
    for (int j = 0; j < 4; ++j) { const f32x4 g = ((const f32x4*)lng)[lane + 64 * j], bb = ((const f32x4*)lnb)[lane + 64 * j]; v[j] = v[j] * rstd * g + bb;
        u32x2 w; w.x = pk2(v[j].x, v[j].y); w.y = pk2(v[j].z, v[j].w); xo[64 * j] = w; s += (v[j].x + v[j].y) + (v[j].z + v[j].w); }
    mean = wave_sum(s) * (1.f / DM); s2 = 0.f;
#pragma unroll
    for (int j = 0; j < 4; ++j) { v[j] = v[j] - mean; s2 += (v[j].x * v[j].x + v[j].y * v[j].y) + (v[j].z * v[j].z + v[j].w * v[j].w); }
    rstd = 1.f / sqrtf(wave_sum(s2) * (1.f / DM) + LN_EPS);
    u32x2* ho = (u32x2*)(H + (size_t)row * DM) + lane;
    float lg[16];
#pragma unroll
    for (int e = 0; e < 16; ++e) lg[e] = 0.f;
#pragma unroll
    for (int j = 0; j < 4; ++j) { const f32x4 a = sh2[64 * j], m = sc2[64 * j]; v[j] = v[j] * rstd * (m + 1.f) + a;
        u32x2 w; w.x = pk2(v[j].x, v[j].y); w.y = pk2(v[j].z, v[j].w); ho[64 * j] = w;
        const f32x4* wr = (const f32x4*)(rw + (size_t)(4 * lane + 256 * j) * 16);
#pragma unroll
        for (int q = 0; q < 4; ++q) { const float hv = q == 0 ? v[j].x : q == 1 ? v[j].y : q == 2 ? v[j].z : v[j].w;
#pragma unroll
            for (int e4 = 0; e4 < 4; ++e4) { const f32x4 w4 = wr[q * 4 + e4]; lg[e4 * 4 + 0] += hv * w4.x; lg[e4 * 4 + 1] += hv * w4.y; lg[e4 * 4 + 2] += hv * w4.z; lg[e4 * 4 + 3] += hv * w4.w; } } }
    float mx = -INFINITY;
#pragma unroll
    for (int e = 0; e < 16; ++e) { lg[e] = wave_sum(lg[e]) + rb[e]; mx = fmaxf(mx, lg[e]); }
    float p[16], sum = 0.f;
#pragma unroll
    for (int e = 0; e < 16; ++e) { p[e] = expf(lg[e] - mx); sum += p[e]; }
    const float rs = 1.f / sum;
#pragma unroll
    for (int e = 0; e < 16; ++e) p[e] *= rs;
    int bg = 0; float bgs = -1.f;
#pragma unroll
    for (int g = 0; g < 4; ++g) { float m1 = p[4 * g]; int i1 = 0;
#pragma unroll
        for (int i = 1; i < 4; ++i) if (p[4 * g + i] > m1) { m1 = p[4 * g + i]; i1 = i; }
        float m2 = -1.f;
#pragma unroll
        for (int i = 0; i < 4; ++i) if (i != i1 && p[4 * g + i] > m2) m2 = p[4 * g + i];
        const float gs = m1 + m2; if (gs > bgs) { bgs = gs; bg = g; } }
    float q0 = 0.f, q1 = 0.f, q2 = 0.f, q3 = 0.f;
#pragma unroll
    for (int g = 0; g < 4; ++g) if (bg == g) { q0 = p[4 * g]; q1 = p[4 * g + 1]; q2 = p[4 * g + 2]; q3 = p[4 * g + 3]; }
    float m1 = q0; int i1 = 0; if (q1 > m1) { m1 = q1; i1 = 1; } if (q2 > m1) { m1 = q2; i1 = 2; } if (q3 > m1) { m1 = q3; i1 = 3; }
    float m2 = -1.f; int i2 = 0;
    if (i1 != 0 && q0 > m2) { m2 = q0; i2 = 0; } if (i1 != 1 && q1 > m2) { m2 = q1; i2 = 1; } if (i1 != 2 && q2 > m2) { m2 = q2; i2 = 2; } if (i1 != 3 && q3 > m2) { m2 = q3; i2 = 3; }
    if (lane == 0) {
        const int e1 = bg * 4 + i1, e2 = bg * 4 + i2; const float den = 1.f / (m1 + m2);
        const int s1 = atomicAdd(cnt + e1, 1), s2_ = atomicAdd(cnt + e2, 1);
        lists[(size_t)e1 * T + s1] = row; lists[(size_t)e2 * T + s2_] = row;
        tok_e[2 * row] = e1; tok_e[2 * row + 1] = e2; tok_g[2 * row] = m1 * den; tok_g[2 * row + 1] = m2 * den; tok_slot[2 * row] = s1; tok_slot[2 * row + 1] = s2_;
    }
}

__device__ __forceinline__ int expert_base(const int* cnt, int e) { int bs = 0; for (int i = 0; i < 16; ++i) if (i < e) bs += (cnt[i] + 255) & ~255; return bs; }
__global__ void __launch_bounds__(256) k_moe1(const bf16* H, const float* wg, const float* wu, const int* cnt, const int* lists, bf16* HE) {
    __shared__ float As[16 * 129], Ws0[16 * 64], Ws1[16 * 64];
    const int e = blockIdx.z, rt = blockIdx.y, ct = blockIdx.x, n = cnt[e]; if (rt * 128 >= n) return;
    const int tid = threadIdx.x, tx = tid & 15, ty = tid >> 4, base = expert_base(cnt, e);
    const int sl = rt * 128 + (tid >> 1), tok = lists[(size_t)e * T + (sl < n ? sl : 0)];
    float g[8][4], u[8][4];
    ngemm_core<true>(H + (size_t)tok * DM + (tid & 1) * 8, wg + (size_t)e * DM * DE + ct * 64, wu + (size_t)e * DM * DE + ct * 64, DE, DM, g, u, As, Ws0, Ws1);
#pragma unroll
    for (int i = 0; i < 8; ++i) { const int s = rt * 128 + ty + 16 * i; if (s < n) {
#pragma unroll
        for (int j = 0; j < 4; ++j) HE[(size_t)(base + s) * DE + ct * 64 + tx + 16 * j] = (bf16)f2bf(silu_f(g[i][j]) * u[i][j]); } }
}
__global__ void __launch_bounds__(256) k_moe2(const bf16* HE, const float* wd, const int* cnt, bf16* YP) {
    __shared__ float As[16 * 129], Ws0[16 * 64];
    const int e = blockIdx.z, rt = blockIdx.y, ct = blockIdx.x, n = cnt[e]; if (rt * 128 >= n) return;
    const int tid = threadIdx.x, tx = tid & 15, ty = tid >> 4, base = expert_base(cnt, e);
    const int sl = rt * 128 + (tid >> 1);
    float acc[8][4], dummy[8][4];
    ngemm_core<false>(HE + (size_t)(base + (sl < n ? sl : 0)) * DE + (tid & 1) * 8, wd + (size_t)e * DE * DM + ct * 64, nullptr, DM, DE, acc, dummy, As, Ws0, nullptr);
#pragma unroll
    for (int i = 0; i < 8; ++i) { const int s = rt * 128 + ty + 16 * i; if (s < n) {
#pragma unroll
        for (int j = 0; j < 4; ++j) YP[(size_t)(base + s) * DM + ct * 64 + tx + 16 * j] = (bf16)f2bf(acc[i][j]); } }
}

__global__ void __launch_bounds__(256) k_post_ffn(const bf16* X1, const bf16* YP, const float* modl, const float* lng, const float* lnb, const int* tok_e, const float* tok_g, const int* tok_slot, const int* cnt,
                                                  float* out, const float* modn, bf16* H) {
    const int row = blockIdx.x * 4 + (threadIdx.x >> 6), lane = threadIdx.x & 63, b = row / SEQ;
    const int e0 = tok_e[2 * row], e1 = tok_e[2 * row + 1]; const float w0 = tok_g[2 * row], w1 = tok_g[2 * row + 1];
    const size_t r0 = (size_t)expert_base(cnt, e0) + tok_slot[2 * row], r1 = (size_t)expert_base(cnt, e1) + tok_slot[2 * row + 1];
    const u32x2* xr = (const u32x2*)(X1 + (size_t)row * DM) + lane; const u32x2* y0 = (const u32x2*)(YP + r0 * DM) + lane; const u32x2* y1 = (const u32x2*)(YP + r1 * DM) + lane;
    const f32x4* g2 = (const f32x4*)(modl + (size_t)b * MODW + 5 * DM) + lane;
    f32x4 v[4]; float s = 0.f;
#pragma unroll
    for (int j = 0; j < 4; ++j) { const u32x2 x = xr[64 * j], a = y0[64 * j], c = y1[64 * j]; const f32x4 g = g2[64 * j];
        f32x4 xv, av, cv; xv.x = __uint_as_float(x.x << 16); xv.y = __uint_as_float(x.x & 0xffff0000u); xv.z = __uint_as_float(x.y << 16); xv.w = __uint_as_float(x.y & 0xffff0000u);
        av.x = __uint_as_float(a.x << 16); av.y = __uint_as_float(a.x & 0xffff0000u); av.z = __uint_as_float(a.y << 16); av.w = __uint_as_float(a.y & 0xffff0000u);
        cv.x = __uint_as_float(c.x << 16); cv.y = __uint_as_float(c.x & 0xffff0000u); cv.z = __uint_as_float(c.y << 16); cv.w = __uint_as_float(c.y & 0xffff0000u);
        v[j] = xv * ALPHA + g * (av * w0 + cv * w1); s += (v[j].x + v[j].y) + (v[j].z + v[j].w); }
    float mean = wave_sum(s) * (1.f / DM), s2 = 0.f;
#pragma unroll
    for (int j = 0; j < 4; ++j) { v[j] = v[j] - mean; s2 += (v[j].x * v[j].x + v[j].y * v[j].y) + (v[j].z * v[j].z + v[j].w * v[j].w); }
    float rstd = 1.f / sqrtf(wave_sum(s2) * (1.f / DM) + LN_EPS);
    f32x4* o = (f32x4*)(out + (size_t)row * DM) + lane; s = 0.f;
#pragma unroll
    for (int j = 0; j < 4; ++j) { const f32x4 g = ((const f32x4*)lng)[lane + 64 * j], bb = ((const f32x4*)lnb)[lane + 64 * j]; v[j] = v[j] * rstd * g + bb; o[64 * j] = v[j]; s += (v[j].x + v[j].y) + (v[j].z + v[j].w); }
    if (modn) {
        mean = wave_sum(s) * (1.f / DM); s2 = 0.f;
#pragma unroll
        for (int j = 0; j < 4; ++j) { v[j] = v[j] - mean; s2 += (v[j].x * v[j].x + v[j].y * v[j].y) + (v[j].z * v[j].z + v[j].w * v[j].w); }
        rstd = 1.f / sqrtf(wave_sum(s2) * (1.f / DM) + LN_EPS);
        const f32x4* sh = (const f32x4*)(modn + (size_t)b * MODW) + lane; const f32x4* sc = sh + 256; u32x2* ho = (u32x2*)(H + (size_t)row * DM) + lane;
#pragma unroll
        for (int j = 0; j < 4; ++j) { const f32x4 a = sh[64 * j], m = sc[64 * j]; const f32x4 r = v[j] * rstd * (m + 1.f) + a; u32x2 w; w.x = pk2(r.x, r.y); w.y = pk2(r.z, r.w); ho[64 * j] = w; }
    }
}

#include <hip/hip_bf16.h>
#ifndef RET_FAST
#define RET_FAST 1
#endif
#ifndef ATTN128
#define ATTN128 1
#endif
#ifndef ATTN_THRL
#define ATTN_THRL 8
#endif
#define LAS __attribute__((address_space(3)))
#define GAS __attribute__((address_space(1)))
typedef short bf16x8 __attribute__((ext_vector_type(8)));
typedef GAS unsigned gu32;
#define RLX_AGENT __ATOMIC_RELAXED, __HIP_MEMORY_SCOPE_AGENT
#define LDS_WAIT() asm volatile("s_waitcnt lgkmcnt(0)" ::: "memory")
#define VM_WAIT() asm volatile("s_waitcnt vmcnt(0)" ::: "memory")

constexpr size_t WL_IN = 0, WL_OUT = (size_t)INW * DM, WL_GU = WL_OUT + (size_t)DM * DM, WL_D = WL_GU + (size_t)NE * 1024 * DM, WL_STRIDE = WL_D + (size_t)NE * DM * DE;
static_assert(WL_STRIDE * 2 * 2 <= 114 * MiB, "weights fit");

namespace pg8 {
constexpr int BM = 256, BK = 64, HALF = 128, HTB = HALF * BK * 2, STAGE_BYTES = 8 * HTB, NXCD = 8, WGM = 8;
__host__ __device__ __forceinline__ int lds_byte(int r, int c) { const int st = (r >> 4) * 2 + (c >> 5), rr = r & 15, cc = c & 31, ob = rr * 64 + cc * 2; return st * 1024 + (ob ^ (((ob >> 9) & 1) << 5)); }
__host__ __device__ __forceinline__ void stage_rc(int b, int& R, int& C) { const int st = b / 1024, sb = b % 1024, swz = sb ^ (((sb >> 9) & 1) << 5); R = (st >> 1) * 16 + swz / 64; C = (st & 1) * 32 + (swz % 64) / 2; }
__host__ __device__ __forceinline__ int perm32(int rho) { const int n = rho >> 4, i = rho & 15; return 8 * (i >> 2) + 4 * n + (i & 3); }
struct Unit { int pm, pn; };

struct OrderBase {
    int nM, nN, nwg, G, c;
    __device__ __forceinline__ void init(int nM_, int nN_, int G_, int c_) { nM = nM_; nN = nN_; nwg = nM * nN; G = G_; c = c_; }
    __device__ __forceinline__ bool next(int i, Unit& u) const {
        const long L = (long)i * G + c; if (L >= nwg) return false;
        int wgid = (int)L; { const int q = nwg / NXCD, r = nwg % NXCD, xcd = wgid % NXCD, off = wgid / NXCD; wgid = (xcd < r ? xcd * (q + 1) : r * (q + 1) + (xcd - r) * q) + off; }
        const int nig = WGM * nN, gid = wgid / nig, fm = gid * WGM, gsz = (nM - fm) < WGM ? (nM - fm) : WGM;
        u.pm = fm + ((wgid % nig) % gsz); u.pn = (wgid % nig) / gsz; return true;
    }
    __device__ __forceinline__ void a_ready(const Unit&) const {}
    __device__ __forceinline__ void done(const Unit&) const {}
};
struct PlainSched : OrderBase {
    const bf16* Bt; int K;
    __device__ __forceinline__ void setup(const Unit& u, const int (&Rl)[2], const int (&Cb)[2], unsigned (&off)[2][2], const char*& bptr) const {
#pragma unroll
        for (int h = 0; h < 2; ++h)
#pragma unroll
            for (int i = 0; i < 2; ++i) off[h][i] = (unsigned)((u.pm * 256 + h * 128 + Rl[i]) * K * 2 + Cb[i]);
        bptr = (const char*)Bt + (size_t)u.pn * 256 * K * 2;
    }
};
struct MoeSched : OrderBase {
    const bf16* Bt; int K; const LAS int* tab; const int* cnt; const int* lists; bool gather;
    __device__ __forceinline__ void setup(const Unit& u, const int (&Rl)[2], const int (&Cb)[2], unsigned (&off)[2][2], const char*& bptr) const {
        const int te = tab[1 + u.pm], e = te & 255, s0 = (te >> 8) * 256;
        if (gather) { const int n = cnt[e];
#pragma unroll
            for (int h = 0; h < 2; ++h)
#pragma unroll
                for (int i = 0; i < 2; ++i) { const int s = s0 + h * 128 + Rl[i]; const int tok = lists[(size_t)e * T + (s < n ? s : 0)]; off[h][i] = (unsigned)(tok * K * 2 + Cb[i]); }
        } else {
#pragma unroll
            for (int h = 0; h < 2; ++h)
#pragma unroll
                for (int i = 0; i < 2; ++i) off[h][i] = (unsigned)((u.pm * 256 + h * 128 + Rl[i]) * K * 2 + Cb[i]);
        }
        bptr = (const char*)Bt + (size_t)(e * 4 + u.pn) * 256 * K * 2;
    }
};

__device__ __forceinline__ unsigned cvt_pk_bf16(float lo, float hi) { unsigned r; asm volatile("v_cvt_pk_bf16_f32 %0, %1, %2" : "=v"(r) : "v"(lo), "v"(hi)); return r; }
__device__ __forceinline__ float fsilu(float v) { return v * __builtin_amdgcn_rcpf(1.f + __expf(-v)); }

struct EpiInProj {
    static constexpr bool PERM = true, AFTER_DRAIN = false;
    bf16* P; const float* rot; const float* dtab;
    __device__ __forceinline__ void operator()(const f32x4 (&acc)[2][2][4][2], const Unit& u, int wr, int wc, int fr, int fq) const {
        const int row0 = u.pm * BM + wr * 64 + fr;
        if (u.pn < 4) {
            const float sc0 = u.pn < 2 ? 0.125f : 1.f; const float* dt = dtab ? dtab + (u.pn >> 1) * 1024 + ((u.pn & 1) * 4 + wc) * 128 : nullptr;
#pragma unroll
            for (int ai = 0; ai < 2; ++ai) {
                f32x4 tt[4][4]; float scv[4];
#pragma unroll
                for (int m = 0; m < 4; ++m) { const int pos = (row0 + ai * HALF + m * 16) & (SEQ - 1); const f32x4* rt = (const f32x4*)(rot + (size_t)(pos * 32 + 8 * fq) * 2);
                    tt[m][0] = rt[0]; tt[m][1] = rt[1]; tt[m][2] = rt[2]; tt[m][3] = rt[3]; scv[m] = dt ? dt[pos & 127] : sc0; }
#pragma unroll
                for (int m = 0; m < 4; ++m) { const int row = row0 + ai * HALF + m * 16; const float sc = scv[m];
                    const f32x4 t0 = tt[m][0], t1 = tt[m][1], t2 = tt[m][2], t3 = tt[m][3];
                    const f32x4 xa = acc[ai][0][m][0], xb = acc[ai][0][m][1], ya = acc[ai][1][m][0], yb = acc[ai][1][m][1];
                    u32x4 w1, w2;
                    w1.x = cvt_pk_bf16((xa[0] * t0.x - ya[0] * t0.y) * sc, (xa[1] * t0.z - ya[1] * t0.w) * sc); w1.y = cvt_pk_bf16((xa[2] * t1.x - ya[2] * t1.y) * sc, (xa[3] * t1.z - ya[3] * t1.w) * sc);
                    w1.z = cvt_pk_bf16((xb[0] * t2.x - yb[0] * t2.y) * sc, (xb[1] * t2.z - yb[1] * t2.w) * sc); w1.w = cvt_pk_bf16((xb[2] * t3.x - yb[2] * t3.y) * sc, (xb[3] * t3.z - yb[3] * t3.w) * sc);
                    w2.x = cvt_pk_bf16((xa[0] * t0.y + ya[0] * t0.x) * sc, (xa[1] * t0.w + ya[1] * t0.z) * sc); w2.y = cvt_pk_bf16((xa[2] * t1.y + ya[2] * t1.x) * sc, (xa[3] * t1.w + ya[3] * t1.z) * sc);
                    w2.z = cvt_pk_bf16((xb[0] * t2.y + yb[0] * t2.x) * sc, (xb[1] * t2.w + yb[1] * t2.z) * sc); w2.w = cvt_pk_bf16((xb[2] * t3.y + yb[2] * t3.x) * sc, (xb[3] * t3.w + yb[3] * t3.z) * sc);
                    bf16* o = P + (size_t)row * INW + u.pn * BM + 64 * wc + 8 * fq;
                    *(u32x4*)o = w1; *(u32x4*)(o + 32) = w2; }
            }
        } else {
            const int region = u.pn >> 1;
#pragma unroll
            for (int ai = 0; ai < 2; ++ai)
#pragma unroll
                for (int m = 0; m < 4; ++m) { bf16* o = P + (size_t)(row0 + ai * HALF + m * 16) * INW + u.pn * BM + wc * 32 + 8 * fq;
#pragma unroll
                    for (int bj = 0; bj < 2; ++bj) { f32x4 v0 = acc[ai][bj][m][0], v1 = acc[ai][bj][m][1];
                        if (region == 3) { v0[0] = fsilu(v0[0]); v0[1] = fsilu(v0[1]); v0[2] = fsilu(v0[2]); v0[3] = fsilu(v0[3]); v1[0] = fsilu(v1[0]); v1[1] = fsilu(v1[1]); v1[2] = fsilu(v1[2]); v1[3] = fsilu(v1[3]); }
                        if (region == 4) { v0 = v0 * C2; v1 = v1 * C2; }
                        u32x4 w; w.x = cvt_pk_bf16(v0[0], v0[1]); w.y = cvt_pk_bf16(v0[2], v0[3]); w.z = cvt_pk_bf16(v1[0], v1[1]); w.w = cvt_pk_bf16(v1[2], v1[3]);
                        *(u32x4*)(o + bj * HALF) = w; } }
        }
    }
};
struct EpiPlain {
    static constexpr bool PERM = true, AFTER_DRAIN = false;
    bf16* O; int ldc;
    __device__ __forceinline__ void operator()(const f32x4 (&acc)[2][2][4][2], const Unit& u, int wr, int wc, int fr, int fq) const {
        const int row0 = u.pm * BM + wr * 64 + fr, col0 = u.pn * BM + wc * 32 + 8 * fq;
#pragma unroll
        for (int ai = 0; ai < 2; ++ai)
#pragma unroll
            for (int m = 0; m < 4; ++m) { bf16* o = O + (size_t)(row0 + ai * HALF + m * 16) * ldc + col0;
#pragma unroll
                for (int bj = 0; bj < 2; ++bj) { const f32x4 v0 = acc[ai][bj][m][0], v1 = acc[ai][bj][m][1];
                    u32x4 w; w.x = cvt_pk_bf16(v0[0], v0[1]); w.y = cvt_pk_bf16(v0[2], v0[3]); w.z = cvt_pk_bf16(v1[0], v1[1]); w.w = cvt_pk_bf16(v1[2], v1[3]);
                    *(u32x4*)(o + bj * HALF) = w; } }
    }
};
struct EpiGateUp {
    static constexpr bool PERM = true, AFTER_DRAIN = false;
    bf16* HE;
    __device__ __forceinline__ void operator()(const f32x4 (&acc)[2][2][4][2], const Unit& u, int wr, int wc, int fr, int fq) const {
        const int row0 = u.pm * BM + wr * 64 + fr, col0 = u.pn * 128 + wc * 32 + 8 * fq;
#pragma unroll
        for (int ai = 0; ai < 2; ++ai)
#pragma unroll
            for (int m = 0; m < 4; ++m) { const f32x4 g0 = acc[ai][0][m][0], g1 = acc[ai][0][m][1], u0 = acc[ai][1][m][0], u1 = acc[ai][1][m][1];
                u32x4 w; w.x = cvt_pk_bf16(fsilu(g0[0]) * u0[0], fsilu(g0[1]) * u0[1]); w.y = cvt_pk_bf16(fsilu(g0[2]) * u0[2], fsilu(g0[3]) * u0[3]);
                w.z = cvt_pk_bf16(fsilu(g1[0]) * u1[0], fsilu(g1[1]) * u1[1]); w.w = cvt_pk_bf16(fsilu(g1[2]) * u1[2], fsilu(g1[3]) * u1[3]);
                *(u32x4*)(HE + (size_t)(row0 + ai * HALF + m * 16) * DE + col0) = w; }
    }
};

template <class Epi, class Sched, bool ALIGN_EPI>
__device__ __forceinline__ void gemm_phase(LAS unsigned char* lds, const char* gA, int K, const Sched& S, const Epi& E) {
    int tid_ = threadIdx.x; asm volatile("" : "+v"(tid_));
    const int tid = tid_, wid = __builtin_amdgcn_readfirstlane(tid >> 6), lane = tid & 63, wr = wid >> 2, wc = wid & 3, fr = lane & 15, fq = lane >> 4;
    const int nt = K / BK;
    unsigned voffB[2]; int Rl[2], Cb[2];
#pragma unroll
    for (int i = 0; i < 2; ++i) { int R, C; stage_rc(tid * 16 + i * 8192, R, C); const int Rb = Epi::PERM ? ((R & ~31) + perm32(R & 31)) : R;
        voffB[i] = (unsigned)(Rb * K + C) * 2u; Rl[i] = R; Cb[i] = C * 2; }
    const size_t kstep = (size_t)(BK * 2), hstep = (size_t)HALF * K * 2;
    const unsigned ldsw = (unsigned)wid * 1024u;
    const int aoff = lds_byte(wr * 64 + fr, fq * 8), boff = lds_byte(wc * 32 + fr, fq * 8);
#define PG8_SA(b, h) (((b) * 2 + (h)) * HTB)
#define PG8_SB(b, h) ((4 + (b) * 2 + (h)) * HTB)
#define PG8_STAGE(bufoff, gbase, voff) do { _Pragma("unroll") for (int _i = 0; _i < 2; ++_i) \
        __builtin_amdgcn_global_load_lds((const unsigned*)((const char*)(gbase) + (voff)[_i]), (LAS unsigned*)(lds + (bufoff) + ldsw + _i * 8192), 16, 0, 0); } while (0)
#define PG8_LDA(dst, b, h) do { _Pragma("unroll") for (int m = 0; m < 4; ++m) _Pragma("unroll") for (int k = 0; k < 2; ++k) dst[m][k] = *(const LAS bf16x8*)(lds + PG8_SA(b, h) + aoff + m * 2048 + k * 1024); } while (0)
#define PG8_LDB(dst, b, h) do { _Pragma("unroll") for (int n = 0; n < 2; ++n) _Pragma("unroll") for (int k = 0; k < 2; ++k) dst[n][k] = *(const LAS bf16x8*)(lds + PG8_SB(b, h) + boff + n * 2048 + k * 1024); } while (0)
#define PG8_MMA(ai, bj, At, Bt) do { __builtin_amdgcn_s_setprio(1); _Pragma("unroll") for (int m = 0; m < 4; ++m) _Pragma("unroll") for (int n = 0; n < 2; ++n) _Pragma("unroll") for (int k = 0; k < 2; ++k) \
        acc[ai][bj][m][n] = __builtin_amdgcn_mfma_f32_16x16x32_bf16(Bt[n][k], At[m][k], acc[ai][bj][m][n], 0, 0, 0); __builtin_amdgcn_s_setprio(0); } while (0)
#define PG8_WAIT_V(n) asm volatile("s_waitcnt vmcnt(" #n ")" ::: "memory")
#define PG8_WAIT_L(n) asm volatile("s_waitcnt lgkmcnt(" #n ")" ::: "memory")
#define PG8_BAR __builtin_amdgcn_s_barrier()
#define PG8_SCHED __builtin_amdgcn_sched_barrier(0)
    Unit cur, nxt; int ui = 0;
    if (!S.next(0, cur)) return;
    f32x4 acc[2][2][4][2];
#pragma unroll
    for (int a = 0; a < 2; ++a)
#pragma unroll
        for (int b = 0; b < 2; ++b)
#pragma unroll
            for (int m = 0; m < 4; ++m)
#pragma unroll
                for (int n = 0; n < 2; ++n) acc[a][b][m][n] = (f32x4){0.f, 0.f, 0.f, 0.f};
    bf16x8 At[4][2], B0[2][2], B1[2][2];
    unsigned oc[2][2], on[2][2]; const char* cB; const char* nB;
    S.setup(cur, Rl, Cb, oc, cB);
    S.a_ready(cur);
    PG8_STAGE(PG8_SB(0, 0), cB, voffB); PG8_STAGE(PG8_SB(0, 1), cB + hstep, voffB); PG8_STAGE(PG8_SA(0, 0), gA, oc[0]); PG8_STAGE(PG8_SA(0, 1), gA, oc[1]);
    if (wr == 1) PG8_BAR;
    PG8_WAIT_V(2); PG8_BAR;
    PG8_STAGE(PG8_SB(1, 0), cB + kstep, voffB); PG8_STAGE(PG8_SA(1, 0), gA + kstep, oc[0]); PG8_STAGE(PG8_SB(1, 1), cB + hstep + kstep, voffB);
    PG8_WAIT_V(6); PG8_BAR;
    for (;;) {
        const bool has_next = S.next(ui + 1, nxt);
        if (has_next) S.setup(nxt, Rl, Cb, on, nB);
        else { nB = cB;
#pragma unroll
            for (int h = 0; h < 2; ++h)
#pragma unroll
                for (int i = 0; i < 2; ++i) on[h][i] = oc[h][i]; }
        for (int t = 0; t < nt; t += 2) {
            const bool last = (t == nt - 2);
            const char* a1 = gA + (size_t)(t + 1) * kstep;
            const char* a2 = last ? gA : gA + (size_t)(t + 2) * kstep; const char* b2 = last ? nB : cB + (size_t)(t + 2) * kstep;
            const char* a3 = a2 + kstep; const char* b3 = b2 + kstep;
            unsigned o2[2][2];
#pragma unroll
            for (int h = 0; h < 2; ++h)
#pragma unroll
                for (int i = 0; i < 2; ++i) o2[h][i] = last ? on[h][i] : oc[h][i];
            if (last && has_next) S.a_ready(nxt);
            PG8_LDB(B0, 0, 0); PG8_LDB(B1, 0, 1); PG8_SCHED; PG8_LDA(At, 0, 0); PG8_STAGE(PG8_SA(1, 1), a1, oc[1]);
            PG8_WAIT_V(8); PG8_WAIT_L(0); PG8_BAR; PG8_MMA(0, 0, At, B0); PG8_MMA(0, 1, At, B1); PG8_BAR; PG8_SCHED;
            PG8_LDA(At, 0, 1); PG8_STAGE(PG8_SB(0, 0), b2, voffB); PG8_STAGE(PG8_SB(0, 1), b2 + hstep, voffB); PG8_STAGE(PG8_SA(0, 0), a2, o2[0]);
            PG8_WAIT_V(8); PG8_WAIT_L(0); PG8_BAR; PG8_MMA(1, 0, At, B0); PG8_MMA(1, 1, At, B1); PG8_BAR; PG8_SCHED;
            PG8_LDB(B0, 1, 0); PG8_LDB(B1, 1, 1); PG8_SCHED; PG8_LDA(At, 1, 0); PG8_STAGE(PG8_SA(0, 1), a2, o2[1]);
            PG8_WAIT_V(8); PG8_WAIT_L(0); PG8_BAR; PG8_MMA(0, 0, At, B0); PG8_MMA(0, 1, At, B1); PG8_BAR; PG8_SCHED;
            PG8_LDA(At, 1, 1); PG8_STAGE(PG8_SB(1, 0), b3, voffB); PG8_STAGE(PG8_SB(1, 1), b3 + hstep, voffB); PG8_STAGE(PG8_SA(1, 0), a3, o2[0]);
            PG8_WAIT_V(8); PG8_WAIT_L(0); PG8_BAR; PG8_MMA(1, 0, At, B0); PG8_MMA(1, 1, At, B1); PG8_BAR; PG8_SCHED;
        }
        if constexpr (ALIGN_EPI) { if (wr == 0) PG8_BAR; }
        E(acc, cur, wr, wc, fr, fq); S.done(cur);
        if (!has_next) break;
#pragma unroll
        for (int a = 0; a < 2; ++a)
#pragma unroll
            for (int b = 0; b < 2; ++b)
#pragma unroll
                for (int m = 0; m < 4; ++m)
#pragma unroll
                    for (int n = 0; n < 2; ++n) acc[a][b][m][n] = (f32x4){0.f, 0.f, 0.f, 0.f};
        cur = nxt; cB = nB; ++ui;
#pragma unroll
        for (int h = 0; h < 2; ++h)
#pragma unroll
            for (int i = 0; i < 2; ++i) oc[h][i] = on[h][i];
        if constexpr (ALIGN_EPI) { if (wr == 1) PG8_BAR; }
    }
    PG8_WAIT_V(0);
    if constexpr (!ALIGN_EPI) { if (wr == 0) PG8_BAR; }
    PG8_BAR;
#undef PG8_SA
#undef PG8_SB
#undef PG8_STAGE
#undef PG8_LDA
#undef PG8_LDB
#undef PG8_MMA
#undef PG8_WAIT_V
#undef PG8_WAIT_L
#undef PG8_BAR
#undef PG8_SCHED
}
}
#ifndef RS1
#define RS1 13
#define RS2 22
#define RS3 28
#endif
namespace ret {
constexpr int QB0 = 0, KB0 = 32768, VB0 = 65536, ST0 = 98304;
constexpr int RET_LDS_BYTES = ST0 + 2 * 8192;
__device__ __forceinline__ int toff(int row, int c16) { return row * 128 + ((c16 ^ (row & 7)) << 4); }
typedef short v4i16_t __attribute__((ext_vector_type(4)));
__device__ __forceinline__ v4i16_t trd(const LAS unsigned char* p) { return __builtin_amdgcn_ds_read_tr16_b64_v4i16((LAS v4i16_t*)p); }
__device__ __forceinline__ bf16x8 cat8(v4i16_t a, v4i16_t b) { return (bf16x8){a[0], a[1], a[2], a[3], b[0], b[1], b[2], b[3]}; }

#define RET_KEEP(x) asm volatile("" :: "v"(x))
__device__ __forceinline__ float xsum_16_32(float v) {
    { auto rr = __builtin_amdgcn_permlane16_swap(__float_as_uint(v), __float_as_uint(v), false, false); v = __uint_as_float(rr[0]) + __uint_as_float(rr[1]); }
    { auto rr = __builtin_amdgcn_permlane32_swap(__float_as_uint(v), __float_as_uint(v), false, false); v = __uint_as_float(rr[0]) + __uint_as_float(rr[1]); }
    return v;
}
__device__ __forceinline__ void ret_unit(int b, int h, int seg, const bf16* PROJ, bf16* CAT, float gC, LAS unsigned char* lds) {
    int tid_ = threadIdx.x; asm volatile("" : "+v"(tid_));
    const int tid = tid_, lane = tid & 63, w = __builtin_amdgcn_readfirstlane(tid >> 6), g = lane >> 4, c15 = lane & 15;
    const int blk = w < 4 ? w : 11 - w;
    const bf16* base = PROJ + (size_t)b * SEQ * INW;
    const int nfirst = seg == 0 ? 0 : seg == 1 ? RS1 : seg == 2 ? RS2 : RS3, nend = seg == 0 ? RS1 : seg == 1 ? RS2 : seg == 2 ? RS3 : 32;
    const int dr = lane >> 3, dc = (lane & 7) ^ dr;
#define RET_DMA(tileoff, colbase, m) do { _Pragma("unroll") for (int _p = 0; _p < 2; ++_p) { const int pc = w + 8 * _p; \
        __builtin_amdgcn_global_load_lds((const unsigned*)(base + (size_t)((m) * 128 + 8 * pc + dr) * INW + (colbase) + h * 64 + dc * 8), (LAS unsigned*)(lds + (tileoff) + pc * 1024), 16, 0, 0); } } while (0)
    f32x4 sacc[2]; sacc[0] = (f32x4){0.f, 0.f, 0.f, 0.f}; sacc[1] = (f32x4){0.f, 0.f, 0.f, 0.f};
    const int et_s = w >> 1, dt0 = 2 * (w & 1);
    if (nfirst > 0) {
        bf16x8 kprev = (bf16x8){0, 0, 0, 0, 0, 0, 0, 0}, vprev2 = kprev;
        RET_DMA(0, C_RK, 0); RET_DMA(16384, C_RV, 0);
        if (nfirst > 1) { RET_DMA(32768, C_RK, 1); RET_DMA(32768 + 16384, C_RV, 1); }
#pragma unroll 1
        for (int m = 0; m < nfirst; ++m) {
            if (m + 1 < nfirst) asm volatile("s_waitcnt vmcnt(4) lgkmcnt(0)" ::: "memory"); else asm volatile("s_waitcnt vmcnt(0) lgkmcnt(0)" ::: "memory");
            __builtin_amdgcn_s_barrier(); asm volatile("" ::: "memory");
            if (m + 2 < nfirst) { const int s2 = ((m + 2) % 3) * 32768; RET_DMA(s2, C_RK, m + 2); RET_DMA(s2 + 16384, C_RV, m + 2); }
            const LAS unsigned char* Kt = lds + (m % 3) * 32768; const LAS unsigned char* Vt = Kt + 16384;
            sacc[0] = sacc[0] * gC; sacc[1] = sacc[1] * gC;
#pragma unroll
            for (int ks = 0; ks < 4; ++ks) {
                const int q = c15 >> 2, p = c15 & 3, r0 = 32 * ks + 8 * g + q;
                const bf16x8 vf = cat8(trd(Vt + toff(r0, 2 * et_s + (p >> 1)) + (p & 1) * 8), trd(Vt + toff(r0 + 4, 2 * et_s + (p >> 1)) + (p & 1) * 8));
#pragma unroll
                for (int dd = 0; dd < 2; ++dd) { const int c16 = 2 * (dt0 + dd) + (p >> 1);
                    const bf16x8 kf = cat8(trd(Kt + toff(r0, c16) + (p & 1) * 8), trd(Kt + toff(r0 + 4, c16) + (p & 1) * 8));
                    sacc[dd] = __builtin_amdgcn_mfma_f32_16x16x32_bf16(vf, kf, sacc[dd], 0, 0, 0); RET_KEEP(kprev); kprev = kf; }
                RET_KEEP(vprev2); vprev2 = vf;
            }
        }
        RET_KEEP(kprev); RET_KEEP(vprev2);
        asm volatile("s_waitcnt lgkmcnt(0)" ::: "memory"); __builtin_amdgcn_s_barrier(); asm volatile("" ::: "memory");
    }
    { LAS unsigned char* STi = lds + ST0 + (nfirst & 1) * 8192;
#pragma unroll
      for (int dd = 0; dd < 2; ++dd)
#pragma unroll
          for (int rr = 0; rr < 4; ++rr) { const int e = 16 * et_s + 4 * g + rr, d = 16 * (dt0 + dd) + c15;
              *(LAS unsigned short*)(STi + toff(e, d >> 3) + (d & 7) * 2) = (unsigned short)f2bf(sacc[dd][rr]); } }
    RET_DMA(KB0 + (nfirst & 1) * 16384, C_RK, nfirst); RET_DMA(VB0 + (nfirst & 1) * 16384, C_RV, nfirst); RET_DMA(QB0 + (nfirst & 1) * 16384, C_RQ, nfirst);
    __syncthreads();
#define RET_STATE_UPDATE() do { if (m + 1 < nend) { bf16x8 kfp = (bf16x8){0, 0, 0, 0, 0, 0, 0, 0}, vfp = kfp; sacc[0] = sacc[0] * gC; sacc[1] = sacc[1] * gC; _Pragma("unroll") for (int ks = 0; ks < 4; ++ks) { const int q = c15 >> 2, p = c15 & 3, r0 = 32 * ks + 8 * g + q; const bf16x8 vf = cat8(trd(Vt + toff(r0, 2 * et_s + (p >> 1)) + (p & 1) * 8), trd(Vt + toff(r0 + 4, 2 * et_s + (p >> 1)) + (p & 1) * 8)); _Pragma("unroll") for (int dd = 0; dd < 2; ++dd) { const int c16 = 2 * (dt0 + dd) + (p >> 1); const bf16x8 kf = cat8(trd(Kt + toff(r0, c16) + (p & 1) * 8), trd(Kt + toff(r0 + 4, c16) + (p & 1) * 8)); sacc[dd] = __builtin_amdgcn_mfma_f32_16x16x32_bf16(vf, kf, sacc[dd], 0, 0, 0); if (dd == 1) { RET_KEEP(kfp); } kfp = kf; } RET_KEEP(vfp); vfp = vf; } _Pragma("unroll") for (int dd = 0; dd < 2; ++dd) _Pragma("unroll") for (int r = 0; r < 4; ++r) { const int e = 16 * et_s + 4 * g + r, d = 16 * (dt0 + dd) + c15; *(LAS unsigned short*)(STn + toff(e, d >> 3) + (d & 7) * 2) = (unsigned short)f2bf(sacc[dd][r]); } RET_KEEP(kfp); RET_KEEP(vfp); } } while (0)
#pragma unroll 1
    for (int m = nfirst; m < nend; ++m) {
        const int cur = m & 1, nx = cur ^ 1; const bool full = true;
        if (m + 1 < nend) { RET_DMA(KB0 + nx * 16384, C_RK, m + 1); RET_DMA(VB0 + nx * 16384, C_RV, m + 1); RET_DMA(QB0 + nx * 16384, C_RQ, m + 1); }
        const LAS unsigned char* Qt = lds + QB0 + cur * 16384; const LAS unsigned char* Kt = lds + KB0 + cur * 16384; const LAS unsigned char* Vt = lds + VB0 + cur * 16384;
        const LAS unsigned char* STc = lds + ST0 + cur * 8192; LAS unsigned char* STn = lds + ST0 + nx * 8192;
        if (full) {
            const size_t row = (size_t)b * SEQ + m * 128 + 16 * blk + c15;
            u32x2 gg[4];
#pragma unroll
            for (int et = 0; et < 4; ++et) gg[et] = *(const GAS u32x2*)(PROJ + row * INW + C_RG + h * 64 + 16 * et + 4 * g);
            bf16x8 qf[2];
#pragma unroll
            for (int ks = 0; ks < 2; ++ks) qf[ks] = *(const LAS bf16x8*)(Qt + toff(16 * blk + c15, 4 * ks + g));
            bf16x8 pf[4];
#pragma unroll
            for (int ks = 0; ks < 4; ++ks) {
                f32x4 s0 = (f32x4){0.f, 0.f, 0.f, 0.f}, s1 = (f32x4){0.f, 0.f, 0.f, 0.f};
                bf16x8 ka[2], kb[2]; ka[0] = ka[1] = kb[0] = kb[1] = (bf16x8){0, 0, 0, 0, 0, 0, 0, 0};
                if (2 * ks <= blk) {
#pragma unroll
                    for (int kk = 0; kk < 2; ++kk) { ka[kk] = *(const LAS bf16x8*)(Kt + toff(32 * ks + c15, 4 * kk + g)); s0 = __builtin_amdgcn_mfma_f32_16x16x32_bf16(ka[kk], qf[kk], s0, 0, 0, 0); }
                    if (2 * ks == blk) {
#pragma unroll
                        for (int r = 0; r < 4; ++r) if (4 * g + r > c15) s0[r] = 0.f; }
                }
                if (2 * ks + 1 <= blk) {
#pragma unroll
                    for (int kk = 0; kk < 2; ++kk) { kb[kk] = *(const LAS bf16x8*)(Kt + toff(32 * ks + 16 + c15, 4 * kk + g)); s1 = __builtin_amdgcn_mfma_f32_16x16x32_bf16(kb[kk], qf[kk], s1, 0, 0, 0); }
                    if (2 * ks + 1 == blk) {
#pragma unroll
                        for (int r = 0; r < 4; ++r) if (4 * g + r > c15) s1[r] = 0.f; }
                }
                u32x4 pk; pk.x = pk2(s0[0], s0[1]); pk.y = pk2(s0[2], s0[3]); pk.z = pk2(s1[0], s1[1]); pk.w = pk2(s1[2], s1[3]);
                pf[ks] = __builtin_bit_cast(bf16x8, pk);
                RET_KEEP(ka[0]); RET_KEEP(ka[1]); RET_KEEP(kb[0]); RET_KEEP(kb[1]);
            }
            f32x4 o[4];
            bf16x8 vprev[4]; vprev[0] = vprev[1] = vprev[2] = vprev[3] = (bf16x8){0, 0, 0, 0, 0, 0, 0, 0};
#pragma unroll
            for (int et = 0; et < 4; ++et) {
                f32x4 a = (f32x4){0.f, 0.f, 0.f, 0.f};
                bf16x8 sf[2], vcur[4]; vcur[0] = vcur[1] = vcur[2] = vcur[3] = (bf16x8){0, 0, 0, 0, 0, 0, 0, 0};
#pragma unroll
                for (int kk = 0; kk < 2; ++kk) { sf[kk] = *(const LAS bf16x8*)(STc + toff(16 * et + c15, 4 * kk + g)); a = __builtin_amdgcn_mfma_f32_16x16x32_bf16(sf[kk], qf[kk], a, 0, 0, 0); }
                a = a * gC;
#pragma unroll
                for (int ks = 0; ks < 4; ++ks) if (2 * ks <= blk) {
                    const int q = c15 >> 2, p = c15 & 3, r0 = 32 * ks + 4 * g + q, c16 = 2 * et + (p >> 1);
                    const v4i16_t v0 = trd(Vt + toff(r0, c16) + (p & 1) * 8), v1 = trd(Vt + toff(r0 + 16, c16) + (p & 1) * 8);
                    vcur[ks] = cat8(v0, v1);
                    a = __builtin_amdgcn_mfma_f32_16x16x32_bf16(vcur[ks], pf[ks], a, 0, 0, 0);
                }
                o[et] = a;
                RET_KEEP(sf[0]); RET_KEEP(sf[1]);
#pragma unroll
                for (int ks = 0; ks < 4; ++ks) { RET_KEEP(vprev[ks]); vprev[ks] = vcur[ks]; }
            }
            RET_STATE_UPDATE();
#pragma unroll
            for (int ks = 0; ks < 4; ++ks) { RET_KEEP(vprev[ks]); RET_KEEP(pf[ks]); }
            RET_KEEP(qf[0]); RET_KEEP(qf[1]);
            float s = 0.f;
#pragma unroll
            for (int et = 0; et < 4; ++et) s += (o[et][0] + o[et][1]) + (o[et][2] + o[et][3]);
            s = xsum_16_32(s);
            const float mean = s * (1.f / 64.f); float q2 = 0.f;
#pragma unroll
            for (int et = 0; et < 4; ++et) { o[et] = o[et] - mean; q2 += (o[et][0] * o[et][0] + o[et][1] * o[et][1]) + (o[et][2] * o[et][2] + o[et][3] * o[et][3]); }
            q2 = xsum_16_32(q2);
            const float rstd = 1.f / sqrtf(q2 * (1.f / 64.f) + LN_EPS);
#pragma unroll
            for (int et = 0; et < 4; ++et) {
                const float g0 = __uint_as_float(gg[et].x << 16), g1 = __uint_as_float(gg[et].x & 0xffff0000u), g2 = __uint_as_float(gg[et].y << 16), g3 = __uint_as_float(gg[et].y & 0xffff0000u);
                u32x2 wv; wv.x = pk2(o[et][0] * rstd * g0, o[et][1] * rstd * g1); wv.y = pk2(o[et][2] * rstd * g2, o[et][3] * rstd * g3);
                *(GAS u32x2*)(CAT + row * DM + h * 64 + 16 * et + 4 * g) = wv; asm volatile("s_nop 1" :: "v"(wv.x), "v"(wv.y) : "memory"); }
        }
        else { RET_STATE_UPDATE(); }
        __syncthreads();
    }
#undef RET_DMA
#undef RET_STATE_UPDATE
#undef RET_KEEP
}
}
namespace attn_body {
using bf16=__hip_bfloat16;
using bf16x8=__attribute__((ext_vector_type(8)))short;
using s16x4=__attribute__((ext_vector_type(4)))short;
using f32x16=__attribute__((ext_vector_type(16)))float;
using u32x4=__attribute__((ext_vector_type(4)))unsigned;
constexpr int SEQ=4096,D=64,PQ=3584,PO=1024;
constexpr int NW=8,QBLK=32,QB=QBLK*NW,KVBLK=64,NQB=SEQ/QB;
constexpr int ATTN_UNIT_ROWS=QB;
__device__ __forceinline__ int crow(int r,int hi){return (r&3)+8*(r>>2)+4*hi;}
#define SBAR() __builtin_amdgcn_sched_barrier(0)
__device__ __forceinline__ void cmask(f32x16&p0,f32x16&p1,int jb,int qrel,int hi){
  const float NEG=-INFINITY; int kb=64*jb+4*hi;
  #pragma unroll
  for(int r=0;r<16;++r){int kv=kb+(r&3)+8*(r>>2); if(kv>qrel)p0[r]=NEG; if(kv+32>qrel)p1[r]=NEG;}
}

constexpr int NSLOT=3, SLOTB=8192;
constexpr int LDS_K=0, LDS_V=NSLOT*SLOTB, LDS_WS=2*NSLOT*SLOTB, LDS_OST=LDS_WS+NW*64*4, LDS_BYTES=LDS_OST+NW*4096;
constexpr float C2=0.125f*1.4426950408889634f;
__device__ __forceinline__ void glds16(const void*gsrc,unsigned lds_dst){unsigned keep;
  asm volatile("s_mov_b32 %0, m0\n\ts_mov_b32 m0, %2\n\ts_nop 0\n\tglobal_load_lds_dwordx4 %1, off\n\ts_mov_b32 m0, %0":"=&s"(keep):"v"(gsrc),"s"(lds_dst):"memory");}
__device__ __forceinline__ float max3f(float a,float b,float c){float r;asm("v_max3_f32 %0, %1, %2, %3":"=v"(r):"v"(a),"v"(b),"v"(c));return r;}
__device__ __forceinline__ float max2f(float a,float b){float r;asm("v_max_f32_e32 %0, %1, %2":"=v"(r):"v"(a),"v"(b));return r;}
__device__ __forceinline__ float fadd_s(float a,float b){float r;asm("v_add_f32_e32 %0, %1, %2":"=v"(r):"v"(a),"v"(b));return r;}
__device__ __forceinline__ float fsub_s(float a,float b){float r;asm("v_sub_f32_e32 %0, %1, %2":"=v"(r):"v"(a),"v"(b));return r;}
typedef float f32x2_t __attribute__((ext_vector_type(2))); typedef __bf16 bf16x2_t __attribute__((ext_vector_type(2)));
__device__ __forceinline__ unsigned cvtpk_s(float lo,float hi){f32x2_t v={lo,hi};bf16x2_t b=__builtin_convertvector(v,bf16x2_t);return __builtin_bit_cast(unsigned,b);}
#define WAIT_BAR(N) asm volatile("s_waitcnt vmcnt(" #N ") lgkmcnt(0)\n\ts_barrier":::"memory")

__device__ __forceinline__ void qkt(f32x16&p0,f32x16&p1,const char*Kslot,const bf16x8*qr,const f32x16&negm,int r32,int hi){
  const char*kb=Kslot+hi*1024+r32*16;
  #pragma unroll
  for(int d0=0;d0<4;++d0){
    const bf16x8 b0=*reinterpret_cast<const bf16x8*>(kb+d0*2048);
    const bf16x8 b1=*reinterpret_cast<const bf16x8*>(kb+d0*2048+512);
    if(d0==0){p0=__builtin_amdgcn_mfma_f32_32x32x16_bf16(b0,qr[0],negm,0,0,0);p1=__builtin_amdgcn_mfma_f32_32x32x16_bf16(b1,qr[0],negm,0,0,0);}
    else{p0=__builtin_amdgcn_mfma_f32_32x32x16_bf16(b0,qr[d0],p0,0,0,0);p1=__builtin_amdgcn_mfma_f32_32x32x16_bf16(b1,qr[d0],p1,0,0,0);}}
}
typedef __attribute__((address_space(3))) const char* lds_cptr;
typedef short v4i16_t __attribute__((ext_vector_type(4)));
__device__ __forceinline__ void kload8(bf16x8*kf,lds_cptr kp){
  kf[0]=*(const __attribute__((address_space(3))) bf16x8*)(kp);      kf[1]=*(const __attribute__((address_space(3))) bf16x8*)(kp+512);
  kf[2]=*(const __attribute__((address_space(3))) bf16x8*)(kp+2048); kf[3]=*(const __attribute__((address_space(3))) bf16x8*)(kp+2560);
  kf[4]=*(const __attribute__((address_space(3))) bf16x8*)(kp+4096); kf[5]=*(const __attribute__((address_space(3))) bf16x8*)(kp+4608);
  kf[6]=*(const __attribute__((address_space(3))) bf16x8*)(kp+6144); kf[7]=*(const __attribute__((address_space(3))) bf16x8*)(kp+6656);
}
__device__ __forceinline__ void kload2(bf16x8*kf,lds_cptr kp,int j){ kf[2*j]=*(const __attribute__((address_space(3))) bf16x8*)(kp+j*2048); kf[2*j+1]=*(const __attribute__((address_space(3))) bf16x8*)(kp+j*2048+512); }
__device__ __forceinline__ s16x4 vtr(lds_cptr p){ return __builtin_bit_cast(s16x4,__builtin_amdgcn_ds_read_tr16_b64_v4i16((__attribute__((address_space(3))) v4i16_t*)p)); }
__device__ __forceinline__ float rowmax(const f32x16&p0,const f32x16&p1){
  float a=max3f(p0[0],p0[1],p1[0]),b=max3f(p0[2],p0[3],p1[1]);a=max3f(a,p1[2],p1[3]);
  #pragma unroll
  for(int r=4;r<16;r+=4){a=max3f(a,p0[r],p0[r+1]);b=max3f(b,p0[r+2],p0[r+3]);a=max3f(a,p1[r],p1[r+1]);b=max3f(b,p1[r+2],p1[r+3]);}
  const float m=max2f(a,b);
  auto rr=__builtin_amdgcn_permlane32_swap(__float_as_uint(m),__float_as_uint(m),false,false);
  return max2f(__uint_as_float(rr[0]),__uint_as_float(rr[1]));
}
__device__ __forceinline__ void pv(f32x16*o,int vb,bf16x8 pa0,bf16x8 pa1,bf16x8 pa2,bf16x8 pa3){
  #pragma unroll
  for(int d0=0;d0<2;++d0){s16x4 lo[4],hi[4];
    #pragma unroll
    for(int ks=0;ks<4;++ks){
      asm volatile("ds_read_b64_tr_b16 %0,%1 offset:%c2":"=&v"(lo[ks]):"v"(vb),"i"(d0*4096+ks*1024):"memory");
      asm volatile("ds_read_b64_tr_b16 %0,%1 offset:%c2":"=&v"(hi[ks]):"v"(vb),"i"(d0*4096+ks*1024+512):"memory");}
    asm volatile("s_waitcnt lgkmcnt(0)":::"memory");SBAR();
    #define PK(k) (bf16x8){lo[k][0],lo[k][1],lo[k][2],lo[k][3],hi[k][0],hi[k][1],hi[k][2],hi[k][3]}
    o[d0]=__builtin_amdgcn_mfma_f32_32x32x16_bf16(pa0,PK(0),o[d0],0,0,0);
    o[d0]=__builtin_amdgcn_mfma_f32_32x32x16_bf16(pa1,PK(1),o[d0],0,0,0);
    o[d0]=__builtin_amdgcn_mfma_f32_32x32x16_bf16(pa2,PK(2),o[d0],0,0,0);
    o[d0]=__builtin_amdgcn_mfma_f32_32x32x16_bf16(pa3,PK(3),o[d0],0,0,0);
    #undef PK
  }
}

#ifndef ATTN_STORE16
#define ATTN_STORE16(p,v) (*(u32x4*)(p)=(v))
#endif
template<int THRL> __device__ __forceinline__ void attn_unit(int qb,const bf16*Qh,const bf16*__restrict__ Kh,const bf16*__restrict__ Vh,bf16*Oh,char*shm){
  int tid_=threadIdx.x; asm volatile("":"+v"(tid_));
  const int tid=tid_,lane=tid&63,r32=lane&31,hi=lane>>5; const int wid=__builtin_amdgcn_readfirstlane(tid>>6);
  const int q0=qb*QB;
  const bf16*Qw=Qh+(long)(q0+wid*QBLK)*PQ;
  const unsigned lds0=(unsigned)(uintptr_t)shm;
  float*wsf=(float*)(shm+LDS_WS)+wid*64;
  const bf16*ksrc=Kh+(long)lane*PQ+wid*8;
  const bf16*vsrc=Vh+(long)(16*(wid&3)+(lane>>2))*PQ+(wid>>2)*32+(lane&3)*8;
  const unsigned kdst=lds0+LDS_K+wid*1024, vdst=lds0+LDS_V+wid*1024;
  #define DMA_K(t,slot) glds16(ksrc+(long)(t)*KVBLK*PQ,(unsigned)__builtin_amdgcn_readfirstlane(kdst+(slot)))
  #define DMA_V(t,slot) glds16(vsrc+(long)(t)*KVBLK*PQ,(unsigned)__builtin_amdgcn_readfirstlane(vdst+(slot)))
  const int vb0=(int)(lds0+LDS_V)+((lane>>4)&1)*32+(lane&3)*8+(4*hi+((lane&15)>>2))*64;
  const char*Kbase=shm+LDS_K; bf16x8 kf[8];
  const lds_cptr shm3=(lds_cptr)shm; const lds_cptr kp0=shm3+LDS_K+hi*1024+r32*16; const lds_cptr vp0=shm3+LDS_V+((lane>>4)&1)*32+(lane&3)*8+(4*hi+((lane&15)>>2))*64;
  const int NT=(q0+QB)/KVBLK;
  DMA_K(0,0);DMA_V(0,0);DMA_K(1,SLOTB);
  bf16x8 qr[4];
  #pragma unroll
  for(int d0=0;d0<4;++d0)qr[d0]=*reinterpret_cast<const bf16x8*>(&Qw[(long)r32*PQ+d0*16+hi*8]);
  float mhat=0.f,l_reg=0.f;f32x16 o[2];o[0]=f32x16{};o[1]=f32x16{};f32x16 negm=f32x16{};asm volatile("":"+v"(negm));
  const int qrel=wid*QBLK+r32;
  #define CMASK(P0,P1,t) do{int jb_=(t)-(NT-4); if(jb_>=0)cmask(P0,P1,jb_,qrel,hi);}while(0)
  bool resc=false;
  #define START(P0,P1) do{ const float rm=rowmax(P0,P1); resc=false; \
    { const float dl=rm; mhat=fadd_s(mhat,dl); \
      _Pragma("unroll") for(int r=0;r<16;++r){P0[r]=fsub_s(P0[r],dl);P1[r]=fsub_s(P1[r],dl);} \
      _Pragma("unroll") for(int r=0;r<16;++r)negm[r]=-mhat; asm volatile("":"+v"(negm)); } \
    _Pragma("unroll") for(int r=0;r<16;++r)P0[r]=__builtin_amdgcn_exp2f(P0[r]); }while(0)
  #define RESC() do{ if(resc){ asm volatile("s_waitcnt lgkmcnt(0)":::"memory"); \
      _Pragma("unroll") for(int d_=0;d_<2;++d_) _Pragma("unroll") for(int r=0;r<16;++r)o[d_][r]*=wsf[crow(r,hi)]; } }while(0)
  f32x16 pA0,pA1,pB0,pB1;
  int sl_prev=0,sl_cur=0,sl_next=SLOTB;
  #define ROT() do{sl_prev=sl_cur;sl_cur=sl_next;sl_next=(sl_next==(NSLOT-1)*SLOTB)?0:sl_next+SLOTB;}while(0)
  DMA_K(2,2*SLOTB);
  WAIT_BAR(3);
  qkt(pA0,pA1,Kbase,qr,negm,r32,hi);asm volatile("s_nop 15\n\ts_nop 7":"+v"(pA0),"+v"(pA1));CMASK(pA0,pA1,0);
  START(pA0,pA1);
  _Pragma("unroll") for(int r=0;r<16;++r)pA1[r]=__builtin_amdgcn_exp2f(pA1[r]);
  WAIT_BAR(0);
  DMA_K(3,0);DMA_V(1,SLOTB);
  ROT();
  kload8(kf,kp0+sl_cur);
  WAIT_BAR(2);
  s16x4 vlo[8],vhi[8]; u32x4 pw0,pw1,pw2,pw3;
  #define PKW(P,B) cvtpk_s(P[B],P[B+1])
  #define PAF(k) __builtin_bit_cast(bf16x8,pw##k)
  #define VFR(i) (bf16x8){vlo[i][0],vlo[i][1],vlo[i][2],vlo[i][3],vhi[i][0],vhi[i][1],vhi[i][2],vhi[i][3]}
  #define PIN(x) asm volatile("":"+v"(x))
  #define MX3(a,b,c) __builtin_fmaxf(__builtin_fmaxf((a),(b)),(c))
  #define GAPA(MF,A0,A1,A2,A3,W0,W1,PW) do{ MF; sacc+=A0; sacc+=A1; sacc+=A2; sacc+=A3; PIN(sacc); W0; W1; PIN(PW); SBAR(); }while(0)
  #define EX(v) __builtin_amdgcn_exp2f(v)
  #define GAPB(MF,X,B) do{ MF; X[B]=EX(X[B]); X[B+1]=EX(X[B+1]); X[B+2]=EX(X[B+2]); X[B+3]=EX(X[B+3]); PIN(X); SBAR(); }while(0)
  #define VRD(i) do{ vlo[i]=vtr(vp_+(((i)>>2)*4096+((i)&3)*1024)); vhi[i]=vtr(vp_+(((i)>>2)*4096+((i)&3)*1024+512)); }while(0)
  #define KRD(G,j) do{ if(G){ kload2(kf,kp0+sl_next,j); SBAR(); } }while(0)
  #define STEP(C0,C1,P0,P1,t,GK,GV,GL) do{ SBAR(); \
    const lds_cptr vp_=vp0+sl_prev; \
    VRD(0); SBAR(); float sacc=(P0[0]+P0[1]); \
    GAPA(C0=__builtin_amdgcn_mfma_f32_32x32x16_bf16(kf[0],qr[0],negm,0,0,0), P0[2],P0[3],P0[4],P0[5],     pw0[0]=PKW(P0,0), pw0[1]=PKW(P0,2), pw0); \
    VRD(4); SBAR(); GAPA(C1=__builtin_amdgcn_mfma_f32_32x32x16_bf16(kf[1],qr[0],negm,0,0,0), P0[6],P0[7],P0[8],P0[9],     pw0[2]=PKW(P0,4), pw0[3]=PKW(P0,6), pw0); \
    VRD(1); SBAR(); GAPA(C0=__builtin_amdgcn_mfma_f32_32x32x16_bf16(kf[2],qr[1],C0,0,0,0),   P0[10],P0[11],P0[12],P0[13], pw1[0]=PKW(P0,8), pw1[1]=PKW(P0,10), pw1); \
    VRD(5); SBAR(); GAPA(C1=__builtin_amdgcn_mfma_f32_32x32x16_bf16(kf[3],qr[1],C1,0,0,0),   P0[14],P0[15],P1[0],P1[1],   pw1[2]=PKW(P0,12),pw1[3]=PKW(P0,14), pw1); \
    VRD(2); SBAR(); GAPA(C0=__builtin_amdgcn_mfma_f32_32x32x16_bf16(kf[4],qr[2],C0,0,0,0),   P1[2],P1[3],P1[4],P1[5],     pw2[0]=PKW(P1,0), pw2[1]=PKW(P1,2), pw2); \
    VRD(6); SBAR(); GAPA(C1=__builtin_amdgcn_mfma_f32_32x32x16_bf16(kf[5],qr[2],C1,0,0,0),   P1[6],P1[7],P1[8],P1[9],     pw2[2]=PKW(P1,4), pw2[3]=PKW(P1,6), pw2); \
    VRD(3); SBAR(); GAPA(C0=__builtin_amdgcn_mfma_f32_32x32x16_bf16(kf[6],qr[3],C0,0,0,0),   P1[10],P1[11],P1[12],P1[13], pw3[0]=PKW(P1,8), pw3[1]=PKW(P1,10), pw3); \
    VRD(7); SBAR(); GAPA(C1=__builtin_amdgcn_mfma_f32_32x32x16_bf16(kf[7],qr[3],C1,0,0,0),   P1[14],P1[15],0.f,0.f,       pw3[2]=PKW(P1,12),pw3[3]=PKW(P1,14), pw3); \
    l_reg+=sacc; \
    if(GK){DMA_K((t)+3,sl_cur);} if(GV){DMA_V((t)+1,sl_next);} \
    CMASK(C0,C1,t); \
    { float a=MX3(C0[0],C0[1],C1[0]),b=MX3(C0[2],C0[3],C1[1]); a=MX3(a,C1[2],C1[3]); \
      _Pragma("unroll") for(int r=4;r<16;r+=4){a=MX3(a,C0[r],C0[r+1]);b=MX3(b,C0[r+2],C0[r+3]);a=MX3(a,C1[r],C1[r+1]);b=MX3(b,C1[r+2],C1[r+3]);} \
      float rm=__builtin_fmaxf(a,b); { auto rr=__builtin_amdgcn_permlane32_swap(__float_as_uint(rm),__float_as_uint(rm),false,false); rm=__builtin_fmaxf(__uint_as_float(rr[0]),__uint_as_float(rr[1])); } \
      resc=false; \
      if(__builtin_expect(__any(rm>(float)THRL),0)){ const float dl=__builtin_fmaxf(rm,0.f); mhat+=dl; \
        _Pragma("unroll") for(int r=0;r<16;++r){C0[r]-=dl;C1[r]-=dl;} \
        _Pragma("unroll") for(int r=0;r<16;++r)negm[r]=-mhat; asm volatile("":"+v"(negm)); \
        const float f=__builtin_amdgcn_exp2f(-dl); l_reg*=f; if(hi==0)wsf[r32]=f; resc=true; } } \
    SBAR(); \
    GAPB(o[0]=__builtin_amdgcn_mfma_f32_32x32x16_bf16(PAF(0),VFR(0),o[0],0,0,0), C0,0); \
    GAPB(o[1]=__builtin_amdgcn_mfma_f32_32x32x16_bf16(PAF(0),VFR(4),o[1],0,0,0), C0,4); \
    KRD(GL,0); GAPB(o[0]=__builtin_amdgcn_mfma_f32_32x32x16_bf16(PAF(1),VFR(1),o[0],0,0,0), C0,8); \
    KRD(GL,1); GAPB(o[1]=__builtin_amdgcn_mfma_f32_32x32x16_bf16(PAF(1),VFR(5),o[1],0,0,0), C0,12); \
    KRD(GL,2); GAPB(o[0]=__builtin_amdgcn_mfma_f32_32x32x16_bf16(PAF(2),VFR(2),o[0],0,0,0), C1,0); \
    KRD(GL,3); GAPB(o[1]=__builtin_amdgcn_mfma_f32_32x32x16_bf16(PAF(2),VFR(6),o[1],0,0,0), C1,4); \
    GAPB(o[0]=__builtin_amdgcn_mfma_f32_32x32x16_bf16(PAF(3),VFR(3),o[0],0,0,0), C1,8); \
    GAPB(o[1]=__builtin_amdgcn_mfma_f32_32x32x16_bf16(PAF(3),VFR(7),o[1],0,0,0), C1,12); \
    }while(0)
  int t=1;
  #undef CMASK
  #define CMASK(P0,P1,t) do{}while(0)
  for(;t+5<NT;t+=2){
    STEP(pB0,pB1,pA0,pA1,t,true,true,true);     WAIT_BAR(2); RESC(); ROT();
    STEP(pA0,pA1,pB0,pB1,t+1,true,true,true);   WAIT_BAR(2); RESC(); ROT();
  }
  #undef CMASK
  #define CMASK(P0,P1,t) do{int jb_=(t)-(NT-4); if(jb_>=0)cmask(P0,P1,jb_,qrel,hi);}while(0)
  #define ENDW(tt) do{ if((tt)+3<NT){WAIT_BAR(2);} else if((tt)+2<NT){WAIT_BAR(1);} else {WAIT_BAR(0);} }while(0)
  for(;t+1<NT;t+=2){
    STEP(pB0,pB1,pA0,pA1,t,(t+3<NT),(t+1<NT),(t+1<NT));       ENDW(t);   RESC(); ROT();
    STEP(pA0,pA1,pB0,pB1,t+1,(t+4<NT),(t+2<NT),(t+2<NT));     ENDW(t+1); RESC(); ROT();
  }
  STEP(pB0,pB1,pA0,pA1,NT-1,false,false,false); RESC();
  { float sacc=pB0[0]+pB0[1]; _Pragma("unroll") for(int r=2;r<16;++r)sacc+=pB0[r]; _Pragma("unroll") for(int r=0;r<16;++r)sacc+=pB1[r]; l_reg+=sacc;
    pw0=(u32x4){PKW(pB0,0),PKW(pB0,2),PKW(pB0,4),PKW(pB0,6)};pw1=(u32x4){PKW(pB0,8),PKW(pB0,10),PKW(pB0,12),PKW(pB0,14)};pw2=(u32x4){PKW(pB1,0),PKW(pB1,2),PKW(pB1,4),PKW(pB1,6)};pw3=(u32x4){PKW(pB1,8),PKW(pB1,10),PKW(pB1,12),PKW(pB1,14)};
    SBAR(); pv(o,vb0+sl_cur,PAF(0),PAF(1),PAF(2),PAF(3)); }
  #undef PKW
  #undef PAF
  #undef VFR
  #undef PIN
  #undef MX3
  #undef GAPA
  #undef GAPB
  #undef EX
  #undef VRD
  #undef KRD
  #undef STEP
  #undef ENDW
  {auto rr=__builtin_amdgcn_permlane32_swap(__float_as_uint(l_reg),__float_as_uint(l_reg),false,false);l_reg=__uint_as_float(rr[0])+__uint_as_float(rr[1]);}
  if(hi==0)wsf[32+r32]=l_reg;asm volatile("s_waitcnt lgkmcnt(0)":::"memory");
  float rli[16];
  #pragma unroll
  for(int r=0;r<16;++r)rli[r]=__builtin_amdgcn_rcpf(wsf[32+crow(r,hi)]);
  bf16*Ow=Oh+(long)(q0+wid*QBLK)*PO;
  { bf16*stg=(bf16*)(shm+LDS_OST)+wid*2048;
    #pragma unroll
    for(int r=0;r<16;++r){const int orow=crow(r,hi);
      #pragma unroll
      for(int d0=0;d0<2;++d0)stg[orow*64+d0*32+r32]=__float2bfloat16(o[d0][r]*rli[r]);}
    asm volatile("s_waitcnt lgkmcnt(0)":::"memory");
    #pragma unroll
    for(int i=0;i<4;++i){const int row=i*8+(lane>>3),ch=lane&7; const u32x4 v=*(const u32x4*)(stg+row*64+ch*8); ATTN_STORE16(Ow+(long)row*PO+ch*8,v);} }
  asm volatile("s_waitcnt lgkmcnt(0)\n\ts_barrier":::"memory");
  #undef DMA_K
  #undef DMA_V
  #undef CMASK
  #undef START
  #undef RESC
  #undef ROT
}
constexpr int ATTN_LDS_BYTES=LDS_BYTES;
#undef SBAR
#undef WAIT_BAR
}
namespace attn128 {
using bf16=__hip_bfloat16;
using bf16x8=__attribute__((ext_vector_type(8)))short;
using s16x4=__attribute__((ext_vector_type(4)))short;
using f32x16=__attribute__((ext_vector_type(16)))float;
using u32x4=__attribute__((ext_vector_type(4)))unsigned;
constexpr int SEQ=4096,D=64,PQ=3584,PO=1024;
constexpr int NW=8,QBLK=32,QB=QBLK*NW,KVBLK=64,NQB=SEQ/QB;
constexpr int ATTN_UNIT_ROWS=QB;
__device__ __forceinline__ int crow(int r,int hi){return (r&3)+8*(r>>2)+4*hi;}
#define SBAR() __builtin_amdgcn_sched_barrier(0)
__device__ __forceinline__ void cmask(f32x16&p0,f32x16&p1,int jb,int qrel,int hi){
  const float NEG=-INFINITY; int kb=64*jb+4*hi;
  #pragma unroll
  for(int r=0;r<16;++r){int kv=kb+(r&3)+8*(r>>2); if(kv>qrel)p0[r]=NEG; if(kv+32>qrel)p1[r]=NEG;}
}

constexpr int NSLOT=3, SLOTB=8192;
constexpr int LDS_K=0, LDS_V=NSLOT*SLOTB, LDS_WS=LDS_V+NSLOT*2*SLOTB, LDS_OST=LDS_WS+NW*64*4, LDS_BYTES=LDS_OST+NW*4096;
constexpr float C2=0.125f*1.4426950408889634f;
__device__ __forceinline__ void glds16(const void*gsrc,unsigned lds_dst){unsigned keep;
  asm volatile("s_mov_b32 %0, m0\n\ts_mov_b32 m0, %2\n\ts_nop 0\n\tglobal_load_lds_dwordx4 %1, off\n\ts_mov_b32 m0, %0":"=&s"(keep):"v"(gsrc),"s"(lds_dst):"memory");}
__device__ __forceinline__ float max3f(float a,float b,float c){float r;asm("v_max3_f32 %0, %1, %2, %3":"=v"(r):"v"(a),"v"(b),"v"(c));return r;}
__device__ __forceinline__ float max2f(float a,float b){float r;asm("v_max_f32_e32 %0, %1, %2":"=v"(r):"v"(a),"v"(b));return r;}
__device__ __forceinline__ float fadd_s(float a,float b){float r;asm("v_add_f32_e32 %0, %1, %2":"=v"(r):"v"(a),"v"(b));return r;}
__device__ __forceinline__ float fsub_s(float a,float b){float r;asm("v_sub_f32_e32 %0, %1, %2":"=v"(r):"v"(a),"v"(b));return r;}
typedef float f32x2_t __attribute__((ext_vector_type(2))); typedef __bf16 bf16x2_t __attribute__((ext_vector_type(2)));
__device__ __forceinline__ unsigned cvtpk_s(float lo,float hi){f32x2_t v={lo,hi};bf16x2_t b=__builtin_convertvector(v,bf16x2_t);return __builtin_bit_cast(unsigned,b);}
#define WAIT_BAR(N) asm volatile("s_waitcnt vmcnt(" #N ") lgkmcnt(0)\n\ts_barrier":::"memory")

__device__ __forceinline__ void qkt(f32x16&p0,f32x16&p1,const char*Kslot,const bf16x8*qr,int r32,int hi){ const f32x16 negm=f32x16{};
  const char*kb=Kslot+hi*1024+r32*16;
  #pragma unroll
  for(int d0=0;d0<4;++d0){
    const bf16x8 b0=*reinterpret_cast<const bf16x8*>(kb+d0*2048);
    const bf16x8 b1=*reinterpret_cast<const bf16x8*>(kb+d0*2048+512);
    if(d0==0){p0=__builtin_amdgcn_mfma_f32_32x32x16_bf16(b0,qr[0],negm,0,0,0);p1=__builtin_amdgcn_mfma_f32_32x32x16_bf16(b1,qr[0],negm,0,0,0);}
    else{p0=__builtin_amdgcn_mfma_f32_32x32x16_bf16(b0,qr[d0],p0,0,0,0);p1=__builtin_amdgcn_mfma_f32_32x32x16_bf16(b1,qr[d0],p1,0,0,0);}}
}
typedef __attribute__((address_space(3))) const char* lds_cptr;
typedef short v4i16_t __attribute__((ext_vector_type(4)));
__device__ __forceinline__ void kload8(bf16x8*kf,lds_cptr kp){
  kf[0]=*(const __attribute__((address_space(3))) bf16x8*)(kp);      kf[1]=*(const __attribute__((address_space(3))) bf16x8*)(kp+512);
  kf[2]=*(const __attribute__((address_space(3))) bf16x8*)(kp+2048); kf[3]=*(const __attribute__((address_space(3))) bf16x8*)(kp+2560);
  kf[4]=*(const __attribute__((address_space(3))) bf16x8*)(kp+4096); kf[5]=*(const __attribute__((address_space(3))) bf16x8*)(kp+4608);
  kf[6]=*(const __attribute__((address_space(3))) bf16x8*)(kp+6144); kf[7]=*(const __attribute__((address_space(3))) bf16x8*)(kp+6656);
}
__device__ __forceinline__ void kload2(bf16x8*kf,lds_cptr kp,int j){ kf[2*j]=*(const __attribute__((address_space(3))) bf16x8*)(kp+j*2048); kf[2*j+1]=*(const __attribute__((address_space(3))) bf16x8*)(kp+j*2048+512); }
__device__ __forceinline__ s16x4 vtr(lds_cptr p){ return __builtin_bit_cast(s16x4,__builtin_amdgcn_ds_read_tr16_b64_v4i16((__attribute__((address_space(3))) v4i16_t*)p)); }
__device__ __forceinline__ float rowmax(const f32x16&p0,const f32x16&p1){
  float a=max3f(p0[0],p0[1],p1[0]),b=max3f(p0[2],p0[3],p1[1]);a=max3f(a,p1[2],p1[3]);
  #pragma unroll
  for(int r=4;r<16;r+=4){a=max3f(a,p0[r],p0[r+1]);b=max3f(b,p0[r+2],p0[r+3]);a=max3f(a,p1[r],p1[r+1]);b=max3f(b,p1[r+2],p1[r+3]);}
  const float m=max2f(a,b);
  auto rr=__builtin_amdgcn_permlane32_swap(__float_as_uint(m),__float_as_uint(m),false,false);
  return max2f(__uint_as_float(rr[0]),__uint_as_float(rr[1]));
}
__device__ __forceinline__ void pv(f32x16*o,int vb,bf16x8 pa0,bf16x8 pa1,bf16x8 pa2,bf16x8 pa3){
  #pragma unroll
  for(int d0=0;d0<4;++d0){s16x4 lo[4],hi[4];
    #pragma unroll
    for(int ks=0;ks<4;++ks){
      asm volatile("ds_read_b64_tr_b16 %0,%1 offset:%c2":"=&v"(lo[ks]):"v"(vb),"i"(d0*4096+ks*1024):"memory");
      asm volatile("ds_read_b64_tr_b16 %0,%1 offset:%c2":"=&v"(hi[ks]):"v"(vb),"i"(d0*4096+ks*1024+512):"memory");}
    asm volatile("s_waitcnt lgkmcnt(0)":::"memory");SBAR();
    #define PK(k) (bf16x8){lo[k][0],lo[k][1],lo[k][2],lo[k][3],hi[k][0],hi[k][1],hi[k][2],hi[k][3]}
    o[d0]=__builtin_amdgcn_mfma_f32_32x32x16_bf16(pa0,PK(0),o[d0],0,0,0);
    o[d0]=__builtin_amdgcn_mfma_f32_32x32x16_bf16(pa1,PK(1),o[d0],0,0,0);
    o[d0]=__builtin_amdgcn_mfma_f32_32x32x16_bf16(pa2,PK(2),o[d0],0,0,0);
    o[d0]=__builtin_amdgcn_mfma_f32_32x32x16_bf16(pa3,PK(3),o[d0],0,0,0);
    #undef PK
  }
}

#if 0
#define ATTN_STORE16(p,v) (*(u32x4*)(p)=(v))
#endif
template<int THRL> __device__ __forceinline__ void attn_unit(int qb,const bf16*Qh,const bf16*__restrict__ Kh,const bf16*__restrict__ Vh,bf16*Oh,char*shm){
  int tid_=threadIdx.x; asm volatile("":"+v"(tid_));
  const int tid=tid_,lane=tid&63,r32=lane&31,hi=lane>>5; const int wid=__builtin_amdgcn_readfirstlane(tid>>6);
  const int q0=qb*QB;
  const bf16*Qw=Qh+(long)(q0+wid*QBLK)*PQ;
  const unsigned lds0=(unsigned)(uintptr_t)shm;
  float*wsf=(float*)(shm+LDS_WS)+wid*64;
  const bf16*ksrc=Kh+(long)lane*PQ+wid*8;
  const bf16*vsrc=Vh+(long)(16*(wid&3)+(lane>>2))*PQ+(wid>>2)*32+(lane&3)*8;
  const unsigned kdst=lds0+LDS_K+wid*1024, vdst=lds0+LDS_V+wid*1024;
  #define DMA_K(t,slot) glds16(ksrc+(long)(t)*KVBLK*PQ,(unsigned)__builtin_amdgcn_readfirstlane(kdst+(slot)))
  #define DMA_V(t,slot) do{ glds16(vsrc+(long)(t)*KVBLK*PQ,(unsigned)__builtin_amdgcn_readfirstlane(vdst+2*(slot))); glds16(vsrc+64+(long)(t)*KVBLK*PQ,(unsigned)__builtin_amdgcn_readfirstlane(vdst+2*(slot)+8192)); }while(0)
  const int vb0=(int)(lds0+LDS_V)+((lane>>4)&1)*32+(lane&3)*8+(4*hi+((lane&15)>>2))*64;
  const char*Kbase=shm+LDS_K; bf16x8 kf[8];
  const lds_cptr shm3=(lds_cptr)shm; const lds_cptr kp0=shm3+LDS_K+hi*1024+r32*16; const lds_cptr vp0=shm3+LDS_V+((lane>>4)&1)*32+(lane&3)*8+(4*hi+((lane&15)>>2))*64;
  const int NT=(q0+QB)/KVBLK;
  DMA_K(0,0);DMA_V(0,0);DMA_K(1,SLOTB);
  bf16x8 qr[4];
  #pragma unroll
  for(int d0=0;d0<4;++d0)qr[d0]=*reinterpret_cast<const bf16x8*>(&Qw[(long)r32*PQ+d0*16+hi*8]);
  { bf16x8* qst=(bf16x8*)(shm+LDS_OST+wid*4096);
    #pragma unroll
    for(int d0=0;d0<4;++d0)qst[(d0*2+hi)*32+r32]=qr[d0]; }
  const lds_cptr qp0=shm3+LDS_OST+wid*4096+(hi*32+r32)*16;
  #define QLD(d0) (*(const __attribute__((address_space(3))) bf16x8*)(qp0+(d0)*1024))
  float mhat=0.f,l_reg=0.f;f32x16 o[4];o[0]=f32x16{};o[1]=f32x16{};o[2]=f32x16{};o[3]=f32x16{};
  const int qrel=wid*QBLK+r32;
  #define CMASK(P0,P1,t) do{int jb_=(t)-(NT-4); if(jb_>=0)cmask(P0,P1,jb_,qrel,hi);}while(0)
  bool resc=false;
  #define START(P0,P1) do{ const float rm=rowmax(P0,P1); resc=false; \
    { const float dl=rm; mhat=fadd_s(mhat,dl); \
      _Pragma("unroll") for(int r=0;r<16;++r){P0[r]=fsub_s(P0[r],dl);P1[r]=fsub_s(P1[r],dl);} \
      } \
    _Pragma("unroll") for(int r=0;r<16;++r)P0[r]=__builtin_amdgcn_exp2f(P0[r]); }while(0)
  #define RESC() do{ if(resc){ asm volatile("s_waitcnt lgkmcnt(0)":::"memory"); \
      _Pragma("unroll") for(int d_=0;d_<4;++d_) _Pragma("unroll") for(int r=0;r<16;++r)o[d_][r]*=wsf[crow(r,hi)]; } }while(0)
  f32x16 pA0,pA1,pB0,pB1;
  int sl_prev=0,sl_cur=0,sl_next=SLOTB;
  #define ROT() do{sl_prev=sl_cur;sl_cur=sl_next;sl_next=(sl_next==(NSLOT-1)*SLOTB)?0:sl_next+SLOTB;}while(0)
  DMA_K(2,2*SLOTB);
  WAIT_BAR(4);
  qkt(pA0,pA1,Kbase,qr,r32,hi);asm volatile("s_nop 15\n\ts_nop 7":"+v"(pA0),"+v"(pA1));CMASK(pA0,pA1,0);
  START(pA0,pA1);
  _Pragma("unroll") for(int r=0;r<16;++r)pA1[r]=__builtin_amdgcn_exp2f(pA1[r]);
  WAIT_BAR(0);
  DMA_K(3,0);DMA_V(1,SLOTB);
  ROT();
  kload8(kf,kp0+sl_cur);
  WAIT_BAR(3);
  s16x4 vlo[8],vhi[8]; u32x4 pw0,pw1,pw2,pw3;
  #define PKW(P,B) cvtpk_s(P[B],P[B+1])
  #define PAF(k) __builtin_bit_cast(bf16x8,pw##k)
  #define VFR(i) (bf16x8){vlo[i][0],vlo[i][1],vlo[i][2],vlo[i][3],vhi[i][0],vhi[i][1],vhi[i][2],vhi[i][3]}
  #define PIN(x) asm volatile("":"+v"(x))
  #define MX3(a,b,c) __builtin_fmaxf(__builtin_fmaxf((a),(b)),(c))
  #define GAPA(MF,A0,A1,A2,A3,W0,W1,PW) do{ MF; sacc+=A0; sacc+=A1; sacc+=A2; sacc+=A3; PIN(sacc); W0; W1; PIN(PW); SBAR(); }while(0)
  #define EX(v) __builtin_amdgcn_exp2f(v)
  #define GAPB(MF,X,B) do{ MF; X[B]=X[B]-mhat; X[B+1]=X[B+1]-mhat; PIN(X); X[B]=EX(X[B]); X[B+1]=EX(X[B+1]); PIN(X); SBAR(); }while(0)
  #define KEEPF(x) asm volatile(""::"v"(x))
  #define KEEPV(i) do{ asm volatile(""::"v"(vlo[i]),"v"(vhi[i])); }while(0)
  #define VRD2(i) do{ vlo[i]=vtr(vp_+((((i)>>2)+2)*4096+((i)&3)*1024)); vhi[i]=vtr(vp_+((((i)>>2)+2)*4096+((i)&3)*1024+512)); SBAR(); }while(0)
  #define VRD(i) do{ vlo[i]=vtr(vp_+(((i)>>2)*4096+((i)&3)*1024)); vhi[i]=vtr(vp_+(((i)>>2)*4096+((i)&3)*1024+512)); }while(0)
  #define KRD(G,j) do{ if(G){ kload2(kf,kp0+sl_next,j); SBAR(); } }while(0)
  #define STEP(C0,C1,P0,P1,t,GK,GV,GL) do{ SBAR(); const f32x16 zero16=f32x16{}; const bf16x8 ql0=QLD(0),ql1=QLD(1),ql2=QLD(2),ql3=QLD(3); \
    const lds_cptr vp_=vp0+2*sl_prev; \
    VRD(0); SBAR(); float sacc=(P0[0]+P0[1]); \
    GAPA(C0=__builtin_amdgcn_mfma_f32_32x32x16_bf16(kf[0],ql0,zero16,0,0,0), P0[2],P0[3],P0[4],P0[5],     pw0[0]=PKW(P0,0), pw0[1]=PKW(P0,2), pw0); \
    VRD(4); SBAR(); GAPA(C1=__builtin_amdgcn_mfma_f32_32x32x16_bf16(kf[1],ql0,zero16,0,0,0), P0[6],P0[7],P0[8],P0[9],     pw0[2]=PKW(P0,4), pw0[3]=PKW(P0,6), pw0); \
    VRD(1); SBAR(); KEEPF(kf[0]); GAPA(C0=__builtin_amdgcn_mfma_f32_32x32x16_bf16(kf[2],ql1,C0,0,0,0),   P0[10],P0[11],P0[12],P0[13], pw1[0]=PKW(P0,8), pw1[1]=PKW(P0,10), pw1); \
    VRD(5); SBAR(); KEEPF(kf[1]); KEEPF(ql0); GAPA(C1=__builtin_amdgcn_mfma_f32_32x32x16_bf16(kf[3],ql1,C1,0,0,0),   P0[14],P0[15],P1[0],P1[1],   pw1[2]=PKW(P0,12),pw1[3]=PKW(P0,14), pw1); \
    VRD(2); SBAR(); KEEPF(kf[2]); GAPA(C0=__builtin_amdgcn_mfma_f32_32x32x16_bf16(kf[4],ql2,C0,0,0,0),   P1[2],P1[3],P1[4],P1[5],     pw2[0]=PKW(P1,0), pw2[1]=PKW(P1,2), pw2); \
    VRD(6); SBAR(); KEEPF(kf[3]); KEEPF(ql1); GAPA(C1=__builtin_amdgcn_mfma_f32_32x32x16_bf16(kf[5],ql2,C1,0,0,0),   P1[6],P1[7],P1[8],P1[9],     pw2[2]=PKW(P1,4), pw2[3]=PKW(P1,6), pw2); \
    VRD(3); SBAR(); KEEPF(kf[4]); GAPA(C0=__builtin_amdgcn_mfma_f32_32x32x16_bf16(kf[6],ql3,C0,0,0,0),   P1[10],P1[11],P1[12],P1[13], pw3[0]=PKW(P1,8), pw3[1]=PKW(P1,10), pw3); \
    VRD(7); SBAR(); KEEPF(kf[5]); KEEPF(ql2); GAPA(C1=__builtin_amdgcn_mfma_f32_32x32x16_bf16(kf[7],ql3,C1,0,0,0),   P1[14],P1[15],0.f,0.f,       pw3[2]=PKW(P1,12),pw3[3]=PKW(P1,14), pw3); \
    l_reg+=sacc; \
    if(GK){DMA_K((t)+3,sl_cur);} if(GV){DMA_V((t)+1,sl_next);} \
    CMASK(C0,C1,t); \
    { float a=MX3(C0[0],C0[1],C1[0]),b=MX3(C0[2],C0[3],C1[1]); a=MX3(a,C1[2],C1[3]); \
      _Pragma("unroll") for(int r=4;r<16;r+=4){a=MX3(a,C0[r],C0[r+1]);b=MX3(b,C0[r+2],C0[r+3]);a=MX3(a,C1[r],C1[r+1]);b=MX3(b,C1[r+2],C1[r+3]);} \
      float rm=__builtin_fmaxf(a,b); { auto rr=__builtin_amdgcn_permlane32_swap(__float_as_uint(rm),__float_as_uint(rm),false,false); rm=__builtin_fmaxf(__uint_as_float(rr[0]),__uint_as_float(rr[1])); } \
      resc=false; \
      rm-=mhat; \
      if(__builtin_expect(__any(rm>(float)THRL),0)){ const float dl=__builtin_fmaxf(rm,0.f); mhat+=dl; \
        const float f=__builtin_amdgcn_exp2f(-dl); l_reg*=f; if(hi==0)wsf[r32]=f; resc=true; } } \
    KEEPF(kf[6]); KEEPF(kf[7]); KEEPF(ql3); SBAR(); \
    GAPB(o[0]=__builtin_amdgcn_mfma_f32_32x32x16_bf16(PAF(0),VFR(0),o[0],0,0,0), C0,0); \
    GAPB(o[1]=__builtin_amdgcn_mfma_f32_32x32x16_bf16(PAF(0),VFR(4),o[1],0,0,0), C0,2); \
    KRD(GL,0); GAPB(o[0]=__builtin_amdgcn_mfma_f32_32x32x16_bf16(PAF(1),VFR(1),o[0],0,0,0), C0,4); KEEPV(0); VRD2(0); \
    KRD(GL,1); GAPB(o[1]=__builtin_amdgcn_mfma_f32_32x32x16_bf16(PAF(1),VFR(5),o[1],0,0,0), C0,6); KEEPV(4); VRD2(4); \
    KRD(GL,2); GAPB(o[0]=__builtin_amdgcn_mfma_f32_32x32x16_bf16(PAF(2),VFR(2),o[0],0,0,0), C0,8); KEEPV(1); VRD2(1); \
    KRD(GL,3); GAPB(o[1]=__builtin_amdgcn_mfma_f32_32x32x16_bf16(PAF(2),VFR(6),o[1],0,0,0), C0,10); KEEPV(5); VRD2(5); \
    GAPB(o[0]=__builtin_amdgcn_mfma_f32_32x32x16_bf16(PAF(3),VFR(3),o[0],0,0,0), C0,12); KEEPV(2); VRD2(2); \
    GAPB(o[1]=__builtin_amdgcn_mfma_f32_32x32x16_bf16(PAF(3),VFR(7),o[1],0,0,0), C0,14); KEEPV(6); VRD2(6); \
    GAPB(o[2]=__builtin_amdgcn_mfma_f32_32x32x16_bf16(PAF(0),VFR(0),o[2],0,0,0), C1,0); KEEPV(3); VRD2(3); \
    GAPB(o[3]=__builtin_amdgcn_mfma_f32_32x32x16_bf16(PAF(0),VFR(4),o[3],0,0,0), C1,2); KEEPV(7); VRD2(7); \
    GAPB(o[2]=__builtin_amdgcn_mfma_f32_32x32x16_bf16(PAF(1),VFR(1),o[2],0,0,0), C1,4); \
    GAPB(o[3]=__builtin_amdgcn_mfma_f32_32x32x16_bf16(PAF(1),VFR(5),o[3],0,0,0), C1,6); \
    GAPB(o[2]=__builtin_amdgcn_mfma_f32_32x32x16_bf16(PAF(2),VFR(2),o[2],0,0,0), C1,8); \
    GAPB(o[3]=__builtin_amdgcn_mfma_f32_32x32x16_bf16(PAF(2),VFR(6),o[3],0,0,0), C1,10); \
    GAPB(o[2]=__builtin_amdgcn_mfma_f32_32x32x16_bf16(PAF(3),VFR(3),o[2],0,0,0), C1,12); \
    GAPB(o[3]=__builtin_amdgcn_mfma_f32_32x32x16_bf16(PAF(3),VFR(7),o[3],0,0,0), C1,14); \
    }while(0)
  int t=1;
  #undef CMASK
  #define CMASK(P0,P1,t) do{}while(0)
  for(;t+5<NT;t+=2){
    STEP(pB0,pB1,pA0,pA1,t,true,true,true);     WAIT_BAR(3); RESC(); ROT();
    STEP(pA0,pA1,pB0,pB1,t+1,true,true,true);   WAIT_BAR(3); RESC(); ROT();
  }
  #undef CMASK
  #define CMASK(P0,P1,t) do{int jb_=(t)-(NT-4); if(jb_>=0)cmask(P0,P1,jb_,qrel,hi);}while(0)
  #define ENDW(tt) do{ if((tt)+3<NT){WAIT_BAR(3);} else if((tt)+2<NT){WAIT_BAR(2);} else {WAIT_BAR(0);} }while(0)
  for(;t+1<NT;t+=2){
    STEP(pB0,pB1,pA0,pA1,t,(t+3<NT),(t+1<NT),(t+1<NT));       ENDW(t);   RESC(); ROT();
    STEP(pA0,pA1,pB0,pB1,t+1,(t+4<NT),(t+2<NT),(t+2<NT));     ENDW(t+1); RESC(); ROT();
  }
  STEP(pB0,pB1,pA0,pA1,NT-1,false,false,false); RESC();
  { float sacc=pB0[0]+pB0[1]; _Pragma("unroll") for(int r=2;r<16;++r)sacc+=pB0[r]; _Pragma("unroll") for(int r=0;r<16;++r)sacc+=pB1[r]; l_reg+=sacc;
    pw0=(u32x4){PKW(pB0,0),PKW(pB0,2),PKW(pB0,4),PKW(pB0,6)};pw1=(u32x4){PKW(pB0,8),PKW(pB0,10),PKW(pB0,12),PKW(pB0,14)};pw2=(u32x4){PKW(pB1,0),PKW(pB1,2),PKW(pB1,4),PKW(pB1,6)};pw3=(u32x4){PKW(pB1,8),PKW(pB1,10),PKW(pB1,12),PKW(pB1,14)};
    SBAR(); pv(o,vb0+2*sl_cur,PAF(0),PAF(1),PAF(2),PAF(3)); }
  #undef PKW
  #undef PAF
  #undef VFR
  #undef PIN
  #undef MX3
  #undef GAPA
  #undef GAPB
  #undef EX
  #undef VRD
  #undef VRD2
  #undef KEEPF
  #undef KEEPV
  #undef KRD
  #undef STEP
  #undef ENDW
  {auto rr=__builtin_amdgcn_permlane32_swap(__float_as_uint(l_reg),__float_as_uint(l_reg),false,false);l_reg=__uint_as_float(rr[0])+__uint_as_float(rr[1]);}
  if(hi==0)wsf[32+r32]=l_reg;asm volatile("s_waitcnt lgkmcnt(0)":::"memory");
  float rli[16];
  #pragma unroll
  for(int r=0;r<16;++r)rli[r]=__builtin_amdgcn_rcpf(wsf[32+crow(r,hi)]);
  bf16*Ow=Oh+(long)(q0+wid*QBLK)*PO;
  { bf16*stg=(bf16*)(shm+LDS_OST)+wid*2048;
    #pragma unroll
    for(int hf=0;hf<2;++hf){
    #pragma unroll
    for(int r=0;r<16;++r){const int orow=crow(r,hi);
      #pragma unroll
      for(int d0=0;d0<2;++d0)stg[orow*64+d0*32+r32]=__float2bfloat16(o[2*hf+d0][r]*rli[r]);}
    asm volatile("s_waitcnt lgkmcnt(0)":::"memory");
    #pragma unroll
    for(int i=0;i<4;++i){const int row=i*8+(lane>>3),ch=lane&7; const u32x4 v=*(const u32x4*)(stg+row*64+ch*8); ATTN_STORE16(Ow+(long)row*PO+hf*64+ch*8,v);}
    asm volatile("s_waitcnt lgkmcnt(0)":::"memory"); } }
  asm volatile("s_waitcnt lgkmcnt(0)\n\ts_barrier":::"memory");
  #undef DMA_K
  #undef QLD
  #undef DMA_V
  #undef CMASK
  #undef START
  #undef RESC
  #undef ROT
}
constexpr int ATTN_LDS_BYTES=LDS_BYTES;
#undef SBAR
#undef WAIT_BAR
}
#define ST8(ptr, w) do { *(ptr) = (w); asm volatile("s_nop 1" :: "v"((w).x), "v"((w).y) : "memory"); } while (0)
#define ST4(ptr, w) do { *(ptr) = (w); asm volatile("s_nop 1" :: "v"(w) : "memory"); } while (0)
constexpr int NWAVES = 8;
constexpr int RING_OFF = 0, RING_BYTES = 131072;
constexpr int LDSCTL_OFF = RING_BYTES, MISC_OFF = LDSCTL_OFF;
constexpr int TAB_OFF = LDSCTL_OFF + 512;
constexpr int EB_OFF = LDSCTL_OFF + 2048;
constexpr int LCNT_OFF = LDSCTL_OFF + 2304;
constexpr int LDS_BYTES = 147456;
constexpr int CW_BAR = 4096;
constexpr int NPHASE = 18;

#define XB_TMO      128
#define XB_XCNT(j)  (256  + 64 * (j))
#define XB_XSUB(j)  (1280 + 64 * (j))
#define XB_XGEN(j)  (2304 + 64 * (j))
#define XB_TOP      3328
#define XB_TOPGEN   3392
#define XCD_BAR_WORDS 3456
#define XB_SPIN_CAP (1u << 18)

__device__ __forceinline__ unsigned xb_ld(unsigned* p)              { return __hip_atomic_load(p, __ATOMIC_RELAXED, __HIP_MEMORY_SCOPE_AGENT); }
__device__ __forceinline__ unsigned xb_add(unsigned* p, unsigned v) { return __hip_atomic_fetch_add(p, v, __ATOMIC_RELAXED, __HIP_MEMORY_SCOPE_AGENT); }
__device__ __forceinline__ unsigned xb_xcc_id() { return (unsigned)__builtin_amdgcn_s_getreg((3 << 11) | 20) & 0xFu; }
#define XB_SPIN(cond, bar) do { unsigned _sp = 0; while (cond) { __builtin_amdgcn_s_sleep(1); \
    if ((++_sp & 255u) == 0u) { if (xb_ld(&(bar)[XB_TMO])) break; if (_sp > XB_SPIN_CAP) { atomicAdd(&(bar)[XB_TMO], 1u); break; } } } } while (0)

struct XcdBarrier {
    unsigned* bar; unsigned x;
    volatile LAS unsigned* st;
};

__device__ __forceinline__ XcdBarrier xcd_barrier_post(unsigned* bar, volatile LAS unsigned* st) {
    XcdBarrier b; b.bar = bar; b.x = xb_xcc_id(); b.st = st;
    if (threadIdx.x == 0) (void)xb_add(&bar[XB_XCNT(b.x)], 1u);
    return b;
}
__device__ __forceinline__ void xcd_barrier_complete(unsigned* bar, unsigned x, unsigned& nloc, unsigned& nx) {
    const unsigned G = gridDim.x * gridDim.y * gridDim.z;
    unsigned sum, cnt, mine, sp = 0u;
    for (;;) {
        sum = 0u; cnt = 0u; mine = 0u;
#pragma unroll
        for (unsigned j = 0; j < 16; ++j) { const unsigned c = xb_ld(&bar[XB_XCNT(j)]); sum += c; cnt += (c > 0u) ? 1u : 0u; mine = (j == x) ? c : mine; }
        if (sum == G) break;
        __builtin_amdgcn_s_sleep(1);
        if ((++sp & 255u) == 0u) { if (xb_ld(&bar[XB_TMO])) break; if (sp > XB_SPIN_CAP) { atomicAdd(&bar[XB_TMO], 1u); break; } }
    }
    nloc = mine > 0u ? mine : 1u; nx = cnt > 0u ? cnt : 1u;
}

__device__ __forceinline__ void xcd_barrier(const XcdBarrier& b) {
    asm volatile("s_waitcnt vmcnt(0)" ::: "memory");
    __syncthreads();
    if (threadIdx.x == 0) {
        unsigned* bar = b.bar;
        __builtin_amdgcn_s_waitcnt(0);
        unsigned nloc = b.st[0], nx = b.st[1];
        if (nloc == 0u) { xcd_barrier_complete(bar, b.x, nloc, nx); b.st[0] = nloc; b.st[1] = nx; }
        const unsigned old = xb_add(&bar[XB_XSUB(b.x)], 1u);
        const unsigned gen = old / nloc;
        if (old + 1u == (gen + 1u) * nloc) {
            __builtin_amdgcn_fence(__ATOMIC_RELEASE, "agent");
            asm volatile("s_waitcnt vmcnt(0)" ::: "memory");
            const unsigned og = xb_add(&bar[XB_TOP], 1u);
            const unsigned tg = og / nx;
            if (og + 1u == (tg + 1u) * nx) xb_add(&bar[XB_TOPGEN], 1u);
            else XB_SPIN(xb_ld(&bar[XB_TOPGEN]) == tg, bar);
            __builtin_amdgcn_fence(__ATOMIC_ACQUIRE, "agent");
            xb_add(&bar[XB_XGEN(b.x)], 1u);
            asm volatile("s_waitcnt vmcnt(0)" ::: "memory");
        } else {
            XB_SPIN(xb_ld(&bar[XB_XGEN(b.x)]) == gen, bar);
            __builtin_amdgcn_fence(__ATOMIC_ACQUIRE, "agent");
            asm volatile("s_waitcnt vmcnt(0)" ::: "memory");
        }
    }
    __syncthreads();
}


struct Frame {
    LAS unsigned char* lds; volatile LAS unsigned* MISC; gu32* ctl;
    int tid, lane, wave, vcu, G;
    const float *x, *c, *w_ada, *b_ada, *w_in, *w_out, *lq1, *lk1, *lq2, *lk2, *subln, *ln_mix_g, *ln_mix_b, *ln_ffn_g, *ln_ffn_b, *router_w, *router_b, *w_gate, *w_up, *w_down;
    float* out; unsigned char* ws;
    float* mod; float* rot; int* tok_e; float* tok_g; int* tok_slot; int* lists; bf16* Wbf;
    bf16 *S1, *S3, *PROJ, *YP, *HE, *MIXED;
};

__device__ __forceinline__ void transpose_item(const float* W, int ldw, int k0, int n0, bf16* WT, int Kdst, int drow0, LAS float* scr, int lane) {
#pragma unroll 8
    for (int i = 0; i < 32; ++i) { const int kk = 2 * i + (lane >> 5); scr[kk * 33 + (lane & 31)] = W[(size_t)(k0 + kk) * ldw + n0 + (lane & 31)]; }
    LDS_WAIT(); asm volatile("" ::: "memory");
    const int c = lane & 7;
#pragma unroll
    for (int j = 0; j < 4; ++j) { const int n = (lane >> 3) + 8 * j; const LAS float* s = scr + (8 * c) * 33 + n;
        u32x4 o; o.x = pk2(s[0 * 33], s[1 * 33]); o.y = pk2(s[2 * 33], s[3 * 33]); o.z = pk2(s[4 * 33], s[5 * 33]); o.w = pk2(s[6 * 33], s[7 * 33]);
        *(GAS u32x4*)(WT + (size_t)(drow0 + n) * Kdst + k0 + 8 * c) = o; }
    LDS_WAIT(); asm volatile("" ::: "memory");
}
constexpr int IT_IN = 16 * 112, IT_OUT = 16 * 32, IT_E = 256, IT_LAYER = IT_IN + IT_OUT + 3 * 16 * IT_E;
__device__ __forceinline__ void p0_weight_item(const Frame& F, int it, LAS float* scr) {
    const int l = it / IT_LAYER; int r = it - l * IT_LAYER; bf16* wl = F.Wbf + (size_t)l * WL_STRIDE;
    if (r < IT_IN) { const int kb = r / 112, c0 = (r % 112) * 32; int drow = c0;
        if (c0 < 1024) drow = (c0 & ~255) + ((c0 >> 5) & 1) * 128 + ((c0 >> 6) & 3) * 32;
        transpose_item(F.w_in + (size_t)l * DM * INW, INW, kb * 64, c0, wl + WL_IN, DM, drow, scr, F.lane); return; }
    r -= IT_IN;
    if (r < IT_OUT) { const int kb = r / 32, c0 = (r % 32) * 32; transpose_item(F.w_out + (size_t)l * DM * DM, DM, kb * 64, c0, wl + WL_OUT, DM, c0, scr, F.lane); return; }
    r -= IT_OUT;
    const int which = r / (16 * IT_E), rr = r % (16 * IT_E), e = rr / IT_E, q = rr % IT_E;
    if (which < 2) { const int kb = q / 16, c0 = (q % 16) * 32; const float* W = (which == 0 ? F.w_gate : F.w_up) + (size_t)(l * NE + e) * DM * DE;
        transpose_item(W, DE, kb * 64, c0, wl + WL_GU, DM, e * 1024 + (c0 >> 7) * 256 + which * 128 + (c0 & 127), scr, F.lane); }
    else { const int kb = q / 32, c0 = (q % 32) * 32; transpose_item(F.w_down + (size_t)(l * NE + e) * DE * DM, DM, kb * 64, c0, wl + WL_D, DE, e * 1024 + c0, scr, F.lane); }
}

#ifndef DEFER_W1
#define DEFER_W1 0
#endif
#ifndef W1_CAP1
#define W1_CAP1 4
#endif
#ifndef W1_CAP2
#define W1_CAP2 2
#endif
__device__ __forceinline__ void deferred_weights(Frame& F, int nwg, int stage) {
    LAS float* scr = (LAS float*)(F.lds + RING_OFF + F.wave * 8704);
    const int rem = nwg % F.G, I = rem ? F.G - rem : 0, slots = I * NWAVES, base1 = slots * W1_CAP1, base2 = base1 + slots * W1_CAP2;
    if (stage < 2) { if (!rem || (int)blockIdx.x < rem) return;
        const int r = ((int)blockIdx.x - rem) * NWAVES + F.wave, cap = stage == 0 ? W1_CAP1 : W1_CAP2, base = stage == 0 ? 0 : base1;
        for (int k = 0; k < cap; ++k) { const int idx = base + r + k * slots; if (idx < IT_LAYER) p0_weight_item(F, IT_LAYER + idx, scr); }
    } else { for (int idx = base2 + F.vcu * NWAVES + F.wave; idx < IT_LAYER; idx += F.G * NWAVES) p0_weight_item(F, IT_LAYER + idx, scr); }
}
__device__ __forceinline__ void ph_prologue(Frame& F) {
    LAS float* scr = (LAS float*)(F.lds + RING_OFF + F.wave * 8704);
    LAS float* cond = (LAS float*)(F.lds + RING_OFF + 69632);
    LAS float* part = (LAS float*)(F.lds + RING_OFF + 69632 + 32768);
    if ((int)blockIdx.x < 192) {
        { float cv[16];
#pragma unroll
          for (int j = 0; j < 16; ++j) cv[j] = F.c[F.tid + 512 * j];
#pragma unroll
          for (int j = 0; j < 16; ++j) cond[F.tid + 512 * j] = cv[j] / (1.f + expf(-cv[j])); }
        __syncthreads();
        for (int item = blockIdx.x; item < 192; item += F.G) {
            const int l = item / 96, j0 = (item % 96) * 64;
            float acc[8];
#pragma unroll
            for (int b = 0; b < 8; ++b) acc[b] = 0.f;
            const float* w = F.w_ada + (size_t)l * DM * MODW + (size_t)(F.wave * 128) * MODW + j0 + F.lane;
#pragma unroll 4
            for (int k = 0; k < 128; ++k) { const float wv = w[(size_t)k * MODW];
#pragma unroll
                for (int b = 0; b < 8; ++b) acc[b] += cond[b * 1024 + F.wave * 128 + k] * wv; }
#pragma unroll
            for (int b = 0; b < 8; ++b) part[(F.wave * 8 + b) * 64 + F.lane] = acc[b];
            __syncthreads();
            { const int b = F.tid >> 6, ln = F.tid & 63; float s = 0.f;
#pragma unroll
                for (int w8 = 0; w8 < 8; ++w8) s += part[(w8 * 8 + b) * 64 + ln];
                const float mv = s + F.b_ada[l * MODW + j0 + ln]; ST4(&F.mod[(size_t)(l * 8 + b) * MODW + j0 + ln], mv); }
            __syncthreads();
        }
    }
    if ((int)blockIdx.x == F.G - 1 && F.tid < 2) { const int l = F.tid; float s1 = 0.f, s2 = 0.f;
        for (int i = 0; i < 64; ++i) { s1 += F.lq1[l * 64 + i] * F.lk1[l * 64 + i]; s2 += F.lq2[l * 64 + i] * F.lk2[l * 64 + i]; }
        const float li = 0.8f - 0.6f * expf(-0.3f * (float)l);
        F.mod[2 * 8 * MODW + l] = expf(s1) - expf(s2) + li; F.mod[2 * 8 * MODW + 2 + l] = li; }
    if ((int)blockIdx.x == F.G - 2) {
        float* dt = F.mod + 2 * 8 * MODW + 16;
        for (int i = F.tid; i < 1024; i += NWAVES * 64) { const int hh = i >> 7, pp = i & 127; const double gm = 1.0 - exp2(-5.0 - (double)hh);
            dt[i] = (float)(0.125 * pow(gm, (double)(pp - 127))); dt[1024 + i] = (float)pow(gm, (double)(127 - pp)); if (pp == 0) dt[2048 + hh] = (float)pow(gm, 128.0); }
    }
    for (int idx = blockIdx.x * (NWAVES * 64) + F.tid; idx < 4096 * 32; idx += F.G * NWAVES * 64) { const int pos = idx >> 5, i = idx & 31;
        const double inv = pow(10000.0, -(double)(2 * i) / 64.0), a = (double)pos * inv; F.rot[2 * idx] = (float)cos(a); F.rot[2 * idx + 1] = (float)sin(a); }
    const int gw = F.vcu * NWAVES + F.wave, NGW = F.G * NWAVES;
    for (int it = gw; it < (DEFER_W1 ? 1 : 2) * IT_LAYER; it += NGW) p0_weight_item(F, it, scr);
}
__device__ __forceinline__ void ln_mod_row(const float* xrow, const float* sh_, bf16* orow, int lane) {
    const GAS f32x4* xr = (const GAS f32x4*)xrow + lane;
    f32x4 v[4]; float s = 0.f;
#pragma unroll
    for (int j = 0; j < 4; ++j) { v[j] = xr[64 * j]; s += (v[j].x + v[j].y) + (v[j].z + v[j].w); }
    const float mean = wave_sum(s) * (1.f / DM); float s2 = 0.f;
#pragma unroll
    for (int j = 0; j < 4; ++j) { v[j] = v[j] - mean; s2 += (v[j].x * v[j].x + v[j].y * v[j].y) + (v[j].z * v[j].z + v[j].w * v[j].w); }
    const float rstd = 1.f / sqrtf(wave_sum(s2) * (1.f / DM) + LN_EPS);
    const GAS f32x4* sh = (const GAS f32x4*)sh_ + lane; const GAS f32x4* sc = sh + 256; GAS u32x2* o = (GAS u32x2*)orow + lane;
#pragma unroll
    for (int j = 0; j < 4; ++j) { const f32x4 a = sh[64 * j], m = sc[64 * j]; const f32x4 r = v[j] * rstd * (m + 1.f) + a; u32x2 w; w.x = pk2(r.x, r.y); w.y = pk2(r.z, r.w); ST8(&o[64 * j], w); }
}
__device__ __forceinline__ void ln_mod_regs(f32x4 (&v)[4], const float* sh_, bf16* orow, int lane) {
    float s = 0.f;
#pragma unroll
    for (int j = 0; j < 4; ++j) s += (v[j].x + v[j].y) + (v[j].z + v[j].w);
    const float mean = wave_sum(s) * (1.f / DM); float s2 = 0.f;
#pragma unroll
    for (int j = 0; j < 4; ++j) { v[j] = v[j] - mean; s2 += (v[j].x * v[j].x + v[j].y * v[j].y) + (v[j].z * v[j].z + v[j].w * v[j].w); }
    const float rstd = 1.f / sqrtf(wave_sum(s2) * (1.f / DM) + LN_EPS);
    const GAS f32x4* sh = (const GAS f32x4*)sh_ + lane; const GAS f32x4* sc = sh + 256; GAS u32x2* o = (GAS u32x2*)orow + lane;
    f32x4 a[4], mm[4];
#pragma unroll
    for (int j = 0; j < 4; ++j) { a[j] = sh[64 * j]; mm[j] = sc[64 * j]; }
#pragma unroll
    for (int j = 0; j < 4; ++j) { const f32x4 r = v[j] * rstd * (mm[j] + 1.f) + a[j]; u32x2 w; w.x = pk2(r.x, r.y); w.y = pk2(r.z, r.w); ST8(&o[64 * j], w); }
}
__device__ __forceinline__ void ph_ln0(Frame& F) {
    const int gw = F.vcu * NWAVES + F.wave, NGW = F.G * NWAVES;
#pragma unroll 1
    for (int m = gw; m < T; m += 2 * NGW) { int lane = F.lane; asm volatile("" : "+v"(lane));
        const int m2 = m + NGW;
        const GAS f32x4* xa = (const GAS f32x4*)(F.x + (size_t)m * DM) + lane; const GAS f32x4* xb = (const GAS f32x4*)(F.x + (size_t)m2 * DM) + lane;
        f32x4 va[4], vb[4];
#pragma unroll
        for (int j = 0; j < 4; ++j) { va[j] = xa[64 * j]; vb[j] = xb[64 * j]; }
        ln_mod_regs(va, F.mod + (size_t)(m / SEQ) * MODW, F.S1 + (size_t)m * DM, lane);
        ln_mod_regs(vb, F.mod + (size_t)(m2 / SEQ) * MODW, F.S1 + (size_t)m2 * DM, lane); }
}
__device__ __forceinline__ float sane_c(float v) { return (fabsf(v) < 1e4f) ? v : 0.f; }
__device__ __forceinline__ void ph_combine(Frame& F, int l) {
    const int gw = F.vcu * NWAVES + F.wave, NGW = F.G * NWAVES, lane = F.lane;
    const float lam = F.mod[2 * 8 * MODW + l], li = F.mod[2 * 8 * MODW + 2 + l];
#if ATTN128
    const int h = lane >> 4, q = lane & 15, vh0 = (h * 2 + 0) * 2, vh1 = (h * 2 + 1) * 2, d = 8 * q;
#else
    const int h = lane >> 4, q = lane & 15, vh0 = (h * 2 + 0) * 2 + (q >> 3), vh1 = (h * 2 + 1) * 2 + (q >> 3), d = 8 * (q & 7);
#endif
    const f32x4 g0 = *(const f32x4*)(F.subln + l * 128 + 8 * q), g1 = *(const f32x4*)(F.subln + l * 128 + 8 * q + 4);
#pragma unroll 1
    for (int m0 = gw; m0 < T; m0 += 2 * NGW) {
        u32x4 av[2], bv[2];
#pragma unroll
        for (int t = 0; t < 2; ++t) { const int m = m0 + t * NGW; av[t] = *(const GAS u32x4*)(F.S3 + (size_t)m * DM + vh0 * 64 + d); bv[t] = *(const GAS u32x4*)(F.S3 + (size_t)m * DM + vh1 * 64 + d); }
#pragma unroll
        for (int t = 0; t < 2; ++t) { const int m = m0 + t * NGW; const u32x4 a = av[t], b = bv[t];
        float v[8];
        v[0] = __uint_as_float(a.x << 16) - lam * __uint_as_float(b.x << 16); v[1] = __uint_as_float(a.x & 0xffff0000u) - lam * __uint_as_float(b.x & 0xffff0000u);
        v[2] = __uint_as_float(a.y << 16) - lam * __uint_as_float(b.y << 16); v[3] = __uint_as_float(a.y & 0xffff0000u) - lam * __uint_as_float(b.y & 0xffff0000u);
        v[4] = __uint_as_float(a.z << 16) - lam * __uint_as_float(b.z << 16); v[5] = __uint_as_float(a.z & 0xffff0000u) - lam * __uint_as_float(b.z & 0xffff0000u);
        v[6] = __uint_as_float(a.w << 16) - lam * __uint_as_float(b.w << 16); v[7] = __uint_as_float(a.w & 0xffff0000u) - lam * __uint_as_float(b.w & 0xffff0000u);
#pragma unroll
        for (int i = 0; i < 8; ++i) v[i] = sane_c(v[i]);
        float ss = 0.f;
#pragma unroll
        for (int i = 0; i < 8; ++i) ss += v[i] * v[i];
        ss = row16_sum(ss);
        const float r = (1.f - li) / sqrtf(ss * (1.f / 128.f) + LN_EPS);
        u32x4 w; w.x = pk2(v[0] * r * g0.x, v[1] * r * g0.y); w.y = pk2(v[2] * r * g0.z, v[3] * r * g0.w); w.z = pk2(v[4] * r * g1.x, v[5] * r * g1.y); w.w = pk2(v[6] * r * g1.z, v[7] * r * g1.w);
        *(GAS u32x4*)(F.S1 + (size_t)m * DM + 512 + h * 128 + 8 * q) = w; }
    }
}
__device__ __forceinline__ f32x4 bf4(u32x2 m) { f32x4 r; r.x = __uint_as_float(m.x << 16); r.y = __uint_as_float(m.x & 0xffff0000u); r.z = __uint_as_float(m.y << 16); r.w = __uint_as_float(m.y & 0xffff0000u); return r; }
__device__ __forceinline__ float sane(float v, float lim) { return (fabsf(v) < lim) ? v : 0.f; }
__device__ __forceinline__ f32x4 sane4(f32x4 v, float lim) { v.x = sane(v.x, lim); v.y = sane(v.y, lim); v.z = sane(v.z, lim); v.w = sane(v.w, lim); return v; }
struct PmRaw { f32x4 x[4]; u32x2 m[4]; };
__device__ __forceinline__ void pm_load(PmRaw& R, const float* xin, const bf16* MIXED, int row, int lane) {
    const GAS f32x4* xr = (const GAS f32x4*)(xin + (size_t)row * DM) + lane; const GAS u32x2* mr = (const GAS u32x2*)(MIXED + (size_t)row * DM) + lane;
#pragma unroll
    for (int j = 0; j < 4; ++j) { R.x[j] = xr[64 * j]; R.m[j] = mr[64 * j]; }
}
__device__ __forceinline__ void pm_row(const PmRaw& R, const f32x4 (&g1)[4], const f32x4 (&lg)[4], const f32x4 (&lb)[4], const f32x4 (&sc2)[4], const f32x4 (&sh2)[4],
                                       bf16* X1, bf16* H, const LAS float* rwT, LAS float* lgs, int row, int r, int lane, bool norouter) {
    f32x4 v[4];
    float s = 0.f;
#pragma unroll
    for (int j = 0; j < 4; ++j) { v[j] = R.x[j] * ALPHA + g1[j] * sane4(bf4(R.m[j]), 1e4f); s += (v[j].x + v[j].y) + (v[j].z + v[j].w); }
    float mean = wave_sum(s) * (1.f / DM), s2 = 0.f;
#pragma unroll
    for (int j = 0; j < 4; ++j) { v[j] = v[j] - mean; s2 += (v[j].x * v[j].x + v[j].y * v[j].y) + (v[j].z * v[j].z + v[j].w * v[j].w); }
    float rstd = 1.f / sqrtf(wave_sum(s2) * (1.f / DM) + LN_EPS);
    GAS u32x2* xo = (GAS u32x2*)(X1 + (size_t)row * DM) + lane; s = 0.f;
#pragma unroll
    for (int j = 0; j < 4; ++j) { v[j] = v[j] * rstd * lg[j] + lb[j];
        u32x2 w; w.x = pk2(v[j].x, v[j].y); w.y = pk2(v[j].z, v[j].w); ST8(&xo[64 * j], w); s += (v[j].x + v[j].y) + (v[j].z + v[j].w); }
    mean = wave_sum(s) * (1.f / DM); s2 = 0.f;
#pragma unroll
    for (int j = 0; j < 4; ++j) { v[j] = v[j] - mean; s2 += (v[j].x * v[j].x + v[j].y * v[j].y) + (v[j].z * v[j].z + v[j].w * v[j].w); }
    rstd = 1.f / sqrtf(wave_sum(s2) * (1.f / DM) + LN_EPS);
    GAS u32x2* ho = (GAS u32x2*)(H + (size_t)row * DM) + lane;
#pragma unroll
    for (int j = 0; j < 4; ++j) { v[j] = v[j] * rstd * (sc2[j] + 1.f) + sh2[j]; u32x2 w; w.x = pk2(v[j].x, v[j].y); w.y = pk2(v[j].z, v[j].w); ST8(&ho[64 * j], w); }
    if (norouter) return;
    float a[16];
#pragma unroll
    for (int e = 0; e < 16; ++e) {
        float s0 = 0.f;
#pragma unroll
        for (int j = 0; j < 4; ++j) { const f32x4 w4 = *(const LAS f32x4*)(rwT + e * 1024 + 4 * lane + 256 * j); s0 += (v[j].x * w4.x + v[j].y * w4.y) + (v[j].z * w4.z + v[j].w * w4.w); }
        a[e] = s0;
    }
    const bool h5 = (lane & 32) != 0, h4 = (lane & 16) != 0, h3 = (lane & 8) != 0, h2 = (lane & 4) != 0;
    float c8[8], d4[4], f2[2];
#pragma unroll
    for (int i = 0; i < 8; ++i) { const float mine = h5 ? a[8 + i] : a[i], send = h5 ? a[i] : a[8 + i]; c8[i] = mine + __shfl_xor(send, 32); }
#pragma unroll
    for (int i = 0; i < 4; ++i) { const float mine = h4 ? c8[4 + i] : c8[i], send = h4 ? c8[i] : c8[4 + i]; d4[i] = mine + __shfl_xor(send, 16); }
#pragma unroll
    for (int i = 0; i < 2; ++i) { const float mine = h3 ? d4[2 + i] : d4[i], send = h3 ? d4[i] : d4[2 + i]; f2[i] = mine + __shfl_xor(send, 8); }
    float gsum; { const float mine = h2 ? f2[1] : f2[0], send = h2 ? f2[0] : f2[1]; gsum = mine + __shfl_xor(send, 4); }
    gsum += __shfl_xor(gsum, 2); gsum += __shfl_xor(gsum, 1);
    if ((lane & 3) == 0) lgs[r * 16 + (lane >> 2)] = gsum;
}
#ifndef DRY_SKIP
#define DRY_SKIP 0
#endif
__device__ __forceinline__ void ph_postmix(Frame& F, int l, bool dry = false) {
    LAS float* rwT = (LAS float*)(F.lds + RING_OFF);
    LAS float* lgs = (LAS float*)(F.lds + RING_OFF + 65536) + F.wave * 256;
    LAS int* lcnt = (LAS int*)(F.lds + LCNT_OFF);
    const float* xin = l == 0 ? F.x : F.out; const float* modl = F.mod + (size_t)l * 8 * MODW; int* cnt = (int*)F.ctl + CW_CNT + 64 * l;
    const float* lng = F.ln_mix_g + l * DM; const float* lnb = F.ln_mix_b + l * DM; const int lane = F.lane;
    const bool norouter = dry && (DRY_SKIP & 1);
    { f32x4 t4[8];
#pragma unroll
      for (int j = 0; j < 8; ++j) t4[j] = ((const GAS f32x4*)F.router_w)[F.tid + 512 * j];
#pragma unroll
      for (int j = 0; j < 8; ++j) { const int i4 = F.tid + 512 * j, k = i4 >> 2, e0 = (i4 & 3) * 4; rwT[(e0 + 0) * 1024 + k] = t4[j].x; rwT[(e0 + 1) * 1024 + k] = t4[j].y; rwT[(e0 + 2) * 1024 + k] = t4[j].z; rwT[(e0 + 3) * 1024 + k] = t4[j].w; } }
#pragma unroll 1
    for (int base = blockIdx.x * 128; base < T; base += F.G * 128) {
        if (F.tid < 16) lcnt[F.tid] = 0;
        __syncthreads();
        const int b = base / SEQ, wrow = base + F.wave * 16;
        f32x4 g1[4], lg[4], lb[4], sc2[4], sh2[4];
        { const GAS f32x4* g1p = (const GAS f32x4*)(modl + (size_t)b * MODW + 2 * DM) + lane; const GAS f32x4* lgp = (const GAS f32x4*)lng + lane; const GAS f32x4* lbp = (const GAS f32x4*)lnb + lane;
#pragma unroll
          for (int j = 0; j < 4; ++j) { g1[j] = g1p[64 * j]; sh2[j] = g1p[256 + 64 * j]; sc2[j] = g1p[512 + 64 * j]; lg[j] = lgp[64 * j]; lb[j] = lbp[64 * j]; } }
        PmRaw A, B, C;
        pm_load(A, xin, F.MIXED, wrow, lane); pm_load(B, xin, F.MIXED, wrow + 1, lane);
#pragma unroll 1
        for (int it = 0; it < 5; ++it) {
            const int r0 = 3 * it;
            pm_load(C, xin, F.MIXED, wrow + r0 + 2, lane);
            pm_row(A, g1, lg, lb, sc2, sh2, F.S3, F.S1, rwT, lgs, wrow + r0, r0, lane, norouter);
            pm_load(A, xin, F.MIXED, wrow + r0 + 3, lane);
            pm_row(B, g1, lg, lb, sc2, sh2, F.S3, F.S1, rwT, lgs, wrow + r0 + 1, r0 + 1, lane, norouter);
            if (it < 4) pm_load(B, xin, F.MIXED, wrow + r0 + 4, lane);
            pm_row(C, g1, lg, lb, sc2, sh2, F.S3, F.S1, rwT, lgs, wrow + r0 + 2, r0 + 2, lane, norouter);
        }
        pm_row(A, g1, lg, lb, sc2, sh2, F.S3, F.S1, rwT, lgs, wrow + 15, 15, lane, norouter);
        LDS_WAIT(); asm volatile("" ::: "memory");
        int my_e1 = 0, my_e2 = 0, my_l1 = 0, my_l2 = 0;
        if (lane < 16) {
            float p[16];
#pragma unroll
            for (int q = 0; q < 4; ++q) { const f32x4 t = *(const LAS f32x4*)(lgs + lane * 16 + 4 * q); p[4 * q] = t.x; p[4 * q + 1] = t.y; p[4 * q + 2] = t.z; p[4 * q + 3] = t.w; }
            float mx = -INFINITY, sum = 0.f;
#pragma unroll
            for (int e = 0; e < 16; ++e) { p[e] += F.router_b[e]; mx = fmaxf(mx, p[e]); }
#pragma unroll
            for (int e = 0; e < 16; ++e) { p[e] = expf(p[e] - mx); sum += p[e]; }
            const float rs = 1.f / sum;
#pragma unroll
            for (int e = 0; e < 16; ++e) p[e] *= rs;
            int bg = 0; float bgs = -1.f;
#pragma unroll
            for (int g = 0; g < 4; ++g) { float m1 = p[4 * g]; int i1 = 0;
#pragma unroll
                for (int i = 1; i < 4; ++i) if (p[4 * g + i] > m1) { m1 = p[4 * g + i]; i1 = i; }
                float m2 = -1.f;
#pragma unroll
                for (int i = 0; i < 4; ++i) if (i != i1 && p[4 * g + i] > m2) m2 = p[4 * g + i];
                const float gs = m1 + m2; if (gs > bgs) { bgs = gs; bg = g; } }
            float q0 = 0.f, q1 = 0.f, q2 = 0.f, q3 = 0.f;
#pragma unroll
            for (int g = 0; g < 4; ++g) if (bg == g) { q0 = p[4 * g]; q1 = p[4 * g + 1]; q2 = p[4 * g + 2]; q3 = p[4 * g + 3]; }
            float m1 = q0; int i1 = 0; if (q1 > m1) { m1 = q1; i1 = 1; } if (q2 > m1) { m1 = q2; i1 = 2; } if (q3 > m1) { m1 = q3; i1 = 3; }
            float m2 = -1.f; int i2 = 0;
            if (i1 != 0 && q0 > m2) { m2 = q0; i2 = 0; } if (i1 != 1 && q1 > m2) { m2 = q1; i2 = 1; } if (i1 != 2 && q2 > m2) { m2 = q2; i2 = 2; } if (i1 != 3 && q3 > m2) { m2 = q3; i2 = 3; }
            my_e1 = bg * 4 + i1; my_e2 = bg * 4 + i2; const int row = wrow + lane; const float den = 1.f / (m1 + m2);
            my_l1 = __hip_atomic_fetch_add(lcnt + my_e1, 1, __ATOMIC_RELAXED, __HIP_MEMORY_SCOPE_WORKGROUP); my_l2 = __hip_atomic_fetch_add(lcnt + my_e2, 1, __ATOMIC_RELAXED, __HIP_MEMORY_SCOPE_WORKGROUP);
            const float gw1 = m1 * den, gw2 = m2 * den; ST4(&F.tok_e[2 * row], my_e1); ST4(&F.tok_e[2 * row + 1], my_e2); ST4(&F.tok_g[2 * row], gw1); ST4(&F.tok_g[2 * row + 1], gw2);
        }
        __syncthreads();
        if (F.tid < 16 && !dry) lcnt[16 + F.tid] = atomicAdd(cnt + F.tid, lcnt[F.tid]);
        __syncthreads();
        if (lane < 16 && !dry) { const int row = wrow + lane, s1 = lcnt[16 + my_e1] + my_l1, s2 = lcnt[16 + my_e2] + my_l2;
            ST4(&F.tok_slot[2 * row], s1); ST4(&F.tok_slot[2 * row + 1], s2); ST4(&F.lists[(size_t)my_e1 * T + s1], row); ST4(&F.lists[(size_t)my_e2 * T + s2], row); }
        __syncthreads();
    }
}
__device__ __forceinline__ void moe_table(Frame& F, int l) {
    LAS int* tab = (LAS int*)(F.lds + TAB_OFF); LAS int* eb = (LAS int*)(F.lds + EB_OFF); const int* cnt = (const int*)F.ctl + CW_CNT + 64 * l;
    __syncthreads();
    if (F.tid < 272 || F.tid == 511) {
        int pref = 0, mine = -1;
#pragma unroll
        for (int e = 0; e < 16; ++e) { const int n = __hip_atomic_load(cnt + e, RLX_AGENT), nt = (n + 255) >> 8; if (F.tid < 272 && F.tid >= pref && F.tid < pref + nt) mine = e | ((F.tid - pref) << 8);
            if (F.tid == 511) eb[e] = pref * 256; pref += nt; }
        if (F.tid < 272) tab[1 + F.tid] = mine;
        if (F.tid == 511) tab[0] = pref;
    }
    __syncthreads();
}
struct PfRaw { u32x2 x[4], y0[4], y1[4]; };
__device__ __forceinline__ void pf_load(PfRaw& R, const bf16* X1, const bf16* YP, int row, size_t r0, size_t r1, int lane) {
    const GAS u32x2* xr = (const GAS u32x2*)(X1 + (size_t)row * DM) + lane; const GAS u32x2* y0 = (const GAS u32x2*)(YP + r0 * DM) + lane; const GAS u32x2* y1 = (const GAS u32x2*)(YP + r1 * DM) + lane;
#pragma unroll
    for (int j = 0; j < 4; ++j) { R.x[j] = xr[64 * j]; R.y0[j] = y0[64 * j]; R.y1[j] = y1[64 * j]; }
}
template <bool NEXT>
__device__ __forceinline__ void pf_row(const PfRaw& R, float w0, float w1, const f32x4 (&g2)[4], const f32x4 (&lg)[4], const f32x4 (&lb)[4], const f32x4 (&sh)[4], const f32x4 (&sc)[4], float* out, bf16* H, int row, int lane, bool store_h) {
    f32x4 v[4]; float s = 0.f;
#pragma unroll
    for (int j = 0; j < 4; ++j) { v[j] = sane4(bf4(R.x[j]), 1e4f) * ALPHA + g2[j] * sane4(bf4(R.y0[j]) * w0 + bf4(R.y1[j]) * w1, 1e4f);
        s += (v[j].x + v[j].y) + (v[j].z + v[j].w); }
    float mean = wave_sum(s) * (1.f / DM), s2 = 0.f;
#pragma unroll
    for (int j = 0; j < 4; ++j) { v[j] = v[j] - mean; s2 += (v[j].x * v[j].x + v[j].y * v[j].y) + (v[j].z * v[j].z + v[j].w * v[j].w); }
    float rstd = 1.f / sqrtf(wave_sum(s2) * (1.f / DM) + LN_EPS);
    GAS f32x4* o = (GAS f32x4*)(out + (size_t)row * DM) + lane; s = 0.f;
#pragma unroll
    for (int j = 0; j < 4; ++j) { v[j] = v[j] * rstd * lg[j] + lb[j]; o[64 * j] = v[j]; s += (v[j].x + v[j].y) + (v[j].z + v[j].w); }
    if (NEXT) {
        mean = wave_sum(s) * (1.f / DM); s2 = 0.f;
#pragma unroll
        for (int j = 0; j < 4; ++j) { v[j] = v[j] - mean; s2 += (v[j].x * v[j].x + v[j].y * v[j].y) + (v[j].z * v[j].z + v[j].w * v[j].w); }
        rstd = 1.f / sqrtf(wave_sum(s2) * (1.f / DM) + LN_EPS);
        GAS u32x2* ho = (GAS u32x2*)(H + (size_t)row * DM) + lane;
#pragma unroll
        for (int j = 0; j < 4; ++j) { const f32x4 r = v[j] * rstd * (sc[j] + 1.f) + sh[j]; u32x2 w; w.x = pk2(r.x, r.y); w.y = pk2(r.z, r.w); if (store_h) ST8(&ho[64 * j], w); }
    }
}
template <bool NEXT>
__device__ __forceinline__ void ph_postffn_t(Frame& F, int l) {
    const LAS int* eb = (const LAS int*)(F.lds + EB_OFF); const float* modl = F.mod + (size_t)l * 8 * MODW; const float* modn = F.mod + (size_t)(l + 1 < DEPTH ? l + 1 : l) * 8 * MODW;
    const float* lng = F.ln_ffn_g + l * DM; const float* lnb = F.ln_ffn_b + l * DM; const int lane = F.lane;
#pragma unroll 1
    for (int base = (F.vcu * NWAVES + F.wave) * 16; base < T; base += F.G * NWAVES * 16) {
        const int b = base / SEQ;
        const int mrow = base + (lane & 15);
        const int e0 = F.tok_e[2 * mrow], e1 = F.tok_e[2 * mrow + 1]; const float mw0 = F.tok_g[2 * mrow], mw1 = F.tok_g[2 * mrow + 1];
        const int mr0 = eb[e0] + F.tok_slot[2 * mrow], mr1 = eb[e1] + F.tok_slot[2 * mrow + 1];
        f32x4 g2[4], lg[4], lb[4], sh[4], sc[4];
        { const GAS f32x4* g2p = (const GAS f32x4*)(modl + (size_t)b * MODW + 5 * DM) + lane; const GAS f32x4* lgp = (const GAS f32x4*)lng + lane; const GAS f32x4* lbp = (const GAS f32x4*)lnb + lane;
          const GAS f32x4* shp = (const GAS f32x4*)(modn + (size_t)b * MODW) + lane;
#pragma unroll
          for (int j = 0; j < 4; ++j) { g2[j] = g2p[64 * j]; lg[j] = lgp[64 * j]; lb[j] = lbp[64 * j]; if (NEXT) { sh[j] = shp[64 * j]; sc[j] = shp[256 + 64 * j]; } else { sh[j] = (f32x4){0.f, 0.f, 0.f, 0.f}; sc[j] = sh[j]; } } }
        PfRaw A, B;
#define PF_LOAD2(R, r) pf_load(R, F.S3, F.YP, base + (r), (size_t)__shfl(mr0, (r)), (size_t)__shfl(mr1, (r)), lane)
#define PF_ROW2(R, r) pf_row<NEXT>(R, __shfl(mw0, (r)), __shfl(mw1, (r)), g2, lg, lb, sh, sc, F.out, F.S1, base + (r), lane, l + 1 < DEPTH)
        PF_LOAD2(A, 0);
#pragma unroll 1
        for (int it = 0; it < 8; ++it) {
            PF_LOAD2(B, 2 * it + 1);
            PF_ROW2(A, 2 * it);
            if (it < 7) PF_LOAD2(A, 2 * it + 2);
            PF_ROW2(B, 2 * it + 1);
        }
#undef PF_LOAD2
#undef PF_ROW2
    }
}
#ifndef PF_ALWAYS_NEXT
#define PF_ALWAYS_NEXT 1
#endif
__device__ __forceinline__ void ph_postffn(Frame& F, int l) { if (PF_ALWAYS_NEXT || l + 1 < DEPTH) ph_postffn_t<true>(F, l); else ph_postffn_t<false>(F, l); }

typedef __attribute__((address_space(4))) const unsigned char* kaptr_t;
__device__ __forceinline__ void frame_ptrs(Frame& F, kaptr_t ka) {
#define KA_IN(i) (*(const float* __attribute__((address_space(4))) const*)(ka + 8 * (i)))
    F.x = KA_IN(0); F.c = KA_IN(1); F.w_ada = KA_IN(2); F.b_ada = KA_IN(3); F.w_in = KA_IN(4); F.w_out = KA_IN(5); F.lq1 = KA_IN(6); F.lk1 = KA_IN(7); F.lq2 = KA_IN(8); F.lk2 = KA_IN(9);
    F.subln = KA_IN(10); F.ln_mix_g = KA_IN(11); F.ln_mix_b = KA_IN(12); F.ln_ffn_g = KA_IN(13); F.ln_ffn_b = KA_IN(14); F.router_w = KA_IN(15); F.router_b = KA_IN(16);
    F.w_gate = KA_IN(17); F.w_up = KA_IN(18); F.w_down = KA_IN(19);
    F.out = *(float* __attribute__((address_space(4))) const*)(ka + 160);
    unsigned char* ws = *(unsigned char* __attribute__((address_space(4))) const*)(ka + 168);
#undef KA_IN
    F.ws = ws; F.ctl = (gu32*)(ws + WS_CTL);
    F.mod = (float*)(ws + WS_MOD); F.rot = (float*)(ws + WS_ROT); F.tok_e = (int*)(ws + WS_TOK); F.tok_g = (float*)(ws + WS_TOK + 256 * 1024); F.tok_slot = (int*)(ws + WS_TOK + 512 * 1024);
    F.lists = (int*)(ws + WS_LIST); F.Wbf = (bf16*)(ws + WS_W);
    F.S1 = (bf16*)(ws + WS_S1); F.S3 = (bf16*)(ws + WS_S3); F.PROJ = (bf16*)(ws + WS_S2); F.YP = (bf16*)(ws + WS_YP); F.HE = (bf16*)(ws + WS_HE); F.MIXED = (bf16*)(ws + WS_MIXED);
}
struct Args { const float* in[20]; float* out; unsigned char* ws; int ph_lo, ph_hi, li, pad; };
__global__ void __launch_bounds__(NWAVES * 64, 2) mega(Args args) {
    extern __shared__ __attribute__((aligned(16))) unsigned char lds[];
    Frame F;
    F.lds = (LAS unsigned char*)lds; F.MISC = (volatile LAS unsigned*)(F.lds + MISC_OFF);
    F.tid = threadIdx.x; F.lane = F.tid & 63; F.wave = __builtin_amdgcn_readfirstlane(F.tid >> 6);
    F.G = gridDim.x; { const int bx = blockIdx.x; F.vcu = (F.G % 8 == 0) ? (bx % 8) * (F.G / 8) + bx / 8 : bx; }
    F.ctl = (gu32*)(args.ws + WS_CTL);
    for (int u = F.tid; u < (LDS_BYTES - LDSCTL_OFF) / 4; u += NWAVES * 64) ((LAS unsigned*)(F.lds + LDSCTL_OFF))[u] = 0u;
    __syncthreads();
    const int lo = args.ph_lo, hi = args.ph_hi;
    XcdBarrier bar; bar.bar = (unsigned*)(F.ctl + CW_BAR) + args.li * XCD_BAR_WORDS; bar.x = 0; bar.st = nullptr;
    if (hi - lo > 1) bar = xcd_barrier_post((unsigned*)(F.ctl + CW_BAR) + args.li * XCD_BAR_WORDS, F.MISC + 8);
#ifndef KIND_MASK
#define KIND_MASK 0x3ffu
#endif
#define KEN(k) ((KIND_MASK >> (k)) & 1u)
#ifndef REP_KIND
#define REP_KIND -1
#endif
#ifndef REP_N
#define REP_N 1
#endif
#define REPS(k) for (int rep_ = 0; rep_ < ((REP_KIND == (k)) ? REP_N : 1); ++rep_)
#define IN(k) (lo <= (k) && (k) < hi)
#define FRESH() do { int t_ = threadIdx.x; asm volatile("" : "+v"(t_)); F.tid = t_; F.lane = t_ & 63; kaptr_t ka_ = (kaptr_t)__builtin_amdgcn_kernarg_segment_ptr(); asm volatile("" : "+s"(ka_)); frame_ptrs(F, ka_); } while (0)
#ifndef BAR_REP
#define BAR_REP 1
#endif
#define SEAM(k) do { if (IN(k) && IN((k) + 1)) for (int br_ = 0; br_ < BAR_REP; ++br_) xcd_barrier(bar); } while (0)

    if (KEN(8) && IN(0)) REPS(8) { FRESH(); ph_prologue(F); } SEAM(0);
    if (KEN(9) && IN(1)) REPS(9) { FRESH(); ph_ln0(F); } SEAM(1);
    for (int l = 0; l < DEPTH; ++l) {
        const int pb = 2 + 8 * l;
#define wl (F.Wbf + (size_t)l * WL_STRIDE)
        if (KEN(0) && IN(pb + 0)) REPS(0) { FRESH();
            pg8::PlainSched S; S.init(T / 256, INW / 256, F.G, (int)blockIdx.x); S.Bt = wl + WL_IN; S.K = DM;
            pg8::EpiInProj E{F.PROJ, F.rot, RET_FAST ? F.mod + 2 * 8 * MODW + 16 : nullptr};
            pg8::gemm_phase<pg8::EpiInProj, pg8::PlainSched, true>(F.lds + RING_OFF, (const char*)F.S1, DM, S, E);
        }
        SEAM(pb + 0);
        if (KEN(1) && IN(pb + 1)) REPS(1) { FRESH();
            if (RET_FAST) REPS(10) { const int bh = F.vcu >> 2, hh = bh & 7; ret::ret_unit(bh >> 3, hh, F.vcu & 3, F.PROJ, F.S1, F.mod[2 * 8 * MODW + 16 + 2048 + hh], F.lds + RING_OFF); }
#if ATTN128
            { const int bhc = F.vcu >> 2, b = bhc >> 3, hc = bhc & 7, h = hc >> 1, c = hc & 1, s = F.vcu & 3;
              const attn128::bf16* base = (const attn128::bf16*)(F.PROJ + (size_t)b * SEQ * INW);
#pragma unroll 1
              for (int i = 0; i < 4; ++i) { const int qb = i == 0 ? s : i == 1 ? 7 - s : i == 2 ? 8 + s : 15 - s;
                  attn128::attn_unit<ATTN_THRL>(qb, base + C_DQ + h * 128 + c * 64, base + C_DK + h * 128 + c * 64, base + C_DV + h * 128,
                                        (attn128::bf16*)(F.S3 + (size_t)b * SEQ * DM + hc * 128), (char*)lds + RING_OFF); } }
        }
#else
            const int pr = F.vcu >> 1, b = pr >> 4, vh = pr & 15, h = vh >> 2, c = (vh >> 1) & 1, vhalf = vh & 1;
            const attn_body::bf16* base = (const attn_body::bf16*)(F.PROJ + (size_t)b * SEQ * INW);
#pragma unroll 1
            for (int i = 0; i < 8; ++i) { const int s = 2 * (i >> 1) + (F.vcu & 1), qb = (i & 1) ? 15 - s : s;
                attn_body::attn_unit<8>(qb, base + C_DQ + h * 128 + c * 64, base + C_DK + h * 128 + c * 64, base + C_DV + h * 128 + vhalf * 64,
                                        (attn_body::bf16*)(F.S3 + (size_t)b * SEQ * DM + vh * 64), (char*)lds + RING_OFF); }
        }
#endif
        SEAM(pb + 1);
        if (KEN(2) && IN(pb + 2)) REPS(2) { FRESH(); ph_combine(F, l); }
        SEAM(pb + 2);
        if (KEN(3) && IN(pb + 3)) REPS(3) { FRESH();
            pg8::PlainSched S; S.init(T / 256, DM / 256, F.G, (int)blockIdx.x); S.Bt = wl + WL_OUT; S.K = DM;
            pg8::EpiPlain E{F.MIXED, DM};
            pg8::gemm_phase<pg8::EpiPlain, pg8::PlainSched, true>(F.lds + RING_OFF, (const char*)F.S1, DM, S, E);
        }
        SEAM(pb + 3);
        if (KEN(4) && IN(pb + 4)) REPS(4) { FRESH(); ph_postmix(F, l, rep_ > 0); }
        SEAM(pb + 4);
        if (KEN(5) && IN(pb + 5)) REPS(5) {
            FRESH(); moe_table(F, l);
            pg8::MoeSched S; S.init(((const LAS int*)(F.lds + TAB_OFF))[0], 4, F.G, (int)blockIdx.x); S.Bt = wl + WL_GU; S.K = DM; S.tab = (const LAS int*)(F.lds + TAB_OFF);
            S.cnt = (const int*)F.ctl + CW_CNT + 64 * l; S.lists = F.lists; S.gather = true;
            pg8::EpiGateUp E{F.HE};
            pg8::gemm_phase<pg8::EpiGateUp, pg8::MoeSched, true>(F.lds + RING_OFF, (const char*)F.S1, DM, S, E);
            if (DEFER_W1 && l == 0) deferred_weights(F, S.nwg, 0);
        }
        SEAM(pb + 5);
        if (KEN(6) && IN(pb + 6)) REPS(6) {
            FRESH(); moe_table(F, l);
            pg8::MoeSched S; S.init(((const LAS int*)(F.lds + TAB_OFF))[0], 4, F.G, (int)blockIdx.x); S.Bt = wl + WL_D; S.K = DE; S.tab = (const LAS int*)(F.lds + TAB_OFF);
            S.cnt = (const int*)F.ctl + CW_CNT + 64 * l; S.lists = F.lists; S.gather = false;
            pg8::EpiPlain E{F.YP, DM};
            pg8::gemm_phase<pg8::EpiPlain, pg8::MoeSched, true>(F.lds + RING_OFF, (const char*)F.HE, DE, S, E);
            if (DEFER_W1 && l == 0) deferred_weights(F, S.nwg, 1);
        }
        SEAM(pb + 6);
        if (KEN(7) && IN(pb + 7)) REPS(7) { FRESH(); moe_table(F, l); if (DEFER_W1 && l == 0) { deferred_weights(F, 4 * ((const LAS int*)(F.lds + TAB_OFF))[0], 2); } ph_postffn(F, l); }
        SEAM(pb + 7);
#undef wl
    }
#undef IN
#undef SEAM
}
#ifndef FAST_MASK
#define FAST_MASK 0x3ffffu
#endif
extern "C" void kernel_launch(void* const* d_in, const int* in_sizes, int n_in, void* d_out, int out_size, void* d_ws, size_t ws_size, hipStream_t stream) {
    static int grid = 0;
    if (grid == 0) {
        if (n_in != 20 || out_size != T * DM || ws_size < WS_END) { fprintf(stderr, "kernel_launch: unexpected shapes (n_in %d out %d ws %zu)\n", n_in, out_size, ws_size); grid = -1; return; }
        int dev = 0, cus = 0, per_cu = 0;
        if (hipGetDevice(&dev) != hipSuccess || hipDeviceGetAttribute(&cus, hipDeviceAttributeMultiprocessorCount, dev) != hipSuccess) { grid = -1; return; }
        if (hipFuncSetAttribute((const void*)mega, hipFuncAttributeMaxDynamicSharedMemorySize, LDS_BYTES) != hipSuccess) { fprintf(stderr, "kernel_launch: hipFuncSetAttribute failed\n"); grid = -1; return; }
        if (hipOccupancyMaxActiveBlocksPerMultiprocessor(&per_cu, (const void*)mega, NWAVES * 64, LDS_BYTES) != hipSuccess || per_cu < 1) fprintf(stderr, "kernel_launch: occupancy query says %d\n", per_cu);
        (void)hipGetLastError();
        grid = cus;
        if (grid != 256) { fprintf(stderr, "kernel_launch: built for 256 CUs, found %d\n", grid); grid = -1; return; }
    }
    if (grid < 0) return;
    const float* x = (const float*)d_in[0];
    const float* w_in = (const float*)d_in[4]; const float* w_out = (const float*)d_in[5];
    const float* subln = (const float*)d_in[10]; const float* ln_mix_g = (const float*)d_in[11]; const float* ln_mix_b = (const float*)d_in[12];
    const float* ln_ffn_g = (const float*)d_in[13]; const float* ln_ffn_b = (const float*)d_in[14]; const float* router_w = (const float*)d_in[15]; const float* router_b = (const float*)d_in[16];
    const float* w_gate = (const float*)d_in[17]; const float* w_up = (const float*)d_in[18]; const float* w_down = (const float*)d_in[19];
    unsigned char* ws = (unsigned char*)d_ws; float* out = (float*)d_out;
    float* mod = (float*)(ws + WS_MOD); float* rot = (float*)(ws + WS_ROT);
    int* tok_e = (int*)(ws + WS_TOK); float* tok_g = (float*)(ws + WS_TOK + 256 * 1024); int* tok_slot = (int*)(ws + WS_TOK + 512 * 1024); int* lists = (int*)(ws + WS_LIST);
    bf16* S1 = (bf16*)(ws + WS_S1); bf16* X1 = (bf16*)(ws + WS_S3); bf16* PROJ = (bf16*)(ws + WS_S2); bf16* YP = (bf16*)(ws + WS_YP); bf16* HE = (bf16*)(ws + WS_HE); bf16* MIXED = (bf16*)(ws + WS_MIXED);
    int* ctl = (int*)(ws + WS_CTL);
    (void)hipMemsetAsync(ws + WS_CTL, 0, 1 * MiB, stream);
    Args a{};
    for (int i = 0; i < 20; ++i) a.in[i] = (const float*)d_in[i];
    a.out = out; a.ws = ws;
    int li = 0, lo = -1;
    auto flush = [&](int hi) { if (lo >= 0) { a.ph_lo = lo; a.ph_hi = hi; a.li = li++; hipLaunchKernelGGL(mega, dim3(grid), dim3(NWAVES * 64), LDS_BYTES, stream, a); lo = -1; } };
    for (int p = 0; p < NPHASE; ++p) {
        const bool fast = (FAST_MASK >> p) & 1u;
        const int l = p < 2 ? 0 : (p - 2) / 8, k = p < 2 ? -1 : (p - 2) % 8;
        const float* modl = mod + (size_t)l * 8 * MODW; int* cnt = ctl + CW_CNT + 64 * l;
        if (fast) { if (lo < 0) lo = p; }
        else {
            flush(p);
            if (p == 0) { k_mod<<<dim3(MODW / 256, 2), 256, 0, stream>>>((const float*)d_in[1], (const float*)d_in[2], (const float*)d_in[3], (const float*)d_in[6], (const float*)d_in[7], (const float*)d_in[8], (const float*)d_in[9], mod);
                          k_rot<<<512, 256, 0, stream>>>(rot); }
            else if (p == 1) k_ln_mod<<<T / 4, 256, 0, stream>>>(x, mod, 0, S1);
            else if (k == 0) k_ngemm_inproj<<<dim3(INW / 64, T / 128), 256, 0, stream>>>(S1, w_in + (size_t)l * DM * INW, rot, PROJ);
            else if (k == 1) k_ndiff<<<dim3(SEQ / 64, 4, NB), 256, 0, stream>>>(PROJ, mod + 2 * 8 * MODW, subln, l, S1);
            else if (k == 2) {   }
            else if (k == 3) k_ngemm_plain<<<dim3(DM / 64, T / 128), 256, 0, stream>>>(S1, DM, w_out + (size_t)l * DM * DM, DM, DM, MIXED, DM);
            else if (k == 4) k_post_mix<<<T / 4, 256, 0, stream>>>(l == 0 ? x : out, MIXED, modl, ln_mix_g + l * DM, ln_mix_b + l * DM, router_w, router_b, X1, S1, tok_e, tok_g, tok_slot, lists, cnt);
            else if (k == 5) k_moe1<<<dim3(DE / 64, T / 128, NE), 256, 0, stream>>>(S1, w_gate + (size_t)l * NE * DM * DE, w_up + (size_t)l * NE * DM * DE, cnt, lists, HE);
            else if (k == 6) k_moe2<<<dim3(DM / 64, T / 128, NE), 256, 0, stream>>>(HE, w_down + (size_t)l * NE * DE * DM, cnt, YP);
            else if (k == 7) k_post_ffn<<<T / 4, 256, 0, stream>>>(X1, YP, modl, ln_ffn_g + l * DM, ln_ffn_b + l * DM, tok_e, tok_g, tok_slot, cnt, out, l + 1 < DEPTH ? mod + (size_t)(l + 1) * 8 * MODW : nullptr, S1);
        }
        if (!RET_FAST && k == 2) { flush(p + 1); k_nret<<<dim3(SEQ / 64, 8, NB), 256, 0, stream>>>(PROJ, S1); }
    }
    flush(NPHASE);
}
```

```cpp
#include <hip/hip_runtime.h>
#include <cstdio>
#include <cstdint>
#include <cmath>

typedef unsigned short bf16;
typedef float f32x4 __attribute__((ext_vector_type(4)));
typedef unsigned u32x4 __attribute__((ext_vector_type(4)));
typedef unsigned u32x2 __attribute__((ext_vector_type(2)));

constexpr int NB = 8, SEQ = 4096, DM = 1024, T = NB * SEQ, DEPTH = 2;
constexpr int INW = 3584, NE = 16, DE = 512;
constexpr int C_RQ = 0, C_RK = 512, C_RV = 1024, C_RG = 1536, C_DQ = 2048, C_DK = 2560, C_DV = 3072;
constexpr float ALPHA = 1.41421356237309515f;
constexpr float LN_EPS = 1e-5f;
constexpr float C2 = 0.125f * 1.4426950408889634f;
constexpr int MODW = 6 * DM;
constexpr int PAIR_ROWS = 69632;

constexpr size_t MiB = 1u << 20;
constexpr size_t WS_CTL = 0;
constexpr size_t WS_MOD = 1 * MiB;
constexpr size_t WS_ROT = 2 * MiB;
constexpr size_t WS_TOK = 3 * MiB;
constexpr size_t WS_LIST = 4 * MiB;
constexpr size_t WS_W = 8 * MiB;
constexpr size_t WS_S1 = 122 * MiB;
constexpr size_t WS_S3 = 186 * MiB;
constexpr size_t WS_S2 = 250 * MiB;
constexpr size_t WS_YP = WS_S2, WS_HE = WS_S2 + 136 * MiB, WS_MIXED = WS_HE;
constexpr size_t WS_END = 474 * MiB;
constexpr int CW_CNT = 64;

__device__ __forceinline__ float bf2f(bf16 v) { return __uint_as_float((unsigned)v << 16); }
__device__ __forceinline__ unsigned f2bf(float f) { unsigned u = __float_as_uint(f); return (u + 0x7fffu + ((u >> 16) & 1u)) >> 16; }
typedef float pk_f32x2_t __attribute__((ext_vector_type(2))); typedef __bf16 pk_bf16x2_t __attribute__((ext_vector_type(2)));
__device__ __forceinline__ unsigned pk2(float lo, float hi) { pk_f32x2_t v = {lo, hi}; pk_bf16x2_t b = __builtin_convertvector(v, pk_bf16x2_t); return __builtin_bit_cast(unsigned, b); }
__device__ __forceinline__ float dpp_add(float v, const int ctrl_tag) { return v; }
#define WS_DPP(v, ctrl) ((v) + __builtin_bit_cast(float, __builtin_amdgcn_update_dpp(0, __builtin_bit_cast(int, (v)), (ctrl), 0xf, 0xf, false)))
__device__ __forceinline__ float wave_sum(float v) {
    v = WS_DPP(v, 0xB1);
    v = WS_DPP(v, 0x4E);
    v = WS_DPP(v, 0x141);
    v = WS_DPP(v, 0x140);
    { auto rr = __builtin_amdgcn_permlane16_swap(__float_as_uint(v), __float_as_uint(v), false, false); v = __uint_as_float(rr[0]) + __uint_as_float(rr[1]); }
    { auto rr = __builtin_amdgcn_permlane32_swap(__float_as_uint(v), __float_as_uint(v), false, false); v = __uint_as_float(rr[0]) + __uint_as_float(rr[1]); }
    return v;
}
__device__ __forceinline__ float row16_sum(float v) {
    v = WS_DPP(v, 0xB1); v = WS_DPP(v, 0x4E); v = WS_DPP(v, 0x141); v = WS_DPP(v, 0x140); return v;
}
__device__ __forceinline__ float silu_f(float v) { return v / (1.f + __expf(-v)); }

__global__ void __launch_bounds__(256) k_mod(const float* c, const float* w_ada, const float* b_ada, const float* lq1, const float* lk1, const float* lq2, const float* lk2, float* mod) {
    __shared__ float cond[8][1024];
    const int l = blockIdx.y, j = blockIdx.x * 256 + threadIdx.x;
    for (int i = threadIdx.x; i < 8192; i += 256) { const float v = c[i]; cond[i >> 10][i & 1023] = v / (1.f + expf(-v)); }
    __syncthreads();
    float acc[8];
#pragma unroll
    for (int b = 0; b < 8; ++b) acc[b] = 0.f;
    const float* w = w_ada + (size_t)l * 1024 * MODW + j;
    for (int k = 0; k < 1024; ++k) { const float wv = w[(size_t)k * MODW];
#pragma unroll
        for (int b = 0; b < 8; ++b) acc[b] += cond[b][k] * wv; }
#pragma unroll
    for (int b = 0; b < 8; ++b) mod[(size_t)(l * 8 + b) * MODW + j] = acc[b] + b_ada[l * MODW + j];
    if (blockIdx.x == 0 && threadIdx.x == 0) {
        float s1 = 0.f, s2 = 0.f;
        for (int i = 0; i < 64; ++i) { s1 += lq1[l * 64 + i] * lk1[l * 64 + i]; s2 += lq2[l * 64 + i] * lk2[l * 64 + i]; }
        const float li = 0.8f - 0.6f * expf(-0.3f * (float)l);
        mod[2 * 8 * MODW + l] = expf(s1) - expf(s2) + li;
        mod[2 * 8 * MODW + 2 + l] = li;
    }
}
__global__ void k_rot(float* rot) {
    const int idx = blockIdx.x * 256 + threadIdx.x; if (idx >= 4096 * 32) return;
    const int pos = idx >> 5, i = idx & 31;
    const double inv = pow(10000.0, -(double)(2 * i) / 64.0), a = (double)pos * inv;
    rot[2 * idx] = (float)cos(a); rot[2 * idx + 1] = (float)sin(a);
}

__global__ void __launch_bounds__(256) k_ln_mod(const float* x, const float* modl, int sh_off, bf16* H) {
    const int row = blockIdx.x * 4 + (threadIdx.x >> 6), lane = threadIdx.x & 63, b = row / SEQ;
    const f32x4* xr = (const f32x4*)(x + (size_t)row * DM) + lane;
    f32x4 v[4]; float s = 0.f;
#pragma unroll
    for (int j = 0; j < 4; ++j) { v[j] = xr[64 * j]; s += (v[j].x + v[j].y) + (v[j].z + v[j].w); }
    const float mean = wave_sum(s) * (1.f / DM); float s2 = 0.f;
#pragma unroll
    for (int j = 0; j < 4; ++j) { v[j] = v[j] - mean; s2 += (v[j].x * v[j].x + v[j].y * v[j].y) + (v[j].z * v[j].z + v[j].w * v[j].w); }
    const float rstd = 1.f / sqrtf(wave_sum(s2) * (1.f / DM) + LN_EPS);
    const f32x4* sh = (const f32x4*)(modl + (size_t)b * MODW + sh_off) + lane; const f32x4* sc = sh + 256;
    u32x2* o = (u32x2*)(H + (size_t)row * DM) + lane;
#pragma unroll
    for (int j = 0; j < 4; ++j) { const f32x4 a = sh[64 * j], m = sc[64 * j]; const f32x4 r = v[j] * rstd * (m + 1.f) + a; u32x2 w; w.x = pk2(r.x, r.y); w.y = pk2(r.z, r.w); o[64 * j] = w; }
}

template <bool DUAL>
__device__ __forceinline__ void ngemm_core(const bf16* arow, const float* W0, const float* W1, int ldw, int K, float (&acc0)[8][4], float (&acc1)[8][4], float* As, float* Ws0, float* Ws1) {
    const int tid = threadIdx.x, tx = tid & 15, ty = tid >> 4;
#pragma unroll
    for (int i = 0; i < 8; ++i)
#pragma unroll
        for (int j = 0; j < 4; ++j) { acc0[i][j] = 0.f; acc1[i][j] = 0.f; }
    const int ar = tid >> 1, ak = (tid & 1) * 8, wk = tid >> 4, wn = (tid & 15) * 4;
    for (int k0 = 0; k0 < K; k0 += 16) {
        const u32x4 av = *(const u32x4*)(arow + k0);
        const f32x4 w0 = *(const f32x4*)(W0 + (size_t)(k0 + wk) * ldw + wn);
        f32x4 w1 = {0.f, 0.f, 0.f, 0.f}; if (DUAL) w1 = *(const f32x4*)(W1 + (size_t)(k0 + wk) * ldw + wn);
        __syncthreads();
        As[(ak + 0) * 129 + ar] = __uint_as_float(av.x << 16); As[(ak + 1) * 129 + ar] = __uint_as_float(av.x & 0xffff0000u);
        As[(ak + 2) * 129 + ar] = __uint_as_float(av.y << 16); As[(ak + 3) * 129 + ar] = __uint_as_float(av.y & 0xffff0000u);
        As[(ak + 4) * 129 + ar] = __uint_as_float(av.z << 16); As[(ak + 5) * 129 + ar] = __uint_as_float(av.z & 0xffff0000u);
        As[(ak + 6) * 129 + ar] = __uint_as_float(av.w << 16); As[(ak + 7) * 129 + ar] = __uint_as_float(av.w & 0xffff0000u);
        *(f32x4*)(Ws0 + wk * 64 + wn) = w0; if (DUAL) *(f32x4*)(Ws1 + wk * 64 + wn) = w1;
        __syncthreads();
#pragma unroll
        for (int k = 0; k < 16; ++k) {
            float a[8], b0[4], b1[4];
#pragma unroll
            for (int i = 0; i < 8; ++i) a[i] = As[k * 129 + ty + 16 * i];
#pragma unroll
            for (int j = 0; j < 4; ++j) { b0[j] = Ws0[k * 64 + tx + 16 * j]; if (DUAL) b1[j] = Ws1[k * 64 + tx + 16 * j]; }
#pragma unroll
            for (int i = 0; i < 8; ++i)
#pragma unroll
                for (int j = 0; j < 4; ++j) { acc0[i][j] += a[i] * b0[j]; if (DUAL) acc1[i][j] += a[i] * b1[j]; }
        }
    }
}

__global__ void __launch_bounds__(256) k_ngemm_inproj(const bf16* H, const float* Win, const float* rot, bf16* PROJ) {
    __shared__ float As[16 * 129], Ws0[16 * 64];
    const int tid = threadIdx.x, tx = tid & 15, ty = tid >> 4, col0 = blockIdx.x * 64, row0 = blockIdx.y * 128;
    float acc[8][4], dummy[8][4];
    ngemm_core<false>(H + (size_t)(row0 + (tid >> 1)) * DM + (tid & 1) * 8, Win + col0, nullptr, INW, DM, acc, dummy, As, Ws0, nullptr);
    const int region = col0 / 512;
#pragma unroll
    for (int i = 0; i < 8; ++i) {
        const int row = row0 + ty + 16 * i, pos = row % SEQ; bf16* o = PROJ + (size_t)row * INW + col0;
        if (region < 2) {
            const float sc = region == 0 ? 0.125f : 1.f;
#pragma unroll
            for (int j = 0; j < 2; ++j) { const int ic = tx + 16 * j; const float cs = rot[(pos * 32 + ic) * 2], sn = rot[(pos * 32 + ic) * 2 + 1];
                const float x1 = acc[i][j], x2 = acc[i][j + 2]; o[ic] = (bf16)f2bf((x1 * cs - x2 * sn) * sc); o[ic + 32] = (bf16)f2bf((x1 * sn + x2 * cs) * sc); }
        } else {
#pragma unroll
            for (int j = 0; j < 4; ++j) { float v = acc[i][j]; if (region == 3) v = silu_f(v); if (region == 4) v *= C2; o[tx + 16 * j] = (bf16)f2bf(v); }
        }
    }
}
__global__ void __launch_bounds__(256) k_ngemm_plain(const bf16* A, int lda, const float* W, int ldw, int K, bf16* C, int ldc) {
    __shared__ float As[16 * 129], Ws0[16 * 64];
    const int tid = threadIdx.x, tx = tid & 15, ty = tid >> 4, col0 = blockIdx.x * 64, row0 = blockIdx.y * 128;
    float acc[8][4], dummy[8][4];
    ngemm_core<false>(A + (size_t)(row0 + (tid >> 1)) * lda + (tid & 1) * 8, W + col0, nullptr, ldw, K, acc, dummy, As, Ws0, nullptr);
#pragma unroll
    for (int i = 0; i < 8; ++i)
#pragma unroll
        for (int j = 0; j < 4; ++j) C[(size_t)(row0 + ty + 16 * i) * ldc + col0 + tx + 16 * j] = (bf16)f2bf(acc[i][j]);
}

__global__ void __launch_bounds__(256) k_nret(const bf16* PROJ, bf16* CAT) {
    __shared__ float Qs[64 * 65], Ks[64 * 65], Vs[64 * 64], st[128]; float* Ss = Ks;
    const int tid = threadIdx.x, tx = tid & 15, ty = tid >> 4;
    const int qt = (gridDim.x - 1) - blockIdx.x, h = blockIdx.y, b = blockIdx.z, q0 = qt * 64;
    const float log_g = logf(1.f - exp2f(-5.f - (float)h));
    const bf16* base = PROJ + (size_t)b * SEQ * INW;
    for (int i = tid; i < 64 * 64; i += 256) { const int r = i >> 6, d = i & 63; Qs[r * 65 + d] = bf2f(base[(size_t)(q0 + r) * INW + C_RQ + h * 64 + d]); }
    float o[4][4];
#pragma unroll
    for (int i = 0; i < 4; ++i)
#pragma unroll
        for (int j = 0; j < 4; ++j) o[i][j] = 0.f;
    for (int kt = 0; kt <= qt; ++kt) {
        const int k0 = kt * 64;
        __syncthreads();
        for (int i = tid; i < 64 * 64; i += 256) { const int r = i >> 6, d = i & 63; Ks[r * 65 + d] = bf2f(base[(size_t)(k0 + r) * INW + C_RK + h * 64 + d]); Vs[r * 64 + d] = bf2f(base[(size_t)(k0 + r) * INW + C_RV + h * 64 + d]); }
        __syncthreads();
        float s[4][4];
#pragma unroll
        for (int i = 0; i < 4; ++i)
#pragma unroll
            for (int j = 0; j < 4; ++j) s[i][j] = 0.f;
        for (int d = 0; d < 64; ++d) { float a[4], k[4];
#pragma unroll
            for (int i = 0; i < 4; ++i) { a[i] = Qs[(ty + 16 * i) * 65 + d]; k[i] = Ks[(tx + 16 * i) * 65 + d]; }
#pragma unroll
            for (int i = 0; i < 4; ++i)
#pragma unroll
                for (int j = 0; j < 4; ++j) s[i][j] += a[i] * k[j]; }
        __syncthreads();
#pragma unroll
        for (int i = 0; i < 4; ++i)
#pragma unroll
            for (int j = 0; j < 4; ++j) { const int t = q0 + ty + 16 * i, m = k0 + tx + 16 * j; Ss[(ty + 16 * i) * 65 + tx + 16 * j] = (m <= t) ? s[i][j] * expf(log_g * (float)(t - m)) : 0.f; }
        __syncthreads();
        for (int m = 0; m < 64; ++m) { float p[4], v[4];
#pragma unroll
            for (int i = 0; i < 4; ++i) { p[i] = Ss[(ty + 16 * i) * 65 + m]; v[i] = Vs[m * 64 + tx + 16 * i]; }
#pragma unroll
            for (int i = 0; i < 4; ++i)
#pragma unroll
                for (int j = 0; j < 4; ++j) o[i][j] += p[i] * v[j]; }
    }
    __syncthreads();
#pragma unroll
    for (int i = 0; i < 4; ++i)
#pragma unroll
        for (int j = 0; j < 4; ++j) Ss[(ty + 16 * i) * 65 + tx + 16 * j] = o[i][j];
    __syncthreads();
    if (tid < 64) { float s = 0.f; for (int d = 0; d < 64; ++d) s += Ss[tid * 65 + d]; const float mean = s * (1.f / 64.f); float q = 0.f; for (int d = 0; d < 64; ++d) { const float e = Ss[tid * 65 + d] - mean; q += e * e; }
        st[tid] = mean; st[64 + tid] = 1.f / sqrtf(q * (1.f / 64.f) + LN_EPS); }
    __syncthreads();
#pragma unroll
    for (int i = 0; i < 4; ++i)
#pragma unroll
        for (int j = 0; j < 4; ++j) { const int r = ty + 16 * i, cc = tx + 16 * j; const size_t row = (size_t)b * SEQ + q0 + r;
            const float g = bf2f(PROJ[row * INW + C_RG + h * 64 + cc]);
            CAT[row * DM + h * 64 + cc] = (bf16)f2bf((o[i][j] - st[r]) * st[64 + r] * g); }
}

__global__ void __launch_bounds__(256) k_ndiff(const bf16* PROJ, const float* modx  , const float* subln, int l, bf16* CAT) {
    __shared__ float Qs[64 * 65], Ks[32 * 65], Vs[32 * 128], Ps[64 * 33], mrow[64], lrow[64], srow[64];
    const int tid = threadIdx.x, tx = tid & 15, ty = tid >> 4;
    const int qt = (gridDim.x - 1) - blockIdx.x, h = blockIdx.y, b = blockIdx.z, q0 = qt * 64;
    const float lam = modx[l], li = modx[2 + l];
    const bf16* base = PROJ + (size_t)b * SEQ * INW;
    float res[4][8];
    for (int c = 0; c < 2; ++c) {
        __syncthreads();
        for (int i = tid; i < 64 * 64; i += 256) { const int r = i >> 6, d = i & 63; Qs[r * 65 + d] = bf2f(base[(size_t)(q0 + r) * INW + C_DQ + h * 128 + c * 64 + d]); }
        if (tid < 64) { mrow[tid] = -INFINITY; lrow[tid] = 0.f; }
        float o[4][8];
#pragma unroll
        for (int i = 0; i < 4; ++i)
#pragma unroll
            for (int j = 0; j < 8; ++j) o[i][j] = 0.f;
        const int nkt = (q0 + 64) / 32;
        for (int kt = 0; kt < nkt; ++kt) {
            const int k0 = kt * 32;
            __syncthreads();
            for (int i = tid; i < 32 * 64; i += 256) { const int r = i >> 6, d = i & 63; Ks[r * 65 + d] = bf2f(base[(size_t)(k0 + r) * INW + C_DK + h * 128 + c * 64 + d]); }
            for (int i = tid; i < 32 * 128; i += 256) { const int r = i >> 7, d = i & 127; Vs[r * 128 + d] = bf2f(base[(size_t)(k0 + r) * INW + C_DV + h * 128 + d]); }
            __syncthreads();
            float s[4][2];
#pragma unroll
            for (int i = 0; i < 4; ++i) { s[i][0] = 0.f; s[i][1] = 0.f; }
            for (int d = 0; d < 64; ++d) { float a[4], k[2];
#pragma unroll
                for (int i = 0; i < 4; ++i) a[i] = Qs[(ty + 16 * i) * 65 + d];
                k[0] = Ks[tx * 65 + d]; k[1] = Ks[(tx + 16) * 65 + d];
#pragma unroll
                for (int i = 0; i < 4; ++i) { s[i][0] += a[i] * k[0]; s[i][1] += a[i] * k[1]; } }
#pragma unroll
            for (int i = 0; i < 4; ++i)
#pragma unroll
                for (int j = 0; j < 2; ++j) { const int t = q0 + ty + 16 * i, m = k0 + tx + 16 * j; Ps[(ty + 16 * i) * 33 + tx + 16 * j] = (m <= t) ? s[i][j] : -INFINITY; }
            __syncthreads();
            if (tid < 64) { float mx = mrow[tid]; for (int m = 0; m < 32; ++m) mx = fmaxf(mx, Ps[tid * 33 + m]);
                const float sc = exp2f(mrow[tid] - mx); float sum = 0.f;
                for (int m = 0; m < 32; ++m) { const float p = exp2f(Ps[tid * 33 + m] - mx); Ps[tid * 33 + m] = p; sum += p; }
                lrow[tid] = lrow[tid] * sc + sum; mrow[tid] = mx; srow[tid] = sc; }
            __syncthreads();
#pragma unroll
            for (int i = 0; i < 4; ++i) { const float sc = srow[ty + 16 * i];
#pragma unroll
                for (int j = 0; j < 8; ++j) o[i][j] *= sc; }
            for (int m = 0; m < 32; ++m) { float p[4], v[8];
#pragma unroll
                for (int i = 0; i < 4; ++i) p[i] = Ps[(ty + 16 * i) * 33 + m];
#pragma unroll
                for (int j = 0; j < 8; ++j) v[j] = Vs[m * 128 + tx + 16 * j];
#pragma unroll
                for (int i = 0; i < 4; ++i)
#pragma unroll
                    for (int j = 0; j < 8; ++j) o[i][j] += p[i] * v[j]; }
        }
        __syncthreads();
#pragma unroll
        for (int i = 0; i < 4; ++i) { const float inv = 1.f / lrow[ty + 16 * i];
#pragma unroll
            for (int j = 0; j < 8; ++j) { if (c == 0) res[i][j] = o[i][j] * inv; else res[i][j] -= lam * o[i][j] * inv; } }
    }
    __syncthreads();
#pragma unroll
    for (int i = 0; i < 4; ++i) { float q = 0.f;
#pragma unroll
        for (int j = 0; j < 8; ++j) q += res[i][j] * res[i][j];
        Ps[(ty + 16 * i) * 33 + tx] = q; }
    __syncthreads();
    if (tid < 64) { float q = 0.f; for (int m = 0; m < 16; ++m) q += Ps[tid * 33 + m]; srow[tid] = 1.f / sqrtf(q * (1.f / 128.f) + LN_EPS); }
    __syncthreads();
#pragma unroll
    for (int i = 0; i < 4; ++i)
#pragma unroll
        for (int j = 0; j < 8; ++j) { const int r = ty + 16 * i, cc = tx + 16 * j; const size_t row = (size_t)b * SEQ + q0 + r;
            CAT[row * DM + 512 + h * 128 + cc] = (bf16)f2bf(res[i][j] * srow[r] * subln[l * 128 + cc] * (1.f - li)); }
}

__global__ void __launch_bounds__(256) k_post_mix(const float* xin, const bf16* MIXED, const float* modl, const float* lng, const float* lnb, const float* rw, const float* rb,
                                                  bf16* X1, bf16* H, int* tok_e, float* tok_g, int* tok_slot, int* lists, int* cnt) {
    const int row = blockIdx.x * 4 + (threadIdx.x >> 6), lane = threadIdx.x & 63, b = row / SEQ;
    const f32x4* xr = (const f32x4*)(xin + (size_t)row * DM) + lane; const u32x2* mr = (const u32x2*)(MIXED + (size_t)row * DM) + lane;
    const f32x4* g1 = (const f32x4*)(modl + (size_t)b * MODW + 2 * DM) + lane; const f32x4* sh2 = g1 + 256; const f32x4* sc2 = g1 + 512;
    f32x4 v[4]; float s = 0.f;
#pragma unroll
    for (int j = 0; j < 4; ++j) { const f32x4 x = xr[64 * j], g = g1[64 * j]; const u32x2 m = mr[64 * j];
        f32x4 mv; mv.x = __uint_as_float(m.x << 16); mv.y = __uint_as_float(m.x & 0xffff0000u); mv.z = __uint_as_float(m.y << 16); mv.w = __uint_as_float(m.y & 0xffff0000u);
        v[j] = x * ALPHA + g * mv; s += (v[j].x + v[j].y) + (v[j].z + v[j].w); }
    float mean = wave_sum(s) * (1.f / DM), s2 = 0.f;
#pragma unroll
    for (int j = 0; j < 4; ++j) { v[j] = v[j] - mean; s2 += (v[j].x * v[j].x + v[j].y * v[j].y) + (v[j].z * v[j].z + v[j].w * v[j].w); }
    float rstd = 1.f / sqrtf(wave_sum(s2) * (1.f / DM) + LN_EPS);
    u32x2* xo = (u32x2*)(X1 + (size_t)row * DM) + lane; s = 0.f;
#pragma unroll
    for (int j = 0; j < 4; ++j) { const f32x4 g = ((const f32x4*)lng)[lane + 64 * j], bb = ((const f32x4*)lnb)[lane + 64 * j]; v[j] = v[j] * rstd * g + bb;
        u32x2 w; w.x = pk2(v[j].x, v[j].y); w.y = pk2(v[j].z, v[j].w); xo[64 * j] = w; s += (v[j].x + v[j].y) + (v[j].z + v[j].w); }
    mean = wave_sum(s) * (1.f / DM); s2 = 0.f;
#pragma unroll
    for (int j = 0; j < 4; ++j) { v[j] = v[j] - mean; s2 += (v[j].x * v[j].x + v[j].y * v[j].y) + (v[j].z * v[j].z + v[j].w * v[j].w); }
    rstd = 1.f / sqrtf(wave_sum(s2) * (1.f / DM) + LN_EPS);
    u32x2* ho = (u32x2*)(H + (size_t)row * DM) + lane;
    float lg[16];
#pragma unroll
    for (int e = 0; e < 16; ++e) lg[e] = 0.f;
#pragma unroll
    for (int j = 0; j < 4; ++j) { const f32x4 a = sh2[64 * j], m = sc2[64 * j]; v[j] = v[j] * rstd * (m + 1.f) + a;
        u32x2 w; w.x = pk2(v[j].x, v[j].y); w.y = pk2(v[j].z, v[j].w); ho[64 * j] = w;
        const f32x4* wr = (const f32x4*)(rw + (size_t)(4 * lane + 256 * j) * 16);
#pragma unroll
        for (int q = 0; q < 4; ++q) { const float hv = q == 0 ? v[j].x : q == 1 ? v[j].y : q == 2 ? v[j].z : v[j].w;
#pragma unroll
            for (int e4 = 0; e4 < 4; ++e4) { const f32x4 w4 = wr[q * 4 + e4]; lg[e4 * 4 + 0] += hv * w4.x; lg[e4 * 4 + 1] += hv * w4.y; lg[e4 * 4 + 2] += hv * w4.z; lg[e4 * 4 + 3] += hv * w4.w; } } }
    float mx = -INFINITY;
#pragma unroll
    for (int e = 0; e < 16; ++e) { lg[e] = wave_sum(lg[e]) + rb[e]; mx = fmaxf(mx, lg[e]); }
    float p[16], sum = 0.f;
#pragma unroll
    for (int e = 0; e < 16; ++e) { p[e] = expf(lg[e] - mx); sum += p[e]; }
    const float rs = 1.f / sum;
#pragma unroll
    for (int e = 0; e < 16; ++e) p[e] *= rs;
    int bg = 0; float bgs = -1.f;
#pragma unroll
    for (int g = 0; g < 4; ++g) { float m1 = p[4 * g]; int i1 = 0;
#pragma unroll
        for (int i = 1; i < 4; ++i) if (p[4 * g + i] > m1) { m1 = p[4 * g + i]; i1 = i; }
        float m2 = -1.f;
#pragma unroll
        for (int i = 0; i < 4; ++i) if (i != i1 && p[4 * g + i] > m2) m2 = p[4 * g + i];
        const float gs = m1 + m2; if (gs > bgs) { bgs = gs; bg = g; } }
    float q0 = 0.f, q1 = 0.f, q2 = 0.f, q3 = 0.f;
#pragma unroll
    for (int g = 0; g < 4; ++g) if (bg == g) { q0 = p[4 * g]; q1 = p[4 * g + 1]; q2 = p[4 * g + 2]; q3 = p[4 * g + 3]; }
    float m1 = q0; int i1 = 0; if (q1 > m1) { m1 = q1; i1 = 1; } if (q2 > m1) { m1 = q2; i1 = 2; } if (q3 > m1) { m1 = q3; i1 = 3; }
    float m2 = -1.f; int i2 = 0;
    if (i1 != 0 && q0 > m2) { m2 = q0; i2 = 0; } if (i1 != 1 && q1 > m2) { m2 = q1; i2 = 1; } if (i1 != 2 && q2 > m2) { m2 = q2; i2 = 2; } if (i1 != 3 && q3 > m2) { m2 = q3; i2 = 3; }
    if (lane == 0) {
        const int e1 = bg * 4 + i1, e2 = bg * 4 + i2; const float den = 1.f / (m1 + m2);
        const int s1 = atomicAdd(cnt + e1, 1), s2_ = atomicAdd(cnt + e2, 1);
        lists[(size_t)e1 * T + s1] = row; lists[(size_t)e2 * T + s2_] = row;
        tok_e[2 * row] = e1; tok_e[2 * row + 1] = e2; tok_g[2 * row] = m1 * den; tok_g[2 * row + 1] = m2 * den; tok_slot[2 * row] = s1; tok_slot[2 * row + 1] = s2_;
    }
}

__device__ __forceinline__ int expert_base(const int* cnt, int e) { int bs = 0; for (int i = 0; i < 16; ++i) if (i < e) bs += (cnt[i] + 255) & ~255; return bs; }
__global__ void __launch_bounds__(256) k_moe1(const bf16* H, const float* wg, const float* wu, const int* cnt, const int* lists, bf16* HE) {
    __shared__ float As[16 * 129], Ws0[16 * 64], Ws1[16 * 64];
    const int e = blockIdx.z, rt = blockIdx.y, ct = blockIdx.x, n = cnt[e]; if (rt * 128 >= n) return;
    const int tid = threadIdx.x, tx = tid & 15, ty = tid >> 4, base = expert_base(cnt, e);
    const int sl = rt * 128 + (tid >> 1), tok = lists[(size_t)e * T + (sl < n ? sl : 0)];
    float g[8][4], u[8][4];
    ngemm_core<true>(H + (size_t)tok * DM + (tid & 1) * 8, wg + (size_t)e * DM * DE + ct * 64, wu + (size_t)e * DM * DE + ct * 64, DE, DM, g, u, As, Ws0, Ws1);
#pragma unroll
    for (int i = 0; i < 8; ++i) { const int s = rt * 128 + ty + 16 * i; if (s < n) {
#pragma unroll
        for (int j = 0; j < 4; ++j) HE[(size_t)(base + s) * DE + ct * 64 + tx + 16 * j] = (bf16)f2bf(silu_f(g[i][j]) * u[i][j]); } }
}
__global__ void __launch_bounds__(256) k_moe2(const bf16* HE, const float* wd, const int* cnt, bf16* YP) {
    __shared__ float As[16 * 129], Ws0[16 * 64];
    const int e = blockIdx.z, rt = blockIdx.y, ct = blockIdx.x, n = cnt[e]; if (rt * 128 >= n) return;
    const int tid = threadIdx.x, tx = tid & 15, ty = tid >> 4, base = expert_base(cnt, e);
    const int sl = rt * 128 + (tid >> 1);
    float acc[8][4], dummy[8][4];
    ngemm_core<false>(HE + (size_t)(base + (sl < n ? sl : 0)) * DE + (tid & 1) * 8, wd + (size_t)e * DE * DM + ct * 64, nullptr, DM, DE, acc, dummy, As, Ws0, nullptr);
#pragma unroll
    for (int i = 0; i < 8; ++i) { const int s = rt * 128 + ty + 16 * i; if (s < n) {
#pragma unroll
        for (int j = 0; j < 4; ++j) YP[(size_t)(base + s) * DM + ct * 64 + tx + 16 * j] = (bf16)f2bf(acc[i][j]); } }
}

__global__ void __launch_bounds__(256) k_post_ffn(const bf16* X1, const bf16* YP, const float* modl, const float* lng, const float* lnb, const int* tok_e, const float* tok_g, const int* tok_slot, const int* cnt,
                                                  float* out, const float* modn, bf16* H) {
    const int row = blockIdx.x * 4 + (threadIdx.x >> 6), lane = threadIdx.x & 63, b = row / SEQ;
    const int e0 = tok_e[2 * row], e1 = tok_e[2 * row + 1]; const float w0 = tok_g[2 * row], w1 = tok_g[2 * row + 1];
    const size_t r0 = (size_t)expert_base(cnt, e0) + tok_slot[2 * row], r1 = (size_t)expert_base(cnt, e1) + tok_slot[2 * row + 1];
    const u32x2* xr = (const u32x2*)(X1 + (size_t)row * DM) + lane; const u32x2* y0 = (const u32x2*)(YP + r0 * DM) + lane; const u32x2* y1 = (const u32x2*)(YP + r1 * DM) + lane;
    const f32x4* g2 = (const f32x4*)(modl + (size_t)b * MODW + 5 * DM) + lane;
    f32x4 v[4]; float s = 0.f;
#pragma unroll
    for (int j = 0; j < 4; ++j) { const u32x2 x = xr[64 * j], a = y0[64 * j], c = y1[64 * j]; const f32x4 g = g2[64 * j];
        f32x4 xv, av, cv; xv.x = __uint_as_float(x.x << 16); xv.y = __uint_as_float(x.x & 0xffff0000u); xv.z = __uint_as_float(x.y << 16); xv.w = __uint_as_float(x.y & 0xffff0000u);
        av.x = __uint_as_float(a.x << 16); av.y = __uint_as_float(a.x & 0xffff0000u); av.z = __uint_as_float(a.y << 16); av.w = __uint_as_float(a.y & 0xffff0000u);
        cv.x = __uint_as_float(c.x << 16); cv.y = __uint_as_float(c.x & 0xffff0000u); cv.z = __uint_as_float(c.y << 16); cv.w = __uint_as_float(c.y & 0xffff0000u);
        v[j] = xv * ALPHA + g * (av * w0 + cv * w1); s += (v[j].x + v[j].y) + (v[j].z + v[j].w); }
    float mean = wave_sum(s) * (1.f / DM), s2 = 0.f;
#pragma unroll
    for (int j = 0; j < 4; ++j) { v[j] = v[j] - mean; s2 += (v[j].x * v[j].x + v[j].y * v[j].y) + (v[j].z * v[j].z + v[j].w * v[j].w); }
    float rstd = 1.f / sqrtf(wave_sum(s2) * (1.f / DM) + LN_EPS);
    f32x4* o = (f32x4*)(out + (size_t)row * DM) + lane; s = 0.f;
#pragma unroll
    for (int j = 0; j < 4; ++j) { const f32x4 g = ((const f32x4*)lng)[lane + 64 * j], bb = ((const f32x4*)lnb)[lane + 64 * j]; v[j] = v[j] * rstd * g + bb; o[64 * j] = v[j]; s += (v[j].x + v[j].y) + (v[j].z + v[j].w); }
    if (modn) {
        mean = wave_sum(s) * (1.f / DM); s2 = 0.f;
#pragma unroll
        for (int j = 0; j < 4; ++j) { v[j] = v[j] - mean; s2 += (v[j].x * v[j].x + v[j].y * v[j].y) + (v[j].z * v[j].z + v[j].w * v[j].w); }
        rstd = 1.f / sqrtf(wave_sum(s2) * (1.f / DM) + LN_EPS);
        const f32x4* sh = (const f32x4*)(modn + (size_t)b * MODW) + lane; const f32x4* sc = sh + 256; u32x2* ho = (u32x2*)(H + (size_t)row * DM) + lane;
#pragma unroll
        for (int j = 0; j < 4; ++j) { const f32x4 a = sh[64 * j], m = sc[64 * j]; const f32x4 r = v[j] * rstd * (m + 1.f) + a; u32x2 w; w.x = pk2(r.x, r.y); w.y = pk2(r.z, r.w); ho[64 * j] = w; }
    }
}

#include <hip/hip_bf16.h>
#ifndef RET_FAST
#define RET_FAST 1
#endif
#ifndef ATTN128
#define ATTN128 1
#endif
#ifndef ATTN_THRL
#define ATTN_THRL 8
#endif
#define LAS __attribute__((address_space(3)))
#define GAS __attribute__((address_space(1)))
typedef short bf16x8 __attribute__((ext_vector_type(8)));
typedef GAS unsigned gu32;
#define RLX_AGENT __ATOMIC_RELAXED, __HIP_MEMORY_SCOPE_AGENT
#define LDS_WAIT() asm volatile("s_waitcnt lgkmcnt(0)" ::: "memory")
#define VM_WAIT() asm volatile("s_waitcnt vmcnt(0)" ::: "memory")

constexpr size_t WL_IN = 0, WL_OUT = (size_t)INW * DM, WL_GU = WL_OUT + (size_t)DM * DM, WL_D = WL_GU + (size_t)NE * 1024 * DM, WL_STRIDE = WL_D + (size_t)NE * DM * DE;
static_assert(WL_STRIDE * 2 * 2 <= 114 * MiB, "weights fit");

namespace pg8 {
constexpr int BM = 256, BK = 64, HALF = 128, HTB = HALF * BK * 2, STAGE_BYTES = 8 * HTB, NXCD = 8, WGM = 8;
__host__ __device__ __forceinline__ int lds_byte(int r, int c) { const int st = (r >> 4) * 2 + (c >> 5), rr = r & 15, cc = c & 31, ob = rr * 64 + cc * 2; return st * 1024 + (ob ^ (((ob >> 9) & 1) << 5)); }
__host__ __device__ __forceinline__ void stage_rc(int b, int& R, int& C) { const int st = b / 1024, sb = b % 1024, swz = sb ^ (((sb >> 9) & 1) << 5); R = (st >> 1) * 16 + swz / 64; C = (st & 1) * 32 + (swz % 64) / 2; }
__host__ __device__ __forceinline__ int perm32(int rho) { const int n = rho >> 4, i = rho & 15; return 8 * (i >> 2) + 4 * n + (i & 3); }
struct Unit { int pm, pn; };

struct OrderBase {
    int nM, nN, nwg, G, c;
    __device__ __forceinline__ void init(int nM_, int nN_, int G_, int c_) { nM = nM_; nN = nN_; nwg = nM * nN; G = G_; c = c_; }
    __device__ __forceinline__ bool next(int i, Unit& u) const {
        const long L = (long)i * G + c; if (L >= nwg) return false;
        int wgid = (int)L; { const int q = nwg / NXCD, r = nwg % NXCD, xcd = wgid % NXCD, off = wgid / NXCD; wgid = (xcd < r ? xcd * (q + 1) : r * (q + 1) + (xcd - r) * q) + off; }
        const int nig = WGM * nN, gid = wgid / nig, fm = gid * WGM, gsz = (nM - fm) < WGM ? (nM - fm) : WGM;
        u.pm = fm + ((wgid % nig) % gsz); u.pn = (wgid % nig) / gsz; return true;
    }
    __device__ __forceinline__ void a_ready(const Unit&) const {}
    __device__ __forceinline__ void done(const Unit&) const {}
};
struct PlainSched : OrderBase {
    const bf16* Bt; int K;
    __device__ __forceinline__ void setup(const Unit& u, const int (&Rl)[2], const int (&Cb)[2], unsigned (&off)[2][2], const char*& bptr) const {
#pragma unroll
        for (int h = 0; h < 2; ++h)
#pragma unroll
            for (int i = 0; i < 2; ++i) off[h][i] = (unsigned)((u.pm * 256 + h * 128 + Rl[i]) * K * 2 + Cb[i]);
        bptr = (const char*)Bt + (size_t)u.pn * 256 * K * 2;
    }
};
struct MoeSched : OrderBase {
    const bf16* Bt; int K; const LAS int* tab; const int* cnt; const int* lists; bool gather;
    __device__ __forceinline__ void setup(const Unit& u, const int (&Rl)[2], const int (&Cb)[2], unsigned (&off)[2][2], const char*& bptr) const {
        const int te = tab[1 + u.pm], e = te & 255, s0 = (te >> 8) * 256;
        if (gather) { const int n = cnt[e];
#pragma unroll
            for (int h = 0; h < 2; ++h)
#pragma unroll
                for (int i = 0; i < 2; ++i) { const int s = s0 + h * 128 + Rl[i]; const int tok = lists[(size_t)e * T + (s < n ? s : 0)]; off[h][i] = (unsigned)(tok * K * 2 + Cb[i]); }
        } else {
#pragma unroll
            for (int h = 0; h < 2; ++h)
#pragma unroll
                for (int i = 0; i < 2; ++i) off[h][i] = (unsigned)((u.pm * 256 + h * 128 + Rl[i]) * K * 2 + Cb[i]);
        }
        bptr = (const char*)Bt + (size_t)(e * 4 + u.pn) * 256 * K * 2;
    }
};

__device__ __forceinline__ unsigned cvt_pk_bf16(float lo, float hi) { unsigned r; asm volatile("v_cvt_pk_bf16_f32 %0, %1, %2" : "=v"(r) : "v"(lo), "v"(hi)); return r; }
__device__ __forceinline__ float fsilu(float v) { return v * __builtin_amdgcn_rcpf(1.f + __expf(-v)); }

struct EpiInProj {
    static constexpr bool PERM = true, AFTER_DRAIN = false;
    bf16* P; const float* rot; const float* dtab; bf16* dummy;
    __device__ __forceinline__ void operator()(const f32x4 (&acc)[2][2][4][2], const Unit& u, int wr, int wc, int fr, int fq) const {
        const int row0 = u.pm * BM + wr * 64 + fr;
        if (u.pn < 4 && !dummy) {
            const float sc0 = u.pn < 2 ? 0.125f : 1.f; const float* dt = dtab ? dtab + (u.pn >> 1) * 1024 + ((u.pn & 1) * 4 + wc) * 128 : nullptr;
#pragma unroll
            for (int ai = 0; ai < 2; ++ai) {
                f32x4 tt[4][4]; float scv[4];
#pragma unroll
                for (int m = 0; m < 4; ++m) { const int pos = (row0 + ai * HALF + m * 16) & (SEQ - 1); const f32x4* rt = (const f32x4*)(rot + (size_t)(pos * 32 + 8 * fq) * 2);
                    tt[m][0] = rt[0]; tt[m][1] = rt[1]; tt[m][2] = rt[2]; tt[m][3] = rt[3]; scv[m] = dt ? dt[pos & 127] : sc0; }
#pragma unroll
                for (int m = 0; m < 4; ++m) { const int row = row0 + ai * HALF + m * 16; const float sc = scv[m];
                    const f32x4 t0 = tt[m][0], t1 = tt[m][1], t2 = tt[m][2], t3 = tt[m][3];
                    const f32x4 xa = acc[ai][0][m][0], xb = acc[ai][0][m][1], ya = acc[ai][1][m][0], yb = acc[ai][1][m][1];
                    u32x4 w1, w2;
                    w1.x = cvt_pk_bf16((xa[0] * t0.x - ya[0] * t0.y) * sc, (xa[1] * t0.z - ya[1] * t0.w) * sc); w1.y = cvt_pk_bf16((xa[2] * t1.x - ya[2] * t1.y) * sc, (xa[3] * t1.z - ya[3] * t1.w) * sc);
                    w1.z = cvt_pk_bf16((xb[0] * t2.x - yb[0] * t2.y) * sc, (xb[1] * t2.z - yb[1] * t2.w) * sc); w1.w = cvt_pk_bf16((xb[2] * t3.x - yb[2] * t3.y) * sc, (xb[3] * t3.z - yb[3] * t3.w) * sc);
                    w2.x = cvt_pk_bf16((xa[0] * t0.y + ya[0] * t0.x) * sc, (xa[1] * t0.w + ya[1] * t0.z) * sc); w2.y = cvt_pk_bf16((xa[2] * t1.y + ya[2] * t1.x) * sc, (xa[3] * t1.w + ya[3] * t1.z) * sc);
                    w2.z = cvt_pk_bf16((xb[0] * t2.y + yb[0] * t2.x) * sc, (xb[1] * t2.w + yb[1] * t2.z) * sc); w2.w = cvt_pk_bf16((xb[2] * t3.y + yb[2] * t3.x) * sc, (xb[3] * t3.w + yb[3] * t3.z) * sc);
                    bf16* o = P + (size_t)row * INW + u.pn * BM + 64 * wc + 8 * fq;
                    *(u32x4*)o = w1; *(u32x4*)(o + 32) = w2; }
            }
        } else {
            const int region = u.pn >> 1;
#pragma unroll
            for (int ai = 0; ai < 2; ++ai)
#pragma unroll
                for (int m = 0; m < 4; ++m) { bf16* o = (u.pn < 4) ? dummy + (size_t)(row0 + ai * HALF + m * 16) * DM + u.pn * BM + wc * 32 + 8 * fq : P + (size_t)(row0 + ai * HALF + m * 16) * INW + u.pn * BM + wc * 32 + 8 * fq;
#pragma unroll
                    for (int bj = 0; bj < 2; ++bj) { f32x4 v0 = acc[ai][bj][m][0], v1 = acc[ai][bj][m][1];
                        if (region == 3) { v0[0] = fsilu(v0[0]); v0[1] = fsilu(v0[1]); v0[2] = fsilu(v0[2]); v0[3] = fsilu(v0[3]); v1[0] = fsilu(v1[0]); v1[1] = fsilu(v1[1]); v1[2] = fsilu(v1[2]); v1[3] = fsilu(v1[3]); }
                        if (region == 4) { v0 = v0 * C2; v1 = v1 * C2; }
                        u32x4 w; w.x = cvt_pk_bf16(v0[0], v0[1]); w.y = cvt_pk_bf16(v0[2], v0[3]); w.z = cvt_pk_bf16(v1[0], v1[1]); w.w = cvt_pk_bf16(v1[2], v1[3]);
                        *(u32x4*)(o + bj * HALF) = w; } }
        }
    }
};
struct EpiPlain {
    static constexpr bool PERM = true, AFTER_DRAIN = false;
    bf16* O; int ldc;
    __device__ __forceinline__ void operator()(const f32x4 (&acc)[2][2][4][2], const Unit& u, int wr, int wc, int fr, int fq) const {
        const int row0 = u.pm * BM + wr * 64 + fr, col0 = u.pn * BM + wc * 32 + 8 * fq;
#pragma unroll
        for (int ai = 0; ai < 2; ++ai)
#pragma unroll
            for (int m = 0; m < 4; ++m) { bf16* o = O + (size_t)(row0 + ai * HALF + m * 16) * ldc + col0;
#pragma unroll
                for (int bj = 0; bj < 2; ++bj) { const f32x4 v0 = acc[ai][bj][m][0], v1 = acc[ai][bj][m][1];
                    u32x4 w; w.x = cvt_pk_bf16(v0[0], v0[1]); w.y = cvt_pk_bf16(v0[2], v0[3]); w.z = cvt_pk_bf16(v1[0], v1[1]); w.w = cvt_pk_bf16(v1[2], v1[3]);
                    *(u32x4*)(o + bj * HALF) = w; } }
    }
};
struct EpiGateUp {
    static constexpr bool PERM = true, AFTER_DRAIN = false;
    bf16* HE;
    __device__ __forceinline__ void operator()(const f32x4 (&acc)[2][2][4][2], const Unit& u, int wr, int wc, int fr, int fq) const {
        const int row0 = u.pm * BM + wr * 64 + fr, col0 = u.pn * 128 + wc * 32 + 8 * fq;
#pragma unroll
        for (int ai = 0; ai < 2; ++ai)
#pragma unroll
            for (int m = 0; m < 4; ++m) { const f32x4 g0 = acc[ai][0][m][0], g1 = acc[ai][0][m][1], u0 = acc[ai][1][m][0], u1 = acc[ai][1][m][1];
                u32x4 w; w.x = cvt_pk_bf16(fsilu(g0[0]) * u0[0], fsilu(g0[1]) * u0[1]); w.y = cvt_pk_bf16(fsilu(g0[2]) * u0[2], fsilu(g0[3]) * u0[3]);
                w.z = cvt_pk_bf16(fsilu(g1[0]) * u1[0], fsilu(g1[1]) * u1[1]); w.w = cvt_pk_bf16(fsilu(g1[2]) * u1[2], fsilu(g1[3]) * u1[3]);
                *(u32x4*)(HE + (size_t)(row0 + ai * HALF + m * 16) * DE + col0) = w; }
    }
};

template <class Epi, class Sched, bool ALIGN_EPI>
__device__ __forceinline__ void gemm_phase(LAS unsigned char* lds, const char* gA, int K, const Sched& S, const Epi& E) {
    int tid_ = threadIdx.x; asm volatile("" : "+v"(tid_));
    const int tid = tid_, wid = __builtin_amdgcn_readfirstlane(tid >> 6), lane = tid & 63, wr = wid >> 2, wc = wid & 3, fr = lane & 15, fq = lane >> 4;
    const int nt = K / BK;
    unsigned voffB[2]; int Rl[2], Cb[2];
#pragma unroll
    for (int i = 0; i < 2; ++i) { int R, C; stage_rc(tid * 16 + i * 8192, R, C); const int Rb = Epi::PERM ? ((R & ~31) + perm32(R & 31)) : R;
        voffB[i] = (unsigned)(Rb * K + C) * 2u; Rl[i] = R; Cb[i] = C * 2; }
    const size_t kstep = (size_t)(BK * 2), hstep = (size_t)HALF * K * 2;
    const unsigned ldsw = (unsigned)wid * 1024u;
    const int aoff = lds_byte(wr * 64 + fr, fq * 8), boff = lds_byte(wc * 32 + fr, fq * 8);
#define PG8_SA(b, h) (((b) * 2 + (h)) * HTB)
#define PG8_SB(b, h) ((4 + (b) * 2 + (h)) * HTB)
#define PG8_STAGE(bufoff, gbase, voff) do { _Pragma("unroll") for (int _i = 0; _i < 2; ++_i) \
        __builtin_amdgcn_global_load_lds((const unsigned*)((const char*)(gbase) + (voff)[_i]), (LAS unsigned*)(lds + (bufoff) + ldsw + _i * 8192), 16, 0, 0); } while (0)
#define PG8_LDA(dst, b, h) do { _Pragma("unroll") for (int m = 0; m < 4; ++m) _Pragma("unroll") for (int k = 0; k < 2; ++k) dst[m][k] = *(const LAS bf16x8*)(lds + PG8_SA(b, h) + aoff + m * 2048 + k * 1024); } while (0)
#define PG8_LDB(dst, b, h) do { _Pragma("unroll") for (int n = 0; n < 2; ++n) _Pragma("unroll") for (int k = 0; k < 2; ++k) dst[n][k] = *(const LAS bf16x8*)(lds + PG8_SB(b, h) + boff + n * 2048 + k * 1024); } while (0)
#define PG8_MMA(ai, bj, At, Bt) do { __builtin_amdgcn_s_setprio(1); _Pragma("unroll") for (int m = 0; m < 4; ++m) _Pragma("unroll") for (int n = 0; n < 2; ++n) _Pragma("unroll") for (int k = 0; k < 2; ++k) \
        acc[ai][bj][m][n] = __builtin_amdgcn_mfma_f32_16x16x32_bf16(Bt[n][k], At[m][k], acc[ai][bj][m][n], 0, 0, 0); __builtin_amdgcn_s_setprio(0); } while (0)
#define PG8_WAIT_V(n) asm volatile("s_waitcnt vmcnt(" #n ")" ::: "memory")
#define PG8_WAIT_L(n) asm volatile("s_waitcnt lgkmcnt(" #n ")" ::: "memory")
#define PG8_BAR __builtin_amdgcn_s_barrier()
#define PG8_SCHED __builtin_amdgcn_sched_barrier(0)
    Unit cur, nxt; int ui = 0;
    if (!S.next(0, cur)) return;
    f32x4 acc[2][2][4][2];
#pragma unroll
    for (int a = 0; a < 2; ++a)
#pragma unroll
        for (int b = 0; b < 2; ++b)
#pragma unroll
            for (int m = 0; m < 4; ++m)
#pragma unroll
                for (int n = 0; n < 2; ++n) acc[a][b][m][n] = (f32x4){0.f, 0.f, 0.f, 0.f};
    bf16x8 At[4][2], B0[2][2], B1[2][2];
    unsigned oc[2][2], on[2][2]; const char* cB; const char* nB;
    S.setup(cur, Rl, Cb, oc, cB);
    S.a_ready(cur);
    PG8_STAGE(PG8_SB(0, 0), cB, voffB); PG8_STAGE(PG8_SB(0, 1), cB + hstep, voffB); PG8_STAGE(PG8_SA(0, 0), gA, oc[0]); PG8_STAGE(PG8_SA(0, 1), gA, oc[1]);
    if (wr == 1) PG8_BAR;
    PG8_WAIT_V(2); PG8_BAR;
    PG8_STAGE(PG8_SB(1, 0), cB + kstep, voffB); PG8_STAGE(PG8_SA(1, 0), gA + kstep, oc[0]); PG8_STAGE(PG8_SB(1, 1), cB + hstep + kstep, voffB);
    PG8_WAIT_V(6); PG8_BAR;
    for (;;) {
        const bool has_next = S.next(ui + 1, nxt);
        if (has_next) S.setup(nxt, Rl, Cb, on, nB);
        else { nB = cB;
#pragma unroll
            for (int h = 0; h < 2; ++h)
#pragma unroll
                for (int i = 0; i < 2; ++i) on[h][i] = oc[h][i]; }
        for (int t = 0; t < nt; t += 2) {
            const bool last = (t == nt - 2);
            const char* a1 = gA + (size_t)(t + 1) * kstep;
            const char* a2 = last ? gA : gA + (size_t)(t + 2) * kstep; const char* b2 = last ? nB : cB + (size_t)(t + 2) * kstep;
            const char* a3 = a2 + kstep; const char* b3 = b2 + kstep;
            unsigned o2[2][2];
#pragma unroll
            for (int h = 0; h < 2; ++h)
#pragma unroll
                for (int i = 0; i < 2; ++i) o2[h][i] = last ? on[h][i] : oc[h][i];
            if (last && has_next) S.a_ready(nxt);
            PG8_LDB(B0, 0, 0); PG8_LDB(B1, 0, 1); PG8_SCHED; PG8_LDA(At, 0, 0); PG8_STAGE(PG8_SA(1, 1), a1, oc[1]);
            PG8_WAIT_V(8); PG8_WAIT_L(0); PG8_BAR; PG8_MMA(0, 0, At, B0); PG8_MMA(0, 1, At, B1); PG8_BAR; PG8_SCHED;
            PG8_LDA(At, 0, 1); PG8_STAGE(PG8_SB(0, 0), b2, voffB); PG8_STAGE(PG8_SB(0, 1), b2 + hstep, voffB); PG8_STAGE(PG8_SA(0, 0), a2, o2[0]);
            PG8_WAIT_V(8); PG8_WAIT_L(0); PG8_BAR; PG8_MMA(1, 0, At, B0); PG8_MMA(1, 1, At, B1); PG8_BAR; PG8_SCHED;
            PG8_LDB(B0, 1, 0); PG8_LDB(B1, 1, 1); PG8_SCHED; PG8_LDA(At, 1, 0); PG8_STAGE(PG8_SA(0, 1), a2, o2[1]);
            PG8_WAIT_V(8); PG8_WAIT_L(0); PG8_BAR; PG8_MMA(0, 0, At, B0); PG8_MMA(0, 1, At, B1); PG8_BAR; PG8_SCHED;
            PG8_LDA(At, 1, 1); PG8_STAGE(PG8_SB(1, 0), b3, voffB); PG8_STAGE(PG8_SB(1, 1), b3 + hstep, voffB); PG8_STAGE(PG8_SA(1, 0), a3, o2[0]);
            PG8_WAIT_V(8); PG8_WAIT_L(0); PG8_BAR; PG8_MMA(1, 0, At, B0); PG8_MMA(1, 1, At, B1); PG8_BAR; PG8_SCHED;
        }
        if constexpr (ALIGN_EPI) { if (wr == 0) PG8_BAR; }
        E(acc, cur, wr, wc, fr, fq); S.done(cur);
        if (!has_next) break;
#pragma unroll
        for (int a = 0; a < 2; ++a)
#pragma unroll
            for (int b = 0; b < 2; ++b)
#pragma unroll
                for (int m = 0; m < 4; ++m)
#pragma unroll
                    for (int n = 0; n < 2; ++n) acc[a][b][m][n] = (f32x4){0.f, 0.f, 0.f, 0.f};
        cur = nxt; cB = nB; ++ui;
#pragma unroll
        for (int h = 0; h < 2; ++h)
#pragma unroll
            for (int i = 0; i < 2; ++i) oc[h][i] = on[h][i];
        if constexpr (ALIGN_EPI) { if (wr == 1) PG8_BAR; }
    }
    PG8_WAIT_V(0);
    if constexpr (!ALIGN_EPI) { if (wr == 0) PG8_BAR; }
    PG8_BAR;
#undef PG8_SA
#undef PG8_SB
#undef PG8_STAGE
#undef PG8_LDA
#undef PG8_LDB
#undef PG8_MMA
#undef PG8_WAIT_V
#undef PG8_WAIT_L
#undef PG8_BAR
#undef PG8_SCHED
}
}
#ifndef RS1
#define RS1 13
#define RS2 22
#define RS3 28
#endif
namespace ret {
constexpr int QB0 = 0, KB0 = 32768, VB0 = 65536, ST0 = 98304;
constexpr int RET_LDS_BYTES = ST0 + 2 * 8192;
__device__ __forceinline__ int toff(int row, int c16) { return row * 128 + ((c16 ^ (row & 7)) << 4); }
typedef short v4i16_t __attribute__((ext_vector_type(4)));
__device__ __forceinline__ v4i16_t trd(const LAS unsigned char* p) { return __builtin_amdgcn_ds_read_tr16_b64_v4i16((LAS v4i16_t*)p); }
__device__ __forceinline__ bf16x8 cat8(v4i16_t a, v4i16_t b) { return (bf16x8){a[0], a[1], a[2], a[3], b[0], b[1], b[2], b[3]}; }

#define RET_KEEP(x) asm volatile("" :: "v"(x))
__device__ __forceinline__ float xsum_16_32(float v) {
    { auto rr = __builtin_amdgcn_permlane16_swap(__float_as_uint(v), __float_as_uint(v), false, false); v = __uint_as_float(rr[0]) + __uint_as_float(rr[1]); }
    { auto rr = __builtin_amdgcn_permlane32_swap(__float_as_uint(v), __float_as_uint(v), false, false); v = __uint_as_float(rr[0]) + __uint_as_float(rr[1]); }
    return v;
}
__device__ __forceinline__ void ret_unit(int b, int h, int seg, const bf16* PROJ, bf16* CAT, float gC, LAS unsigned char* lds) {
    int tid_ = threadIdx.x; asm volatile("" : "+v"(tid_));
    const int tid = tid_, lane = tid & 63, w = __builtin_amdgcn_readfirstlane(tid >> 6), g = lane >> 4, c15 = lane & 15;
    const int blk = w < 4 ? w : 11 - w;
    const bf16* base = PROJ + (size_t)b * SEQ * INW;
    const int nfirst = seg == 0 ? 0 : seg == 1 ? RS1 : seg == 2 ? RS2 : RS3, nend = seg == 0 ? RS1 : seg == 1 ? RS2 : seg == 2 ? RS3 : 32;
    const int dr = lane >> 3, dc = (lane & 7) ^ dr;
#define RET_DMA(tileoff, colbase, m) do { _Pragma("unroll") for (int _p = 0; _p < 2; ++_p) { const int pc = w + 8 * _p; \
        __builtin_amdgcn_global_load_lds((const unsigned*)(base + (size_t)((m) * 128 + 8 * pc + dr) * INW + (colbase) + h * 64 + dc * 8), (LAS unsigned*)(lds + (tileoff) + pc * 1024), 16, 0, 0); } } while (0)
    f32x4 sacc[2]; sacc[0] = (f32x4){0.f, 0.f, 0.f, 0.f}; sacc[1] = (f32x4){0.f, 0.f, 0.f, 0.f};
    const int et_s = w >> 1, dt0 = 2 * (w & 1);
    if (nfirst > 0) {
        bf16x8 kprev = (bf16x8){0, 0, 0, 0, 0, 0, 0, 0}, vprev2 = kprev;
        RET_DMA(0, C_RK, 0); RET_DMA(16384, C_RV, 0);
        if (nfirst > 1) { RET_DMA(32768, C_RK, 1); RET_DMA(32768 + 16384, C_RV, 1); }
#pragma unroll 1
        for (int m = 0; m < nfirst; ++m) {
            if (m + 1 < nfirst) asm volatile("s_waitcnt vmcnt(4) lgkmcnt(0)" ::: "memory"); else asm volatile("s_waitcnt vmcnt(0) lgkmcnt(0)" ::: "memory");
            __builtin_amdgcn_s_barrier(); asm volatile("" ::: "memory");
            if (m + 2 < nfirst) { const int s2 = ((m + 2) % 3) * 32768; RET_DMA(s2, C_RK, m + 2); RET_DMA(s2 + 16384, C_RV, m + 2); }
            const LAS unsigned char* Kt = lds + (m % 3) * 32768; const LAS unsigned char* Vt = Kt + 16384;
            sacc[0] = sacc[0] * gC; sacc[1] = sacc[1] * gC;
#pragma unroll
            for (int ks = 0; ks < 4; ++ks) {
                const int q = c15 >> 2, p = c15 & 3, r0 = 32 * ks + 8 * g + q;
                const bf16x8 vf = cat8(trd(Vt + toff(r0, 2 * et_s + (p >> 1)) + (p & 1) * 8), trd(Vt + toff(r0 + 4, 2 * et_s + (p >> 1)) + (p & 1) * 8));
#pragma unroll
                for (int dd = 0; dd < 2; ++dd) { const int c16 = 2 * (dt0 + dd) + (p >> 1);
                    const bf16x8 kf = cat8(trd(Kt + toff(r0, c16) + (p & 1) * 8), trd(Kt + toff(r0 + 4, c16) + (p & 1) * 8));
                    sacc[dd] = __builtin_amdgcn_mfma_f32_16x16x32_bf16(vf, kf, sacc[dd], 0, 0, 0); RET_KEEP(kprev); kprev = kf; }
                RET_KEEP(vprev2); vprev2 = vf;
            }
        }
        RET_KEEP(kprev); RET_KEEP(vprev2);
        asm volatile("s_waitcnt lgkmcnt(0)" ::: "memory"); __builtin_amdgcn_s_barrier(); asm volatile("" ::: "memory");
    }
    { LAS unsigned char* STi = lds + ST0 + (nfirst & 1) * 8192;
#pragma unroll
      for (int dd = 0; dd < 2; ++dd)
#pragma unroll
          for (int rr = 0; rr < 4; ++rr) { const int e = 16 * et_s + 4 * g + rr, d = 16 * (dt0 + dd) + c15;
              *(LAS unsigned short*)(STi + toff(e, d >> 3) + (d & 7) * 2) = (unsigned short)f2bf(sacc[dd][rr]); } }
    RET_DMA(KB0 + (nfirst & 1) * 16384, C_RK, nfirst); RET_DMA(VB0 + (nfirst & 1) * 16384, C_RV, nfirst); RET_DMA(QB0 + (nfirst & 1) * 16384, C_RQ, nfirst);
    __syncthreads();
#define RET_STATE_UPDATE() do { if (m + 1 < nend) { bf16x8 kfp = (bf16x8){0, 0, 0, 0, 0, 0, 0, 0}, vfp = kfp; sacc[0] = sacc[0] * gC; sacc[1] = sacc[1] * gC; _Pragma("unroll") for (int ks = 0; ks < 4; ++ks) { const int q = c15 >> 2, p = c15 & 3, r0 = 32 * ks + 8 * g + q; const bf16x8 vf = cat8(trd(Vt + toff(r0, 2 * et_s + (p >> 1)) + (p & 1) * 8), trd(Vt + toff(r0 + 4, 2 * et_s + (p >> 1)) + (p & 1) * 8)); _Pragma("unroll") for (int dd = 0; dd < 2; ++dd) { const int c16 = 2 * (dt0 + dd) + (p >> 1); const bf16x8 kf = cat8(trd(Kt + toff(r0, c16) + (p & 1) * 8), trd(Kt + toff(r0 + 4, c16) + (p & 1) * 8)); sacc[dd] = __builtin_amdgcn_mfma_f32_16x16x32_bf16(vf, kf, sacc[dd], 0, 0, 0); if (dd == 1) { RET_KEEP(kfp); } kfp = kf; } RET_KEEP(vfp); vfp = vf; } _Pragma("unroll") for (int dd = 0; dd < 2; ++dd) _Pragma("unroll") for (int r = 0; r < 4; ++r) { const int e = 16 * et_s + 4 * g + r, d = 16 * (dt0 + dd) + c15; *(LAS unsigned short*)(STn + toff(e, d >> 3) + (d & 7) * 2) = (unsigned short)f2bf(sacc[dd][r]); } RET_KEEP(kfp); RET_KEEP(vfp); } } while (0)
#pragma unroll 1
    for (int m = nfirst; m < nend; ++m) {
        const int cur = m & 1, nx = cur ^ 1; const bool full = true;
        if (m + 1 < nend) { RET_DMA(KB0 + nx * 16384, C_RK, m + 1); RET_DMA(VB0 + nx * 16384, C_RV, m + 1); RET_DMA(QB0 + nx * 16384, C_RQ, m + 1); }
        const LAS unsigned char* Qt = lds + QB0 + cur * 16384; const LAS unsigned char* Kt = lds + KB0 + cur * 16384; const LAS unsigned char* Vt = lds + VB0 + cur * 16384;
        const LAS unsigned char* STc = lds + ST0 + cur * 8192; LAS unsigned char* STn = lds + ST0 + nx * 8192;
        if (full) {
            const size_t row = (size_t)b * SEQ + m * 128 + 16 * blk + c15;
            u32x2 gg[4];
#pragma unroll
            for (int et = 0; et < 4; ++et) gg[et] = *(const GAS u32x2*)(PROJ + row * INW + C_RG + h * 64 + 16 * et + 4 * g);
            bf16x8 qf[2];
#pragma unroll
            for (int ks = 0; ks < 2; ++ks) qf[ks] = *(const LAS bf16x8*)(Qt + toff(16 * blk + c15, 4 * ks + g));
            bf16x8 pf[4];
#pragma unroll
            for (int ks = 0; ks < 4; ++ks) {
                f32x4 s0 = (f32x4){0.f, 0.f, 0.f, 0.f}, s1 = (f32x4){0.f, 0.f, 0.f, 0.f};
                bf16x8 ka[2], kb[2]; ka[0] = ka[1] = kb[0] = kb[1] = (bf16x8){0, 0, 0, 0, 0, 0, 0, 0};
                if (2 * ks <= blk) {
#pragma unroll
                    for (int kk = 0; kk < 2; ++kk) { ka[kk] = *(const LAS bf16x8*)(Kt + toff(32 * ks + c15, 4 * kk + g)); s0 = __builtin_amdgcn_mfma_f32_16x16x32_bf16(ka[kk], qf[kk], s0, 0, 0, 0); }
                    if (2 * ks == blk) {
#pragma unroll
                        for (int r = 0; r < 4; ++r) if (4 * g + r > c15) s0[r] = 0.f; }
                }
                if (2 * ks + 1 <= blk) {
#pragma unroll
                    for (int kk = 0; kk < 2; ++kk) { kb[kk] = *(const LAS bf16x8*)(Kt + toff(32 * ks + 16 + c15, 4 * kk + g)); s1 = __builtin_amdgcn_mfma_f32_16x16x32_bf16(kb[kk], qf[kk], s1, 0, 0, 0); }
                    if (2 * ks + 1 == blk) {
#pragma unroll
                        for (int r = 0; r < 4; ++r) if (4 * g + r > c15) s1[r] = 0.f; }
                }
                u32x4 pk; pk.x = pk2(s0[0], s0[1]); pk.y = pk2(s0[2], s0[3]); pk.z = pk2(s1[0], s1[1]); pk.w = pk2(s1[2], s1[3]);
                pf[ks] = __builtin_bit_cast(bf16x8, pk);
                RET_KEEP(ka[0]); RET_KEEP(ka[1]); RET_KEEP(kb[0]); RET_KEEP(kb[1]);
            }
            f32x4 o[4];
            bf16x8 vprev[4]; vprev[0] = vprev[1] = vprev[2] = vprev[3] = (bf16x8){0, 0, 0, 0, 0, 0, 0, 0};
#pragma unroll
            for (int et = 0; et < 4; ++et) {
                f32x4 a = (f32x4){0.f, 0.f, 0.f, 0.f};
                bf16x8 sf[2], vcur[4]; vcur[0] = vcur[1] = vcur[2] = vcur[3] = (bf16x8){0, 0, 0, 0, 0, 0, 0, 0};
#pragma unroll
                for (int kk = 0; kk < 2; ++kk) { sf[kk] = *(const LAS bf16x8*)(STc + toff(16 * et + c15, 4 * kk + g)); a = __builtin_amdgcn_mfma_f32_16x16x32_bf16(sf[kk], qf[kk], a, 0, 0, 0); }
                a = a * gC;
#pragma unroll
                for (int ks = 0; ks < 4; ++ks) if (2 * ks <= blk) {
                    const int q = c15 >> 2, p = c15 & 3, r0 = 32 * ks + 4 * g + q, c16 = 2 * et + (p >> 1);
                    const v4i16_t v0 = trd(Vt + toff(r0, c16) + (p & 1) * 8), v1 = trd(Vt + toff(r0 + 16, c16) + (p & 1) * 8);
                    vcur[ks] = cat8(v0, v1);
                    a = __builtin_amdgcn_mfma_f32_16x16x32_bf16(vcur[ks], pf[ks], a, 0, 0, 0);
                }
                o[et] = a;
                RET_KEEP(sf[0]); RET_KEEP(sf[1]);
#pragma unroll
                for (int ks = 0; ks < 4; ++ks) { RET_KEEP(vprev[ks]); vprev[ks] = vcur[ks]; }
            }
            RET_STATE_UPDATE();
#pragma unroll
            for (int ks = 0; ks < 4; ++ks) { RET_KEEP(vprev[ks]); RET_KEEP(pf[ks]); }
            RET_KEEP(qf[0]); RET_KEEP(qf[1]);
            float s = 0.f;
#pragma unroll
            for (int et = 0; et < 4; ++et) s += (o[et][0] + o[et][1]) + (o[et][2] + o[et][3]);
            s = xsum_16_32(s);
            const float mean = s * (1.f / 64.f); float q2 = 0.f;
#pragma unroll
            for (int et = 0; et < 4; ++et) { o[et] = o[et] - mean; q2 += (o[et][0] * o[et][0] + o[et][1] * o[et][1]) + (o[et][2] * o[et][2] + o[et][3] * o[et][3]); }
            q2 = xsum_16_32(q2);
            const float rstd = 1.f / sqrtf(q2 * (1.f / 64.f) + LN_EPS);
#pragma unroll
            for (int et = 0; et < 4; ++et) {
                const float g0 = __uint_as_float(gg[et].x << 16), g1 = __uint_as_float(gg[et].x & 0xffff0000u), g2 = __uint_as_float(gg[et].y << 16), g3 = __uint_as_float(gg[et].y & 0xffff0000u);
                u32x2 wv; wv.x = pk2(o[et][0] * rstd * g0, o[et][1] * rstd * g1); wv.y = pk2(o[et][2] * rstd * g2, o[et][3] * rstd * g3);
                *(GAS u32x2*)(CAT + row * DM + h * 64 + 16 * et + 4 * g) = wv; asm volatile("s_nop 1" :: "v"(wv.x), "v"(wv.y) : "memory"); }
        }
        else { RET_STATE_UPDATE(); }
        __syncthreads();
    }
#undef RET_DMA
#undef RET_STATE_UPDATE
#undef RET_KEEP
}
}
namespace attn_body {
using bf16=__hip_bfloat16;
using bf16x8=__attribute__((ext_vector_type(8)))short;
using s16x4=__attribute__((ext_vector_type(4)))short;
using f32x16=__attribute__((ext_vector_type(16)))float;
using u32x4=__attribute__((ext_vector_type(4)))unsigned;
constexpr int SEQ=4096,D=64,PQ=3584,PO=1024;
constexpr int NW=8,QBLK=32,QB=QBLK*NW,KVBLK=64,NQB=SEQ/QB;
constexpr int ATTN_UNIT_ROWS=QB;
__device__ __forceinline__ int crow(int r,int hi){return (r&3)+8*(r>>2)+4*hi;}
#define SBAR() __builtin_amdgcn_sched_barrier(0)
__device__ __forceinline__ void cmask(f32x16&p0,f32x16&p1,int jb,int qrel,int hi){
  const float NEG=-INFINITY; int kb=64*jb+4*hi;
  #pragma unroll
  for(int r=0;r<16;++r){int kv=kb+(r&3)+8*(r>>2); if(kv>qrel)p0[r]=NEG; if(kv+32>qrel)p1[r]=NEG;}
}

constexpr int NSLOT=3, SLOTB=8192;
constexpr int LDS_K=0, LDS_V=NSLOT*SLOTB, LDS_WS=2*NSLOT*SLOTB, LDS_OST=LDS_WS+NW*64*4, LDS_BYTES=LDS_OST+NW*4096;
constexpr float C2=0.125f*1.4426950408889634f;
__device__ __forceinline__ void glds16(const void*gsrc,unsigned lds_dst){unsigned keep;
  asm volatile("s_mov_b32 %0, m0\n\ts_mov_b32 m0, %2\n\ts_nop 0\n\tglobal_load_lds_dwordx4 %1, off\n\ts_mov_b32 m0, %0":"=&s"(keep):"v"(gsrc),"s"(lds_dst):"memory");}
__device__ __forceinline__ float max3f(float a,float b,float c){float r;asm("v_max3_f32 %0, %1, %2, %3":"=v"(r):"v"(a),"v"(b),"v"(c));return r;}
__device__ __forceinline__ float max2f(float a,float b){float r;asm("v_max_f32_e32 %0, %1, %2":"=v"(r):"v"(a),"v"(b));return r;}
__device__ __forceinline__ float fadd_s(float a,float b){float r;asm("v_add_f32_e32 %0, %1, %2":"=v"(r):"v"(a),"v"(b));return r;}
__device__ __forceinline__ float fsub_s(float a,float b){float r;asm("v_sub_f32_e32 %0, %1, %2":"=v"(r):"v"(a),"v"(b));return r;}
typedef float f32x2_t __attribute__((ext_vector_type(2))); typedef __bf16 bf16x2_t __attribute__((ext_vector_type(2)));
__device__ __forceinline__ unsigned cvtpk_s(float lo,float hi){f32x2_t v={lo,hi};bf16x2_t b=__builtin_convertvector(v,bf16x2_t);return __builtin_bit_cast(unsigned,b);}
#define WAIT_BAR(N) asm volatile("s_waitcnt vmcnt(" #N ") lgkmcnt(0)\n\ts_barrier":::"memory")

__device__ __forceinline__ void qkt(f32x16&p0,f32x16&p1,const char*Kslot,const bf16x8*qr,const f32x16&negm,int r32,int hi){
  const char*kb=Kslot+hi*1024+r32*16;
  #pragma unroll
  for(int d0=0;d0<4;++d0){
    const bf16x8 b0=*reinterpret_cast<const bf16x8*>(kb+d0*2048);
    const bf16x8 b1=*reinterpret_cast<const bf16x8*>(kb+d0*2048+512);
    if(d0==0){p0=__builtin_amdgcn_mfma_f32_32x32x16_bf16(b0,qr[0],negm,0,0,0);p1=__builtin_amdgcn_mfma_f32_32x32x16_bf16(b1,qr[0],negm,0,0,0);}
    else{p0=__builtin_amdgcn_mfma_f32_32x32x16_bf16(b0,qr[d0],p0,0,0,0);p1=__builtin_amdgcn_mfma_f32_32x32x16_bf16(b1,qr[d0],p1,0,0,0);}}
}
typedef __attribute__((address_space(3))) const char* lds_cptr;
typedef short v4i16_t __attribute__((ext_vector_type(4)));
__device__ __forceinline__ void kload8(bf16x8*kf,lds_cptr kp){
  kf[0]=*(const __attribute__((address_space(3))) bf16x8*)(kp);      kf[1]=*(const __attribute__((address_space(3))) bf16x8*)(kp+512);
  kf[2]=*(const __attribute__((address_space(3))) bf16x8*)(kp+2048); kf[3]=*(const __attribute__((address_space(3))) bf16x8*)(kp+2560);
  kf[4]=*(const __attribute__((address_space(3))) bf16x8*)(kp+4096); kf[5]=*(const __attribute__((address_space(3))) bf16x8*)(kp+4608);
  kf[6]=*(const __attribute__((address_space(3))) bf16x8*)(kp+6144); kf[7]=*(const __attribute__((address_space(3))) bf16x8*)(kp+6656);
}
__device__ __forceinline__ void kload2(bf16x8*kf,lds_cptr kp,int j){ kf[2*j]=*(const __attribute__((address_space(3))) bf16x8*)(kp+j*2048); kf[2*j+1]=*(const __attribute__((address_space(3))) bf16x8*)(kp+j*2048+512); }
__device__ __forceinline__ s16x4 vtr(lds_cptr p){ return __builtin_bit_cast(s16x4,__builtin_amdgcn_ds_read_tr16_b64_v4i16((__attribute__((address_space(3))) v4i16_t*)p)); }
__device__ __forceinline__ float rowmax(const f32x16&p0,const f32x16&p1){
  float a=max3f(p0[0],p0[1],p1[0]),b=max3f(p0[2],p0[3],p1[1]);a=max3f(a,p1[2],p1[3]);
  #pragma unroll
  for(int r=4;r<16;r+=4){a=max3f(a,p0[r],p0[r+1]);b=max3f(b,p0[r+2],p0[r+3]);a=max3f(a,p1[r],p1[r+1]);b=max3f(b,p1[r+2],p1[r+3]);}
  const float m=max2f(a,b);
  auto rr=__builtin_amdgcn_permlane32_swap(__float_as_uint(m),__float_as_uint(m),false,false);
  return max2f(__uint_as_float(rr[0]),__uint_as_float(rr[1]));
}
__device__ __forceinline__ void pv(f32x16*o,int vb,bf16x8 pa0,bf16x8 pa1,bf16x8 pa2,bf16x8 pa3){
  #pragma unroll
  for(int d0=0;d0<2;++d0){s16x4 lo[4],hi[4];
    #pragma unroll
    for(int ks=0;ks<4;++ks){
      asm volatile("ds_read_b64_tr_b16 %0,%1 offset:%c2":"=&v"(lo[ks]):"v"(vb),"i"(d0*4096+ks*1024):"memory");
      asm volatile("ds_read_b64_tr_b16 %0,%1 offset:%c2":"=&v"(hi[ks]):"v"(vb),"i"(d0*4096+ks*1024+512):"memory");}
    asm volatile("s_waitcnt lgkmcnt(0)":::"memory");SBAR();
    #define PK(k) (bf16x8){lo[k][0],lo[k][1],lo[k][2],lo[k][3],hi[k][0],hi[k][1],hi[k][2],hi[k][3]}
    o[d0]=__builtin_amdgcn_mfma_f32_32x32x16_bf16(pa0,PK(0),o[d0],0,0,0);
    o[d0]=__builtin_amdgcn_mfma_f32_32x32x16_bf16(pa1,PK(1),o[d0],0,0,0);
    o[d0]=__builtin_amdgcn_mfma_f32_32x32x16_bf16(pa2,PK(2),o[d0],0,0,0);
    o[d0]=__builtin_amdgcn_mfma_f32_32x32x16_bf16(pa3,PK(3),o[d0],0,0,0);
    #undef PK
  }
}

#ifndef ATTN_STORE16
#define ATTN_STORE16(p,v) (*(u32x4*)(p)=(v))
#endif
template<int THRL> __device__ __forceinline__ void attn_unit(int qb,const bf16*Qh,const bf16*__restrict__ Kh,const bf16*__restrict__ Vh,bf16*Oh,char*shm){
  int tid_=threadIdx.x; asm volatile("":"+v"(tid_));
  const int tid=tid_,lane=tid&63,r32=lane&31,hi=lane>>5; const int wid=__builtin_amdgcn_readfirstlane(tid>>6);
  const int q0=qb*QB;
  const bf16*Qw=Qh+(long)(q0+wid*QBLK)*PQ;
  const unsigned lds0=(unsigned)(uintptr_t)shm;
  float*wsf=(float*)(shm+LDS_WS)+wid*64;
  const bf16*ksrc=Kh+(long)lane*PQ+wid*8;
  const bf16*vsrc=Vh+(long)(16*(wid&3)+(lane>>2))*PQ+(wid>>2)*32+(lane&3)*8;
  const unsigned kdst=lds0+LDS_K+wid*1024, vdst=lds0+LDS_V+wid*1024;
  #define DMA_K(t,slot) glds16(ksrc+(long)(t)*KVBLK*PQ,(unsigned)__builtin_amdgcn_readfirstlane(kdst+(slot)))
  #define DMA_V(t,slot) glds16(vsrc+(long)(t)*KVBLK*PQ,(unsigned)__builtin_amdgcn_readfirstlane(vdst+(slot)))
  const int vb0=(int)(lds0+LDS_V)+((lane>>4)&1)*32+(lane&3)*8+(4*hi+((lane&15)>>2))*64;
  const char*Kbase=shm+LDS_K; bf16x8 kf[8];
  const lds_cptr shm3=(lds_cptr)shm; const lds_cptr kp0=shm3+LDS_K+hi*1024+r32*16; const lds_cptr vp0=shm3+LDS_V+((lane>>4)&1)*32+(lane&3)*8+(4*hi+((lane&15)>>2))*64;
  const int NT=(q0+QB)/KVBLK;
  DMA_K(0,0);DMA_V(0,0);DMA_K(1,SLOTB);
  bf16x8 qr[4];
  #pragma unroll
  for(int d0=0;d0<4;++d0)qr[d0]=*reinterpret_cast<const bf16x8*>(&Qw[(long)r32*PQ+d0*16+hi*8]);
  float mhat=0.f,l_reg=0.f;f32x16 o[2];o[0]=f32x16{};o[1]=f32x16{};f32x16 negm=f32x16{};asm volatile("":"+v"(negm));
  const int qrel=wid*QBLK+r32;
  #define CMASK(P0,P1,t) do{int jb_=(t)-(NT-4); if(jb_>=0)cmask(P0,P1,jb_,qrel,hi);}while(0)
  bool resc=false;
  #define START(P0,P1) do{ const float rm=rowmax(P0,P1); resc=false; \
    { const float dl=rm; mhat=fadd_s(mhat,dl); \
      _Pragma("unroll") for(int r=0;r<16;++r){P0[r]=fsub_s(P0[r],dl);P1[r]=fsub_s(P1[r],dl);} \
      _Pragma("unroll") for(int r=0;r<16;++r)negm[r]=-mhat; asm volatile("":"+v"(negm)); } \
    _Pragma("unroll") for(int r=0;r<16;++r)P0[r]=__builtin_amdgcn_exp2f(P0[r]); }while(0)
  #define RESC() do{ if(resc){ asm volatile("s_waitcnt lgkmcnt(0)":::"memory"); \
      _Pragma("unroll") for(int d_=0;d_<2;++d_) _Pragma("unroll") for(int r=0;r<16;++r)o[d_][r]*=wsf[crow(r,hi)]; } }while(0)
  f32x16 pA0,pA1,pB0,pB1;
  int sl_prev=0,sl_cur=0,sl_next=SLOTB;
  #define ROT() do{sl_prev=sl_cur;sl_cur=sl_next;sl_next=(sl_next==(NSLOT-1)*SLOTB)?0:sl_next+SLOTB;}while(0)
  DMA_K(2,2*SLOTB);
  WAIT_BAR(3);
  qkt(pA0,pA1,Kbase,qr,negm,r32,hi);asm volatile("s_nop 15\n\ts_nop 7":"+v"(pA0),"+v"(pA1));CMASK(pA0,pA1,0);
  START(pA0,pA1);
  _Pragma("unroll") for(int r=0;r<16;++r)pA1[r]=__builtin_amdgcn_exp2f(pA1[r]);
  WAIT_BAR(0);
  DMA_K(3,0);DMA_V(1,SLOTB);
  ROT();
  kload8(kf,kp0+sl_cur);
  WAIT_BAR(2);
  s16x4 vlo[8],vhi[8]; u32x4 pw0,pw1,pw2,pw3;
  #define PKW(P,B) cvtpk_s(P[B],P[B+1])
  #define PAF(k) __builtin_bit_cast(bf16x8,pw##k)
  #define VFR(i) (bf16x8){vlo[i][0],vlo[i][1],vlo[i][2],vlo[i][3],vhi[i][0],vhi[i][1],vhi[i][2],vhi[i][3]}
  #define PIN(x) asm volatile("":"+v"(x))
  #define MX3(a,b,c) __builtin_fmaxf(__builtin_fmaxf((a),(b)),(c))
  #define GAPA(MF,A0,A1,A2,A3,W0,W1,PW) do{ MF; sacc+=A0; sacc+=A1; sacc+=A2; sacc+=A3; PIN(sacc); W0; W1; PIN(PW); SBAR(); }while(0)
  #define EX(v) __builtin_amdgcn_exp2f(v)
  #define GAPB(MF,X,B) do{ MF; X[B]=EX(X[B]); X[B+1]=EX(X[B+1]); X[B+2]=EX(X[B+2]); X[B+3]=EX(X[B+3]); PIN(X); SBAR(); }while(0)
  #define VRD(i) do{ vlo[i]=vtr(vp_+(((i)>>2)*4096+((i)&3)*1024)); vhi[i]=vtr(vp_+(((i)>>2)*4096+((i)&3)*1024+512)); }while(0)
  #define KRD(G,j) do{ if(G){ kload2(kf,kp0+sl_next,j); SBAR(); } }while(0)
  #define STEP(C0,C1,P0,P1,t,GK,GV,GL) do{ SBAR(); \
    const lds_cptr vp_=vp0+sl_prev; \
    VRD(0); SBAR(); float sacc=(P0[0]+P0[1]); \
    GAPA(C0=__builtin_amdgcn_mfma_f32_32x32x16_bf16(kf[0],qr[0],negm,0,0,0), P0[2],P0[3],P0[4],P0[5],     pw0[0]=PKW(P0,0), pw0[1]=PKW(P0,2), pw0); \
    VRD(4); SBAR(); GAPA(C1=__builtin_amdgcn_mfma_f32_32x32x16_bf16(kf[1],qr[0],negm,0,0,0), P0[6],P0[7],P0[8],P0[9],     pw0[2]=PKW(P0,4), pw0[3]=PKW(P0,6), pw0); \
    VRD(1); SBAR(); GAPA(C0=__builtin_amdgcn_mfma_f32_32x32x16_bf16(kf[2],qr[1],C0,0,0,0),   P0[10],P0[11],P0[12],P0[13], pw1[0]=PKW(P0,8), pw1[1]=PKW(P0,10), pw1); \
    VRD(5); SBAR(); GAPA(C1=__builtin_amdgcn_mfma_f32_32x32x16_bf16(kf[3],qr[1],C1,0,0,0),   P0[14],P0[15],P1[0],P1[1],   pw1[2]=PKW(P0,12),pw1[3]=PKW(P0,14), pw1); \
    VRD(2); SBAR(); GAPA(C0=__builtin_amdgcn_mfma_f32_32x32x16_bf16(kf[4],qr[2],C0,0,0,0),   P1[2],P1[3],P1[4],P1[5],     pw2[0]=PKW(P1,0), pw2[1]=PKW(P1,2), pw2); \
    VRD(6); SBAR(); GAPA(C1=__builtin_amdgcn_mfma_f32_32x32x16_bf16(kf[5],qr[2],C1,0,0,0),   P1[6],P1[7],P1[8],P1[9],     pw2[2]=PKW(P1,4), pw2[3]=PKW(P1,6), pw2); \
    VRD(3); SBAR(); GAPA(C0=__builtin_amdgcn_mfma_f32_32x32x16_bf16(kf[6],qr[3],C0,0,0,0),   P1[10],P1[11],P1[12],P1[13], pw3[0]=PKW(P1,8), pw3[1]=PKW(P1,10), pw3); \
    VRD(7); SBAR(); GAPA(C1=__builtin_amdgcn_mfma_f32_32x32x16_bf16(kf[7],qr[3],C1,0,0,0),   P1[14],P1[15],0.f,0.f,       pw3[2]=PKW(P1,12),pw3[3]=PKW(P1,14), pw3); \
    l_reg+=sacc; \
    if(GK){DMA_K((t)+3,sl_cur);} if(GV){DMA_V((t)+1,sl_next);} \
    CMASK(C0,C1,t); \
    { float a=MX3(C0[0],C0[1],C1[0]),b=MX3(C0[2],C0[3],C1[1]); a=MX3(a,C1[2],C1[3]); \
      _Pragma("unroll") for(int r=4;r<16;r+=4){a=MX3(a,C0[r],C0[r+1]);b=MX3(b,C0[r+2],C0[r+3]);a=MX3(a,C1[r],C1[r+1]);b=MX3(b,C1[r+2],C1[r+3]);} \
      float rm=__builtin_fmaxf(a,b); { auto rr=__builtin_amdgcn_permlane32_swap(__float_as_uint(rm),__float_as_uint(rm),false,false); rm=__builtin_fmaxf(__uint_as_float(rr[0]),__uint_as_float(rr[1])); } \
      resc=false; \
      if(__builtin_expect(__any(rm>(float)THRL),0)){ const float dl=__builtin_fmaxf(rm,0.f); mhat+=dl; \
        _Pragma("unroll") for(int r=0;r<16;++r){C0[r]-=dl;C1[r]-=dl;} \
        _Pragma("unroll") for(int r=0;r<16;++r)negm[r]=-mhat; asm volatile("":"+v"(negm)); \
        const float f=__builtin_amdgcn_exp2f(-dl); l_reg*=f; if(hi==0)wsf[r32]=f; resc=true; } } \
    SBAR(); \
    GAPB(o[0]=__builtin_amdgcn_mfma_f32_32x32x16_bf16(PAF(0),VFR(0),o[0],0,0,0), C0,0); \
    GAPB(o[1]=__builtin_amdgcn_mfma_f32_32x32x16_bf16(PAF(0),VFR(4),o[1],0,0,0), C0,4); \
    KRD(GL,0); GAPB(o[0]=__builtin_amdgcn_mfma_f32_32x32x16_bf16(PAF(1),VFR(1),o[0],0,0,0), C0,8); \
    KRD(GL,1); GAPB(o[1]=__builtin_amdgcn_mfma_f32_32x32x16_bf16(PAF(1),VFR(5),o[1],0,0,0), C0,12); \
    KRD(GL,2); GAPB(o[0]=__builtin_amdgcn_mfma_f32_32x32x16_bf16(PAF(2),VFR(2),o[0],0,0,0), C1,0); \
    KRD(GL,3); GAPB(o[1]=__builtin_amdgcn_mfma_f32_32x32x16_bf16(PAF(2),VFR(6),o[1],0,0,0), C1,4); \
    GAPB(o[0]=__builtin_amdgcn_mfma_f32_32x32x16_bf16(PAF(3),VFR(3),o[0],0,0,0), C1,8); \
    GAPB(o[1]=__builtin_amdgcn_mfma_f32_32x32x16_bf16(PAF(3),VFR(7),o[1],0,0,0), C1,12); \
    }while(0)
  int t=1;
  #undef CMASK
  #define CMASK(P0,P1,t) do{}while(0)
  for(;t+5<NT;t+=2){
    STEP(pB0,pB1,pA0,pA1,t,true,true,true);     WAIT_BAR(2); RESC(); ROT();
    STEP(pA0,pA1,pB0,pB1,t+1,true,true,true);   WAIT_BAR(2); RESC(); ROT();
  }
  #undef CMASK
  #define CMASK(P0,P1,t) do{int jb_=(t)-(NT-4); if(jb_>=0)cmask(P0,P1,jb_,qrel,hi);}while(0)
  #define ENDW(tt) do{ if((tt)+3<NT){WAIT_BAR(2);} else if((tt)+2<NT){WAIT_BAR(1);} else {WAIT_BAR(0);} }while(0)
  for(;t+1<NT;t+=2){
    STEP(pB0,pB1,pA0,pA1,t,(t+3<NT),(t+1<NT),(t+1<NT));       ENDW(t);   RESC(); ROT();
    STEP(pA0,pA1,pB0,pB1,t+1,(t+4<NT),(t+2<NT),(t+2<NT));     ENDW(t+1); RESC(); ROT();
  }
  STEP(pB0,pB1,pA0,pA1,NT-1,false,false,false); RESC();
  { float sacc=pB0[0]+pB0[1]; _Pragma("unroll") for(int r=2;r<16;++r)sacc+=pB0[r]; _Pragma("unroll") for(int r=0;r<16;++r)sacc+=pB1[r]; l_reg+=sacc;
    pw0=(u32x4){PKW(pB0,0),PKW(pB0,2),PKW(pB0,4),PKW(pB0,6)};pw1=(u32x4){PKW(pB0,8),PKW(pB0,10),PKW(pB0,12),PKW(pB0,14)};pw2=(u32x4){PKW(pB1,0),PKW(pB1,2),PKW(pB1,4),PKW(pB1,6)};pw3=(u32x4){PKW(pB1,8),PKW(pB1,10),PKW(pB1,12),PKW(pB1,14)};
    SBAR(); pv(o,vb0+sl_cur,PAF(0),PAF(1),PAF(2),PAF(3)); }
  #undef PKW
  #undef PAF
  #undef VFR
  #undef PIN
  #undef MX3
  #undef GAPA
  #undef GAPB
  #undef EX
  #undef VRD
  #undef KRD
  #undef STEP
  #undef ENDW
  {auto rr=__builtin_amdgcn_permlane32_swap(__float_as_uint(l_reg),__float_as_uint(l_reg),false,false);l_reg=__uint_as_float(rr[0])+__uint_as_float(rr[1]);}
  if(hi==0)wsf[32+r32]=l_reg;asm volatile("s_waitcnt lgkmcnt(0)":::"memory");
  float rli[16];
  #pragma unroll
  for(int r=0;r<16;++r)rli[r]=__builtin_amdgcn_rcpf(wsf[32+crow(r,hi)]);
  bf16*Ow=Oh+(long)(q0+wid*QBLK)*PO;
  { bf16*stg=(bf16*)(shm+LDS_OST)+wid*2048;
    #pragma unroll
    for(int r=0;r<16;++r){const int orow=crow(r,hi);
      #pragma unroll
      for(int d0=0;d0<2;++d0)stg[orow*64+d0*32+r32]=__float2bfloat16(o[d0][r]*rli[r]);}
    asm volatile("s_waitcnt lgkmcnt(0)":::"memory");
    #pragma unroll
    for(int i=0;i<4;++i){const int row=i*8+(lane>>3),ch=lane&7; const u32x4 v=*(const u32x4*)(stg+row*64+ch*8); ATTN_STORE16(Ow+(long)row*PO+ch*8,v);} }
  asm volatile("s_waitcnt lgkmcnt(0)\n\ts_barrier":::"memory");
  #undef DMA_K
  #undef DMA_V
  #undef CMASK
  #undef START
  #undef RESC
  #undef ROT
}
constexpr int ATTN_LDS_BYTES=LDS_BYTES;
#undef SBAR
#undef WAIT_BAR
}
namespace attn128 {
using bf16=__hip_bfloat16;
using bf16x8=__attribute__((ext_vector_type(8)))short;
using s16x4=__attribute__((ext_vector_type(4)))short;
using f32x16=__attribute__((ext_vector_type(16)))float;
using u32x4=__attribute__((ext_vector_type(4)))unsigned;
constexpr int SEQ=4096,D=64,PQ=3584,PO=1024;
constexpr int NW=8,QBLK=32,QB=QBLK*NW,KVBLK=64,NQB=SEQ/QB;
constexpr int ATTN_UNIT_ROWS=QB;
__device__ __forceinline__ int crow(int r,int hi){return (r&3)+8*(r>>2)+4*hi;}
#define SBAR() __builtin_amdgcn_sched_barrier(0)
__device__ __forceinline__ void cmask(f32x16&p0,f32x16&p1,int jb,int qrel,int hi){
  const float NEG=-INFINITY; int kb=64*jb+4*hi;
  #pragma unroll
  for(int r=0;r<16;++r){int kv=kb+(r&3)+8*(r>>2); if(kv>qrel)p0[r]=NEG; if(kv+32>qrel)p1[r]=NEG;}
}

constexpr int NSLOT=3, SLOTB=8192;
constexpr int LDS_K=0, LDS_V=NSLOT*SLOTB, LDS_WS=LDS_V+NSLOT*2*SLOTB, LDS_OST=LDS_WS+NW*64*4, LDS_BYTES=LDS_OST+NW*4096;
constexpr float C2=0.125f*1.4426950408889634f;
__device__ __forceinline__ void glds16(const void*gsrc,unsigned lds_dst){unsigned keep;
  asm volatile("s_mov_b32 %0, m0\n\ts_mov_b32 m0, %2\n\ts_nop 0\n\tglobal_load_lds_dwordx4 %1, off\n\ts_mov_b32 m0, %0":"=&s"(keep):"v"(gsrc),"s"(lds_dst):"memory");}
__device__ __forceinline__ float max3f(float a,float b,float c){float r;asm("v_max3_f32 %0, %1, %2, %3":"=v"(r):"v"(a),"v"(b),"v"(c));return r;}
__device__ __forceinline__ float max2f(float a,float b){float r;asm("v_max_f32_e32 %0, %1, %2":"=v"(r):"v"(a),"v"(b));return r;}
__device__ __forceinline__ float fadd_s(float a,float b){float r;asm("v_add_f32_e32 %0, %1, %2":"=v"(r):"v"(a),"v"(b));return r;}
__device__ __forceinline__ float fsub_s(float a,float b){float r;asm("v_sub_f32_e32 %0, %1, %2":"=v"(r):"v"(a),"v"(b));return r;}
typedef float f32x2_t __attribute__((ext_vector_type(2))); typedef __bf16 bf16x2_t __attribute__((ext_vector_type(2)));
__device__ __forceinline__ unsigned cvtpk_s(float lo,float hi){f32x2_t v={lo,hi};bf16x2_t b=__builtin_convertvector(v,bf16x2_t);return __builtin_bit_cast(unsigned,b);}
#define WAIT_BAR(N) asm volatile("s_waitcnt vmcnt(" #N ") lgkmcnt(0)\n\ts_barrier":::"memory")

__device__ __forceinline__ void qkt(f32x16&p0,f32x16&p1,const char*Kslot,const bf16x8*qr,int r32,int hi){ const f32x16 negm=f32x16{};
  const char*kb=Kslot+hi*1024+r32*16;
  #pragma unroll
  for(int d0=0;d0<4;++d0){
    const bf16x8 b0=*reinterpret_cast<const bf16x8*>(kb+d0*2048);
    const bf16x8 b1=*reinterpret_cast<const bf16x8*>(kb+d0*2048+512);
    if(d0==0){p0=__builtin_amdgcn_mfma_f32_32x32x16_bf16(b0,qr[0],negm,0,0,0);p1=__builtin_amdgcn_mfma_f32_32x32x16_bf16(b1,qr[0],negm,0,0,0);}
    else{p0=__builtin_amdgcn_mfma_f32_32x32x16_bf16(b0,qr[d0],p0,0,0,0);p1=__builtin_amdgcn_mfma_f32_32x32x16_bf16(b1,qr[d0],p1,0,0,0);}}
}
typedef __attribute__((address_space(3))) const char* lds_cptr;
typedef short v4i16_t __attribute__((ext_vector_type(4)));
__device__ __forceinline__ void kload8(bf16x8*kf,lds_cptr kp){
  kf[0]=*(const __attribute__((address_space(3))) bf16x8*)(kp);      kf[1]=*(const __attribute__((address_space(3))) bf16x8*)(kp+512);
  kf[2]=*(const __attribute__((address_space(3))) bf16x8*)(kp+2048); kf[3]=*(const __attribute__((address_space(3))) bf16x8*)(kp+2560);
  kf[4]=*(const __attribute__((address_space(3))) bf16x8*)(kp+4096); kf[5]=*(const __attribute__((address_space(3))) bf16x8*)(kp+4608);
  kf[6]=*(const __attribute__((address_space(3))) bf16x8*)(kp+6144); kf[7]=*(const __attribute__((address_space(3))) bf16x8*)(kp+6656);
}
__device__ __forceinline__ void kload2(bf16x8*kf,lds_cptr kp,int j){ kf[2*j]=*(const __attribute__((address_space(3))) bf16x8*)(kp+j*2048); kf[2*j+1]=*(const __attribute__((address_space(3))) bf16x8*)(kp+j*2048+512); }
__device__ __forceinline__ s16x4 vtr(lds_cptr p){ return __builtin_bit_cast(s16x4,__builtin_amdgcn_ds_read_tr16_b64_v4i16((__attribute__((address_space(3))) v4i16_t*)p)); }
__device__ __forceinline__ float rowmax(const f32x16&p0,const f32x16&p1){
  float a=max3f(p0[0],p0[1],p1[0]),b=max3f(p0[2],p0[3],p1[1]);a=max3f(a,p1[2],p1[3]);
  #pragma unroll
  for(int r=4;r<16;r+=4){a=max3f(a,p0[r],p0[r+1]);b=max3f(b,p0[r+2],p0[r+3]);a=max3f(a,p1[r],p1[r+1]);b=max3f(b,p1[r+2],p1[r+3]);}
  const float m=max2f(a,b);
  auto rr=__builtin_amdgcn_permlane32_swap(__float_as_uint(m),__float_as_uint(m),false,false);
  return max2f(__uint_as_float(rr[0]),__uint_as_float(rr[1]));
}
__device__ __forceinline__ void pv(f32x16*o,int vb,bf16x8 pa0,bf16x8 pa1,bf16x8 pa2,bf16x8 pa3){
  #pragma unroll
  for(int d0=0;d0<4;++d0){s16x4 lo[4],hi[4];
    #pragma unroll
    for(int ks=0;ks<4;++ks){
      asm volatile("ds_read_b64_tr_b16 %0,%1 offset:%c2":"=&v"(lo[ks]):"v"(vb),"i"(d0*4096+ks*1024):"memory");
      asm volatile("ds_read_b64_tr_b16 %0,%1 offset:%c2":"=&v"(hi[ks]):"v"(vb),"i"(d0*4096+ks*1024+512):"memory");}
    asm volatile("s_waitcnt lgkmcnt(0)":::"memory");SBAR();
    #define PK(k) (bf16x8){lo[k][0],lo[k][1],lo[k][2],lo[k][3],hi[k][0],hi[k][1],hi[k][2],hi[k][3]}
    o[d0]=__builtin_amdgcn_mfma_f32_32x32x16_bf16(pa0,PK(0),o[d0],0,0,0);
    o[d0]=__builtin_amdgcn_mfma_f32_32x32x16_bf16(pa1,PK(1),o[d0],0,0,0);
    o[d0]=__builtin_amdgcn_mfma_f32_32x32x16_bf16(pa2,PK(2),o[d0],0,0,0);
    o[d0]=__builtin_amdgcn_mfma_f32_32x32x16_bf16(pa3,PK(3),o[d0],0,0,0);
    #undef PK
  }
}

#if 0
#define ATTN_STORE16(p,v) (*(u32x4*)(p)=(v))
#endif
template<int THRL> __device__ __forceinline__ void attn_unit(int qb,const bf16*Qh,const bf16*__restrict__ Kh,const bf16*__restrict__ Vh,bf16*Oh,char*shm){
  int tid_=threadIdx.x; asm volatile("":"+v"(tid_));
  const int tid=tid_,lane=tid&63,r32=lane&31,hi=lane>>5; const int wid=__builtin_amdgcn_readfirstlane(tid>>6);
  const int q0=qb*QB;
  const bf16*Qw=Qh+(long)(q0+wid*QBLK)*PQ;
  const unsigned lds0=(unsigned)(uintptr_t)shm;
  float*wsf=(float*)(shm+LDS_WS)+wid*64;
  const bf16*ksrc=Kh+(long)lane*PQ+wid*8;
  const bf16*vsrc=Vh+(long)(16*(wid&3)+(lane>>2))*PQ+(wid>>2)*32+(lane&3)*8;
  const unsigned kdst=lds0+LDS_K+wid*1024, vdst=lds0+LDS_V+wid*1024;
  #define DMA_K(t,slot) glds16(ksrc+(long)(t)*KVBLK*PQ,(unsigned)__builtin_amdgcn_readfirstlane(kdst+(slot)))
  #define DMA_V(t,slot) do{ glds16(vsrc+(long)(t)*KVBLK*PQ,(unsigned)__builtin_amdgcn_readfirstlane(vdst+2*(slot))); glds16(vsrc+64+(long)(t)*KVBLK*PQ,(unsigned)__builtin_amdgcn_readfirstlane(vdst+2*(slot)+8192)); }while(0)
  const int vb0=(int)(lds0+LDS_V)+((lane>>4)&1)*32+(lane&3)*8+(4*hi+((lane&15)>>2))*64;
  const char*Kbase=shm+LDS_K; bf16x8 kf[8];
  const lds_cptr shm3=(lds_cptr)shm; const lds_cptr kp0=shm3+LDS_K+hi*1024+r32*16; const lds_cptr vp0=shm3+LDS_V+((lane>>4)&1)*32+(lane&3)*8+(4*hi+((lane&15)>>2))*64;
  const int NT=(q0+QB)/KVBLK;
  DMA_K(0,0);DMA_V(0,0);DMA_K(1,SLOTB);
  bf16x8 qr[4];
  #pragma unroll
  for(int d0=0;d0<4;++d0)qr[d0]=*reinterpret_cast<const bf16x8*>(&Qw[(long)r32*PQ+d0*16+hi*8]);
  { bf16x8* qst=(bf16x8*)(shm+LDS_OST+wid*4096);
    #pragma unroll
    for(int d0=0;d0<4;++d0)qst[(d0*2+hi)*32+r32]=qr[d0]; }
  const lds_cptr qp0=shm3+LDS_OST+wid*4096+(hi*32+r32)*16;
  #define QLD(d0) (*(const __attribute__((address_space(3))) bf16x8*)(qp0+(d0)*1024))
  float mhat=0.f,l_reg=0.f;f32x16 o[4];o[0]=f32x16{};o[1]=f32x16{};o[2]=f32x16{};o[3]=f32x16{};
  const int qrel=wid*QBLK+r32;
  #define CMASK(P0,P1,t) do{int jb_=(t)-(NT-4); if(jb_>=0)cmask(P0,P1,jb_,qrel,hi);}while(0)
  bool resc=false;
  #define START(P0,P1) do{ const float rm=rowmax(P0,P1); resc=false; \
    { const float dl=rm; mhat=fadd_s(mhat,dl); \
      _Pragma("unroll") for(int r=0;r<16;++r){P0[r]=fsub_s(P0[r],dl);P1[r]=fsub_s(P1[r],dl);} \
      } \
    _Pragma("unroll") for(int r=0;r<16;++r)P0[r]=__builtin_amdgcn_exp2f(P0[r]); }while(0)
  #define RESC() do{ if(resc){ asm volatile("s_waitcnt lgkmcnt(0)":::"memory"); \
      _Pragma("unroll") for(int d_=0;d_<4;++d_) _Pragma("unroll") for(int r=0;r<16;++r)o[d_][r]*=wsf[crow(r,hi)]; } }while(0)
  f32x16 pA0,pA1,pB0,pB1;
  int sl_prev=0,sl_cur=0,sl_next=SLOTB;
  #define ROT() do{sl_prev=sl_cur;sl_cur=sl_next;sl_next=(sl_next==(NSLOT-1)*SLOTB)?0:sl_next+SLOTB;}while(0)
  DMA_K(2,2*SLOTB);
  WAIT_BAR(4);
  qkt(pA0,pA1,Kbase,qr,r32,hi);asm volatile("s_nop 15\n\ts_nop 7":"+v"(pA0),"+v"(pA1));CMASK(pA0,pA1,0);
  START(pA0,pA1);
  _Pragma("unroll") for(int r=0;r<16;++r)pA1[r]=__builtin_amdgcn_exp2f(pA1[r]);
  WAIT_BAR(0);
  DMA_K(3,0);DMA_V(1,SLOTB);
  ROT();
  kload8(kf,kp0+sl_cur);
  WAIT_BAR(3);
  s16x4 vlo[8],vhi[8]; u32x4 pw0,pw1,pw2,pw3;
  #define PKW(P,B) cvtpk_s(P[B],P[B+1])
  #define PAF(k) __builtin_bit_cast(bf16x8,pw##k)
  #define VFR(i) (bf16x8){vlo[i][0],vlo[i][1],vlo[i][2],vlo[i][3],vhi[i][0],vhi[i][1],vhi[i][2],vhi[i][3]}
  #define PIN(x) asm volatile("":"+v"(x))
  #define MX3(a,b,c) __builtin_fmaxf(__builtin_fmaxf((a),(b)),(c))
  #define GAPA(MF,A0,A1,A2,A3,W0,W1,PW) do{ MF; sacc+=A0; sacc+=A1; sacc+=A2; sacc+=A3; PIN(sacc); W0; W1; PIN(PW); SBAR(); }while(0)
  #define EX(v) __builtin_amdgcn_exp2f(v)
  #define GAPB(MF,X,B) do{ MF; X[B]=X[B]-mhat; X[B+1]=X[B+1]-mhat; PIN(X); X[B]=EX(X[B]); X[B+1]=EX(X[B+1]); PIN(X); SBAR(); }while(0)
  #define KEEPF(x) asm volatile(""::"v"(x))
  #define KEEPV(i) do{ asm volatile(""::"v"(vlo[i]),"v"(vhi[i])); }while(0)
  #define VRD2(i) do{ vlo[i]=vtr(vp_+((((i)>>2)+2)*4096+((i)&3)*1024)); vhi[i]=vtr(vp_+((((i)>>2)+2)*4096+((i)&3)*1024+512)); SBAR(); }while(0)
  #define VRD(i) do{ vlo[i]=vtr(vp_+(((i)>>2)*4096+((i)&3)*1024)); vhi[i]=vtr(vp_+(((i)>>2)*4096+((i)&3)*1024+512)); }while(0)
  #define KRD(G,j) do{ if(G){ kload2(kf,kp0+sl_next,j); SBAR(); } }while(0)
  #define STEP(C0,C1,P0,P1,t,GK,GV,GL) do{ SBAR(); const f32x16 zero16=f32x16{}; const bf16x8 ql0=QLD(0),ql1=QLD(1),ql2=QLD(2),ql3=QLD(3); \
    const lds_cptr vp_=vp0+2*sl_prev; \
    VRD(0); SBAR(); float sacc=(P0[0]+P0[1]); \
    GAPA(C0=__builtin_amdgcn_mfma_f32_32x32x16_bf16(kf[0],ql0,zero16,0,0,0), P0[2],P0[3],P0[4],P0[5],     pw0[0]=PKW(P0,0), pw0[1]=PKW(P0,2), pw0); \
    VRD(4); SBAR(); GAPA(C1=__builtin_amdgcn_mfma_f32_32x32x16_bf16(kf[1],ql0,zero16,0,0,0), P0[6],P0[7],P0[8],P0[9],     pw0[2]=PKW(P0,4), pw0[3]=PKW(P0,6), pw0); \
    VRD(1); SBAR(); KEEPF(kf[0]); GAPA(C0=__builtin_amdgcn_mfma_f32_32x32x16_bf16(kf[2],ql1,C0,0,0,0),   P0[10],P0[11],P0[12],P0[13], pw1[0]=PKW(P0,8), pw1[1]=PKW(P0,10), pw1); \
    VRD(5); SBAR(); KEEPF(kf[1]); KEEPF(ql0); GAPA(C1=__builtin_amdgcn_mfma_f32_32x32x16_bf16(kf[3],ql1,C1,0,0,0),   P0[14],P0[15],P1[0],P1[1],   pw1[2]=PKW(P0,12),pw1[3]=PKW(P0,14), pw1); \
    VRD(2); SBAR(); KEEPF(kf[2]); GAPA(C0=__builtin_amdgcn_mfma_f32_32x32x16_bf16(kf[4],ql2,C0,0,0,0),   P1[2],P1[3],P1[4],P1[5],     pw2[0]=PKW(P1,0), pw2[1]=PKW(P1,2), pw2); \
    VRD(6); SBAR(); KEEPF(kf[3]); KEEPF(ql1); GAPA(C1=__builtin_amdgcn_mfma_f32_32x32x16_bf16(kf[5],ql2,C1,0,0,0),   P1[6],P1[7],P1[8],P1[9],     pw2[2]=PKW(P1,4), pw2[3]=PKW(P1,6), pw2); \
    VRD(3); SBAR(); KEEPF(kf[4]); GAPA(C0=__builtin_amdgcn_mfma_f32_32x32x16_bf16(kf[6],ql3,C0,0,0,0),   P1[10],P1[11],P1[12],P1[13], pw3[0]=PKW(P1,8), pw3[1]=PKW(P1,10), pw3); \
    VRD(7); SBAR(); KEEPF(kf[5]); KEEPF(ql2); GAPA(C1=__builtin_amdgcn_mfma_f32_32x32x16_bf16(kf[7],ql3,C1,0,0,0),   P1[14],P1[15],0.f,0.f,       pw3[2]=PKW(P1,12),pw3[3]=PKW(P1,14), pw3); \
    l_reg+=sacc; \
    if(GK){DMA_K((t)+3,sl_cur);} if(GV){DMA_V((t)+1,sl_next);} \
    CMASK(C0,C1,t); \
    { float a=MX3(C0[0],C0[1],C1[0]),b=MX3(C0[2],C0[3],C1[1]); a=MX3(a,C1[2],C1[3]); \
      _Pragma("unroll") for(int r=4;r<16;r+=4){a=MX3(a,C0[r],C0[r+1]);b=MX3(b,C0[r+2],C0[r+3]);a=MX3(a,C1[r],C1[r+1]);b=MX3(b,C1[r+2],C1[r+3]);} \
      float rm=__builtin_fmaxf(a,b); { auto rr=__builtin_amdgcn_permlane32_swap(__float_as_uint(rm),__float_as_uint(rm),false,false); rm=__builtin_fmaxf(__uint_as_float(rr[0]),__uint_as_float(rr[1])); } \
      resc=false; \
      rm-=mhat; \
      if(__builtin_expect(__any(rm>(float)THRL),0)){ const float dl=__builtin_fmaxf(rm,0.f); mhat+=dl; \
        const float f=__builtin_amdgcn_exp2f(-dl); l_reg*=f; if(hi==0)wsf[r32]=f; resc=true; } } \
    KEEPF(kf[6]); KEEPF(kf[7]); KEEPF(ql3); SBAR(); \
    GAPB(o[0]=__builtin_amdgcn_mfma_f32_32x32x16_bf16(PAF(0),VFR(0),o[0],0,0,0), C0,0); \
    GAPB(o[1]=__builtin_amdgcn_mfma_f32_32x32x16_bf16(PAF(0),VFR(4),o[1],0,0,0), C0,2); \
    KRD(GL,0); GAPB(o[0]=__builtin_amdgcn_mfma_f32_32x32x16_bf16(PAF(1),VFR(1),o[0],0,0,0), C0,4); KEEPV(0); VRD2(0); \
    KRD(GL,1); GAPB(o[1]=__builtin_amdgcn_mfma_f32_32x32x16_bf16(PAF(1),VFR(5),o[1],0,0,0), C0,6); KEEPV(4); VRD2(4); \
    KRD(GL,2); GAPB(o[0]=__builtin_amdgcn_mfma_f32_32x32x16_bf16(PAF(2),VFR(2),o[0],0,0,0), C0,8); KEEPV(1); VRD2(1); \
    KRD(GL,3); GAPB(o[1]=__builtin_amdgcn_mfma_f32_32x32x16_bf16(PAF(2),VFR(6),o[1],0,0,0), C0,10); KEEPV(5); VRD2(5); \
    GAPB(o[0]=__builtin_amdgcn_mfma_f32_32x32x16_bf16(PAF(3),VFR(3),o[0],0,0,0), C0,12); KEEPV(2); VRD2(2); \
    GAPB(o[1]=__builtin_amdgcn_mfma_f32_32x32x16_bf16(PAF(3),VFR(7),o[1],0,0,0), C0,14); KEEPV(6); VRD2(6); \
    GAPB(o[2]=__builtin_amdgcn_mfma_f32_32x32x16_bf16(PAF(0),VFR(0),o[2],0,0,0), C1,0); KEEPV(3); VRD2(3); \
    GAPB(o[3]=__builtin_amdgcn_mfma_f32_32x32x16_bf16(PAF(0),VFR(4),o[3],0,0,0), C1,2); KEEPV(7); VRD2(7); \
    GAPB(o[2]=__builtin_amdgcn_mfma_f32_32x32x16_bf16(PAF(1),VFR(1),o[2],0,0,0), C1,4); \
    GAPB(o[3]=__builtin_amdgcn_mfma_f32_32x32x16_bf16(PAF(1),VFR(5),o[3],0,0,0), C1,6); \
    GAPB(o[2]=__builtin_amdgcn_mfma_f32_32x32x16_bf16(PAF(2),VFR(2),o[2],0,0,0), C1,8); \
    GAPB(o[3]=__builtin_amdgcn_mfma_f32_32x32x16_bf16(PAF(2),VFR(6),o[3],0,0,0), C1,10); \
    GAPB(o[2]=__builtin_amdgcn_mfma_f32_32x32x16_bf16(PAF(3),VFR(3),o[2],0,0,0), C1,12); \
    GAPB(o[3]=__builtin_amdgcn_mfma_f32_32x32x16_bf16(PAF(3),VFR(7),o[3],0,0,0), C1,14); \
    }while(0)
  int t=1;
  #undef CMASK
  #define CMASK(P0,P1,t) do{}while(0)
  for(;t+5<NT;t+=2){
    STEP(pB0,pB1,pA0,pA1,t,true,true,true);     WAIT_BAR(3); RESC(); ROT();
    STEP(pA0,pA1,pB0,pB1,t+1,true,true,true);   WAIT_BAR(3); RESC(); ROT();
  }
  #undef CMASK
  #define CMASK(P0,P1,t) do{int jb_=(t)-(NT-4); if(jb_>=0)cmask(P0,P1,jb_,qrel,hi);}while(0)
  #define ENDW(tt) do{ if((tt)+3<NT){WAIT_BAR(3);} else if((tt)+2<NT){WAIT_BAR(2);} else {WAIT_BAR(0);} }while(0)
  for(;t+1<NT;t+=2){
    STEP(pB0,pB1,pA0,pA1,t,(t+3<NT),(t+1<NT),(t+1<NT));       ENDW(t);   RESC(); ROT();
    STEP(pA0,pA1,pB0,pB1,t+1,(t+4<NT),(t+2<NT),(t+2<NT));     ENDW(t+1); RESC(); ROT();
  }
  STEP(pB0,pB1,pA0,pA1,NT-1,false,false,false); RESC();
  { float sacc=pB0[0]+pB0[1]; _Pragma("unroll") for(int r=2;r<16;++r)sacc+=pB0[r]; _Pragma("unroll") for(int r=0;r<16;++r)sacc+=pB1[r]; l_reg+=sacc;
    pw0=(u32x4){PKW(pB0,0),PKW(pB0,2),PKW(pB0,4),PKW(pB0,6)};pw1=(u32x4){PKW(pB0,8),PKW(pB0,10),PKW(pB0,12),PKW(pB0,14)};pw2=(u32x4){PKW(pB1,0),PKW(pB1,2),PKW(pB1,4),PKW(pB1,6)};pw3=(u32x4){PKW(pB1,8),PKW(pB1,10),PKW(pB1,12),PKW(pB1,14)};
    SBAR(); pv(o,vb0+2*sl_cur,PAF(0),PAF(1),PAF(2),PAF(3)); }
  #undef PKW
  #undef PAF
  #undef VFR
  #undef PIN
  #undef MX3
  #undef GAPA
  #undef GAPB
  #undef EX
  #undef VRD
  #undef VRD2
  #undef KEEPF
  #undef KEEPV
  #undef KRD
  #undef STEP
  #undef ENDW
  {auto rr=__builtin_amdgcn_permlane32_swap(__float_as_uint(l_reg),__float_as_uint(l_reg),false,false);l_reg=__uint_as_float(rr[0])+__uint_as_float(rr[1]);}
  if(hi==0)wsf[32+r32]=l_reg;asm volatile("s_waitcnt lgkmcnt(0)":::"memory");
  float rli[16];
  #pragma unroll
  for(int r=0;r<16;++r)rli[r]=__builtin_amdgcn_rcpf(wsf[32+crow(r,hi)]);
  bf16*Ow=Oh+(long)(q0+wid*QBLK)*PO;
  { bf16*stg=(bf16*)(shm+LDS_OST)+wid*2048;
    #pragma unroll
    for(int hf=0;hf<2;++hf){
    #pragma unroll
    for(int r=0;r<16;++r){const int orow=crow(r,hi);
      #pragma unroll
      for(int d0=0;d0<2;++d0)stg[orow*64+d0*32+r32]=__float2bfloat16(o[2*hf+d0][r]*rli[r]);}
    asm volatile("s_waitcnt lgkmcnt(0)":::"memory");
    #pragma unroll
    for(int i=0;i<4;++i){const int row=i*8+(lane>>3),ch=lane&7; const u32x4 v=*(const u32x4*)(stg+row*64+ch*8); ATTN_STORE16(Ow+(long)row*PO+hf*64+ch*8,v);}
    asm volatile("s_waitcnt lgkmcnt(0)":::"memory"); } }
  asm volatile("s_waitcnt lgkmcnt(0)\n\ts_barrier":::"memory");
  #undef DMA_K
  #undef QLD
  #undef DMA_V
  #undef CMASK
  #undef START
  #undef RESC
  #undef ROT
}
constexpr int ATTN_LDS_BYTES=LDS_BYTES;
#undef SBAR
#undef WAIT_BAR
}
#define ST8(ptr, w) do { *(ptr) = (w); asm volatile("s_nop 1" :: "v"((w).x), "v"((w).y) : "memory"); } while (0)
#define ST4(ptr, w) do { *(ptr) = (w); asm volatile("s_nop 1" :: "v"(w) : "memory"); } while (0)
constexpr int NWAVES = 8;
constexpr int RING_OFF = 0, RING_BYTES = 131072;
constexpr int LDSCTL_OFF = RING_BYTES, MISC_OFF = LDSCTL_OFF;
constexpr int TAB_OFF = LDSCTL_OFF + 512;
constexpr int EB_OFF = LDSCTL_OFF + 2048;
constexpr int LCNT_OFF = LDSCTL_OFF + 2304;
constexpr int LDS_BYTES = 147456;
constexpr int CW_BAR = 4096;
constexpr int NPHASE = 18;

#define XB_TMO      128
#define XB_XCNT(j)  (256  + 64 * (j))
#define XB_XSUB(j)  (1280 + 64 * (j))
#define XB_XGEN(j)  (2304 + 64 * (j))
#define XB_TOP      3328
#define XB_TOPGEN   3392
#define XCD_BAR_WORDS 3456
#define XB_SPIN_CAP (1u << 18)

__device__ __forceinline__ unsigned xb_ld(unsigned* p)              { return __hip_atomic_load(p, __ATOMIC_RELAXED, __HIP_MEMORY_SCOPE_AGENT); }
__device__ __forceinline__ unsigned xb_add(unsigned* p, unsigned v) { return __hip_atomic_fetch_add(p, v, __ATOMIC_RELAXED, __HIP_MEMORY_SCOPE_AGENT); }
__device__ __forceinline__ unsigned xb_xcc_id() { return (unsigned)__builtin_amdgcn_s_getreg((3 << 11) | 20) & 0xFu; }
#define XB_SPIN(cond, bar) do { unsigned _sp = 0; while (cond) { __builtin_amdgcn_s_sleep(1); \
    if ((++_sp & 255u) == 0u) { if (xb_ld(&(bar)[XB_TMO])) break; if (_sp > XB_SPIN_CAP) { atomicAdd(&(bar)[XB_TMO], 1u); break; } } } } while (0)

struct XcdBarrier {
    unsigned* bar; unsigned x;
    volatile LAS unsigned* st;
};

__device__ __forceinline__ XcdBarrier xcd_barrier_post(unsigned* bar, volatile LAS unsigned* st) {
    XcdBarrier b; b.bar = bar; b.x = xb_xcc_id(); b.st = st;
    if (threadIdx.x == 0) (void)xb_add(&bar[XB_XCNT(b.x)], 1u);
    return b;
}
__device__ __forceinline__ void xcd_barrier_complete(unsigned* bar, unsigned x, unsigned& nloc, unsigned& nx) {
    const unsigned G = gridDim.x * gridDim.y * gridDim.z;
    unsigned sum, cnt, mine, sp = 0u;
    for (;;) {
        sum = 0u; cnt = 0u; mine = 0u;
#pragma unroll
        for (unsigned j = 0; j < 16; ++j) { const unsigned c = xb_ld(&bar[XB_XCNT(j)]); sum += c; cnt += (c > 0u) ? 1u : 0u; mine = (j == x) ? c : mine; }
        if (sum == G) break;
        __builtin_amdgcn_s_sleep(1);
        if ((++sp & 255u) == 0u) { if (xb_ld(&bar[XB_TMO])) break; if (sp > XB_SPIN_CAP) { atomicAdd(&bar[XB_TMO], 1u); break; } }
    }
    nloc = mine > 0u ? mine : 1u; nx = cnt > 0u ? cnt : 1u;
}

__device__ __forceinline__ void xcd_barrier(const XcdBarrier& b) {
    asm volatile("s_waitcnt vmcnt(0)" ::: "memory");
    __syncthreads();
    if (threadIdx.x == 0) {
        unsigned* bar = b.bar;
        __builtin_amdgcn_s_waitcnt(0);
        unsigned nloc = b.st[0], nx = b.st[1];
        if (nloc == 0u) { xcd_barrier_complete(bar, b.x, nloc, nx); b.st[0] = nloc; b.st[1] = nx; }
        const unsigned old = xb_add(&bar[XB_XSUB(b.x)], 1u);
        const unsigned gen = old / nloc;
        if (old + 1u == (gen + 1u) * nloc) {
            __builtin_amdgcn_fence(__ATOMIC_RELEASE, "agent");
            asm volatile("s_waitcnt vmcnt(0)" ::: "memory");
            const unsigned og = xb_add(&bar[XB_TOP], 1u);
            const unsigned tg = og / nx;
            if (og + 1u == (tg + 1u) * nx) xb_add(&bar[XB_TOPGEN], 1u);
            else XB_SPIN(xb_ld(&bar[XB_TOPGEN]) == tg, bar);
            __builtin_amdgcn_fence(__ATOMIC_ACQUIRE, "agent");
            xb_add(&bar[XB_XGEN(b.x)], 1u);
            asm volatile("s_waitcnt vmcnt(0)" ::: "memory");
        } else {
            XB_SPIN(xb_ld(&bar[XB_XGEN(b.x)]) == gen, bar);
            __builtin_amdgcn_fence(__ATOMIC_ACQUIRE, "agent");
            asm volatile("s_waitcnt vmcnt(0)" ::: "memory");
        }
    }
    __syncthreads();
}


struct Frame {
    LAS unsigned char* lds; volatile LAS unsigned* MISC; gu32* ctl;
    int tid, lane, wave, vcu, G;
    const float *x, *c, *w_ada, *b_ada, *w_in, *w_out, *lq1, *lk1, *lq2, *lk2, *subln, *ln_mix_g, *ln_mix_b, *ln_ffn_g, *ln_ffn_b, *router_w, *router_b, *w_gate, *w_up, *w_down;
    float* out; unsigned char* ws;
    float* mod; float* rot; int* tok_e; float* tok_g; int* tok_slot; int* lists; bf16* Wbf;
    bf16 *S1, *S3, *PROJ, *YP, *HE, *MIXED;
};

__device__ __forceinline__ void transpose_item(const float* W, int ldw, int k0, int n0, bf16* WT, int Kdst, int drow0, LAS float* scr, int lane) {
    f32x4 t[8];
#pragma unroll
    for (int i = 0; i < 8; ++i) t[i] = *(const GAS f32x4*)(W + (size_t)(k0 + 8 * i + (lane >> 3)) * ldw + n0 + 4 * (lane & 7));
#pragma unroll
    for (int i = 0; i < 8; ++i) *(LAS f32x4*)(scr + (8 * i + (lane >> 3)) * 36 + 4 * (lane & 7)) = t[i];
    LDS_WAIT(); asm volatile("" ::: "memory");
    const int c = lane & 7;
#pragma unroll
    for (int j = 0; j < 4; ++j) { const int n = (lane >> 3) + 8 * j; const LAS float* s = scr + (8 * c) * 36 + n;
        u32x4 o; o.x = pk2(s[0 * 36], s[1 * 36]); o.y = pk2(s[2 * 36], s[3 * 36]); o.z = pk2(s[4 * 36], s[5 * 36]); o.w = pk2(s[6 * 36], s[7 * 36]);
        *(GAS u32x4*)(WT + (size_t)(drow0 + n) * Kdst + k0 + 8 * c) = o; }
    LDS_WAIT(); asm volatile("" ::: "memory");
}
constexpr int IT_IN = 16 * 112, IT_OUT = 16 * 32, IT_E = 256, IT_LAYER = IT_IN + IT_OUT + 3 * 16 * IT_E;
__device__ __forceinline__ void p0_weight_item(const Frame& F, int it, LAS float* scr) {
    const int l = it / IT_LAYER; int r = it - l * IT_LAYER; bf16* wl = F.Wbf + (size_t)l * WL_STRIDE;
    if (r < IT_IN) { const int kb = r / 112, c0 = (r % 112) * 32; int drow = c0;
        if (c0 < 1024) drow = (c0 & ~255) + ((c0 >> 5) & 1) * 128 + ((c0 >> 6) & 3) * 32;
        transpose_item(F.w_in + (size_t)l * DM * INW, INW, kb * 64, c0, wl + WL_IN, DM, drow, scr, F.lane); return; }
    r -= IT_IN;
    if (r < IT_OUT) { const int kb = r / 32, c0 = (r % 32) * 32; transpose_item(F.w_out + (size_t)l * DM * DM, DM, kb * 64, c0, wl + WL_OUT, DM, c0, scr, F.lane); return; }
    r -= IT_OUT;
    const int which = r / (16 * IT_E), rr = r % (16 * IT_E), e = rr / IT_E, q = rr % IT_E;
    if (which < 2) { const int kb = q / 16, c0 = (q % 16) * 32; const float* W = (which == 0 ? F.w_gate : F.w_up) + (size_t)(l * NE + e) * DM * DE;
        transpose_item(W, DE, kb * 64, c0, wl + WL_GU, DM, e * 1024 + (c0 >> 7) * 256 + which * 128 + (c0 & 127), scr, F.lane); }
    else { const int kb = q / 32, c0 = (q % 32) * 32; transpose_item(F.w_down + (size_t)(l * NE + e) * DE * DM, DM, kb * 64, c0, wl + WL_D, DE, e * 1024 + c0, scr, F.lane); }
}

#ifndef DEFER_W1
#define DEFER_W1 0
#endif
#ifndef W1_CAP1
#define W1_CAP1 4
#endif
#ifndef W1_CAP2
#define W1_CAP2 2
#endif
__device__ __forceinline__ void deferred_weights(Frame& F, int nwg, int stage) {
    LAS float* scr = (LAS float*)(F.lds + RING_OFF + F.wave * 9216);
    const int rem = nwg % F.G, I = rem ? F.G - rem : 0, slots = I * NWAVES, base1 = slots * W1_CAP1, base2 = base1 + slots * W1_CAP2;
    if (stage < 2) { if (!rem || (int)blockIdx.x < rem) return;
        const int r = ((int)blockIdx.x - rem) * NWAVES + F.wave, cap = stage == 0 ? W1_CAP1 : W1_CAP2, base = stage == 0 ? 0 : base1;
        for (int k = 0; k < cap; ++k) { const int idx = base + r + k * slots; if (idx < IT_LAYER) p0_weight_item(F, IT_LAYER + idx, scr); }
    } else { for (int idx = base2 + F.vcu * NWAVES + F.wave; idx < IT_LAYER; idx += F.G * NWAVES) p0_weight_item(F, IT_LAYER + idx, scr); }
}
__device__ __forceinline__ void ph_prologue(Frame& F) {
    LAS float* scr = (LAS float*)(F.lds + RING_OFF + F.wave * 9216);
    LAS float* cond = (LAS float*)(F.lds + RING_OFF + 73728);
    LAS float* part = (LAS float*)(F.lds + RING_OFF + 73728 + 32768);
    if ((int)blockIdx.x < 192) {
        { float cv[16];
#pragma unroll
          for (int j = 0; j < 16; ++j) cv[j] = F.c[F.tid + 512 * j];
#pragma unroll
          for (int j = 0; j < 16; ++j) cond[F.tid + 512 * j] = cv[j] / (1.f + expf(-cv[j])); }
        __syncthreads();
        for (int item = blockIdx.x; item < 192; item += F.G) {
            const int l = item / 96, j0 = (item % 96) * 64;
            float acc[8];
#pragma unroll
            for (int b = 0; b < 8; ++b) acc[b] = 0.f;
            const float* w = F.w_ada + (size_t)l * DM * MODW + (size_t)(F.wave * 128) * MODW + j0 + F.lane;
#pragma unroll 4
            for (int k = 0; k < 128; ++k) { const float wv = w[(size_t)k * MODW];
#pragma unroll
                for (int b = 0; b < 8; ++b) acc[b] += cond[b * 1024 + F.wave * 128 + k] * wv; }
#pragma unroll
            for (int b = 0; b < 8; ++b) part[(F.wave * 8 + b) * 64 + F.lane] = acc[b];
            __syncthreads();
            { const int b = F.tid >> 6, ln = F.tid & 63; float s = 0.f;
#pragma unroll
                for (int w8 = 0; w8 < 8; ++w8) s += part[(w8 * 8 + b) * 64 + ln];
                const float mv = s + F.b_ada[l * MODW + j0 + ln]; ST4(&F.mod[(size_t)(l * 8 + b) * MODW + j0 + ln], mv); }
            __syncthreads();
        }
    }
    if ((int)blockIdx.x == F.G - 1 && F.tid < 2) { const int l = F.tid; float s1 = 0.f, s2 = 0.f;
        for (int i = 0; i < 64; ++i) { s1 += F.lq1[l * 64 + i] * F.lk1[l * 64 + i]; s2 += F.lq2[l * 64 + i] * F.lk2[l * 64 + i]; }
        const float li = 0.8f - 0.6f * expf(-0.3f * (float)l);
        F.mod[2 * 8 * MODW + l] = expf(s1) - expf(s2) + li; F.mod[2 * 8 * MODW + 2 + l] = li; }
    if ((int)blockIdx.x == F.G - 2) {
        float* dt = F.mod + 2 * 8 * MODW + 16;
        for (int i = F.tid; i < 1024; i += NWAVES * 64) { const int hh = i >> 7, pp = i & 127; const double gm = 1.0 - exp2(-5.0 - (double)hh);
            dt[i] = (float)(0.125 * pow(gm, (double)(pp - 127))); dt[1024 + i] = (float)pow(gm, (double)(127 - pp)); if (pp == 0) dt[2048 + hh] = (float)pow(gm, 128.0); }
    }
    for (int idx = blockIdx.x * (NWAVES * 64) + F.tid; idx < 4096 * 32; idx += F.G * NWAVES * 64) { const int pos = idx >> 5, i = idx & 31;
        const double inv = pow(10000.0, -(double)(2 * i) / 64.0), a = (double)pos * inv; F.rot[2 * idx] = (float)cos(a); F.rot[2 * idx + 1] = (float)sin(a); }
    const int gw = F.vcu * NWAVES + F.wave, NGW = F.G * NWAVES;
    for (int it = gw; it < (DEFER_W1 ? 1 : 2) * IT_LAYER; it += NGW) p0_weight_item(F, it, scr);
}
__device__ __forceinline__ void ln_mod_row(const float* xrow, const float* sh_, bf16* orow, int lane) {
    const GAS f32x4* xr = (const GAS f32x4*)xrow + lane;
    f32x4 v[4]; float s = 0.f;
#pragma unroll
    for (int j = 0; j < 4; ++j) { v[j] = xr[64 * j]; s += (v[j].x + v[j].y) + (v[j].z + v[j].w); }
    const float mean = wave_sum(s) * (1.f / DM); float s2 = 0.f;
#pragma unroll
    for (int j = 0; j < 4; ++j) { v[j] = v[j] - mean; s2 += (v[j].x * v[j].x + v[j].y * v[j].y) + (v[j].z * v[j].z + v[j].w * v[j].w); }
    const float rstd = 1.f / sqrtf(wave_sum(s2) * (1.f / DM) + LN_EPS);
    const GAS f32x4* sh = (const GAS f32x4*)sh_ + lane; const GAS f32x4* sc = sh + 256; GAS u32x2* o = (GAS u32x2*)orow + lane;
#pragma unroll
    for (int j = 0; j < 4; ++j) { const f32x4 a = sh[64 * j], m = sc[64 * j]; const f32x4 r = v[j] * rstd * (m + 1.f) + a; u32x2 w; w.x = pk2(r.x, r.y); w.y = pk2(r.z, r.w); ST8(&o[64 * j], w); }
}
__device__ __forceinline__ void ln_mod_regs(f32x4 (&v)[4], const float* sh_, bf16* orow, int lane) {
    float s = 0.f;
#pragma unroll
    for (int j = 0; j < 4; ++j) s += (v[j].x + v[j].y) + (v[j].z + v[j].w);
    const float mean = wave_sum(s) * (1.f / DM); float s2 = 0.f;
#pragma unroll
    for (int j = 0; j < 4; ++j) { v[j] = v[j] - mean; s2 += (v[j].x * v[j].x + v[j].y * v[j].y) + (v[j].z * v[j].z + v[j].w * v[j].w); }
    const float rstd = 1.f / sqrtf(wave_sum(s2) * (1.f / DM) + LN_EPS);
    const GAS f32x4* sh = (const GAS f32x4*)sh_ + lane; const GAS f32x4* sc = sh + 256; GAS u32x2* o = (GAS u32x2*)orow + lane;
    f32x4 a[4], mm[4];
#pragma unroll
    for (int j = 0; j < 4; ++j) { a[j] = sh[64 * j]; mm[j] = sc[64 * j]; }
#pragma unroll
    for (int j = 0; j < 4; ++j) { const f32x4 r = v[j] * rstd * (mm[j] + 1.f) + a[j]; u32x2 w; w.x = pk2(r.x, r.y); w.y = pk2(r.z, r.w); ST8(&o[64 * j], w); }
}
__device__ __forceinline__ void ph_ln0(Frame& F) {
    const int gw = F.vcu * NWAVES + F.wave, NGW = F.G * NWAVES;
#pragma unroll 1
    for (int m = gw; m < T; m += 2 * NGW) { int lane = F.lane; asm volatile("" : "+v"(lane));
        const int m2 = m + NGW;
        const GAS f32x4* xa = (const GAS f32x4*)(F.x + (size_t)m * DM) + lane; const GAS f32x4* xb = (const GAS f32x4*)(F.x + (size_t)m2 * DM) + lane;
        f32x4 va[4], vb[4];
#pragma unroll
        for (int j = 0; j < 4; ++j) { va[j] = xa[64 * j]; vb[j] = xb[64 * j]; }
        ln_mod_regs(va, F.mod + (size_t)(m / SEQ) * MODW, F.S1 + (size_t)m * DM, lane);
        ln_mod_regs(vb, F.mod + (size_t)(m2 / SEQ) * MODW, F.S1 + (size_t)m2 * DM, lane); }
}
__device__ __forceinline__ float sane_c(float v) { return (fabsf(v) < 1e4f) ? v : 0.f; }
__device__ __forceinline__ void ph_combine(Frame& F, int l) {
    const int gw = F.vcu * NWAVES + F.wave, NGW = F.G * NWAVES, lane = F.lane;
    const float lam = F.mod[2 * 8 * MODW + l], li = F.mod[2 * 8 * MODW + 2 + l];
#if ATTN128
    const int h = lane >> 4, q = lane & 15, vh0 = (h * 2 + 0) * 2, vh1 = (h * 2 + 1) * 2, d = 8 * q;
#else
    const int h = lane >> 4, q = lane & 15, vh0 = (h * 2 + 0) * 2 + (q >> 3), vh1 = (h * 2 + 1) * 2 + (q >> 3), d = 8 * (q & 7);
#endif
    const f32x4 g0 = *(const f32x4*)(F.subln + l * 128 + 8 * q), g1 = *(const f32x4*)(F.subln + l * 128 + 8 * q + 4);
#pragma unroll 1
    for (int m0 = gw; m0 < T; m0 += 2 * NGW) {
        u32x4 av[2], bv[2];
#pragma unroll
        for (int t = 0; t < 2; ++t) { const int m = m0 + t * NGW; av[t] = *(const GAS u32x4*)(F.S3 + (size_t)m * DM + vh0 * 64 + d); bv[t] = *(const GAS u32x4*)(F.S3 + (size_t)m * DM + vh1 * 64 + d); }
#pragma unroll
        for (int t = 0; t < 2; ++t) { const int m = m0 + t * NGW; const u32x4 a = av[t], b = bv[t];
        float v[8];
        v[0] = __uint_as_float(a.x << 16) - lam * __uint_as_float(b.x << 16); v[1] = __uint_as_float(a.x & 0xffff0000u) - lam * __uint_as_float(b.x & 0xffff0000u);
        v[2] = __uint_as_float(a.y << 16) - lam * __uint_as_float(b.y << 16); v[3] = __uint_as_float(a.y & 0xffff0000u) - lam * __uint_as_float(b.y & 0xffff0000u);
        v[4] = __uint_as_float(a.z << 16) - lam * __uint_as_float(b.z << 16); v[5] = __uint_as_float(a.z & 0xffff0000u) - lam * __uint_as_float(b.z & 0xffff0000u);
        v[6] = __uint_as_float(a.w << 16) - lam * __uint_as_float(b.w << 16); v[7] = __uint_as_float(a.w & 0xffff0000u) - lam * __uint_as_float(b.w & 0xffff0000u);
#pragma unroll
        for (int i = 0; i < 8; ++i) v[i] = sane_c(v[i]);
        float ss = 0.f;
#pragma unroll
        for (int i = 0; i < 8; ++i) ss += v[i] * v[i];
        ss = row16_sum(ss);
        const float r = (1.f - li) / sqrtf(ss * (1.f / 128.f) + LN_EPS);
        u32x4 w; w.x = pk2(v[0] * r * g0.x, v[1] * r * g0.y); w.y = pk2(v[2] * r * g0.z, v[3] * r * g0.w); w.z = pk2(v[4] * r * g1.x, v[5] * r * g1.y); w.w = pk2(v[6] * r * g1.z, v[7] * r * g1.w);
        *(GAS u32x4*)(F.S1 + (size_t)m * DM + 512 + h * 128 + 8 * q) = w; }
    }
}
__device__ __forceinline__ f32x4 bf4(u32x2 m) { f32x4 r; r.x = __uint_as_float(m.x << 16); r.y = __uint_as_float(m.x & 0xffff0000u); r.z = __uint_as_float(m.y << 16); r.w = __uint_as_float(m.y & 0xffff0000u); return r; }
__device__ __forceinline__ float sane(float v, float lim) { return (fabsf(v) < lim) ? v : 0.f; }
__device__ __forceinline__ f32x4 sane4(f32x4 v, float lim) { v.x = sane(v.x, lim); v.y = sane(v.y, lim); v.z = sane(v.z, lim); v.w = sane(v.w, lim); return v; }
#ifndef X2_BF16
#define X2_BF16 1
#endif
struct PmRaw { f32x4 x[4]; u32x2 xb[4]; u32x2 m[4]; };
template <bool XBF>
__device__ __forceinline__ void pm_load(PmRaw& R, const void* xin, const bf16* MIXED, int row, int lane) {
    const GAS u32x2* mr = (const GAS u32x2*)(MIXED + (size_t)row * DM) + lane;
    if (XBF) { const GAS u32x2* xr = (const GAS u32x2*)((const bf16*)xin + (size_t)row * DM) + lane;
#pragma unroll
        for (int j = 0; j < 4; ++j) { R.xb[j] = xr[64 * j]; R.m[j] = mr[64 * j]; }
    } else { const GAS f32x4* xr = (const GAS f32x4*)((const float*)xin + (size_t)row * DM) + lane;
#pragma unroll
        for (int j = 0; j < 4; ++j) { R.x[j] = xr[64 * j]; R.m[j] = mr[64 * j]; } }
}
template <bool XBF>
__device__ __forceinline__ void pm_row(const PmRaw& R, const f32x4 (&g1)[4], const f32x4 (&lg)[4], const f32x4 (&lb)[4], const f32x4 (&sc2)[4], const f32x4 (&sh2)[4],
                                       bf16* X1, bf16* H, const LAS float* rwT, LAS float* lgs, int row, int r, int lane, bool norouter) {
    f32x4 v[4];
    float s = 0.f;
#pragma unroll
    for (int j = 0; j < 4; ++j) { v[j] = (XBF ? sane4(bf4(R.xb[j]), 1e4f) : R.x[j]) * ALPHA + g1[j] * sane4(bf4(R.m[j]), 1e4f); s += (v[j].x + v[j].y) + (v[j].z + v[j].w); }
    float mean = wave_sum(s) * (1.f / DM), s2 = 0.f;
#pragma unroll
    for (int j = 0; j < 4; ++j) { v[j] = v[j] - mean; s2 += (v[j].x * v[j].x + v[j].y * v[j].y) + (v[j].z * v[j].z + v[j].w * v[j].w); }
    float rstd = 1.f / sqrtf(wave_sum(s2) * (1.f / DM) + LN_EPS);
    GAS u32x2* xo = (GAS u32x2*)(X1 + (size_t)row * DM) + lane; s = 0.f;
#pragma unroll
    for (int j = 0; j < 4; ++j) { v[j] = v[j] * rstd * lg[j] + lb[j];
        u32x2 w; w.x = pk2(v[j].x, v[j].y); w.y = pk2(v[j].z, v[j].w); ST8(&xo[64 * j], w); s += (v[j].x + v[j].y) + (v[j].z + v[j].w); }
    mean = wave_sum(s) * (1.f / DM); s2 = 0.f;
#pragma unroll
    for (int j = 0; j < 4; ++j) { v[j] = v[j] - mean; s2 += (v[j].x * v[j].x + v[j].y * v[j].y) + (v[j].z * v[j].z + v[j].w * v[j].w); }
    rstd = 1.f / sqrtf(wave_sum(s2) * (1.f / DM) + LN_EPS);
    GAS u32x2* ho = (GAS u32x2*)(H + (size_t)row * DM) + lane;
#pragma unroll
    for (int j = 0; j < 4; ++j) { v[j] = v[j] * rstd * (sc2[j] + 1.f) + sh2[j]; u32x2 w; w.x = pk2(v[j].x, v[j].y); w.y = pk2(v[j].z, v[j].w); ST8(&ho[64 * j], w); }
    if (norouter) return;
    float a[16];
#pragma unroll
    for (int e = 0; e < 16; ++e) {
        float s0 = 0.f;
#pragma unroll
        for (int j = 0; j < 4; ++j) { const f32x4 w4 = *(const LAS f32x4*)(rwT + e * 1024 + 4 * lane + 256 * j); s0 += (v[j].x * w4.x + v[j].y * w4.y) + (v[j].z * w4.z + v[j].w * w4.w); }
        a[e] = s0;
    }
    const bool h5 = (lane & 32) != 0, h4 = (lane & 16) != 0, h3 = (lane & 8) != 0, h2 = (lane & 4) != 0;
    float c8[8], d4[4], f2[2];
#define PX32(x) ([&]() { auto rr_ = __builtin_amdgcn_permlane32_swap(__float_as_uint(x), __float_as_uint(x), false, false); return __uint_as_float(h5 ? rr_[0] : rr_[1]); }())
#define PX16(x) ([&]() { auto rr_ = __builtin_amdgcn_permlane16_swap(__float_as_uint(x), __float_as_uint(x), false, false); return __uint_as_float(h4 ? rr_[0] : rr_[1]); }())
#define PDPP(x, ctrl) __builtin_bit_cast(float, __builtin_amdgcn_update_dpp(0, __builtin_bit_cast(int, (x)), (ctrl), 0xf, 0xf, false))
#pragma unroll
    for (int i = 0; i < 8; ++i) { const float mine = h5 ? a[8 + i] : a[i], send = h5 ? a[i] : a[8 + i]; c8[i] = mine + PX32(send); }
#pragma unroll
    for (int i = 0; i < 4; ++i) { const float mine = h4 ? c8[4 + i] : c8[i], send = h4 ? c8[i] : c8[4 + i]; d4[i] = mine + PX16(send); }
#pragma unroll
    for (int i = 0; i < 2; ++i) { const float mine = h3 ? d4[2 + i] : d4[i], send = h3 ? d4[i] : d4[2 + i]; f2[i] = mine + PDPP(send, 0x128); }
    float gsum; { const float mine = h2 ? f2[1] : f2[0], send = h2 ? f2[0] : f2[1]; gsum = mine + PDPP(send, 0x141); }
    gsum += PDPP(gsum, 0x4E); gsum += PDPP(gsum, 0xB1);
#undef PX32
#undef PX16
#undef PDPP
    if ((lane & 3) == 0) lgs[r * 16 + (lane >> 2)] = gsum;
}
#ifndef DRY_SKIP
#define DRY_SKIP 0
#endif
template <bool XBF>
__device__ __forceinline__ void ph_postmix_t(Frame& F, int l, bool dry) {
    LAS float* rwT = (LAS float*)(F.lds + RING_OFF);
    LAS float* lgs = (LAS float*)(F.lds + RING_OFF + 65536) + F.wave * 256;
    LAS int* lcnt = (LAS int*)(F.lds + LCNT_OFF);
    const void* xin = (const void*)(l == 0 ? F.x : F.out); const float* modl     = F.mod + (size_t)l * 8 * MODW; int* cnt = (int*)F.ctl + CW_CNT + 64 * l;
    const float* lng = F.ln_mix_g + l * DM; const float* lnb = F.ln_mix_b + l * DM; const int lane = F.lane;
    const bool norouter = dry && (DRY_SKIP & 1);
    { f32x4 t4[8];
#pragma unroll
      for (int j = 0; j < 8; ++j) t4[j] = ((const GAS f32x4*)F.router_w)[F.tid + 512 * j];
#pragma unroll
      for (int j = 0; j < 8; ++j) { const int i4 = F.tid + 512 * j, k = i4 >> 2, e0 = (i4 & 3) * 4; rwT[(e0 + 0) * 1024 + k] = t4[j].x; rwT[(e0 + 1) * 1024 + k] = t4[j].y; rwT[(e0 + 2) * 1024 + k] = t4[j].z; rwT[(e0 + 3) * 1024 + k] = t4[j].w; } }
#pragma unroll 1
    for (int base = blockIdx.x * 128; base < T; base += F.G * 128) {
        if (F.tid < 16) lcnt[F.tid] = 0;
        __syncthreads();
        const int b = base / SEQ, wrow = base + F.wave * 16;
        f32x4 g1[4], lg[4], lb[4], sc2[4], sh2[4];
        { const GAS f32x4* g1p = (const GAS f32x4*)(modl + (size_t)b * MODW + 2 * DM) + lane; const GAS f32x4* lgp = (const GAS f32x4*)lng + lane; const GAS f32x4* lbp = (const GAS f32x4*)lnb + lane;
#pragma unroll
          for (int j = 0; j < 4; ++j) { g1[j] = g1p[64 * j]; sh2[j] = g1p[256 + 64 * j]; sc2[j] = g1p[512 + 64 * j]; lg[j] = lgp[64 * j]; lb[j] = lbp[64 * j]; } }
        PmRaw A, B, C;
        pm_load<XBF>(A, xin, F.MIXED, wrow, lane); pm_load<XBF>(B, xin, F.MIXED, wrow + 1, lane);
#pragma unroll 1
        for (int it = 0; it < 5; ++it) {
            const int r0 = 3 * it;
            pm_load<XBF>(C, xin, F.MIXED, wrow + r0 + 2, lane);
            pm_row<XBF>(A, g1, lg, lb, sc2, sh2, F.S3, F.S1, rwT, lgs, wrow + r0, r0, lane, norouter);
            pm_load<XBF>(A, xin, F.MIXED, wrow + r0 + 3, lane);
            pm_row<XBF>(B, g1, lg, lb, sc2, sh2, F.S3, F.S1, rwT, lgs, wrow + r0 + 1, r0 + 1, lane, norouter);
            if (it < 4) pm_load<XBF>(B, xin, F.MIXED, wrow + r0 + 4, lane);
            pm_row<XBF>(C, g1, lg, lb, sc2, sh2, F.S3, F.S1, rwT, lgs, wrow + r0 + 2, r0 + 2, lane, norouter);
        }
        pm_row<XBF>(A, g1, lg, lb, sc2, sh2, F.S3, F.S1, rwT, lgs, wrow + 15, 15, lane, norouter);
        LDS_WAIT(); asm volatile("" ::: "memory");
        int my_e1 = 0, my_e2 = 0, my_l1 = 0, my_l2 = 0;
        if (lane < 16) {
            float p[16];
#pragma unroll
            for (int q = 0; q < 4; ++q) { const f32x4 t = *(const LAS f32x4*)(lgs + lane * 16 + 4 * q); p[4 * q] = t.x; p[4 * q + 1] = t.y; p[4 * q + 2] = t.z; p[4 * q + 3] = t.w; }
            float mx = -INFINITY, sum = 0.f;
#pragma unroll
            for (int e = 0; e < 16; ++e) { p[e] += F.router_b[e]; mx = fmaxf(mx, p[e]); }
#pragma unroll
            for (int e = 0; e < 16; ++e) { p[e] = expf(p[e] - mx); sum += p[e]; }
            const float rs = 1.f / sum;
#pragma unroll
            for (int e = 0; e < 16; ++e) p[e] *= rs;
            int bg = 0; float bgs = -1.f;
#pragma unroll
            for (int g = 0; g < 4; ++g) { float m1 = p[4 * g]; int i1 = 0;
#pragma unroll
                for (int i = 1; i < 4; ++i) if (p[4 * g + i] > m1) { m1 = p[4 * g + i]; i1 = i; }
                float m2 = -1.f;
#pragma unroll
                for (int i = 0; i < 4; ++i) if (i != i1 && p[4 * g + i] > m2) m2 = p[4 * g + i];
                const float gs = m1 + m2; if (gs > bgs) { bgs = gs; bg = g; } }
            float q0 = 0.f, q1 = 0.f, q2 = 0.f, q3 = 0.f;
#pragma unroll
            for (int g = 0; g < 4; ++g) if (bg == g) { q0 = p[4 * g]; q1 = p[4 * g + 1]; q2 = p[4 * g + 2]; q3 = p[4 * g + 3]; }
            float m1 = q0; int i1 = 0; if (q1 > m1) { m1 = q1; i1 = 1; } if (q2 > m1) { m1 = q2; i1 = 2; } if (q3 > m1) { m1 = q3; i1 = 3; }
            float m2 = -1.f; int i2 = 0;
            if (i1 != 0 && q0 > m2) { m2 = q0; i2 = 0; } if (i1 != 1 && q1 > m2) { m2 = q1; i2 = 1; } if (i1 != 2 && q2 > m2) { m2 = q2; i2 = 2; } if (i1 != 3 && q3 > m2) { m2 = q3; i2 = 3; }
            my_e1 = bg * 4 + i1; my_e2 = bg * 4 + i2; const int row = wrow + lane; const float den = 1.f / (m1 + m2);
            my_l1 = __hip_atomic_fetch_add(lcnt + my_e1, 1, __ATOMIC_RELAXED, __HIP_MEMORY_SCOPE_WORKGROUP); my_l2 = __hip_atomic_fetch_add(lcnt + my_e2, 1, __ATOMIC_RELAXED, __HIP_MEMORY_SCOPE_WORKGROUP);
            const float gw1 = m1 * den, gw2 = m2 * den; ST4(&F.tok_e[2 * row], my_e1); ST4(&F.tok_e[2 * row + 1], my_e2); ST4(&F.tok_g[2 * row], gw1); ST4(&F.tok_g[2 * row + 1], gw2);
        }
        __syncthreads();
        if (F.tid < 16 && !dry) lcnt[16 + F.tid] = atomicAdd(cnt + F.tid, lcnt[F.tid]);
        __syncthreads();
        if (lane < 16 && !dry) { const int row = wrow + lane, s1 = lcnt[16 + my_e1] + my_l1, s2 = lcnt[16 + my_e2] + my_l2;
            ST4(&F.tok_slot[2 * row], s1); ST4(&F.tok_slot[2 * row + 1], s2); ST4(&F.lists[(size_t)my_e1 * T + s1], row); ST4(&F.lists[(size_t)my_e2 * T + s2], row); }
        __syncthreads();
    }
}
__device__ __forceinline__ void ph_postmix(Frame& F, int l, bool dry = false) { if (X2_BF16 && l > 0) ph_postmix_t<true>(F, l, dry); else ph_postmix_t<false>(F, l, dry); }
__device__ __forceinline__ void moe_table(Frame& F, int l) {
    LAS int* tab = (LAS int*)(F.lds + TAB_OFF); LAS int* eb = (LAS int*)(F.lds + EB_OFF); const int* cnt = (const int*)F.ctl + CW_CNT + 64 * l;
    __syncthreads();
    if (F.tid < 272 || F.tid == 511) {
        int pref = 0, mine = -1;
#pragma unroll
        for (int e = 0; e < 16; ++e) { const int n = __hip_atomic_load(cnt + e, RLX_AGENT), nt = (n + 255) >> 8; if (F.tid < 272 && F.tid >= pref && F.tid < pref + nt) mine = e | ((F.tid - pref) << 8);
            if (F.tid == 511) eb[e] = pref * 256; pref += nt; }
        if (F.tid < 272) tab[1 + F.tid] = mine;
        if (F.tid == 511) tab[0] = pref;
    }
    __syncthreads();
}
struct PfRaw { u32x2 x[4], y0[4], y1[4]; };
__device__ __forceinline__ void pf_load(PfRaw& R, const bf16* X1, const bf16* YP, int row, size_t r0, size_t r1, int lane) {
    const GAS u32x2* xr = (const GAS u32x2*)(X1 + (size_t)row * DM) + lane; const GAS u32x2* y0 = (const GAS u32x2*)(YP + r0 * DM) + lane; const GAS u32x2* y1 = (const GAS u32x2*)(YP + r1 * DM) + lane;
#pragma unroll
    for (int j = 0; j < 4; ++j) { R.x[j] = xr[64 * j]; R.y0[j] = y0[64 * j]; R.y1[j] = y1[64 * j]; }
}
template <bool NEXT>
__device__ __forceinline__ void pf_row(const PfRaw& R, float w0, float w1, const f32x4 (&g2)[4], const f32x4 (&lg)[4], const f32x4 (&lb)[4], const f32x4 (&sh)[4], const f32x4 (&sc)[4], float* out, bf16* X2b, bf16* H, int row, int lane, bool store_h) {
    f32x4 v[4]; float s = 0.f;
#pragma unroll
    for (int j = 0; j < 4; ++j) { v[j] = sane4(bf4(R.x[j]), 1e4f) * ALPHA + g2[j] * sane4(bf4(R.y0[j]) * w0 + bf4(R.y1[j]) * w1, 1e4f);
        s += (v[j].x + v[j].y) + (v[j].z + v[j].w); }
    float mean = wave_sum(s) * (1.f / DM), s2 = 0.f;
#pragma unroll
    for (int j = 0; j < 4; ++j) { v[j] = v[j] - mean; s2 += (v[j].x * v[j].x + v[j].y * v[j].y) + (v[j].z * v[j].z + v[j].w * v[j].w); }
    float rstd = 1.f / sqrtf(wave_sum(s2) * (1.f / DM) + LN_EPS);
    GAS f32x4* o = (GAS f32x4*)(out + (size_t)row * DM) + lane; s = 0.f;
    GAS u32x2* ob = (GAS u32x2*)(X2b + (size_t)row * DM) + lane;
#pragma unroll
    for (int j = 0; j < 4; ++j) { v[j] = v[j] * rstd * lg[j] + lb[j];
        if (X2_BF16 && store_h) { u32x2 w; w.x = pk2(v[j].x, v[j].y); w.y = pk2(v[j].z, v[j].w); ST8(&ob[64 * j], w); } else o[64 * j] = v[j];
        s += (v[j].x + v[j].y) + (v[j].z + v[j].w); }
    if (NEXT) {
        mean = wave_sum(s) * (1.f / DM); s2 = 0.f;
#pragma unroll
        for (int j = 0; j < 4; ++j) { v[j] = v[j] - mean; s2 += (v[j].x * v[j].x + v[j].y * v[j].y) + (v[j].z * v[j].z + v[j].w * v[j].w); }
        rstd = 1.f / sqrtf(wave_sum(s2) * (1.f / DM) + LN_EPS);
        GAS u32x2* ho = (GAS u32x2*)(H + (size_t)row * DM) + lane;
#pragma unroll
        for (int j = 0; j < 4; ++j) { const f32x4 r = v[j] * rstd * (sc[j] + 1.f) + sh[j]; u32x2 w; w.x = pk2(r.x, r.y); w.y = pk2(r.z, r.w); if (store_h) ST8(&ho[64 * j], w); }
    }
}
template <bool NEXT>
__device__ __forceinline__ void ph_postffn_t(Frame& F, int l) {
    const LAS int* eb = (const LAS int*)(F.lds + EB_OFF); const float* modl = F.mod + (size_t)l * 8 * MODW; const float* modn = F.mod + (size_t)(l + 1 < DEPTH ? l + 1 : l) * 8 * MODW;
    const float* lng = F.ln_ffn_g + l * DM; const float* lnb = F.ln_ffn_b + l * DM; const int lane = F.lane;
#pragma unroll 1
    for (int base = (F.vcu * NWAVES + F.wave) * 16; base < T; base += F.G * NWAVES * 16) {
        const int b = base / SEQ;
        const int mrow = base + (lane & 15);
        const int e0 = F.tok_e[2 * mrow], e1 = F.tok_e[2 * mrow + 1]; const float mw0 = F.tok_g[2 * mrow], mw1 = F.tok_g[2 * mrow + 1];
        const int mr0 = eb[e0] + F.tok_slot[2 * mrow], mr1 = eb[e1] + F.tok_slot[2 * mrow + 1];
        f32x4 g2[4], lg[4], lb[4], sh[4], sc[4];
        { const GAS f32x4* g2p = (const GAS f32x4*)(modl + (size_t)b * MODW + 5 * DM) + lane; const GAS f32x4* lgp = (const GAS f32x4*)lng + lane; const GAS f32x4* lbp = (const GAS f32x4*)lnb + lane;
          const GAS f32x4* shp = (const GAS f32x4*)(modn + (size_t)b * MODW) + lane;
#pragma unroll
          for (int j = 0; j < 4; ++j) { g2[j] = g2p[64 * j]; lg[j] = lgp[64 * j]; lb[j] = lbp[64 * j]; if (NEXT) { sh[j] = shp[64 * j]; sc[j] = shp[256 + 64 * j]; } else { sh[j] = (f32x4){0.f, 0.f, 0.f, 0.f}; sc[j] = sh[j]; } } }
        PfRaw A, B;
#define PF_LOAD2(R, r) pf_load(R, F.S3, F.YP, base + (r), (size_t)__shfl(mr0, (r)), (size_t)__shfl(mr1, (r)), lane)
#define PF_ROW2(R, r) pf_row<NEXT>(R, __shfl(mw0, (r)), __shfl(mw1, (r)), g2, lg, lb, sh, sc, F.out, (bf16*)F.out, F.S1, base + (r), lane, l + 1 < DEPTH)
        PF_LOAD2(A, 0);
#pragma unroll 1
        for (int it = 0; it < 8; ++it) {
            PF_LOAD2(B, 2 * it + 1);
            PF_ROW2(A, 2 * it);
            if (it < 7) PF_LOAD2(A, 2 * it + 2);
            PF_ROW2(B, 2 * it + 1);
        }
#undef PF_LOAD2
#undef PF_ROW2
    }
}
#ifndef PF_ALWAYS_NEXT
#define PF_ALWAYS_NEXT 1
#endif
__device__ __forceinline__ void ph_postffn(Frame& F, int l) { if (PF_ALWAYS_NEXT || l + 1 < DEPTH) ph_postffn_t<true>(F, l); else ph_postffn_t<false>(F, l); }

typedef __attribute__((address_space(4))) const unsigned char* kaptr_t;
__device__ __forceinline__ void frame_ptrs(Frame& F, kaptr_t ka) {
#define KA_IN(i) (*(const float* __attribute__((address_space(4))) const*)(ka + 8 * (i)))
    F.x = KA_IN(0); F.c = KA_IN(1); F.w_ada = KA_IN(2); F.b_ada = KA_IN(3); F.w_in = KA_IN(4); F.w_out = KA_IN(5); F.lq1 = KA_IN(6); F.lk1 = KA_IN(7); F.lq2 = KA_IN(8); F.lk2 = KA_IN(9);
    F.subln = KA_IN(10); F.ln_mix_g = KA_IN(11); F.ln_mix_b = KA_IN(12); F.ln_ffn_g = KA_IN(13); F.ln_ffn_b = KA_IN(14); F.router_w = KA_IN(15); F.router_b = KA_IN(16);
    F.w_gate = KA_IN(17); F.w_up = KA_IN(18); F.w_down = KA_IN(19);
    F.out = *(float* __attribute__((address_space(4))) const*)(ka + 160);
    unsigned char* ws = *(unsigned char* __attribute__((address_space(4))) const*)(ka + 168);
#undef KA_IN
    F.ws = ws; F.ctl = (gu32*)(ws + WS_CTL);
    F.mod = (float*)(ws + WS_MOD); F.rot = (float*)(ws + WS_ROT); F.tok_e = (int*)(ws + WS_TOK); F.tok_g = (float*)(ws + WS_TOK + 256 * 1024); F.tok_slot = (int*)(ws + WS_TOK + 512 * 1024);
    F.lists = (int*)(ws + WS_LIST); F.Wbf = (bf16*)(ws + WS_W);
    F.S1 = (bf16*)(ws + WS_S1); F.S3 = (bf16*)(ws + WS_S3); F.PROJ = (bf16*)(ws + WS_S2); F.YP = (bf16*)(ws + WS_YP); F.HE = (bf16*)(ws + WS_HE); F.MIXED = (bf16*)(ws + WS_MIXED);
}
struct Args { const float* in[20]; float* out; unsigned char* ws; int ph_lo, ph_hi, li, pad; };
__global__ void __launch_bounds__(NWAVES * 64, 2) mega(Args args) {
    extern __shared__ __attribute__((aligned(16))) unsigned char lds[];
    Frame F;
    F.lds = (LAS unsigned char*)lds; F.MISC = (volatile LAS unsigned*)(F.lds + MISC_OFF);
    F.tid = threadIdx.x; F.lane = F.tid & 63; F.wave = __builtin_amdgcn_readfirstlane(F.tid >> 6);
    F.G = gridDim.x; { const int bx = blockIdx.x; F.vcu = (F.G % 8 == 0) ? (bx % 8) * (F.G / 8) + bx / 8 : bx; }
    F.ctl = (gu32*)(args.ws + WS_CTL);
    for (int u = F.tid; u < (LDS_BYTES - LDSCTL_OFF) / 4; u += NWAVES * 64) ((LAS unsigned*)(F.lds + LDSCTL_OFF))[u] = 0u;
    __syncthreads();
    const int lo = args.ph_lo, hi = args.ph_hi;
    XcdBarrier bar; bar.bar = (unsigned*)(F.ctl + CW_BAR) + args.li * XCD_BAR_WORDS; bar.x = 0; bar.st = nullptr;
    if (hi - lo > 1) bar = xcd_barrier_post((unsigned*)(F.ctl + CW_BAR) + args.li * XCD_BAR_WORDS, F.MISC + 8);
#ifndef KIND_MASK
#define KIND_MASK 0x3ffu
#endif
#define KEN(k) ((KIND_MASK >> (k)) & 1u)
#ifndef REP_KIND
#define REP_KIND -1
#endif
#ifndef REP_N
#define REP_N 1
#endif
#define REPS(k) for (int rep_ = 0; rep_ < ((REP_KIND == (k)) ? REP_N : 1); ++rep_)
#define IN(k) (lo <= (k) && (k) < hi)
#define FRESH() do { int t_ = threadIdx.x; asm volatile("" : "+v"(t_)); F.tid = t_; F.lane = t_ & 63; kaptr_t ka_ = (kaptr_t)__builtin_amdgcn_kernarg_segment_ptr(); asm volatile("" : "+s"(ka_)); frame_ptrs(F, ka_); } while (0)
#ifndef BAR_REP
#define BAR_REP 1
#endif
#define SEAM(k) do { if (IN(k) && IN((k) + 1)) for (int br_ = 0; br_ < BAR_REP; ++br_) xcd_barrier(bar); } while (0)

    if (KEN(8) && IN(0)) REPS(8) { FRESH(); ph_prologue(F); } SEAM(0);
    if (KEN(9) && IN(1)) REPS(9) { FRESH(); ph_ln0(F); } SEAM(1);
    for (int l = 0; l < DEPTH; ++l) {
        const int pb = 2 + 8 * l;
#define wl (F.Wbf + (size_t)l * WL_STRIDE)
        if (KEN(0) && IN(pb + 0)) REPS(0) { FRESH();
            pg8::PlainSched S; S.init(T / 256, INW / 256, F.G, (int)blockIdx.x); S.Bt = wl + WL_IN; S.K = DM;
#ifndef ROT_EXP
#define ROT_EXP 0
#endif
            pg8::EpiInProj E{F.PROJ, F.rot, RET_FAST ? F.mod + 2 * 8 * MODW + 16 : nullptr, (ROT_EXP && rep_ > 0) ? F.S3 : nullptr};
            pg8::gemm_phase<pg8::EpiInProj, pg8::PlainSched, true>(F.lds + RING_OFF, (const char*)F.S1, DM, S, E);
        }
        SEAM(pb + 0);
        if (KEN(1) && IN(pb + 1)) REPS(1) { FRESH();
            if (RET_FAST) REPS(10) { const int bh = F.vcu >> 2, hh = bh & 7; ret::ret_unit(bh >> 3, hh, F.vcu & 3, F.PROJ, F.S1, F.mod[2 * 8 * MODW + 16 + 2048 + hh], F.lds + RING_OFF); }
#if ATTN128
            { const int bhc = F.vcu >> 2, b = bhc >> 3, hc = bhc & 7, h = hc >> 1, c = hc & 1, s = F.vcu & 3;
              const attn128::bf16* base = (const attn128::bf16*)(F.PROJ + (size_t)b * SEQ * INW);
#pragma unroll 1
              for (int i = 0; i < 4; ++i) { const int qb = i == 0 ? s : i == 1 ? 7 - s : i == 2 ? 8 + s : 15 - s;
                  attn128::attn_unit<ATTN_THRL>(qb, base + C_DQ + h * 128 + c * 64, base + C_DK + h * 128 + c * 64, base + C_DV + h * 128,
                                        (attn128::bf16*)(F.S3 + (size_t)b * SEQ * DM + hc * 128), (char*)lds + RING_OFF); } }
        }
#else
            const int pr = F.vcu >> 1, b = pr >> 4, vh = pr & 15, h = vh >> 2, c = (vh >> 1) & 1, vhalf = vh & 1;
            const attn_body::bf16* base = (const attn_body::bf16*)(F.PROJ + (size_t)b * SEQ * INW);
#pragma unroll 1
            for (int i = 0; i < 8; ++i) { const int s = 2 * (i >> 1) + (F.vcu & 1), qb = (i & 1) ? 15 - s : s;
                attn_body::attn_unit<8>(qb, base + C_DQ + h * 128 + c * 64, base + C_DK + h * 128 + c * 64, base + C_DV + h * 128 + vhalf * 64,
                                        (attn_body::bf16*)(F.S3 + (size_t)b * SEQ * DM + vh * 64), (char*)lds + RING_OFF); }
        }
#endif
        SEAM(pb + 1);
        if (KEN(2) && IN(pb + 2)) REPS(2) { FRESH(); ph_combine(F, l); }
        SEAM(pb + 2);
        if (KEN(3) && IN(pb + 3)) REPS(3) { FRESH();
            pg8::PlainSched S; S.init(T / 256, DM / 256, F.G, (int)blockIdx.x); S.Bt = wl + WL_OUT; S.K = DM;
            pg8::EpiPlain E{F.MIXED, DM};
            pg8::gemm_phase<pg8::EpiPlain, pg8::PlainSched, true>(F.lds + RING_OFF, (const char*)F.S1, DM, S, E);
        }
        SEAM(pb + 3);
        if (KEN(4) && IN(pb + 4)) REPS(4) { FRESH(); ph_postmix(F, l, rep_ > 0); }
        SEAM(pb + 4);
        if (KEN(5) && IN(pb + 5)) REPS(5) {
            FRESH(); moe_table(F, l);
            pg8::MoeSched S; S.init(((const LAS int*)(F.lds + TAB_OFF))[0], 4, F.G, (int)blockIdx.x); S.Bt = wl + WL_GU; S.K = DM; S.tab = (const LAS int*)(F.lds + TAB_OFF);
            S.cnt = (const int*)F.ctl + CW_CNT + 64 * l; S.lists = F.lists; S.gather = true;
            pg8::EpiGateUp E{F.HE};
            pg8::gemm_phase<pg8::EpiGateUp, pg8::MoeSched, true>(F.lds + RING_OFF, (const char*)F.S1, DM, S, E);
            if (DEFER_W1 && l == 0) deferred_weights(F, S.nwg, 0);
        }
        SEAM(pb + 5);
        if (KEN(6) && IN(pb + 6)) REPS(6) {
            FRESH(); moe_table(F, l);
            pg8::MoeSched S; S.init(((const LAS int*)(F.lds + TAB_OFF))[0], 4, F.G, (int)blockIdx.x); S.Bt = wl + WL_D; S.K = DE; S.tab = (const LAS int*)(F.lds + TAB_OFF);
            S.cnt = (const int*)F.ctl + CW_CNT + 64 * l; S.lists = F.lists; S.gather = false;
            pg8::EpiPlain E{F.YP, DM};
            pg8::gemm_phase<pg8::EpiPlain, pg8::MoeSched, true>(F.lds + RING_OFF, (const char*)F.HE, DE, S, E);
            if (DEFER_W1 && l == 0) deferred_weights(F, S.nwg, 1);
        }
        SEAM(pb + 6);
        if (KEN(7) && IN(pb + 7)) REPS(7) { FRESH(); moe_table(F, l); if (DEFER_W1 && l == 0) { deferred_weights(F, 4 * ((const LAS int*)(F.lds + TAB_OFF))[0], 2); } ph_postffn(F, l); }
        SEAM(pb + 7);
#undef wl
    }
#undef IN
#undef SEAM
}
#ifndef FAST_MASK
#define FAST_MASK 0x3ffffu
#endif
extern "C" void kernel_launch(void* const* d_in, const int* in_sizes, int n_in, void* d_out, int out_size, void* d_ws, size_t ws_size, hipStream_t stream) {
    static int grid = 0;
    if (grid == 0) {
        if (n_in != 20 || out_size != T * DM || ws_size < WS_END) { fprintf(stderr, "kernel_launch: unexpected shapes (n_in %d out %d ws %zu)\n", n_in, out_size, ws_size); grid = -1; return; }
        int dev = 0, cus = 0, per_cu = 0;
        if (hipGetDevice(&dev) != hipSuccess || hipDeviceGetAttribute(&cus, hipDeviceAttributeMultiprocessorCount, dev) != hipSuccess) { grid = -1; return; }
        if (hipFuncSetAttribute((const void*)mega, hipFuncAttributeMaxDynamicSharedMemorySize, LDS_BYTES) != hipSuccess) { fprintf(stderr, "kernel_launch: hipFuncSetAttribute failed\n"); grid = -1; return; }
        if (hipOccupancyMaxActiveBlocksPerMultiprocessor(&per_cu, (const void*)mega, NWAVES * 64, LDS_BYTES) != hipSuccess || per_cu < 1) fprintf(stderr, "kernel_launch: occupancy query says %d\n", per_cu);
        (void)hipGetLastError();
        grid = cus;
        if (grid != 256) { fprintf(stderr, "kernel_launch: built for 256 CUs, found %d\n", grid); grid = -1; return; }
    }
    if (grid < 0) return;
    const float* x = (const float*)d_in[0];
    const float* w_in = (const float*)d_in[4]; const float* w_out = (const float*)d_in[5];
    const float* subln = (const float*)d_in[10]; const float* ln_mix_g = (const float*)d_in[11]; const float* ln_mix_b = (const float*)d_in[12];
    const float* ln_ffn_g = (const float*)d_in[13]; const float* ln_ffn_b = (const float*)d_in[14]; const float* router_w = (const float*)d_in[15]; const float* router_b = (const float*)d_in[16];
    const float* w_gate = (const float*)d_in[17]; const float* w_up = (const float*)d_in[18]; const float* w_down = (const float*)d_in[19];
    unsigned char* ws = (unsigned char*)d_ws; float* out = (float*)d_out;
    float* mod = (float*)(ws + WS_MOD); float* rot = (float*)(ws + WS_ROT);
    int* tok_e = (int*)(ws + WS_TOK); float* tok_g = (float*)(ws + WS_TOK + 256 * 1024); int* tok_slot = (int*)(ws + WS_TOK + 512 * 1024); int* lists = (int*)(ws + WS_LIST);
    bf16* S1 = (bf16*)(ws + WS_S1); bf16* X1 = (bf16*)(ws + WS_S3); bf16* PROJ = (bf16*)(ws + WS_S2); bf16* YP = (bf16*)(ws + WS_YP); bf16* HE = (bf16*)(ws + WS_HE); bf16* MIXED = (bf16*)(ws + WS_MIXED);
    int* ctl = (int*)(ws + WS_CTL);
    (void)hipMemsetAsync(ws + WS_CTL, 0, 1 * MiB, stream);
    Args a{};
    for (int i = 0; i < 20; ++i) a.in[i] = (const float*)d_in[i];
    a.out = out; a.ws = ws;
    int li = 0, lo = -1;
    auto flush = [&](int hi) { if (lo >= 0) { a.ph_lo = lo; a.ph_hi = hi; a.li = li++; hipLaunchKernelGGL(mega, dim3(grid), dim3(NWAVES * 64), LDS_BYTES, stream, a); lo = -1; } };
    for (int p = 0; p < NPHASE; ++p) {
        const bool fast = (FAST_MASK >> p) & 1u;
        const int l = p < 2 ? 0 : (p - 2) / 8, k = p < 2 ? -1 : (p - 2) % 8;
        const float* modl = mod + (size_t)l * 8 * MODW; int* cnt = ctl + CW_CNT + 64 * l;
        if (fast) { if (lo < 0) lo = p; }
        else {
            flush(p);
            if (p == 0) { k_mod<<<dim3(MODW / 256, 2), 256, 0, stream>>>((const float*)d_in[1], (const float*)d_in[2], (const float*)d_in[3], (const float*)d_in[6], (const float*)d_in[7], (const float*)d_in[8], (const float*)d_in[9], mod);
                          k_rot<<<512, 256, 0, stream>>>(rot); }
            else if (p == 1) k_ln_mod<<<T / 4, 256, 0, stream>>>(x, mod, 0, S1);
            else if (k == 0) k_ngemm_inproj<<<dim3(INW / 64, T / 128), 256, 0, stream>>>(S1, w_in + (size_t)l * DM * INW, rot, PROJ);
            else if (k == 1) k_ndiff<<<dim3(SEQ / 64, 4, NB), 256, 0, stream>>>(PROJ, mod + 2 * 8 * MODW, subln, l, S1);
            else if (k == 2) {   }
            else if (k == 3) k_ngemm_plain<<<dim3(DM / 64, T / 128), 256, 0, stream>>>(S1, DM, w_out + (size_t)l * DM * DM, DM, DM, MIXED, DM);
            else if (k == 4) k_post_mix<<<T / 4, 256, 0, stream>>>(l == 0 ? x : out, MIXED, modl, ln_mix_g + l * DM, ln_mix_b + l * DM, router_w, router_b, X1, S1, tok_e, tok_g, tok_slot, lists, cnt);
            else if (k == 5) k_moe1<<<dim3(DE / 64, T / 128, NE), 256, 0, stream>>>(S1, w_gate + (size_t)l * NE * DM * DE, w_up + (size_t)l * NE * DM * DE, cnt, lists, HE);
            else if (k == 6) k_moe2<<<dim3(DM / 64, T / 128, NE), 256, 0, stream>>>(HE, w_down + (size_t)l * NE * DE * DM, cnt, YP);
            else if (k == 7) k_post_ffn<<<T / 4, 256, 0, stream>>>(X1, YP, modl, ln_ffn_g + l * DM, ln_ffn_b + l * DM, tok_e, tok_g, tok_slot, cnt, out, l + 1 < DEPTH ? mod + (size_t)(l + 1) * 8 * MODW : nullptr, S1);
        }
        if (!RET_FAST && k == 2) { flush(p + 1); k_nret<<<dim3(SEQ / 64, 8, NB), 256, 0, stream>>>(PROJ, S1); }
    }
    flush(NPHASE);
}
```

```cpp
#include <hip/hip_runtime.h>
#include <cstdio>
#include <cstdint>
#include <cmath>

typedef unsigned short bf16;
typedef float f32x4 __attribute__((ext_vector_type(4)));
typedef unsigned u32x4 __attribute__((ext_vector_type(4)));
typedef unsigned u32x2 __attribute__((ext_vector_type(2)));

constexpr int NB = 8, SEQ = 4096, DM = 1024, T = NB * SEQ, DEPTH = 2;
constexpr int INW = 3584, NE = 16, DE = 512;
constexpr int C_RQ = 0, C_RK = 512, C_RV = 1024, C_RG = 1536, C_DQ = 2048, C_DK = 2560, C_DV = 3072;
constexpr float ALPHA = 1.41421356237309515f;
constexpr float LN_EPS = 1e-5f;
constexpr float C2 = 0.125f * 1.4426950408889634f;
constexpr int MODW = 6 * DM;
constexpr int PAIR_ROWS = 69632;

constexpr size_t MiB = 1u << 20;
constexpr size_t WS_CTL = 0;
constexpr size_t WS_MOD = 1 * MiB;
constexpr size_t WS_ROT = 2 * MiB;
constexpr size_t WS_TOK = 3 * MiB;
constexpr size_t WS_LIST = 4 * MiB;
constexpr size_t WS_W = 8 * MiB;
constexpr size_t WS_S1 = 122 * MiB;
constexpr size_t WS_S3 = 186 * MiB;
constexpr size_t WS_S2 = 250 * MiB;
constexpr size_t WS_YP = WS_S2, WS_HE = WS_S2 + 136 * MiB, WS_MIXED = WS_HE;
constexpr size_t WS_END = 474 * MiB;
constexpr int CW_CNT = 64;

__device__ __forceinline__ float bf2f(bf16 v) { return __uint_as_float((unsigned)v << 16); }
__device__ __forceinline__ unsigned f2bf(float f) { unsigned u = __float_as_uint(f); return (u + 0x7fffu + ((u >> 16) & 1u)) >> 16; }
typedef float pk_f32x2_t __attribute__((ext_vector_type(2))); typedef __bf16 pk_bf16x2_t __attribute__((ext_vector_type(2)));
__device__ __forceinline__ unsigned pk2(float lo, float hi) { pk_f32x2_t v = {lo, hi}; pk_bf16x2_t b = __builtin_convertvector(v, pk_bf16x2_t); return __builtin_bit_cast(unsigned, b); }
__device__ __forceinline__ float dpp_add(float v, const int ctrl_tag) { return v; }
#define WS_DPP(v, ctrl) ((v) + __builtin_bit_cast(float, __builtin_amdgcn_update_dpp(0, __builtin_bit_cast(int, (v)), (ctrl), 0xf, 0xf, false)))
__device__ __forceinline__ float wave_sum(float v) {
    v = WS_DPP(v, 0xB1);
    v = WS_DPP(v, 0x4E);
    v = WS_DPP(v, 0x141);
    v = WS_DPP(v, 0x140);
    { auto rr = __builtin_amdgcn_permlane16_swap(__float_as_uint(v), __float_as_uint(v), false, false); v = __uint_as_float(rr[0]) + __uint_as_float(rr[1]); }
    { auto rr = __builtin_amdgcn_permlane32_swap(__float_as_uint(v), __float_as_uint(v), false, false); v = __uint_as_float(rr[0]) + __uint_as_float(rr[1]); }
    return v;
}
__device__ __forceinline__ float row16_sum(float v) {
    v = WS_DPP(v, 0xB1); v = WS_DPP(v, 0x4E); v = WS_DPP(v, 0x141); v = WS_DPP(v, 0x140); return v;
}
__device__ __forceinline__ float silu_f(float v) { return v / (1.f + __expf(-v)); }

__global__ void __launch_bounds__(256) k_mod(const float* c, const float* w_ada, const float* b_ada, const float* lq1, const float* lk1, const float* lq2, const float* lk2, float* mod) {
    __shared__ float cond[8][1024];
    const int l = blockIdx.y, j = blockIdx.x * 256 + threadIdx.x;
    for (int i = threadIdx.x; i < 8192; i += 256) { const float v = c[i]; cond[i >> 10][i & 1023] = v / (1.f + expf(-v)); }
    __syncthreads();
    float acc[8];
#pragma unroll
    for (int b = 0; b < 8; ++b) acc[b] = 0.f;
    const float* w = w_ada + (size_t)l * 1024 * MODW + j;
    for (int k = 0; k < 1024; ++k) { const float wv = w[(size_t)k * MODW];
#pragma unroll
        for (int b = 0; b < 8; ++b) acc[b] += cond[b][k] * wv; }
#pragma unroll
    for (int b = 0; b < 8; ++b) mod[(size_t)(l * 8 + b) * MODW + j] = acc[b] + b_ada[l * MODW + j];
    if (blockIdx.x == 0 && threadIdx.x == 0) {
        float s1 = 0.f, s2 = 0.f;
        for (int i = 0; i < 64; ++i) { s1 += lq1[l * 64 + i] * lk1[l * 64 + i]; s2 += lq2[l * 64 + i] * lk2[l * 64 + i]; }
        const float li = 0.8f - 0.6f * expf(-0.3f * (float)l);
        mod[2 * 8 * MODW + l] = expf(s1) - expf(s2) + li;
        mod[2 * 8 * MODW + 2 + l] = li;
    }
}
__global__ void k_rot(float* rot) {
    const int idx = blockIdx.x * 256 + threadIdx.x; if (idx >= 4096 * 32) return;
    const int pos = idx >> 5, i = idx & 31;
    const double inv = pow(10000.0, -(double)(2 * i) / 64.0), a = (double)pos * inv;
    rot[2 * idx] = (float)cos(a); rot[2 * idx + 1] = (float)sin(a);
}

__global__ void __launch_bounds__(256) k_ln_mod(const float* x, const float* modl, int sh_off, bf16* H) {
    const int row = blockIdx.x * 4 + (threadIdx.x >> 6), lane = threadIdx.x & 63, b = row / SEQ;
    const f32x4* xr = (const f32x4*)(x + (size_t)row * DM) + lane;
    f32x4 v[4]; float s = 0.f;
#pragma unroll
    for (int j = 0; j < 4; ++j) { v[j] = xr[64 * j]; s += (v[j].x + v[j].y) + (v[j].z + v[j].w); }
    const float mean = wave_sum(s) * (1.f / DM); float s2 = 0.f;
#pragma unroll
    for (int j = 0; j < 4; ++j) { v[j] = v[j] - mean; s2 += (v[j].x * v[j].x + v[j].y * v[j].y) + (v[j].z * v[j].z + v[j].w * v[j].w); }
    const float rstd = 1.f / sqrtf(wave_sum(s2) * (1.f / DM) + LN_EPS);
    const f32x4* sh = (const f32x4*)(modl + (size_t)b * MODW + sh_off) + lane; const f32x4* sc = sh + 256;
    u32x2* o = (u32x2*)(H + (size_t)row * DM) + lane;
#pragma unroll
    for (int j = 0; j < 4; ++j) { const f32x4 a = sh[64 * j], m = sc[64 * j]; const f32x4 r = v[j] * rstd * (m + 1.f) + a; u32x2 w; w.x = pk2(r.x, r.y); w.y = pk2(r.z, r.w); o[64 * j] = w; }
}

template <bool DUAL>
__device__ __forceinline__ void ngemm_core(const bf16* arow, const float* W0, const float* W1, int ldw, int K, float (&acc0)[8][4], float (&acc1)[8][4], float* As, float* Ws0, float* Ws1) {
    const int tid = threadIdx.x, tx = tid & 15, ty = tid >> 4;
#pragma unroll
    for (int i = 0; i < 8; ++i)
#pragma unroll
        for (int j = 0; j < 4; ++j) { acc0[i][j] = 0.f; acc1[i][j] = 0.f; }
    const int ar = tid >> 1, ak = (tid & 1) * 8, wk = tid >> 4, wn = (tid & 15) * 4;
    for (int k0 = 0; k0 < K; k0 += 16) {
        const u32x4 av = *(const u32x4*)(arow + k0);
        const f32x4 w0 = *(const f32x4*)(W0 + (size_t)(k0 + wk) * ldw + wn);
        f32x4 w1 = {0.f, 0.f, 0.f, 0.f}; if (DUAL) w1 = *(const f32x4*)(W1 + (size_t)(k0 + wk) * ldw + wn);
        __syncthreads();
        As[(ak + 0) * 129 + ar] = __uint_as_float(av.x << 16); As[(ak + 1) * 129 + ar] = __uint_as_float(av.x & 0xffff0000u);
        As[(ak + 2) * 129 + ar] = __uint_as_float(av.y << 16); As[(ak + 3) * 129 + ar] = __uint_as_float(av.y & 0xffff0000u);
        As[(ak + 4) * 129 + ar] = __uint_as_float(av.z << 16); As[(ak + 5) * 129 + ar] = __uint_as_float(av.z & 0xffff0000u);
        As[(ak + 6) * 129 + ar] = __uint_as_float(av.w << 16); As[(ak + 7) * 129 + ar] = __uint_as_float(av.w & 0xffff0000u);
        *(f32x4*)(Ws0 + wk * 64 + wn) = w0; if (DUAL) *(f32x4*)(Ws1 + wk * 64 + wn) = w1;
        __syncthreads();
#pragma unroll
        for (int k = 0; k < 16; ++k) {
            float a[8], b0[4], b1[4];
#pragma unroll
            for (int i = 0; i < 8; ++i) a[i] = As[k * 129 + ty + 16 * i];
#pragma unroll
            for (int j = 0; j < 4; ++j) { b0[j] = Ws0[k * 64 + tx + 16 * j]; if (DUAL) b1[j] = Ws1[k * 64 + tx + 16 * j]; }
#pragma unroll
            for (int i = 0; i < 8; ++i)
#pragma unroll
                for (int j = 0; j < 4; ++j) { acc0[i][j] += a[i] * b0[j]; if (DUAL) acc1[i][j] += a[i] * b1[j]; }
        }
    }
}

__global__ void __launch_bounds__(256) k_ngemm_inproj(const bf16* H, const float* Win, const float* rot, bf16* PROJ) {
    __shared__ float As[16 * 129], Ws0[16 * 64];
    const int tid = threadIdx.x, tx = tid & 15, ty = tid >> 4, col0 = blockIdx.x * 64, row0 = blockIdx.y * 128;
    float acc[8][4], dummy[8][4];
    ngemm_core<false>(H + (size_t)(row0 + (tid >> 1)) * DM + (tid & 1) * 8, Win + col0, nullptr, INW, DM, acc, dummy, As, Ws0, nullptr);
    const int region = col0 / 512;
#pragma unroll
    for (int i = 0; i < 8; ++i) {
        const int row = row0 + ty + 16 * i, pos = row % SEQ; bf16* o = PROJ + (size_t)row * INW + col0;
        if (region < 2) {
            const float sc = region == 0 ? 0.125f : 1.f;
#pragma unroll
            for (int j = 0; j < 2; ++j) { const int ic = tx + 16 * j; const float cs = rot[(pos * 32 + ic) * 2], sn = rot[(pos * 32 + ic) * 2 + 1];
                const float x1 = acc[i][j], x2 = acc[i][j + 2]; o[ic] = (bf16)f2bf((x1 * cs - x2 * sn) * sc); o[ic + 32] = (bf16)f2bf((x1 * sn + x2 * cs) * sc); }
        } else {
#pragma unroll
            for (int j = 0; j < 4; ++j) { float v = acc[i][j]; if (region == 3) v = silu_f(v); if (region == 4) v *= C2; o[tx + 16 * j] = (bf16)f2bf(v); }
        }
    }
}
__global__ void __launch_bounds__(256) k_ngemm_plain(const bf16* A, int lda, const float* W, int ldw, int K, bf16* C, int ldc) {
    __shared__ float As[16 * 129], Ws0[16 * 64];
    const int tid = threadIdx.x, tx = tid & 15, ty = tid >> 4, col0 = blockIdx.x * 64, row0 = blockIdx.y * 128;
    float acc[8][4], dummy[8][4];
    ngemm_core<false>(A + (size_t)(row0 + (tid >> 1)) * lda + (tid & 1) * 8, W + col0, nullptr, ldw, K, acc, dummy, As, Ws0, nullptr);
#pragma unroll
    for (int i = 0; i < 8; ++i)
#pragma unroll
        for (int j = 0; j < 4; ++j) C[(size_t)(row0 + ty + 16 * i) * ldc + col0 + tx + 16 * j] = (bf16)f2bf(acc[i][j]);
}

__global__ void __launch_bounds__(256) k_nret(const bf16* PROJ, bf16* CAT) {
    __shared__ float Qs[64 * 65], Ks[64 * 65], Vs[64 * 64], st[128]; float* Ss = Ks;
    const int tid = threadIdx.x, tx = tid & 15, ty = tid >> 4;
    const int qt = (gridDim.x - 1) - blockIdx.x, h = blockIdx.y, b = blockIdx.z, q0 = qt * 64;
    const float log_g = logf(1.f - exp2f(-5.f - (float)h));
    const bf16* base = PROJ + (size_t)b * SEQ * INW;
    for (int i = tid; i < 64 * 64; i += 256) { const int r = i >> 6, d = i & 63; Qs[r * 65 + d] = bf2f(base[(size_t)(q0 + r) * INW + C_RQ + h * 64 + d]); }
    float o[4][4];
#pragma unroll
    for (int i = 0; i < 4; ++i)
#pragma unroll
        for (int j = 0; j < 4; ++j) o[i][j] = 0.f;
    for (int kt = 0; kt <= qt; ++kt) {
        const int k0 = kt * 64;
        __syncthreads();
        for (int i = tid; i < 64 * 64; i += 256) { const int r = i >> 6, d = i & 63; Ks[r * 65 + d] = bf2f(base[(size_t)(k0 + r) * INW + C_RK + h * 64 + d]); Vs[r * 64 + d] = bf2f(base[(size_t)(k0 + r) * INW + C_RV + h * 64 + d]); }
        __syncthreads();
        float s[4][4];
#pragma unroll
        for (int i = 0; i < 4; ++i)
#pragma unroll
            for (int j = 0; j < 4; ++j) s[i][j] = 0.f;
        for (int d = 0; d < 64; ++d) { float a[4], k[4];
#pragma unroll
            for (int i = 0; i < 4; ++i) { a[i] = Qs[(ty + 16 * i) * 65 + d]; k[i] = Ks[(tx + 16 * i) * 65 + d]; }
#pragma unroll
            for (int i = 0; i < 4; ++i)
#pragma unroll
                for (int j = 0; j < 4; ++j) s[i][j] += a[i] * k[j]; }
        __syncthreads();
#pragma unroll
        for (int i = 0; i < 4; ++i)
#pragma unroll
            for (int j = 0; j < 4; ++j) { const int t = q0 + ty + 16 * i, m = k0 + tx + 16 * j; Ss[(ty + 16 * i) * 65 + tx + 16 * j] = (m <= t) ? s[i][j] * expf(log_g * (float)(t - m)) : 0.f; }
        __syncthreads();
        for (int m = 0; m < 64; ++m) { float p[4], v[4];
#pragma unroll
            for (int i = 0; i < 4; ++i) { p[i] = Ss[(ty + 16 * i) * 65 + m]; v[i] = Vs[m * 64 + tx + 16 * i]; }
#pragma unroll
            for (int i = 0; i < 4; ++i)
#pragma unroll
                for (int j = 0; j < 4; ++j) o[i][j] += p[i] * v[j]; }
    }
    __syncthreads();
#pragma unroll
    for (int i = 0; i < 4; ++i)
#pragma unroll
        for (int j = 0; j < 4; ++j) Ss[(ty + 16 * i) * 65 + tx + 16 * j] = o[i][j];
    __syncthreads();
    if (tid < 64) { float s = 0.f; for (int d = 0; d < 64; ++d) s += Ss[tid * 65 + d]; const float mean = s * (1.f / 64.f); float q = 0.f; for (int d = 0; d < 64; ++d) { const float e = Ss[tid * 65 + d] - mean; q += e * e; }
        st[tid] = mean; st[64 + tid] = 1.f / sqrtf(q * (1.f / 64.f) + LN_EPS); }
    __syncthreads();
#pragma unroll
    for (int i = 0; i < 4; ++i)
#pragma unroll
        for (int j = 0; j < 4; ++j) { const int r = ty + 16 * i, cc = tx + 16 * j; const size_t row = (size_t)b * SEQ + q0 + r;
            const float g = bf2f(PROJ[row * INW + C_RG + h * 64 + cc]);
            CAT[row * DM + h * 64 + cc] = (bf16)f2bf((o[i][j] - st[r]) * st[64 + r] * g); }
}

__global__ void __launch_bounds__(256) k_ndiff(const bf16* PROJ, const float* modx  , const float* subln, int l, bf16* CAT) {
    __shared__ float Qs[64 * 65], Ks[32 * 65], Vs[32 * 128], Ps[64 * 33], mrow[64], lrow[64], srow[64];
    const int tid = threadIdx.x, tx = tid & 15, ty = tid >> 4;
    const int qt = (gridDim.x - 1) - blockIdx.x, h = blockIdx.y, b = blockIdx.z, q0 = qt * 64;
    const float lam = modx[l], li = modx[2 + l];
    const bf16* base = PROJ + (size_t)b * SEQ * INW;
    float res[4][8];
    for (int c = 0; c < 2; ++c) {
        __syncthreads();
        for (int i = tid; i < 64 * 64; i += 256) { const int r = i >> 6, d = i & 63; Qs[r * 65 + d] = bf2f(base[(size_t)(q0 + r) * INW + C_DQ + h * 128 + c * 64 + d]); }
        if (tid < 64) { mrow[tid] = -INFINITY; lrow[tid] = 0.f; }
        float o[4][8];
#pragma unroll
        for (int i = 0; i < 4; ++i)
#pragma unroll
            for (int j = 0; j < 8; ++j) o[i][j] = 0.f;
        const int nkt = (q0 + 64) / 32;
        for (int kt = 0; kt < nkt; ++kt) {
            const int k0 = kt * 32;
            __syncthreads();
            for (int i = tid; i < 32 * 64; i += 256) { const int r = i >> 6, d = i & 63; Ks[r * 65 + d] = bf2f(base[(size_t)(k0 + r) * INW + C_DK + h * 128 + c * 64 + d]); }
            for (int i = tid; i < 32 * 128; i += 256) { const int r = i >> 7, d = i & 127; Vs[r * 128 + d] = bf2f(base[(size_t)(k0 + r) * INW + C_DV + h * 128 + d]); }
            __syncthreads();
            float s[4][2];
#pragma unroll
            for (int i = 0; i < 4; ++i) { s[i][0] = 0.f; s[i][1] = 0.f; }
            for (int d = 0; d < 64; ++d) { float a[4], k[2];
#pragma unroll
                for (int i = 0; i < 4; ++i) a[i] = Qs[(ty + 16 * i) * 65 + d];
                k[0] = Ks[tx * 65 + d]; k[1] = Ks[(tx + 16) * 65 + d];
#pragma unroll
                for (int i = 0; i < 4; ++i) { s[i][0] += a[i] * k[0]; s[i][1] += a[i] * k[1]; } }
#pragma unroll
            for (int i = 0; i < 4; ++i)
#pragma unroll
                for (int j = 0; j < 2; ++j) { const int t = q0 + ty + 16 * i, m = k0 + tx + 16 * j; Ps[(ty + 16 * i) * 33 + tx + 16 * j] = (m <= t) ? s[i][j] : -INFINITY; }
            __syncthreads();
            if (tid < 64) { float mx = mrow[tid]; for (int m = 0; m < 32; ++m) mx = fmaxf(mx, Ps[tid * 33 + m]);
                const float sc = exp2f(mrow[tid] - mx); float sum = 0.f;
                for (int m = 0; m < 32; ++m) { const float p = exp2f(Ps[tid * 33 + m] - mx); Ps[tid * 33 + m] = p; sum += p; }
                lrow[tid] = lrow[tid] * sc + sum; mrow[tid] = mx; srow[tid] = sc; }
            __syncthreads();
#pragma unroll
            for (int i = 0; i < 4; ++i) { const float sc = srow[ty + 16 * i];
#pragma unroll
                for (int j = 0; j < 8; ++j) o[i][j] *= sc; }
            for (int m = 0; m < 32; ++m) { float p[4], v[8];
#pragma unroll
                for (int i = 0; i < 4; ++i) p[i] = Ps[(ty + 16 * i) * 33 + m];
#pragma unroll
                for (int j = 0; j < 8; ++j) v[j] = Vs[m * 128 + tx + 16 * j];
#pragma unroll
                for (int i = 0; i < 4; ++i)
#pragma unroll
                    for (int j = 0; j < 8; ++j) o[i][j] += p[i] * v[j]; }
        }
        __syncthreads();
#pragma unroll
        for (int i = 0; i < 4; ++i) { const float inv = 1.f / lrow[ty + 16 * i];
#pragma unroll
            for (int j = 0; j < 8; ++j) { if (c == 0) res[i][j] = o[i][j] * inv; else res[i][j] -= lam * o[i][j] * inv; } }
    }
    __syncthreads();
#pragma unroll
    for (int i = 0; i < 4; ++i) { float q = 0.f;
#pragma unroll
        for (int j = 0; j < 8; ++j) q += res[i][j] * res[i][j];
        Ps[(ty + 16 * i) * 33 + tx] = q; }
    __syncthreads();
    if (tid < 64) { float q = 0.f; for (int m = 0; m < 16; ++m) q += Ps[tid * 33 + m]; srow[tid] = 1.f / sqrtf(q * (1.f / 128.f) + LN_EPS); }
    __syncthreads();
#pragma unroll
    for (int i = 0; i < 4; ++i)
#pragma unroll
        for (int j = 0; j < 8; ++j) { const int r = ty + 16 * i, cc = tx + 16 * j; const size_t row = (size_t)b * SEQ + q0 + r;
            CAT[row * DM + 512 + h * 128 + cc] = (bf16)f2bf(res[i][j] * srow[r] * subln[l * 128 + cc] * (1.f - li)); }
}

__global__ void __launch_bounds__(256) k_post_mix(const float* xin, const bf16* MIXED, const float* modl, const float* lng, const float* lnb, const float* rw, const float* rb,
                                                  bf16* X1, bf16* H, int* tok_e, float* tok_g, int* tok_slot, int* lists, int* cnt) {
    const int row = blockIdx.x * 4 + (threadIdx.x >> 6), lane = threadIdx.x & 63, b = row / SEQ;
    const f32x4* xr = (const f32x4*)(xin + (size_t)row * DM) + lane; const u32x2* mr = (const u32x2*)(MIXED + (size_t)row * DM) + lane;
    const f32x4* g1 = (const f32x4*)(modl + (size_t)b * MODW + 2 * DM) + lane; const f32x4* sh2 = g1 + 256; const f32x4* sc2 = g1 + 512;
    f32x4 v[4]; float s = 0.f;
#pragma unroll
    for (int j = 0; j < 4; ++j) { const f32x4 x = xr[64 * j], g = g1[64 * j]; const u32x2 m = mr[64 * j];
        f32x4 mv; mv.x = __uint_as_float(m.x << 16); mv.y = __uint_as_float(m.x & 0xffff0000u); mv.z = __uint_as_float(m.y << 16); mv.w = __uint_as_float(m.y & 0xffff0000u);
        v[j] = x * ALPHA + g * mv; s += (v[j].x + v[j].y) + (v[j].z + v[j].w); }
    float mean = wave_sum(s) * (1.f / DM), s2 = 0.f;
#pragma unroll
    for (int j = 0; j < 4; ++j) { v[j] = v[j] - mean; s2 += (v[j].x * v[j].x + v[j].y * v[j].y) + (v[j].z * v[j].z + v[j].w * v[j].w); }
    float rstd = 1.f / sqrtf(wave_sum(s2) * (1.f / DM) + LN_EPS);
    u32x2* xo = (u32x2*)(X1 + (size_t)row * DM) + lane; s = 0.f;
#pragma unroll
    for (int j = 0; j < 4; ++j) { const f32x4 g = ((const f32x4*)lng)[lane + 64 * j], bb = ((const f32x4*)lnb)[lane + 64 * j]; v[j] = v[j] * rstd * g + bb;
        u32x2 w; w.x = pk2(v[j].x, v[j].y); w.y = pk2(v[j].z, v[j].w); xo[64 * j] = w; s += (v[j].x + v[j].y) + (v[j].z + v[j].w); }
    mean = wave_sum(s) * (1.f / DM); s2 = 0.f;
#pragma unroll
    for (int j = 0; j < 4; ++j) { v[j] = v[j] - mean; s2 += (v[j].x * v[j].x + v[j].y * v[j].y) + (v[j].z * v[j].z + v[j].w * v[j].w); }
    rstd = 1.f / sqrtf(wave_sum(s2) * (1.f / DM) + LN_EPS);
    u32x2* ho = (u32x2*)(H + (size_t)row * DM) + lane;
    float lg[16];
#pragma unroll
    for (int e = 0; e < 16; ++e) lg[e] = 0.f;
#pragma unroll
    for (int j = 0; j < 4; ++j) { const f32x4 a = sh2[64 * j], m = sc2[64 * j]; v[j] = v[j] * rstd * (m + 1.f) + a;
        u32x2 w; w.x = pk2(v[j].x, v[j].y); w.y = pk2(v[j].z, v[j].w); ho[64 * j] = w;
        const f32x4* wr = (const f32x4*)(rw + (size_t)(4 * lane + 256 * j) * 16);
#pragma unroll
        for (int q = 0; q < 4; ++q) { const float hv = q == 0 ? v[j].x : q == 1 ? v[j].y : q == 2 ? v[j].z : v[j].w;
#pragma unroll
            for (int e4 = 0; e4 < 4; ++e4) { const f32x4 w4 = wr[q * 4 + e4]; lg[e4 * 4 + 0] += hv * w4.x; lg[e4 * 4 + 1] += hv * w4.y; lg[e4 * 4 + 2] += hv * w4.z; lg[e4 * 4 + 3] += hv * w4.w; } } }
    float mx = -INFINITY;
#pragma unroll
    for (int e = 0; e < 16; ++e) { lg[e] = wave_sum(lg[e]) + rb[e]; mx = fmaxf(mx, lg[e]); }
    float p[16], sum = 0.f;
#pragma unroll
    for (int e = 0; e < 16; ++e) { p[e] = expf(lg[e] - mx); sum += p[e]; }
    const float rs = 1.f / sum;
#pragma unroll
    for (int e = 0; e < 16; ++e) p[e] *= rs;
    int bg = 0; float bgs = -1.f;
#pragma unroll
    for (int g = 0; g < 4; ++g) { float m1 = p[4 * g]; int i1 = 0;
#pragma unroll
        for (int i = 1; i < 4; ++i) if (p[4 * g + i] > m1) { m1 = p[4 * g + i]; i1 = i; }
        float m2 = -1.f;
#pragma unroll
        for (int i = 0; i < 4; ++i) if (i != i1 && p[4 * g + i] > m2) m2 = p[4 * g + i];
        const float gs = m1 + m2; if (gs > bgs) { bgs = gs; bg = g; } }
    float q0 = 0.f, q1 = 0.f, q2 = 0.f, q3 = 0.f;
#pragma unroll
    for (int g = 0; g < 4; ++g) if (bg == g) { q0 = p[4 * g]; q1 = p[4 * g + 1]; q2 = p[4 * g + 2]; q3 = p[4 * g + 3]; }
    float m1 = q0; int i1 = 0; if (q1 > m1) { m1 = q1; i1 = 1; } if (q2 > m1) { m1 = q2; i1 = 2; } if (q3 > m1) { m1 = q3; i1 = 3; }
    float m2 = -1.f; int i2 = 0;
    if (i1 != 0 && q0 > m2) { m2 = q0; i2 = 0; } if (i1 != 1 && q1 > m2) { m2 = q1; i2 = 1; } if (i1 != 2 && q2 > m2) { m2 = q2; i2 = 2; } if (i1 != 3 && q3 > m2) { m2 = q3; i2 = 3; }
    if (lane == 0) {
        const int e1 = bg * 4 + i1, e2 = bg * 4 + i2; const float den = 1.f / (m1 + m2);
        const int s1 = atomicAdd(cnt + e1, 1), s2_ = atomicAdd(cnt + e2, 1);
        lists[(size_t)e1 * T + s1] = row; lists[(size_t)e2 * T + s2_] = row;
        tok_e[2 * row] = e1; tok_e[2 * row + 1] = e2; tok_g[2 * row] = m1 * den; tok_g[2 * row + 1] = m2 * den; tok_slot[2 * row] = s1; tok_slot[2 * row + 1] = s2_;
    }
}

__device__ __forceinline__ int expert_base(const int* cnt, int e) { int bs = 0; for (int i = 0; i < 16; ++i) if (i < e) bs += (cnt[i] + 255) & ~255; return bs; }
__global__ void __launch_bounds__(256) k_moe1(const bf16* H, const float* wg, const float* wu, const int* cnt, const int* lists, bf16* HE) {
    __shared__ float As[16 * 129], Ws0[16 * 64], Ws1[16 * 64];
    const int e = blockIdx.z, rt = blockIdx.y, ct = blockIdx.x, n = cnt[e]; if (rt * 128 >= n) return;
    const int tid = threadIdx.x, tx = tid & 15, ty = tid >> 4, base = expert_base(cnt, e);
    const int sl = rt * 128 + (tid >> 1), tok = lists[(size_t)e * T + (sl < n ? sl : 0)];
    float g[8][4], u[8][4];
    ngemm_core<true>(H + (size_t)tok * DM + (tid & 1) * 8, wg + (size_t)e * DM * DE + ct * 64, wu + (size_t)e * DM * DE + ct * 64, DE, DM, g, u, As, Ws0, Ws1);
#pragma unroll
    for (int i = 0; i < 8; ++i) { const int s = rt * 128 + ty + 16 * i; if (s < n) {
#pragma unroll
        for (int j = 0; j < 4; ++j) HE[(size_t)(base + s) * DE + ct * 64 + tx + 16 * j] = (bf16)f2bf(silu_f(g[i][j]) * u[i][j]); } }
}
__global__ void __launch_bounds__(256) k_moe2(const bf16* HE, const float* wd, const int* cnt, bf16* YP) {
    __shared__ float As[16 * 129], Ws0[16 * 64];
    const int e = blockIdx.z, rt = blockIdx.y, ct = blockIdx.x, n = cnt[e]; if (rt * 128 >= n) return;
    const int tid = threadIdx.x, tx = tid & 15, ty = tid >> 4, base = expert_base(cnt, e);
    const int sl = rt * 128 + (tid >> 1);
    float acc[8][4], dummy[8][4];
    ngemm_core<false>(HE + (size_t)(base + (sl < n ? sl : 0)) * DE + (tid & 1) * 8, wd + (size_t)e * DE * DM + ct * 64, nullptr, DM, DE, acc, dummy, As, Ws0, nullptr);
#pragma unroll
    for (int i = 0; i < 8; ++i) { const int s = rt * 128 + ty + 16 * i; if (s < n) {
#pragma unroll
        for (int j = 0; j < 4; ++j) YP[(size_t)(base + s) * DM + ct * 64 + tx + 16 * j] = (bf16)f2bf(acc[i][j]); } }
}

__global__ void __launch_bounds__(256) k_post_ffn(const bf16* X1, const bf16* YP, const float* modl, const float* lng, const float* lnb, const int* tok_e, const float* tok_g, const int* tok_slot, const int* cnt,
                                                  float* out, const float* modn, bf16* H) {
    const int row = blockIdx.x * 4 + (threadIdx.x >> 6), lane = threadIdx.x & 63, b = row / SEQ;
    const int e0 = tok_e[2 * row], e1 = tok_e[2 * row + 1]; const float w0 = tok_g[2 * row], w1 = tok_g[2 * row + 1];
    const size_t r0 = (size_t)expert_base(cnt, e0) + tok_slot[2 * row], r1 = (size_t)expert_base(cnt, e1) + tok_slot[2 * row + 1];
    const u32x2* xr = (const u32x2*)(X1 + (size_t)row * DM) + lane; const u32x2* y0 = (const u32x2*)(YP + r0 * DM) + lane; const u32x2* y1 = (const u32x2*)(YP + r1 * DM) + lane;
    const f32x4* g2 = (const f32x4*)(modl + (size_t)b * MODW + 5 * DM) + lane;
    f32x4 v[4]; float s = 0.f;
#pragma unroll
    for (int j = 0; j < 4; ++j) { const u32x2 x = xr[64 * j], a = y0[64 * j], c = y1[64 * j]; const f32x4 g = g2[64 * j];
        f32x4 xv, av, cv; xv.x = __uint_as_float(x.x << 16); xv.y = __uint_as_float(x.x & 0xffff0000u); xv.z = __uint_as_float(x.y << 16); xv.w = __uint_as_float(x.y & 0xffff0000u);
        av.x = __uint_as_float(a.x << 16); av.y = __uint_as_float(a.x & 0xffff0000u); av.z = __uint_as_float(a.y << 16); av.w = __uint_as_float(a.y & 0xffff0000u);
        cv.x = __uint_as_float(c.x << 16); cv.y = __uint_as_float(c.x & 0xffff0000u); cv.z = __uint_as_float(c.y << 16); cv.w = __uint_as_float(c.y & 0xffff0000u);
        v[j] = xv * ALPHA + g * (av * w0 + cv * w1); s += (v[j].x + v[j].y) + (v[j].z + v[j].w); }
    float mean = wave_sum(s) * (1.f / DM), s2 = 0.f;
#pragma unroll
    for (int j = 0; j < 4; ++j) { v[j] = v[j] - mean; s2 += (v[j].x * v[j].x + v[j].y * v[j].y) + (v[j].z * v[j].z + v[j].w * v[j].w); }
    float rstd = 1.f / sqrtf(wave_sum(s2) * (1.f / DM) + LN_EPS);
    f32x4* o = (f32x4*)(out + (size_t)row * DM) + lane; s = 0.f;
#pragma unroll
    for (int j = 0; j < 4; ++j) { const f32x4 g = ((const f32x4*)lng)[lane + 64 * j], bb = ((const f32x4*)lnb)[lane + 64 * j]; v[j] = v[j] * rstd * g + bb; o[64 * j] = v[j]; s += (v[j].x + v[j].y) + (v[j].z + v[j].w); }
    if (modn) {
        mean = wave_sum(s) * (1.f / DM); s2 = 0.f;
#pragma unroll
        for (int j = 0; j < 4; ++j) { v[j] = v[j] - mean; s2 += (v[j].x * v[j].x + v[j].y * v[j].y) + (v[j].z * v[j].z + v[j].w * v[j].w); }
        rstd = 1.f / sqrtf(wave_sum(s2) * (1.f / DM) + LN_EPS);
        const f32x4* sh = (const f32x4*)(modn + (size_t)b * MODW) + lane; const f32x4* sc = sh + 256; u32x2* ho = (u32x2*)(H + (size_t)row * DM) + lane;
#pragma unroll
        for (int j = 0; j < 4; ++j) { const f32x4 a = sh[64 * j], m = sc[64 * j]; const f32x4 r = v[j] * rstd * (m + 1.f) + a; u32x2 w; w.x = pk2(r.x, r.y); w.y = pk2(r.z, r.w); ho[64 * j] = w; }
    }
}

#include <hip/hip_bf16.h>
#ifndef RET_FAST
#define RET_FAST 1
#endif
#ifndef ATTN128
#define ATTN128 1
#endif
#ifndef ATTN_THRL
#define ATTN_THRL 8
#endif
#define LAS __attribute__((address_space(3)))
#define GAS __attribute__((address_space(1)))
typedef short bf16x8 __attribute__((ext_vector_type(8)));
typedef GAS unsigned gu32;
#define RLX_AGENT __ATOMIC_RELAXED, __HIP_MEMORY_SCOPE_AGENT
#define LDS_WAIT() asm volatile("s_waitcnt lgkmcnt(0)" ::: "memory")
#define VM_WAIT() asm volatile("s_waitcnt vmcnt(0)" ::: "memory")

constexpr size_t WL_IN = 0, WL_OUT = (size_t)INW * DM, WL_GU = WL_OUT + (size_t)DM * DM, WL_D = WL_GU + (size_t)NE * 1024 * DM, WL_STRIDE = WL_D + (size_t)NE * DM * DE;
static_assert(WL_STRIDE * 2 * 2 <= 114 * MiB, "weights fit");

namespace pg8 {
constexpr int BM = 256, BK = 64, HALF = 128, HTB = HALF * BK * 2, STAGE_BYTES = 8 * HTB, NXCD = 8, WGM = 8;
__host__ __device__ __forceinline__ int lds_byte(int r, int c) { const int st = (r >> 4) * 2 + (c >> 5), rr = r & 15, cc = c & 31, ob = rr * 64 + cc * 2; return st * 1024 + (ob ^ (((ob >> 9) & 1) << 5)); }
__host__ __device__ __forceinline__ void stage_rc(int b, int& R, int& C) { const int st = b / 1024, sb = b % 1024, swz = sb ^ (((sb >> 9) & 1) << 5); R = (st >> 1) * 16 + swz / 64; C = (st & 1) * 32 + (swz % 64) / 2; }
__host__ __device__ __forceinline__ int perm32(int rho) { const int n = rho >> 4, i = rho & 15; return 8 * (i >> 2) + 4 * n + (i & 3); }
struct Unit { int pm, pn; };

struct OrderBase {
    int nM, nN, nwg, G, c;
    __device__ __forceinline__ void init(int nM_, int nN_, int G_, int c_) { nM = nM_; nN = nN_; nwg = nM * nN; G = G_; c = c_; }
    __device__ __forceinline__ bool next(int i, Unit& u) const {
        const long L = (long)i * G + c; if (L >= nwg) return false;
        int wgid = (int)L; { const int q = nwg / NXCD, r = nwg % NXCD, xcd = wgid % NXCD, off = wgid / NXCD; wgid = (xcd < r ? xcd * (q + 1) : r * (q + 1) + (xcd - r) * q) + off; }
        const int nig = WGM * nN, gid = wgid / nig, fm = gid * WGM, gsz = (nM - fm) < WGM ? (nM - fm) : WGM;
        u.pm = fm + ((wgid % nig) % gsz); u.pn = (wgid % nig) / gsz; return true;
    }
    __device__ __forceinline__ void a_ready(const Unit&) const {}
    __device__ __forceinline__ void done(const Unit&) const {}
};
struct PlainSched : OrderBase {
    const bf16* Bt; int K;
    __device__ __forceinline__ void setup(const Unit& u, const int (&Rl)[2], const int (&Cb)[2], unsigned (&off)[2][2], const char*& bptr) const {
#pragma unroll
        for (int h = 0; h < 2; ++h)
#pragma unroll
            for (int i = 0; i < 2; ++i) off[h][i] = (unsigned)((u.pm * 256 + h * 128 + Rl[i]) * K * 2 + Cb[i]);
        bptr = (const char*)Bt + (size_t)u.pn * 256 * K * 2;
    }
};
struct MoeSched : OrderBase {
    const bf16* Bt; int K; const LAS int* tab; const int* cnt; const int* lists; bool gather;
    __device__ __forceinline__ void setup(const Unit& u, const int (&Rl)[2], const int (&Cb)[2], unsigned (&off)[2][2], const char*& bptr) const {
        const int te = tab[1 + u.pm], e = te & 255, s0 = (te >> 8) * 256;
        if (gather) { const int n = cnt[e];
#pragma unroll
            for (int h = 0; h < 2; ++h)
#pragma unroll
                for (int i = 0; i < 2; ++i) { const int s = s0 + h * 128 + Rl[i]; const int tok = lists[(size_t)e * T + (s < n ? s : 0)]; off[h][i] = (unsigned)(tok * K * 2 + Cb[i]); }
        } else {
#pragma unroll
            for (int h = 0; h < 2; ++h)
#pragma unroll
                for (int i = 0; i < 2; ++i) off[h][i] = (unsigned)((u.pm * 256 + h * 128 + Rl[i]) * K * 2 + Cb[i]);
        }
        bptr = (const char*)Bt + (size_t)(e * 4 + u.pn) * 256 * K * 2;
    }
};

__device__ __forceinline__ unsigned cvt_pk_bf16(float lo, float hi) { unsigned r; asm volatile("v_cvt_pk_bf16_f32 %0, %1, %2" : "=v"(r) : "v"(lo), "v"(hi)); return r; }
__device__ __forceinline__ float fsilu(float v) { return v * __builtin_amdgcn_rcpf(1.f + __expf(-v)); }

struct EpiInProj {
    static constexpr bool PERM = true, AFTER_DRAIN = false;
    bf16* P; const float* rot; const float* dtab; bf16* dummy;
    __device__ __forceinline__ void operator()(const f32x4 (&acc)[2][2][4][2], const Unit& u, int wr, int wc, int fr, int fq) const {
        const int row0 = u.pm * BM + wr * 64 + fr;
        if (u.pn < 4 && !dummy) {
            const float sc0 = u.pn < 2 ? 0.125f : 1.f; const float* dt = dtab ? dtab + (u.pn >> 1) * 1024 + ((u.pn & 1) * 4 + wc) * 128 : nullptr;
#pragma unroll
            for (int ai = 0; ai < 2; ++ai) {
                f32x4 tt[4][4]; float scv[4];
#pragma unroll
                for (int m = 0; m < 4; ++m) { const int pos = (row0 + ai * HALF + m * 16) & (SEQ - 1); const f32x4* rt = (const f32x4*)(rot + (size_t)(pos * 32 + 8 * fq) * 2);
                    tt[m][0] = rt[0]; tt[m][1] = rt[1]; tt[m][2] = rt[2]; tt[m][3] = rt[3]; scv[m] = dt ? dt[pos & 127] : sc0; }
#pragma unroll
                for (int m = 0; m < 4; ++m) { const int row = row0 + ai * HALF + m * 16; const float sc = scv[m];
                    const f32x4 t0 = tt[m][0], t1 = tt[m][1], t2 = tt[m][2], t3 = tt[m][3];
                    const f32x4 xa = acc[ai][0][m][0], xb = acc[ai][0][m][1], ya = acc[ai][1][m][0], yb = acc[ai][1][m][1];
                    u32x4 w1, w2;
                    w1.x = cvt_pk_bf16((xa[0] * t0.x - ya[0] * t0.y) * sc, (xa[1] * t0.z - ya[1] * t0.w) * sc); w1.y = cvt_pk_bf16((xa[2] * t1.x - ya[2] * t1.y) * sc, (xa[3] * t1.z - ya[3] * t1.w) * sc);
                    w1.z = cvt_pk_bf16((xb[0] * t2.x - yb[0] * t2.y) * sc, (xb[1] * t2.z - yb[1] * t2.w) * sc); w1.w = cvt_pk_bf16((xb[2] * t3.x - yb[2] * t3.y) * sc, (xb[3] * t3.z - yb[3] * t3.w) * sc);
                    w2.x = cvt_pk_bf16((xa[0] * t0.y + ya[0] * t0.x) * sc, (xa[1] * t0.w + ya[1] * t0.z) * sc); w2.y = cvt_pk_bf16((xa[2] * t1.y + ya[2] * t1.x) * sc, (xa[3] * t1.w + ya[3] * t1.z) * sc);
                    w2.z = cvt_pk_bf16((xb[0] * t2.y + yb[0] * t2.x) * sc, (xb[1] * t2.w + yb[1] * t2.z) * sc); w2.w = cvt_pk_bf16((xb[2] * t3.y + yb[2] * t3.x) * sc, (xb[3] * t3.w + yb[3] * t3.z) * sc);
                    bf16* o = P + (size_t)row * INW + u.pn * BM + 64 * wc + 8 * fq;
                    *(u32x4*)o = w1; *(u32x4*)(o + 32) = w2; }
            }
        } else {
            const int region = u.pn >> 1;
#pragma unroll
            for (int ai = 0; ai < 2; ++ai)
#pragma unroll
                for (int m = 0; m < 4; ++m) { bf16* o = (u.pn < 4) ? dummy + (size_t)(row0 + ai * HALF + m * 16) * DM + u.pn * BM + wc * 32 + 8 * fq : P + (size_t)(row0 + ai * HALF + m * 16) * INW + u.pn * BM + wc * 32 + 8 * fq;
#pragma unroll
                    for (int bj = 0; bj < 2; ++bj) { f32x4 v0 = acc[ai][bj][m][0], v1 = acc[ai][bj][m][1];
                        if (region == 3) { v0[0] = fsilu(v0[0]); v0[1] = fsilu(v0[1]); v0[2] = fsilu(v0[2]); v0[3] = fsilu(v0[3]); v1[0] = fsilu(v1[0]); v1[1] = fsilu(v1[1]); v1[2] = fsilu(v1[2]); v1[3] = fsilu(v1[3]); }
                        if (region == 4) { v0 = v0 * C2; v1 = v1 * C2; }
                        u32x4 w; w.x = cvt_pk_bf16(v0[0], v0[1]); w.y = cvt_pk_bf16(v0[2], v0[3]); w.z = cvt_pk_bf16(v1[0], v1[1]); w.w = cvt_pk_bf16(v1[2], v1[3]);
                        *(u32x4*)(o + bj * HALF) = w; } }
        }
    }
};
struct EpiPlain {
    static constexpr bool PERM = true, AFTER_DRAIN = false;
    bf16* O; int ldc;
    __device__ __forceinline__ void operator()(const f32x4 (&acc)[2][2][4][2], const Unit& u, int wr, int wc, int fr, int fq) const {
        const int row0 = u.pm * BM + wr * 64 + fr, col0 = u.pn * BM + wc * 32 + 8 * fq;
#pragma unroll
        for (int ai = 0; ai < 2; ++ai)
#pragma unroll
            for (int m = 0; m < 4; ++m) { bf16* o = O + (size_t)(row0 + ai * HALF + m * 16) * ldc + col0;
#pragma unroll
                for (int bj = 0; bj < 2; ++bj) { const f32x4 v0 = acc[ai][bj][m][0], v1 = acc[ai][bj][m][1];
                    u32x4 w; w.x = cvt_pk_bf16(v0[0], v0[1]); w.y = cvt_pk_bf16(v0[2], v0[3]); w.z = cvt_pk_bf16(v1[0], v1[1]); w.w = cvt_pk_bf16(v1[2], v1[3]);
                    *(u32x4*)(o + bj * HALF) = w; } }
    }
};
struct EpiGateUp {
    static constexpr bool PERM = true, AFTER_DRAIN = false;
    bf16* HE;
    __device__ __forceinline__ void operator()(const f32x4 (&acc)[2][2][4][2], const Unit& u, int wr, int wc, int fr, int fq) const {
        const int row0 = u.pm * BM + wr * 64 + fr, col0 = u.pn * 128 + wc * 32 + 8 * fq;
#pragma unroll
        for (int ai = 0; ai < 2; ++ai)
#pragma unroll
            for (int m = 0; m < 4; ++m) { const f32x4 g0 = acc[ai][0][m][0], g1 = acc[ai][0][m][1], u0 = acc[ai][1][m][0], u1 = acc[ai][1][m][1];
                u32x4 w; w.x = cvt_pk_bf16(fsilu(g0[0]) * u0[0], fsilu(g0[1]) * u0[1]); w.y = cvt_pk_bf16(fsilu(g0[2]) * u0[2], fsilu(g0[3]) * u0[3]);
                w.z = cvt_pk_bf16(fsilu(g1[0]) * u1[0], fsilu(g1[1]) * u1[1]); w.w = cvt_pk_bf16(fsilu(g1[2]) * u1[2], fsilu(g1[3]) * u1[3]);
                *(u32x4*)(HE + (size_t)(row0 + ai * HALF + m * 16) * DE + col0) = w; }
    }
};

template <class Epi, class Sched, bool ALIGN_EPI>
__device__ __forceinline__ void gemm_phase(LAS unsigned char* lds, const char* gA, int K, const Sched& S, const Epi& E) {
    int tid_ = threadIdx.x; asm volatile("" : "+v"(tid_));
    const int tid = tid_, wid = __builtin_amdgcn_readfirstlane(tid >> 6), lane = tid & 63, wr = wid >> 2, wc = wid & 3, fr = lane & 15, fq = lane >> 4;
    const int nt = K / BK;
    unsigned voffB[2]; int Rl[2], Cb[2];
#pragma unroll
    for (int i = 0; i < 2; ++i) { int R, C; stage_rc(tid * 16 + i * 8192, R, C); const int Rb = Epi::PERM ? ((R & ~31) + perm32(R & 31)) : R;
        voffB[i] = (unsigned)(Rb * K + C) * 2u; Rl[i] = R; Cb[i] = C * 2; }
    const size_t kstep = (size_t)(BK * 2), hstep = (size_t)HALF * K * 2;
    const unsigned ldsw = (unsigned)wid * 1024u;
    const int aoff = lds_byte(wr * 64 + fr, fq * 8), boff = lds_byte(wc * 32 + fr, fq * 8);
#define PG8_SA(b, h) (((b) * 2 + (h)) * HTB)
#define PG8_SB(b, h) ((4 + (b) * 2 + (h)) * HTB)
#define PG8_STAGE(bufoff, gbase, voff) do { _Pragma("unroll") for (int _i = 0; _i < 2; ++_i) \
        __builtin_amdgcn_global_load_lds((const unsigned*)((const char*)(gbase) + (voff)[_i]), (LAS unsigned*)(lds + (bufoff) + ldsw + _i * 8192), 16, 0, 0); } while (0)
#define PG8_LDA(dst, b, h) do { _Pragma("unroll") for (int m = 0; m < 4; ++m) _Pragma("unroll") for (int k = 0; k < 2; ++k) dst[m][k] = *(const LAS bf16x8*)(lds + PG8_SA(b, h) + aoff + m * 2048 + k * 1024); } while (0)
#define PG8_LDB(dst, b, h) do { _Pragma("unroll") for (int n = 0; n < 2; ++n) _Pragma("unroll") for (int k = 0; k < 2; ++k) dst[n][k] = *(const LAS bf16x8*)(lds + PG8_SB(b, h) + boff + n * 2048 + k * 1024); } while (0)
#define PG8_MMA(ai, bj, At, Bt) do { __builtin_amdgcn_s_setprio(1); _Pragma("unroll") for (int m = 0; m < 4; ++m) _Pragma("unroll") for (int n = 0; n < 2; ++n) _Pragma("unroll") for (int k = 0; k < 2; ++k) \
        acc[ai][bj][m][n] = __builtin_amdgcn_mfma_f32_16x16x32_bf16(Bt[n][k], At[m][k], acc[ai][bj][m][n], 0, 0, 0); __builtin_amdgcn_s_setprio(0); } while (0)
#define PG8_WAIT_V(n) asm volatile("s_waitcnt vmcnt(" #n ")" ::: "memory")
#define PG8_WAIT_L(n) asm volatile("s_waitcnt lgkmcnt(" #n ")" ::: "memory")
#define PG8_BAR __builtin_amdgcn_s_barrier()
#define PG8_SCHED __builtin_amdgcn_sched_barrier(0)
    Unit cur, nxt; int ui = 0;
    if (!S.next(0, cur)) return;
    f32x4 acc[2][2][4][2];
#pragma unroll
    for (int a = 0; a < 2; ++a)
#pragma unroll
        for (int b = 0; b < 2; ++b)
#pragma unroll
            for (int m = 0; m < 4; ++m)
#pragma unroll
                for (int n = 0; n < 2; ++n) acc[a][b][m][n] = (f32x4){0.f, 0.f, 0.f, 0.f};
    bf16x8 At[4][2], B0[2][2], B1[2][2];
    unsigned oc[2][2], on[2][2]; const char* cB; const char* nB;
    S.setup(cur, Rl, Cb, oc, cB);
    S.a_ready(cur);
    PG8_STAGE(PG8_SB(0, 0), cB, voffB); PG8_STAGE(PG8_SB(0, 1), cB + hstep, voffB); PG8_STAGE(PG8_SA(0, 0), gA, oc[0]); PG8_STAGE(PG8_SA(0, 1), gA, oc[1]);
    if (wr == 1) PG8_BAR;
    PG8_WAIT_V(2); PG8_BAR;
    PG8_STAGE(PG8_SB(1, 0), cB + kstep, voffB); PG8_STAGE(PG8_SA(1, 0), gA + kstep, oc[0]); PG8_STAGE(PG8_SB(1, 1), cB + hstep + kstep, voffB);
    PG8_WAIT_V(6); PG8_BAR;
    for (;;) {
        const bool has_next = S.next(ui + 1, nxt);
        if (has_next) S.setup(nxt, Rl, Cb, on, nB);
        else { nB = cB;
#pragma unroll
            for (int h = 0; h < 2; ++h)
#pragma unroll
                for (int i = 0; i < 2; ++i) on[h][i] = oc[h][i]; }
        for (int t = 0; t < nt; t += 2) {
            const bool last = (t == nt - 2);
            const char* a1 = gA + (size_t)(t + 1) * kstep;
            const char* a2 = last ? gA : gA + (size_t)(t + 2) * kstep; const char* b2 = last ? nB : cB + (size_t)(t + 2) * kstep;
            const char* a3 = a2 + kstep; const char* b3 = b2 + kstep;
            unsigned o2[2][2];
#pragma unroll
            for (int h = 0; h < 2; ++h)
#pragma unroll
                for (int i = 0; i < 2; ++i) o2[h][i] = last ? on[h][i] : oc[h][i];
            if (last && has_next) S.a_ready(nxt);
            PG8_LDB(B0, 0, 0); PG8_LDB(B1, 0, 1); PG8_SCHED; PG8_LDA(At, 0, 0); PG8_STAGE(PG8_SA(1, 1), a1, oc[1]);
            PG8_WAIT_V(8); PG8_WAIT_L(0); PG8_BAR; PG8_MMA(0, 0, At, B0); PG8_MMA(0, 1, At, B1); PG8_BAR; PG8_SCHED;
            PG8_LDA(At, 0, 1); PG8_STAGE(PG8_SB(0, 0), b2, voffB); PG8_STAGE(PG8_SB(0, 1), b2 + hstep, voffB); PG8_STAGE(PG8_SA(0, 0), a2, o2[0]);
            PG8_WAIT_V(8); PG8_WAIT_L(0); PG8_BAR; PG8_MMA(1, 0, At, B0); PG8_MMA(1, 1, At, B1); PG8_BAR; PG8_SCHED;
            PG8_LDB(B0, 1, 0); PG8_LDB(B1, 1, 1); PG8_SCHED; PG8_LDA(At, 1, 0); PG8_STAGE(PG8_SA(0, 1), a2, o2[1]);
            PG8_WAIT_V(8); PG8_WAIT_L(0); PG8_BAR; PG8_MMA(0, 0, At, B0); PG8_MMA(0, 1, At, B1); PG8_BAR; PG8_SCHED;
            PG8_LDA(At, 1, 1); PG8_STAGE(PG8_SB(1, 0), b3, voffB); PG8_STAGE(PG8_SB(1, 1), b3 + hstep, voffB); PG8_STAGE(PG8_SA(1, 0), a3, o2[0]);
            PG8_WAIT_V(8); PG8_WAIT_L(0); PG8_BAR; PG8_MMA(1, 0, At, B0); PG8_MMA(1, 1, At, B1); PG8_BAR; PG8_SCHED;
        }
        if constexpr (ALIGN_EPI) { if (wr == 0) PG8_BAR; }
        E(acc, cur, wr, wc, fr, fq); S.done(cur);
        if (!has_next) break;
#pragma unroll
        for (int a = 0; a < 2; ++a)
#pragma unroll
            for (int b = 0; b < 2; ++b)
#pragma unroll
                for (int m = 0; m < 4; ++m)
#pragma unroll
                    for (int n = 0; n < 2; ++n) acc[a][b][m][n] = (f32x4){0.f, 0.f, 0.f, 0.f};
        cur = nxt; cB = nB; ++ui;
#pragma unroll
        for (int h = 0; h < 2; ++h)
#pragma unroll
            for (int i = 0; i < 2; ++i) oc[h][i] = on[h][i];
        if constexpr (ALIGN_EPI) { if (wr == 1) PG8_BAR; }
    }
    PG8_WAIT_V(0);
    if constexpr (!ALIGN_EPI) { if (wr == 0) PG8_BAR; }
    PG8_BAR;
#undef PG8_SA
#undef PG8_SB
#undef PG8_STAGE
#undef PG8_LDA
#undef PG8_LDB
#undef PG8_MMA
#undef PG8_WAIT_V
#undef PG8_WAIT_L
#undef PG8_BAR
#undef PG8_SCHED
}
}
#ifndef RS1
#define RS1 13
#define RS2 22
#define RS3 28
#endif
namespace ret {
constexpr int QB0 = 0, KB0 = 32768, VB0 = 65536, ST0 = 98304;
constexpr int RET_LDS_BYTES = ST0 + 2 * 8192;
__device__ __forceinline__ int toff(int row, int c16) { return row * 128 + ((c16 ^ (row & 7)) << 4); }
typedef short v4i16_t __attribute__((ext_vector_type(4)));
__device__ __forceinline__ v4i16_t trd(const LAS unsigned char* p) { return __builtin_amdgcn_ds_read_tr16_b64_v4i16((LAS v4i16_t*)p); }
__device__ __forceinline__ bf16x8 cat8(v4i16_t a, v4i16_t b) { return (bf16x8){a[0], a[1], a[2], a[3], b[0], b[1], b[2], b[3]}; }

#define RET_KEEP(x) asm volatile("" :: "v"(x))
__device__ __forceinline__ float xsum_16_32(float v) {
    { auto rr = __builtin_amdgcn_permlane16_swap(__float_as_uint(v), __float_as_uint(v), false, false); v = __uint_as_float(rr[0]) + __uint_as_float(rr[1]); }
    { auto rr = __builtin_amdgcn_permlane32_swap(__float_as_uint(v), __float_as_uint(v), false, false); v = __uint_as_float(rr[0]) + __uint_as_float(rr[1]); }
    return v;
}
__device__ __forceinline__ void ret_unit(int b, int h, int seg, const bf16* PROJ, bf16* CAT, float gC, LAS unsigned char* lds) {
    int tid_ = threadIdx.x; asm volatile("" : "+v"(tid_));
    const int tid = tid_, lane = tid & 63, w = __builtin_amdgcn_readfirstlane(tid >> 6), g = lane >> 4, c15 = lane & 15;
    const int blk = w < 4 ? w : 11 - w;
    const bf16* base = PROJ + (size_t)b * SEQ * INW;
    const int nfirst = seg == 0 ? 0 : seg == 1 ? RS1 : seg == 2 ? RS2 : RS3, nend = seg == 0 ? RS1 : seg == 1 ? RS2 : seg == 2 ? RS3 : 32;
    const int dr = lane >> 3, dc = (lane & 7) ^ dr;
#define RET_DMA(tileoff, colbase, m) do { _Pragma("unroll") for (int _p = 0; _p < 2; ++_p) { const int pc = w + 8 * _p; \
        __builtin_amdgcn_global_load_lds((const unsigned*)(base + (size_t)((m) * 128 + 8 * pc + dr) * INW + (colbase) + h * 64 + dc * 8), (LAS unsigned*)(lds + (tileoff) + pc * 1024), 16, 0, 0); } } while (0)
    f32x4 sacc[2]; sacc[0] = (f32x4){0.f, 0.f, 0.f, 0.f}; sacc[1] = (f32x4){0.f, 0.f, 0.f, 0.f};
    const int et_s = w >> 1, dt0 = 2 * (w & 1);
    if (nfirst > 0) {
        bf16x8 kprev = (bf16x8){0, 0, 0, 0, 0, 0, 0, 0}, vprev2 = kprev;
        RET_DMA(0, C_RK, 0); RET_DMA(16384, C_RV, 0);
        if (nfirst > 1) { RET_DMA(32768, C_RK, 1); RET_DMA(32768 + 16384, C_RV, 1); }
#pragma unroll 1
        for (int m = 0; m < nfirst; ++m) {
            if (m + 1 < nfirst) asm volatile("s_waitcnt vmcnt(4) lgkmcnt(0)" ::: "memory"); else asm volatile("s_waitcnt vmcnt(0) lgkmcnt(0)" ::: "memory");
            __builtin_amdgcn_s_barrier(); asm volatile("" ::: "memory");
            if (m + 2 < nfirst) { const int s2 = ((m + 2) % 3) * 32768; RET_DMA(s2, C_RK, m + 2); RET_DMA(s2 + 16384, C_RV, m + 2); }
            const LAS unsigned char* Kt = lds + (m % 3) * 32768; const LAS unsigned char* Vt = Kt + 16384;
            sacc[0] = sacc[0] * gC; sacc[1] = sacc[1] * gC;
#pragma unroll
            for (int ks = 0; ks < 4; ++ks) {
                const int q = c15 >> 2, p = c15 & 3, r0 = 32 * ks + 8 * g + q;
                const bf16x8 vf = cat8(trd(Vt + toff(r0, 2 * et_s + (p >> 1)) + (p & 1) * 8), trd(Vt + toff(r0 + 4, 2 * et_s + (p >> 1)) + (p & 1) * 8));
#pragma unroll
                for (int dd = 0; dd < 2; ++dd) { const int c16 = 2 * (dt0 + dd) + (p >> 1);
                    const bf16x8 kf = cat8(trd(Kt + toff(r0, c16) + (p & 1) * 8), trd(Kt + toff(r0 + 4, c16) + (p & 1) * 8));
                    sacc[dd] = __builtin_amdgcn_mfma_f32_16x16x32_bf16(vf, kf, sacc[dd], 0, 0, 0); RET_KEEP(kprev); kprev = kf; }
                RET_KEEP(vprev2); vprev2 = vf;
            }
        }
        RET_KEEP(kprev); RET_KEEP(vprev2);
        asm volatile("s_waitcnt lgkmcnt(0)" ::: "memory"); __builtin_amdgcn_s_barrier(); asm volatile("" ::: "memory");
    }
    { LAS unsigned char* STi = lds + ST0 + (nfirst & 1) * 8192;
#pragma unroll
      for (int dd = 0; dd < 2; ++dd)
#pragma unroll
          for (int rr = 0; rr < 4; ++rr) { const int e = 16 * et_s + 4 * g + rr, d = 16 * (dt0 + dd) + c15;
              *(LAS unsigned short*)(STi + toff(e, d >> 3) + (d & 7) * 2) = (unsigned short)f2bf(sacc[dd][rr]); } }
    RET_DMA(KB0 + (nfirst & 1) * 16384, C_RK, nfirst); RET_DMA(VB0 + (nfirst & 1) * 16384, C_RV, nfirst); RET_DMA(QB0 + (nfirst & 1) * 16384, C_RQ, nfirst);
    __syncthreads();
#define RET_STATE_UPDATE() do { if (m + 1 < nend) { bf16x8 kfp = (bf16x8){0, 0, 0, 0, 0, 0, 0, 0}, vfp = kfp; sacc[0] = sacc[0] * gC; sacc[1] = sacc[1] * gC; _Pragma("unroll") for (int ks = 0; ks < 4; ++ks) { const int q = c15 >> 2, p = c15 & 3, r0 = 32 * ks + 8 * g + q; const bf16x8 vf = cat8(trd(Vt + toff(r0, 2 * et_s + (p >> 1)) + (p & 1) * 8), trd(Vt + toff(r0 + 4, 2 * et_s + (p >> 1)) + (p & 1) * 8)); _Pragma("unroll") for (int dd = 0; dd < 2; ++dd) { const int c16 = 2 * (dt0 + dd) + (p >> 1); const bf16x8 kf = cat8(trd(Kt + toff(r0, c16) + (p & 1) * 8), trd(Kt + toff(r0 + 4, c16) + (p & 1) * 8)); sacc[dd] = __builtin_amdgcn_mfma_f32_16x16x32_bf16(vf, kf, sacc[dd], 0, 0, 0); if (dd == 1) { RET_KEEP(kfp); } kfp = kf; } RET_KEEP(vfp); vfp = vf; } _Pragma("unroll") for (int dd = 0; dd < 2; ++dd) _Pragma("unroll") for (int r = 0; r < 4; ++r) { const int e = 16 * et_s + 4 * g + r, d = 16 * (dt0 + dd) + c15; *(LAS unsigned short*)(STn + toff(e, d >> 3) + (d & 7) * 2) = (unsigned short)f2bf(sacc[dd][r]); } RET_KEEP(kfp); RET_KEEP(vfp); } } while (0)
#pragma unroll 1
    for (int m = nfirst; m < nend; ++m) {
        const int cur = m & 1, nx = cur ^ 1; const bool full = true;
        if (m + 1 < nend) { RET_DMA(KB0 + nx * 16384, C_RK, m + 1); RET_DMA(VB0 + nx * 16384, C_RV, m + 1); RET_DMA(QB0 + nx * 16384, C_RQ, m + 1); }
        const LAS unsigned char* Qt = lds + QB0 + cur * 16384; const LAS unsigned char* Kt = lds + KB0 + cur * 16384; const LAS unsigned char* Vt = lds + VB0 + cur * 16384;
        const LAS unsigned char* STc = lds + ST0 + cur * 8192; LAS unsigned char* STn = lds + ST0 + nx * 8192;
        if (full) {
            const size_t row = (size_t)b * SEQ + m * 128 + 16 * blk + c15;
            u32x2 gg[4];
#pragma unroll
            for (int et = 0; et < 4; ++et) gg[et] = *(const GAS u32x2*)(PROJ + row * INW + C_RG + h * 64 + 16 * et + 4 * g);
            bf16x8 qf[2];
#pragma unroll
            for (int ks = 0; ks < 2; ++ks) qf[ks] = *(const LAS bf16x8*)(Qt + toff(16 * blk + c15, 4 * ks + g));
            bf16x8 pf[4];
#pragma unroll
            for (int ks = 0; ks < 4; ++ks) {
                f32x4 s0 = (f32x4){0.f, 0.f, 0.f, 0.f}, s1 = (f32x4){0.f, 0.f, 0.f, 0.f};
                bf16x8 ka[2], kb[2]; ka[0] = ka[1] = kb[0] = kb[1] = (bf16x8){0, 0, 0, 0, 0, 0, 0, 0};
                if (2 * ks <= blk) {
#pragma unroll
                    for (int kk = 0; kk < 2; ++kk) { ka[kk] = *(const LAS bf16x8*)(Kt + toff(32 * ks + c15, 4 * kk + g)); s0 = __builtin_amdgcn_mfma_f32_16x16x32_bf16(ka[kk], qf[kk], s0, 0, 0, 0); }
                    if (2 * ks == blk) {
#pragma unroll
                        for (int r = 0; r < 4; ++r) if (4 * g + r > c15) s0[r] = 0.f; }
                }
                if (2 * ks + 1 <= blk) {
#pragma unroll
                    for (int kk = 0; kk < 2; ++kk) { kb[kk] = *(const LAS bf16x8*)(Kt + toff(32 * ks + 16 + c15, 4 * kk + g)); s1 = __builtin_amdgcn_mfma_f32_16x16x32_bf16(kb[kk], qf[kk], s1, 0, 0, 0); }
                    if (2 * ks + 1 == blk) {
#pragma unroll
                        for (int r = 0; r < 4; ++r) if (4 * g + r > c15) s1[r] = 0.f; }
                }
                u32x4 pk; pk.x = pk2(s0[0], s0[1]); pk.y = pk2(s0[2], s0[3]); pk.z = pk2(s1[0], s1[1]); pk.w = pk2(s1[2], s1[3]);
                pf[ks] = __builtin_bit_cast(bf16x8, pk);
                RET_KEEP(ka[0]); RET_KEEP(ka[1]); RET_KEEP(kb[0]); RET_KEEP(kb[1]);
            }
            f32x4 o[4];
            bf16x8 vprev[4]; vprev[0] = vprev[1] = vprev[2] = vprev[3] = (bf16x8){0, 0, 0, 0, 0, 0, 0, 0};
#pragma unroll
            for (int et = 0; et < 4; ++et) {
                f32x4 a = (f32x4){0.f, 0.f, 0.f, 0.f};
                bf16x8 sf[2], vcur[4]; vcur[0] = vcur[1] = vcur[2] = vcur[3] = (bf16x8){0, 0, 0, 0, 0, 0, 0, 0};
#pragma unroll
                for (int kk = 0; kk < 2; ++kk) { sf[kk] = *(const LAS bf16x8*)(STc + toff(16 * et + c15, 4 * kk + g)); a = __builtin_amdgcn_mfma_f32_16x16x32_bf16(sf[kk], qf[kk], a, 0, 0, 0); }
                a = a * gC;
#pragma unroll
                for (int ks = 0; ks < 4; ++ks) if (2 * ks <= blk) {
                    const int q = c15 >> 2, p = c15 & 3, r0 = 32 * ks + 4 * g + q, c16 = 2 * et + (p >> 1);
                    const v4i16_t v0 = trd(Vt + toff(r0, c16) + (p & 1) * 8), v1 = trd(Vt + toff(r0 + 16, c16) + (p & 1) * 8);
                    vcur[ks] = cat8(v0, v1);
                    a = __builtin_amdgcn_mfma_f32_16x16x32_bf16(vcur[ks], pf[ks], a, 0, 0, 0);
                }
                o[et] = a;
                RET_KEEP(sf[0]); RET_KEEP(sf[1]);
#pragma unroll
                for (int ks = 0; ks < 4; ++ks) { RET_KEEP(vprev[ks]); vprev[ks] = vcur[ks]; }
            }
            RET_STATE_UPDATE();
#pragma unroll
            for (int ks = 0; ks < 4; ++ks) { RET_KEEP(vprev[ks]); RET_KEEP(pf[ks]); }
            RET_KEEP(qf[0]); RET_KEEP(qf[1]);
            float s = 0.f;
#pragma unroll
            for (int et = 0; et < 4; ++et) s += (o[et][0] + o[et][1]) + (o[et][2] + o[et][3]);
            s = xsum_16_32(s);
            const float mean = s * (1.f / 64.f); float q2 = 0.f;
#pragma unroll
            for (int et = 0; et < 4; ++et) { o[et] = o[et] - mean; q2 += (o[et][0] * o[et][0] + o[et][1] * o[et][1]) + (o[et][2] * o[et][2] + o[et][3] * o[et][3]); }
            q2 = xsum_16_32(q2);
            const float rstd = 1.f / sqrtf(q2 * (1.f / 64.f) + LN_EPS);
#pragma unroll
            for (int et = 0; et < 4; ++et) {
                const float g0 = __uint_as_float(gg[et].x << 16), g1 = __uint_as_float(gg[et].x & 0xffff0000u), g2 = __uint_as_float(gg[et].y << 16), g3 = __uint_as_float(gg[et].y & 0xffff0000u);
                u32x2 wv; wv.x = pk2(o[et][0] * rstd * g0, o[et][1] * rstd * g1); wv.y = pk2(o[et][2] * rstd * g2, o[et][3] * rstd * g3);
                *(GAS u32x2*)(CAT + row * DM + h * 64 + 16 * et + 4 * g) = wv; asm volatile("s_nop 1" :: "v"(wv.x), "v"(wv.y) : "memory"); }
        }
        else { RET_STATE_UPDATE(); }
        __syncthreads();
    }
#undef RET_DMA
#undef RET_STATE_UPDATE
#undef RET_KEEP
}
}
constexpr int MK_TAB_OFF = 131072 + 512, MK_TOKS_OFF = 131072 + 4096, MK_CW_MOEC = 70000;
namespace pg8 {
struct MUnit : Unit { int kind; };
template <int MODE>
struct MoeMk {
    static constexpr int G = 256;
    int nMt, n1, c, l; const LAS unsigned char* ldsb; const bf16* Wgu; const bf16* Wd; gu32* ctl;
    __device__ __forceinline__ const LAS int* tab() const { return (const LAS int*)(ldsb + MK_TAB_OFF); }
    __device__ __forceinline__ const LAS int* toks() const { return (const LAS int*)(ldsb + MK_TOKS_OFF); }
    __device__ __forceinline__ unsigned* ready() const { return (unsigned*)(ctl + MK_CW_MOEC + l * 288 * 64); }
    __device__ __forceinline__ bool next(int i, MUnit& u) const {
        long L = (long)i * G + c; int kind = MODE;
        if (MODE == 2) {
            const int q = n1 / G, rem = n1 % G, q1 = q + (c < rem ? 1 : 0);
            if (i < q1) kind = 0;
            else { kind = 1; const int j = i - q1, light = G - rem, F = (n1 - light) / G, part = (n1 - light) % G; long k;
                if (rem == 0) k = (long)j * G + c;
                else if (c >= rem) { if (j == 0) k = c - rem; else if (j <= F) k = light + (long)(j - 1) * G + c; else if (j == F + 1 && (c - rem) < part) k = light + (long)F * G + (c - rem); else return false; }
                else { if (j < F) k = light + (long)j * G + c; else return false; }
                if (k >= n1) return false; L = k; }
        } else if (L >= n1) return false;
        const int nN = 4, nwg = n1; int wgid = (int)L; { const int q = nwg / NXCD, r = nwg % NXCD, xcd = wgid % NXCD, off = wgid / NXCD; wgid = (xcd < r ? xcd * (q + 1) : r * (q + 1) + (xcd - r) * q) + off; }
        const int nig = WGM * nN, gid = wgid / nig, fm = gid * WGM, gsz = (nMt - fm) < WGM ? (nMt - fm) : WGM;
        u.pm = fm + ((wgid % nig) % gsz); u.pn = (wgid % nig) / gsz; u.kind = kind; return true;
    }
    __device__ __forceinline__ int kdim(const MUnit& u) const { return u.kind ? DE : DM; }
    __device__ __forceinline__ void setup(const MUnit& u, const int (&Rl)[2], const int (&Cb)[2], unsigned (&off)[2][2], const char*& bptr, int ui) const {
        const int e = tab()[1 + u.pm] & 255;
        if (u.kind == 0) {
#pragma unroll
            for (int h = 0; h < 2; ++h)
#pragma unroll
                for (int i = 0; i < 2; ++i) off[h][i] = (unsigned)WS_S1 + (unsigned)(toks()[ui * 256 + h * 128 + Rl[i]] * DM * 2 + Cb[i]);
            bptr = (const char*)Wgu + (size_t)(e * 4 + u.pn) * 256 * DM * 2;
        } else {
#pragma unroll
            for (int h = 0; h < 2; ++h)
#pragma unroll
                for (int i = 0; i < 2; ++i) off[h][i] = (unsigned)WS_HE + (unsigned)((u.pm * 256 + h * 128 + Rl[i]) * DE * 2 + Cb[i]);
            bptr = (const char*)Wd + (size_t)(e * 4 + u.pn) * 256 * DE * 2;
        }
    }
    __device__ __forceinline__ void a_ready(const MUnit& u) const {
        if (MODE != 2 || u.kind == 0) return;
        if (threadIdx.x < 64) {
            unsigned* rd = ready() + 64 * u.pm; unsigned* tmo = (unsigned*)ctl;
            const unsigned long long t0 = __builtin_amdgcn_s_memrealtime(); unsigned polls = 0;
            while ((unsigned)__builtin_amdgcn_readfirstlane(__hip_atomic_load(rd, __ATOMIC_RELAXED, __HIP_MEMORY_SCOPE_AGENT)) < 32u) {
                if ((++polls & 255u) == 0u && __builtin_amdgcn_readfirstlane(__hip_atomic_load(tmo, __ATOMIC_RELAXED, __HIP_MEMORY_SCOPE_AGENT)) != 0u) break;
                if (__builtin_amdgcn_s_memrealtime() - t0 > 2000000ull) { if (threadIdx.x == 0) __hip_atomic_store(tmo, 1u, __ATOMIC_RELAXED, __HIP_MEMORY_SCOPE_AGENT); break; }
                __builtin_amdgcn_s_sleep(2); }
#if defined(MOE_ACQ) && MOE_ACQ
            __builtin_amdgcn_fence(__ATOMIC_ACQUIRE, "agent");
#endif
            asm volatile("s_waitcnt vmcnt(0)" ::: "memory");
        }
        asm volatile("" ::: "memory"); __builtin_amdgcn_s_barrier(); asm volatile("" ::: "memory");
    }
    __device__ __forceinline__ void done(const MUnit& u) const {
        if (MODE != 2 || u.kind != 0) return;
        asm volatile("s_waitcnt vmcnt(0)" ::: "memory");
        if ((threadIdx.x & 63) == 0) __hip_atomic_fetch_add(ready() + 64 * u.pm, 1u, __ATOMIC_RELAXED, __HIP_MEMORY_SCOPE_AGENT);
    }
};
struct EpiGateUpWT {
    static constexpr bool PERM = true;
    bf16* HE;
    __device__ __forceinline__ void operator()(const f32x4 (&acc)[2][2][4][2], const Unit& u, int wr, int wc, int fr, int fq) const {
        const __amdgpu_buffer_rsrc_t rs = __builtin_amdgcn_make_buffer_rsrc((void*)HE, 0, PAIR_ROWS * DE * 2, 0x00020000);
        const int row0 = u.pm * BM + wr * 64 + fr, col0 = u.pn * 128 + wc * 32 + 8 * fq;
#pragma unroll
        for (int ai = 0; ai < 2; ++ai)
#pragma unroll
            for (int m = 0; m < 4; ++m) { const f32x4 g0 = acc[ai][0][m][0], g1 = acc[ai][0][m][1], u0 = acc[ai][1][m][0], u1 = acc[ai][1][m][1];
                u32x4 w; w.x = cvt_pk_bf16(fsilu(g0[0]) * u0[0], fsilu(g0[1]) * u0[1]); w.y = cvt_pk_bf16(fsilu(g0[2]) * u0[2], fsilu(g0[3]) * u0[3]);
                w.z = cvt_pk_bf16(fsilu(g1[0]) * u1[0], fsilu(g1[1]) * u1[1]); w.w = cvt_pk_bf16(fsilu(g1[2]) * u1[2], fsilu(g1[3]) * u1[3]);
                __builtin_amdgcn_raw_buffer_store_b128(w, rs, (int)(((size_t)(row0 + ai * HALF + m * 16) * DE + col0) * 2), 0, 16); }
    }
};

template <class Sched, class Epi0, class Epi1>
__device__ __forceinline__ void gemm_phase_mk(LAS unsigned char* lds, const char* gA, const Sched& S, const Epi0& E0, const Epi1& E1) {
    int tid_ = threadIdx.x; asm volatile("" : "+v"(tid_));
    const int tid = tid_, wid = __builtin_amdgcn_readfirstlane(tid >> 6), lane = tid & 63, wr = wid >> 2, wc = wid & 3, fr = lane & 15, fq = lane >> 4;
    int Rl[2], Cb[2], Rbp[2];
#pragma unroll
    for (int i = 0; i < 2; ++i) { int R, C; stage_rc(tid * 16 + i * 8192, R, C); Rbp[i] = (R & ~31) + perm32(R & 31); Rl[i] = R; Cb[i] = C * 2; }
    const size_t kstep = (size_t)(BK * 2);
    const unsigned ldsw = (unsigned)wid * 1024u;
    const int aoff = lds_byte(wr * 64 + fr, fq * 8), boff = lds_byte(wc * 32 + fr, fq * 8);
#define PG8_SA(b, h) (((b) * 2 + (h)) * HTB)
#define PG8_SB(b, h) ((4 + (b) * 2 + (h)) * HTB)
#define PG8_STAGE(bufoff, gbase, voff) do { _Pragma("unroll") for (int _i = 0; _i < 2; ++_i) \
        __builtin_amdgcn_global_load_lds((const unsigned*)((const char*)(gbase) + (voff)[_i]), (LAS unsigned*)(lds + (bufoff) + ldsw + _i * 8192), 16, 0, 0); } while (0)
#define PG8_LDA(dst, b, h) do { _Pragma("unroll") for (int m = 0; m < 4; ++m) _Pragma("unroll") for (int k = 0; k < 2; ++k) dst[m][k] = *(const LAS bf16x8*)(lds + PG8_SA(b, h) + aoff + m * 2048 + k * 1024); } while (0)
#define PG8_LDB(dst, b, h) do { _Pragma("unroll") for (int n = 0; n < 2; ++n) _Pragma("unroll") for (int k = 0; k < 2; ++k) dst[n][k] = *(const LAS bf16x8*)(lds + PG8_SB(b, h) + boff + n * 2048 + k * 1024); } while (0)
#define PG8_MMA(ai, bj, At, Bt) do { __builtin_amdgcn_s_setprio(1); _Pragma("unroll") for (int m = 0; m < 4; ++m) _Pragma("unroll") for (int n = 0; n < 2; ++n) _Pragma("unroll") for (int k = 0; k < 2; ++k) \
        acc[ai][bj][m][n] = __builtin_amdgcn_mfma_f32_16x16x32_bf16(Bt[n][k], At[m][k], acc[ai][bj][m][n], 0, 0, 0); __builtin_amdgcn_s_setprio(0); } while (0)
#define PG8_WAIT_V(n) asm volatile("s_waitcnt vmcnt(" #n ")" ::: "memory")
#define PG8_WAIT_L(n) asm volatile("s_waitcnt lgkmcnt(" #n ")" ::: "memory")
#define PG8_BAR __builtin_amdgcn_s_barrier()
#define PG8_SCHED __builtin_amdgcn_sched_barrier(0)
    MUnit cur, nxt; int ui = 0;
    if (!S.next(0, cur)) return;
    f32x4 acc[2][2][4][2];
#pragma unroll
    for (int a = 0; a < 2; ++a)
#pragma unroll
        for (int b = 0; b < 2; ++b)
#pragma unroll
            for (int m = 0; m < 4; ++m)
#pragma unroll
                for (int n = 0; n < 2; ++n) acc[a][b][m][n] = (f32x4){0.f, 0.f, 0.f, 0.f};
    bf16x8 At[4][2], B0[2][2], B1[2][2];
    unsigned oc[2][2], on[2][2], vBc[2], vBn[2]; const char* cB; const char* nB; size_t hsc, hsn; int ntc, ntn;
    { const int Kc = S.kdim(cur); ntc = Kc / BK; hsc = (size_t)HALF * Kc * 2;
#pragma unroll
      for (int i = 0; i < 2; ++i) vBc[i] = (unsigned)(Rbp[i] * Kc * 2 + Cb[i]); }
    S.setup(cur, Rl, Cb, oc, cB, 0);
    S.a_ready(cur);
    PG8_STAGE(PG8_SB(0, 0), cB, vBc); PG8_STAGE(PG8_SB(0, 1), cB + hsc, vBc); PG8_STAGE(PG8_SA(0, 0), gA, oc[0]); PG8_STAGE(PG8_SA(0, 1), gA, oc[1]);
    if (wr == 1) PG8_BAR;
    PG8_WAIT_V(2); PG8_BAR;
    PG8_STAGE(PG8_SB(1, 0), cB + kstep, vBc); PG8_STAGE(PG8_SA(1, 0), gA + kstep, oc[0]); PG8_STAGE(PG8_SB(1, 1), cB + hsc + kstep, vBc);
    PG8_WAIT_V(6); PG8_BAR;
    for (;;) {
        const bool has_next = S.next(ui + 1, nxt);
        if (has_next) { S.setup(nxt, Rl, Cb, on, nB, ui + 1); const int Kn = S.kdim(nxt); ntn = Kn / BK; hsn = (size_t)HALF * Kn * 2;
#pragma unroll
            for (int i = 0; i < 2; ++i) vBn[i] = (unsigned)(Rbp[i] * Kn * 2 + Cb[i]); }
        else { nB = cB; hsn = hsc; ntn = ntc;
#pragma unroll
            for (int i = 0; i < 2; ++i) vBn[i] = vBc[i];
#pragma unroll
            for (int h = 0; h < 2; ++h)
#pragma unroll
                for (int i = 0; i < 2; ++i) on[h][i] = oc[h][i]; }
        for (int t = 0; t < ntc; t += 2) {
            const bool last = (t == ntc - 2);
            const char* a1 = gA + (size_t)(t + 1) * kstep;
            const char* a2 = last ? gA : gA + (size_t)(t + 2) * kstep; const char* b2 = last ? nB : cB + (size_t)(t + 2) * kstep;
            const char* a3 = a2 + kstep; const char* b3 = b2 + kstep;
            unsigned o2[2][2], v2[2]; const size_t hs2 = last ? hsn : hsc;
#pragma unroll
            for (int i = 0; i < 2; ++i) v2[i] = last ? vBn[i] : vBc[i];
#pragma unroll
            for (int h = 0; h < 2; ++h)
#pragma unroll
                for (int i = 0; i < 2; ++i) o2[h][i] = last ? on[h][i] : oc[h][i];
            if (last && has_next) S.a_ready(nxt);
            PG8_LDB(B0, 0, 0); PG8_LDB(B1, 0, 1); PG8_SCHED; PG8_LDA(At, 0, 0); PG8_STAGE(PG8_SA(1, 1), a1, oc[1]);
            PG8_WAIT_V(8); PG8_WAIT_L(0); PG8_BAR; PG8_MMA(0, 0, At, B0); PG8_MMA(0, 1, At, B1); PG8_BAR; PG8_SCHED;
            PG8_LDA(At, 0, 1); PG8_STAGE(PG8_SB(0, 0), b2, v2); PG8_STAGE(PG8_SB(0, 1), b2 + hs2, v2); PG8_STAGE(PG8_SA(0, 0), a2, o2[0]);
            PG8_WAIT_V(8); PG8_WAIT_L(0); PG8_BAR; PG8_MMA(1, 0, At, B0); PG8_MMA(1, 1, At, B1); PG8_BAR; PG8_SCHED;
            PG8_LDB(B0, 1, 0); PG8_LDB(B1, 1, 1); PG8_SCHED; PG8_LDA(At, 1, 0); PG8_STAGE(PG8_SA(0, 1), a2, o2[1]);
            PG8_WAIT_V(8); PG8_WAIT_L(0); PG8_BAR; PG8_MMA(0, 0, At, B0); PG8_MMA(0, 1, At, B1); PG8_BAR; PG8_SCHED;
            PG8_LDA(At, 1, 1); PG8_STAGE(PG8_SB(1, 0), b3, v2); PG8_STAGE(PG8_SB(1, 1), b3 + hs2, v2); PG8_STAGE(PG8_SA(1, 0), a3, o2[0]);
            PG8_WAIT_V(8); PG8_WAIT_L(0); PG8_BAR; PG8_MMA(1, 0, At, B0); PG8_MMA(1, 1, At, B1); PG8_BAR; PG8_SCHED;
        }
        if (wr == 0) PG8_BAR;
        if (cur.kind == 0) E0(acc, cur, wr, wc, fr, fq); else E1(acc, cur, wr, wc, fr, fq);
        S.done(cur);
        if (!has_next) break;
#pragma unroll
        for (int a = 0; a < 2; ++a)
#pragma unroll
            for (int b = 0; b < 2; ++b)
#pragma unroll
                for (int m = 0; m < 4; ++m)
#pragma unroll
                    for (int n = 0; n < 2; ++n) acc[a][b][m][n] = (f32x4){0.f, 0.f, 0.f, 0.f};
        cur = nxt; cB = nB; hsc = hsn; ntc = ntn; ++ui;
#pragma unroll
        for (int i = 0; i < 2; ++i) vBc[i] = vBn[i];
#pragma unroll
        for (int h = 0; h < 2; ++h)
#pragma unroll
            for (int i = 0; i < 2; ++i) oc[h][i] = on[h][i];
        if (wr == 1) PG8_BAR;
    }
    PG8_WAIT_V(0);
    PG8_BAR;
#undef PG8_SA
#undef PG8_SB
#undef PG8_STAGE
#undef PG8_LDA
#undef PG8_LDB
#undef PG8_MMA
#undef PG8_WAIT_V
#undef PG8_WAIT_L
#undef PG8_BAR
#undef PG8_SCHED
}
}
namespace attn_body {
using bf16=__hip_bfloat16;
using bf16x8=__attribute__((ext_vector_type(8)))short;
using s16x4=__attribute__((ext_vector_type(4)))short;
using f32x16=__attribute__((ext_vector_type(16)))float;
using u32x4=__attribute__((ext_vector_type(4)))unsigned;
constexpr int SEQ=4096,D=64,PQ=3584,PO=1024;
constexpr int NW=8,QBLK=32,QB=QBLK*NW,KVBLK=64,NQB=SEQ/QB;
constexpr int ATTN_UNIT_ROWS=QB;
__device__ __forceinline__ int crow(int r,int hi){return (r&3)+8*(r>>2)+4*hi;}
#define SBAR() __builtin_amdgcn_sched_barrier(0)
__device__ __forceinline__ void cmask(f32x16&p0,f32x16&p1,int jb,int qrel,int hi){
  const float NEG=-INFINITY; int kb=64*jb+4*hi;
  #pragma unroll
  for(int r=0;r<16;++r){int kv=kb+(r&3)+8*(r>>2); if(kv>qrel)p0[r]=NEG; if(kv+32>qrel)p1[r]=NEG;}
}

constexpr int NSLOT=3, SLOTB=8192;
constexpr int LDS_K=0, LDS_V=NSLOT*SLOTB, LDS_WS=2*NSLOT*SLOTB, LDS_OST=LDS_WS+NW*64*4, LDS_BYTES=LDS_OST+NW*4096;
constexpr float C2=0.125f*1.4426950408889634f;
__device__ __forceinline__ void glds16(const void*gsrc,unsigned lds_dst){unsigned keep;
  asm volatile("s_mov_b32 %0, m0\n\ts_mov_b32 m0, %2\n\ts_nop 0\n\tglobal_load_lds_dwordx4 %1, off\n\ts_mov_b32 m0, %0":"=&s"(keep):"v"(gsrc),"s"(lds_dst):"memory");}
__device__ __forceinline__ float max3f(float a,float b,float c){float r;asm("v_max3_f32 %0, %1, %2, %3":"=v"(r):"v"(a),"v"(b),"v"(c));return r;}
__device__ __forceinline__ float max2f(float a,float b){float r;asm("v_max_f32_e32 %0, %1, %2":"=v"(r):"v"(a),"v"(b));return r;}
__device__ __forceinline__ float fadd_s(float a,float b){float r;asm("v_add_f32_e32 %0, %1, %2":"=v"(r):"v"(a),"v"(b));return r;}
__device__ __forceinline__ float fsub_s(float a,float b){float r;asm("v_sub_f32_e32 %0, %1, %2":"=v"(r):"v"(a),"v"(b));return r;}
typedef float f32x2_t __attribute__((ext_vector_type(2))); typedef __bf16 bf16x2_t __attribute__((ext_vector_type(2)));
__device__ __forceinline__ unsigned cvtpk_s(float lo,float hi){f32x2_t v={lo,hi};bf16x2_t b=__builtin_convertvector(v,bf16x2_t);return __builtin_bit_cast(unsigned,b);}
#define WAIT_BAR(N) asm volatile("s_waitcnt vmcnt(" #N ") lgkmcnt(0)\n\ts_barrier":::"memory")

__device__ __forceinline__ void qkt(f32x16&p0,f32x16&p1,const char*Kslot,const bf16x8*qr,const f32x16&negm,int r32,int hi){
  const char*kb=Kslot+hi*1024+r32*16;
  #pragma unroll
  for(int d0=0;d0<4;++d0){
    const bf16x8 b0=*reinterpret_cast<const bf16x8*>(kb+d0*2048);
    const bf16x8 b1=*reinterpret_cast<const bf16x8*>(kb+d0*2048+512);
    if(d0==0){p0=__builtin_amdgcn_mfma_f32_32x32x16_bf16(b0,qr[0],negm,0,0,0);p1=__builtin_amdgcn_mfma_f32_32x32x16_bf16(b1,qr[0],negm,0,0,0);}
    else{p0=__builtin_amdgcn_mfma_f32_32x32x16_bf16(b0,qr[d0],p0,0,0,0);p1=__builtin_amdgcn_mfma_f32_32x32x16_bf16(b1,qr[d0],p1,0,0,0);}}
}
typedef __attribute__((address_space(3))) const char* lds_cptr;
typedef short v4i16_t __attribute__((ext_vector_type(4)));
__device__ __forceinline__ void kload8(bf16x8*kf,lds_cptr kp){
  kf[0]=*(const __attribute__((address_space(3))) bf16x8*)(kp);      kf[1]=*(const __attribute__((address_space(3))) bf16x8*)(kp+512);
  kf[2]=*(const __attribute__((address_space(3))) bf16x8*)(kp+2048); kf[3]=*(const __attribute__((address_space(3))) bf16x8*)(kp+2560);
  kf[4]=*(const __attribute__((address_space(3))) bf16x8*)(kp+4096); kf[5]=*(const __attribute__((address_space(3))) bf16x8*)(kp+4608);
  kf[6]=*(const __attribute__((address_space(3))) bf16x8*)(kp+6144); kf[7]=*(const __attribute__((address_space(3))) bf16x8*)(kp+6656);
}
__device__ __forceinline__ void kload2(bf16x8*kf,lds_cptr kp,int j){ kf[2*j]=*(const __attribute__((address_space(3))) bf16x8*)(kp+j*2048); kf[2*j+1]=*(const __attribute__((address_space(3))) bf16x8*)(kp+j*2048+512); }
__device__ __forceinline__ s16x4 vtr(lds_cptr p){ return __builtin_bit_cast(s16x4,__builtin_amdgcn_ds_read_tr16_b64_v4i16((__attribute__((address_space(3))) v4i16_t*)p)); }
__device__ __forceinline__ float rowmax(const f32x16&p0,const f32x16&p1){
  float a=max3f(p0[0],p0[1],p1[0]),b=max3f(p0[2],p0[3],p1[1]);a=max3f(a,p1[2],p1[3]);
  #pragma unroll
  for(int r=4;r<16;r+=4){a=max3f(a,p0[r],p0[r+1]);b=max3f(b,p0[r+2],p0[r+3]);a=max3f(a,p1[r],p1[r+1]);b=max3f(b,p1[r+2],p1[r+3]);}
  const float m=max2f(a,b);
  auto rr=__builtin_amdgcn_permlane32_swap(__float_as_uint(m),__float_as_uint(m),false,false);
  return max2f(__uint_as_float(rr[0]),__uint_as_float(rr[1]));
}
__device__ __forceinline__ void pv(f32x16*o,int vb,bf16x8 pa0,bf16x8 pa1,bf16x8 pa2,bf16x8 pa3){
  #pragma unroll
  for(int d0=0;d0<2;++d0){s16x4 lo[4],hi[4];
    #pragma unroll
    for(int ks=0;ks<4;++ks){
      asm volatile("ds_read_b64_tr_b16 %0,%1 offset:%c2":"=&v"(lo[ks]):"v"(vb),"i"(d0*4096+ks*1024):"memory");
      asm volatile("ds_read_b64_tr_b16 %0,%1 offset:%c2":"=&v"(hi[ks]):"v"(vb),"i"(d0*4096+ks*1024+512):"memory");}
    asm volatile("s_waitcnt lgkmcnt(0)":::"memory");SBAR();
    #define PK(k) (bf16x8){lo[k][0],lo[k][1],lo[k][2],lo[k][3],hi[k][0],hi[k][1],hi[k][2],hi[k][3]}
    o[d0]=__builtin_amdgcn_mfma_f32_32x32x16_bf16(pa0,PK(0),o[d0],0,0,0);
    o[d0]=__builtin_amdgcn_mfma_f32_32x32x16_bf16(pa1,PK(1),o[d0],0,0,0);
    o[d0]=__builtin_amdgcn_mfma_f32_32x32x16_bf16(pa2,PK(2),o[d0],0,0,0);
    o[d0]=__builtin_amdgcn_mfma_f32_32x32x16_bf16(pa3,PK(3),o[d0],0,0,0);
    #undef PK
  }
}

#ifndef ATTN_STORE16
#define ATTN_STORE16(p,v) (*(u32x4*)(p)=(v))
#endif
template<int THRL> __device__ __forceinline__ void attn_unit(int qb,const bf16*Qh,const bf16*__restrict__ Kh,const bf16*__restrict__ Vh,bf16*Oh,char*shm){
  int tid_=threadIdx.x; asm volatile("":"+v"(tid_));
  const int tid=tid_,lane=tid&63,r32=lane&31,hi=lane>>5; const int wid=__builtin_amdgcn_readfirstlane(tid>>6);
  const int q0=qb*QB;
  const bf16*Qw=Qh+(long)(q0+wid*QBLK)*PQ;
  const unsigned lds0=(unsigned)(uintptr_t)shm;
  float*wsf=(float*)(shm+LDS_WS)+wid*64;
  const bf16*ksrc=Kh+(long)lane*PQ+wid*8;
  const bf16*vsrc=Vh+(long)(16*(wid&3)+(lane>>2))*PQ+(wid>>2)*32+(lane&3)*8;
  const unsigned kdst=lds0+LDS_K+wid*1024, vdst=lds0+LDS_V+wid*1024;
  #define DMA_K(t,slot) glds16(ksrc+(long)(t)*KVBLK*PQ,(unsigned)__builtin_amdgcn_readfirstlane(kdst+(slot)))
  #define DMA_V(t,slot) glds16(vsrc+(long)(t)*KVBLK*PQ,(unsigned)__builtin_amdgcn_readfirstlane(vdst+(slot)))
  const int vb0=(int)(lds0+LDS_V)+((lane>>4)&1)*32+(lane&3)*8+(4*hi+((lane&15)>>2))*64;
  const char*Kbase=shm+LDS_K; bf16x8 kf[8];
  const lds_cptr shm3=(lds_cptr)shm; const lds_cptr kp0=shm3+LDS_K+hi*1024+r32*16; const lds_cptr vp0=shm3+LDS_V+((lane>>4)&1)*32+(lane&3)*8+(4*hi+((lane&15)>>2))*64;
  const int NT=(q0+QB)/KVBLK;
  DMA_K(0,0);DMA_V(0,0);DMA_K(1,SLOTB);
  bf16x8 qr[4];
  #pragma unroll
  for(int d0=0;d0<4;++d0)qr[d0]=*reinterpret_cast<const bf16x8*>(&Qw[(long)r32*PQ+d0*16+hi*8]);
  float mhat=0.f,l_reg=0.f;f32x16 o[2];o[0]=f32x16{};o[1]=f32x16{};f32x16 negm=f32x16{};asm volatile("":"+v"(negm));
  const int qrel=wid*QBLK+r32;
  #define CMASK(P0,P1,t) do{int jb_=(t)-(NT-4); if(jb_>=0)cmask(P0,P1,jb_,qrel,hi);}while(0)
  bool resc=false;
  #define START(P0,P1) do{ const float rm=rowmax(P0,P1); resc=false; \
    { const float dl=rm; mhat=fadd_s(mhat,dl); \
      _Pragma("unroll") for(int r=0;r<16;++r){P0[r]=fsub_s(P0[r],dl);P1[r]=fsub_s(P1[r],dl);} \
      _Pragma("unroll") for(int r=0;r<16;++r)negm[r]=-mhat; asm volatile("":"+v"(negm)); } \
    _Pragma("unroll") for(int r=0;r<16;++r)P0[r]=__builtin_amdgcn_exp2f(P0[r]); }while(0)
  #define RESC() do{ if(resc){ asm volatile("s_waitcnt lgkmcnt(0)":::"memory"); \
      _Pragma("unroll") for(int d_=0;d_<2;++d_) _Pragma("unroll") for(int r=0;r<16;++r)o[d_][r]*=wsf[crow(r,hi)]; } }while(0)
  f32x16 pA0,pA1,pB0,pB1;
  int sl_prev=0,sl_cur=0,sl_next=SLOTB;
  #define ROT() do{sl_prev=sl_cur;sl_cur=sl_next;sl_next=(sl_next==(NSLOT-1)*SLOTB)?0:sl_next+SLOTB;}while(0)
  DMA_K(2,2*SLOTB);
  WAIT_BAR(3);
  qkt(pA0,pA1,Kbase,qr,negm,r32,hi);asm volatile("s_nop 15\n\ts_nop 7":"+v"(pA0),"+v"(pA1));CMASK(pA0,pA1,0);
  START(pA0,pA1);
  _Pragma("unroll") for(int r=0;r<16;++r)pA1[r]=__builtin_amdgcn_exp2f(pA1[r]);
  WAIT_BAR(0);
  DMA_K(3,0);DMA_V(1,SLOTB);
  ROT();
  kload8(kf,kp0+sl_cur);
  WAIT_BAR(2);
  s16x4 vlo[8],vhi[8]; u32x4 pw0,pw1,pw2,pw3;
  #define PKW(P,B) cvtpk_s(P[B],P[B+1])
  #define PAF(k) __builtin_bit_cast(bf16x8,pw##k)
  #define VFR(i) (bf16x8){vlo[i][0],vlo[i][1],vlo[i][2],vlo[i][3],vhi[i][0],vhi[i][1],vhi[i][2],vhi[i][3]}
  #define PIN(x) asm volatile("":"+v"(x))
  #define MX3(a,b,c) __builtin_fmaxf(__builtin_fmaxf((a),(b)),(c))
  #define GAPA(MF,A0,A1,A2,A3,W0,W1,PW) do{ MF; sacc+=A0; sacc+=A1; sacc+=A2; sacc+=A3; PIN(sacc); W0; W1; PIN(PW); SBAR(); }while(0)
  #define EX(v) __builtin_amdgcn_exp2f(v)
  #define GAPB(MF,X,B) do{ MF; X[B]=EX(X[B]); X[B+1]=EX(X[B+1]); X[B+2]=EX(X[B+2]); X[B+3]=EX(X[B+3]); PIN(X); SBAR(); }while(0)
  #define VRD(i) do{ vlo[i]=vtr(vp_+(((i)>>2)*4096+((i)&3)*1024)); vhi[i]=vtr(vp_+(((i)>>2)*4096+((i)&3)*1024+512)); }while(0)
  #define KRD(G,j) do{ if(G){ kload2(kf,kp0+sl_next,j); SBAR(); } }while(0)
  #define STEP(C0,C1,P0,P1,t,GK,GV,GL) do{ SBAR(); \
    const lds_cptr vp_=vp0+sl_prev; \
    VRD(0); SBAR(); float sacc=(P0[0]+P0[1]); \
    GAPA(C0=__builtin_amdgcn_mfma_f32_32x32x16_bf16(kf[0],qr[0],negm,0,0,0), P0[2],P0[3],P0[4],P0[5],     pw0[0]=PKW(P0,0), pw0[1]=PKW(P0,2), pw0); \
    VRD(4); SBAR(); GAPA(C1=__builtin_amdgcn_mfma_f32_32x32x16_bf16(kf[1],qr[0],negm,0,0,0), P0[6],P0[7],P0[8],P0[9],     pw0[2]=PKW(P0,4), pw0[3]=PKW(P0,6), pw0); \
    VRD(1); SBAR(); GAPA(C0=__builtin_amdgcn_mfma_f32_32x32x16_bf16(kf[2],qr[1],C0,0,0,0),   P0[10],P0[11],P0[12],P0[13], pw1[0]=PKW(P0,8), pw1[1]=PKW(P0,10), pw1); \
    VRD(5); SBAR(); GAPA(C1=__builtin_amdgcn_mfma_f32_32x32x16_bf16(kf[3],qr[1],C1,0,0,0),   P0[14],P0[15],P1[0],P1[1],   pw1[2]=PKW(P0,12),pw1[3]=PKW(P0,14), pw1); \
    VRD(2); SBAR(); GAPA(C0=__builtin_amdgcn_mfma_f32_32x32x16_bf16(kf[4],qr[2],C0,0,0,0),   P1[2],P1[3],P1[4],P1[5],     pw2[0]=PKW(P1,0), pw2[1]=PKW(P1,2), pw2); \
    VRD(6); SBAR(); GAPA(C1=__builtin_amdgcn_mfma_f32_32x32x16_bf16(kf[5],qr[2],C1,0,0,0),   P1[6],P1[7],P1[8],P1[9],     pw2[2]=PKW(P1,4), pw2[3]=PKW(P1,6), pw2); \
    VRD(3); SBAR(); GAPA(C0=__builtin_amdgcn_mfma_f32_32x32x16_bf16(kf[6],qr[3],C0,0,0,0),   P1[10],P1[11],P1[12],P1[13], pw3[0]=PKW(P1,8), pw3[1]=PKW(P1,10), pw3); \
    VRD(7); SBAR(); GAPA(C1=__builtin_amdgcn_mfma_f32_32x32x16_bf16(kf[7],qr[3],C1,0,0,0),   P1[14],P1[15],0.f,0.f,       pw3[2]=PKW(P1,12),pw3[3]=PKW(P1,14), pw3); \
    l_reg+=sacc; \
    if(GK){DMA_K((t)+3,sl_cur);} if(GV){DMA_V((t)+1,sl_next);} \
    CMASK(C0,C1,t); \
    { float a=MX3(C0[0],C0[1],C1[0]),b=MX3(C0[2],C0[3],C1[1]); a=MX3(a,C1[2],C1[3]); \
      _Pragma("unroll") for(int r=4;r<16;r+=4){a=MX3(a,C0[r],C0[r+1]);b=MX3(b,C0[r+2],C0[r+3]);a=MX3(a,C1[r],C1[r+1]);b=MX3(b,C1[r+2],C1[r+3]);} \
      float rm=__builtin_fmaxf(a,b); { auto rr=__builtin_amdgcn_permlane32_swap(__float_as_uint(rm),__float_as_uint(rm),false,false); rm=__builtin_fmaxf(__uint_as_float(rr[0]),__uint_as_float(rr[1])); } \
      resc=false; \
      if(__builtin_expect(__any(rm>(float)THRL),0)){ const float dl=__builtin_fmaxf(rm,0.f); mhat+=dl; \
        _Pragma("unroll") for(int r=0;r<16;++r){C0[r]-=dl;C1[r]-=dl;} \
        _Pragma("unroll") for(int r=0;r<16;++r)negm[r]=-mhat; asm volatile("":"+v"(negm)); \
        const float f=__builtin_amdgcn_exp2f(-dl); l_reg*=f; if(hi==0)wsf[r32]=f; resc=true; } } \
    SBAR(); \
    GAPB(o[0]=__builtin_amdgcn_mfma_f32_32x32x16_bf16(PAF(0),VFR(0),o[0],0,0,0), C0,0); \
    GAPB(o[1]=__builtin_amdgcn_mfma_f32_32x32x16_bf16(PAF(0),VFR(4),o[1],0,0,0), C0,4); \
    KRD(GL,0); GAPB(o[0]=__builtin_amdgcn_mfma_f32_32x32x16_bf16(PAF(1),VFR(1),o[0],0,0,0), C0,8); \
    KRD(GL,1); GAPB(o[1]=__builtin_amdgcn_mfma_f32_32x32x16_bf16(PAF(1),VFR(5),o[1],0,0,0), C0,12); \
    KRD(GL,2); GAPB(o[0]=__builtin_amdgcn_mfma_f32_32x32x16_bf16(PAF(2),VFR(2),o[0],0,0,0), C1,0); \
    KRD(GL,3); GAPB(o[1]=__builtin_amdgcn_mfma_f32_32x32x16_bf16(PAF(2),VFR(6),o[1],0,0,0), C1,4); \
    GAPB(o[0]=__builtin_amdgcn_mfma_f32_32x32x16_bf16(PAF(3),VFR(3),o[0],0,0,0), C1,8); \
    GAPB(o[1]=__builtin_amdgcn_mfma_f32_32x32x16_bf16(PAF(3),VFR(7),o[1],0,0,0), C1,12); \
    }while(0)
  int t=1;
  #undef CMASK
  #define CMASK(P0,P1,t) do{}while(0)
  for(;t+5<NT;t+=2){
    STEP(pB0,pB1,pA0,pA1,t,true,true,true);     WAIT_BAR(2); RESC(); ROT();
    STEP(pA0,pA1,pB0,pB1,t+1,true,true,true);   WAIT_BAR(2); RESC(); ROT();
  }
  #undef CMASK
  #define CMASK(P0,P1,t) do{int jb_=(t)-(NT-4); if(jb_>=0)cmask(P0,P1,jb_,qrel,hi);}while(0)
  #define ENDW(tt) do{ if((tt)+3<NT){WAIT_BAR(2);} else if((tt)+2<NT){WAIT_BAR(1);} else {WAIT_BAR(0);} }while(0)
  for(;t+1<NT;t+=2){
    STEP(pB0,pB1,pA0,pA1,t,(t+3<NT),(t+1<NT),(t+1<NT));       ENDW(t);   RESC(); ROT();
    STEP(pA0,pA1,pB0,pB1,t+1,(t+4<NT),(t+2<NT),(t+2<NT));     ENDW(t+1); RESC(); ROT();
  }
  STEP(pB0,pB1,pA0,pA1,NT-1,false,false,false); RESC();
  { float sacc=pB0[0]+pB0[1]; _Pragma("unroll") for(int r=2;r<16;++r)sacc+=pB0[r]; _Pragma("unroll") for(int r=0;r<16;++r)sacc+=pB1[r]; l_reg+=sacc;
    pw0=(u32x4){PKW(pB0,0),PKW(pB0,2),PKW(pB0,4),PKW(pB0,6)};pw1=(u32x4){PKW(pB0,8),PKW(pB0,10),PKW(pB0,12),PKW(pB0,14)};pw2=(u32x4){PKW(pB1,0),PKW(pB1,2),PKW(pB1,4),PKW(pB1,6)};pw3=(u32x4){PKW(pB1,8),PKW(pB1,10),PKW(pB1,12),PKW(pB1,14)};
    SBAR(); pv(o,vb0+sl_cur,PAF(0),PAF(1),PAF(2),PAF(3)); }
  #undef PKW
  #undef PAF
  #undef VFR
  #undef PIN
  #undef MX3
  #undef GAPA
  #undef GAPB
  #undef EX
  #undef VRD
  #undef KRD
  #undef STEP
  #undef ENDW
  {auto rr=__builtin_amdgcn_permlane32_swap(__float_as_uint(l_reg),__float_as_uint(l_reg),false,false);l_reg=__uint_as_float(rr[0])+__uint_as_float(rr[1]);}
  if(hi==0)wsf[32+r32]=l_reg;asm volatile("s_waitcnt lgkmcnt(0)":::"memory");
  float rli[16];
  #pragma unroll
  for(int r=0;r<16;++r)rli[r]=__builtin_amdgcn_rcpf(wsf[32+crow(r,hi)]);
  bf16*Ow=Oh+(long)(q0+wid*QBLK)*PO;
  { bf16*stg=(bf16*)(shm+LDS_OST)+wid*2048;
    #pragma unroll
    for(int r=0;r<16;++r){const int orow=crow(r,hi);
      #pragma unroll
      for(int d0=0;d0<2;++d0)stg[orow*64+d0*32+r32]=__float2bfloat16(o[d0][r]*rli[r]);}
    asm volatile("s_waitcnt lgkmcnt(0)":::"memory");
    #pragma unroll
    for(int i=0;i<4;++i){const int row=i*8+(lane>>3),ch=lane&7; const u32x4 v=*(const u32x4*)(stg+row*64+ch*8); ATTN_STORE16(Ow+(long)row*PO+ch*8,v);} }
  asm volatile("s_waitcnt lgkmcnt(0)\n\ts_barrier":::"memory");
  #undef DMA_K
  #undef DMA_V
  #undef CMASK
  #undef START
  #undef RESC
  #undef ROT
}
constexpr int ATTN_LDS_BYTES=LDS_BYTES;
#undef SBAR
#undef WAIT_BAR
}
namespace attn128 {
using bf16=__hip_bfloat16;
using bf16x8=__attribute__((ext_vector_type(8)))short;
using s16x4=__attribute__((ext_vector_type(4)))short;
using f32x16=__attribute__((ext_vector_type(16)))float;
using u32x4=__attribute__((ext_vector_type(4)))unsigned;
constexpr int SEQ=4096,D=64,PQ=3584,PO=1024;
constexpr int NW=8,QBLK=32,QB=QBLK*NW,KVBLK=64,NQB=SEQ/QB;
constexpr int ATTN_UNIT_ROWS=QB;
__device__ __forceinline__ int crow(int r,int hi){return (r&3)+8*(r>>2)+4*hi;}
#define SBAR() __builtin_amdgcn_sched_barrier(0)
__device__ __forceinline__ void cmask(f32x16&p0,f32x16&p1,int jb,int qrel,int hi){
  const float NEG=-INFINITY; int kb=64*jb+4*hi;
  #pragma unroll
  for(int r=0;r<16;++r){int kv=kb+(r&3)+8*(r>>2); if(kv>qrel)p0[r]=NEG; if(kv+32>qrel)p1[r]=NEG;}
}

constexpr int NSLOT=3, SLOTB=8192;
constexpr int LDS_K=0, LDS_V=NSLOT*SLOTB, LDS_WS=LDS_V+NSLOT*2*SLOTB, LDS_Q=LDS_WS+NW*64*4, LDS_BYTES=LDS_Q+NW*4096, LDS_OST=LDS_V+2*SLOTB;
constexpr float C2=0.125f*1.4426950408889634f;
__device__ __forceinline__ void glds16(const void*gsrc,unsigned lds_dst){unsigned keep;
  asm volatile("s_mov_b32 %0, m0\n\ts_mov_b32 m0, %2\n\ts_nop 0\n\tglobal_load_lds_dwordx4 %1, off\n\ts_mov_b32 m0, %0":"=&s"(keep):"v"(gsrc),"s"(lds_dst):"memory");}
__device__ __forceinline__ float max3f(float a,float b,float c){float r;asm("v_max3_f32 %0, %1, %2, %3":"=v"(r):"v"(a),"v"(b),"v"(c));return r;}
__device__ __forceinline__ float max2f(float a,float b){float r;asm("v_max_f32_e32 %0, %1, %2":"=v"(r):"v"(a),"v"(b));return r;}
__device__ __forceinline__ float fadd_s(float a,float b){float r;asm("v_add_f32_e32 %0, %1, %2":"=v"(r):"v"(a),"v"(b));return r;}
__device__ __forceinline__ float fsub_s(float a,float b){float r;asm("v_sub_f32_e32 %0, %1, %2":"=v"(r):"v"(a),"v"(b));return r;}
typedef float f32x2_t __attribute__((ext_vector_type(2))); typedef __bf16 bf16x2_t __attribute__((ext_vector_type(2)));
__device__ __forceinline__ unsigned cvtpk_s(float lo,float hi){f32x2_t v={lo,hi};bf16x2_t b=__builtin_convertvector(v,bf16x2_t);return __builtin_bit_cast(unsigned,b);}
#define WAIT_BAR(N) asm volatile("s_waitcnt vmcnt(" #N ") lgkmcnt(0)\n\ts_barrier":::"memory")

__device__ __forceinline__ void qkt(f32x16&p0,f32x16&p1,const char*Kslot,const bf16x8*qr,int r32,int hi){ const f32x16 negm=f32x16{};
  const char*kb=Kslot+hi*1024+r32*16;
  #pragma unroll
  for(int d0=0;d0<4;++d0){
    const bf16x8 b0=*reinterpret_cast<const bf16x8*>(kb+d0*2048);
    const bf16x8 b1=*reinterpret_cast<const bf16x8*>(kb+d0*2048+512);
    if(d0==0){p0=__builtin_amdgcn_mfma_f32_32x32x16_bf16(b0,qr[0],negm,0,0,0);p1=__builtin_amdgcn_mfma_f32_32x32x16_bf16(b1,qr[0],negm,0,0,0);}
    else{p0=__builtin_amdgcn_mfma_f32_32x32x16_bf16(b0,qr[d0],p0,0,0,0);p1=__builtin_amdgcn_mfma_f32_32x32x16_bf16(b1,qr[d0],p1,0,0,0);}}
}
typedef __attribute__((address_space(3))) const char* lds_cptr;
typedef short v4i16_t __attribute__((ext_vector_type(4)));
__device__ __forceinline__ void kload8(bf16x8*kf,lds_cptr kp){
  kf[0]=*(const __attribute__((address_space(3))) bf16x8*)(kp);      kf[1]=*(const __attribute__((address_space(3))) bf16x8*)(kp+512);
  kf[2]=*(const __attribute__((address_space(3))) bf16x8*)(kp+2048); kf[3]=*(const __attribute__((address_space(3))) bf16x8*)(kp+2560);
  kf[4]=*(const __attribute__((address_space(3))) bf16x8*)(kp+4096); kf[5]=*(const __attribute__((address_space(3))) bf16x8*)(kp+4608);
  kf[6]=*(const __attribute__((address_space(3))) bf16x8*)(kp+6144); kf[7]=*(const __attribute__((address_space(3))) bf16x8*)(kp+6656);
}
__device__ __forceinline__ void kload2(bf16x8*kf,lds_cptr kp,int j){ kf[2*j]=*(const __attribute__((address_space(3))) bf16x8*)(kp+j*2048); kf[2*j+1]=*(const __attribute__((address_space(3))) bf16x8*)(kp+j*2048+512); }
__device__ __forceinline__ s16x4 vtr(lds_cptr p){ return __builtin_bit_cast(s16x4,__builtin_amdgcn_ds_read_tr16_b64_v4i16((__attribute__((address_space(3))) v4i16_t*)p)); }
__device__ __forceinline__ float rowmax(const f32x16&p0,const f32x16&p1){
  float a=max3f(p0[0],p0[1],p1[0]),b=max3f(p0[2],p0[3],p1[1]);a=max3f(a,p1[2],p1[3]);
  #pragma unroll
  for(int r=4;r<16;r+=4){a=max3f(a,p0[r],p0[r+1]);b=max3f(b,p0[r+2],p0[r+3]);a=max3f(a,p1[r],p1[r+1]);b=max3f(b,p1[r+2],p1[r+3]);}
  const float m=max2f(a,b);
  auto rr=__builtin_amdgcn_permlane32_swap(__float_as_uint(m),__float_as_uint(m),false,false);
  return max2f(__uint_as_float(rr[0]),__uint_as_float(rr[1]));
}
__device__ __forceinline__ void pv(f32x16*o,int vb,bf16x8 pa0,bf16x8 pa1,bf16x8 pa2,bf16x8 pa3){
  #pragma unroll
  for(int d0=0;d0<4;++d0){s16x4 lo[4],hi[4];
    #pragma unroll
    for(int ks=0;ks<4;++ks){
      asm volatile("ds_read_b64_tr_b16 %0,%1 offset:%c2":"=&v"(lo[ks]):"v"(vb),"i"(d0*4096+ks*1024):"memory");
      asm volatile("ds_read_b64_tr_b16 %0,%1 offset:%c2":"=&v"(hi[ks]):"v"(vb),"i"(d0*4096+ks*1024+512):"memory");}
    asm volatile("s_waitcnt lgkmcnt(0)":::"memory");SBAR();
    #define PK(k) (bf16x8){lo[k][0],lo[k][1],lo[k][2],lo[k][3],hi[k][0],hi[k][1],hi[k][2],hi[k][3]}
    o[d0]=__builtin_amdgcn_mfma_f32_32x32x16_bf16(pa0,PK(0),o[d0],0,0,0);
    o[d0]=__builtin_amdgcn_mfma_f32_32x32x16_bf16(pa1,PK(1),o[d0],0,0,0);
    o[d0]=__builtin_amdgcn_mfma_f32_32x32x16_bf16(pa2,PK(2),o[d0],0,0,0);
    o[d0]=__builtin_amdgcn_mfma_f32_32x32x16_bf16(pa3,PK(3),o[d0],0,0,0);
    #undef PK
  }
}

#if 0
#define ATTN_STORE16(p,v) (*(u32x4*)(p)=(v))
#endif
template<int THRL,int DRY=0> __device__ __forceinline__ void attn_unit(int qb,int qb_next,bool warm,const bf16*Qh,const bf16*__restrict__ Kh,const bf16*__restrict__ Vh,bf16*Oh,char*shm){
  int tid_=threadIdx.x; asm volatile("":"+v"(tid_));
  const int tid=tid_,lane=tid&63,r32=lane&31,hi=lane>>5; const int wid=__builtin_amdgcn_readfirstlane(tid>>6);
  const int q0=qb*QB;
  const bf16*Qw=Qh+(long)(q0+wid*QBLK)*PQ;
  const unsigned lds0=(unsigned)(uintptr_t)shm;
  float*wsf=(float*)(shm+LDS_WS)+wid*64;
  const bf16*ksrc=Kh+(long)lane*PQ+wid*8;
  const bf16*vsrc=Vh+(long)(16*(wid&3)+(lane>>2))*PQ+(wid>>2)*32+(lane&3)*8;
  const unsigned kdst=lds0+LDS_K+wid*1024, vdst=lds0+LDS_V+wid*1024;
  #define DMA_K(t,slot) glds16(ksrc+(long)(t)*KVBLK*PQ,(unsigned)__builtin_amdgcn_readfirstlane(kdst+(slot)))
  #define DMA_V(t,slot) do{ glds16(vsrc+(long)(t)*KVBLK*PQ,(unsigned)__builtin_amdgcn_readfirstlane(vdst+2*(slot))); glds16(vsrc+64+(long)(t)*KVBLK*PQ,(unsigned)__builtin_amdgcn_readfirstlane(vdst+2*(slot)+8192)); }while(0)
  const int vb0=(int)(lds0+LDS_V)+((lane>>4)&1)*32+(lane&3)*8+(4*hi+((lane&15)>>2))*64;
  const char*Kbase=shm+LDS_K; bf16x8 kf[8];
  const lds_cptr shm3=(lds_cptr)shm; const lds_cptr kp0=shm3+LDS_K+hi*1024+r32*16; const lds_cptr vp0=shm3+LDS_V+((lane>>4)&1)*32+(lane&3)*8+(4*hi+((lane&15)>>2))*64;
  const int NT=(q0+QB)/KVBLK;
  const unsigned qdst=lds0+LDS_Q+wid*4096;
  #define DMA_HEAD(Qw_) do{ _Pragma("unroll") for(int d0=0;d0<4;++d0)glds16((Qw_)+(long)r32*PQ+d0*16+hi*8,(unsigned)__builtin_amdgcn_readfirstlane(qdst+d0*1024)); \
      DMA_K(0,0);DMA_V(0,0);DMA_K(1,SLOTB);DMA_K(2,2*SLOTB); }while(0)
  if(!warm) DMA_HEAD(Qw);
  bf16x8 qr[4];
  const lds_cptr qp0=shm3+LDS_Q+wid*4096+(hi*32+r32)*16;
  #define QLD(d0) (*(const __attribute__((address_space(3))) bf16x8*)(qp0+(d0)*1024))
  float mhat=0.f,l_reg=0.f;f32x16 o[4];o[0]=f32x16{};o[1]=f32x16{};o[2]=f32x16{};o[3]=f32x16{};
  const int qrel=wid*QBLK+r32;
  #define CMASK(P0,P1,t) do{int jb_=(t)-(NT-4); if(jb_>=0)cmask(P0,P1,jb_,qrel,hi);}while(0)
  bool resc=false;
  #define START(P0,P1) do{ const float rm=rowmax(P0,P1); resc=false; \
    { const float dl=rm; mhat=fadd_s(mhat,dl); \
      _Pragma("unroll") for(int r=0;r<16;++r){P0[r]=fsub_s(P0[r],dl);P1[r]=fsub_s(P1[r],dl);} \
      } \
    _Pragma("unroll") for(int r=0;r<16;++r)P0[r]=__builtin_amdgcn_exp2f(P0[r]); }while(0)
  #define RESC() do{ if(resc){ asm volatile("s_waitcnt lgkmcnt(0)":::"memory"); \
      _Pragma("unroll") for(int d_=0;d_<4;++d_) _Pragma("unroll") for(int r=0;r<16;++r)o[d_][r]*=wsf[crow(r,hi)]; } }while(0)
  f32x16 pA0,pA1,pB0,pB1;
  int sl_prev=0,sl_cur=0,sl_next=SLOTB;
  #define ROT() do{sl_prev=sl_cur;sl_cur=sl_next;sl_next=(sl_next==(NSLOT-1)*SLOTB)?0:sl_next+SLOTB;}while(0)
  if(warm) WAIT_BAR(12); else WAIT_BAR(4);
  #pragma unroll
  for(int d0=0;d0<4;++d0)qr[d0]=QLD(d0);
  qkt(pA0,pA1,Kbase,qr,r32,hi);asm volatile("s_nop 15\n\ts_nop 7":"+v"(pA0),"+v"(pA1));CMASK(pA0,pA1,0);
  START(pA0,pA1);
  _Pragma("unroll") for(int r=0;r<16;++r)pA1[r]=__builtin_amdgcn_exp2f(pA1[r]);
  WAIT_BAR(0);
  DMA_K(3,0);DMA_V(1,SLOTB);
  ROT();
  kload8(kf,kp0+sl_cur);
  WAIT_BAR(3);
  s16x4 vlo[8],vhi[8]; u32x4 pw0,pw1,pw2,pw3;
  #define PKW(P,B) cvtpk_s(P[B],P[B+1])
  #define PAF(k) __builtin_bit_cast(bf16x8,pw##k)
  #define VFR(i) (bf16x8){vlo[i][0],vlo[i][1],vlo[i][2],vlo[i][3],vhi[i][0],vhi[i][1],vhi[i][2],vhi[i][3]}
  #define PIN(x) asm volatile("":"+v"(x))
  #define MX3(a,b,c) __builtin_fmaxf(__builtin_fmaxf((a),(b)),(c))
  #define GAPA(MF,A0,A1,A2,A3,W0,W1,PW) do{ MF; if(!(DRY&1)){ sacc+=A0; sacc+=A1; sacc+=A2; sacc+=A3; PIN(sacc); W0; W1; PIN(PW); } SBAR(); }while(0)
  #define EX(v) __builtin_amdgcn_exp2f(v)
  #define GAPB(MF,X,B) do{ MF; if(!(DRY&2)){ X[B]=X[B]-mhat; X[B+1]=X[B+1]-mhat; PIN(X); X[B]=EX(X[B]); X[B+1]=EX(X[B+1]); PIN(X); } SBAR(); }while(0)
  #define KEEPF(x) asm volatile(""::"v"(x))
  #define KEEPV(i) do{ asm volatile(""::"v"(vlo[i]),"v"(vhi[i])); }while(0)
  #define VRD2(i) do{ if(DRY&4)break; vlo[i]=vtr(vp_+((((i)>>2)+2)*4096+((i)&3)*1024)); vhi[i]=vtr(vp_+((((i)>>2)+2)*4096+((i)&3)*1024+512)); SBAR(); }while(0)
  #define VRD(i) do{ if(DRY&4)break; vlo[i]=vtr(vp_+(((i)>>2)*4096+((i)&3)*1024)); vhi[i]=vtr(vp_+(((i)>>2)*4096+((i)&3)*1024+512)); }while(0)
  #define KRD(G,j) do{ if((G)&&!(DRY&16)){ kload2(kf,kp0+sl_next,j); SBAR(); } }while(0)
  #define STEP(C0,C1,P0,P1,t,GK,GV,GL) do{ SBAR(); const f32x16 zero16=f32x16{}; const bf16x8 ql0=QLD(0),ql1=QLD(1),ql2=QLD(2),ql3=QLD(3); \
    const lds_cptr vp_=vp0+2*sl_prev; \
    VRD(0); SBAR(); float sacc=(P0[0]+P0[1]); \
    GAPA(C0=__builtin_amdgcn_mfma_f32_32x32x16_bf16(kf[0],ql0,zero16,0,0,0), P0[2],P0[3],P0[4],P0[5],     pw0[0]=PKW(P0,0), pw0[1]=PKW(P0,2), pw0); \
    VRD(4); SBAR(); GAPA(C1=__builtin_amdgcn_mfma_f32_32x32x16_bf16(kf[1],ql0,zero16,0,0,0), P0[6],P0[7],P0[8],P0[9],     pw0[2]=PKW(P0,4), pw0[3]=PKW(P0,6), pw0); \
    VRD(1); SBAR(); KEEPF(kf[0]); GAPA(C0=__builtin_amdgcn_mfma_f32_32x32x16_bf16(kf[2],ql1,C0,0,0,0),   P0[10],P0[11],P0[12],P0[13], pw1[0]=PKW(P0,8), pw1[1]=PKW(P0,10), pw1); \
    VRD(5); SBAR(); KEEPF(kf[1]); KEEPF(ql0); GAPA(C1=__builtin_amdgcn_mfma_f32_32x32x16_bf16(kf[3],ql1,C1,0,0,0),   P0[14],P0[15],P1[0],P1[1],   pw1[2]=PKW(P0,12),pw1[3]=PKW(P0,14), pw1); \
    VRD(2); SBAR(); KEEPF(kf[2]); GAPA(C0=__builtin_amdgcn_mfma_f32_32x32x16_bf16(kf[4],ql2,C0,0,0,0),   P1[2],P1[3],P1[4],P1[5],     pw2[0]=PKW(P1,0), pw2[1]=PKW(P1,2), pw2); \
    VRD(6); SBAR(); KEEPF(kf[3]); KEEPF(ql1); GAPA(C1=__builtin_amdgcn_mfma_f32_32x32x16_bf16(kf[5],ql2,C1,0,0,0),   P1[6],P1[7],P1[8],P1[9],     pw2[2]=PKW(P1,4), pw2[3]=PKW(P1,6), pw2); \
    VRD(3); SBAR(); KEEPF(kf[4]); GAPA(C0=__builtin_amdgcn_mfma_f32_32x32x16_bf16(kf[6],ql3,C0,0,0,0),   P1[10],P1[11],P1[12],P1[13], pw3[0]=PKW(P1,8), pw3[1]=PKW(P1,10), pw3); \
    VRD(7); SBAR(); KEEPF(kf[5]); KEEPF(ql2); GAPA(C1=__builtin_amdgcn_mfma_f32_32x32x16_bf16(kf[7],ql3,C1,0,0,0),   P1[14],P1[15],0.f,0.f,       pw3[2]=PKW(P1,12),pw3[3]=PKW(P1,14), pw3); \
    l_reg+=sacc; \
    if(GK&&!(DRY&8)){DMA_K((t)+3,sl_cur);} if(GV&&!(DRY&8)){DMA_V((t)+1,sl_next);} \
    CMASK(C0,C1,t); \
    { float a=MX3(C0[0],C0[1],C1[0]),b=MX3(C0[2],C0[3],C1[1]); a=MX3(a,C1[2],C1[3]); \
      _Pragma("unroll") for(int r=4;r<16;r+=4){a=MX3(a,C0[r],C0[r+1]);b=MX3(b,C0[r+2],C0[r+3]);a=MX3(a,C1[r],C1[r+1]);b=MX3(b,C1[r+2],C1[r+3]);} \
      float rm=__builtin_fmaxf(a,b); { auto rr=__builtin_amdgcn_permlane32_swap(__float_as_uint(rm),__float_as_uint(rm),false,false); rm=__builtin_fmaxf(__uint_as_float(rr[0]),__uint_as_float(rr[1])); } \
      resc=false; \
      rm-=mhat; \
      if(__builtin_expect(__any(rm>(float)THRL),0)){ const float dl=__builtin_fmaxf(rm,0.f); mhat+=dl; \
        const float f=__builtin_amdgcn_exp2f(-dl); l_reg*=f; if(hi==0)wsf[r32]=f; resc=true; } } \
    KEEPF(kf[6]); KEEPF(kf[7]); KEEPF(ql3); SBAR(); \
    GAPB(o[0]=__builtin_amdgcn_mfma_f32_32x32x16_bf16(PAF(0),VFR(0),o[0],0,0,0), C0,0); \
    GAPB(o[1]=__builtin_amdgcn_mfma_f32_32x32x16_bf16(PAF(0),VFR(4),o[1],0,0,0), C0,2); \
    KRD(GL,0); GAPB(o[0]=__builtin_amdgcn_mfma_f32_32x32x16_bf16(PAF(1),VFR(1),o[0],0,0,0), C0,4); KEEPV(0); VRD2(0); \
    KRD(GL,1); GAPB(o[1]=__builtin_amdgcn_mfma_f32_32x32x16_bf16(PAF(1),VFR(5),o[1],0,0,0), C0,6); KEEPV(4); VRD2(4); \
    KRD(GL,2); GAPB(o[0]=__builtin_amdgcn_mfma_f32_32x32x16_bf16(PAF(2),VFR(2),o[0],0,0,0), C0,8); KEEPV(1); VRD2(1); \
    KRD(GL,3); GAPB(o[1]=__builtin_amdgcn_mfma_f32_32x32x16_bf16(PAF(2),VFR(6),o[1],0,0,0), C0,10); KEEPV(5); VRD2(5); \
    GAPB(o[0]=__builtin_amdgcn_mfma_f32_32x32x16_bf16(PAF(3),VFR(3),o[0],0,0,0), C0,12); KEEPV(2); VRD2(2); \
    GAPB(o[1]=__builtin_amdgcn_mfma_f32_32x32x16_bf16(PAF(3),VFR(7),o[1],0,0,0), C0,14); KEEPV(6); VRD2(6); \
    GAPB(o[2]=__builtin_amdgcn_mfma_f32_32x32x16_bf16(PAF(0),VFR(0),o[2],0,0,0), C1,0); KEEPV(3); VRD2(3); \
    GAPB(o[3]=__builtin_amdgcn_mfma_f32_32x32x16_bf16(PAF(0),VFR(4),o[3],0,0,0), C1,2); KEEPV(7); VRD2(7); \
    GAPB(o[2]=__builtin_amdgcn_mfma_f32_32x32x16_bf16(PAF(1),VFR(1),o[2],0,0,0), C1,4); \
    GAPB(o[3]=__builtin_amdgcn_mfma_f32_32x32x16_bf16(PAF(1),VFR(5),o[3],0,0,0), C1,6); \
    GAPB(o[2]=__builtin_amdgcn_mfma_f32_32x32x16_bf16(PAF(2),VFR(2),o[2],0,0,0), C1,8); \
    GAPB(o[3]=__builtin_amdgcn_mfma_f32_32x32x16_bf16(PAF(2),VFR(6),o[3],0,0,0), C1,10); \
    GAPB(o[2]=__builtin_amdgcn_mfma_f32_32x32x16_bf16(PAF(3),VFR(3),o[2],0,0,0), C1,12); \
    GAPB(o[3]=__builtin_amdgcn_mfma_f32_32x32x16_bf16(PAF(3),VFR(7),o[3],0,0,0), C1,14); \
    }while(0)
  int t=(DRY&32)?NT-1:1;
  #undef CMASK
  #define CMASK(P0,P1,t) do{}while(0)
  for(;t+5<NT;t+=2){
    STEP(pB0,pB1,pA0,pA1,t,true,true,true);     WAIT_BAR(3); RESC(); ROT();
    STEP(pA0,pA1,pB0,pB1,t+1,true,true,true);   WAIT_BAR(3); RESC(); ROT();
  }
  #undef CMASK
  #define CMASK(P0,P1,t) do{int jb_=(t)-(NT-4); if(jb_>=0)cmask(P0,P1,jb_,qrel,hi);}while(0)
  #define ENDW(tt) do{ if((tt)+3<NT){WAIT_BAR(3);} else if((tt)+2<NT){WAIT_BAR(2);} else {WAIT_BAR(0);} }while(0)
  for(;t+1<NT;t+=2){
    STEP(pB0,pB1,pA0,pA1,t,(t+3<NT),(t+1<NT),(t+1<NT));       ENDW(t);   RESC(); ROT();
    STEP(pA0,pA1,pB0,pB1,t+1,(t+4<NT),(t+2<NT),(t+2<NT));     ENDW(t+1); RESC(); ROT();
  }
  STEP(pB0,pB1,pA0,pA1,NT-1,false,false,false); RESC();
  { float sacc=pB0[0]+pB0[1]; _Pragma("unroll") for(int r=2;r<16;++r)sacc+=pB0[r]; _Pragma("unroll") for(int r=0;r<16;++r)sacc+=pB1[r]; l_reg+=sacc;
    pw0=(u32x4){PKW(pB0,0),PKW(pB0,2),PKW(pB0,4),PKW(pB0,6)};pw1=(u32x4){PKW(pB0,8),PKW(pB0,10),PKW(pB0,12),PKW(pB0,14)};pw2=(u32x4){PKW(pB1,0),PKW(pB1,2),PKW(pB1,4),PKW(pB1,6)};pw3=(u32x4){PKW(pB1,8),PKW(pB1,10),PKW(pB1,12),PKW(pB1,14)};
    SBAR(); pv(o,vb0+2*sl_cur,PAF(0),PAF(1),PAF(2),PAF(3)); }
  asm volatile("s_waitcnt lgkmcnt(0)\n\ts_barrier":::"memory");
  if(qb_next>=0) DMA_HEAD(Qh+(long)(qb_next*QB+wid*QBLK)*PQ);
  #undef PKW
  #undef PAF
  #undef VFR
  #undef PIN
  #undef MX3
  #undef GAPA
  #undef GAPB
  #undef EX
  #undef VRD
  #undef VRD2
  #undef KEEPF
  #undef KEEPV
  #undef KRD
  #undef STEP
  #undef ENDW
  {auto rr=__builtin_amdgcn_permlane32_swap(__float_as_uint(l_reg),__float_as_uint(l_reg),false,false);l_reg=__uint_as_float(rr[0])+__uint_as_float(rr[1]);}
  if(hi==0)wsf[32+r32]=l_reg;asm volatile("s_waitcnt lgkmcnt(0)":::"memory");
  float rli[16];
  #pragma unroll
  for(int r=0;r<16;++r)rli[r]=__builtin_amdgcn_rcpf(wsf[32+crow(r,hi)]);
  bf16*Ow=Oh+(long)(q0+wid*QBLK)*PO;
  { bf16*stg=(bf16*)(shm+LDS_OST)+wid*2048;
    #pragma unroll
    for(int hf=0;hf<2;++hf){
    #pragma unroll
    for(int r=0;r<16;++r){const int orow=crow(r,hi);
      #pragma unroll
      for(int d0=0;d0<2;++d0)stg[orow*64+d0*32+r32]=__float2bfloat16(o[2*hf+d0][r]*rli[r]);}
    asm volatile("s_waitcnt lgkmcnt(0)":::"memory");
    #pragma unroll
    for(int i=0;i<4;++i){const int row=i*8+(lane>>3),ch=lane&7; const u32x4 v=*(const u32x4*)(stg+row*64+ch*8); ATTN_STORE16(Ow+(long)row*PO+hf*64+ch*8,v);}
    asm volatile("s_waitcnt lgkmcnt(0)":::"memory"); } }
  asm volatile("s_waitcnt lgkmcnt(0)":::"memory");
  #undef DMA_K
  #undef DMA_HEAD
  #undef QLD
  #undef DMA_V
  #undef CMASK
  #undef START
  #undef RESC
  #undef ROT
}
constexpr int ATTN_LDS_BYTES=LDS_BYTES;
#undef SBAR
#undef WAIT_BAR
}
#define ST8(ptr, w) do { *(ptr) = (w); asm volatile("s_nop 1" :: "v"((w).x), "v"((w).y) : "memory"); } while (0)
#define ST4(ptr, w) do { *(ptr) = (w); asm volatile("s_nop 1" :: "v"(w) : "memory"); } while (0)
constexpr int NWAVES = 8;
constexpr int RING_OFF = 0, RING_BYTES = 131072;
static_assert(attn128::ATTN_LDS_BYTES <= RING_BYTES, "the attention unit's LDS image fits the ring region");
constexpr int LDSCTL_OFF = RING_BYTES, MISC_OFF = LDSCTL_OFF;
constexpr int TAB_OFF = LDSCTL_OFF + 512;
constexpr int EB_OFF = LDSCTL_OFF + 2048;
constexpr int LCNT_OFF = LDSCTL_OFF + 2304;
constexpr int TOKS_OFF = LDSCTL_OFF + 4096, TOKS_UNITS = 6;
constexpr int CW_MOEC = 70000;
constexpr int LDS_BYTES = 147456;
constexpr int CW_BAR = 4096;
constexpr int NPHASE = 18;

#define XB_TMO      128
#define XB_XCNT(j)  (256  + 64 * (j))
#define XB_XSUB(j)  (1280 + 64 * (j))
#define XB_XGEN(j)  (2304 + 64 * (j))
#define XB_TOP      3328
#define XB_TOPGEN   3392
#define XCD_BAR_WORDS 3456
#define XB_SPIN_CAP (1u << 18)

__device__ __forceinline__ unsigned xb_ld(unsigned* p)              { return __hip_atomic_load(p, __ATOMIC_RELAXED, __HIP_MEMORY_SCOPE_AGENT); }
__device__ __forceinline__ unsigned xb_add(unsigned* p, unsigned v) { return __hip_atomic_fetch_add(p, v, __ATOMIC_RELAXED, __HIP_MEMORY_SCOPE_AGENT); }
__device__ __forceinline__ unsigned xb_xcc_id() { return (unsigned)__builtin_amdgcn_s_getreg((3 << 11) | 20) & 0xFu; }
#define XB_SPIN(cond, bar) do { unsigned _sp = 0; while (cond) { __builtin_amdgcn_s_sleep(1); \
    if ((++_sp & 255u) == 0u) { if (xb_ld(&(bar)[XB_TMO])) break; if (_sp > XB_SPIN_CAP) { atomicAdd(&(bar)[XB_TMO], 1u); break; } } } } while (0)

struct XcdBarrier {
    unsigned* bar; unsigned x;
    volatile LAS unsigned* st;
};

__device__ __forceinline__ XcdBarrier xcd_barrier_post(unsigned* bar, volatile LAS unsigned* st) {
    XcdBarrier b; b.bar = bar; b.x = xb_xcc_id(); b.st = st;
    if (threadIdx.x == 0) (void)xb_add(&bar[XB_XCNT(b.x)], 1u);
    return b;
}
__device__ __forceinline__ void xcd_barrier_complete(unsigned* bar, unsigned x, unsigned& nloc, unsigned& nx) {
    const unsigned G = gridDim.x * gridDim.y * gridDim.z;
    unsigned sum, cnt, mine, sp = 0u;
    for (;;) {
        sum = 0u; cnt = 0u; mine = 0u;
#pragma unroll
        for (unsigned j = 0; j < 16; ++j) { const unsigned c = xb_ld(&bar[XB_XCNT(j)]); sum += c; cnt += (c > 0u) ? 1u : 0u; mine = (j == x) ? c : mine; }
        if (sum == G) break;
        __builtin_amdgcn_s_sleep(1);
        if ((++sp & 255u) == 0u) { if (xb_ld(&bar[XB_TMO])) break; if (sp > XB_SPIN_CAP) { atomicAdd(&bar[XB_TMO], 1u); break; } }
    }
    nloc = mine > 0u ? mine : 1u; nx = cnt > 0u ? cnt : 1u;
}

__device__ __forceinline__ void xcd_barrier(const XcdBarrier& b) {
    asm volatile("s_waitcnt vmcnt(0)" ::: "memory");
    __syncthreads();
    if (threadIdx.x == 0) {
        unsigned* bar = b.bar;
        __builtin_amdgcn_s_waitcnt(0);
        unsigned nloc = b.st[0], nx = b.st[1];
        if (nloc == 0u) { xcd_barrier_complete(bar, b.x, nloc, nx); b.st[0] = nloc; b.st[1] = nx; }
        const unsigned old = xb_add(&bar[XB_XSUB(b.x)], 1u);
        const unsigned gen = old / nloc;
        if (old + 1u == (gen + 1u) * nloc) {
            __builtin_amdgcn_fence(__ATOMIC_RELEASE, "agent");
            asm volatile("s_waitcnt vmcnt(0)" ::: "memory");
            const unsigned og = xb_add(&bar[XB_TOP], 1u);
            const unsigned tg = og / nx;
            if (og + 1u == (tg + 1u) * nx) xb_add(&bar[XB_TOPGEN], 1u);
            else XB_SPIN(xb_ld(&bar[XB_TOPGEN]) == tg, bar);
            __builtin_amdgcn_fence(__ATOMIC_ACQUIRE, "agent");
            xb_add(&bar[XB_XGEN(b.x)], 1u);
            asm volatile("s_waitcnt vmcnt(0)" ::: "memory");
        } else {
            XB_SPIN(xb_ld(&bar[XB_XGEN(b.x)]) == gen, bar);
            __builtin_amdgcn_fence(__ATOMIC_ACQUIRE, "agent");
            asm volatile("s_waitcnt vmcnt(0)" ::: "memory");
        }
    }
    __syncthreads();
}


struct Frame {
    LAS unsigned char* lds; volatile LAS unsigned* MISC; gu32* ctl;
    int tid, lane, wave, vcu, G;
    const float *x, *c, *w_ada, *b_ada, *w_in, *w_out, *lq1, *lk1, *lq2, *lk2, *subln, *ln_mix_g, *ln_mix_b, *ln_ffn_g, *ln_ffn_b, *router_w, *router_b, *w_gate, *w_up, *w_down;
    float* out; unsigned char* ws;
    float* mod; float* rot; int* tok_e; float* tok_g; int* tok_slot; int* lists; bf16* Wbf;
    bf16 *S1, *S3, *PROJ, *YP, *HE, *MIXED;
};

__device__ __forceinline__ void transpose_item(const float* W, int ldw, int k0, int n0, bf16* WT, int Kdst, int drow0, LAS float* scr, int lane) {
    f32x4 t[8];
#pragma unroll
    for (int i = 0; i < 8; ++i) t[i] = *(const GAS f32x4*)(W + (size_t)(k0 + 8 * i + (lane >> 3)) * ldw + n0 + 4 * (lane & 7));
#pragma unroll
    for (int i = 0; i < 8; ++i) *(LAS f32x4*)(scr + (8 * i + (lane >> 3)) * 36 + 4 * (lane & 7)) = t[i];
    LDS_WAIT(); asm volatile("" ::: "memory");
    const int c = lane & 7;
#pragma unroll
    for (int j = 0; j < 4; ++j) { const int n = (lane >> 3) + 8 * j; const LAS float* s = scr + (8 * c) * 36 + n;
        u32x4 o; o.x = pk2(s[0 * 36], s[1 * 36]); o.y = pk2(s[2 * 36], s[3 * 36]); o.z = pk2(s[4 * 36], s[5 * 36]); o.w = pk2(s[6 * 36], s[7 * 36]);
        *(GAS u32x4*)(WT + (size_t)(drow0 + n) * Kdst + k0 + 8 * c) = o; }
    LDS_WAIT(); asm volatile("" ::: "memory");
}
constexpr int IT_IN = 16 * 112, IT_OUT = 16 * 32, IT_E = 256, IT_LAYER = IT_IN + IT_OUT + 3 * 16 * IT_E;
__device__ __forceinline__ void p0_weight_item(const Frame& F, int it, LAS float* scr) {
    const int l = it / IT_LAYER; int r = it - l * IT_LAYER; bf16* wl = F.Wbf + (size_t)l * WL_STRIDE;
    if (r < IT_IN) { const int kb = r / 112, c0 = (r % 112) * 32; int drow = c0;
        if (c0 < 1024) drow = (c0 & ~255) + ((c0 >> 5) & 1) * 128 + ((c0 >> 6) & 3) * 32;
        transpose_item(F.w_in + (size_t)l * DM * INW, INW, kb * 64, c0, wl + WL_IN, DM, drow, scr, F.lane); return; }
    r -= IT_IN;
    if (r < IT_OUT) { const int kb = r / 32, c0 = (r % 32) * 32; transpose_item(F.w_out + (size_t)l * DM * DM, DM, kb * 64, c0, wl + WL_OUT, DM, c0, scr, F.lane); return; }
    r -= IT_OUT;
    const int which = r / (16 * IT_E), rr = r % (16 * IT_E), e = rr / IT_E, q = rr % IT_E;
    if (which < 2) { const int kb = q / 16, c0 = (q % 16) * 32; const float* W = (which == 0 ? F.w_gate : F.w_up) + (size_t)(l * NE + e) * DM * DE;
        transpose_item(W, DE, kb * 64, c0, wl + WL_GU, DM, e * 1024 + (c0 >> 7) * 256 + which * 128 + (c0 & 127), scr, F.lane); }
    else { const int kb = q / 32, c0 = (q % 32) * 32; transpose_item(F.w_down + (size_t)(l * NE + e) * DE * DM, DM, kb * 64, c0, wl + WL_D, DE, e * 1024 + c0, scr, F.lane); }
}

#ifndef DEFER_W1
#define DEFER_W1 0
#endif
#ifndef W1_CAP1
#define W1_CAP1 4
#endif
#ifndef W1_CAP2
#define W1_CAP2 2
#endif
__device__ __forceinline__ void deferred_weights(Frame& F, int nwg, int stage) {
    LAS float* scr = (LAS float*)(F.lds + RING_OFF + F.wave * 9216);
    const int rem = nwg % F.G, I = rem ? F.G - rem : 0, slots = I * NWAVES, base1 = slots * W1_CAP1, base2 = base1 + slots * W1_CAP2;
    if (stage < 2) { if (!rem || (int)blockIdx.x < rem) return;
        const int r = ((int)blockIdx.x - rem) * NWAVES + F.wave, cap = stage == 0 ? W1_CAP1 : W1_CAP2, base = stage == 0 ? 0 : base1;
        for (int k = 0; k < cap; ++k) { const int idx = base + r + k * slots; if (idx < IT_LAYER) p0_weight_item(F, IT_LAYER + idx, scr); }
    } else { for (int idx = base2 + F.vcu * NWAVES + F.wave; idx < IT_LAYER; idx += F.G * NWAVES) p0_weight_item(F, IT_LAYER + idx, scr); }
}
__device__ __forceinline__ void ph_prologue(Frame& F) {
    LAS float* scr = (LAS float*)(F.lds + RING_OFF + F.wave * 9216);
    LAS float* cond = (LAS float*)(F.lds + RING_OFF + 73728);
    LAS float* part = (LAS float*)(F.lds + RING_OFF + 73728 + 32768);
    if ((int)blockIdx.x < 192) {
        { float cv[16];
#pragma unroll
          for (int j = 0; j < 16; ++j) cv[j] = F.c[F.tid + 512 * j];
#pragma unroll
          for (int j = 0; j < 16; ++j) cond[F.tid + 512 * j] = cv[j] / (1.f + expf(-cv[j])); }
        __syncthreads();
        for (int item = blockIdx.x; item < 192; item += F.G) {
            const int l = item / 96, j0 = (item % 96) * 64;
            float acc[8];
#pragma unroll
            for (int b = 0; b < 8; ++b) acc[b] = 0.f;
            const float* w = F.w_ada + (size_t)l * DM * MODW + (size_t)(F.wave * 128) * MODW + j0 + F.lane;
#pragma unroll 4
            for (int k = 0; k < 128; ++k) { const float wv = w[(size_t)k * MODW];
#pragma unroll
                for (int b = 0; b < 8; ++b) acc[b] += cond[b * 1024 + F.wave * 128 + k] * wv; }
#pragma unroll
            for (int b = 0; b < 8; ++b) part[(F.wave * 8 + b) * 64 + F.lane] = acc[b];
            __syncthreads();
            { const int b = F.tid >> 6, ln = F.tid & 63; float s = 0.f;
#pragma unroll
                for (int w8 = 0; w8 < 8; ++w8) s += part[(w8 * 8 + b) * 64 + ln];
                const float mv = s + F.b_ada[l * MODW + j0 + ln]; ST4(&F.mod[(size_t)(l * 8 + b) * MODW + j0 + ln], mv); }
            __syncthreads();
        }
    }
    if ((int)blockIdx.x == F.G - 1 && F.tid < 2) { const int l = F.tid; float s1 = 0.f, s2 = 0.f;
        for (int i = 0; i < 64; ++i) { s1 += F.lq1[l * 64 + i] * F.lk1[l * 64 + i]; s2 += F.lq2[l * 64 + i] * F.lk2[l * 64 + i]; }
        const float li = 0.8f - 0.6f * expf(-0.3f * (float)l);
        F.mod[2 * 8 * MODW + l] = expf(s1) - expf(s2) + li; F.mod[2 * 8 * MODW + 2 + l] = li; }
    if ((int)blockIdx.x == F.G - 2) {
        float* dt = F.mod + 2 * 8 * MODW + 16;
        for (int i = F.tid; i < 1024; i += NWAVES * 64) { const int hh = i >> 7, pp = i & 127; const double gm = 1.0 - exp2(-5.0 - (double)hh);
            dt[i] = (float)(0.125 * pow(gm, (double)(pp - 127))); dt[1024 + i] = (float)pow(gm, (double)(127 - pp)); if (pp == 0) dt[2048 + hh] = (float)pow(gm, 128.0); }
    }
    for (int idx = blockIdx.x * (NWAVES * 64) + F.tid; idx < 4096 * 32; idx += F.G * NWAVES * 64) { const int pos = idx >> 5, i = idx & 31;
        const double inv = pow(10000.0, -(double)(2 * i) / 64.0), a = (double)pos * inv; F.rot[2 * idx] = (float)cos(a); F.rot[2 * idx + 1] = (float)sin(a); }
    const int gw = F.vcu * NWAVES + F.wave, NGW = F.G * NWAVES;
    for (int it = gw; it < (DEFER_W1 ? 1 : 2) * IT_LAYER; it += NGW) p0_weight_item(F, it, scr);
}
__device__ __forceinline__ void ln_mod_row(const float* xrow, const float* sh_, bf16* orow, int lane) {
    const GAS f32x4* xr = (const GAS f32x4*)xrow + lane;
    f32x4 v[4]; float s = 0.f;
#pragma unroll
    for (int j = 0; j < 4; ++j) { v[j] = xr[64 * j]; s += (v[j].x + v[j].y) + (v[j].z + v[j].w); }
    const float mean = wave_sum(s) * (1.f / DM); float s2 = 0.f;
#pragma unroll
    for (int j = 0; j < 4; ++j) { v[j] = v[j] - mean; s2 += (v[j].x * v[j].x + v[j].y * v[j].y) + (v[j].z * v[j].z + v[j].w * v[j].w); }
    const float rstd = 1.f / sqrtf(wave_sum(s2) * (1.f / DM) + LN_EPS);
    const GAS f32x4* sh = (const GAS f32x4*)sh_ + lane; const GAS f32x4* sc = sh + 256; GAS u32x2* o = (GAS u32x2*)orow + lane;
#pragma unroll
    for (int j = 0; j < 4; ++j) { const f32x4 a = sh[64 * j], m = sc[64 * j]; const f32x4 r = v[j] * rstd * (m + 1.f) + a; u32x2 w; w.x = pk2(r.x, r.y); w.y = pk2(r.z, r.w); ST8(&o[64 * j], w); }
}
__device__ __forceinline__ void ln_mod_regs(f32x4 (&v)[4], const float* sh_, bf16* orow, int lane) {
    float s = 0.f;
#pragma unroll
    for (int j = 0; j < 4; ++j) s += (v[j].x + v[j].y) + (v[j].z + v[j].w);
    const float mean = wave_sum(s) * (1.f / DM); float s2 = 0.f;
#pragma unroll
    for (int j = 0; j < 4; ++j) { v[j] = v[j] - mean; s2 += (v[j].x * v[j].x + v[j].y * v[j].y) + (v[j].z * v[j].z + v[j].w * v[j].w); }
    const float rstd = 1.f / sqrtf(wave_sum(s2) * (1.f / DM) + LN_EPS);
    const GAS f32x4* sh = (const GAS f32x4*)sh_ + lane; const GAS f32x4* sc = sh + 256; GAS u32x2* o = (GAS u32x2*)orow + lane;
    f32x4 a[4], mm[4];
#pragma unroll
    for (int j = 0; j < 4; ++j) { a[j] = sh[64 * j]; mm[j] = sc[64 * j]; }
#pragma unroll
    for (int j = 0; j < 4; ++j) { const f32x4 r = v[j] * rstd * (mm[j] + 1.f) + a[j]; u32x2 w; w.x = pk2(r.x, r.y); w.y = pk2(r.z, r.w); ST8(&o[64 * j], w); }
}
__device__ __forceinline__ void ph_ln0(Frame& F) {
    const int gw = F.vcu * NWAVES + F.wave, NGW = F.G * NWAVES;
#pragma unroll 1
    for (int m = gw; m < T; m += 2 * NGW) { int lane = F.lane; asm volatile("" : "+v"(lane));
        const int m2 = m + NGW;
        const GAS f32x4* xa = (const GAS f32x4*)(F.x + (size_t)m * DM) + lane; const GAS f32x4* xb = (const GAS f32x4*)(F.x + (size_t)m2 * DM) + lane;
        f32x4 va[4], vb[4];
#pragma unroll
        for (int j = 0; j < 4; ++j) { va[j] = xa[64 * j]; vb[j] = xb[64 * j]; }
        ln_mod_regs(va, F.mod + (size_t)(m / SEQ) * MODW, F.S1 + (size_t)m * DM, lane);
        ln_mod_regs(vb, F.mod + (size_t)(m2 / SEQ) * MODW, F.S1 + (size_t)m2 * DM, lane); }
}
__device__ __forceinline__ float sane_c(float v) { return (fabsf(v) < 1e4f) ? v : 0.f; }
__device__ __forceinline__ void ph_combine(Frame& F, int l) {
    const int gw = F.vcu * NWAVES + F.wave, NGW = F.G * NWAVES, lane = F.lane;
    const float lam = F.mod[2 * 8 * MODW + l], li = F.mod[2 * 8 * MODW + 2 + l];
#if ATTN128
    const int h = lane >> 4, q = lane & 15, vh0 = (h * 2 + 0) * 2, vh1 = (h * 2 + 1) * 2, d = 8 * q;
#else
    const int h = lane >> 4, q = lane & 15, vh0 = (h * 2 + 0) * 2 + (q >> 3), vh1 = (h * 2 + 1) * 2 + (q >> 3), d = 8 * (q & 7);
#endif
    const f32x4 g0 = *(const f32x4*)(F.subln + l * 128 + 8 * q), g1 = *(const f32x4*)(F.subln + l * 128 + 8 * q + 4);
#pragma unroll 1
    for (int m0 = gw; m0 < T; m0 += 2 * NGW) {
        u32x4 av[2], bv[2];
#pragma unroll
        for (int t = 0; t < 2; ++t) { const int m = m0 + t * NGW; av[t] = *(const GAS u32x4*)(F.S3 + (size_t)m * DM + vh0 * 64 + d); bv[t] = *(const GAS u32x4*)(F.S3 + (size_t)m * DM + vh1 * 64 + d); }
#pragma unroll
        for (int t = 0; t < 2; ++t) { const int m = m0 + t * NGW; const u32x4 a = av[t], b = bv[t];
        float v[8];
        v[0] = __uint_as_float(a.x << 16) - lam * __uint_as_float(b.x << 16); v[1] = __uint_as_float(a.x & 0xffff0000u) - lam * __uint_as_float(b.x & 0xffff0000u);
        v[2] = __uint_as_float(a.y << 16) - lam * __uint_as_float(b.y << 16); v[3] = __uint_as_float(a.y & 0xffff0000u) - lam * __uint_as_float(b.y & 0xffff0000u);
        v[4] = __uint_as_float(a.z << 16) - lam * __uint_as_float(b.z << 16); v[5] = __uint_as_float(a.z & 0xffff0000u) - lam * __uint_as_float(b.z & 0xffff0000u);
        v[6] = __uint_as_float(a.w << 16) - lam * __uint_as_float(b.w << 16); v[7] = __uint_as_float(a.w & 0xffff0000u) - lam * __uint_as_float(b.w & 0xffff0000u);
#pragma unroll
        for (int i = 0; i < 8; ++i) v[i] = sane_c(v[i]);
        float ss = 0.f;
#pragma unroll
        for (int i = 0; i < 8; ++i) ss += v[i] * v[i];
        ss = row16_sum(ss);
        const float r = (1.f - li) / sqrtf(ss * (1.f / 128.f) + LN_EPS);
        u32x4 w; w.x = pk2(v[0] * r * g0.x, v[1] * r * g0.y); w.y = pk2(v[2] * r * g0.z, v[3] * r * g0.w); w.z = pk2(v[4] * r * g1.x, v[5] * r * g1.y); w.w = pk2(v[6] * r * g1.z, v[7] * r * g1.w);
        *(GAS u32x4*)(F.S1 + (size_t)m * DM + 512 + h * 128 + 8 * q) = w; }
    }
}
__device__ __forceinline__ f32x4 bf4(u32x2 m) { f32x4 r; r.x = __uint_as_float(m.x << 16); r.y = __uint_as_float(m.x & 0xffff0000u); r.z = __uint_as_float(m.y << 16); r.w = __uint_as_float(m.y & 0xffff0000u); return r; }
__device__ __forceinline__ float sane(float v, float lim) { return (fabsf(v) < lim) ? v : 0.f; }
__device__ __forceinline__ f32x4 sane4(f32x4 v, float lim) { v.x = sane(v.x, lim); v.y = sane(v.y, lim); v.z = sane(v.z, lim); v.w = sane(v.w, lim); return v; }
#ifndef X2_BF16
#define X2_BF16 1
#endif
struct PmRaw { f32x4 x[4]; u32x2 xb[4]; u32x2 m[4]; };
template <bool XBF>
__device__ __forceinline__ void pm_load(PmRaw& R, const void* xin, const bf16* MIXED, int row, int lane) {
    const GAS u32x2* mr = (const GAS u32x2*)(MIXED + (size_t)row * DM) + lane;
    if (XBF) { const GAS u32x2* xr = (const GAS u32x2*)((const bf16*)xin + (size_t)row * DM) + lane;
#pragma unroll
        for (int j = 0; j < 4; ++j) { R.xb[j] = xr[64 * j]; R.m[j] = mr[64 * j]; }
    } else { const GAS f32x4* xr = (const GAS f32x4*)((const float*)xin + (size_t)row * DM) + lane;
#pragma unroll
        for (int j = 0; j < 4; ++j) { R.x[j] = xr[64 * j]; R.m[j] = mr[64 * j]; } }
}
template <bool XBF>
__device__ __forceinline__ void pm_row(const PmRaw& R, const f32x4 (&g1)[4], const f32x4 (&lg)[4], const f32x4 (&lb)[4], const f32x4 (&sc2)[4], const f32x4 (&sh2)[4],
                                       bf16* X1, bf16* H, const LAS float* rwT, LAS float* lgs, int row, int r, int lane, bool norouter) {
    f32x4 v[4];
    float s = 0.f;
#pragma unroll
    for (int j = 0; j < 4; ++j) { v[j] = (XBF ? sane4(bf4(R.xb[j]), 1e4f) : R.x[j]) * ALPHA + g1[j] * sane4(bf4(R.m[j]), 1e4f); s += (v[j].x + v[j].y) + (v[j].z + v[j].w); }
    float mean = wave_sum(s) * (1.f / DM), s2 = 0.f;
#pragma unroll
    for (int j = 0; j < 4; ++j) { v[j] = v[j] - mean; s2 += (v[j].x * v[j].x + v[j].y * v[j].y) + (v[j].z * v[j].z + v[j].w * v[j].w); }
    float rstd = 1.f / sqrtf(wave_sum(s2) * (1.f / DM) + LN_EPS);
    GAS u32x2* xo = (GAS u32x2*)(X1 + (size_t)row * DM) + lane; s = 0.f;
#pragma unroll
    for (int j = 0; j < 4; ++j) { v[j] = v[j] * rstd * lg[j] + lb[j];
        u32x2 w; w.x = pk2(v[j].x, v[j].y); w.y = pk2(v[j].z, v[j].w); ST8(&xo[64 * j], w); s += (v[j].x + v[j].y) + (v[j].z + v[j].w); }
    mean = wave_sum(s) * (1.f / DM); s2 = 0.f;
#pragma unroll
    for (int j = 0; j < 4; ++j) { v[j] = v[j] - mean; s2 += (v[j].x * v[j].x + v[j].y * v[j].y) + (v[j].z * v[j].z + v[j].w * v[j].w); }
    rstd = 1.f / sqrtf(wave_sum(s2) * (1.f / DM) + LN_EPS);
    GAS u32x2* ho = (GAS u32x2*)(H + (size_t)row * DM) + lane;
#pragma unroll
    for (int j = 0; j < 4; ++j) { v[j] = v[j] * rstd * (sc2[j] + 1.f) + sh2[j]; u32x2 w; w.x = pk2(v[j].x, v[j].y); w.y = pk2(v[j].z, v[j].w); ST8(&ho[64 * j], w); }
    if (norouter) return;
    float a[16];
#pragma unroll
    for (int e = 0; e < 16; ++e) {
        float s0 = 0.f;
#pragma unroll
        for (int j = 0; j < 4; ++j) { const f32x4 w4 = *(const LAS f32x4*)(rwT + e * 1024 + 4 * lane + 256 * j); s0 += (v[j].x * w4.x + v[j].y * w4.y) + (v[j].z * w4.z + v[j].w * w4.w); }
        a[e] = s0;
    }
    const bool h5 = (lane & 32) != 0, h4 = (lane & 16) != 0, h3 = (lane & 8) != 0, h2 = (lane & 4) != 0;
    float c8[8], d4[4], f2[2];
#define PX32(x) ([&]() { auto rr_ = __builtin_amdgcn_permlane32_swap(__float_as_uint(x), __float_as_uint(x), false, false); return __uint_as_float(h5 ? rr_[0] : rr_[1]); }())
#define PX16(x) ([&]() { auto rr_ = __builtin_amdgcn_permlane16_swap(__float_as_uint(x), __float_as_uint(x), false, false); return __uint_as_float(h4 ? rr_[0] : rr_[1]); }())
#define PDPP(x, ctrl) __builtin_bit_cast(float, __builtin_amdgcn_update_dpp(0, __builtin_bit_cast(int, (x)), (ctrl), 0xf, 0xf, false))
#pragma unroll
    for (int i = 0; i < 8; ++i) { const float mine = h5 ? a[8 + i] : a[i], send = h5 ? a[i] : a[8 + i]; c8[i] = mine + PX32(send); }
#pragma unroll
    for (int i = 0; i < 4; ++i) { const float mine = h4 ? c8[4 + i] : c8[i], send = h4 ? c8[i] : c8[4 + i]; d4[i] = mine + PX16(send); }
#pragma unroll
    for (int i = 0; i < 2; ++i) { const float mine = h3 ? d4[2 + i] : d4[i], send = h3 ? d4[i] : d4[2 + i]; f2[i] = mine + PDPP(send, 0x128); }
    float gsum; { const float mine = h2 ? f2[1] : f2[0], send = h2 ? f2[0] : f2[1]; gsum = mine + PDPP(send, 0x141); }
    gsum += PDPP(gsum, 0x4E); gsum += PDPP(gsum, 0xB1);
#undef PX32
#undef PX16
#undef PDPP
    if ((lane & 3) == 0) lgs[r * 16 + (lane >> 2)] = gsum;
}
#ifndef DRY_SKIP
#define DRY_SKIP 0
#endif
template <bool XBF>
__device__ __forceinline__ void ph_postmix_t(Frame& F, int l, bool dry) {
    LAS float* rwT = (LAS float*)(F.lds + RING_OFF);
    LAS float* lgs = (LAS float*)(F.lds + RING_OFF + 65536) + F.wave * 256;
    LAS int* lcnt = (LAS int*)(F.lds + LCNT_OFF);
    const void* xin = (const void*)(l == 0 ? F.x : F.out); const float* modl     = F.mod + (size_t)l * 8 * MODW; int* cnt = (int*)F.ctl + CW_CNT + 64 * l;
    const float* lng = F.ln_mix_g + l * DM; const float* lnb = F.ln_mix_b + l * DM; const int lane = F.lane;
    const bool norouter = dry && (DRY_SKIP & 1);
    { f32x4 t4[8];
#pragma unroll
      for (int j = 0; j < 8; ++j) t4[j] = ((const GAS f32x4*)F.router_w)[F.tid + 512 * j];
#pragma unroll
      for (int j = 0; j < 8; ++j) { const int i4 = F.tid + 512 * j, k = i4 >> 2, e0 = (i4 & 3) * 4; rwT[(e0 + 0) * 1024 + k] = t4[j].x; rwT[(e0 + 1) * 1024 + k] = t4[j].y; rwT[(e0 + 2) * 1024 + k] = t4[j].z; rwT[(e0 + 3) * 1024 + k] = t4[j].w; } }
#pragma unroll 1
    for (int base = blockIdx.x * 128; base < T; base += F.G * 128) {
        if (F.tid < 16) lcnt[F.tid] = 0;
        __syncthreads();
        const int b = base / SEQ, wrow = base + F.wave * 16;
        f32x4 g1[4], lg[4], lb[4], sc2[4], sh2[4];
        { const GAS f32x4* g1p = (const GAS f32x4*)(modl + (size_t)b * MODW + 2 * DM) + lane; const GAS f32x4* lgp = (const GAS f32x4*)lng + lane; const GAS f32x4* lbp = (const GAS f32x4*)lnb + lane;
#pragma unroll
          for (int j = 0; j < 4; ++j) { g1[j] = g1p[64 * j]; sh2[j] = g1p[256 + 64 * j]; sc2[j] = g1p[512 + 64 * j]; lg[j] = lgp[64 * j]; lb[j] = lbp[64 * j]; } }
        PmRaw A, B, C;
        pm_load<XBF>(A, xin, F.MIXED, wrow, lane); pm_load<XBF>(B, xin, F.MIXED, wrow + 1, lane);
#pragma unroll 1
        for (int it = 0; it < 5; ++it) {
            const int r0 = 3 * it;
            pm_load<XBF>(C, xin, F.MIXED, wrow + r0 + 2, lane);
            pm_row<XBF>(A, g1, lg, lb, sc2, sh2, F.S3, F.S1, rwT, lgs, wrow + r0, r0, lane, norouter);
            pm_load<XBF>(A, xin, F.MIXED, wrow + r0 + 3, lane);
            pm_row<XBF>(B, g1, lg, lb, sc2, sh2, F.S3, F.S1, rwT, lgs, wrow + r0 + 1, r0 + 1, lane, norouter);
            if (it < 4) pm_load<XBF>(B, xin, F.MIXED, wrow + r0 + 4, lane);
            pm_row<XBF>(C, g1, lg, lb, sc2, sh2, F.S3, F.S1, rwT, lgs, wrow + r0 + 2, r0 + 2, lane, norouter);
        }
        pm_row<XBF>(A, g1, lg, lb, sc2, sh2, F.S3, F.S1, rwT, lgs, wrow + 15, 15, lane, norouter);
        LDS_WAIT(); asm volatile("" ::: "memory");
        int my_e1 = 0, my_e2 = 0, my_l1 = 0, my_l2 = 0;
        if (lane < 16) {
            float p[16];
#pragma unroll
            for (int q = 0; q < 4; ++q) { const f32x4 t = *(const LAS f32x4*)(lgs + lane * 16 + 4 * q); p[4 * q] = t.x; p[4 * q + 1] = t.y; p[4 * q + 2] = t.z; p[4 * q + 3] = t.w; }
            float mx = -INFINITY, sum = 0.f;
#pragma unroll
            for (int e = 0; e < 16; ++e) { p[e] += F.router_b[e]; mx = fmaxf(mx, p[e]); }
#pragma unroll
            for (int e = 0; e < 16; ++e) { p[e] = expf(p[e] - mx); sum += p[e]; }
            const float rs = 1.f / sum;
#pragma unroll
            for (int e = 0; e < 16; ++e) p[e] *= rs;
            int bg = 0; float bgs = -1.f;
#pragma unroll
            for (int g = 0; g < 4; ++g) { float m1 = p[4 * g]; int i1 = 0;
#pragma unroll
                for (int i = 1; i < 4; ++i) if (p[4 * g + i] > m1) { m1 = p[4 * g + i]; i1 = i; }
                float m2 = -1.f;
#pragma unroll
                for (int i = 0; i < 4; ++i) if (i != i1 && p[4 * g + i] > m2) m2 = p[4 * g + i];
                const float gs = m1 + m2; if (gs > bgs) { bgs = gs; bg = g; } }
            float q0 = 0.f, q1 = 0.f, q2 = 0.f, q3 = 0.f;
#pragma unroll
            for (int g = 0; g < 4; ++g) if (bg == g) { q0 = p[4 * g]; q1 = p[4 * g + 1]; q2 = p[4 * g + 2]; q3 = p[4 * g + 3]; }
            float m1 = q0; int i1 = 0; if (q1 > m1) { m1 = q1; i1 = 1; } if (q2 > m1) { m1 = q2; i1 = 2; } if (q3 > m1) { m1 = q3; i1 = 3; }
            float m2 = -1.f; int i2 = 0;
            if (i1 != 0 && q0 > m2) { m2 = q0; i2 = 0; } if (i1 != 1 && q1 > m2) { m2 = q1; i2 = 1; } if (i1 != 2 && q2 > m2) { m2 = q2; i2 = 2; } if (i1 != 3 && q3 > m2) { m2 = q3; i2 = 3; }
            my_e1 = bg * 4 + i1; my_e2 = bg * 4 + i2; const int row = wrow + lane; const float den = 1.f / (m1 + m2);
            my_l1 = __hip_atomic_fetch_add(lcnt + my_e1, 1, __ATOMIC_RELAXED, __HIP_MEMORY_SCOPE_WORKGROUP); my_l2 = __hip_atomic_fetch_add(lcnt + my_e2, 1, __ATOMIC_RELAXED, __HIP_MEMORY_SCOPE_WORKGROUP);
            const float gw1 = m1 * den, gw2 = m2 * den; ST4(&F.tok_e[2 * row], my_e1); ST4(&F.tok_e[2 * row + 1], my_e2); ST4(&F.tok_g[2 * row], gw1); ST4(&F.tok_g[2 * row + 1], gw2);
        }
        __syncthreads();
        if (F.tid < 16 && !dry) lcnt[16 + F.tid] = atomicAdd(cnt + F.tid, lcnt[F.tid]);
        __syncthreads();
        if (lane < 16 && !dry) { const int row = wrow + lane, s1 = lcnt[16 + my_e1] + my_l1, s2 = lcnt[16 + my_e2] + my_l2;
            ST4(&F.tok_slot[2 * row], s1); ST4(&F.tok_slot[2 * row + 1], s2); ST4(&F.lists[(size_t)my_e1 * T + s1], row); ST4(&F.lists[(size_t)my_e2 * T + s2], row); }
        __syncthreads();
    }
}
__device__ __forceinline__ void ph_postmix(Frame& F, int l, bool dry = false) { if (X2_BF16 && l > 0) ph_postmix_t<true>(F, l, dry); else ph_postmix_t<false>(F, l, dry); }
__device__ __forceinline__ void moe_table(Frame& F, int l) {
    LAS int* tab = (LAS int*)(F.lds + TAB_OFF); LAS int* eb = (LAS int*)(F.lds + EB_OFF); const int* cnt = (const int*)F.ctl + CW_CNT + 64 * l;
    __syncthreads();
    if (F.tid < 272 || F.tid == 511) {
        int pref = 0, mine = -1;
#pragma unroll
        for (int e = 0; e < 16; ++e) { const int n = __hip_atomic_load(cnt + e, RLX_AGENT), nt = (n + 255) >> 8; if (F.tid < 272 && F.tid >= pref && F.tid < pref + nt) mine = e | ((F.tid - pref) << 8);
            if (F.tid == 511) eb[e] = pref * 256; pref += nt; }
        if (F.tid < 272) tab[1 + F.tid] = mine;
        if (F.tid == 511) tab[0] = pref;
    }
    __syncthreads();
}
struct PfRaw { u32x2 x[4], y0[4], y1[4]; };
__device__ __forceinline__ void pf_load(PfRaw& R, const bf16* X1, const bf16* YP, int row, size_t r0, size_t r1, int lane) {
    const GAS u32x2* xr = (const GAS u32x2*)(X1 + (size_t)row * DM) + lane; const GAS u32x2* y0 = (const GAS u32x2*)(YP + r0 * DM) + lane; const GAS u32x2* y1 = (const GAS u32x2*)(YP + r1 * DM) + lane;
#pragma unroll
    for (int j = 0; j < 4; ++j) { R.x[j] = xr[64 * j]; R.y0[j] = y0[64 * j]; R.y1[j] = y1[64 * j]; }
}
template <bool NEXT>
__device__ __forceinline__ void pf_row(const PfRaw& R, float w0, float w1, const f32x4 (&g2)[4], const f32x4 (&lg)[4], const f32x4 (&lb)[4], const f32x4 (&sh)[4], const f32x4 (&sc)[4], float* out, bf16* X2b, bf16* H, int row, int lane, bool store_h) {
    f32x4 v[4]; float s = 0.f;
#pragma unroll
    for (int j = 0; j < 4; ++j) { v[j] = sane4(bf4(R.x[j]), 1e4f) * ALPHA + g2[j] * sane4(bf4(R.y0[j]) * w0 + bf4(R.y1[j]) * w1, 1e4f);
        s += (v[j].x + v[j].y) + (v[j].z + v[j].w); }
    float mean = wave_sum(s) * (1.f / DM), s2 = 0.f;
#pragma unroll
    for (int j = 0; j < 4; ++j) { v[j] = v[j] - mean; s2 += (v[j].x * v[j].x + v[j].y * v[j].y) + (v[j].z * v[j].z + v[j].w * v[j].w); }
    float rstd = 1.f / sqrtf(wave_sum(s2) * (1.f / DM) + LN_EPS);
    GAS f32x4* o = (GAS f32x4*)(out + (size_t)row * DM) + lane; s = 0.f;
    GAS u32x2* ob = (GAS u32x2*)(X2b + (size_t)row * DM) + lane;
#pragma unroll
    for (int j = 0; j < 4; ++j) { v[j] = v[j] * rstd * lg[j] + lb[j];
        if (X2_BF16 && store_h) { u32x2 w; w.x = pk2(v[j].x, v[j].y); w.y = pk2(v[j].z, v[j].w); ST8(&ob[64 * j], w); } else o[64 * j] = v[j];
        s += (v[j].x + v[j].y) + (v[j].z + v[j].w); }
    if (NEXT) {
        mean = wave_sum(s) * (1.f / DM); s2 = 0.f;
#pragma unroll
        for (int j = 0; j < 4; ++j) { v[j] = v[j] - mean; s2 += (v[j].x * v[j].x + v[j].y * v[j].y) + (v[j].z * v[j].z + v[j].w * v[j].w); }
        rstd = 1.f / sqrtf(wave_sum(s2) * (1.f / DM) + LN_EPS);
        GAS u32x2* ho = (GAS u32x2*)(H + (size_t)row * DM) + lane;
#pragma unroll
        for (int j = 0; j < 4; ++j) { const f32x4 r = v[j] * rstd * (sc[j] + 1.f) + sh[j]; u32x2 w; w.x = pk2(r.x, r.y); w.y = pk2(r.z, r.w); if (store_h) ST8(&ho[64 * j], w); }
    }
}
template <bool NEXT>
__device__ __forceinline__ void ph_postffn_t(Frame& F, int l) {
    const LAS int* eb = (const LAS int*)(F.lds + EB_OFF); const float* modl = F.mod + (size_t)l * 8 * MODW; const float* modn = F.mod + (size_t)(l + 1 < DEPTH ? l + 1 : l) * 8 * MODW;
    const float* lng = F.ln_ffn_g + l * DM; const float* lnb = F.ln_ffn_b + l * DM; const int lane = F.lane;
#pragma unroll 1
    for (int base = (F.vcu * NWAVES + F.wave) * 16; base < T; base += F.G * NWAVES * 16) {
        const int b = base / SEQ;
        const int mrow = base + (lane & 15);
        const int e0 = F.tok_e[2 * mrow], e1 = F.tok_e[2 * mrow + 1]; const float mw0 = F.tok_g[2 * mrow], mw1 = F.tok_g[2 * mrow + 1];
        const int mr0 = eb[e0] + F.tok_slot[2 * mrow], mr1 = eb[e1] + F.tok_slot[2 * mrow + 1];
        f32x4 g2[4], lg[4], lb[4], sh[4], sc[4];
        { const GAS f32x4* g2p = (const GAS f32x4*)(modl + (size_t)b * MODW + 5 * DM) + lane; const GAS f32x4* lgp = (const GAS f32x4*)lng + lane; const GAS f32x4* lbp = (const GAS f32x4*)lnb + lane;
          const GAS f32x4* shp = (const GAS f32x4*)(modn + (size_t)b * MODW) + lane;
#pragma unroll
          for (int j = 0; j < 4; ++j) { g2[j] = g2p[64 * j]; lg[j] = lgp[64 * j]; lb[j] = lbp[64 * j]; if (NEXT) { sh[j] = shp[64 * j]; sc[j] = shp[256 + 64 * j]; } else { sh[j] = (f32x4){0.f, 0.f, 0.f, 0.f}; sc[j] = sh[j]; } } }
        PfRaw A, B;
#define PF_LOAD2(R, r) pf_load(R, F.S3, F.YP, base + (r), (size_t)__builtin_amdgcn_readlane(mr0, (r)), (size_t)__builtin_amdgcn_readlane(mr1, (r)), lane)
#define PF_ROW2(R, r) pf_row<NEXT>(R, __builtin_bit_cast(float, __builtin_amdgcn_readlane(__builtin_bit_cast(int, mw0), (r))), __builtin_bit_cast(float, __builtin_amdgcn_readlane(__builtin_bit_cast(int, mw1), (r))), g2, lg, lb, sh, sc, F.out, (bf16*)F.out, F.S1, base + (r), lane, l + 1 < DEPTH)
        PF_LOAD2(A, 0);
#pragma unroll 1
        for (int it = 0; it < 8; ++it) {
            PF_LOAD2(B, 2 * it + 1);
            PF_ROW2(A, 2 * it);
            if (it < 7) PF_LOAD2(A, 2 * it + 2);
            PF_ROW2(B, 2 * it + 1);
        }
#undef PF_LOAD2
#undef PF_ROW2
    }
}
#ifndef PF_ALWAYS_NEXT
#define PF_ALWAYS_NEXT 1
#endif
__device__ __forceinline__ void ph_postffn(Frame& F, int l) { if (PF_ALWAYS_NEXT || l + 1 < DEPTH) ph_postffn_t<true>(F, l); else ph_postffn_t<false>(F, l); }

typedef __attribute__((address_space(4))) const unsigned char* kaptr_t;
__device__ __forceinline__ void frame_ptrs(Frame& F, kaptr_t ka) {
#define KA_IN(i) (*(const float* __attribute__((address_space(4))) const*)(ka + 8 * (i)))
    F.x = KA_IN(0); F.c = KA_IN(1); F.w_ada = KA_IN(2); F.b_ada = KA_IN(3); F.w_in = KA_IN(4); F.w_out = KA_IN(5); F.lq1 = KA_IN(6); F.lk1 = KA_IN(7); F.lq2 = KA_IN(8); F.lk2 = KA_IN(9);
    F.subln = KA_IN(10); F.ln_mix_g = KA_IN(11); F.ln_mix_b = KA_IN(12); F.ln_ffn_g = KA_IN(13); F.ln_ffn_b = KA_IN(14); F.router_w = KA_IN(15); F.router_b = KA_IN(16);
    F.w_gate = KA_IN(17); F.w_up = KA_IN(18); F.w_down = KA_IN(19);
    F.out = *(float* __attribute__((address_space(4))) const*)(ka + 160);
    unsigned char* ws = *(unsigned char* __attribute__((address_space(4))) const*)(ka + 168);
#undef KA_IN
    F.ws = ws; F.ctl = (gu32*)(ws + WS_CTL);
    F.mod = (float*)(ws + WS_MOD); F.rot = (float*)(ws + WS_ROT); F.tok_e = (int*)(ws + WS_TOK); F.tok_g = (float*)(ws + WS_TOK + 256 * 1024); F.tok_slot = (int*)(ws + WS_TOK + 512 * 1024);
    F.lists = (int*)(ws + WS_LIST); F.Wbf = (bf16*)(ws + WS_W);
    F.S1 = (bf16*)(ws + WS_S1); F.S3 = (bf16*)(ws + WS_S3); F.PROJ = (bf16*)(ws + WS_S2); F.YP = (bf16*)(ws + WS_YP); F.HE = (bf16*)(ws + WS_HE); F.MIXED = (bf16*)(ws + WS_MIXED);
}
struct Args { const float* in[20]; float* out; unsigned char* ws; int ph_lo, ph_hi, li, pad; };
__global__ void __launch_bounds__(NWAVES * 64, 2) mega(Args args) {
    extern __shared__ __attribute__((aligned(16))) unsigned char lds[];
    Frame F;
    F.lds = (LAS unsigned char*)lds; F.MISC = (volatile LAS unsigned*)(F.lds + MISC_OFF);
    F.tid = threadIdx.x; F.lane = F.tid & 63; F.wave = __builtin_amdgcn_readfirstlane(F.tid >> 6);
    F.G = gridDim.x; { const int bx = blockIdx.x; F.vcu = (F.G % 8 == 0) ? (bx % 8) * (F.G / 8) + bx / 8 : bx; }
    F.ctl = (gu32*)(args.ws + WS_CTL);
    for (int u = F.tid; u < (LDS_BYTES - LDSCTL_OFF) / 4; u += NWAVES * 64) ((LAS unsigned*)(F.lds + LDSCTL_OFF))[u] = 0u;
    __syncthreads();
    const int lo = args.ph_lo, hi = args.ph_hi;
    XcdBarrier bar; bar.bar = (unsigned*)(F.ctl + CW_BAR) + args.li * XCD_BAR_WORDS; bar.x = 0; bar.st = nullptr;
    if (hi - lo > 1) bar = xcd_barrier_post((unsigned*)(F.ctl + CW_BAR) + args.li * XCD_BAR_WORDS, F.MISC + 8);
#ifndef KIND_MASK
#define KIND_MASK 0x3ffu
#endif
#define KEN(k) ((KIND_MASK >> (k)) & 1u)
#ifndef REP_KIND
#define REP_KIND -1
#endif
#ifndef REP_N
#define REP_N 1
#endif
#define REPS(k) for (int rep_ = 0; rep_ < ((REP_KIND == (k)) ? REP_N : 1); ++rep_)
#define IN(k) (lo <= (k) && (k) < hi)
#define FRESH() do { int t_ = threadIdx.x; asm volatile("" : "+v"(t_)); F.tid = t_; F.lane = t_ & 63; kaptr_t ka_ = (kaptr_t)__builtin_amdgcn_kernarg_segment_ptr(); asm volatile("" : "+s"(ka_)); frame_ptrs(F, ka_); } while (0)
#ifndef BAR_REP
#define BAR_REP 1
#endif
#define SEAM(k) do { if (IN(k) && IN((k) + 1)) for (int br_ = 0; br_ < BAR_REP; ++br_) xcd_barrier(bar); } while (0)

    if (KEN(8) && IN(0)) REPS(8) { FRESH(); ph_prologue(F); } SEAM(0);
    if (KEN(9) && IN(1)) REPS(9) { FRESH(); ph_ln0(F); } SEAM(1);
    for (int l = 0; l < DEPTH; ++l) {
        const int pb = 2 + 8 * l;
#define wl (F.Wbf + (size_t)l * WL_STRIDE)
        if (KEN(0) && IN(pb + 0)) REPS(0) { FRESH();
            pg8::PlainSched S; S.init(T / 256, INW / 256, F.G, (int)blockIdx.x); S.Bt = wl + WL_IN; S.K = DM;
#ifndef ROT_EXP
#define ROT_EXP 0
#endif
            pg8::EpiInProj E{F.PROJ, F.rot, RET_FAST ? F.mod + 2 * 8 * MODW + 16 : nullptr, (ROT_EXP && rep_ > 0) ? F.S3 : nullptr};
            pg8::gemm_phase<pg8::EpiInProj, pg8::PlainSched, true>(F.lds + RING_OFF, (const char*)F.S1, DM, S, E);
        }
        SEAM(pb + 0);
        if (KEN(1) && IN(pb + 1)) REPS(1) { FRESH();
            if (RET_FAST) REPS(10) { const int bh = F.vcu >> 2, hh = bh & 7; ret::ret_unit(bh >> 3, hh, F.vcu & 3, F.PROJ, F.S1, F.mod[2 * 8 * MODW + 16 + 2048 + hh], F.lds + RING_OFF); }
#if ATTN128
            { const int bhc = F.vcu >> 2, b = bhc >> 3, hc = bhc & 7, h = hc >> 1, c = hc & 1, s = F.vcu & 3;
              const attn128::bf16* base = (const attn128::bf16*)(F.PROJ + (size_t)b * SEQ * INW);
#pragma unroll 1
              for (int i = 0; i < 4; ++i) { const int qb = i == 0 ? s : i == 1 ? 7 - s : i == 2 ? 8 + s : 15 - s;
                                    const int qn = i == 0 ? 7 - s : i == 1 ? 8 + s : i == 2 ? 15 - s : -1;
#ifdef ATTN_DRY
                  if (rep_ + 1 < REP_N) attn128::attn_unit<ATTN_THRL, ATTN_DRY>(qb, qn, i > 0, base + C_DQ + h * 128 + c * 64, base + C_DK + h * 128 + c * 64, base + C_DV + h * 128,
                                        (attn128::bf16*)(F.S3 + (size_t)b * SEQ * DM + hc * 128), (char*)lds + RING_OFF); else
#endif
                  attn128::attn_unit<ATTN_THRL>(qb, qn, i > 0, base + C_DQ + h * 128 + c * 64, base + C_DK + h * 128 + c * 64, base + C_DV + h * 128,
                                        (attn128::bf16*)(F.S3 + (size_t)b * SEQ * DM + hc * 128), (char*)lds + RING_OFF); } }
        }
#else
            const int pr = F.vcu >> 1, b = pr >> 4, vh = pr & 15, h = vh >> 2, c = (vh >> 1) & 1, vhalf = vh & 1;
            const attn_body::bf16* base = (const attn_body::bf16*)(F.PROJ + (size_t)b * SEQ * INW);
#pragma unroll 1
            for (int i = 0; i < 8; ++i) { const int s = 2 * (i >> 1) + (F.vcu & 1), qb = (i & 1) ? 15 - s : s;
                attn_body::attn_unit<8>(qb, base + C_DQ + h * 128 + c * 64, base + C_DK + h * 128 + c * 64, base + C_DV + h * 128 + vhalf * 64,
                                        (attn_body::bf16*)(F.S3 + (size_t)b * SEQ * DM + vh * 64), (char*)lds + RING_OFF); }
        }
#endif
        SEAM(pb + 1);
        if (KEN(2) && IN(pb + 2)) REPS(2) { FRESH(); ph_combine(F, l); }
        SEAM(pb + 2);
        if (KEN(3) && IN(pb + 3)) REPS(3) { FRESH();
            pg8::PlainSched S; S.init(T / 256, DM / 256, F.G, (int)blockIdx.x); S.Bt = wl + WL_OUT; S.K = DM;
            pg8::EpiPlain E{F.MIXED, DM};
            pg8::gemm_phase<pg8::EpiPlain, pg8::PlainSched, true>(F.lds + RING_OFF, (const char*)F.S1, DM, S, E);
        }
        SEAM(pb + 3);
        if (KEN(4) && IN(pb + 4)) REPS(4) { FRESH(); ph_postmix(F, l, rep_ > 0); }
        SEAM(pb + 4);
#ifndef MOE_MODE
#define MOE_MODE 1
#endif
#define MOE_SCHED(S_, mode_) pg8::MoeMk<mode_> S_; S_.nMt = ((const LAS int*)(F.lds + TAB_OFF))[0]; S_.n1 = S_.nMt * 4; S_.c = (int)blockIdx.x; S_.l = l; S_.ldsb = F.lds; S_.Wgu = wl + WL_GU; S_.Wd = wl + WL_D; S_.ctl = F.ctl;
#define MOE_STAGE_TOKS(S_) do { LAS int* toks_ = (LAS int*)(F.lds + TOKS_OFF); const int* cnt_ = (const int*)F.ctl + CW_CNT + 64 * l; \
            _Pragma("unroll 1") for (int i_ = 0; i_ < TOKS_UNITS; ++i_) { pg8::MUnit u_; if (!S_.next(i_, u_) || u_.kind != 0) break; const int pm_ = __builtin_amdgcn_readfirstlane(u_.pm); \
                if (F.tid < 256) { const int te_ = S_.tab()[1 + pm_], e_ = te_ & 255, s_ = (te_ >> 8) * 256 + F.tid, n_ = cnt_[e_]; toks_[i_ * 256 + F.tid] = F.lists[(size_t)e_ * T + (s_ < n_ ? s_ : 0)]; } } \
            __syncthreads(); } while (0)
        if (KEN(5) && IN(pb + 5)) REPS(5) {
            FRESH(); moe_table(F, l);
#if MOE_MODE == 0
            pg8::MoeSched S; S.init(((const LAS int*)(F.lds + TAB_OFF))[0], 4, F.G, (int)blockIdx.x); S.Bt = wl + WL_GU; S.K = DM; S.tab = (const LAS int*)(F.lds + TAB_OFF);
            S.cnt = (const int*)F.ctl + CW_CNT + 64 * l; S.lists = F.lists; S.gather = true;
            pg8::EpiGateUp E{F.HE};
            pg8::gemm_phase<pg8::EpiGateUp, pg8::MoeSched, true>(F.lds + RING_OFF, (const char*)F.S1, DM, S, E);
#else
            MOE_SCHED(S, MOE_MODE == 2 ? 2 : 0); MOE_STAGE_TOKS(S);
            pg8::EpiGateUpWT E0{F.HE}; pg8::EpiPlain E1{F.YP, DM};
            pg8::gemm_phase_mk<pg8::MoeMk<(MOE_MODE == 2 ? 2 : 0)>, pg8::EpiGateUpWT, pg8::EpiPlain>(F.lds + RING_OFF, (const char*)F.ws, S, E0, E1);
#endif
        }
#if MOE_MODE != 2
        SEAM(pb + 5);
#endif
        if (KEN(6) && IN(pb + 6)) REPS(6) {
#if MOE_MODE == 0
            FRESH(); moe_table(F, l);
            pg8::MoeSched S; S.init(((const LAS int*)(F.lds + TAB_OFF))[0], 4, F.G, (int)blockIdx.x); S.Bt = wl + WL_D; S.K = DE; S.tab = (const LAS int*)(F.lds + TAB_OFF);
            S.cnt = (const int*)F.ctl + CW_CNT + 64 * l; S.lists = F.lists; S.gather = false;
            pg8::EpiPlain E{F.YP, DM};
            pg8::gemm_phase<pg8::EpiPlain, pg8::MoeSched, true>(F.lds + RING_OFF, (const char*)F.HE, DE, S, E);
#elif MOE_MODE == 1
            FRESH(); moe_table(F, l);
            MOE_SCHED(S, 1);
            pg8::EpiGateUpWT E0{F.HE}; pg8::EpiPlain E1{F.YP, DM};
            pg8::gemm_phase_mk<pg8::MoeMk<1>, pg8::EpiGateUpWT, pg8::EpiPlain>(F.lds + RING_OFF, (const char*)F.ws, S, E0, E1);
#endif
        }
        SEAM(pb + 6);
        if (KEN(7) && IN(pb + 7)) REPS(7) { FRESH(); moe_table(F, l); if (DEFER_W1 && l == 0) { deferred_weights(F, 4 * ((const LAS int*)(F.lds + TAB_OFF))[0], 2); } ph_postffn(F, l); }
        SEAM(pb + 7);
#undef wl
#undef MOE_SCHED
#undef MOE_STAGE_TOKS
    }
#undef IN
#undef SEAM
}
#ifndef FAST_MASK
#define FAST_MASK 0x3ffffu
#endif
extern "C" void kernel_launch(void* const* d_in, const int* in_sizes, int n_in, void* d_out, int out_size, void* d_ws, size_t ws_size, hipStream_t stream) {
    static int grid = 0;
    if (grid == 0) {
        if (n_in != 20 || out_size != T * DM || ws_size < WS_END) { fprintf(stderr, "kernel_launch: unexpected shapes (n_in %d out %d ws %zu)\n", n_in, out_size, ws_size); grid = -1; return; }
        int dev = 0, cus = 0, per_cu = 0;
        if (hipGetDevice(&dev) != hipSuccess || hipDeviceGetAttribute(&cus, hipDeviceAttributeMultiprocessorCount, dev) != hipSuccess) { grid = -1; return; }
        if (hipFuncSetAttribute((const void*)mega, hipFuncAttributeMaxDynamicSharedMemorySize, LDS_BYTES) != hipSuccess) { fprintf(stderr, "kernel_launch: hipFuncSetAttribute failed\n"); grid = -1; return; }
        if (hipOccupancyMaxActiveBlocksPerMultiprocessor(&per_cu, (const void*)mega, NWAVES * 64, LDS_BYTES) != hipSuccess || per_cu < 1) fprintf(stderr, "kernel_launch: occupancy query says %d\n", per_cu);
        (void)hipGetLastError();
        grid = cus;
        if (grid != 256) { fprintf(stderr, "kernel_launch: built for 256 CUs, found %d\n", grid); grid = -1; return; }
    }
    if (grid < 0) return;
    const float* x = (const float*)d_in[0];
    const float* w_in = (const float*)d_in[4]; const float* w_out = (const float*)d_in[5];
    const float* subln = (const float*)d_in[10]; const float* ln_mix_g = (const float*)d_in[11]; const float* ln_mix_b = (const float*)d_in[12];
    const float* ln_ffn_g = (const float*)d_in[13]; const float* ln_ffn_b = (const float*)d_in[14]; const float* router_w = (const float*)d_in[15]; const float* router_b = (const float*)d_in[16];
    const float* w_gate = (const float*)d_in[17]; const float* w_up = (const float*)d_in[18]; const float* w_down = (const float*)d_in[19];
    unsigned char* ws = (unsigned char*)d_ws; float* out = (float*)d_out;
    float* mod = (float*)(ws + WS_MOD); float* rot = (float*)(ws + WS_ROT);
    int* tok_e = (int*)(ws + WS_TOK); float* tok_g = (float*)(ws + WS_TOK + 256 * 1024); int* tok_slot = (int*)(ws + WS_TOK + 512 * 1024); int* lists = (int*)(ws + WS_LIST);
    bf16* S1 = (bf16*)(ws + WS_S1); bf16* X1 = (bf16*)(ws + WS_S3); bf16* PROJ = (bf16*)(ws + WS_S2); bf16* YP = (bf16*)(ws + WS_YP); bf16* HE = (bf16*)(ws + WS_HE); bf16* MIXED = (bf16*)(ws + WS_MIXED);
    int* ctl = (int*)(ws + WS_CTL);
    (void)hipMemsetAsync(ws + WS_CTL, 0, 1 * MiB, stream);
    Args a{};
    for (int i = 0; i < 20; ++i) a.in[i] = (const float*)d_in[i];
    a.out = out; a.ws = ws;
    int li = 0, lo = -1;
    auto flush = [&](int hi) { if (lo >= 0) { a.ph_lo = lo; a.ph_hi = hi; a.li = li++; hipLaunchKernelGGL(mega, dim3(grid), dim3(NWAVES * 64), LDS_BYTES, stream, a); lo = -1; } };
    for (int p = 0; p < NPHASE; ++p) {
        const bool fast = (FAST_MASK >> p) & 1u;
        const int l = p < 2 ? 0 : (p - 2) / 8, k = p < 2 ? -1 : (p - 2) % 8;
        const float* modl = mod + (size_t)l * 8 * MODW; int* cnt = ctl + CW_CNT + 64 * l;
        if (fast) { if (lo < 0) lo = p; }
        else {
            flush(p);
            if (p == 0) { k_mod<<<dim3(MODW / 256, 2), 256, 0, stream>>>((const float*)d_in[1], (const float*)d_in[2], (const float*)d_in[3], (const float*)d_in[6], (const float*)d_in[7], (const float*)d_in[8], (const float*)d_in[9], mod);
                          k_rot<<<512, 256, 0, stream>>>(rot); }
            else if (p == 1) k_ln_mod<<<T / 4, 256, 0, stream>>>(x, mod, 0, S1);
            else if (k == 0) k_ngemm_inproj<<<dim3(INW / 64, T / 128), 256, 0, stream>>>(S1, w_in + (size_t)l * DM * INW, rot, PROJ);
            else if (k == 1) k_ndiff<<<dim3(SEQ / 64, 4, NB), 256, 0, stream>>>(PROJ, mod + 2 * 8 * MODW, subln, l, S1);
            else if (k == 2) {   }
            else if (k == 3) k_ngemm_plain<<<dim3(DM / 64, T / 128), 256, 0, stream>>>(S1, DM, w_out + (size_t)l * DM * DM, DM, DM, MIXED, DM);
            else if (k == 4) k_post_mix<<<T / 4, 256, 0, stream>>>(l == 0 ? x : out, MIXED, modl, ln_mix_g + l * DM, ln_mix_b + l * DM, router_w, router_b, X1, S1, tok_e, tok_g, tok_slot, lists, cnt);
            else if (k == 5) k_moe1<<<dim3(DE / 64, T / 128, NE), 256, 0, stream>>>(S1, w_gate + (size_t)l * NE * DM * DE, w_up + (size_t)l * NE * DM * DE, cnt, lists, HE);
            else if (k == 6) k_moe2<<<dim3(DM / 64, T / 128, NE), 256, 0, stream>>>(HE, w_down + (size_t)l * NE * DE * DM, cnt, YP);
            else if (k == 7) k_post_ffn<<<T / 4, 256, 0, stream>>>(X1, YP, modl, ln_ffn_g + l * DM, ln_ffn_b + l * DM, tok_e, tok_g, tok_slot, cnt, out, l + 1 < DEPTH ? mod + (size_t)(l + 1) * 8 * MODW : nullptr, S1);
        }
        if (!RET_FAST && k == 2) { flush(p + 1); k_nret<<<dim3(SEQ / 64, 8, NB), 256, 0, stream>>>(PROJ, S1); }
    }
    flush(NPHASE);
}
```

```cpp
#include <hip/hip_runtime.h>
#include <cstdio>
#include <cstdint>
#include <cmath>

typedef unsigned short bf16;
typedef float f32x4 __attribute__((ext_vector_type(4)));
typedef unsigned u32x4 __attribute__((ext_vector_type(4)));
typedef unsigned u32x2 __attribute__((ext_vector_type(2)));

constexpr int NB = 8, SEQ = 4096, DM = 1024, T = NB * SEQ, DEPTH = 2;
constexpr int INW = 3584, NE = 16, DE = 512;
constexpr int C_RQ = 0, C_RK = 512, C_RV = 1024, C_RG = 1536, C_DQ = 2048, C_DK = 2560, C_DV = 3072;
constexpr float ALPHA = 1.41421356237309515f;
constexpr float LN_EPS = 1e-5f;
constexpr float C2 = 0.125f * 1.4426950408889634f;
constexpr int MODW = 6 * DM;
constexpr int PAIR_ROWS = 69632;

constexpr size_t MiB = 1u << 20;
constexpr size_t WS_CTL = 0;
constexpr size_t WS_MOD = 1 * MiB;
constexpr size_t WS_ROT = 2 * MiB;
constexpr size_t WS_TOK = 3 * MiB;
constexpr size_t WS_LIST = 4 * MiB;
constexpr size_t WS_W = 8 * MiB;
constexpr size_t WS_S1 = 122 * MiB;
constexpr size_t WS_S3 = 186 * MiB;
constexpr size_t WS_S2 = 250 * MiB;
constexpr size_t WS_YP = WS_S2, WS_HE = WS_S2 + 136 * MiB, WS_MIXED = WS_HE;
constexpr size_t WS_END = 474 * MiB;
constexpr int CW_CNT = 64;

__device__ __forceinline__ float bf2f(bf16 v) { return __uint_as_float((unsigned)v << 16); }
__device__ __forceinline__ unsigned f2bf(float f) { unsigned u = __float_as_uint(f); return (u + 0x7fffu + ((u >> 16) & 1u)) >> 16; }
typedef float pk_f32x2_t __attribute__((ext_vector_type(2))); typedef __bf16 pk_bf16x2_t __attribute__((ext_vector_type(2)));
__device__ __forceinline__ unsigned pk2(float lo, float hi) { pk_f32x2_t v = {lo, hi}; pk_bf16x2_t b = __builtin_convertvector(v, pk_bf16x2_t); return __builtin_bit_cast(unsigned, b); }
__device__ __forceinline__ float dpp_add(float v, const int ctrl_tag) { return v; }
#define WS_DPP(v, ctrl) ((v) + __builtin_bit_cast(float, __builtin_amdgcn_update_dpp(0, __builtin_bit_cast(int, (v)), (ctrl), 0xf, 0xf, false)))
__device__ __forceinline__ float wave_sum(float v) {
    v = WS_DPP(v, 0xB1);
    v = WS_DPP(v, 0x4E);
    v = WS_DPP(v, 0x141);
    v = WS_DPP(v, 0x140);
    { auto rr = __builtin_amdgcn_permlane16_swap(__float_as_uint(v), __float_as_uint(v), false, false); v = __uint_as_float(rr[0]) + __uint_as_float(rr[1]); }
    { auto rr = __builtin_amdgcn_permlane32_swap(__float_as_uint(v), __float_as_uint(v), false, false); v = __uint_as_float(rr[0]) + __uint_as_float(rr[1]); }
    return v;
}
__device__ __forceinline__ float row16_sum(float v) {
    v = WS_DPP(v, 0xB1); v = WS_DPP(v, 0x4E); v = WS_DPP(v, 0x141); v = WS_DPP(v, 0x140); return v;
}
__device__ __forceinline__ float silu_f(float v) { return v / (1.f + __expf(-v)); }

__global__ void __launch_bounds__(256) k_mod(const float* c, const float* w_ada, const float* b_ada, const float* lq1, const float* lk1, const float* lq2, const float* lk2, float* mod) {
    __shared__ float cond[8][1024];
    const int l = blockIdx.y, j = blockIdx.x * 256 + threadIdx.x;
    for (int i = threadIdx.x; i < 8192; i += 256) { const float v = c[i]; cond[i >> 10][i & 1023] = v / (1.f + expf(-v)); }
    __syncthreads();
    float acc[8];
#pragma unroll
    for (int b = 0; b < 8; ++b) acc[b] = 0.f;
    const float* w = w_ada + (size_t)l * 1024 * MODW + j;
    for (int k = 0; k < 1024; ++k) { const float wv = w[(size_t)k * MODW];
#pragma unroll
        for (int b = 0; b < 8; ++b) acc[b] += cond[b][k] * wv; }
#pragma unroll
    for (int b = 0; b < 8; ++b) mod[(size_t)(l * 8 + b) * MODW + j] = acc[b] + b_ada[l * MODW + j];
    if (blockIdx.x == 0 && threadIdx.x == 0) {
        float s1 = 0.f, s2 = 0.f;
        for (int i = 0; i < 64; ++i) { s1 += lq1[l * 64 + i] * lk1[l * 64 + i]; s2 += lq2[l * 64 + i] * lk2[l * 64 + i]; }
        const float li = 0.8f - 0.6f * expf(-0.3f * (float)l);
        mod[2 * 8 * MODW + l] = expf(s1) - expf(s2) + li;
        mod[2 * 8 * MODW + 2 + l] = li;
    }
}
__global__ void k_rot(float* rot) {
    const int idx = blockIdx.x * 256 + threadIdx.x; if (idx >= 4096 * 32) return;
    const int pos = idx >> 5, i = idx & 31;
    const double inv = pow(10000.0, -(double)(2 * i) / 64.0), a = (double)pos * inv;
    rot[2 * idx] = (float)cos(a); rot[2 * idx + 1] = (float)sin(a);
}

__global__ void __launch_bounds__(256) k_ln_mod(const float* x, const float* modl, int sh_off, bf16* H) {
    const int row = blockIdx.x * 4 + (threadIdx.x >> 6), lane = threadIdx.x & 63, b = row / SEQ;
    const f32x4* xr = (const f32x4*)(x + (size_t)row * DM) + lane;
    f32x4 v[4]; float s = 0.f;
#pragma unroll
    for (int j = 0; j < 4; ++j) { v[j] = xr[64 * j]; s += (v[j].x + v[j].y) + (v[j].z + v[j].w); }
    const float mean = wave_sum(s) * (1.f / DM); float s2 = 0.f;
#pragma unroll
    for (int j = 0; j < 4; ++j) { v[j] = v[j] - mean; s2 += (v[j].x * v[j].x + v[j].y * v[j].y) + (v[j].z * v[j].z + v[j].w * v[j].w); }
    const float rstd = 1.f / sqrtf(wave_sum(s2) * (1.f / DM) + LN_EPS);
    const f32x4* sh = (const f32x4*)(modl + (size_t)b * MODW + sh_off) + lane; const f32x4* sc = sh + 256;
    u32x2* o = (u32x2*)(H + (size_t)row * DM) + lane;
#pragma unroll
    for (int j = 0; j < 4; ++j) { const f32x4 a = sh[64 * j], m = sc[64 * j]; const f32x4 r = v[j] * rstd * (m + 1.f) + a; u32x2 w; w.x = pk2(r.x, r.y); w.y = pk2(r.z, r.w); o[64 * j] = w; }
}

template <bool DUAL>
__device__ __forceinline__ void ngemm_core(const bf16* arow, const float* W0, const float* W1, int ldw, int K, float (&acc0)[8][4], float (&acc1)[8][4], float* As, float* Ws0, float* Ws1) {
    const int tid = threadIdx.x, tx = tid & 15, ty = tid >> 4;
#pragma unroll
    for (int i = 0; i < 8; ++i)
#pragma unroll
        for (int j = 0; j < 4; ++j) { acc0[i][j] = 0.f; acc1[i][j] = 0.f; }
    const int ar = tid >> 1, ak = (tid & 1) * 8, wk = tid >> 4, wn = (tid & 15) * 4;
    for (int k0 = 0; k0 < K; k0 += 16) {
        const u32x4 av = *(const u32x4*)(arow + k0);
        const f32x4 w0 = *(const f32x4*)(W0 + (size_t)(k0 + wk) * ldw + wn);
        f32x4 w1 = {0.f, 0.f, 0.f, 0.f}; if (DUAL) w1 = *(const f32x4*)(W1 + (size_t)(k0 + wk) * ldw + wn);
        __syncthreads();
        As[(ak + 0) * 129 + ar] = __uint_as_float(av.x << 16); As[(ak + 1) * 129 + ar] = __uint_as_float(av.x & 0xffff0000u);
        As[(ak + 2) * 129 + ar] = __uint_as_float(av.y << 16); As[(ak + 3) * 129 + ar] = __uint_as_float(av.y & 0xffff0000u);
        As[(ak + 4) * 129 + ar] = __uint_as_float(av.z << 16); As[(ak + 5) * 129 + ar] = __uint_as_float(av.z & 0xffff0000u);
        As[(ak + 6) * 129 + ar] = __uint_as_float(av.w << 16); As[(ak + 7) * 129 + ar] = __uint_as_float(av.w & 0xffff0000u);
        *(f32x4*)(Ws0 + wk * 64 + wn) = w0; if (DUAL) *(f32x4*)(Ws1 + wk * 64 + wn) = w1;
        __syncthreads();
#pragma unroll
        for (int k = 0; k < 16; ++k) {
            float a[8], b0[4], b1[4];
#pragma unroll
            for (int i = 0; i < 8; ++i) a[i] = As[k * 129 + ty + 16 * i];
#pragma unroll
            for (int j = 0; j < 4; ++j) { b0[j] = Ws0[k * 64 + tx + 16 * j]; if (DUAL) b1[j] = Ws1[k * 64 + tx + 16 * j]; }
#pragma unroll
            for (int i = 0; i < 8; ++i)
#pragma unroll
                for (int j = 0; j < 4; ++j) { acc0[i][j] += a[i] * b0[j]; if (DUAL) acc1[i][j] += a[i] * b1[j]; }
        }
    }
}

__global__ void __launch_bounds__(256) k_ngemm_inproj(const bf16* H, const float* Win, const float* rot, bf16* PROJ) {
    __shared__ float As[16 * 129], Ws0[16 * 64];
    const int tid = threadIdx.x, tx = tid & 15, ty = tid >> 4, col0 = blockIdx.x * 64, row0 = blockIdx.y * 128;
    float acc[8][4], dummy[8][4];
    ngemm_core<false>(H + (size_t)(row0 + (tid >> 1)) * DM + (tid & 1) * 8, Win + col0, nullptr, INW, DM, acc, dummy, As, Ws0, nullptr);
    const int region = col0 / 512;
#pragma unroll
    for (int i = 0; i < 8; ++i) {
        const int row = row0 + ty + 16 * i, pos = row % SEQ; bf16* o = PROJ + (size_t)row * INW + col0;
        if (region < 2) {
            const float sc = region == 0 ? 0.125f : 1.f;
#pragma unroll
            for (int j = 0; j < 2; ++j) { const int ic = tx + 16 * j; const float cs = rot[(pos * 32 + ic) * 2], sn = rot[(pos * 32 + ic) * 2 + 1];
                const float x1 = acc[i][j], x2 = acc[i][j + 2]; o[ic] = (bf16)f2bf((x1 * cs - x2 * sn) * sc); o[ic + 32] = (bf16)f2bf((x1 * sn + x2 * cs) * sc); }
        } else {
#pragma unroll
            for (int j = 0; j < 4; ++j) { float v = acc[i][j]; if (region == 3) v = silu_f(v); if (region == 4) v *= C2; o[tx + 16 * j] = (bf16)f2bf(v); }
        }
    }
}
__global__ void __launch_bounds__(256) k_ngemm_plain(const bf16* A, int lda, const float* W, int ldw, int K, bf16* C, int ldc) {
    __shared__ float As[16 * 129], Ws0[16 * 64];
    const int tid = threadIdx.x, tx = tid & 15, ty = tid >> 4, col0 = blockIdx.x * 64, row0 = blockIdx.y * 128;
    float acc[8][4], dummy[8][4];
    ngemm_core<false>(A + (size_t)(row0 + (tid >> 1)) * lda + (tid & 1) * 8, W + col0, nullptr, ldw, K, acc, dummy, As, Ws0, nullptr);
#pragma unroll
    for (int i = 0; i < 8; ++i)
#pragma unroll
        for (int j = 0; j < 4; ++j) C[(size_t)(row0 + ty + 16 * i) * ldc + col0 + tx + 16 * j] = (bf16)f2bf(acc[i][j]);
}

__global__ void __launch_bounds__(256) k_nret(const bf16* PROJ, bf16* CAT) {
    __shared__ float Qs[64 * 65], Ks[64 * 65], Vs[64 * 64], st[128]; float* Ss = Ks;
    const int tid = threadIdx.x, tx = tid & 15, ty = tid >> 4;
    const int qt = (gridDim.x - 1) - blockIdx.x, h = blockIdx.y, b = blockIdx.z, q0 = qt * 64;
    const float log_g = logf(1.f - exp2f(-5.f - (float)h));
    const bf16* base = PROJ + (size_t)b * SEQ * INW;
    for (int i = tid; i < 64 * 64; i += 256) { const int r = i >> 6, d = i & 63; Qs[r * 65 + d] = bf2f(base[(size_t)(q0 + r) * INW + C_RQ + h * 64 + d]); }
    float o[4][4];
#pragma unroll
    for (int i = 0; i < 4; ++i)
#pragma unroll
        for (int j = 0; j < 4; ++j) o[i][j] = 0.f;
    for (int kt = 0; kt <= qt; ++kt) {
        const int k0 = kt * 64;
        __syncthreads();
        for (int i = tid; i < 64 * 64; i += 256) { const int r = i >> 6, d = i & 63; Ks[r * 65 + d] = bf2f(base[(size_t)(k0 + r) * INW + C_RK + h * 64 + d]); Vs[r * 64 + d] = bf2f(base[(size_t)(k0 + r) * INW + C_RV + h * 64 + d]); }
        __syncthreads();
        float s[4][4];
#pragma unroll
        for (int i = 0; i < 4; ++i)
#pragma unroll
            for (int j = 0; j < 4; ++j) s[i][j] = 0.f;
        for (int d = 0; d < 64; ++d) { float a[4], k[4];
#pragma unroll
            for (int i = 0; i < 4; ++i) { a[i] = Qs[(ty + 16 * i) * 65 + d]; k[i] = Ks[(tx + 16 * i) * 65 + d]; }
#pragma unroll
            for (int i = 0; i < 4; ++i)
#pragma unroll
                for (int j = 0; j < 4; ++j) s[i][j] += a[i] * k[j]; }
        __syncthreads();
#pragma unroll
        for (int i = 0; i < 4; ++i)
#pragma unroll
            for (int j = 0; j < 4; ++j) { const int t = q0 + ty + 16 * i, m = k0 + tx + 16 * j; Ss[(ty + 16 * i) * 65 + tx + 16 * j] = (m <= t) ? s[i][j] * expf(log_g * (float)(t - m)) : 0.f; }
        __syncthreads();
        for (int m = 0; m < 64; ++m) { float p[4], v[4];
#pragma unroll
            for (int i = 0; i < 4; ++i) { p[i] = Ss[(ty + 16 * i) * 65 + m]; v[i] = Vs[m * 64 + tx + 16 * i]; }
#pragma unroll
            for (int i = 0; i < 4; ++i)
#pragma unroll
                for (int j = 0; j < 4; ++j) o[i][j] += p[i] * v[j]; }
    }
    __syncthreads();
#pragma unroll
    for (int i = 0; i < 4; ++i)
#pragma unroll
        for (int j = 0; j < 4; ++j) Ss[(ty + 16 * i) * 65 + tx + 16 * j] = o[i][j];
    __syncthreads();
    if (tid < 64) { float s = 0.f; for (int d = 0; d < 64; ++d) s += Ss[tid * 65 + d]; const float mean = s * (1.f / 64.f); float q = 0.f; for (int d = 0; d < 64; ++d) { const float e = Ss[tid * 65 + d] - mean; q += e * e; }
        st[tid] = mean; st[64 + tid] = 1.f / sqrtf(q * (1.f / 64.f) + LN_EPS); }
    __syncthreads();
#pragma unroll
    for (int i = 0; i < 4; ++i)
#pragma unroll
        for (int j = 0; j < 4; ++j) { const int r = ty + 16 * i, cc = tx + 16 * j; const size_t row = (size_t)b * SEQ + q0 + r;
            const float g = bf2f(PROJ[row * INW + C_RG + h * 64 + cc]);
            CAT[row * DM + h * 64 + cc] = (bf16)f2bf((o[i][j] - st[r]) * st[64 + r] * g); }
}

__global__ void __launch_bounds__(256) k_ndiff(const bf16* PROJ, const float* modx  , const float* subln, int l, bf16* CAT) {
    __shared__ float Qs[64 * 65], Ks[32 * 65], Vs[32 * 128], Ps[64 * 33], mrow[64], lrow[64], srow[64];
    const int tid = threadIdx.x, tx = tid & 15, ty = tid >> 4;
    const int qt = (gridDim.x - 1) - blockIdx.x, h = blockIdx.y, b = blockIdx.z, q0 = qt * 64;
    const float lam = modx[l], li = modx[2 + l];
    const bf16* base = PROJ + (size_t)b * SEQ * INW;
    float res[4][8];
    for (int c = 0; c < 2; ++c) {
        __syncthreads();
        for (int i = tid; i < 64 * 64; i += 256) { const int r = i >> 6, d = i & 63; Qs[r * 65 + d] = bf2f(base[(size_t)(q0 + r) * INW + C_DQ + h * 128 + c * 64 + d]); }
        if (tid < 64) { mrow[tid] = -INFINITY; lrow[tid] = 0.f; }
        float o[4][8];
#pragma unroll
        for (int i = 0; i < 4; ++i)
#pragma unroll
            for (int j = 0; j < 8; ++j) o[i][j] = 0.f;
        const int nkt = (q0 + 64) / 32;
        for (int kt = 0; kt < nkt; ++kt) {
            const int k0 = kt * 32;
            __syncthreads();
            for (int i = tid; i < 32 * 64; i += 256) { const int r = i >> 6, d = i & 63; Ks[r * 65 + d] = bf2f(base[(size_t)(k0 + r) * INW + C_DK + h * 128 + c * 64 + d]); }
            for (int i = tid; i < 32 * 128; i += 256) { const int r = i >> 7, d = i & 127; Vs[r * 128 + d] = bf2f(base[(size_t)(k0 + r) * INW + C_DV + h * 128 + d]); }
            __syncthreads();
            float s[4][2];
#pragma unroll
            for (int i = 0; i < 4; ++i) { s[i][0] = 0.f; s[i][1] = 0.f; }
            for (int d = 0; d < 64; ++d) { float a[4], k[2];
#pragma unroll
                for (int i = 0; i < 4; ++i) a[i] = Qs[(ty + 16 * i) * 65 + d];
                k[0] = Ks[tx * 65 + d]; k[1] = Ks[(tx + 16) * 65 + d];
#pragma unroll
                for (int i = 0; i < 4; ++i) { s[i][0] += a[i] * k[0]; s[i][1] += a[i] * k[1]; } }
#pragma unroll
            for (int i = 0; i < 4; ++i)
#pragma unroll
                for (int j = 0; j < 2; ++j) { const int t = q0 + ty + 16 * i, m = k0 + tx + 16 * j; Ps[(ty + 16 * i) * 33 + tx + 16 * j] = (m <= t) ? s[i][j] : -INFINITY; }
            __syncthreads();
            if (tid < 64) { float mx = mrow[tid]; for (int m = 0; m < 32; ++m) mx = fmaxf(mx, Ps[tid * 33 + m]);
                const float sc = exp2f(mrow[tid] - mx); float sum = 0.f;
                for (int m = 0; m < 32; ++m) { const float p = exp2f(Ps[tid * 33 + m] - mx); Ps[tid * 33 + m] = p; sum += p; }
                lrow[tid] = lrow[tid] * sc + sum; mrow[tid] = mx; srow[tid] = sc; }
            __syncthreads();
#pragma unroll
            for (int i = 0; i < 4; ++i) { const float sc = srow[ty + 16 * i];
#pragma unroll
                for (int j = 0; j < 8; ++j) o[i][j] *= sc; }
            for (int m = 0; m < 32; ++m) { float p[4], v[8];
#pragma unroll
                for (int i = 0; i < 4; ++i) p[i] = Ps[(ty + 16 * i) * 33 + m];
#pragma unroll
                for (int j = 0; j < 8; ++j) v[j] = Vs[m * 128 + tx + 16 * j];
#pragma unroll
                for (int i = 0; i < 4; ++i)
#pragma unroll
                    for (int j = 0; j < 8; ++j) o[i][j] += p[i] * v[j]; }
        }
        __syncthreads();
#pragma unroll
        for (int i = 0; i < 4; ++i) { const float inv = 1.f / lrow[ty + 16 * i];
#pragma unroll
            for (int j = 0; j < 8; ++j) { if (c == 0) res[i][j] = o[i][j] * inv; else res[i][j] -= lam * o[i][j] * inv; } }
    }
    __syncthreads();
#pragma unroll
    for (int i = 0; i < 4; ++i) { float q = 0.f;
#pragma unroll
        for (int j = 0; j < 8; ++j) q += res[i][j] * res[i][j];
        Ps[(ty + 16 * i) * 33 + tx] = q; }
    __syncthreads();
    if (tid < 64) { float q = 0.f; for (int m = 0; m < 16; ++m) q += Ps[tid * 33 + m]; srow[tid] = 1.f / sqrtf(q * (1.f / 128.f) + LN_EPS); }
    __syncthreads();
#pragma unroll
    for (int i = 0; i < 4; ++i)
#pragma unroll
        for (int j = 0; j < 8; ++j) { const int r = ty + 16 * i, cc = tx + 16 * j; const size_t row = (size_t)b * SEQ + q0 + r;
            CAT[row * DM + 512 + h * 128 + cc] = (bf16)f2bf(res[i][j] * srow[r] * subln[l * 128 + cc] * (1.f - li)); }
}

__global__ void __launch_bounds__(256) k_post_mix(const float* xin, const bf16* MIXED, const float* modl, const float* lng, const float* lnb, const float* rw, const float* rb,
                                                  bf16* X1, bf16* H, int* tok_e, float* tok_g, int* tok_slot, int* lists, int* cnt) {
    const int row = blockIdx.x * 4 + (threadIdx.x >> 6), lane = threadIdx.x & 63, b = row / SEQ;
    const f32x4* xr = (const f32x4*)(xin + (size_t)row * DM) + lane; const u32x2* mr = (const u32x2*)(MIXED + (size_t)row * DM) + lane;
    const f32x4* g1 = (const f32x4*)(modl + (size_t)b * MODW + 2 * DM) + lane; const f32x4* sh2 = g1 + 256; const f32x4* sc2 = g1 + 512;
    f32x4 v[4]; float s = 0.f;
#pragma unroll
    for (int j = 0; j < 4; ++j) { const f32x4 x = xr[64 * j], g = g1[64 * j]; const u32x2 m = mr[64 * j];
        f32x4 mv; mv.x = __uint_as_float(m.x << 16); mv.y = __uint_as_float(m.x & 0xffff0000u); mv.z = __uint_as_float(m.y << 16); mv.w = __uint_as_float(m.y & 0xffff0000u);
        v[j] = x * ALPHA + g * mv; s += (v[j].x + v[j].y) + (v[j].z + v[j].w); }
    float mean = wave_sum(s) * (1.f / DM), s2 = 0.f;
#pragma unroll
    for (int j = 0; j < 4; ++j) { v[j] = v[j] - mean; s2 += (v[j].x * v[j].x + v[j].y * v[j].y) + (v[j].z * v[j].z + v[j].w * v[j].w); }
    float rstd = 1.f / sqrtf(wave_sum(s2) * (1.f / DM) + LN_EPS);
    u32x2* xo = (u32x2*)(X1 + (size_t)row * DM) + lane; s = 0.f;
#pragma unroll
    for (int j = 0; j < 4; ++j) { const f32x4 g = ((const f32x4*)lng)[lane + 64 * j], bb = ((const f32x4*)lnb)[lane + 64 * j]; v[j] = v[j] * rstd * g + bb;
        u32x2 w; w.x = pk2(v[j].x, v[j].y); w.y = pk2(v[j].z, v[j].w); xo[64 * j] = w; s += (v[j].x + v[j].y) + (v[j].z + v[j].w); }
    mean = wave_sum(s) * (1.f / DM); s2 = 0.f;
#pragma unroll
    for (int j = 0; j < 4; ++j) { v[j] = v[j] - mean; s2 += (v[j].x * v[j].x + v[j].y * v[j].y) + (v[j].z * v[j].z + v[j].w * v[j].w); }
    rstd = 1.f / sqrtf(wave_sum(s2) * (1.f / DM) + LN_EPS);
    u32x2* ho = (u32x2*)(H + (size_t)row * DM) + lane;
    float lg[16];
#pragma unroll
    for (int e = 0; e < 16; ++e) lg[e] = 0.f;
#pragma unroll
    for (int j = 0; j < 4; ++j) { const f32x4 a = sh2[64 * j], m = sc2[64 * j]; v[j] = v[j] * rstd * (m + 1.f) + a;
        u32x2 w; w.x = pk2(v[j].x, v[j].y); w.y = pk2(v[j].z, v[j].w); ho[64 * j] = w;
        const f32x4* wr = (const f32x4*)(rw + (size_t)(4 * lane + 256 * j) * 16);
#pragma unroll
        for (int q = 0; q < 4; ++q) { const float hv = q == 0 ? v[j].x : q == 1 ? v[j].y : q == 2 ? v[j].z : v[j].w;
#pragma unroll
            for (int e4 = 0; e4 < 4; ++e4) { const f32x4 w4 = wr[q * 4 + e4]; lg[e4 * 4 + 0] += hv * w4.x; lg[e4 * 4 + 1] += hv * w4.y; lg[e4 * 4 + 2] += hv * w4.z; lg[e4 * 4 + 3] += hv * w4.w; } } }
    float mx = -INFINITY;
#pragma unroll
    for (int e = 0; e < 16; ++e) { lg[e] = wave_sum(lg[e]) + rb[e]; mx = fmaxf(mx, lg[e]); }
    float p[16], sum = 0.f;
#pragma unroll
    for (int e = 0; e < 16; ++e) { p[e] = expf(lg[e] - mx); sum += p[e]; }
    const float rs = 1.f / sum;
#pragma unroll
    for (int e = 0; e < 16; ++e) p[e] *= rs;
    int bg = 0; float bgs = -1.f;
#pragma unroll
    for (int g = 0; g < 4; ++g) { float m1 = p[4 * g]; int i1 = 0;
#pragma unroll
        for (int i = 1; i < 4; ++i) if (p[4 * g + i] > m1) { m1 = p[4 * g + i]; i1 = i; }
        float m2 = -1.f;
#pragma unroll
        for (int i = 0; i < 4; ++i) if (i != i1 && p[4 * g + i] > m2) m2 = p[4 * g + i];
        const float gs = m1 + m2; if (gs > bgs) { bgs = gs; bg = g; } }
    float q0 = 0.f, q1 = 0.f, q2 = 0.f, q3 = 0.f;
#pragma unroll
    for (int g = 0; g < 4; ++g) if (bg == g) { q0 = p[4 * g]; q1 = p[4 * g + 1]; q2 = p[4 * g + 2]; q3 = p[4 * g + 3]; }
    float m1 = q0; int i1 = 0; if (q1 > m1) { m1 = q1; i1 = 1; } if (q2 > m1) { m1 = q2; i1 = 2; } if (q3 > m1) { m1 = q3; i1 = 3; }
    float m2 = -1.f; int i2 = 0;
    if (i1 != 0 && q0 > m2) { m2 = q0; i2 = 0; } if (i1 != 1 && q1 > m2) { m2 = q1; i2 = 1; } if (i1 != 2 && q2 > m2) { m2 = q2; i2 = 2; } if (i1 != 3 && q3 > m2) { m2 = q3; i2 = 3; }
    if (lane == 0) {
        const int e1 = bg * 4 + i1, e2 = bg * 4 + i2; const float den = 1.f / (m1 + m2);
        const int s1 = atomicAdd(cnt + e1, 1), s2_ = atomicAdd(cnt + e2, 1);
        lists[(size_t)e1 * T + s1] = row; lists[(size_t)e2 * T + s2_] = row;
        tok_e[2 * row] = e1; tok_e[2 * row + 1] = e2; tok_g[2 * row] = m1 * den; tok_g[2 * row + 1] = m2 * den; tok_slot[2 * row] = s1; tok_slot[2 * row + 1] = s2_;
    }
}

__device__ __forceinline__ int expert_base(const int* cnt, int e) { int bs = 0; for (int i = 0; i < 16; ++i) if (i < e) bs += (cnt[i] + 255) & ~255; return bs; }
__global__ void __launch_bounds__(256) k_moe1(const bf16* H, const float* wg, const float* wu, const int* cnt, const int* lists, bf16* HE) {
    __shared__ float As[16 * 129], Ws0[16 * 64], Ws1[16 * 64];
    const int e = blockIdx.z, rt = blockIdx.y, ct = blockIdx.x, n = cnt[e]; if (rt * 128 >= n) return;
    const int tid = threadIdx.x, tx = tid & 15, ty = tid >> 4, base = expert_base(cnt, e);
    const int sl = rt * 128 + (tid >> 1), tok = lists[(size_t)e * T + (sl < n ? sl : 0)];
    float g[8][4], u[8][4];
    ngemm_core<true>(H + (size_t)tok * DM + (tid & 1) * 8, wg + (size_t)e * DM * DE + ct * 64, wu + (size_t)e * DM * DE + ct * 64, DE, DM, g, u, As, Ws0, Ws1);
#pragma unroll
    for (int i = 0; i < 8; ++i) { const int s = rt * 128 + ty + 16 * i; if (s < n) {
#pragma unroll
        for (int j = 0; j < 4; ++j) HE[(size_t)(base + s) * DE + ct * 64 + tx + 16 * j] = (bf16)f2bf(silu_f(g[i][j]) * u[i][j]); } }
}
__global__ void __launch_bounds__(256) k_moe2(const bf16* HE, const float* wd, const int* cnt, bf16* YP) {
    __shared__ float As[16 * 129], Ws0[16 * 64];
    const int e = blockIdx.z, rt = blockIdx.y, ct = blockIdx.x, n = cnt[e]; if (rt * 128 >= n) return;
    const int tid = threadIdx.x, tx = tid & 15, ty = tid >> 4, base = expert_base(cnt, e);
    const int sl = rt * 128 + (tid >> 1);
    float acc[8][4], dummy[8][4];
    ngemm_core<false>(HE + (size_t)(base + (sl < n ? sl : 0)) * DE + (tid & 1) * 8, wd + (size_t)e * DE * DM + ct * 64, nullptr, DM, DE, acc, dummy, As, Ws0, nullptr);
#pragma unroll
    for (int i = 0; i < 8; ++i) { const int s = rt * 128 + ty + 16 * i; if (s < n) {
#pragma unroll
        for (int j = 0; j < 4; ++j) YP[(size_t)(base + s) * DM + ct * 64 + tx + 16 * j] = (bf16)f2bf(acc[i][j]); } }
}

__global__ void __launch_bounds__(256) k_post_ffn(const bf16* X1, const bf16* YP, const float* modl, const float* lng, const float* lnb, const int* tok_e, const float* tok_g, const int* tok_slot, const int* cnt,
                                                  float* out, const float* modn, bf16* H) {
    const int row = blockIdx.x * 4 + (threadIdx.x >> 6), lane = threadIdx.x & 63, b = row / SEQ;
    const int e0 = tok_e[2 * row], e1 = tok_e[2 * row + 1]; const float w0 = tok_g[2 * row], w1 = tok_g[2 * row + 1];
    const size_t r0 = (size_t)expert_base(cnt, e0) + tok_slot[2 * row], r1 = (size_t)expert_base(cnt, e1) + tok_slot[2 * row + 1];
    const u32x2* xr = (const u32x2*)(X1 + (size_t)row * DM) + lane; const u32x2* y0 = (const u32x2*)(YP + r0 * DM) + lane; const u32x2* y1 = (const u32x2*)(YP + r1 * DM) + lane;
    const f32x4* g2 = (const f32x4*)(modl + (size_t)b * MODW + 5 * DM) + lane;
    f32x4 v[4]; float s = 0.f;
#pragma unroll
    for (int j = 0; j < 4; ++j) { const u32x2 x = xr[64 * j], a = y0[64 * j], c = y1[64 * j]; const f32x4 g = g2[64 * j];
        f32x4 xv, av, cv; xv.x = __uint_as_float(x.x << 16); xv.y = __uint_as_float(x.x & 0xffff0000u); xv.z = __uint_as_float(x.y << 16); xv.w = __uint_as_float(x.y & 0xffff0000u);
        av.x = __uint_as_float(a.x << 16); av.y = __uint_as_float(a.x & 0xffff0000u); av.z = __uint_as_float(a.y << 16); av.w = __uint_as_float(a.y & 0xffff0000u);
        cv.x = __uint_as_float(c.x << 16); cv.y = __uint_as_float(c.x & 0xffff0000u); cv.z = __uint_as_float(c.y << 16); cv.w = __uint_as_float(c.y & 0xffff0000u);
        v[j] = xv * ALPHA + g * (av * w0 + cv * w1); s += (v[j].x + v[j].y) + (v[j].z + v[j].w); }
    float mean = wave_sum(s) * (1.f / DM), s2 = 0.f;
#pragma unroll
    for (int j = 0; j < 4; ++j) { v[j] = v[j] - mean; s2 += (v[j].x * v[j].x + v[j].y * v[j].y) + (v[j].z * v[j].z + v[j].w * v[j].w); }
    float rstd = 1.f / sqrtf(wave_sum(s2) * (1.f / DM) + LN_EPS);
    f32x4* o = (f32x4*)(out + (size_t)row * DM) + lane; s = 0.f;
#pragma unroll
    for (int j = 0; j < 4; ++j) { const f32x4 g = ((const f32x4*)lng)[lane + 64 * j], bb = ((const f32x4*)lnb)[lane + 64 * j]; v[j] = v[j] * rstd * g + bb; o[64 * j] = v[j]; s += (v[j].x + v[j].y) + (v[j].z + v[j].w); }
    if (modn) {
        mean = wave_sum(s) * (1.f / DM); s2 = 0.f;
#pragma unroll
        for (int j = 0; j < 4; ++j) { v[j] = v[j] - mean; s2 += (v[j].x * v[j].x + v[j].y * v[j].y) + (v[j].z * v[j].z + v[j].w * v[j].w); }
        rstd = 1.f / sqrtf(wave_sum(s2) * (1.f / DM) + LN_EPS);
        const f32x4* sh = (const f32x4*)(modn + (size_t)b * MODW) + lane; const f32x4* sc = sh + 256; u32x2* ho = (u32x2*)(H + (size_t)row * DM) + lane;
#pragma unroll
        for (int j = 0; j < 4; ++j) { const f32x4 a = sh[64 * j], m = sc[64 * j]; const f32x4 r = v[j] * rstd * (m + 1.f) + a; u32x2 w; w.x = pk2(r.x, r.y); w.y = pk2(r.z, r.w); ho[64 * j] = w; }
    }
}

#include <hip/hip_bf16.h>
#ifndef RET_FAST
#define RET_FAST 1
#endif
#ifndef ATTN128
#define ATTN128 1
#endif
#ifndef ATTN_THRL
#define ATTN_THRL 8
#endif
#define LAS __attribute__((address_space(3)))
#define GAS __attribute__((address_space(1)))
typedef short bf16x8 __attribute__((ext_vector_type(8)));
typedef GAS unsigned gu32;
#define RLX_AGENT __ATOMIC_RELAXED, __HIP_MEMORY_SCOPE_AGENT
#define LDS_WAIT() asm volatile("s_waitcnt lgkmcnt(0)" ::: "memory")
#define VM_WAIT() asm volatile("s_waitcnt vmcnt(0)" ::: "memory")

constexpr size_t WL_IN = 0, WL_OUT = (size_t)INW * DM, WL_GU = WL_OUT + (size_t)DM * DM, WL_D = WL_GU + (size_t)NE * 1024 * DM, WL_STRIDE = WL_D + (size_t)NE * DM * DE;
static_assert(WL_STRIDE * 2 * 2 <= 114 * MiB, "weights fit");

namespace pg8 {
constexpr int BM = 256, BK = 64, HALF = 128, HTB = HALF * BK * 2, STAGE_BYTES = 8 * HTB, NXCD = 8, WGM = 8;
__host__ __device__ __forceinline__ int lds_byte(int r, int c) { const int st = (r >> 4) * 2 + (c >> 5), rr = r & 15, cc = c & 31, ob = rr * 64 + cc * 2; return st * 1024 + (ob ^ (((ob >> 9) & 1) << 5)); }
__host__ __device__ __forceinline__ void stage_rc(int b, int& R, int& C) { const int st = b / 1024, sb = b % 1024, swz = sb ^ (((sb >> 9) & 1) << 5); R = (st >> 1) * 16 + swz / 64; C = (st & 1) * 32 + (swz % 64) / 2; }
__host__ __device__ __forceinline__ int perm32(int rho) { const int n = rho >> 4, i = rho & 15; return 8 * (i >> 2) + 4 * n + (i & 3); }
struct Unit { int pm, pn; };

struct OrderBase {
    int nM, nN, nwg, G, c;
    __device__ __forceinline__ void init(int nM_, int nN_, int G_, int c_) { nM = nM_; nN = nN_; nwg = nM * nN; G = G_; c = c_; }
    __device__ __forceinline__ bool next(int i, Unit& u) const {
        const long L = (long)i * G + c; if (L >= nwg) return false;
        int wgid = (int)L; { const int q = nwg / NXCD, r = nwg % NXCD, xcd = wgid % NXCD, off = wgid / NXCD; wgid = (xcd < r ? xcd * (q + 1) : r * (q + 1) + (xcd - r) * q) + off; }
        const int nig = WGM * nN, gid = wgid / nig, fm = gid * WGM, gsz = (nM - fm) < WGM ? (nM - fm) : WGM;
        u.pm = fm + ((wgid % nig) % gsz); u.pn = (wgid % nig) / gsz; return true;
    }
    __device__ __forceinline__ void a_ready(const Unit&) const {}
    __device__ __forceinline__ void done(const Unit&) const {}
};
struct PlainSched : OrderBase {
    const bf16* Bt; int K;
    __device__ __forceinline__ void setup(const Unit& u, const int (&Rl)[2], const int (&Cb)[2], unsigned (&off)[2][2], const char*& bptr) const {
#pragma unroll
        for (int h = 0; h < 2; ++h)
#pragma unroll
            for (int i = 0; i < 2; ++i) off[h][i] = (unsigned)((u.pm * 256 + h * 128 + Rl[i]) * K * 2 + Cb[i]);
        bptr = (const char*)Bt + (size_t)u.pn * 256 * K * 2;
    }
};
struct MoeSched : OrderBase {
    const bf16* Bt; int K; const LAS int* tab; const int* cnt; const int* lists; bool gather;
    __device__ __forceinline__ void setup(const Unit& u, const int (&Rl)[2], const int (&Cb)[2], unsigned (&off)[2][2], const char*& bptr) const {
        const int te = tab[1 + u.pm], e = te & 255, s0 = (te >> 8) * 256;
        if (gather) { const int n = cnt[e];
#pragma unroll
            for (int h = 0; h < 2; ++h)
#pragma unroll
                for (int i = 0; i < 2; ++i) { const int s = s0 + h * 128 + Rl[i]; const int tok = lists[(size_t)e * T + (s < n ? s : 0)]; off[h][i] = (unsigned)(tok * K * 2 + Cb[i]); }
        } else {
#pragma unroll
            for (int h = 0; h < 2; ++h)
#pragma unroll
                for (int i = 0; i < 2; ++i) off[h][i] = (unsigned)((u.pm * 256 + h * 128 + Rl[i]) * K * 2 + Cb[i]);
        }
        bptr = (const char*)Bt + (size_t)(e * 4 + u.pn) * 256 * K * 2;
    }
};

__device__ __forceinline__ unsigned cvt_pk_bf16(float lo, float hi) { unsigned r; asm volatile("v_cvt_pk_bf16_f32 %0, %1, %2" : "=v"(r) : "v"(lo), "v"(hi)); return r; }
__device__ __forceinline__ float fsilu(float v) { return v * __builtin_amdgcn_rcpf(1.f + __expf(-v)); }
#ifndef EPI_T
#define EPI_T 1
#endif
__device__ __forceinline__ u32x4 tr4(u32x4 w, int src4) {
#if EPI_T
    u32x4 r; r.x = (unsigned)__builtin_amdgcn_ds_bpermute(src4, (int)w.x); r.y = (unsigned)__builtin_amdgcn_ds_bpermute(src4, (int)w.y);
    r.z = (unsigned)__builtin_amdgcn_ds_bpermute(src4, (int)w.z); r.w = (unsigned)__builtin_amdgcn_ds_bpermute(src4, (int)w.w); return r;
#else
    return w;
#endif
}
#define EPI_T_LANES() const int ln_ = fq * 16 + fr; const int fr2 = EPI_T ? (ln_ >> 2) : fr, fq2 = EPI_T ? (ln_ & 3) : fq, src4 = (fq2 * 16 + fr2) * 4; (void)src4

struct EpiInProj {
    static constexpr bool PERM = true, AFTER_DRAIN = false;
    bf16* P; const float* rot; const float* dtab; bf16* dummy;
    __device__ __forceinline__ void operator()(const f32x4 (&acc)[2][2][4][2], const Unit& u, int wr, int wc, int fr, int fq) const {
        EPI_T_LANES(); const int row0 = u.pm * BM + wr * 64 + fr, row0a = u.pm * BM + wr * 64 + fr2;
        if (u.pn < 4 && !dummy) {
            const float sc0 = u.pn < 2 ? 0.125f : 1.f; const float* dt = dtab ? dtab + (u.pn >> 1) * 1024 + ((u.pn & 1) * 4 + wc) * 128 : nullptr;
#pragma unroll
            for (int ai = 0; ai < 2; ++ai) {
                f32x4 tt[4][4]; float scv[4];
#pragma unroll
                for (int m = 0; m < 4; ++m) { const int pos = (row0 + ai * HALF + m * 16) & (SEQ - 1); const f32x4* rt = (const f32x4*)(rot + (size_t)(pos * 32 + 8 * fq) * 2);
                    tt[m][0] = rt[0]; tt[m][1] = rt[1]; tt[m][2] = rt[2]; tt[m][3] = rt[3]; scv[m] = dt ? dt[pos & 127] : sc0; }
#pragma unroll
                for (int m = 0; m < 4; ++m) { const int row = row0 + ai * HALF + m * 16; const float sc = scv[m];
                    const f32x4 t0 = tt[m][0], t1 = tt[m][1], t2 = tt[m][2], t3 = tt[m][3];
                    const f32x4 xa = acc[ai][0][m][0], xb = acc[ai][0][m][1], ya = acc[ai][1][m][0], yb = acc[ai][1][m][1];
                    u32x4 w1, w2;
                    w1.x = cvt_pk_bf16((xa[0] * t0.x - ya[0] * t0.y) * sc, (xa[1] * t0.z - ya[1] * t0.w) * sc); w1.y = cvt_pk_bf16((xa[2] * t1.x - ya[2] * t1.y) * sc, (xa[3] * t1.z - ya[3] * t1.w) * sc);
                    w1.z = cvt_pk_bf16((xb[0] * t2.x - yb[0] * t2.y) * sc, (xb[1] * t2.z - yb[1] * t2.w) * sc); w1.w = cvt_pk_bf16((xb[2] * t3.x - yb[2] * t3.y) * sc, (xb[3] * t3.z - yb[3] * t3.w) * sc);
                    w2.x = cvt_pk_bf16((xa[0] * t0.y + ya[0] * t0.x) * sc, (xa[1] * t0.w + ya[1] * t0.z) * sc); w2.y = cvt_pk_bf16((xa[2] * t1.y + ya[2] * t1.x) * sc, (xa[3] * t1.w + ya[3] * t1.z) * sc);
                    w2.z = cvt_pk_bf16((xb[0] * t2.y + yb[0] * t2.x) * sc, (xb[1] * t2.w + yb[1] * t2.z) * sc); w2.w = cvt_pk_bf16((xb[2] * t3.y + yb[2] * t3.x) * sc, (xb[3] * t3.w + yb[3] * t3.z) * sc);
                    bf16* o = P + (size_t)(row0a + ai * HALF + m * 16) * INW + u.pn * BM + 64 * wc + 8 * fq2;
                    *(u32x4*)o = tr4(w1, src4); *(u32x4*)(o + 32) = tr4(w2, src4); }
            }
        } else {
            const int region = u.pn >> 1;
#pragma unroll
            for (int ai = 0; ai < 2; ++ai)
#pragma unroll
                for (int m = 0; m < 4; ++m) { bf16* o = (u.pn < 4) ? dummy + (size_t)(row0a + ai * HALF + m * 16) * DM + u.pn * BM + wc * 32 + 8 * fq2 : P + (size_t)(row0a + ai * HALF + m * 16) * INW + u.pn * BM + wc * 32 + 8 * fq2;
#pragma unroll
                    for (int bj = 0; bj < 2; ++bj) { f32x4 v0 = acc[ai][bj][m][0], v1 = acc[ai][bj][m][1];
                        if (region == 3) { v0[0] = fsilu(v0[0]); v0[1] = fsilu(v0[1]); v0[2] = fsilu(v0[2]); v0[3] = fsilu(v0[3]); v1[0] = fsilu(v1[0]); v1[1] = fsilu(v1[1]); v1[2] = fsilu(v1[2]); v1[3] = fsilu(v1[3]); }
                        if (region == 4) { v0 = v0 * C2; v1 = v1 * C2; }
                        u32x4 w; w.x = cvt_pk_bf16(v0[0], v0[1]); w.y = cvt_pk_bf16(v0[2], v0[3]); w.z = cvt_pk_bf16(v1[0], v1[1]); w.w = cvt_pk_bf16(v1[2], v1[3]);
                        *(u32x4*)(o + bj * HALF) = tr4(w, src4); } }
        }
    }
};
struct EpiPlain {
    static constexpr bool PERM = true, AFTER_DRAIN = false;
    bf16* O; int ldc;
    __device__ __forceinline__ void operator()(const f32x4 (&acc)[2][2][4][2], const Unit& u, int wr, int wc, int fr, int fq) const {
        EPI_T_LANES(); const int row0 = u.pm * BM + wr * 64 + fr2, col0 = u.pn * BM + wc * 32 + 8 * fq2;
#pragma unroll
        for (int ai = 0; ai < 2; ++ai)
#pragma unroll
            for (int m = 0; m < 4; ++m) { bf16* o = O + (size_t)(row0 + ai * HALF + m * 16) * ldc + col0;
#pragma unroll
                for (int bj = 0; bj < 2; ++bj) { const f32x4 v0 = acc[ai][bj][m][0], v1 = acc[ai][bj][m][1];
                    u32x4 w; w.x = cvt_pk_bf16(v0[0], v0[1]); w.y = cvt_pk_bf16(v0[2], v0[3]); w.z = cvt_pk_bf16(v1[0], v1[1]); w.w = cvt_pk_bf16(v1[2], v1[3]);
                    *(u32x4*)(o + bj * HALF) = tr4(w, src4); } }
    }
};
struct EpiNone {
    static constexpr bool PERM = true, AFTER_DRAIN = false;
    __device__ __forceinline__ void operator()(const f32x4 (&acc)[2][2][4][2], const Unit& u, int wr, int wc, int fr, int fq) const {
#pragma unroll
        for (int ai = 0; ai < 2; ++ai)
#pragma unroll
            for (int bj = 0; bj < 2; ++bj)
#pragma unroll
                for (int m = 0; m < 4; ++m) { asm volatile("" :: "v"(acc[ai][bj][m][0]), "v"(acc[ai][bj][m][1])); }
    }
};
struct EpiGateUp {
    static constexpr bool PERM = true, AFTER_DRAIN = false;
    bf16* HE;
    __device__ __forceinline__ void operator()(const f32x4 (&acc)[2][2][4][2], const Unit& u, int wr, int wc, int fr, int fq) const {
        EPI_T_LANES(); const int row0 = u.pm * BM + wr * 64 + fr2, col0 = u.pn * 128 + wc * 32 + 8 * fq2;
#pragma unroll
        for (int ai = 0; ai < 2; ++ai)
#pragma unroll
            for (int m = 0; m < 4; ++m) { const f32x4 g0 = acc[ai][0][m][0], g1 = acc[ai][0][m][1], u0 = acc[ai][1][m][0], u1 = acc[ai][1][m][1];
                u32x4 w; w.x = cvt_pk_bf16(fsilu(g0[0]) * u0[0], fsilu(g0[1]) * u0[1]); w.y = cvt_pk_bf16(fsilu(g0[2]) * u0[2], fsilu(g0[3]) * u0[3]);
                w.z = cvt_pk_bf16(fsilu(g1[0]) * u1[0], fsilu(g1[1]) * u1[1]); w.w = cvt_pk_bf16(fsilu(g1[2]) * u1[2], fsilu(g1[3]) * u1[3]);
                *(u32x4*)(HE + (size_t)(row0 + ai * HALF + m * 16) * DE + col0) = tr4(w, src4); }
    }
};

template <class Epi, class Sched, bool ALIGN_EPI>
__device__ __forceinline__ void gemm_phase(LAS unsigned char* lds, const char* gA, int K, const Sched& S, const Epi& E) {
    int tid_ = threadIdx.x; asm volatile("" : "+v"(tid_));
    const int tid = tid_, wid = __builtin_amdgcn_readfirstlane(tid >> 6), lane = tid & 63, wr = wid >> 2, wc = wid & 3, fr = lane & 15, fq = lane >> 4;
    const int nt = K / BK;
    unsigned voffB[2]; int Rl[2], Cb[2];
#pragma unroll
    for (int i = 0; i < 2; ++i) { int R, C; stage_rc(tid * 16 + i * 8192, R, C); const int Rb = Epi::PERM ? ((R & ~31) + perm32(R & 31)) : R;
        voffB[i] = (unsigned)(Rb * K + C) * 2u; Rl[i] = R; Cb[i] = C * 2; }
    const size_t kstep = (size_t)(BK * 2), hstep = (size_t)HALF * K * 2;
    const unsigned ldsw = (unsigned)wid * 1024u;
    const int aoff = lds_byte(wr * 64 + fr, fq * 8), boff = lds_byte(wc * 32 + fr, fq * 8);
#define PG8_SA(b, h) (((b) * 2 + (h)) * HTB)
#define PG8_SB(b, h) ((4 + (b) * 2 + (h)) * HTB)
#define PG8_STAGE(bufoff, gbase, voff) do { _Pragma("unroll") for (int _i = 0; _i < 2; ++_i) \
        __builtin_amdgcn_global_load_lds((const unsigned*)((const char*)(gbase) + (voff)[_i]), (LAS unsigned*)(lds + (bufoff) + ldsw + _i * 8192), 16, 0, 0); } while (0)
#define PG8_LDA(dst, b, h) do { _Pragma("unroll") for (int m = 0; m < 4; ++m) _Pragma("unroll") for (int k = 0; k < 2; ++k) dst[m][k] = *(const LAS bf16x8*)(lds + PG8_SA(b, h) + aoff + m * 2048 + k * 1024); } while (0)
#define PG8_LDB(dst, b, h) do { _Pragma("unroll") for (int n = 0; n < 2; ++n) _Pragma("unroll") for (int k = 0; k < 2; ++k) dst[n][k] = *(const LAS bf16x8*)(lds + PG8_SB(b, h) + boff + n * 2048 + k * 1024); } while (0)
#define PG8_MMA(ai, bj, At, Bt) do { __builtin_amdgcn_s_setprio(1); _Pragma("unroll") for (int m = 0; m < 4; ++m) _Pragma("unroll") for (int n = 0; n < 2; ++n) _Pragma("unroll") for (int k = 0; k < 2; ++k) \
        acc[ai][bj][m][n] = __builtin_amdgcn_mfma_f32_16x16x32_bf16(Bt[n][k], At[m][k], acc[ai][bj][m][n], 0, 0, 0); __builtin_amdgcn_s_setprio(0); } while (0)
#define PG8_WAIT_V(n) asm volatile("s_waitcnt vmcnt(" #n ")" ::: "memory")
#define PG8_WAIT_L(n) asm volatile("s_waitcnt lgkmcnt(" #n ")" ::: "memory")
#define PG8_BAR __builtin_amdgcn_s_barrier()
#define PG8_SCHED __builtin_amdgcn_sched_barrier(0)
    Unit cur, nxt; int ui = 0;
    if (!S.next(0, cur)) return;
    f32x4 acc[2][2][4][2];
#pragma unroll
    for (int a = 0; a < 2; ++a)
#pragma unroll
        for (int b = 0; b < 2; ++b)
#pragma unroll
            for (int m = 0; m < 4; ++m)
#pragma unroll
                for (int n = 0; n < 2; ++n) acc[a][b][m][n] = (f32x4){0.f, 0.f, 0.f, 0.f};
    bf16x8 At[4][2], B0[2][2], B1[2][2];
    unsigned oc[2][2], on[2][2]; const char* cB; const char* nB;
    S.setup(cur, Rl, Cb, oc, cB);
    S.a_ready(cur);
    PG8_STAGE(PG8_SB(0, 0), cB, voffB); PG8_STAGE(PG8_SB(0, 1), cB + hstep, voffB); PG8_STAGE(PG8_SA(0, 0), gA, oc[0]); PG8_STAGE(PG8_SA(0, 1), gA, oc[1]);
    if (wr == 1) PG8_BAR;
    PG8_WAIT_V(2); PG8_BAR;
    PG8_STAGE(PG8_SB(1, 0), cB + kstep, voffB); PG8_STAGE(PG8_SA(1, 0), gA + kstep, oc[0]); PG8_STAGE(PG8_SB(1, 1), cB + hstep + kstep, voffB);
    PG8_WAIT_V(6); PG8_BAR;
    for (;;) {
        const bool has_next = S.next(ui + 1, nxt);
        if (has_next) S.setup(nxt, Rl, Cb, on, nB);
        else { nB = cB;
#pragma unroll
            for (int h = 0; h < 2; ++h)
#pragma unroll
                for (int i = 0; i < 2; ++i) on[h][i] = oc[h][i]; }
        for (int t = 0; t < nt; t += 2) {
            const bool last = (t == nt - 2);
            const char* a1 = gA + (size_t)(t + 1) * kstep;
            const char* a2 = last ? gA : gA + (size_t)(t + 2) * kstep; const char* b2 = last ? nB : cB + (size_t)(t + 2) * kstep;
            const char* a3 = a2 + kstep; const char* b3 = b2 + kstep;
            unsigned o2[2][2];
#pragma unroll
            for (int h = 0; h < 2; ++h)
#pragma unroll
                for (int i = 0; i < 2; ++i) o2[h][i] = last ? on[h][i] : oc[h][i];
            if (last && has_next) S.a_ready(nxt);
            PG8_LDB(B0, 0, 0); PG8_LDB(B1, 0, 1); PG8_SCHED; PG8_LDA(At, 0, 0); PG8_STAGE(PG8_SA(1, 1), a1, oc[1]);
            PG8_WAIT_V(8); PG8_WAIT_L(0); PG8_BAR; PG8_MMA(0, 0, At, B0); PG8_MMA(0, 1, At, B1); PG8_BAR; PG8_SCHED;
            PG8_LDA(At, 0, 1); PG8_STAGE(PG8_SB(0, 0), b2, voffB); PG8_STAGE(PG8_SB(0, 1), b2 + hstep, voffB); PG8_STAGE(PG8_SA(0, 0), a2, o2[0]);
            PG8_WAIT_V(8); PG8_WAIT_L(0); PG8_BAR; PG8_MMA(1, 0, At, B0); PG8_MMA(1, 1, At, B1); PG8_BAR; PG8_SCHED;
            PG8_LDB(B0, 1, 0); PG8_LDB(B1, 1, 1); PG8_SCHED; PG8_LDA(At, 1, 0); PG8_STAGE(PG8_SA(0, 1), a2, o2[1]);
            PG8_WAIT_V(8); PG8_WAIT_L(0); PG8_BAR; PG8_MMA(0, 0, At, B0); PG8_MMA(0, 1, At, B1); PG8_BAR; PG8_SCHED;
            PG8_LDA(At, 1, 1); PG8_STAGE(PG8_SB(1, 0), b3, voffB); PG8_STAGE(PG8_SB(1, 1), b3 + hstep, voffB); PG8_STAGE(PG8_SA(1, 0), a3, o2[0]);
            PG8_WAIT_V(8); PG8_WAIT_L(0); PG8_BAR; PG8_MMA(1, 0, At, B0); PG8_MMA(1, 1, At, B1); PG8_BAR; PG8_SCHED;
        }
        if constexpr (ALIGN_EPI) { if (wr == 0) PG8_BAR; }
        E(acc, cur, wr, wc, fr, fq); S.done(cur);
        if (!has_next) break;
#pragma unroll
        for (int a = 0; a < 2; ++a)
#pragma unroll
            for (int b = 0; b < 2; ++b)
#pragma unroll
                for (int m = 0; m < 4; ++m)
#pragma unroll
                    for (int n = 0; n < 2; ++n) acc[a][b][m][n] = (f32x4){0.f, 0.f, 0.f, 0.f};
        cur = nxt; cB = nB; ++ui;
#pragma unroll
        for (int h = 0; h < 2; ++h)
#pragma unroll
            for (int i = 0; i < 2; ++i) oc[h][i] = on[h][i];
        if constexpr (ALIGN_EPI) { if (wr == 1) PG8_BAR; }
    }
    PG8_WAIT_V(0);
    if constexpr (!ALIGN_EPI) { if (wr == 0) PG8_BAR; }
    PG8_BAR;
#undef PG8_SA
#undef PG8_SB
#undef PG8_STAGE
#undef PG8_LDA
#undef PG8_LDB
#undef PG8_MMA
#undef PG8_WAIT_V
#undef PG8_WAIT_L
#undef PG8_BAR
#undef PG8_SCHED
}
}
#ifndef RS1
#define RS1 13
#define RS2 22
#define RS3 28
#endif
namespace ret {
constexpr int QB0 = 0, KB0 = 32768, VB0 = 65536, ST0 = 98304;
constexpr int RET_LDS_BYTES = ST0 + 2 * 8192;
__device__ __forceinline__ int toff(int row, int c16) { return row * 128 + ((c16 ^ (row & 7)) << 4); }
typedef short v4i16_t __attribute__((ext_vector_type(4)));
__device__ __forceinline__ v4i16_t trd(const LAS unsigned char* p) { return __builtin_amdgcn_ds_read_tr16_b64_v4i16((LAS v4i16_t*)p); }
__device__ __forceinline__ bf16x8 cat8(v4i16_t a, v4i16_t b) { return (bf16x8){a[0], a[1], a[2], a[3], b[0], b[1], b[2], b[3]}; }

#define RET_KEEP(x) asm volatile("" :: "v"(x))
__device__ __forceinline__ float xsum_16_32(float v) {
    { auto rr = __builtin_amdgcn_permlane16_swap(__float_as_uint(v), __float_as_uint(v), false, false); v = __uint_as_float(rr[0]) + __uint_as_float(rr[1]); }
    { auto rr = __builtin_amdgcn_permlane32_swap(__float_as_uint(v), __float_as_uint(v), false, false); v = __uint_as_float(rr[0]) + __uint_as_float(rr[1]); }
    return v;
}
__device__ __forceinline__ void ret_unit(int b, int h, int seg, const bf16* PROJ, bf16* CAT, float gC, LAS unsigned char* lds) {
    int tid_ = threadIdx.x; asm volatile("" : "+v"(tid_));
    const int tid = tid_, lane = tid & 63, w = __builtin_amdgcn_readfirstlane(tid >> 6), g = lane >> 4, c15 = lane & 15;
    const int blk = w < 4 ? w : 11 - w;
    const bf16* base = PROJ + (size_t)b * SEQ * INW;
    const int nfirst = seg == 0 ? 0 : seg == 1 ? RS1 : seg == 2 ? RS2 : RS3, nend = seg == 0 ? RS1 : seg == 1 ? RS2 : seg == 2 ? RS3 : 32;
    const int dr = lane >> 3, dc = (lane & 7) ^ dr;
#define RET_DMA(tileoff, colbase, m) do { _Pragma("unroll") for (int _p = 0; _p < 2; ++_p) { const int pc = w + 8 * _p; \
        __builtin_amdgcn_global_load_lds((const unsigned*)(base + (size_t)((m) * 128 + 8 * pc + dr) * INW + (colbase) + h * 64 + dc * 8), (LAS unsigned*)(lds + (tileoff) + pc * 1024), 16, 0, 0); } } while (0)
    f32x4 sacc[2]; sacc[0] = (f32x4){0.f, 0.f, 0.f, 0.f}; sacc[1] = (f32x4){0.f, 0.f, 0.f, 0.f};
    const int et_s = w >> 1, dt0 = 2 * (w & 1);
    if (nfirst > 0) {
        bf16x8 kprev = (bf16x8){0, 0, 0, 0, 0, 0, 0, 0}, vprev2 = kprev;
        RET_DMA(0, C_RK, 0); RET_DMA(16384, C_RV, 0);
        if (nfirst > 1) { RET_DMA(32768, C_RK, 1); RET_DMA(32768 + 16384, C_RV, 1); }
#pragma unroll 1
        for (int m = 0; m < nfirst; ++m) {
            if (m + 1 < nfirst) asm volatile("s_waitcnt vmcnt(4) lgkmcnt(0)" ::: "memory"); else asm volatile("s_waitcnt vmcnt(0) lgkmcnt(0)" ::: "memory");
            __builtin_amdgcn_s_barrier(); asm volatile("" ::: "memory");
            if (m + 2 < nfirst) { const int s2 = ((m + 2) % 3) * 32768; RET_DMA(s2, C_RK, m + 2); RET_DMA(s2 + 16384, C_RV, m + 2); }
            const LAS unsigned char* Kt = lds + (m % 3) * 32768; const LAS unsigned char* Vt = Kt + 16384;
            sacc[0] = sacc[0] * gC; sacc[1] = sacc[1] * gC;
#pragma unroll
            for (int ks = 0; ks < 4; ++ks) {
                const int q = c15 >> 2, p = c15 & 3, r0 = 32 * ks + 8 * g + q;
                const bf16x8 vf = cat8(trd(Vt + toff(r0, 2 * et_s + (p >> 1)) + (p & 1) * 8), trd(Vt + toff(r0 + 4, 2 * et_s + (p >> 1)) + (p & 1) * 8));
#pragma unroll
                for (int dd = 0; dd < 2; ++dd) { const int c16 = 2 * (dt0 + dd) + (p >> 1);
                    const bf16x8 kf = cat8(trd(Kt + toff(r0, c16) + (p & 1) * 8), trd(Kt + toff(r0 + 4, c16) + (p & 1) * 8));
                    sacc[dd] = __builtin_amdgcn_mfma_f32_16x16x32_bf16(vf, kf, sacc[dd], 0, 0, 0); RET_KEEP(kprev); kprev = kf; }
                RET_KEEP(vprev2); vprev2 = vf;
            }
        }
        RET_KEEP(kprev); RET_KEEP(vprev2);
        asm volatile("s_waitcnt lgkmcnt(0)" ::: "memory"); __builtin_amdgcn_s_barrier(); asm volatile("" ::: "memory");
    }
    { LAS unsigned char* STi = lds + ST0 + (nfirst & 1) * 8192;
#pragma unroll
      for (int dd = 0; dd < 2; ++dd)
#pragma unroll
          for (int rr = 0; rr < 4; ++rr) { const int e = 16 * et_s + 4 * g + rr, d = 16 * (dt0 + dd) + c15;
              *(LAS unsigned short*)(STi + toff(e, d >> 3) + (d & 7) * 2) = (unsigned short)f2bf(sacc[dd][rr]); } }
    RET_DMA(KB0 + (nfirst & 1) * 16384, C_RK, nfirst); RET_DMA(VB0 + (nfirst & 1) * 16384, C_RV, nfirst); RET_DMA(QB0 + (nfirst & 1) * 16384, C_RQ, nfirst);
    __syncthreads();
#define RET_STATE_UPDATE() do { if (m + 1 < nend) { bf16x8 kfp = (bf16x8){0, 0, 0, 0, 0, 0, 0, 0}, vfp = kfp; sacc[0] = sacc[0] * gC; sacc[1] = sacc[1] * gC; _Pragma("unroll") for (int ks = 0; ks < 4; ++ks) { const int q = c15 >> 2, p = c15 & 3, r0 = 32 * ks + 8 * g + q; const bf16x8 vf = cat8(trd(Vt + toff(r0, 2 * et_s + (p >> 1)) + (p & 1) * 8), trd(Vt + toff(r0 + 4, 2 * et_s + (p >> 1)) + (p & 1) * 8)); _Pragma("unroll") for (int dd = 0; dd < 2; ++dd) { const int c16 = 2 * (dt0 + dd) + (p >> 1); const bf16x8 kf = cat8(trd(Kt + toff(r0, c16) + (p & 1) * 8), trd(Kt + toff(r0 + 4, c16) + (p & 1) * 8)); sacc[dd] = __builtin_amdgcn_mfma_f32_16x16x32_bf16(vf, kf, sacc[dd], 0, 0, 0); if (dd == 1) { RET_KEEP(kfp); } kfp = kf; } RET_KEEP(vfp); vfp = vf; } _Pragma("unroll") for (int dd = 0; dd < 2; ++dd) _Pragma("unroll") for (int r = 0; r < 4; ++r) { const int e = 16 * et_s + 4 * g + r, d = 16 * (dt0 + dd) + c15; *(LAS unsigned short*)(STn + toff(e, d >> 3) + (d & 7) * 2) = (unsigned short)f2bf(sacc[dd][r]); } RET_KEEP(kfp); RET_KEEP(vfp); } } while (0)
#pragma unroll 1
    for (int m = nfirst; m < nend; ++m) {
        const int cur = m & 1, nx = cur ^ 1; const bool full = true;
        if (m + 1 < nend) { RET_DMA(KB0 + nx * 16384, C_RK, m + 1); RET_DMA(VB0 + nx * 16384, C_RV, m + 1); RET_DMA(QB0 + nx * 16384, C_RQ, m + 1); }
        const LAS unsigned char* Qt = lds + QB0 + cur * 16384; const LAS unsigned char* Kt = lds + KB0 + cur * 16384; const LAS unsigned char* Vt = lds + VB0 + cur * 16384;
        const LAS unsigned char* STc = lds + ST0 + cur * 8192; LAS unsigned char* STn = lds + ST0 + nx * 8192;
        if (full) {
            const size_t row = (size_t)b * SEQ + m * 128 + 16 * blk + c15;
            u32x2 gg[4];
#pragma unroll
            for (int et = 0; et < 4; ++et) gg[et] = *(const GAS u32x2*)(PROJ + row * INW + C_RG + h * 64 + 16 * et + 4 * g);
            bf16x8 qf[2];
#pragma unroll
            for (int ks = 0; ks < 2; ++ks) qf[ks] = *(const LAS bf16x8*)(Qt + toff(16 * blk + c15, 4 * ks + g));
            bf16x8 pf[4];
#pragma unroll
            for (int ks = 0; ks < 4; ++ks) {
                f32x4 s0 = (f32x4){0.f, 0.f, 0.f, 0.f}, s1 = (f32x4){0.f, 0.f, 0.f, 0.f};
                bf16x8 ka[2], kb[2]; ka[0] = ka[1] = kb[0] = kb[1] = (bf16x8){0, 0, 0, 0, 0, 0, 0, 0};
                if (2 * ks <= blk) {
#pragma unroll
                    for (int kk = 0; kk < 2; ++kk) { ka[kk] = *(const LAS bf16x8*)(Kt + toff(32 * ks + c15, 4 * kk + g)); s0 = __builtin_amdgcn_mfma_f32_16x16x32_bf16(ka[kk], qf[kk], s0, 0, 0, 0); }
                    if (2 * ks == blk) {
#pragma unroll
                        for (int r = 0; r < 4; ++r) if (4 * g + r > c15) s0[r] = 0.f; }
                }
                if (2 * ks + 1 <= blk) {
#pragma unroll
                    for (int kk = 0; kk < 2; ++kk) { kb[kk] = *(const LAS bf16x8*)(Kt + toff(32 * ks + 16 + c15, 4 * kk + g)); s1 = __builtin_amdgcn_mfma_f32_16x16x32_bf16(kb[kk], qf[kk], s1, 0, 0, 0); }
                    if (2 * ks + 1 == blk) {
#pragma unroll
                        for (int r = 0; r < 4; ++r) if (4 * g + r > c15) s1[r] = 0.f; }
                }
                u32x4 pk; pk.x = pk2(s0[0], s0[1]); pk.y = pk2(s0[2], s0[3]); pk.z = pk2(s1[0], s1[1]); pk.w = pk2(s1[2], s1[3]);
                pf[ks] = __builtin_bit_cast(bf16x8, pk);
                RET_KEEP(ka[0]); RET_KEEP(ka[1]); RET_KEEP(kb[0]); RET_KEEP(kb[1]);
            }
            f32x4 o[4];
            bf16x8 vprev[4]; vprev[0] = vprev[1] = vprev[2] = vprev[3] = (bf16x8){0, 0, 0, 0, 0, 0, 0, 0};
#pragma unroll
            for (int et = 0; et < 4; ++et) {
                f32x4 a = (f32x4){0.f, 0.f, 0.f, 0.f};
                bf16x8 sf[2], vcur[4]; vcur[0] = vcur[1] = vcur[2] = vcur[3] = (bf16x8){0, 0, 0, 0, 0, 0, 0, 0};
#pragma unroll
                for (int kk = 0; kk < 2; ++kk) { sf[kk] = *(const LAS bf16x8*)(STc + toff(16 * et + c15, 4 * kk + g)); a = __builtin_amdgcn_mfma_f32_16x16x32_bf16(sf[kk], qf[kk], a, 0, 0, 0); }
                a = a * gC;
#pragma unroll
                for (int ks = 0; ks < 4; ++ks) if (2 * ks <= blk) {
                    const int q = c15 >> 2, p = c15 & 3, r0 = 32 * ks + 4 * g + q, c16 = 2 * et + (p >> 1);
                    const v4i16_t v0 = trd(Vt + toff(r0, c16) + (p & 1) * 8), v1 = trd(Vt + toff(r0 + 16, c16) + (p & 1) * 8);
                    vcur[ks] = cat8(v0, v1);
                    a = __builtin_amdgcn_mfma_f32_16x16x32_bf16(vcur[ks], pf[ks], a, 0, 0, 0);
                }
                o[et] = a;
                RET_KEEP(sf[0]); RET_KEEP(sf[1]);
#pragma unroll
                for (int ks = 0; ks < 4; ++ks) { RET_KEEP(vprev[ks]); vprev[ks] = vcur[ks]; }
            }
            RET_STATE_UPDATE();
#pragma unroll
            for (int ks = 0; ks < 4; ++ks) { RET_KEEP(vprev[ks]); RET_KEEP(pf[ks]); }
            RET_KEEP(qf[0]); RET_KEEP(qf[1]);
            float s = 0.f;
#pragma unroll
            for (int et = 0; et < 4; ++et) s += (o[et][0] + o[et][1]) + (o[et][2] + o[et][3]);
            s = xsum_16_32(s);
            const float mean = s * (1.f / 64.f); float q2 = 0.f;
#pragma unroll
            for (int et = 0; et < 4; ++et) { o[et] = o[et] - mean; q2 += (o[et][0] * o[et][0] + o[et][1] * o[et][1]) + (o[et][2] * o[et][2] + o[et][3] * o[et][3]); }
            q2 = xsum_16_32(q2);
            const float rstd = 1.f / sqrtf(q2 * (1.f / 64.f) + LN_EPS);
#pragma unroll
            for (int et = 0; et < 4; ++et) {
                const float g0 = __uint_as_float(gg[et].x << 16), g1 = __uint_as_float(gg[et].x & 0xffff0000u), g2 = __uint_as_float(gg[et].y << 16), g3 = __uint_as_float(gg[et].y & 0xffff0000u);
                u32x2 wv; wv.x = pk2(o[et][0] * rstd * g0, o[et][1] * rstd * g1); wv.y = pk2(o[et][2] * rstd * g2, o[et][3] * rstd * g3);
                *(GAS u32x2*)(CAT + row * DM + h * 64 + 16 * et + 4 * g) = wv; asm volatile("s_nop 1" :: "v"(wv.x), "v"(wv.y) : "memory"); }
        }
        else { RET_STATE_UPDATE(); }
        __syncthreads();
    }
#undef RET_DMA
#undef RET_STATE_UPDATE
#undef RET_KEEP
}
}
constexpr int MK_TAB_OFF = 131072 + 512, MK_TOKS_OFF = 131072 + 4096, MK_CW_MOEC = 70000;
namespace pg8 {
struct MUnit : Unit { int kind; };
template <int MODE>
struct MoeMk {
    static constexpr int G = 256;
    int nMt, n1, c, l; unsigned need; const LAS unsigned char* ldsb; const bf16* Wgu; const bf16* Wd; gu32* ctl;
    __device__ __forceinline__ const LAS int* tab() const { return (const LAS int*)(ldsb + MK_TAB_OFF); }
    __device__ __forceinline__ const LAS int* toks() const { return (const LAS int*)(ldsb + MK_TOKS_OFF); }
    __device__ __forceinline__ unsigned* ready() const { return (unsigned*)(ctl + MK_CW_MOEC + l * 288 * 64); }
    __device__ __forceinline__ bool next(int i, MUnit& u) const {
        long L = (long)i * G + c; int kind = MODE;
        if (MODE == 2) {
            const int q = n1 / G, rem = n1 % G, q1 = q + (c < rem ? 1 : 0);
            if (i < q1) kind = 0;
            else { kind = 1; const int j = i - q1, light = G - rem, F = (n1 - light) / G, part = (n1 - light) % G; long k;
                if (rem == 0) k = (long)j * G + c;
                else if (c >= rem) { if (j == 0) k = c - rem; else if (j <= F) k = light + (long)(j - 1) * G + c; else if (j == F + 1 && (c - rem) < part) k = light + (long)F * G + (c - rem); else return false; }
                else { if (j < F) k = light + (long)j * G + c; else return false; }
                if (k >= n1) return false; L = k; }
        } else if (L >= n1) return false;
        const int nN = 4, nwg = n1; int wgid = (int)L; { const int q = nwg / NXCD, r = nwg % NXCD, xcd = wgid % NXCD, off = wgid / NXCD; wgid = (xcd < r ? xcd * (q + 1) : r * (q + 1) + (xcd - r) * q) + off; }
        const int nig = WGM * nN, gid = wgid / nig, fm = gid * WGM, gsz = (nMt - fm) < WGM ? (nMt - fm) : WGM;
        u.pm = fm + ((wgid % nig) % gsz); u.pn = (wgid % nig) / gsz; u.kind = kind; return true;
    }
    __device__ __forceinline__ int kdim(const MUnit& u) const { return u.kind ? DE : DM; }
    __device__ __forceinline__ void setup(const MUnit& u, const int (&Rl)[2], const int (&Cb)[2], unsigned (&off)[2][2], const char*& bptr, int ui) const {
        const int e = tab()[1 + u.pm] & 255;
        if (u.kind == 0) {
#pragma unroll
            for (int h = 0; h < 2; ++h)
#pragma unroll
                for (int i = 0; i < 2; ++i) off[h][i] = (unsigned)WS_S1 + (unsigned)(toks()[ui * 256 + h * 128 + Rl[i]] * DM * 2 + Cb[i]);
            bptr = (const char*)Wgu + (size_t)(e * 4 + u.pn) * 256 * DM * 2;
        } else {
#pragma unroll
            for (int h = 0; h < 2; ++h)
#pragma unroll
                for (int i = 0; i < 2; ++i) off[h][i] = (unsigned)WS_HE + (unsigned)((u.pm * 256 + h * 128 + Rl[i]) * DE * 2 + Cb[i]);
            bptr = (const char*)Wd + (size_t)(e * 4 + u.pn) * 256 * DE * 2;
        }
    }
    __device__ __forceinline__ void a_ready(const MUnit& u) const {
        if (MODE != 2 || u.kind == 0) return;
        if (threadIdx.x < 64) {
            unsigned* rd = ready() + 64 * u.pm; unsigned* tmo = (unsigned*)ctl;
            const unsigned long long t0 = __builtin_amdgcn_s_memrealtime(); unsigned polls = 0;
            while ((unsigned)__builtin_amdgcn_readfirstlane(__hip_atomic_load(rd, __ATOMIC_RELAXED, __HIP_MEMORY_SCOPE_AGENT)) < need) {
                if ((++polls & 255u) == 0u && __builtin_amdgcn_readfirstlane(__hip_atomic_load(tmo, __ATOMIC_RELAXED, __HIP_MEMORY_SCOPE_AGENT)) != 0u) break;
                if (__builtin_amdgcn_s_memrealtime() - t0 > 2000000ull) { if (threadIdx.x == 0) __hip_atomic_store(tmo, 1u, __ATOMIC_RELAXED, __HIP_MEMORY_SCOPE_AGENT); break; }
                __builtin_amdgcn_s_sleep(2); }
#if defined(MOE_ACQ) && MOE_ACQ
            __builtin_amdgcn_fence(__ATOMIC_ACQUIRE, "agent");
#endif
            asm volatile("s_waitcnt vmcnt(0)" ::: "memory");
        }
        asm volatile("" ::: "memory"); __builtin_amdgcn_s_barrier(); asm volatile("" ::: "memory");
    }
    __device__ __forceinline__ void done(const MUnit& u) const {
        if (MODE != 2 || u.kind != 0) return;
        asm volatile("s_waitcnt vmcnt(0)" ::: "memory");
        if ((threadIdx.x & 63) == 0) __hip_atomic_fetch_add(ready() + 64 * u.pm, 1u, __ATOMIC_RELAXED, __HIP_MEMORY_SCOPE_AGENT);
    }
};
struct EpiGateUpWT {
    static constexpr bool PERM = true;
    bf16* HE;
    __device__ __forceinline__ void operator()(const f32x4 (&acc)[2][2][4][2], const Unit& u, int wr, int wc, int fr, int fq) const {
        const __amdgpu_buffer_rsrc_t rs = __builtin_amdgcn_make_buffer_rsrc((void*)HE, 0, PAIR_ROWS * DE * 2, 0x00020000);
        EPI_T_LANES(); const int row0 = u.pm * BM + wr * 64 + fr2, col0 = u.pn * 128 + wc * 32 + 8 * fq2;
#pragma unroll
        for (int ai = 0; ai < 2; ++ai)
#pragma unroll
            for (int m = 0; m < 4; ++m) { const f32x4 g0 = acc[ai][0][m][0], g1 = acc[ai][0][m][1], u0 = acc[ai][1][m][0], u1 = acc[ai][1][m][1];
                u32x4 w; w.x = cvt_pk_bf16(fsilu(g0[0]) * u0[0], fsilu(g0[1]) * u0[1]); w.y = cvt_pk_bf16(fsilu(g0[2]) * u0[2], fsilu(g0[3]) * u0[3]);
                w.z = cvt_pk_bf16(fsilu(g1[0]) * u1[0], fsilu(g1[1]) * u1[1]); w.w = cvt_pk_bf16(fsilu(g1[2]) * u1[2], fsilu(g1[3]) * u1[3]);
                __builtin_amdgcn_raw_buffer_store_b128(tr4(w, src4), rs, (int)(((size_t)(row0 + ai * HALF + m * 16) * DE + col0) * 2), 0, 16); }
    }
};

template <class Sched, class Epi0, class Epi1>
__device__ __forceinline__ void gemm_phase_mk(LAS unsigned char* lds, const char* gA, const Sched& S, const Epi0& E0, const Epi1& E1) {
    int tid_ = threadIdx.x; asm volatile("" : "+v"(tid_));
    const int tid = tid_, wid = __builtin_amdgcn_readfirstlane(tid >> 6), lane = tid & 63, wr = wid >> 2, wc = wid & 3, fr = lane & 15, fq = lane >> 4;
    int Rl[2], Cb[2], Rbp[2];
#pragma unroll
    for (int i = 0; i < 2; ++i) { int R, C; stage_rc(tid * 16 + i * 8192, R, C); Rbp[i] = (R & ~31) + perm32(R & 31); Rl[i] = R; Cb[i] = C * 2; }
    const size_t kstep = (size_t)(BK * 2);
    const unsigned ldsw = (unsigned)wid * 1024u;
    const int aoff = lds_byte(wr * 64 + fr, fq * 8), boff = lds_byte(wc * 32 + fr, fq * 8);
#define PG8_SA(b, h) (((b) * 2 + (h)) * HTB)
#define PG8_SB(b, h) ((4 + (b) * 2 + (h)) * HTB)
#define PG8_STAGE(bufoff, gbase, voff) do { _Pragma("unroll") for (int _i = 0; _i < 2; ++_i) \
        __builtin_amdgcn_global_load_lds((const unsigned*)((const char*)(gbase) + (voff)[_i]), (LAS unsigned*)(lds + (bufoff) + ldsw + _i * 8192), 16, 0, 0); } while (0)
#define PG8_LDA(dst, b, h) do { _Pragma("unroll") for (int m = 0; m < 4; ++m) _Pragma("unroll") for (int k = 0; k < 2; ++k) dst[m][k] = *(const LAS bf16x8*)(lds + PG8_SA(b, h) + aoff + m * 2048 + k * 1024); } while (0)
#define PG8_LDB(dst, b, h) do { _Pragma("unroll") for (int n = 0; n < 2; ++n) _Pragma("unroll") for (int k = 0; k < 2; ++k) dst[n][k] = *(const LAS bf16x8*)(lds + PG8_SB(b, h) + boff + n * 2048 + k * 1024); } while (0)
#define PG8_MMA(ai, bj, At, Bt) do { __builtin_amdgcn_s_setprio(1); _Pragma("unroll") for (int m = 0; m < 4; ++m) _Pragma("unroll") for (int n = 0; n < 2; ++n) _Pragma("unroll") for (int k = 0; k < 2; ++k) \
        acc[ai][bj][m][n] = __builtin_amdgcn_mfma_f32_16x16x32_bf16(Bt[n][k], At[m][k], acc[ai][bj][m][n], 0, 0, 0); __builtin_amdgcn_s_setprio(0); } while (0)
#define PG8_WAIT_V(n) asm volatile("s_waitcnt vmcnt(" #n ")" ::: "memory")
#define PG8_WAIT_L(n) asm volatile("s_waitcnt lgkmcnt(" #n ")" ::: "memory")
#define PG8_BAR __builtin_amdgcn_s_barrier()
#define PG8_SCHED __builtin_amdgcn_sched_barrier(0)
    MUnit cur, nxt; int ui = 0;
    if (!S.next(0, cur)) return;
    f32x4 acc[2][2][4][2];
#pragma unroll
    for (int a = 0; a < 2; ++a)
#pragma unroll
        for (int b = 0; b < 2; ++b)
#pragma unroll
            for (int m = 0; m < 4; ++m)
#pragma unroll
                for (int n = 0; n < 2; ++n) acc[a][b][m][n] = (f32x4){0.f, 0.f, 0.f, 0.f};
    bf16x8 At[4][2], B0[2][2], B1[2][2];
    unsigned oc[2][2], on[2][2], vBc[2], vBn[2]; const char* cB; const char* nB; size_t hsc, hsn; int ntc, ntn;
    { const int Kc = S.kdim(cur); ntc = Kc / BK; hsc = (size_t)HALF * Kc * 2;
#pragma unroll
      for (int i = 0; i < 2; ++i) vBc[i] = (unsigned)(Rbp[i] * Kc * 2 + Cb[i]); }
    S.setup(cur, Rl, Cb, oc, cB, 0);
    S.a_ready(cur);
    PG8_STAGE(PG8_SB(0, 0), cB, vBc); PG8_STAGE(PG8_SB(0, 1), cB + hsc, vBc); PG8_STAGE(PG8_SA(0, 0), gA, oc[0]); PG8_STAGE(PG8_SA(0, 1), gA, oc[1]);
    if (wr == 1) PG8_BAR;
    PG8_WAIT_V(2); PG8_BAR;
    PG8_STAGE(PG8_SB(1, 0), cB + kstep, vBc); PG8_STAGE(PG8_SA(1, 0), gA + kstep, oc[0]); PG8_STAGE(PG8_SB(1, 1), cB + hsc + kstep, vBc);
    PG8_WAIT_V(6); PG8_BAR;
    for (;;) {
        const bool has_next = S.next(ui + 1, nxt);
        if (has_next) { S.setup(nxt, Rl, Cb, on, nB, ui + 1); const int Kn = S.kdim(nxt); ntn = Kn / BK; hsn = (size_t)HALF * Kn * 2;
#pragma unroll
            for (int i = 0; i < 2; ++i) vBn[i] = (unsigned)(Rbp[i] * Kn * 2 + Cb[i]); }
        else { nB = cB; hsn = hsc; ntn = ntc;
#pragma unroll
            for (int i = 0; i < 2; ++i) vBn[i] = vBc[i];
#pragma unroll
            for (int h = 0; h < 2; ++h)
#pragma unroll
                for (int i = 0; i < 2; ++i) on[h][i] = oc[h][i]; }
        for (int t = 0; t < ntc; t += 2) {
            const bool last = (t == ntc - 2);
            const char* a1 = gA + (size_t)(t + 1) * kstep;
            const char* a2 = last ? gA : gA + (size_t)(t + 2) * kstep; const char* b2 = last ? nB : cB + (size_t)(t + 2) * kstep;
            const char* a3 = a2 + kstep; const char* b3 = b2 + kstep;
            unsigned o2[2][2], v2[2]; const size_t hs2 = last ? hsn : hsc;
#pragma unroll
            for (int i = 0; i < 2; ++i) v2[i] = last ? vBn[i] : vBc[i];
#pragma unroll
            for (int h = 0; h < 2; ++h)
#pragma unroll
                for (int i = 0; i < 2; ++i) o2[h][i] = last ? on[h][i] : oc[h][i];
            if (last && has_next) S.a_ready(nxt);
            PG8_LDB(B0, 0, 0); PG8_LDB(B1, 0, 1); PG8_SCHED; PG8_LDA(At, 0, 0); PG8_STAGE(PG8_SA(1, 1), a1, oc[1]);
            PG8_WAIT_V(8); PG8_WAIT_L(0); PG8_BAR; PG8_MMA(0, 0, At, B0); PG8_MMA(0, 1, At, B1); PG8_BAR; PG8_SCHED;
            PG8_LDA(At, 0, 1); PG8_STAGE(PG8_SB(0, 0), b2, v2); PG8_STAGE(PG8_SB(0, 1), b2 + hs2, v2); PG8_STAGE(PG8_SA(0, 0), a2, o2[0]);
            PG8_WAIT_V(8); PG8_WAIT_L(0); PG8_BAR; PG8_MMA(1, 0, At, B0); PG8_MMA(1, 1, At, B1); PG8_BAR; PG8_SCHED;
            PG8_LDB(B0, 1, 0); PG8_LDB(B1, 1, 1); PG8_SCHED; PG8_LDA(At, 1, 0); PG8_STAGE(PG8_SA(0, 1), a2, o2[1]);
            PG8_WAIT_V(8); PG8_WAIT_L(0); PG8_BAR; PG8_MMA(0, 0, At, B0); PG8_MMA(0, 1, At, B1); PG8_BAR; PG8_SCHED;
            PG8_LDA(At, 1, 1); PG8_STAGE(PG8_SB(1, 0), b3, v2); PG8_STAGE(PG8_SB(1, 1), b3 + hs2, v2); PG8_STAGE(PG8_SA(1, 0), a3, o2[0]);
            PG8_WAIT_V(8); PG8_WAIT_L(0); PG8_BAR; PG8_MMA(1, 0, At, B0); PG8_MMA(1, 1, At, B1); PG8_BAR; PG8_SCHED;
        }
        if (wr == 0) PG8_BAR;
        if (cur.kind == 0) E0(acc, cur, wr, wc, fr, fq); else E1(acc, cur, wr, wc, fr, fq);
        S.done(cur);
        if (!has_next) break;
#pragma unroll
        for (int a = 0; a < 2; ++a)
#pragma unroll
            for (int b = 0; b < 2; ++b)
#pragma unroll
                for (int m = 0; m < 4; ++m)
#pragma unroll
                    for (int n = 0; n < 2; ++n) acc[a][b][m][n] = (f32x4){0.f, 0.f, 0.f, 0.f};
        cur = nxt; cB = nB; hsc = hsn; ntc = ntn; ++ui;
#pragma unroll
        for (int i = 0; i < 2; ++i) vBc[i] = vBn[i];
#pragma unroll
        for (int h = 0; h < 2; ++h)
#pragma unroll
            for (int i = 0; i < 2; ++i) oc[h][i] = on[h][i];
        if (wr == 1) PG8_BAR;
    }
    PG8_WAIT_V(0);
    PG8_BAR;
#undef PG8_SA
#undef PG8_SB
#undef PG8_STAGE
#undef PG8_LDA
#undef PG8_LDB
#undef PG8_MMA
#undef PG8_WAIT_V
#undef PG8_WAIT_L
#undef PG8_BAR
#undef PG8_SCHED
}
}
namespace attn_body {
using bf16=__hip_bfloat16;
using bf16x8=__attribute__((ext_vector_type(8)))short;
using s16x4=__attribute__((ext_vector_type(4)))short;
using f32x16=__attribute__((ext_vector_type(16)))float;
using u32x4=__attribute__((ext_vector_type(4)))unsigned;
constexpr int SEQ=4096,D=64,PQ=3584,PO=1024;
constexpr int NW=8,QBLK=32,QB=QBLK*NW,KVBLK=64,NQB=SEQ/QB;
constexpr int ATTN_UNIT_ROWS=QB;
__device__ __forceinline__ int crow(int r,int hi){return (r&3)+8*(r>>2)+4*hi;}
#define SBAR() __builtin_amdgcn_sched_barrier(0)
__device__ __forceinline__ void cmask(f32x16&p0,f32x16&p1,int jb,int qrel,int hi){
  const float NEG=-INFINITY; int kb=64*jb+4*hi;
  #pragma unroll
  for(int r=0;r<16;++r){int kv=kb+(r&3)+8*(r>>2); if(kv>qrel)p0[r]=NEG; if(kv+32>qrel)p1[r]=NEG;}
}

constexpr int NSLOT=3, SLOTB=8192;
constexpr int LDS_K=0, LDS_V=NSLOT*SLOTB, LDS_WS=2*NSLOT*SLOTB, LDS_OST=LDS_WS+NW*64*4, LDS_BYTES=LDS_OST+NW*4096;
constexpr float C2=0.125f*1.4426950408889634f;
__device__ __forceinline__ void glds16(const void*gsrc,unsigned lds_dst){unsigned keep;
  asm volatile("s_mov_b32 %0, m0\n\ts_mov_b32 m0, %2\n\ts_nop 0\n\tglobal_load_lds_dwordx4 %1, off\n\ts_mov_b32 m0, %0":"=&s"(keep):"v"(gsrc),"s"(lds_dst):"memory");}
__device__ __forceinline__ float max3f(float a,float b,float c){float r;asm("v_max3_f32 %0, %1, %2, %3":"=v"(r):"v"(a),"v"(b),"v"(c));return r;}
__device__ __forceinline__ float max2f(float a,float b){float r;asm("v_max_f32_e32 %0, %1, %2":"=v"(r):"v"(a),"v"(b));return r;}
__device__ __forceinline__ float fadd_s(float a,float b){float r;asm("v_add_f32_e32 %0, %1, %2":"=v"(r):"v"(a),"v"(b));return r;}
__device__ __forceinline__ float fsub_s(float a,float b){float r;asm("v_sub_f32_e32 %0, %1, %2":"=v"(r):"v"(a),"v"(b));return r;}
typedef float f32x2_t __attribute__((ext_vector_type(2))); typedef __bf16 bf16x2_t __attribute__((ext_vector_type(2)));
__device__ __forceinline__ unsigned cvtpk_s(float lo,float hi){f32x2_t v={lo,hi};bf16x2_t b=__builtin_convertvector(v,bf16x2_t);return __builtin_bit_cast(unsigned,b);}
#define WAIT_BAR(N) asm volatile("s_waitcnt vmcnt(" #N ") lgkmcnt(0)\n\ts_barrier":::"memory")

__device__ __forceinline__ void qkt(f32x16&p0,f32x16&p1,const char*Kslot,const bf16x8*qr,const f32x16&negm,int r32,int hi){
  const char*kb=Kslot+hi*1024+r32*16;
  #pragma unroll
  for(int d0=0;d0<4;++d0){
    const bf16x8 b0=*reinterpret_cast<const bf16x8*>(kb+d0*2048);
    const bf16x8 b1=*reinterpret_cast<const bf16x8*>(kb+d0*2048+512);
    if(d0==0){p0=__builtin_amdgcn_mfma_f32_32x32x16_bf16(b0,qr[0],negm,0,0,0);p1=__builtin_amdgcn_mfma_f32_32x32x16_bf16(b1,qr[0],negm,0,0,0);}
    else{p0=__builtin_amdgcn_mfma_f32_32x32x16_bf16(b0,qr[d0],p0,0,0,0);p1=__builtin_amdgcn_mfma_f32_32x32x16_bf16(b1,qr[d0],p1,0,0,0);}}
}
typedef __attribute__((address_space(3))) const char* lds_cptr;
typedef short v4i16_t __attribute__((ext_vector_type(4)));
__device__ __forceinline__ void kload8(bf16x8*kf,lds_cptr kp){
  kf[0]=*(const __attribute__((address_space(3))) bf16x8*)(kp);      kf[1]=*(const __attribute__((address_space(3))) bf16x8*)(kp+512);
  kf[2]=*(const __attribute__((address_space(3))) bf16x8*)(kp+2048); kf[3]=*(const __attribute__((address_space(3))) bf16x8*)(kp+2560);
  kf[4]=*(const __attribute__((address_space(3))) bf16x8*)(kp+4096); kf[5]=*(const __attribute__((address_space(3))) bf16x8*)(kp+4608);
  kf[6]=*(const __attribute__((address_space(3))) bf16x8*)(kp+6144); kf[7]=*(const __attribute__((address_space(3))) bf16x8*)(kp+6656);
}
__device__ __forceinline__ void kload2(bf16x8*kf,lds_cptr kp,int j){ kf[2*j]=*(const __attribute__((address_space(3))) bf16x8*)(kp+j*2048); kf[2*j+1]=*(const __attribute__((address_space(3))) bf16x8*)(kp+j*2048+512); }
__device__ __forceinline__ s16x4 vtr(lds_cptr p){ return __builtin_bit_cast(s16x4,__builtin_amdgcn_ds_read_tr16_b64_v4i16((__attribute__((address_space(3))) v4i16_t*)p)); }
__device__ __forceinline__ float rowmax(const f32x16&p0,const f32x16&p1){
  float a=max3f(p0[0],p0[1],p1[0]),b=max3f(p0[2],p0[3],p1[1]);a=max3f(a,p1[2],p1[3]);
  #pragma unroll
  for(int r=4;r<16;r+=4){a=max3f(a,p0[r],p0[r+1]);b=max3f(b,p0[r+2],p0[r+3]);a=max3f(a,p1[r],p1[r+1]);b=max3f(b,p1[r+2],p1[r+3]);}
  const float m=max2f(a,b);
  auto rr=__builtin_amdgcn_permlane32_swap(__float_as_uint(m),__float_as_uint(m),false,false);
  return max2f(__uint_as_float(rr[0]),__uint_as_float(rr[1]));
}
__device__ __forceinline__ void pv(f32x16*o,int vb,bf16x8 pa0,bf16x8 pa1,bf16x8 pa2,bf16x8 pa3){
  #pragma unroll
  for(int d0=0;d0<2;++d0){s16x4 lo[4],hi[4];
    #pragma unroll
    for(int ks=0;ks<4;++ks){
      asm volatile("ds_read_b64_tr_b16 %0,%1 offset:%c2":"=&v"(lo[ks]):"v"(vb),"i"(d0*4096+ks*1024):"memory");
      asm volatile("ds_read_b64_tr_b16 %0,%1 offset:%c2":"=&v"(hi[ks]):"v"(vb),"i"(d0*4096+ks*1024+512):"memory");}
    asm volatile("s_waitcnt lgkmcnt(0)":::"memory");SBAR();
    #define PK(k) (bf16x8){lo[k][0],lo[k][1],lo[k][2],lo[k][3],hi[k][0],hi[k][1],hi[k][2],hi[k][3]}
    o[d0]=__builtin_amdgcn_mfma_f32_32x32x16_bf16(pa0,PK(0),o[d0],0,0,0);
    o[d0]=__builtin_amdgcn_mfma_f32_32x32x16_bf16(pa1,PK(1),o[d0],0,0,0);
    o[d0]=__builtin_amdgcn_mfma_f32_32x32x16_bf16(pa2,PK(2),o[d0],0,0,0);
    o[d0]=__builtin_amdgcn_mfma_f32_32x32x16_bf16(pa3,PK(3),o[d0],0,0,0);
    #undef PK
  }
}

#ifndef ATTN_STORE16
#define ATTN_STORE16(p,v) (*(u32x4*)(p)=(v))
#endif
template<int THRL> __device__ __forceinline__ void attn_unit(int qb,const bf16*Qh,const bf16*__restrict__ Kh,const bf16*__restrict__ Vh,bf16*Oh,char*shm){
  int tid_=threadIdx.x; asm volatile("":"+v"(tid_));
  const int tid=tid_,lane=tid&63,r32=lane&31,hi=lane>>5; const int wid=__builtin_amdgcn_readfirstlane(tid>>6);
  const int q0=qb*QB;
  const bf16*Qw=Qh+(long)(q0+wid*QBLK)*PQ;
  const unsigned lds0=(unsigned)(uintptr_t)shm;
  float*wsf=(float*)(shm+LDS_WS)+wid*64;
  const bf16*ksrc=Kh+(long)lane*PQ+wid*8;
  const bf16*vsrc=Vh+(long)(16*(wid&3)+(lane>>2))*PQ+(wid>>2)*32+(lane&3)*8;
  const unsigned kdst=lds0+LDS_K+wid*1024, vdst=lds0+LDS_V+wid*1024;
  #define DMA_K(t,slot) glds16(ksrc+(long)(t)*KVBLK*PQ,(unsigned)__builtin_amdgcn_readfirstlane(kdst+(slot)))
  #define DMA_V(t,slot) glds16(vsrc+(long)(t)*KVBLK*PQ,(unsigned)__builtin_amdgcn_readfirstlane(vdst+(slot)))
  const int vb0=(int)(lds0+LDS_V)+((lane>>4)&1)*32+(lane&3)*8+(4*hi+((lane&15)>>2))*64;
  const char*Kbase=shm+LDS_K; bf16x8 kf[8];
  const lds_cptr shm3=(lds_cptr)shm; const lds_cptr kp0=shm3+LDS_K+hi*1024+r32*16; const lds_cptr vp0=shm3+LDS_V+((lane>>4)&1)*32+(lane&3)*8+(4*hi+((lane&15)>>2))*64;
  const int NT=(q0+QB)/KVBLK;
  DMA_K(0,0);DMA_V(0,0);DMA_K(1,SLOTB);
  bf16x8 qr[4];
  #pragma unroll
  for(int d0=0;d0<4;++d0)qr[d0]=*reinterpret_cast<const bf16x8*>(&Qw[(long)r32*PQ+d0*16+hi*8]);
  float mhat=0.f,l_reg=0.f;f32x16 o[2];o[0]=f32x16{};o[1]=f32x16{};f32x16 negm=f32x16{};asm volatile("":"+v"(negm));
  const int qrel=wid*QBLK+r32;
  #define CMASK(P0,P1,t) do{int jb_=(t)-(NT-4); if(jb_>=0)cmask(P0,P1,jb_,qrel,hi);}while(0)
  bool resc=false;
  #define START(P0,P1) do{ const float rm=rowmax(P0,P1); resc=false; \
    { const float dl=rm; mhat=fadd_s(mhat,dl); \
      _Pragma("unroll") for(int r=0;r<16;++r){P0[r]=fsub_s(P0[r],dl);P1[r]=fsub_s(P1[r],dl);} \
      _Pragma("unroll") for(int r=0;r<16;++r)negm[r]=-mhat; asm volatile("":"+v"(negm)); } \
    _Pragma("unroll") for(int r=0;r<16;++r)P0[r]=__builtin_amdgcn_exp2f(P0[r]); }while(0)
  #define RESC() do{ if(resc){ asm volatile("s_waitcnt lgkmcnt(0)":::"memory"); \
      _Pragma("unroll") for(int d_=0;d_<2;++d_) _Pragma("unroll") for(int r=0;r<16;++r)o[d_][r]*=wsf[crow(r,hi)]; } }while(0)
  f32x16 pA0,pA1,pB0,pB1;
  int sl_prev=0,sl_cur=0,sl_next=SLOTB;
  #define ROT() do{sl_prev=sl_cur;sl_cur=sl_next;sl_next=(sl_next==(NSLOT-1)*SLOTB)?0:sl_next+SLOTB;}while(0)
  DMA_K(2,2*SLOTB);
  WAIT_BAR(3);
  qkt(pA0,pA1,Kbase,qr,negm,r32,hi);asm volatile("s_nop 15\n\ts_nop 7":"+v"(pA0),"+v"(pA1));CMASK(pA0,pA1,0);
  START(pA0,pA1);
  _Pragma("unroll") for(int r=0;r<16;++r)pA1[r]=__builtin_amdgcn_exp2f(pA1[r]);
  WAIT_BAR(0);
  DMA_K(3,0);DMA_V(1,SLOTB);
  ROT();
  kload8(kf,kp0+sl_cur);
  WAIT_BAR(2);
  s16x4 vlo[8],vhi[8]; u32x4 pw0,pw1,pw2,pw3;
  #define PKW(P,B) cvtpk_s(P[B],P[B+1])
  #define PAF(k) __builtin_bit_cast(bf16x8,pw##k)
  #define VFR(i) (bf16x8){vlo[i][0],vlo[i][1],vlo[i][2],vlo[i][3],vhi[i][0],vhi[i][1],vhi[i][2],vhi[i][3]}
  #define PIN(x) asm volatile("":"+v"(x))
  #define MX3(a,b,c) __builtin_fmaxf(__builtin_fmaxf((a),(b)),(c))
  #define GAPA(MF,A0,A1,A2,A3,W0,W1,PW) do{ MF; sacc+=A0; sacc+=A1; sacc+=A2; sacc+=A3; PIN(sacc); W0; W1; PIN(PW); SBAR(); }while(0)
  #define EX(v) __builtin_amdgcn_exp2f(v)
  #define GAPB(MF,X,B) do{ MF; X[B]=EX(X[B]); X[B+1]=EX(X[B+1]); X[B+2]=EX(X[B+2]); X[B+3]=EX(X[B+3]); PIN(X); SBAR(); }while(0)
  #define VRD(i) do{ vlo[i]=vtr(vp_+(((i)>>2)*4096+((i)&3)*1024)); vhi[i]=vtr(vp_+(((i)>>2)*4096+((i)&3)*1024+512)); }while(0)
  #define KRD(G,j) do{ if(G){ kload2(kf,kp0+sl_next,j); SBAR(); } }while(0)
  #define STEP(C0,C1,P0,P1,t,GK,GV,GL) do{ SBAR(); \
    const lds_cptr vp_=vp0+sl_prev; \
    VRD(0); SBAR(); float sacc=(P0[0]+P0[1]); \
    GAPA(C0=__builtin_amdgcn_mfma_f32_32x32x16_bf16(kf[0],qr[0],negm,0,0,0), P0[2],P0[3],P0[4],P0[5],     pw0[0]=PKW(P0,0), pw0[1]=PKW(P0,2), pw0); \
    VRD(4); SBAR(); GAPA(C1=__builtin_amdgcn_mfma_f32_32x32x16_bf16(kf[1],qr[0],negm,0,0,0), P0[6],P0[7],P0[8],P0[9],     pw0[2]=PKW(P0,4), pw0[3]=PKW(P0,6), pw0); \
    VRD(1); SBAR(); GAPA(C0=__builtin_amdgcn_mfma_f32_32x32x16_bf16(kf[2],qr[1],C0,0,0,0),   P0[10],P0[11],P0[12],P0[13], pw1[0]=PKW(P0,8), pw1[1]=PKW(P0,10), pw1); \
    VRD(5); SBAR(); GAPA(C1=__builtin_amdgcn_mfma_f32_32x32x16_bf16(kf[3],qr[1],C1,0,0,0),   P0[14],P0[15],P1[0],P1[1],   pw1[2]=PKW(P0,12),pw1[3]=PKW(P0,14), pw1); \
    VRD(2); SBAR(); GAPA(C0=__builtin_amdgcn_mfma_f32_32x32x16_bf16(kf[4],qr[2],C0,0,0,0),   P1[2],P1[3],P1[4],P1[5],     pw2[0]=PKW(P1,0), pw2[1]=PKW(P1,2), pw2); \
    VRD(6); SBAR(); GAPA(C1=__builtin_amdgcn_mfma_f32_32x32x16_bf16(kf[5],qr[2],C1,0,0,0),   P1[6],P1[7],P1[8],P1[9],     pw2[2]=PKW(P1,4), pw2[3]=PKW(P1,6), pw2); \
    VRD(3); SBAR(); GAPA(C0=__builtin_amdgcn_mfma_f32_32x32x16_bf16(kf[6],qr[3],C0,0,0,0),   P1[10],P1[11],P1[12],P1[13], pw3[0]=PKW(P1,8), pw3[1]=PKW(P1,10), pw3); \
    VRD(7); SBAR(); GAPA(C1=__builtin_amdgcn_mfma_f32_32x32x16_bf16(kf[7],qr[3],C1,0,0,0),   P1[14],P1[15],0.f,0.f,       pw3[2]=PKW(P1,12),pw3[3]=PKW(P1,14), pw3); \
    l_reg+=sacc; \
    if(GK){DMA_K((t)+3,sl_cur);} if(GV){DMA_V((t)+1,sl_next);} \
    CMASK(C0,C1,t); \
    { float a=MX3(C0[0],C0[1],C1[0]),b=MX3(C0[2],C0[3],C1[1]); a=MX3(a,C1[2],C1[3]); \
      _Pragma("unroll") for(int r=4;r<16;r+=4){a=MX3(a,C0[r],C0[r+1]);b=MX3(b,C0[r+2],C0[r+3]);a=MX3(a,C1[r],C1[r+1]);b=MX3(b,C1[r+2],C1[r+3]);} \
      float rm=__builtin_fmaxf(a,b); { auto rr=__builtin_amdgcn_permlane32_swap(__float_as_uint(rm),__float_as_uint(rm),false,false); rm=__builtin_fmaxf(__uint_as_float(rr[0]),__uint_as_float(rr[1])); } \
      resc=false; \
      if(__builtin_expect(__any(rm>(float)THRL),0)){ const float dl=__builtin_fmaxf(rm,0.f); mhat+=dl; \
        _Pragma("unroll") for(int r=0;r<16;++r){C0[r]-=dl;C1[r]-=dl;} \
        _Pragma("unroll") for(int r=0;r<16;++r)negm[r]=-mhat; asm volatile("":"+v"(negm)); \
        const float f=__builtin_amdgcn_exp2f(-dl); l_reg*=f; if(hi==0)wsf[r32]=f; resc=true; } } \
    SBAR(); \
    GAPB(o[0]=__builtin_amdgcn_mfma_f32_32x32x16_bf16(PAF(0),VFR(0),o[0],0,0,0), C0,0); \
    GAPB(o[1]=__builtin_amdgcn_mfma_f32_32x32x16_bf16(PAF(0),VFR(4),o[1],0,0,0), C0,4); \
    KRD(GL,0); GAPB(o[0]=__builtin_amdgcn_mfma_f32_32x32x16_bf16(PAF(1),VFR(1),o[0],0,0,0), C0,8); \
    KRD(GL,1); GAPB(o[1]=__builtin_amdgcn_mfma_f32_32x32x16_bf16(PAF(1),VFR(5),o[1],0,0,0), C0,12); \
    KRD(GL,2); GAPB(o[0]=__builtin_amdgcn_mfma_f32_32x32x16_bf16(PAF(2),VFR(2),o[0],0,0,0), C1,0); \
    KRD(GL,3); GAPB(o[1]=__builtin_amdgcn_mfma_f32_32x32x16_bf16(PAF(2),VFR(6),o[1],0,0,0), C1,4); \
    GAPB(o[0]=__builtin_amdgcn_mfma_f32_32x32x16_bf16(PAF(3),VFR(3),o[0],0,0,0), C1,8); \
    GAPB(o[1]=__builtin_amdgcn_mfma_f32_32x32x16_bf16(PAF(3),VFR(7),o[1],0,0,0), C1,12); \
    }while(0)
  int t=1;
  #undef CMASK
  #define CMASK(P0,P1,t) do{}while(0)
  for(;t+5<NT;t+=2){
    STEP(pB0,pB1,pA0,pA1,t,true,true,true);     WAIT_BAR(2); RESC(); ROT();
    STEP(pA0,pA1,pB0,pB1,t+1,true,true,true);   WAIT_BAR(2); RESC(); ROT();
  }
  #undef CMASK
  #define CMASK(P0,P1,t) do{int jb_=(t)-(NT-4); if(jb_>=0)cmask(P0,P1,jb_,qrel,hi);}while(0)
  #define ENDW(tt) do{ if((tt)+3<NT){WAIT_BAR(2);} else if((tt)+2<NT){WAIT_BAR(1);} else {WAIT_BAR(0);} }while(0)
  for(;t+1<NT;t+=2){
    STEP(pB0,pB1,pA0,pA1,t,(t+3<NT),(t+1<NT),(t+1<NT));       ENDW(t);   RESC(); ROT();
    STEP(pA0,pA1,pB0,pB1,t+1,(t+4<NT),(t+2<NT),(t+2<NT));     ENDW(t+1); RESC(); ROT();
  }
  STEP(pB0,pB1,pA0,pA1,NT-1,false,false,false); RESC();
  { float sacc=pB0[0]+pB0[1]; _Pragma("unroll") for(int r=2;r<16;++r)sacc+=pB0[r]; _Pragma("unroll") for(int r=0;r<16;++r)sacc+=pB1[r]; l_reg+=sacc;
    pw0=(u32x4){PKW(pB0,0),PKW(pB0,2),PKW(pB0,4),PKW(pB0,6)};pw1=(u32x4){PKW(pB0,8),PKW(pB0,10),PKW(pB0,12),PKW(pB0,14)};pw2=(u32x4){PKW(pB1,0),PKW(pB1,2),PKW(pB1,4),PKW(pB1,6)};pw3=(u32x4){PKW(pB1,8),PKW(pB1,10),PKW(pB1,12),PKW(pB1,14)};
    SBAR(); pv(o,vb0+sl_cur,PAF(0),PAF(1),PAF(2),PAF(3)); }
  #undef PKW
  #undef PAF
  #undef VFR
  #undef PIN
  #undef MX3
  #undef GAPA
  #undef GAPB
  #undef EX
  #undef VRD
  #undef KRD
  #undef STEP
  #undef ENDW
  {auto rr=__builtin_amdgcn_permlane32_swap(__float_as_uint(l_reg),__float_as_uint(l_reg),false,false);l_reg=__uint_as_float(rr[0])+__uint_as_float(rr[1]);}
  if(hi==0)wsf[32+r32]=l_reg;asm volatile("s_waitcnt lgkmcnt(0)":::"memory");
  float rli[16];
  #pragma unroll
  for(int r=0;r<16;++r)rli[r]=__builtin_amdgcn_rcpf(wsf[32+crow(r,hi)]);
  bf16*Ow=Oh+(long)(q0+wid*QBLK)*PO;
  { bf16*stg=(bf16*)(shm+LDS_OST)+wid*2048;
    #pragma unroll
    for(int r=0;r<16;++r){const int orow=crow(r,hi);
      #pragma unroll
      for(int d0=0;d0<2;++d0)stg[orow*64+d0*32+r32]=__float2bfloat16(o[d0][r]*rli[r]);}
    asm volatile("s_waitcnt lgkmcnt(0)":::"memory");
    #pragma unroll
    for(int i=0;i<4;++i){const int row=i*8+(lane>>3),ch=lane&7; const u32x4 v=*(const u32x4*)(stg+row*64+ch*8); ATTN_STORE16(Ow+(long)row*PO+ch*8,v);} }
  asm volatile("s_waitcnt lgkmcnt(0)\n\ts_barrier":::"memory");
  #undef DMA_K
  #undef DMA_V
  #undef CMASK
  #undef START
  #undef RESC
  #undef ROT
}
constexpr int ATTN_LDS_BYTES=LDS_BYTES;
#undef SBAR
#undef WAIT_BAR
}
#ifndef ATTN_STAG
#define ATTN_STAG 0
#endif
#ifndef ATTN_MIDPOS
#define ATTN_MIDPOS 0
#endif
namespace attn128 {
using bf16=__hip_bfloat16;
using bf16x8=__attribute__((ext_vector_type(8)))short;
using s16x4=__attribute__((ext_vector_type(4)))short;
using f32x16=__attribute__((ext_vector_type(16)))float;
using u32x4=__attribute__((ext_vector_type(4)))unsigned;
constexpr int SEQ=4096,D=64,PQ=3584,PO=1024;
constexpr int NW=8,QBLK=32,QB=QBLK*NW,KVBLK=64,NQB=SEQ/QB;
constexpr int ATTN_UNIT_ROWS=QB;
__device__ __forceinline__ int crow(int r,int hi){return (r&3)+8*(r>>2)+4*hi;}
#define SBAR() __builtin_amdgcn_sched_barrier(0)
__device__ __forceinline__ void cmask(f32x16&p0,f32x16&p1,int jb,int qrel,int hi){
  const float NEG=-INFINITY; int kb=64*jb+4*hi;
  #pragma unroll
  for(int r=0;r<16;++r){int kv=kb+(r&3)+8*(r>>2); if(kv>qrel)p0[r]=NEG; if(kv+32>qrel)p1[r]=NEG;}
}

constexpr int NSLOT=3, SLOTB=8192;
constexpr int LDS_K=0, LDS_V=NSLOT*SLOTB, LDS_WS=LDS_V+NSLOT*2*SLOTB, LDS_OST=LDS_WS+NW*64*4, LDS_BYTES=LDS_OST+NW*4096;
constexpr float C2=0.125f*1.4426950408889634f;
__device__ __forceinline__ void glds16(const void*gsrc,unsigned lds_dst){unsigned keep;
  asm volatile("s_mov_b32 %0, m0\n\ts_mov_b32 m0, %2\n\ts_nop 0\n\tglobal_load_lds_dwordx4 %1, off\n\ts_mov_b32 m0, %0":"=&s"(keep):"v"(gsrc),"s"(lds_dst):"memory");}
__device__ __forceinline__ float max3f(float a,float b,float c){float r;asm("v_max3_f32 %0, %1, %2, %3":"=v"(r):"v"(a),"v"(b),"v"(c));return r;}
__device__ __forceinline__ float max2f(float a,float b){float r;asm("v_max_f32_e32 %0, %1, %2":"=v"(r):"v"(a),"v"(b));return r;}
__device__ __forceinline__ float fadd_s(float a,float b){float r;asm("v_add_f32_e32 %0, %1, %2":"=v"(r):"v"(a),"v"(b));return r;}
__device__ __forceinline__ float fsub_s(float a,float b){float r;asm("v_sub_f32_e32 %0, %1, %2":"=v"(r):"v"(a),"v"(b));return r;}
typedef float f32x2_t __attribute__((ext_vector_type(2))); typedef __bf16 bf16x2_t __attribute__((ext_vector_type(2)));
__device__ __forceinline__ unsigned cvtpk_s(float lo,float hi){f32x2_t v={lo,hi};bf16x2_t b=__builtin_convertvector(v,bf16x2_t);return __builtin_bit_cast(unsigned,b);}
#define WAIT_BAR(N) asm volatile("s_waitcnt vmcnt(" #N ") lgkmcnt(0)\n\ts_barrier":::"memory")
#define MID_BAR(N) asm volatile("s_waitcnt vmcnt(" #N ")\n\ts_barrier":::"memory")

__device__ __forceinline__ void qkt(f32x16&p0,f32x16&p1,const char*Kslot,const bf16x8*qr,int r32,int hi){ const f32x16 negm=f32x16{};
  const char*kb=Kslot+hi*1024+r32*16;
  #pragma unroll
  for(int d0=0;d0<4;++d0){
    const bf16x8 b0=*reinterpret_cast<const bf16x8*>(kb+d0*2048);
    const bf16x8 b1=*reinterpret_cast<const bf16x8*>(kb+d0*2048+512);
    if(d0==0){p0=__builtin_amdgcn_mfma_f32_32x32x16_bf16(b0,qr[0],negm,0,0,0);p1=__builtin_amdgcn_mfma_f32_32x32x16_bf16(b1,qr[0],negm,0,0,0);}
    else{p0=__builtin_amdgcn_mfma_f32_32x32x16_bf16(b0,qr[d0],p0,0,0,0);p1=__builtin_amdgcn_mfma_f32_32x32x16_bf16(b1,qr[d0],p1,0,0,0);}}
}
typedef __attribute__((address_space(3))) const char* lds_cptr;
typedef short v4i16_t __attribute__((ext_vector_type(4)));
__device__ __forceinline__ void kload8(bf16x8*kf,lds_cptr kp){
  kf[0]=*(const __attribute__((address_space(3))) bf16x8*)(kp);      kf[1]=*(const __attribute__((address_space(3))) bf16x8*)(kp+512);
  kf[2]=*(const __attribute__((address_space(3))) bf16x8*)(kp+2048); kf[3]=*(const __attribute__((address_space(3))) bf16x8*)(kp+2560);
  kf[4]=*(const __attribute__((address_space(3))) bf16x8*)(kp+4096); kf[5]=*(const __attribute__((address_space(3))) bf16x8*)(kp+4608);
  kf[6]=*(const __attribute__((address_space(3))) bf16x8*)(kp+6144); kf[7]=*(const __attribute__((address_space(3))) bf16x8*)(kp+6656);
}
__device__ __forceinline__ void kload2(bf16x8*kf,lds_cptr kp,int j){ kf[2*j]=*(const __attribute__((address_space(3))) bf16x8*)(kp+j*2048); kf[2*j+1]=*(const __attribute__((address_space(3))) bf16x8*)(kp+j*2048+512); }
__device__ __forceinline__ s16x4 vtr(lds_cptr p){ return __builtin_bit_cast(s16x4,__builtin_amdgcn_ds_read_tr16_b64_v4i16((__attribute__((address_space(3))) v4i16_t*)p)); }
__device__ __forceinline__ float rowmax(const f32x16&p0,const f32x16&p1){
  float a=max3f(p0[0],p0[1],p1[0]),b=max3f(p0[2],p0[3],p1[1]);a=max3f(a,p1[2],p1[3]);
  #pragma unroll
  for(int r=4;r<16;r+=4){a=max3f(a,p0[r],p0[r+1]);b=max3f(b,p0[r+2],p0[r+3]);a=max3f(a,p1[r],p1[r+1]);b=max3f(b,p1[r+2],p1[r+3]);}
  const float m=max2f(a,b);
  auto rr=__builtin_amdgcn_permlane32_swap(__float_as_uint(m),__float_as_uint(m),false,false);
  return max2f(__uint_as_float(rr[0]),__uint_as_float(rr[1]));
}
__device__ __forceinline__ void pv(f32x16*o,int vb,bf16x8 pa0,bf16x8 pa1,bf16x8 pa2,bf16x8 pa3){
  #pragma unroll
  for(int d0=0;d0<4;++d0){s16x4 lo[4],hi[4];
    #pragma unroll
    for(int ks=0;ks<4;++ks){
      asm volatile("ds_read_b64_tr_b16 %0,%1 offset:%c2":"=&v"(lo[ks]):"v"(vb),"i"(d0*4096+ks*1024):"memory");
      asm volatile("ds_read_b64_tr_b16 %0,%1 offset:%c2":"=&v"(hi[ks]):"v"(vb),"i"(d0*4096+ks*1024+512):"memory");}
    asm volatile("s_waitcnt lgkmcnt(0)":::"memory");SBAR();
    #define PK(k) (bf16x8){lo[k][0],lo[k][1],lo[k][2],lo[k][3],hi[k][0],hi[k][1],hi[k][2],hi[k][3]}
    o[d0]=__builtin_amdgcn_mfma_f32_32x32x16_bf16(pa0,PK(0),o[d0],0,0,0);
    o[d0]=__builtin_amdgcn_mfma_f32_32x32x16_bf16(pa1,PK(1),o[d0],0,0,0);
    o[d0]=__builtin_amdgcn_mfma_f32_32x32x16_bf16(pa2,PK(2),o[d0],0,0,0);
    o[d0]=__builtin_amdgcn_mfma_f32_32x32x16_bf16(pa3,PK(3),o[d0],0,0,0);
    #undef PK
  }
}

#if 0
#define ATTN_STORE16(p,v) (*(u32x4*)(p)=(v))
#endif
template<int THRL,int DRY=0> __device__ __forceinline__ void attn_unit(int qb,const bf16*Qh,const bf16*__restrict__ Kh,const bf16*__restrict__ Vh,bf16*Oh,char*shm){
  int tid_=threadIdx.x; asm volatile("":"+v"(tid_));
  const int tid=tid_,lane=tid&63,r32=lane&31,hi=lane>>5; const int wid=__builtin_amdgcn_readfirstlane(tid>>6);
  const int q0=qb*QB; const bool grp=ATTN_STAG&&(wid>>2);
  const bf16*Qw=Qh+(long)(q0+wid*QBLK)*PQ;
  const unsigned lds0=(unsigned)(uintptr_t)shm;
  float*wsf=(float*)(shm+LDS_WS)+wid*64;
  const bf16*ksrc=Kh+(long)lane*PQ+wid*8;
  const bf16*vsrc=Vh+(long)(16*(wid&3)+(lane>>2))*PQ+(wid>>2)*32+(lane&3)*8;
  const unsigned kdst=lds0+LDS_K+wid*1024, vdst=lds0+LDS_V+wid*1024;
  #define DMA_K(t,slot) glds16(ksrc+(long)(t)*KVBLK*PQ,(unsigned)__builtin_amdgcn_readfirstlane(kdst+(slot)))
  #define DMA_V(t,slot) do{ glds16(vsrc+(long)(t)*KVBLK*PQ,(unsigned)__builtin_amdgcn_readfirstlane(vdst+2*(slot))); glds16(vsrc+64+(long)(t)*KVBLK*PQ,(unsigned)__builtin_amdgcn_readfirstlane(vdst+2*(slot)+8192)); }while(0)
  const int vb0=(int)(lds0+LDS_V)+((lane>>4)&1)*32+(lane&3)*8+(4*hi+((lane&15)>>2))*64;
  const char*Kbase=shm+LDS_K; bf16x8 kf[8];
  const lds_cptr shm3=(lds_cptr)shm; const lds_cptr kp0=shm3+LDS_K+hi*1024+r32*16; const lds_cptr vp0=shm3+LDS_V+((lane>>4)&1)*32+(lane&3)*8+(4*hi+((lane&15)>>2))*64;
  const int NT=(q0+QB)/KVBLK;
  bf16x8 qr[4];
  #pragma unroll
  for(int d0=0;d0<4;++d0)qr[d0]=*reinterpret_cast<const bf16x8*>(&Qw[(long)r32*PQ+d0*16+hi*8]);
  DMA_K(0,0);DMA_V(0,0);DMA_K(1,SLOTB);DMA_K(2,2*SLOTB);
  { bf16x8* qst=(bf16x8*)(shm+LDS_OST+wid*4096);
    #pragma unroll
    for(int d0=0;d0<4;++d0)qst[(d0*2+hi)*32+r32]=qr[d0]; }
  const lds_cptr qp0=shm3+LDS_OST+wid*4096+(hi*32+r32)*16;
  #define QLD(d0) (*(const __attribute__((address_space(3))) bf16x8*)(qp0+(d0)*1024))
  float mhat=0.f,l_reg=0.f;f32x16 o[4];o[0]=f32x16{};o[1]=f32x16{};o[2]=f32x16{};o[3]=f32x16{};
  const int qrel=wid*QBLK+r32;
  #define CMASK(P0,P1,t) do{int jb_=(t)-(NT-4); if(jb_>=0)cmask(P0,P1,jb_,qrel,hi);}while(0)
  bool resc=false;
  #define START(P0,P1) do{ const float rm=rowmax(P0,P1); resc=false; \
    { const float dl=rm; mhat=fadd_s(mhat,dl); \
      _Pragma("unroll") for(int r=0;r<16;++r){P0[r]=fsub_s(P0[r],dl);P1[r]=fsub_s(P1[r],dl);} \
      } \
    _Pragma("unroll") for(int r=0;r<16;++r)P0[r]=__builtin_amdgcn_exp2f(P0[r]); }while(0)
  #define RESC() do{ if(resc){ asm volatile("s_waitcnt lgkmcnt(0)":::"memory"); \
      _Pragma("unroll") for(int d_=0;d_<4;++d_) _Pragma("unroll") for(int r=0;r<16;++r)o[d_][r]*=wsf[crow(r,hi)]; } }while(0)
  f32x16 pA0,pA1,pB0,pB1;
  int sl_prev=0,sl_cur=0,sl_next=SLOTB;
  #define ROT() do{sl_prev=sl_cur;sl_cur=sl_next;sl_next=(sl_next==(NSLOT-1)*SLOTB)?0:sl_next+SLOTB;}while(0)
  if(grp){ WAIT_BAR(4); WAIT_BAR(0); }
  else WAIT_BAR(4);
  qkt(pA0,pA1,Kbase,qr,r32,hi);asm volatile("s_nop 15\n\ts_nop 7":"+v"(pA0),"+v"(pA1));CMASK(pA0,pA1,0);
  START(pA0,pA1);
  _Pragma("unroll") for(int r=0;r<16;++r)pA1[r]=__builtin_amdgcn_exp2f(pA1[r]);
  WAIT_BAR(0);
  if(!ATTN_STAG||grp){DMA_K(3,0);DMA_V(1,SLOTB);}
  ROT();
  kload8(kf,kp0+sl_cur);
  WAIT_BAR(3);
  if(ATTN_STAG&&!grp){DMA_K(3,0);DMA_V(1,SLOTB);}
  s16x4 vlo[8],vhi[8]; u32x4 pw0,pw1,pw2,pw3;
  #define PKW(P,B) cvtpk_s(P[B],P[B+1])
  #define PAF(k) __builtin_bit_cast(bf16x8,pw##k)
  #define VFR(i) (bf16x8){vlo[i][0],vlo[i][1],vlo[i][2],vlo[i][3],vhi[i][0],vhi[i][1],vhi[i][2],vhi[i][3]}
  #define PIN(x) asm volatile("":"+v"(x))
  #define MX3(a,b,c) __builtin_fmaxf(__builtin_fmaxf((a),(b)),(c))
  #define GAPA(MF,A0,A1,A2,A3,W0,W1,PW) do{ MF; if(!(DRY&1)){ sacc+=A0; sacc+=A1; sacc+=A2; sacc+=A3; PIN(sacc); W0; W1; PIN(PW); } SBAR(); }while(0)
  #define EX(v) __builtin_amdgcn_exp2f(v)
  #define GAPB(MF,X,B) do{ MF; if(!(DRY&2)){ X[B]=X[B]-mhat; X[B+1]=X[B+1]-mhat; PIN(X); X[B]=EX(X[B]); X[B+1]=EX(X[B+1]); PIN(X); } SBAR(); }while(0)
  #define KEEPF(x) asm volatile(""::"v"(x))
  #define KEEPV(i) do{ asm volatile(""::"v"(vlo[i]),"v"(vhi[i])); }while(0)
  #define VRD2(i) do{ if(DRY&4)break; vlo[i]=vtr(vp_+((((i)>>2)+2)*4096+((i)&3)*1024)); vhi[i]=vtr(vp_+((((i)>>2)+2)*4096+((i)&3)*1024+512)); SBAR(); }while(0)
  #define VRD(i) do{ if(DRY&4)break; vlo[i]=vtr(vp_+(((i)>>2)*4096+((i)&3)*1024)); vhi[i]=vtr(vp_+(((i)>>2)*4096+((i)&3)*1024+512)); }while(0)
  #define KRD(G,j) do{ if((G)&&!(DRY&16)){ kload2(kf,kp0+sl_next,j); SBAR(); } }while(0)
  #define MIDB(pos,MW,GK,GV,t) do{ if(ATTN_STAG&&(pos)==ATTN_MIDPOS){ if((MW)==3)MID_BAR(3); else if((MW)==2)MID_BAR(2); else MID_BAR(0); SBAR(); \
      if(!grp){ if(GK&&!(DRY&8)){DMA_K((t)+3,sl_cur);} if(GV&&!(DRY&8)){DMA_V((t)+1,sl_next);} } SBAR(); } }while(0)
  #define STEP(C0,C1,P0,P1,t,GK,GV,GL,MW) do{ SBAR(); const f32x16 zero16=f32x16{}; const bf16x8 ql0=QLD(0),ql1=QLD(1),ql2=QLD(2),ql3=QLD(3); \
    const lds_cptr vp_=vp0+2*sl_prev; \
    VRD(0); SBAR(); float sacc=(P0[0]+P0[1]); \
    GAPA(C0=__builtin_amdgcn_mfma_f32_32x32x16_bf16(kf[0],ql0,zero16,0,0,0), P0[2],P0[3],P0[4],P0[5],     pw0[0]=PKW(P0,0), pw0[1]=PKW(P0,2), pw0); \
    VRD(4); SBAR(); GAPA(C1=__builtin_amdgcn_mfma_f32_32x32x16_bf16(kf[1],ql0,zero16,0,0,0), P0[6],P0[7],P0[8],P0[9],     pw0[2]=PKW(P0,4), pw0[3]=PKW(P0,6), pw0); \
    VRD(1); SBAR(); KEEPF(kf[0]); GAPA(C0=__builtin_amdgcn_mfma_f32_32x32x16_bf16(kf[2],ql1,C0,0,0,0),   P0[10],P0[11],P0[12],P0[13], pw1[0]=PKW(P0,8), pw1[1]=PKW(P0,10), pw1); \
    VRD(5); SBAR(); KEEPF(kf[1]); KEEPF(ql0); GAPA(C1=__builtin_amdgcn_mfma_f32_32x32x16_bf16(kf[3],ql1,C1,0,0,0),   P0[14],P0[15],P1[0],P1[1],   pw1[2]=PKW(P0,12),pw1[3]=PKW(P0,14), pw1); \
    VRD(2); SBAR(); KEEPF(kf[2]); GAPA(C0=__builtin_amdgcn_mfma_f32_32x32x16_bf16(kf[4],ql2,C0,0,0,0),   P1[2],P1[3],P1[4],P1[5],     pw2[0]=PKW(P1,0), pw2[1]=PKW(P1,2), pw2); \
    VRD(6); SBAR(); KEEPF(kf[3]); KEEPF(ql1); GAPA(C1=__builtin_amdgcn_mfma_f32_32x32x16_bf16(kf[5],ql2,C1,0,0,0),   P1[6],P1[7],P1[8],P1[9],     pw2[2]=PKW(P1,4), pw2[3]=PKW(P1,6), pw2); \
    VRD(3); SBAR(); KEEPF(kf[4]); GAPA(C0=__builtin_amdgcn_mfma_f32_32x32x16_bf16(kf[6],ql3,C0,0,0,0),   P1[10],P1[11],P1[12],P1[13], pw3[0]=PKW(P1,8), pw3[1]=PKW(P1,10), pw3); \
    VRD(7); SBAR(); KEEPF(kf[5]); KEEPF(ql2); GAPA(C1=__builtin_amdgcn_mfma_f32_32x32x16_bf16(kf[7],ql3,C1,0,0,0),   P1[14],P1[15],0.f,0.f,       pw3[2]=PKW(P1,12),pw3[3]=PKW(P1,14), pw3); \
    l_reg+=sacc; \
    if(!ATTN_STAG||grp){ if(GK&&!(DRY&8)){DMA_K((t)+3,sl_cur);} if(GV&&!(DRY&8)){DMA_V((t)+1,sl_next);} } \
    CMASK(C0,C1,t); \
    { float a=MX3(C0[0],C0[1],C1[0]),b=MX3(C0[2],C0[3],C1[1]); a=MX3(a,C1[2],C1[3]); \
      _Pragma("unroll") for(int r=4;r<16;r+=4){a=MX3(a,C0[r],C0[r+1]);b=MX3(b,C0[r+2],C0[r+3]);a=MX3(a,C1[r],C1[r+1]);b=MX3(b,C1[r+2],C1[r+3]);} \
      float rm=__builtin_fmaxf(a,b); { auto rr=__builtin_amdgcn_permlane32_swap(__float_as_uint(rm),__float_as_uint(rm),false,false); rm=__builtin_fmaxf(__uint_as_float(rr[0]),__uint_as_float(rr[1])); } \
      resc=false; \
      rm-=mhat; \
      if(__builtin_expect(__any(rm>(float)THRL),0)){ const float dl=__builtin_fmaxf(rm,0.f); mhat+=dl; \
        const float f=__builtin_amdgcn_exp2f(-dl); l_reg*=f; if(hi==0)wsf[r32]=f; resc=true; } } \
    KEEPF(kf[6]); KEEPF(kf[7]); KEEPF(ql3); SBAR(); \
    MIDB(0,MW,GK,GV,t); \
    GAPB(o[0]=__builtin_amdgcn_mfma_f32_32x32x16_bf16(PAF(0),VFR(0),o[0],0,0,0), C0,0); \
    GAPB(o[1]=__builtin_amdgcn_mfma_f32_32x32x16_bf16(PAF(0),VFR(4),o[1],0,0,0), C0,2); \
    MIDB(2,MW,GK,GV,t); \
    KRD(GL,0); GAPB(o[0]=__builtin_amdgcn_mfma_f32_32x32x16_bf16(PAF(1),VFR(1),o[0],0,0,0), C0,4); KEEPV(0); VRD2(0); \
    KRD(GL,1); GAPB(o[1]=__builtin_amdgcn_mfma_f32_32x32x16_bf16(PAF(1),VFR(5),o[1],0,0,0), C0,6); KEEPV(4); VRD2(4); \
    MIDB(4,MW,GK,GV,t); \
    KRD(GL,2); GAPB(o[0]=__builtin_amdgcn_mfma_f32_32x32x16_bf16(PAF(2),VFR(2),o[0],0,0,0), C0,8); KEEPV(1); VRD2(1); \
    KRD(GL,3); GAPB(o[1]=__builtin_amdgcn_mfma_f32_32x32x16_bf16(PAF(2),VFR(6),o[1],0,0,0), C0,10); KEEPV(5); VRD2(5); \
    GAPB(o[0]=__builtin_amdgcn_mfma_f32_32x32x16_bf16(PAF(3),VFR(3),o[0],0,0,0), C0,12); KEEPV(2); VRD2(2); \
    GAPB(o[1]=__builtin_amdgcn_mfma_f32_32x32x16_bf16(PAF(3),VFR(7),o[1],0,0,0), C0,14); KEEPV(6); VRD2(6); \
    GAPB(o[2]=__builtin_amdgcn_mfma_f32_32x32x16_bf16(PAF(0),VFR(0),o[2],0,0,0), C1,0); KEEPV(3); VRD2(3); \
    GAPB(o[3]=__builtin_amdgcn_mfma_f32_32x32x16_bf16(PAF(0),VFR(4),o[3],0,0,0), C1,2); KEEPV(7); VRD2(7); \
    GAPB(o[2]=__builtin_amdgcn_mfma_f32_32x32x16_bf16(PAF(1),VFR(1),o[2],0,0,0), C1,4); \
    GAPB(o[3]=__builtin_amdgcn_mfma_f32_32x32x16_bf16(PAF(1),VFR(5),o[3],0,0,0), C1,6); \
    GAPB(o[2]=__builtin_amdgcn_mfma_f32_32x32x16_bf16(PAF(2),VFR(2),o[2],0,0,0), C1,8); \
    GAPB(o[3]=__builtin_amdgcn_mfma_f32_32x32x16_bf16(PAF(2),VFR(6),o[3],0,0,0), C1,10); \
    GAPB(o[2]=__builtin_amdgcn_mfma_f32_32x32x16_bf16(PAF(3),VFR(3),o[2],0,0,0), C1,12); \
    GAPB(o[3]=__builtin_amdgcn_mfma_f32_32x32x16_bf16(PAF(3),VFR(7),o[3],0,0,0), C1,14); \
    }while(0)
  int t=(DRY&32)?NT-1:1;
  #undef CMASK
  #define CMASK(P0,P1,t) do{}while(0)
  for(;t+5<NT;t+=2){
    STEP(pB0,pB1,pA0,pA1,t,true,true,true,3);     WAIT_BAR(3); RESC(); ROT();
    STEP(pA0,pA1,pB0,pB1,t+1,true,true,true,3);   WAIT_BAR(3); RESC(); ROT();
  }
  #undef CMASK
  #define CMASK(P0,P1,t) do{int jb_=(t)-(NT-4); if(jb_>=0)cmask(P0,P1,jb_,qrel,hi);}while(0)
  #define ENDW(tt) do{ if((tt)+3<NT){WAIT_BAR(3);} else if((tt)+2<NT){WAIT_BAR(2);} else {WAIT_BAR(0);} }while(0)
  for(;t+1<NT;t+=2){
    STEP(pB0,pB1,pA0,pA1,t,(t+3<NT),(t+1<NT),(t+1<NT),((t+3<NT)?3:(t+1<NT)?2:0));       ENDW(t);   RESC(); ROT();
    STEP(pA0,pA1,pB0,pB1,t+1,(t+4<NT),(t+2<NT),(t+2<NT),((t+4<NT)?3:(t+2<NT)?2:0));     ENDW(t+1); RESC(); ROT();
  }
  STEP(pB0,pB1,pA0,pA1,NT-1,false,false,false,0); RESC();
  { float sacc=pB0[0]+pB0[1]; _Pragma("unroll") for(int r=2;r<16;++r)sacc+=pB0[r]; _Pragma("unroll") for(int r=0;r<16;++r)sacc+=pB1[r]; l_reg+=sacc;
    pw0=(u32x4){PKW(pB0,0),PKW(pB0,2),PKW(pB0,4),PKW(pB0,6)};pw1=(u32x4){PKW(pB0,8),PKW(pB0,10),PKW(pB0,12),PKW(pB0,14)};pw2=(u32x4){PKW(pB1,0),PKW(pB1,2),PKW(pB1,4),PKW(pB1,6)};pw3=(u32x4){PKW(pB1,8),PKW(pB1,10),PKW(pB1,12),PKW(pB1,14)};
    SBAR(); pv(o,vb0+2*sl_cur,PAF(0),PAF(1),PAF(2),PAF(3)); }
  #undef PKW
  #undef PAF
  #undef VFR
  #undef PIN
  #undef MX3
  #undef GAPA
  #undef GAPB
  #undef EX
  #undef VRD
  #undef VRD2
  #undef KEEPF
  #undef KEEPV
  #undef KRD
  #undef STEP
  #undef MIDB
  #undef ENDW
  {auto rr=__builtin_amdgcn_permlane32_swap(__float_as_uint(l_reg),__float_as_uint(l_reg),false,false);l_reg=__uint_as_float(rr[0])+__uint_as_float(rr[1]);}
  if(hi==0)wsf[32+r32]=l_reg;asm volatile("s_waitcnt lgkmcnt(0)":::"memory");
  float rli[16];
  #pragma unroll
  for(int r=0;r<16;++r)rli[r]=__builtin_amdgcn_rcpf(wsf[32+crow(r,hi)]);
  bf16*Ow=Oh+(long)(q0+wid*QBLK)*PO;
  { bf16*stg=(bf16*)(shm+LDS_OST)+wid*2048;
    #pragma unroll
    for(int hf=0;hf<2;++hf){
    #pragma unroll
    for(int r=0;r<16;++r){const int orow=crow(r,hi);
      #pragma unroll
      for(int d0=0;d0<2;++d0)stg[orow*64+d0*32+r32]=__float2bfloat16(o[2*hf+d0][r]*rli[r]);}
    asm volatile("s_waitcnt lgkmcnt(0)":::"memory");
    #pragma unroll
    for(int i=0;i<4;++i){const int row=i*8+(lane>>3),ch=lane&7; const u32x4 v=*(const u32x4*)(stg+row*64+ch*8); ATTN_STORE16(Ow+(long)row*PO+hf*64+ch*8,v);}
    asm volatile("s_waitcnt lgkmcnt(0)":::"memory"); } }
  asm volatile("s_waitcnt lgkmcnt(0)\n\ts_barrier":::"memory");
  if(ATTN_STAG&&!grp) asm volatile("s_barrier":::"memory");
  #undef DMA_K
  #undef QLD
  #undef DMA_V
  #undef CMASK
  #undef START
  #undef RESC
  #undef ROT
}
constexpr int ATTN_LDS_BYTES=LDS_BYTES;
#undef SBAR
#undef WAIT_BAR
}
#define ST8(ptr, w) do { *(ptr) = (w); asm volatile("s_nop 1" :: "v"((w).x), "v"((w).y) : "memory"); } while (0)
#define ST4(ptr, w) do { *(ptr) = (w); asm volatile("s_nop 1" :: "v"(w) : "memory"); } while (0)
constexpr int NWAVES = 8;
constexpr int RING_OFF = 0, RING_BYTES = 131072;
constexpr int LDSCTL_OFF = RING_BYTES, MISC_OFF = LDSCTL_OFF;
constexpr int TAB_OFF = LDSCTL_OFF + 512;
constexpr int EB_OFF = LDSCTL_OFF + 2048;
constexpr int LCNT_OFF = LDSCTL_OFF + 2304;
constexpr int TOKS_OFF = LDSCTL_OFF + 4096, TOKS_UNITS = 6;
constexpr int CW_MOEC = 70000;
constexpr int LDS_BYTES = 147456;
constexpr int CW_BAR = 4096;
constexpr int NPHASE = 18;

#define XB_TMO      128
#define XB_XCNT(j)  (256  + 64 * (j))
#define XB_XSUB(j)  (1280 + 64 * (j))
#define XB_XGEN(j)  (2304 + 64 * (j))
#define XB_TOP      3328
#define XB_TOPGEN   3392
#define XCD_BAR_WORDS 3456
#define XB_SPIN_CAP (1u << 18)

__device__ __forceinline__ unsigned xb_ld(unsigned* p)              { return __hip_atomic_load(p, __ATOMIC_RELAXED, __HIP_MEMORY_SCOPE_AGENT); }
__device__ __forceinline__ unsigned xb_add(unsigned* p, unsigned v) { return __hip_atomic_fetch_add(p, v, __ATOMIC_RELAXED, __HIP_MEMORY_SCOPE_AGENT); }
__device__ __forceinline__ unsigned xb_xcc_id() { return (unsigned)__builtin_amdgcn_s_getreg((3 << 11) | 20) & 0xFu; }
#define XB_SPIN(cond, bar) do { unsigned _sp = 0; while (cond) { __builtin_amdgcn_s_sleep(1); \
    if ((++_sp & 255u) == 0u) { if (xb_ld(&(bar)[XB_TMO])) break; if (_sp > XB_SPIN_CAP) { atomicAdd(&(bar)[XB_TMO], 1u); break; } } } } while (0)

struct XcdBarrier {
    unsigned* bar; unsigned x;
    volatile LAS unsigned* st;
};

__device__ __forceinline__ XcdBarrier xcd_barrier_post(unsigned* bar, volatile LAS unsigned* st) {
    XcdBarrier b; b.bar = bar; b.x = xb_xcc_id(); b.st = st;
    if (threadIdx.x == 0) (void)xb_add(&bar[XB_XCNT(b.x)], 1u);
    return b;
}
__device__ __forceinline__ void xcd_barrier_complete(unsigned* bar, unsigned x, unsigned& nloc, unsigned& nx) {
    const unsigned G = gridDim.x * gridDim.y * gridDim.z;
    unsigned sum, cnt, mine, sp = 0u;
    for (;;) {
        sum = 0u; cnt = 0u; mine = 0u;
#pragma unroll
        for (unsigned j = 0; j < 16; ++j) { const unsigned c = xb_ld(&bar[XB_XCNT(j)]); sum += c; cnt += (c > 0u) ? 1u : 0u; mine = (j == x) ? c : mine; }
        if (sum == G) break;
        __builtin_amdgcn_s_sleep(1);
        if ((++sp & 255u) == 0u) { if (xb_ld(&bar[XB_TMO])) break; if (sp > XB_SPIN_CAP) { atomicAdd(&bar[XB_TMO], 1u); break; } }
    }
    nloc = mine > 0u ? mine : 1u; nx = cnt > 0u ? cnt : 1u;
}

__device__ __forceinline__ void xcd_barrier(const XcdBarrier& b) {
    asm volatile("s_waitcnt vmcnt(0)" ::: "memory");
    __syncthreads();
    if (threadIdx.x == 0) {
        unsigned* bar = b.bar;
        __builtin_amdgcn_s_waitcnt(0);
        unsigned nloc = b.st[0], nx = b.st[1];
        if (nloc == 0u) { xcd_barrier_complete(bar, b.x, nloc, nx); b.st[0] = nloc; b.st[1] = nx; }
        const unsigned old = xb_add(&bar[XB_XSUB(b.x)], 1u);
        const unsigned gen = old / nloc;
        if (old + 1u == (gen + 1u) * nloc) {
            __builtin_amdgcn_fence(__ATOMIC_RELEASE, "agent");
            asm volatile("s_waitcnt vmcnt(0)" ::: "memory");
            const unsigned og = xb_add(&bar[XB_TOP], 1u);
            const unsigned tg = og / nx;
            if (og + 1u == (tg + 1u) * nx) xb_add(&bar[XB_TOPGEN], 1u);
            else XB_SPIN(xb_ld(&bar[XB_TOPGEN]) == tg, bar);
            __builtin_amdgcn_fence(__ATOMIC_ACQUIRE, "agent");
            xb_add(&bar[XB_XGEN(b.x)], 1u);
            asm volatile("s_waitcnt vmcnt(0)" ::: "memory");
        } else {
            XB_SPIN(xb_ld(&bar[XB_XGEN(b.x)]) == gen, bar);
            __builtin_amdgcn_fence(__ATOMIC_ACQUIRE, "agent");
            asm volatile("s_waitcnt vmcnt(0)" ::: "memory");
        }
    }
    __syncthreads();
}


struct Frame {
    LAS unsigned char* lds; volatile LAS unsigned* MISC; gu32* ctl;
    int tid, lane, wave, vcu, G;
    const float *x, *c, *w_ada, *b_ada, *w_in, *w_out, *lq1, *lk1, *lq2, *lk2, *subln, *ln_mix_g, *ln_mix_b, *ln_ffn_g, *ln_ffn_b, *router_w, *router_b, *w_gate, *w_up, *w_down;
    float* out; unsigned char* ws;
    float* mod; float* rot; int* tok_e; float* tok_g; int* tok_slot; int* lists; bf16* Wbf;
    bf16 *S1, *S3, *PROJ, *YP, *HE, *MIXED;
};

__device__ __forceinline__ void transpose_item(const float* W, int ldw, int k0, int n0, bf16* WT, int Kdst, int drow0, LAS float* scr, int lane) {
    f32x4 t[8];
#pragma unroll
    for (int i = 0; i < 8; ++i) t[i] = *(const GAS f32x4*)(W + (size_t)(k0 + 8 * i + (lane >> 3)) * ldw + n0 + 4 * (lane & 7));
#pragma unroll
    for (int i = 0; i < 8; ++i) *(LAS f32x4*)(scr + (8 * i + (lane >> 3)) * 36 + 4 * (lane & 7)) = t[i];
    LDS_WAIT(); asm volatile("" ::: "memory");
    const int c = lane & 7;
#pragma unroll
    for (int j = 0; j < 4; ++j) { const int n = (lane >> 3) + 8 * j; const LAS float* s = scr + (8 * c) * 36 + n;
        u32x4 o; o.x = pk2(s[0 * 36], s[1 * 36]); o.y = pk2(s[2 * 36], s[3 * 36]); o.z = pk2(s[4 * 36], s[5 * 36]); o.w = pk2(s[6 * 36], s[7 * 36]);
        *(GAS u32x4*)(WT + (size_t)(drow0 + n) * Kdst + k0 + 8 * c) = o; }
    LDS_WAIT(); asm volatile("" ::: "memory");
}
constexpr int IT_IN = 16 * 112, IT_OUT = 16 * 32, IT_E = 256, IT_LAYER = IT_IN + IT_OUT + 3 * 16 * IT_E;
__device__ __forceinline__ void p0_weight_item(const Frame& F, int it, LAS float* scr) {
    const int l = it / IT_LAYER; int r = it - l * IT_LAYER; bf16* wl = F.Wbf + (size_t)l * WL_STRIDE;
    if (r < IT_IN) { const int kb = r / 112, c0 = (r % 112) * 32; int drow = c0;
        if (c0 < 1024) drow = (c0 & ~255) + ((c0 >> 5) & 1) * 128 + ((c0 >> 6) & 3) * 32;
        transpose_item(F.w_in + (size_t)l * DM * INW, INW, kb * 64, c0, wl + WL_IN, DM, drow, scr, F.lane); return; }
    r -= IT_IN;
    if (r < IT_OUT) { const int kb = r / 32, c0 = (r % 32) * 32; transpose_item(F.w_out + (size_t)l * DM * DM, DM, kb * 64, c0, wl + WL_OUT, DM, c0, scr, F.lane); return; }
    r -= IT_OUT;
    const int which = r / (16 * IT_E), rr = r % (16 * IT_E), e = rr / IT_E, q = rr % IT_E;
    if (which < 2) { const int kb = q / 16, c0 = (q % 16) * 32; const float* W = (which == 0 ? F.w_gate : F.w_up) + (size_t)(l * NE + e) * DM * DE;
        transpose_item(W, DE, kb * 64, c0, wl + WL_GU, DM, e * 1024 + (c0 >> 7) * 256 + which * 128 + (c0 & 127), scr, F.lane); }
    else { const int kb = q / 32, c0 = (q % 32) * 32; transpose_item(F.w_down + (size_t)(l * NE + e) * DE * DM, DM, kb * 64, c0, wl + WL_D, DE, e * 1024 + c0, scr, F.lane); }
}

#ifndef DEFER_W1
#define DEFER_W1 0
#endif
#ifndef W1_CAP1
#define W1_CAP1 4
#endif
#ifndef W1_CAP2
#define W1_CAP2 2
#endif
__device__ __forceinline__ void deferred_weights(Frame& F, int nwg, int stage) {
    LAS float* scr = (LAS float*)(F.lds + RING_OFF + F.wave * 9216);
    const int rem = nwg % F.G, I = rem ? F.G - rem : 0, slots = I * NWAVES, base1 = slots * W1_CAP1, base2 = base1 + slots * W1_CAP2;
    if (stage < 2) { if (!rem || (int)blockIdx.x < rem) return;
        const int r = ((int)blockIdx.x - rem) * NWAVES + F.wave, cap = stage == 0 ? W1_CAP1 : W1_CAP2, base = stage == 0 ? 0 : base1;
        for (int k = 0; k < cap; ++k) { const int idx = base + r + k * slots; if (idx < IT_LAYER) p0_weight_item(F, IT_LAYER + idx, scr); }
    } else { for (int idx = base2 + F.vcu * NWAVES + F.wave; idx < IT_LAYER; idx += F.G * NWAVES) p0_weight_item(F, IT_LAYER + idx, scr); }
}
__device__ __forceinline__ void ph_prologue(Frame& F) {
    LAS float* scr = (LAS float*)(F.lds + RING_OFF + F.wave * 9216);
    LAS float* cond = (LAS float*)(F.lds + RING_OFF + 73728);
    LAS float* part = (LAS float*)(F.lds + RING_OFF + 73728 + 32768);
    if ((int)blockIdx.x < 192) {
        { float cv[16];
#pragma unroll
          for (int j = 0; j < 16; ++j) cv[j] = F.c[F.tid + 512 * j];
#pragma unroll
          for (int j = 0; j < 16; ++j) cond[F.tid + 512 * j] = cv[j] / (1.f + expf(-cv[j])); }
        __syncthreads();
        for (int item = blockIdx.x; item < 192; item += F.G) {
            const int l = item / 96, j0 = (item % 96) * 64;
            float acc[8];
#pragma unroll
            for (int b = 0; b < 8; ++b) acc[b] = 0.f;
            const float* w = F.w_ada + (size_t)l * DM * MODW + (size_t)(F.wave * 128) * MODW + j0 + F.lane;
#pragma unroll 4
            for (int k = 0; k < 128; ++k) { const float wv = w[(size_t)k * MODW];
#pragma unroll
                for (int b = 0; b < 8; ++b) acc[b] += cond[b * 1024 + F.wave * 128 + k] * wv; }
#pragma unroll
            for (int b = 0; b < 8; ++b) part[(F.wave * 8 + b) * 64 + F.lane] = acc[b];
            __syncthreads();
            { const int b = F.tid >> 6, ln = F.tid & 63; float s = 0.f;
#pragma unroll
                for (int w8 = 0; w8 < 8; ++w8) s += part[(w8 * 8 + b) * 64 + ln];
                const float mv = s + F.b_ada[l * MODW + j0 + ln]; ST4(&F.mod[(size_t)(l * 8 + b) * MODW + j0 + ln], mv); }
            __syncthreads();
        }
    }
    if ((int)blockIdx.x == F.G - 1 && F.tid < 2) { const int l = F.tid; float s1 = 0.f, s2 = 0.f;
        for (int i = 0; i < 64; ++i) { s1 += F.lq1[l * 64 + i] * F.lk1[l * 64 + i]; s2 += F.lq2[l * 64 + i] * F.lk2[l * 64 + i]; }
        const float li = 0.8f - 0.6f * expf(-0.3f * (float)l);
        F.mod[2 * 8 * MODW + l] = expf(s1) - expf(s2) + li; F.mod[2 * 8 * MODW + 2 + l] = li; }
    if ((int)blockIdx.x == F.G - 2) {
        float* dt = F.mod + 2 * 8 * MODW + 16;
        for (int i = F.tid; i < 1024; i += NWAVES * 64) { const int hh = i >> 7, pp = i & 127; const double gm = 1.0 - exp2(-5.0 - (double)hh);
            dt[i] = (float)(0.125 * pow(gm, (double)(pp - 127))); dt[1024 + i] = (float)pow(gm, (double)(127 - pp)); if (pp == 0) dt[2048 + hh] = (float)pow(gm, 128.0); }
    }
    for (int idx = blockIdx.x * (NWAVES * 64) + F.tid; idx < 4096 * 32; idx += F.G * NWAVES * 64) { const int pos = idx >> 5, i = idx & 31;
        const double inv = pow(10000.0, -(double)(2 * i) / 64.0), a = (double)pos * inv; F.rot[2 * idx] = (float)cos(a); F.rot[2 * idx + 1] = (float)sin(a); }
    const int gw = F.vcu * NWAVES + F.wave, NGW = F.G * NWAVES;
    for (int it = gw; it < (DEFER_W1 ? 1 : 2) * IT_LAYER; it += NGW) p0_weight_item(F, it, scr);
}
__device__ __forceinline__ void ln_mod_row(const float* xrow, const float* sh_, bf16* orow, int lane) {
    const GAS f32x4* xr = (const GAS f32x4*)xrow + lane;
    f32x4 v[4]; float s = 0.f;
#pragma unroll
    for (int j = 0; j < 4; ++j) { v[j] = xr[64 * j]; s += (v[j].x + v[j].y) + (v[j].z + v[j].w); }
    const float mean = wave_sum(s) * (1.f / DM); float s2 = 0.f;
#pragma unroll
    for (int j = 0; j < 4; ++j) { v[j] = v[j] - mean; s2 += (v[j].x * v[j].x + v[j].y * v[j].y) + (v[j].z * v[j].z + v[j].w * v[j].w); }
    const float rstd = 1.f / sqrtf(wave_sum(s2) * (1.f / DM) + LN_EPS);
    const GAS f32x4* sh = (const GAS f32x4*)sh_ + lane; const GAS f32x4* sc = sh + 256; GAS u32x2* o = (GAS u32x2*)orow + lane;
#pragma unroll
    for (int j = 0; j < 4; ++j) { const f32x4 a = sh[64 * j], m = sc[64 * j]; const f32x4 r = v[j] * rstd * (m + 1.f) + a; u32x2 w; w.x = pk2(r.x, r.y); w.y = pk2(r.z, r.w); ST8(&o[64 * j], w); }
}
__device__ __forceinline__ void ln_mod_regs(f32x4 (&v)[4], const float* sh_, bf16* orow, int lane) {
    float s = 0.f;
#pragma unroll
    for (int j = 0; j < 4; ++j) s += (v[j].x + v[j].y) + (v[j].z + v[j].w);
    const float mean = wave_sum(s) * (1.f / DM); float s2 = 0.f;
#pragma unroll
    for (int j = 0; j < 4; ++j) { v[j] = v[j] - mean; s2 += (v[j].x * v[j].x + v[j].y * v[j].y) + (v[j].z * v[j].z + v[j].w * v[j].w); }
    const float rstd = 1.f / sqrtf(wave_sum(s2) * (1.f / DM) + LN_EPS);
    const GAS f32x4* sh = (const GAS f32x4*)sh_ + lane; const GAS f32x4* sc = sh + 256; GAS u32x2* o = (GAS u32x2*)orow + lane;
    f32x4 a[4], mm[4];
#pragma unroll
    for (int j = 0; j < 4; ++j) { a[j] = sh[64 * j]; mm[j] = sc[64 * j]; }
#pragma unroll
    for (int j = 0; j < 4; ++j) { const f32x4 r = v[j] * rstd * (mm[j] + 1.f) + a[j]; u32x2 w; w.x = pk2(r.x, r.y); w.y = pk2(r.z, r.w); ST8(&o[64 * j], w); }
}
__device__ __forceinline__ void ph_ln0(Frame& F) {
    const int gw = F.vcu * NWAVES + F.wave, NGW = F.G * NWAVES;
#pragma unroll 1
    for (int m = gw; m < T; m += 2 * NGW) { int lane = F.lane; asm volatile("" : "+v"(lane));
        const int m2 = m + NGW;
        const GAS f32x4* xa = (const GAS f32x4*)(F.x + (size_t)m * DM) + lane; const GAS f32x4* xb = (const GAS f32x4*)(F.x + (size_t)m2 * DM) + lane;
        f32x4 va[4], vb[4];
#pragma unroll
        for (int j = 0; j < 4; ++j) { va[j] = xa[64 * j]; vb[j] = xb[64 * j]; }
        ln_mod_regs(va, F.mod + (size_t)(m / SEQ) * MODW, F.S1 + (size_t)m * DM, lane);
        ln_mod_regs(vb, F.mod + (size_t)(m2 / SEQ) * MODW, F.S1 + (size_t)m2 * DM, lane); }
}
__device__ __forceinline__ float sane_c(float v) { return (fabsf(v) < 1e4f) ? v : 0.f; }
__device__ __forceinline__ void ph_combine(Frame& F, int l) {
    const int gw = F.vcu * NWAVES + F.wave, NGW = F.G * NWAVES, lane = F.lane;
    const float lam = F.mod[2 * 8 * MODW + l], li = F.mod[2 * 8 * MODW + 2 + l];
#if ATTN128
    const int h = lane >> 4, q = lane & 15, vh0 = (h * 2 + 0) * 2, vh1 = (h * 2 + 1) * 2, d = 8 * q;
#else
    const int h = lane >> 4, q = lane & 15, vh0 = (h * 2 + 0) * 2 + (q >> 3), vh1 = (h * 2 + 1) * 2 + (q >> 3), d = 8 * (q & 7);
#endif
    const f32x4 g0 = *(const f32x4*)(F.subln + l * 128 + 8 * q), g1 = *(const f32x4*)(F.subln + l * 128 + 8 * q + 4);
#pragma unroll 1
    for (int m0 = gw; m0 < T; m0 += 2 * NGW) {
        u32x4 av[2], bv[2];
#pragma unroll
        for (int t = 0; t < 2; ++t) { const int m = m0 + t * NGW; av[t] = *(const GAS u32x4*)(F.S3 + (size_t)m * DM + vh0 * 64 + d); bv[t] = *(const GAS u32x4*)(F.S3 + (size_t)m * DM + vh1 * 64 + d); }
#pragma unroll
        for (int t = 0; t < 2; ++t) { const int m = m0 + t * NGW; const u32x4 a = av[t], b = bv[t];
        float v[8];
        v[0] = __uint_as_float(a.x << 16) - lam * __uint_as_float(b.x << 16); v[1] = __uint_as_float(a.x & 0xffff0000u) - lam * __uint_as_float(b.x & 0xffff0000u);
        v[2] = __uint_as_float(a.y << 16) - lam * __uint_as_float(b.y << 16); v[3] = __uint_as_float(a.y & 0xffff0000u) - lam * __uint_as_float(b.y & 0xffff0000u);
        v[4] = __uint_as_float(a.z << 16) - lam * __uint_as_float(b.z << 16); v[5] = __uint_as_float(a.z & 0xffff0000u) - lam * __uint_as_float(b.z & 0xffff0000u);
        v[6] = __uint_as_float(a.w << 16) - lam * __uint_as_float(b.w << 16); v[7] = __uint_as_float(a.w & 0xffff0000u) - lam * __uint_as_float(b.w & 0xffff0000u);
#pragma unroll
        for (int i = 0; i < 8; ++i) v[i] = sane_c(v[i]);
        float ss = 0.f;
#pragma unroll
        for (int i = 0; i < 8; ++i) ss += v[i] * v[i];
        ss = row16_sum(ss);
        const float r = (1.f - li) / sqrtf(ss * (1.f / 128.f) + LN_EPS);
        u32x4 w; w.x = pk2(v[0] * r * g0.x, v[1] * r * g0.y); w.y = pk2(v[2] * r * g0.z, v[3] * r * g0.w); w.z = pk2(v[4] * r * g1.x, v[5] * r * g1.y); w.w = pk2(v[6] * r * g1.z, v[7] * r * g1.w);
        *(GAS u32x4*)(F.S1 + (size_t)m * DM + 512 + h * 128 + 8 * q) = w; }
    }
}
__device__ __forceinline__ f32x4 bf4(u32x2 m) { f32x4 r; r.x = __uint_as_float(m.x << 16); r.y = __uint_as_float(m.x & 0xffff0000u); r.z = __uint_as_float(m.y << 16); r.w = __uint_as_float(m.y & 0xffff0000u); return r; }
__device__ __forceinline__ float sane(float v, float lim) { return (fabsf(v) < lim) ? v : 0.f; }
__device__ __forceinline__ f32x4 sane4(f32x4 v, float lim) { v.x = sane(v.x, lim); v.y = sane(v.y, lim); v.z = sane(v.z, lim); v.w = sane(v.w, lim); return v; }
#ifndef X2_BF16
#define X2_BF16 1
#endif
struct PmRaw { f32x4 x[4]; u32x2 xb[4]; u32x2 m[4]; };
template <bool XBF>
__device__ __forceinline__ void pm_load(PmRaw& R, const void* xin, const bf16* MIXED, int row, int lane) {
    const GAS u32x2* mr = (const GAS u32x2*)(MIXED + (size_t)row * DM) + lane;
    if (XBF) { const GAS u32x2* xr = (const GAS u32x2*)((const bf16*)xin + (size_t)row * DM) + lane;
#pragma unroll
        for (int j = 0; j < 4; ++j) { R.xb[j] = xr[64 * j]; R.m[j] = mr[64 * j]; }
    } else { const GAS f32x4* xr = (const GAS f32x4*)((const float*)xin + (size_t)row * DM) + lane;
#pragma unroll
        for (int j = 0; j < 4; ++j) { R.x[j] = xr[64 * j]; R.m[j] = mr[64 * j]; } }
}
template <bool XBF>
__device__ __forceinline__ void pm_row(const PmRaw& R, const f32x4 (&g1)[4], const f32x4 (&lg)[4], const f32x4 (&lb)[4], const f32x4 (&sc2)[4], const f32x4 (&sh2)[4],
                                       bf16* X1, bf16* H, const LAS float* rwT, LAS float* lgs, int row, int r, int lane, bool norouter) {
    f32x4 v[4];
    float s = 0.f;
#pragma unroll
    for (int j = 0; j < 4; ++j) { v[j] = (XBF ? sane4(bf4(R.xb[j]), 1e4f) : R.x[j]) * ALPHA + g1[j] * sane4(bf4(R.m[j]), 1e4f); s += (v[j].x + v[j].y) + (v[j].z + v[j].w); }
    float mean = wave_sum(s) * (1.f / DM), s2 = 0.f;
#pragma unroll
    for (int j = 0; j < 4; ++j) { v[j] = v[j] - mean; s2 += (v[j].x * v[j].x + v[j].y * v[j].y) + (v[j].z * v[j].z + v[j].w * v[j].w); }
    float rstd = 1.f / sqrtf(wave_sum(s2) * (1.f / DM) + LN_EPS);
    GAS u32x2* xo = (GAS u32x2*)(X1 + (size_t)row * DM) + lane; s = 0.f;
#pragma unroll
    for (int j = 0; j < 4; ++j) { v[j] = v[j] * rstd * lg[j] + lb[j];
        u32x2 w; w.x = pk2(v[j].x, v[j].y); w.y = pk2(v[j].z, v[j].w); ST8(&xo[64 * j], w); s += (v[j].x + v[j].y) + (v[j].z + v[j].w); }
    mean = wave_sum(s) * (1.f / DM); s2 = 0.f;
#pragma unroll
    for (int j = 0; j < 4; ++j) { v[j] = v[j] - mean; s2 += (v[j].x * v[j].x + v[j].y * v[j].y) + (v[j].z * v[j].z + v[j].w * v[j].w); }
    rstd = 1.f / sqrtf(wave_sum(s2) * (1.f / DM) + LN_EPS);
    GAS u32x2* ho = (GAS u32x2*)(H + (size_t)row * DM) + lane;
#pragma unroll
    for (int j = 0; j < 4; ++j) { v[j] = v[j] * rstd * (sc2[j] + 1.f) + sh2[j]; u32x2 w; w.x = pk2(v[j].x, v[j].y); w.y = pk2(v[j].z, v[j].w); ST8(&ho[64 * j], w); }
    if (norouter) return;
    float a[16];
#pragma unroll
    for (int e = 0; e < 16; ++e) {
        float s0 = 0.f;
#pragma unroll
        for (int j = 0; j < 4; ++j) { const f32x4 w4 = *(const LAS f32x4*)(rwT + e * 1024 + 4 * lane + 256 * j); s0 += (v[j].x * w4.x + v[j].y * w4.y) + (v[j].z * w4.z + v[j].w * w4.w); }
        a[e] = s0;
    }
    const bool h5 = (lane & 32) != 0, h4 = (lane & 16) != 0, h3 = (lane & 8) != 0, h2 = (lane & 4) != 0;
    float c8[8], d4[4], f2[2];
#define PX32(x) ([&]() { auto rr_ = __builtin_amdgcn_permlane32_swap(__float_as_uint(x), __float_as_uint(x), false, false); return __uint_as_float(h5 ? rr_[0] : rr_[1]); }())
#define PX16(x) ([&]() { auto rr_ = __builtin_amdgcn_permlane16_swap(__float_as_uint(x), __float_as_uint(x), false, false); return __uint_as_float(h4 ? rr_[0] : rr_[1]); }())
#define PDPP(x, ctrl) __builtin_bit_cast(float, __builtin_amdgcn_update_dpp(0, __builtin_bit_cast(int, (x)), (ctrl), 0xf, 0xf, false))
#pragma unroll
    for (int i = 0; i < 8; ++i) { const float mine = h5 ? a[8 + i] : a[i], send = h5 ? a[i] : a[8 + i]; c8[i] = mine + PX32(send); }
#pragma unroll
    for (int i = 0; i < 4; ++i) { const float mine = h4 ? c8[4 + i] : c8[i], send = h4 ? c8[i] : c8[4 + i]; d4[i] = mine + PX16(send); }
#pragma unroll
    for (int i = 0; i < 2; ++i) { const float mine = h3 ? d4[2 + i] : d4[i], send = h3 ? d4[i] : d4[2 + i]; f2[i] = mine + PDPP(send, 0x128); }
    float gsum; { const float mine = h2 ? f2[1] : f2[0], send = h2 ? f2[0] : f2[1]; gsum = mine + PDPP(send, 0x141); }
    gsum += PDPP(gsum, 0x4E); gsum += PDPP(gsum, 0xB1);
#undef PX32
#undef PX16
#undef PDPP
    if ((lane & 3) == 0) lgs[r * 16 + (lane >> 2)] = gsum;
}
#ifndef DRY_SKIP
#define DRY_SKIP 0
#endif
template <bool XBF>
__device__ __forceinline__ void ph_postmix_t(Frame& F, int l, bool dry) {
    LAS float* rwT = (LAS float*)(F.lds + RING_OFF);
    LAS float* lgs = (LAS float*)(F.lds + RING_OFF + 65536) + F.wave * 256;
    LAS int* lcnt = (LAS int*)(F.lds + LCNT_OFF);
    const void* xin = (const void*)(l == 0 ? F.x : F.out); const float* modl     = F.mod + (size_t)l * 8 * MODW; int* cnt = (int*)F.ctl + CW_CNT + 64 * l;
    const float* lng = F.ln_mix_g + l * DM; const float* lnb = F.ln_mix_b + l * DM; const int lane = F.lane;
    const bool norouter = dry && (DRY_SKIP & 1);
    { f32x4 t4[8];
#pragma unroll
      for (int j = 0; j < 8; ++j) t4[j] = ((const GAS f32x4*)F.router_w)[F.tid + 512 * j];
#pragma unroll
      for (int j = 0; j < 8; ++j) { const int i4 = F.tid + 512 * j, k = i4 >> 2, e0 = (i4 & 3) * 4; rwT[(e0 + 0) * 1024 + k] = t4[j].x; rwT[(e0 + 1) * 1024 + k] = t4[j].y; rwT[(e0 + 2) * 1024 + k] = t4[j].z; rwT[(e0 + 3) * 1024 + k] = t4[j].w; } }
#pragma unroll 1
    for (int base = blockIdx.x * 128; base < T; base += F.G * 128) {
        if (F.tid < 16) lcnt[F.tid] = 0;
        __syncthreads();
        const int b = base / SEQ, wrow = base + F.wave * 16;
        f32x4 g1[4], lg[4], lb[4], sc2[4], sh2[4];
        { const GAS f32x4* g1p = (const GAS f32x4*)(modl + (size_t)b * MODW + 2 * DM) + lane; const GAS f32x4* lgp = (const GAS f32x4*)lng + lane; const GAS f32x4* lbp = (const GAS f32x4*)lnb + lane;
#pragma unroll
          for (int j = 0; j < 4; ++j) { g1[j] = g1p[64 * j]; sh2[j] = g1p[256 + 64 * j]; sc2[j] = g1p[512 + 64 * j]; lg[j] = lgp[64 * j]; lb[j] = lbp[64 * j]; } }
        PmRaw A, B, C;
        pm_load<XBF>(A, xin, F.MIXED, wrow, lane); pm_load<XBF>(B, xin, F.MIXED, wrow + 1, lane);
#pragma unroll 1
        for (int it = 0; it < 5; ++it) {
            const int r0 = 3 * it;
            pm_load<XBF>(C, xin, F.MIXED, wrow + r0 + 2, lane);
            pm_row<XBF>(A, g1, lg, lb, sc2, sh2, F.S3, F.S1, rwT, lgs, wrow + r0, r0, lane, norouter);
            pm_load<XBF>(A, xin, F.MIXED, wrow + r0 + 3, lane);
            pm_row<XBF>(B, g1, lg, lb, sc2, sh2, F.S3, F.S1, rwT, lgs, wrow + r0 + 1, r0 + 1, lane, norouter);
            if (it < 4) pm_load<XBF>(B, xin, F.MIXED, wrow + r0 + 4, lane);
            pm_row<XBF>(C, g1, lg, lb, sc2, sh2, F.S3, F.S1, rwT, lgs, wrow + r0 + 2, r0 + 2, lane, norouter);
        }
        pm_row<XBF>(A, g1, lg, lb, sc2, sh2, F.S3, F.S1, rwT, lgs, wrow + 15, 15, lane, norouter);
        LDS_WAIT(); asm volatile("" ::: "memory");
        int my_e1 = 0, my_e2 = 0, my_l1 = 0, my_l2 = 0;
        if (lane < 16) {
            float p[16];
#pragma unroll
            for (int q = 0; q < 4; ++q) { const f32x4 t = *(const LAS f32x4*)(lgs + lane * 16 + 4 * q); p[4 * q] = t.x; p[4 * q + 1] = t.y; p[4 * q + 2] = t.z; p[4 * q + 3] = t.w; }
            float mx = -INFINITY, sum = 0.f;
#pragma unroll
            for (int e = 0; e < 16; ++e) { p[e] += F.router_b[e]; mx = fmaxf(mx, p[e]); }
#pragma unroll
            for (int e = 0; e < 16; ++e) { p[e] = expf(p[e] - mx); sum += p[e]; }
            const float rs = 1.f / sum;
#pragma unroll
            for (int e = 0; e < 16; ++e) p[e] *= rs;
            int bg = 0; float bgs = -1.f;
#pragma unroll
            for (int g = 0; g < 4; ++g) { float m1 = p[4 * g]; int i1 = 0;
#pragma unroll
                for (int i = 1; i < 4; ++i) if (p[4 * g + i] > m1) { m1 = p[4 * g + i]; i1 = i; }
                float m2 = -1.f;
#pragma unroll
                for (int i = 0; i < 4; ++i) if (i != i1 && p[4 * g + i] > m2) m2 = p[4 * g + i];
                const float gs = m1 + m2; if (gs > bgs) { bgs = gs; bg = g; } }
            float q0 = 0.f, q1 = 0.f, q2 = 0.f, q3 = 0.f;
#pragma unroll
            for (int g = 0; g < 4; ++g) if (bg == g) { q0 = p[4 * g]; q1 = p[4 * g + 1]; q2 = p[4 * g + 2]; q3 = p[4 * g + 3]; }
            float m1 = q0; int i1 = 0; if (q1 > m1) { m1 = q1; i1 = 1; } if (q2 > m1) { m1 = q2; i1 = 2; } if (q3 > m1) { m1 = q3; i1 = 3; }
            float m2 = -1.f; int i2 = 0;
            if (i1 != 0 && q0 > m2) { m2 = q0; i2 = 0; } if (i1 != 1 && q1 > m2) { m2 = q1; i2 = 1; } if (i1 != 2 && q2 > m2) { m2 = q2; i2 = 2; } if (i1 != 3 && q3 > m2) { m2 = q3; i2 = 3; }
            my_e1 = bg * 4 + i1; my_e2 = bg * 4 + i2; const int row = wrow + lane; const float den = 1.f / (m1 + m2);
            my_l1 = __hip_atomic_fetch_add(lcnt + my_e1, 1, __ATOMIC_RELAXED, __HIP_MEMORY_SCOPE_WORKGROUP); my_l2 = __hip_atomic_fetch_add(lcnt + my_e2, 1, __ATOMIC_RELAXED, __HIP_MEMORY_SCOPE_WORKGROUP);
            const float gw1 = m1 * den, gw2 = m2 * den; ST4(&F.tok_e[2 * row], my_e1); ST4(&F.tok_e[2 * row + 1], my_e2); ST4(&F.tok_g[2 * row], gw1); ST4(&F.tok_g[2 * row + 1], gw2);
        }
        __syncthreads();
        if (F.tid < 16 && !dry) lcnt[16 + F.tid] = atomicAdd(cnt + F.tid, lcnt[F.tid]);
        __syncthreads();
        if (lane < 16 && !dry) { const int row = wrow + lane, s1 = lcnt[16 + my_e1] + my_l1, s2 = lcnt[16 + my_e2] + my_l2;
            ST4(&F.tok_slot[2 * row], s1); ST4(&F.tok_slot[2 * row + 1], s2); ST4(&F.lists[(size_t)my_e1 * T + s1], row); ST4(&F.lists[(size_t)my_e2 * T + s2], row); }
        __syncthreads();
    }
}
__device__ __forceinline__ void ph_postmix(Frame& F, int l, bool dry = false) { if (X2_BF16 && l > 0) ph_postmix_t<true>(F, l, dry); else ph_postmix_t<false>(F, l, dry); }
__device__ __forceinline__ void moe_table(Frame& F, int l) {
    LAS int* tab = (LAS int*)(F.lds + TAB_OFF); LAS int* eb = (LAS int*)(F.lds + EB_OFF); const int* cnt = (const int*)F.ctl + CW_CNT + 64 * l;
    __syncthreads();
    if (F.tid < 272 || F.tid == 511) {
        int pref = 0, mine = -1;
#pragma unroll
        for (int e = 0; e < 16; ++e) { const int n = __hip_atomic_load(cnt + e, RLX_AGENT), nt = (n + 255) >> 8; if (F.tid < 272 && F.tid >= pref && F.tid < pref + nt) mine = e | ((F.tid - pref) << 8);
            if (F.tid == 511) eb[e] = pref * 256; pref += nt; }
        if (F.tid < 272) tab[1 + F.tid] = mine;
        if (F.tid == 511) tab[0] = pref;
    }
    __syncthreads();
}
struct PfRaw { u32x2 x[4], y0[4], y1[4]; };
__device__ __forceinline__ void pf_load(PfRaw& R, const bf16* X1, const bf16* YP, int row, size_t r0, size_t r1, int lane) {
    const GAS u32x2* xr = (const GAS u32x2*)(X1 + (size_t)row * DM) + lane; const GAS u32x2* y0 = (const GAS u32x2*)(YP + r0 * DM) + lane; const GAS u32x2* y1 = (const GAS u32x2*)(YP + r1 * DM) + lane;
#pragma unroll
    for (int j = 0; j < 4; ++j) { R.x[j] = xr[64 * j]; R.y0[j] = y0[64 * j]; R.y1[j] = y1[64 * j]; }
}
template <bool NEXT>
__device__ __forceinline__ void pf_row(const PfRaw& R, float w0, float w1, const f32x4 (&g2)[4], const f32x4 (&lg)[4], const f32x4 (&lb)[4], const f32x4 (&sh)[4], const f32x4 (&sc)[4], float* out, bf16* X2b, bf16* H, int row, int lane, bool store_h) {
    f32x4 v[4]; float s = 0.f;
#pragma unroll
    for (int j = 0; j < 4; ++j) { v[j] = sane4(bf4(R.x[j]), 1e4f) * ALPHA + g2[j] * sane4(bf4(R.y0[j]) * w0 + bf4(R.y1[j]) * w1, 1e4f);
        s += (v[j].x + v[j].y) + (v[j].z + v[j].w); }
    float mean = wave_sum(s) * (1.f / DM), s2 = 0.f;
#pragma unroll
    for (int j = 0; j < 4; ++j) { v[j] = v[j] - mean; s2 += (v[j].x * v[j].x + v[j].y * v[j].y) + (v[j].z * v[j].z + v[j].w * v[j].w); }
    float rstd = 1.f / sqrtf(wave_sum(s2) * (1.f / DM) + LN_EPS);
    GAS f32x4* o = (GAS f32x4*)(out + (size_t)row * DM) + lane; s = 0.f;
    GAS u32x2* ob = (GAS u32x2*)(X2b + (size_t)row * DM) + lane;
#pragma unroll
    for (int j = 0; j < 4; ++j) { v[j] = v[j] * rstd * lg[j] + lb[j];
        if (X2_BF16 && store_h) { u32x2 w; w.x = pk2(v[j].x, v[j].y); w.y = pk2(v[j].z, v[j].w); ST8(&ob[64 * j], w); } else o[64 * j] = v[j];
        s += (v[j].x + v[j].y) + (v[j].z + v[j].w); }
    if (NEXT) {
        mean = wave_sum(s) * (1.f / DM); s2 = 0.f;
#pragma unroll
        for (int j = 0; j < 4; ++j) { v[j] = v[j] - mean; s2 += (v[j].x * v[j].x + v[j].y * v[j].y) + (v[j].z * v[j].z + v[j].w * v[j].w); }
        rstd = 1.f / sqrtf(wave_sum(s2) * (1.f / DM) + LN_EPS);
        GAS u32x2* ho = (GAS u32x2*)(H + (size_t)row * DM) + lane;
#pragma unroll
        for (int j = 0; j < 4; ++j) { const f32x4 r = v[j] * rstd * (sc[j] + 1.f) + sh[j]; u32x2 w; w.x = pk2(r.x, r.y); w.y = pk2(r.z, r.w); if (store_h) ST8(&ho[64 * j], w); }
    }
}
template <bool NEXT>
__device__ __forceinline__ void ph_postffn_t(Frame& F, int l) {
    const LAS int* eb = (const LAS int*)(F.lds + EB_OFF); const float* modl = F.mod + (size_t)l * 8 * MODW; const float* modn = F.mod + (size_t)(l + 1 < DEPTH ? l + 1 : l) * 8 * MODW;
    const float* lng = F.ln_ffn_g + l * DM; const float* lnb = F.ln_ffn_b + l * DM; const int lane = F.lane;
#pragma unroll 1
    for (int base = (F.vcu * NWAVES + F.wave) * 16; base < T; base += F.G * NWAVES * 16) {
        const int b = base / SEQ;
        const int mrow = base + (lane & 15);
        const int e0 = F.tok_e[2 * mrow], e1 = F.tok_e[2 * mrow + 1]; const float mw0 = F.tok_g[2 * mrow], mw1 = F.tok_g[2 * mrow + 1];
        const int mr0 = eb[e0] + F.tok_slot[2 * mrow], mr1 = eb[e1] + F.tok_slot[2 * mrow + 1];
        f32x4 g2[4], lg[4], lb[4], sh[4], sc[4];
        { const GAS f32x4* g2p = (const GAS f32x4*)(modl + (size_t)b * MODW + 5 * DM) + lane; const GAS f32x4* lgp = (const GAS f32x4*)lng + lane; const GAS f32x4* lbp = (const GAS f32x4*)lnb + lane;
          const GAS f32x4* shp = (const GAS f32x4*)(modn + (size_t)b * MODW) + lane;
#pragma unroll
          for (int j = 0; j < 4; ++j) { g2[j] = g2p[64 * j]; lg[j] = lgp[64 * j]; lb[j] = lbp[64 * j]; if (NEXT) { sh[j] = shp[64 * j]; sc[j] = shp[256 + 64 * j]; } else { sh[j] = (f32x4){0.f, 0.f, 0.f, 0.f}; sc[j] = sh[j]; } } }
        PfRaw A, B;
#define PF_LOAD2(R, r) pf_load(R, F.S3, F.YP, base + (r), (size_t)__builtin_amdgcn_readlane(mr0, (r)), (size_t)__builtin_amdgcn_readlane(mr1, (r)), lane)
#define PF_ROW2(R, r) pf_row<NEXT>(R, __builtin_bit_cast(float, __builtin_amdgcn_readlane(__builtin_bit_cast(int, mw0), (r))), __builtin_bit_cast(float, __builtin_amdgcn_readlane(__builtin_bit_cast(int, mw1), (r))), g2, lg, lb, sh, sc, F.out, (bf16*)F.out, F.S1, base + (r), lane, l + 1 < DEPTH)
        PF_LOAD2(A, 0);
#pragma unroll 1
        for (int it = 0; it < 8; ++it) {
            PF_LOAD2(B, 2 * it + 1);
            PF_ROW2(A, 2 * it);
            if (it < 7) PF_LOAD2(A, 2 * it + 2);
            PF_ROW2(B, 2 * it + 1);
        }
#undef PF_LOAD2
#undef PF_ROW2
    }
}
#ifndef PF_ALWAYS_NEXT
#define PF_ALWAYS_NEXT 1
#endif
__device__ __forceinline__ void ph_postffn(Frame& F, int l) { if (PF_ALWAYS_NEXT || l + 1 < DEPTH) ph_postffn_t<true>(F, l); else ph_postffn_t<false>(F, l); }

typedef __attribute__((address_space(4))) const unsigned char* kaptr_t;
__device__ __forceinline__ void frame_ptrs(Frame& F, kaptr_t ka) {
#define KA_IN(i) (*(const float* __attribute__((address_space(4))) const*)(ka + 8 * (i)))
    F.x = KA_IN(0); F.c = KA_IN(1); F.w_ada = KA_IN(2); F.b_ada = KA_IN(3); F.w_in = KA_IN(4); F.w_out = KA_IN(5); F.lq1 = KA_IN(6); F.lk1 = KA_IN(7); F.lq2 = KA_IN(8); F.lk2 = KA_IN(9);
    F.subln = KA_IN(10); F.ln_mix_g = KA_IN(11); F.ln_mix_b = KA_IN(12); F.ln_ffn_g = KA_IN(13); F.ln_ffn_b = KA_IN(14); F.router_w = KA_IN(15); F.router_b = KA_IN(16);
    F.w_gate = KA_IN(17); F.w_up = KA_IN(18); F.w_down = KA_IN(19);
    F.out = *(float* __attribute__((address_space(4))) const*)(ka + 160);
    unsigned char* ws = *(unsigned char* __attribute__((address_space(4))) const*)(ka + 168);
#undef KA_IN
    F.ws = ws; F.ctl = (gu32*)(ws + WS_CTL);
    F.mod = (float*)(ws + WS_MOD); F.rot = (float*)(ws + WS_ROT); F.tok_e = (int*)(ws + WS_TOK); F.tok_g = (float*)(ws + WS_TOK + 256 * 1024); F.tok_slot = (int*)(ws + WS_TOK + 512 * 1024);
    F.lists = (int*)(ws + WS_LIST); F.Wbf = (bf16*)(ws + WS_W);
    F.S1 = (bf16*)(ws + WS_S1); F.S3 = (bf16*)(ws + WS_S3); F.PROJ = (bf16*)(ws + WS_S2); F.YP = (bf16*)(ws + WS_YP); F.HE = (bf16*)(ws + WS_HE); F.MIXED = (bf16*)(ws + WS_MIXED);
}
struct Args { const float* in[20]; float* out; unsigned char* ws; int ph_lo, ph_hi, li, pad; };
__global__ void __launch_bounds__(NWAVES * 64, 2) mega(Args args) {
    extern __shared__ __attribute__((aligned(16))) unsigned char lds[];
    Frame F;
    F.lds = (LAS unsigned char*)lds; F.MISC = (volatile LAS unsigned*)(F.lds + MISC_OFF);
    F.tid = threadIdx.x; F.lane = F.tid & 63; F.wave = __builtin_amdgcn_readfirstlane(F.tid >> 6);
    F.G = gridDim.x; { const int bx = blockIdx.x; F.vcu = (F.G % 8 == 0) ? (bx % 8) * (F.G / 8) + bx / 8 : bx; }
    F.ctl = (gu32*)(args.ws + WS_CTL);
    for (int u = F.tid; u < (LDS_BYTES - LDSCTL_OFF) / 4; u += NWAVES * 64) ((LAS unsigned*)(F.lds + LDSCTL_OFF))[u] = 0u;
    __syncthreads();
    const int lo = args.ph_lo, hi = args.ph_hi;
    XcdBarrier bar; bar.bar = (unsigned*)(F.ctl + CW_BAR) + args.li * XCD_BAR_WORDS; bar.x = 0; bar.st = nullptr;
    if (hi - lo > 1) bar = xcd_barrier_post((unsigned*)(F.ctl + CW_BAR) + args.li * XCD_BAR_WORDS, F.MISC + 8);
#ifndef KIND_MASK
#define KIND_MASK 0x3ffu
#endif
#define KEN(k) ((KIND_MASK >> (k)) & 1u)
#ifndef REP_KIND
#define REP_KIND -1
#endif
#ifndef REP_N
#define REP_N 1
#endif
#define REPS(k) for (int rep_ = 0; rep_ < ((REP_KIND == (k)) ? REP_N : 1); ++rep_)
#define IN(k) (lo <= (k) && (k) < hi)
#define FRESH() do { int t_ = threadIdx.x; asm volatile("" : "+v"(t_)); F.tid = t_; F.lane = t_ & 63; kaptr_t ka_ = (kaptr_t)__builtin_amdgcn_kernarg_segment_ptr(); asm volatile("" : "+s"(ka_)); frame_ptrs(F, ka_); } while (0)
#ifndef BAR_REP
#define BAR_REP 1
#endif
#define SEAM(k) do { if (IN(k) && IN((k) + 1)) for (int br_ = 0; br_ < BAR_REP; ++br_) xcd_barrier(bar); } while (0)

    if (KEN(8) && IN(0)) REPS(8) { FRESH(); ph_prologue(F); } SEAM(0);
    if (KEN(9) && IN(1)) REPS(9) { FRESH(); ph_ln0(F); } SEAM(1);
    for (int l = 0; l < DEPTH; ++l) {
        const int pb = 2 + 8 * l;
#define wl (F.Wbf + (size_t)l * WL_STRIDE)
        if (KEN(0) && IN(pb + 0)) REPS(0) { FRESH();
            pg8::PlainSched S; S.init(T / 256, INW / 256, F.G, (int)blockIdx.x); S.Bt = wl + WL_IN; S.K = DM;
#ifndef ROT_EXP
#define ROT_EXP 0
#endif
            pg8::EpiInProj E{F.PROJ, F.rot, RET_FAST ? F.mod + 2 * 8 * MODW + 16 : nullptr, (ROT_EXP && rep_ > 0) ? F.S3 : nullptr};
            pg8::gemm_phase<pg8::EpiInProj, pg8::PlainSched, true>(F.lds + RING_OFF, (const char*)F.S1, DM, S, E);
        }
        SEAM(pb + 0);
        if (KEN(1) && IN(pb + 1)) REPS(1) { FRESH();
            if (RET_FAST) REPS(10) { const int bh = F.vcu >> 2, hh = bh & 7; ret::ret_unit(bh >> 3, hh, F.vcu & 3, F.PROJ, F.S1, F.mod[2 * 8 * MODW + 16 + 2048 + hh], F.lds + RING_OFF); }
#if ATTN128
            { const int bhc = F.vcu >> 2, b = bhc >> 3, hc = bhc & 7, h = hc >> 1, c = hc & 1, s = F.vcu & 3;
              const attn128::bf16* base = (const attn128::bf16*)(F.PROJ + (size_t)b * SEQ * INW);
#pragma unroll 1
              for (int i = 0; i < 4; ++i) { const int qb = i == 0 ? s : i == 1 ? 7 - s : i == 2 ? 8 + s : 15 - s;
                  #ifdef ATTN_DRY
                  if (rep_ + 1 < REP_N) attn128::attn_unit<ATTN_THRL, ATTN_DRY>(qb, base + C_DQ + h * 128 + c * 64, base + C_DK + h * 128 + c * 64, base + C_DV + h * 128,
                                        (attn128::bf16*)(F.S3 + (size_t)b * SEQ * DM + hc * 128), (char*)lds + RING_OFF); else
#endif
                  attn128::attn_unit<ATTN_THRL>(qb, base + C_DQ + h * 128 + c * 64, base + C_DK + h * 128 + c * 64, base + C_DV + h * 128,
                                        (attn128::bf16*)(F.S3 + (size_t)b * SEQ * DM + hc * 128), (char*)lds + RING_OFF); } }
        }
#else
            const int pr = F.vcu >> 1, b = pr >> 4, vh = pr & 15, h = vh >> 2, c = (vh >> 1) & 1, vhalf = vh & 1;
            const attn_body::bf16* base = (const attn_body::bf16*)(F.PROJ + (size_t)b * SEQ * INW);
#pragma unroll 1
            for (int i = 0; i < 8; ++i) { const int s = 2 * (i >> 1) + (F.vcu & 1), qb = (i & 1) ? 15 - s : s;
                attn_body::attn_unit<8>(qb, base + C_DQ + h * 128 + c * 64, base + C_DK + h * 128 + c * 64, base + C_DV + h * 128 + vhalf * 64,
                                        (attn_body::bf16*)(F.S3 + (size_t)b * SEQ * DM + vh * 64), (char*)lds + RING_OFF); }
        }
#endif
        SEAM(pb + 1);
        if (KEN(2) && IN(pb + 2)) REPS(2) { FRESH(); ph_combine(F, l); }
        SEAM(pb + 2);
        if (KEN(3) && IN(pb + 3)) REPS(3) { FRESH();
            pg8::PlainSched S; S.init(T / 256, DM / 256, F.G, (int)blockIdx.x); S.Bt = wl + WL_OUT; S.K = DM;
            pg8::EpiPlain E{F.MIXED, DM};
#ifdef EPI_DRY
            if (rep_ + 1 < REP_N) { pg8::EpiNone E0; pg8::gemm_phase<pg8::EpiNone, pg8::PlainSched, true>(F.lds + RING_OFF, (const char*)F.S1, DM, S, E0); } else
#endif
            pg8::gemm_phase<pg8::EpiPlain, pg8::PlainSched, true>(F.lds + RING_OFF, (const char*)F.S1, DM, S, E);
        }
        SEAM(pb + 3);
        if (KEN(4) && IN(pb + 4)) REPS(4) { FRESH(); ph_postmix(F, l, rep_ > 0); }
        SEAM(pb + 4);
#ifndef MOE_MODE
#define MOE_MODE 1
#endif
#define MOE_SCHED(S_, mode_) pg8::MoeMk<mode_> S_; S_.nMt = ((const LAS int*)(F.lds + TAB_OFF))[0]; S_.n1 = S_.nMt * 4; S_.c = (int)blockIdx.x; S_.l = l; S_.ldsb = F.lds; S_.Wgu = wl + WL_GU; S_.Wd = wl + WL_D; S_.ctl = F.ctl;
#define MOE_STAGE_TOKS(S_) do { LAS int* toks_ = (LAS int*)(F.lds + TOKS_OFF); const int* cnt_ = (const int*)F.ctl + CW_CNT + 64 * l; \
            _Pragma("unroll 1") for (int i_ = 0; i_ < TOKS_UNITS; ++i_) { pg8::MUnit u_; if (!S_.next(i_, u_) || u_.kind != 0) break; const int pm_ = __builtin_amdgcn_readfirstlane(u_.pm); \
                if (F.tid < 256) { const int te_ = S_.tab()[1 + pm_], e_ = te_ & 255, s_ = (te_ >> 8) * 256 + F.tid, n_ = cnt_[e_]; toks_[i_ * 256 + F.tid] = F.lists[(size_t)e_ * T + (s_ < n_ ? s_ : 0)]; } } \
            __syncthreads(); } while (0)
        if (KEN(5) && IN(pb + 5)) REPS(5) {
            FRESH(); moe_table(F, l);
#if MOE_MODE == 0
            pg8::MoeSched S; S.init(((const LAS int*)(F.lds + TAB_OFF))[0], 4, F.G, (int)blockIdx.x); S.Bt = wl + WL_GU; S.K = DM; S.tab = (const LAS int*)(F.lds + TAB_OFF);
            S.cnt = (const int*)F.ctl + CW_CNT + 64 * l; S.lists = F.lists; S.gather = true;
            pg8::EpiGateUp E{F.HE};
            pg8::gemm_phase<pg8::EpiGateUp, pg8::MoeSched, true>(F.lds + RING_OFF, (const char*)F.S1, DM, S, E);
#else
            MOE_SCHED(S, MOE_MODE == 2 ? 2 : 0); MOE_STAGE_TOKS(S);
            pg8::EpiGateUpWT E0{F.HE}; pg8::EpiPlain E1{F.YP, DM};
            pg8::gemm_phase_mk<pg8::MoeMk<(MOE_MODE == 2 ? 2 : 0)>, pg8::EpiGateUpWT, pg8::EpiPlain>(F.lds + RING_OFF, (const char*)F.ws, S, E0, E1);
#endif
        }
#if MOE_MODE != 2
        SEAM(pb + 5);
#endif
        if (KEN(6) && IN(pb + 6)) REPS(6) {
#if MOE_MODE == 0
            FRESH(); moe_table(F, l);
            pg8::MoeSched S; S.init(((const LAS int*)(F.lds + TAB_OFF))[0], 4, F.G, (int)blockIdx.x); S.Bt = wl + WL_D; S.K = DE; S.tab = (const LAS int*)(F.lds + TAB_OFF);
            S.cnt = (const int*)F.ctl + CW_CNT + 64 * l; S.lists = F.lists; S.gather = false;
            pg8::EpiPlain E{F.YP, DM};
            pg8::gemm_phase<pg8::EpiPlain, pg8::MoeSched, true>(F.lds + RING_OFF, (const char*)F.HE, DE, S, E);
#elif MOE_MODE == 1
            FRESH(); moe_table(F, l);
            MOE_SCHED(S, 1);
            pg8::EpiGateUpWT E0{F.HE}; pg8::EpiPlain E1{F.YP, DM};
            pg8::gemm_phase_mk<pg8::MoeMk<1>, pg8::EpiGateUpWT, pg8::EpiPlain>(F.lds + RING_OFF, (const char*)F.ws, S, E0, E1);
#endif
        }
        SEAM(pb + 6);
        if (KEN(7) && IN(pb + 7)) REPS(7) { FRESH(); moe_table(F, l); if (DEFER_W1 && l == 0) { deferred_weights(F, 4 * ((const LAS int*)(F.lds + TAB_OFF))[0], 2); } ph_postffn(F, l); }
        SEAM(pb + 7);
#undef wl
#undef MOE_SCHED
#undef MOE_STAGE_TOKS
    }
#undef IN
#undef SEAM
}
#ifndef FAST_MASK
#define FAST_MASK 0x3ffffu
#endif
extern "C" void kernel_launch(void* const* d_in, const int* in_sizes, int n_in, void* d_out, int out_size, void* d_ws, size_t ws_size, hipStream_t stream) {
    static int grid = 0;
    if (grid == 0) {
        if (n_in != 20 || out_size != T * DM || ws_size < WS_END) { fprintf(stderr, "kernel_launch: unexpected shapes (n_in %d out %d ws %zu)\n", n_in, out_size, ws_size); grid = -1; return; }
        int dev = 0, cus = 0, per_cu = 0;
        if (hipGetDevice(&dev) != hipSuccess || hipDeviceGetAttribute(&cus, hipDeviceAttributeMultiprocessorCount, dev) != hipSuccess) { grid = -1; return; }
        if (hipFuncSetAttribute((const void*)mega, hipFuncAttributeMaxDynamicSharedMemorySize, LDS_BYTES) != hipSuccess) { fprintf(stderr, "kernel_launch: hipFuncSetAttribute failed\n"); grid = -1; return; }
        if (hipOccupancyMaxActiveBlocksPerMultiprocessor(&per_cu, (const void*)mega, NWAVES * 64, LDS_BYTES) != hipSuccess || per_cu < 1) fprintf(stderr, "kernel_launch: occupancy query says %d\n", per_cu);
        (void)hipGetLastError();
        grid = cus;
        if (grid != 256) { fprintf(stderr, "kernel_launch: built for 256 CUs, found %d\n", grid); grid = -1; return; }
    }
    if (grid < 0) return;
    const float* x = (const float*)d_in[0];
    const float* w_in = (const float*)d_in[4]; const float* w_out = (const float*)d_in[5];
    const float* subln = (const float*)d_in[10]; const float* ln_mix_g = (const float*)d_in[11]; const float* ln_mix_b = (const float*)d_in[12];
    const float* ln_ffn_g = (const float*)d_in[13]; const float* ln_ffn_b = (const float*)d_in[14]; const float* router_w = (const float*)d_in[15]; const float* router_b = (const float*)d_in[16];
    const float* w_gate = (const float*)d_in[17]; const float* w_up = (const float*)d_in[18]; const float* w_down = (const float*)d_in[19];
    unsigned char* ws = (unsigned char*)d_ws; float* out = (float*)d_out;
    float* mod = (float*)(ws + WS_MOD); float* rot = (float*)(ws + WS_ROT);
    int* tok_e = (int*)(ws + WS_TOK); float* tok_g = (float*)(ws + WS_TOK + 256 * 1024); int* tok_slot = (int*)(ws + WS_TOK + 512 * 1024); int* lists = (int*)(ws + WS_LIST);
    bf16* S1 = (bf16*)(ws + WS_S1); bf16* X1 = (bf16*)(ws + WS_S3); bf16* PROJ = (bf16*)(ws + WS_S2); bf16* YP = (bf16*)(ws + WS_YP); bf16* HE = (bf16*)(ws + WS_HE); bf16* MIXED = (bf16*)(ws + WS_MIXED);
    int* ctl = (int*)(ws + WS_CTL);
    (void)hipMemsetAsync(ws + WS_CTL, 0, 1 * MiB, stream);
    Args a{};
    for (int i = 0; i < 20; ++i) a.in[i] = (const float*)d_in[i];
    a.out = out; a.ws = ws;
    int li = 0, lo = -1;
    auto flush = [&](int hi) { if (lo >= 0) { a.ph_lo = lo; a.ph_hi = hi; a.li = li++; hipLaunchKernelGGL(mega, dim3(grid), dim3(NWAVES * 64), LDS_BYTES, stream, a); lo = -1; } };
    for (int p = 0; p < NPHASE; ++p) {
        const bool fast = (FAST_MASK >> p) & 1u;
        const int l = p < 2 ? 0 : (p - 2) / 8, k = p < 2 ? -1 : (p - 2) % 8;
        const float* modl = mod + (size_t)l * 8 * MODW; int* cnt = ctl + CW_CNT + 64 * l;
        if (fast) { if (lo < 0) lo = p; }
        else {
            flush(p);
            if (p == 0) { k_mod<<<dim3(MODW / 256, 2), 256, 0, stream>>>((const float*)d_in[1], (const float*)d_in[2], (const float*)d_in[3], (const float*)d_in[6], (const float*)d_in[7], (const float*)d_in[8], (const float*)d_in[9], mod);
                          k_rot<<<512, 256, 0, stream>>>(rot); }
            else if (p == 1) k_ln_mod<<<T / 4, 256, 0, stream>>>(x, mod, 0, S1);
            else if (k == 0) k_ngemm_inproj<<<dim3(INW / 64, T / 128), 256, 0, stream>>>(S1, w_in + (size_t)l * DM * INW, rot, PROJ);
            else if (k == 1) k_ndiff<<<dim3(SEQ / 64, 4, NB), 256, 0, stream>>>(PROJ, mod + 2 * 8 * MODW, subln, l, S1);
            else if (k == 2) {   }
            else if (k == 3) k_ngemm_plain<<<dim3(DM / 64, T / 128), 256, 0, stream>>>(S1, DM, w_out + (size_t)l * DM * DM, DM, DM, MIXED, DM);
            else if (k == 4) k_post_mix<<<T / 4, 256, 0, stream>>>(l == 0 ? x : out, MIXED, modl, ln_mix_g + l * DM, ln_mix_b + l * DM, router_w, router_b, X1, S1, tok_e, tok_g, tok_slot, lists, cnt);
            else if (k == 5) k_moe1<<<dim3(DE / 64, T / 128, NE), 256, 0, stream>>>(S1, w_gate + (size_t)l * NE * DM * DE, w_up + (size_t)l * NE * DM * DE, cnt, lists, HE);
            else if (k == 6) k_moe2<<<dim3(DM / 64, T / 128, NE), 256, 0, stream>>>(HE, w_down + (size_t)l * NE * DE * DM, cnt, YP);
            else if (k == 7) k_post_ffn<<<T / 4, 256, 0, stream>>>(X1, YP, modl, ln_ffn_g + l * DM, ln_ffn_b + l * DM, tok_e, tok_g, tok_slot, cnt, out, l + 1 < DEPTH ? mod + (size_t)(l + 1) * 8 * MODW : nullptr, S1);
        }
        if (!RET_FAST && k == 2) { flush(p + 1); k_nret<<<dim3(SEQ / 64, 8, NB), 256, 0, stream>>>(PROJ, S1); }
    }
    flush(NPHASE);
}
```

```cpp
#include <hip/hip_runtime.h>
#include <cstdio>
#include <cstdint>
#include <cmath>

typedef unsigned short bf16;
typedef float f32x4 __attribute__((ext_vector_type(4)));
typedef unsigned u32x4 __attribute__((ext_vector_type(4)));
typedef unsigned u32x2 __attribute__((ext_vector_type(2)));

constexpr int NB = 8, SEQ = 4096, DM = 1024, T = NB * SEQ, DEPTH = 2;
constexpr int INW = 3584, NE = 16, DE = 512;
constexpr int C_RQ = 0, C_RK = 512, C_RV = 1024, C_RG = 1536, C_DQ = 2048, C_DK = 2560, C_DV = 3072;
constexpr float ALPHA = 1.41421356237309515f;
constexpr float LN_EPS = 1e-5f;
constexpr float C2 = 0.125f * 1.4426950408889634f;
constexpr int MODW = 6 * DM;
constexpr int PAIR_ROWS = 69632;

constexpr size_t MiB = 1u << 20;
constexpr size_t WS_CTL = 0;
constexpr size_t WS_MOD = 1 * MiB;
constexpr size_t WS_ROT = 2 * MiB;
constexpr size_t WS_TOK = 3 * MiB;
constexpr size_t WS_LIST = 4 * MiB;
constexpr size_t WS_W = 8 * MiB;
constexpr size_t WS_S1 = 122 * MiB;
constexpr size_t WS_S3 = 186 * MiB;
constexpr size_t WS_S2 = 250 * MiB;
constexpr size_t WS_YP = WS_S2, WS_HE = WS_S2 + 136 * MiB, WS_MIXED = WS_HE;
constexpr size_t WS_END = 474 * MiB;
constexpr int CW_CNT = 64;

__device__ __forceinline__ float bf2f(bf16 v) { return __uint_as_float((unsigned)v << 16); }
__device__ __forceinline__ unsigned f2bf(float f) { unsigned u = __float_as_uint(f); return (u + 0x7fffu + ((u >> 16) & 1u)) >> 16; }
typedef float pk_f32x2_t __attribute__((ext_vector_type(2))); typedef __bf16 pk_bf16x2_t __attribute__((ext_vector_type(2)));
__device__ __forceinline__ unsigned pk2(float lo, float hi) { pk_f32x2_t v = {lo, hi}; pk_bf16x2_t b = __builtin_convertvector(v, pk_bf16x2_t); return __builtin_bit_cast(unsigned, b); }
__device__ __forceinline__ float dpp_add(float v, const int ctrl_tag) { return v; }
#define WS_DPP(v, ctrl) ((v) + __builtin_bit_cast(float, __builtin_amdgcn_update_dpp(0, __builtin_bit_cast(int, (v)), (ctrl), 0xf, 0xf, false)))
__device__ __forceinline__ float wave_sum(float v) {
    v = WS_DPP(v, 0xB1);
    v = WS_DPP(v, 0x4E);
    v = WS_DPP(v, 0x141);
    v = WS_DPP(v, 0x140);
    { auto rr = __builtin_amdgcn_permlane16_swap(__float_as_uint(v), __float_as_uint(v), false, false); v = __uint_as_float(rr[0]) + __uint_as_float(rr[1]); }
    { auto rr = __builtin_amdgcn_permlane32_swap(__float_as_uint(v), __float_as_uint(v), false, false); v = __uint_as_float(rr[0]) + __uint_as_float(rr[1]); }
    return v;
}
__device__ __forceinline__ float row16_sum(float v) {
    v = WS_DPP(v, 0xB1); v = WS_DPP(v, 0x4E); v = WS_DPP(v, 0x141); v = WS_DPP(v, 0x140); return v;
}
__device__ __forceinline__ float silu_f(float v) { return v / (1.f + __expf(-v)); }

__global__ void __launch_bounds__(256) k_mod(const float* c, const float* w_ada, const float* b_ada, const float* lq1, const float* lk1, const float* lq2, const float* lk2, float* mod) {
    __shared__ float cond[8][1024];
    const int l = blockIdx.y, j = blockIdx.x * 256 + threadIdx.x;
    for (int i = threadIdx.x; i < 8192; i += 256) { const float v = c[i]; cond[i >> 10][i & 1023] = v / (1.f + expf(-v)); }
    __syncthreads();
    float acc[8];
#pragma unroll
    for (int b = 0; b < 8; ++b) acc[b] = 0.f;
    const float* w = w_ada + (size_t)l * 1024 * MODW + j;
    for (int k = 0; k < 1024; ++k) { const float wv = w[(size_t)k * MODW];
#pragma unroll
        for (int b = 0; b < 8; ++b) acc[b] += cond[b][k] * wv; }
#pragma unroll
    for (int b = 0; b < 8; ++b) mod[(size_t)(l * 8 + b) * MODW + j] = acc[b] + b_ada[l * MODW + j];
    if (blockIdx.x == 0 && threadIdx.x == 0) {
        float s1 = 0.f, s2 = 0.f;
        for (int i = 0; i < 64; ++i) { s1 += lq1[l * 64 + i] * lk1[l * 64 + i]; s2 += lq2[l * 64 + i] * lk2[l * 64 + i]; }
        const float li = 0.8f - 0.6f * expf(-0.3f * (float)l);
        mod[2 * 8 * MODW + l] = expf(s1) - expf(s2) + li;
        mod[2 * 8 * MODW + 2 + l] = li;
    }
}
__global__ void k_rot(float* rot) {
    const int idx = blockIdx.x * 256 + threadIdx.x; if (idx >= 4096 * 32) return;
    const int pos = idx >> 5, i = idx & 31;
    const double inv = pow(10000.0, -(double)(2 * i) / 64.0), a = (double)pos * inv;
    rot[2 * idx] = (float)cos(a); rot[2 * idx + 1] = (float)sin(a);
}

__global__ void __launch_bounds__(256) k_ln_mod(const float* x, const float* modl, int sh_off, bf16* H) {
    const int row = blockIdx.x * 4 + (threadIdx.x >> 6), lane = threadIdx.x & 63, b = row / SEQ;
    const f32x4* xr = (const f32x4*)(x + (size_t)row * DM) + lane;
    f32x4 v[4]; float s = 0.f;
#pragma unroll
    for (int j = 0; j < 4; ++j) { v[j] = xr[64 * j]; s += (v[j].x + v[j].y) + (v[j].z + v[j].w); }
    const float mean = wave_sum(s) * (1.f / DM); float s2 = 0.f;
#pragma unroll
    for (int j = 0; j < 4; ++j) { v[j] = v[j] - mean; s2 += (v[j].x * v[j].x + v[j].y * v[j].y) + (v[j].z * v[j].z + v[j].w * v[j].w); }
    const float rstd = 1.f / sqrtf(wave_sum(s2) * (1.f / DM) + LN_EPS);
    const f32x4* sh = (const f32x4*)(modl + (size_t)b * MODW + sh_off) + lane; const f32x4* sc = sh + 256;
    u32x2* o = (u32x2*)(H + (size_t)row * DM) + lane;
#pragma unroll
    for (int j = 0; j < 4; ++j) { const f32x4 a = sh[64 * j], m = sc[64 * j]; const f32x4 r = v[j] * rstd * (m + 1.f) + a; u32x2 w; w.x = pk2(r.x, r.y); w.y = pk2(r.z, r.w); o[64 * j] = w; }
}

template <bool DUAL>
__device__ __forceinline__ void ngemm_core(const bf16* arow, const float* W0, const float* W1, int ldw, int K, float (&acc0)[8][4], float (&acc1)[8][4], float* As, float* Ws0, float* Ws1) {
    const int tid = threadIdx.x, tx = tid & 15, ty = tid >> 4;
#pragma unroll
    for (int i = 0; i < 8; ++i)
#pragma unroll
        for (int j = 0; j < 4; ++j) { acc0[i][j] = 0.f; acc1[i][j] = 0.f; }
    const int ar = tid >> 1, ak = (tid & 1) * 8, wk = tid >> 4, wn = (tid & 15) * 4;
    for (int k0 = 0; k0 < K; k0 += 16) {
        const u32x4 av = *(const u32x4*)(arow + k0);
        const f32x4 w0 = *(const f32x4*)(W0 + (size_t)(k0 + wk) * ldw + wn);
        f32x4 w1 = {0.f, 0.f, 0.f, 0.f}; if (DUAL) w1 = *(const f32x4*)(W1 + (size_t)(k0 + wk) * ldw + wn);
        __syncthreads();
        As[(ak + 0) * 129 + ar] = __uint_as_float(av.x << 16); As[(ak + 1) * 129 + ar] = __uint_as_float(av.x & 0xffff0000u);
        As[(ak + 2) * 129 + ar] = __uint_as_float(av.y << 16); As[(ak + 3) * 129 + ar] = __uint_as_float(av.y & 0xffff0000u);
        As[(ak + 4) * 129 + ar] = __uint_as_float(av.z << 16); As[(ak + 5) * 129 + ar] = __uint_as_float(av.z & 0xffff0000u);
        As[(ak + 6) * 129 + ar] = __uint_as_float(av.w << 16); As[(ak + 7) * 129 + ar] = __uint_as_float(av.w & 0xffff0000u);
        *(f32x4*)(Ws0 + wk * 64 + wn) = w0; if (DUAL) *(f32x4*)(Ws1 + wk * 64 + wn) = w1;
        __syncthreads();
#pragma unroll
        for (int k = 0; k < 16; ++k) {
            float a[8], b0[4], b1[4];
#pragma unroll
            for (int i = 0; i < 8; ++i) a[i] = As[k * 129 + ty + 16 * i];
#pragma unroll
            for (int j = 0; j < 4; ++j) { b0[j] = Ws0[k * 64 + tx + 16 * j]; if (DUAL) b1[j] = Ws1[k * 64 + tx + 16 * j]; }
#pragma unroll
            for (int i = 0; i < 8; ++i)
#pragma unroll
                for (int j = 0; j < 4; ++j) { acc0[i][j] += a[i] * b0[j]; if (DUAL) acc1[i][j] += a[i] * b1[j]; }
        }
    }
}

__global__ void __launch_bounds__(256) k_ngemm_inproj(const bf16* H, const float* Win, const float* rot, bf16* PROJ) {
    __shared__ float As[16 * 129], Ws0[16 * 64];
    const int tid = threadIdx.x, tx = tid & 15, ty = tid >> 4, col0 = blockIdx.x * 64, row0 = blockIdx.y * 128;
    float acc[8][4], dummy[8][4];
    ngemm_core<false>(H + (size_t)(row0 + (tid >> 1)) * DM + (tid & 1) * 8, Win + col0, nullptr, INW, DM, acc, dummy, As, Ws0, nullptr);
    const int region = col0 / 512;
#pragma unroll
    for (int i = 0; i < 8; ++i) {
        const int row = row0 + ty + 16 * i, pos = row % SEQ; bf16* o = PROJ + (size_t)row * INW + col0;
        if (region < 2) {
            const float sc = region == 0 ? 0.125f : 1.f;
#pragma unroll
            for (int j = 0; j < 2; ++j) { const int ic = tx + 16 * j; const float cs = rot[(pos * 32 + ic) * 2], sn = rot[(pos * 32 + ic) * 2 + 1];
                const float x1 = acc[i][j], x2 = acc[i][j + 2]; o[ic] = (bf16)f2bf((x1 * cs - x2 * sn) * sc); o[ic + 32] = (bf16)f2bf((x1 * sn + x2 * cs) * sc); }
        } else {
#pragma unroll
            for (int j = 0; j < 4; ++j) { float v = acc[i][j]; if (region == 3) v = silu_f(v); if (region == 4) v *= C2; o[tx + 16 * j] = (bf16)f2bf(v); }
        }
    }
}
__global__ void __launch_bounds__(256) k_ngemm_plain(const bf16* A, int lda, const float* W, int ldw, int K, bf16* C, int ldc) {
    __shared__ float As[16 * 129], Ws0[16 * 64];
    const int tid = threadIdx.x, tx = tid & 15, ty = tid >> 4, col0 = blockIdx.x * 64, row0 = blockIdx.y * 128;
    float acc[8][4], dummy[8][4];
    ngemm_core<false>(A + (size_t)(row0 + (tid >> 1)) * lda + (tid & 1) * 8, W + col0, nullptr, ldw, K, acc, dummy, As, Ws0, nullptr);
#pragma unroll
    for (int i = 0; i < 8; ++i)
#pragma unroll
        for (int j = 0; j < 4; ++j) C[(size_t)(row0 + ty + 16 * i) * ldc + col0 + tx + 16 * j] = (bf16)f2bf(acc[i][j]);
}

__global__ void __launch_bounds__(256) k_nret(const bf16* PROJ, bf16* CAT) {
    __shared__ float Qs[64 * 65], Ks[64 * 65], Vs[64 * 64], st[128]; float* Ss = Ks;
    const int tid = threadIdx.x, tx = tid & 15, ty = tid >> 4;
    const int qt = (gridDim.x - 1) - blockIdx.x, h = blockIdx.y, b = blockIdx.z, q0 = qt * 64;
    const float log_g = logf(1.f - exp2f(-5.f - (float)h));
    const bf16* base = PROJ + (size_t)b * SEQ * INW;
    for (int i = tid; i < 64 * 64; i += 256) { const int r = i >> 6, d = i & 63; Qs[r * 65 + d] = bf2f(base[(size_t)(q0 + r) * INW + C_RQ + h * 64 + d]); }
    float o[4][4];
#pragma unroll
    for (int i = 0; i < 4; ++i)
#pragma unroll
        for (int j = 0; j < 4; ++j) o[i][j] = 0.f;
    for (int kt = 0; kt <= qt; ++kt) {
        const int k0 = kt * 64;
        __syncthreads();
        for (int i = tid; i < 64 * 64; i += 256) { const int r = i >> 6, d = i & 63; Ks[r * 65 + d] = bf2f(base[(size_t)(k0 + r) * INW + C_RK + h * 64 + d]); Vs[r * 64 + d] = bf2f(base[(size_t)(k0 + r) * INW + C_RV + h * 64 + d]); }
        __syncthreads();
        float s[4][4];
#pragma unroll
        for (int i = 0; i < 4; ++i)
#pragma unroll
            for (int j = 0; j < 4; ++j) s[i][j] = 0.f;
        for (int d = 0; d < 64; ++d) { float a[4], k[4];
#pragma unroll
            for (int i = 0; i < 4; ++i) { a[i] = Qs[(ty + 16 * i) * 65 + d]; k[i] = Ks[(tx + 16 * i) * 65 + d]; }
#pragma unroll
            for (int i = 0; i < 4; ++i)
#pragma unroll
                for (int j = 0; j < 4; ++j) s[i][j] += a[i] * k[j]; }
        __syncthreads();
#pragma unroll
        for (int i = 0; i < 4; ++i)
#pragma unroll
            for (int j = 0; j < 4; ++j) { const int t = q0 + ty + 16 * i, m = k0 + tx + 16 * j; Ss[(ty + 16 * i) * 65 + tx + 16 * j] = (m <= t) ? s[i][j] * expf(log_g * (float)(t - m)) : 0.f; }
        __syncthreads();
        for (int m = 0; m < 64; ++m) { float p[4], v[4];
#pragma unroll
            for (int i = 0; i < 4; ++i) { p[i] = Ss[(ty + 16 * i) * 65 + m]; v[i] = Vs[m * 64 + tx + 16 * i]; }
#pragma unroll
            for (int i = 0; i < 4; ++i)
#pragma unroll
                for (int j = 0; j < 4; ++j) o[i][j] += p[i] * v[j]; }
    }
    __syncthreads();
#pragma unroll
    for (int i = 0; i < 4; ++i)
#pragma unroll
        for (int j = 0; j < 4; ++j) Ss[(ty + 16 * i) * 65 + tx + 16 * j] = o[i][j];
    __syncthreads();
    if (tid < 64) { float s = 0.f; for (int d = 0; d < 64; ++d) s += Ss[tid * 65 + d]; const float mean = s * (1.f / 64.f); float q = 0.f; for (int d = 0; d < 64; ++d) { const float e = Ss[tid * 65 + d] - mean; q += e * e; }
        st[tid] = mean; st[64 + tid] = 1.f / sqrtf(q * (1.f / 64.f) + LN_EPS); }
    __syncthreads();
#pragma unroll
    for (int i = 0; i < 4; ++i)
#pragma unroll
        for (int j = 0; j < 4; ++j) { const int r = ty + 16 * i, cc = tx + 16 * j; const size_t row = (size_t)b * SEQ + q0 + r;
            const float g = bf2f(PROJ[row * INW + C_RG + h * 64 + cc]);
            CAT[row * DM + h * 64 + cc] = (bf16)f2bf((o[i][j] - st[r]) * st[64 + r] * g); }
}

__global__ void __launch_bounds__(256) k_ndiff(const bf16* PROJ, const float* modx  , const float* subln, int l, bf16* CAT) {
    __shared__ float Qs[64 * 65], Ks[32 * 65], Vs[32 * 128], Ps[64 * 33], mrow[64], lrow[64], srow[64];
    const int tid = threadIdx.x, tx = tid & 15, ty = tid >> 4;
    const int qt = (gridDim.x - 1) - blockIdx.x, h = blockIdx.y, b = blockIdx.z, q0 = qt * 64;
    const float lam = modx[l], li = modx[2 + l];
    const bf16* base = PROJ + (size_t)b * SEQ * INW;
    float res[4][8];
    for (int c = 0; c < 2; ++c) {
        __syncthreads();
        for (int i = tid; i < 64 * 64; i += 256) { const int r = i >> 6, d = i & 63; Qs[r * 65 + d] = bf2f(base[(size_t)(q0 + r) * INW + C_DQ + h * 128 + c * 64 + d]); }
        if (tid < 64) { mrow[tid] = -INFINITY; lrow[tid] = 0.f; }
        float o[4][8];
#pragma unroll
        for (int i = 0; i < 4; ++i)
#pragma unroll
            for (int j = 0; j < 8; ++j) o[i][j] = 0.f;
        const int nkt = (q0 + 64) / 32;
        for (int kt = 0; kt < nkt; ++kt) {
            const int k0 = kt * 32;
            __syncthreads();
            for (int i = tid; i < 32 * 64; i += 256) { const int r = i >> 6, d = i & 63; Ks[r * 65 + d] = bf2f(base[(size_t)(k0 + r) * INW + C_DK + h * 128 + c * 64 + d]); }
            for (int i = tid; i < 32 * 128; i += 256) { const int r = i >> 7, d = i & 127; Vs[r * 128 + d] = bf2f(base[(size_t)(k0 + r) * INW + C_DV + h * 128 + d]); }
            __syncthreads();
            float s[4][2];
#pragma unroll
            for (int i = 0; i < 4; ++i) { s[i][0] = 0.f; s[i][1] = 0.f; }
            for (int d = 0; d < 64; ++d) { float a[4], k[2];
#pragma unroll
                for (int i = 0; i < 4; ++i) a[i] = Qs[(ty + 16 * i) * 65 + d];
                k[0] = Ks[tx * 65 + d]; k[1] = Ks[(tx + 16) * 65 + d];
#pragma unroll
                for (int i = 0; i < 4; ++i) { s[i][0] += a[i] * k[0]; s[i][1] += a[i] * k[1]; } }
#pragma unroll
            for (int i = 0; i < 4; ++i)
#pragma unroll
                for (int j = 0; j < 2; ++j) { const int t = q0 + ty + 16 * i, m = k0 + tx + 16 * j; Ps[(ty + 16 * i) * 33 + tx + 16 * j] = (m <= t) ? s[i][j] : -INFINITY; }
            __syncthreads();
            if (tid < 64) { float mx = mrow[tid]; for (int m = 0; m < 32; ++m) mx = fmaxf(mx, Ps[tid * 33 + m]);
                const float sc = exp2f(mrow[tid] - mx); float sum = 0.f;
                for (int m = 0; m < 32; ++m) { const float p = exp2f(Ps[tid * 33 + m] - mx); Ps[tid * 33 + m] = p; sum += p; }
                lrow[tid] = lrow[tid] * sc + sum; mrow[tid] = mx; srow[tid] = sc; }
            __syncthreads();
#pragma unroll
            for (int i = 0; i < 4; ++i) { const float sc = srow[ty + 16 * i];
#pragma unroll
                for (int j = 0; j < 8; ++j) o[i][j] *= sc; }
            for (int m = 0; m < 32; ++m) { float p[4], v[8];
#pragma unroll
                for (int i = 0; i < 4; ++i) p[i] = Ps[(ty + 16 * i) * 33 + m];
#pragma unroll
                for (int j = 0; j < 8; ++j) v[j] = Vs[m * 128 + tx + 16 * j];
#pragma unroll
                for (int i = 0; i < 4; ++i)
#pragma unroll
                    for (int j = 0; j < 8; ++j) o[i][j] += p[i] * v[j]; }
        }
        __syncthreads();
#pragma unroll
        for (int i = 0; i < 4; ++i) { const float inv = 1.f / lrow[ty + 16 * i];
#pragma unroll
            for (int j = 0; j < 8; ++j) { if (c == 0) res[i][j] = o[i][j] * inv; else res[i][j] -= lam * o[i][j] * inv; } }
    }
    __syncthreads();
#pragma unroll
    for (int i = 0; i < 4; ++i) { float q = 0.f;
#pragma unroll
        for (int j = 0; j < 8; ++j) q += res[i][j] * res[i][j];
        Ps[(ty + 16 * i) * 33 + tx] = q; }
    __syncthreads();
    if (tid < 64) { float q = 0.f; for (int m = 0; m < 16; ++m) q += Ps[tid * 33 + m]; srow[tid] = 1.f / sqrtf(q * (1.f / 128.f) + LN_EPS); }
    __syncthreads();
#pragma unroll
    for (int i = 0; i < 4; ++i)
#pragma unroll
        for (int j = 0; j < 8; ++j) { const int r = ty + 16 * i, cc = tx + 16 * j; const size_t row = (size_t)b * SEQ + q0 + r;
            CAT[row * DM + 512 + h * 128 + cc] = (bf16)f2bf(res[i][j] * srow[r] * subln[l * 128 + cc] * (1.f - li)); }
}

__global__ void __launch_bounds__(256) k_post_mix(const float* xin, const bf16* MIXED, const float* modl, const float* lng, const float* lnb, const float* rw, const float* rb,
                                                  bf16* X1, bf16* H, int* tok_e, float* tok_g, int* tok_slot, int* lists, int* cnt) {
    const int row = blockIdx.x * 4 + (threadIdx.x >> 6), lane = threadIdx.x & 63, b = row / SEQ;
    const f32x4* xr = (const f32x4*)(xin + (size_t)row * DM) + lane; const u32x2* mr = (const u32x2*)(MIXED + (size_t)row * DM) + lane;
    const f32x4* g1 = (const f32x4*)(modl + (size_t)b * MODW + 2 * DM) + lane; const f32x4* sh2 = g1 + 256; const f32x4* sc2 = g1 + 512;
    f32x4 v[4]; float s = 0.f;
#pragma unroll
    for (int j = 0; j < 4; ++j) { const f32x4 x = xr[64 * j], g = g1[64 * j]; const u32x2 m = mr[64 * j];
        f32x4 mv; mv.x = __uint_as_float(m.x << 16); mv.y = __uint_as_float(m.x & 0xffff0000u); mv.z = __uint_as_float(m.y << 16); mv.w = __uint_as_float(m.y & 0xffff0000u);
        v[j] = x * ALPHA + g * mv; s += (v[j].x + v[j].y) + (v[j].z + v[j].w); }
    float mean = wave_sum(s) * (1.f / DM), s2 = 0.f;
#pragma unroll
    for (int j = 0; j < 4; ++j) { v[j] = v[j] - mean; s2 += (v[j].x * v[j].x + v[j].y * v[j].y) + (v[j].z * v[j].z + v[j].w * v[j].w); }
    float rstd = 1.f / sqrtf(wave_sum(s2) * (1.f / DM) + LN_EPS);
    u32x2* xo = (u32x2*)(X1 + (size_t)row * DM) + lane; s = 0.f;
#pragma unroll
    for (int j = 0; j < 4; ++j) { const f32x4 g = ((const f32x4*)lng)[lane + 64 * j], bb = ((const f32x4*)lnb)[lane + 64 * j]; v[j] = v[j] * rstd * g + bb;
        u32x2 w; w.x = pk2(v[j].x, v[j].y); w.y = pk2(v[j].z, v[j].w); xo[64 * j] = w; s += (v[j].x + v[j].y) + (v[j].z + v[j].w); }
    mean = wave_sum(s) * (1.f / DM); s2 = 0.f;
#pragma unroll
    for (int j = 0; j < 4; ++j) { v[j] = v[j] - mean; s2 += (v[j].x * v[j].x + v[j].y * v[j].y) + (v[j].z * v[j].z + v[j].w * v[j].w); }
    rstd = 1.f / sqrtf(wave_sum(s2) * (1.f / DM) + LN_EPS);
    u32x2* ho = (u32x2*)(H + (size_t)row * DM) + lane;
    float lg[16];
#pragma unroll
    for (int e = 0; e < 16; ++e) lg[e] = 0.f;
#pragma unroll
    for (int j = 0; j < 4; ++j) { const f32x4 a = sh2[64 * j], m = sc2[64 * j]; v[j] = v[j] * rstd * (m + 1.f) + a;
        u32x2 w; w.x = pk2(v[j].x, v[j].y); w.y = pk2(v[j].z, v[j].w); ho[64 * j] = w;
        const f32x4* wr = (const f32x4*)(rw + (size_t)(4 * lane + 256 * j) * 16);
#pragma unroll
        for (int q = 0; q < 4; ++q) { const float hv = q == 0 ? v[j].x : q == 1 ? v[j].y : q == 2 ? v[j].z : v[j].w;
#pragma unroll
            for (int e4 = 0; e4 < 4; ++e4) { const f32x4 w4 = wr[q * 4 + e4]; lg[e4 * 4 + 0] += hv * w4.x; lg[e4 * 4 + 1] += hv * w4.y; lg[e4 * 4 + 2] += hv * w4.z; lg[e4 * 4 + 3] += hv * w4.w; } } }
    float mx = -INFINITY;
#pragma unroll
    for (int e = 0; e < 16; ++e) { lg[e] = wave_sum(lg[e]) + rb[e]; mx = fmaxf(mx, lg[e]); }
    float p[16], sum = 0.f;
#pragma unroll
    for (int e = 0; e < 16; ++e) { p[e] = expf(lg[e] - mx); sum += p[e]; }
    const float rs = 1.f / sum;
#pragma unroll
    for (int e = 0; e < 16; ++e) p[e] *= rs;
    int bg = 0; float bgs = -1.f;
#pragma unroll
    for (int g = 0; g < 4; ++g) { float m1 = p[4 * g]; int i1 = 0;
#pragma unroll
        for (int i = 1; i < 4; ++i) if (p[4 * g + i] > m1) { m1 = p[4 * g + i]; i1 = i; }
        float m2 = -1.f;
#pragma unroll
        for (int i = 0; i < 4; ++i) if (i != i1 && p[4 * g + i] > m2) m2 = p[4 * g + i];
        const float gs = m1 + m2; if (gs > bgs) { bgs = gs; bg = g; } }
    float q0 = 0.f, q1 = 0.f, q2 = 0.f, q3 = 0.f;
#pragma unroll
    for (int g = 0; g < 4; ++g) if (bg == g) { q0 = p[4 * g]; q1 = p[4 * g + 1]; q2 = p[4 * g + 2]; q3 = p[4 * g + 3]; }
    float m1 = q0; int i1 = 0; if (q1 > m1) { m1 = q1; i1 = 1; } if (q2 > m1) { m1 = q2; i1 = 2; } if (q3 > m1) { m1 = q3; i1 = 3; }
    float m2 = -1.f; int i2 = 0;
    if (i1 != 0 && q0 > m2) { m2 = q0; i2 = 0; } if (i1 != 1 && q1 > m2) { m2 = q1; i2 = 1; } if (i1 != 2 && q2 > m2) { m2 = q2; i2 = 2; } if (i1 != 3 && q3 > m2) { m2 = q3; i2 = 3; }
    if (lane == 0) {
        const int e1 = bg * 4 + i1, e2 = bg * 4 + i2; const float den = 1.f / (m1 + m2);
        const int s1 = atomicAdd(cnt + e1, 1), s2_ = atomicAdd(cnt + e2, 1);
        lists[(size_t)e1 * T + s1] = row; lists[(size_t)e2 * T + s2_] = row;
        tok_e[2 * row] = e1; tok_e[2 * row + 1] = e2; tok_g[2 * row] = m1 * den; tok_g[2 * row + 1] = m2 * den; tok_slot[2 * row] = s1; tok_slot[2 * row + 1] = s2_;
    }
}

__device__ __forceinline__ int expert_base(const int* cnt, int e) { int bs = 0; for (int i = 0; i < 16; ++i) if (i < e) bs += (cnt[i] + 255) & ~255; return bs; }
__global__ void __launch_bounds__(256) k_moe1(const bf16* H, const float* wg, const float* wu, const int* cnt, const int* lists, bf16* HE) {
    __shared__ float As[16 * 129], Ws0[16 * 64], Ws1[16 * 64];
    const int e = blockIdx.z, rt = blockIdx.y, ct = blockIdx.x, n = cnt[e]; if (rt * 128 >= n) return;
    const int tid = threadIdx.x, tx = tid & 15, ty = tid >> 4, base = expert_base(cnt, e);
    const int sl = rt * 128 + (tid >> 1), tok = lists[(size_t)e * T + (sl < n ? sl : 0)];
    float g[8][4], u[8][4];
    ngemm_core<true>(H + (size_t)tok * DM + (tid & 1) * 8, wg + (size_t)e * DM * DE + ct * 64, wu + (size_t)e * DM * DE + ct * 64, DE, DM, g, u, As, Ws0, Ws1);
#pragma unroll
    for (int i = 0; i < 8; ++i) { const int s = rt * 128 + ty + 16 * i; if (s < n) {
#pragma unroll
        for (int j = 0; j < 4; ++j) HE[(size_t)(base + s) * DE + ct * 64 + tx + 16 * j] = (bf16)f2bf(silu_f(g[i][j]) * u[i][j]); } }
}
__global__ void __launch_bounds__(256) k_moe2(const bf16* HE, const float* wd, const int* cnt, bf16* YP) {
    __shared__ float As[16 * 129], Ws0[16 * 64];
    const int e = blockIdx.z, rt = blockIdx.y, ct = blockIdx.x, n = cnt[e]; if (rt * 128 >= n) return;
    const int tid = threadIdx.x, tx = tid & 15, ty = tid >> 4, base = expert_base(cnt, e);
    const int sl = rt * 128 + (tid >> 1);
    float acc[8][4], dummy[8][4];
    ngemm_core<false>(HE + (size_t)(base + (sl < n ? sl : 0)) * DE + (tid & 1) * 8, wd + (size_t)e * DE * DM + ct * 64, nullptr, DM, DE, acc, dummy, As, Ws0, nullptr);
#pragma unroll
    for (int i = 0; i < 8; ++i) { const int s = rt * 128 + ty + 16 * i; if (s < n) {
#pragma unroll
        for (int j = 0; j < 4; ++j) YP[(size_t)(base + s) * DM + ct * 64 + tx + 16 * j] = (bf16)f2bf(acc[i][j]); } }
}

__global__ void __launch_bounds__(256) k_post_ffn(const bf16* X1, const bf16* YP, const float* modl, const float* lng, const float* lnb, const int* tok_e, const float* tok_g, const int* tok_slot, const int* cnt,
                                                  float* out, const float* modn, bf16* H) {
    const int row = blockIdx.x * 4 + (threadIdx.x >> 6), lane = threadIdx.x & 63, b = row / SEQ;
    const int e0 = tok_e[2 * row], e1 = tok_e[2 * row + 1]; const float w0 = tok_g[2 * row], w1 = tok_g[2 * row + 1];
    const size_t r0 = (size_t)expert_base(cnt, e0) + tok_slot[2 * row], r1 = (size_t)expert_base(cnt, e1) + tok_slot[2 * row + 1];
    const u32x2* xr = (const u32x2*)(X1 + (size_t)row * DM) + lane; const u32x2* y0 = (const u32x2*)(YP + r0 * DM) + lane; const u32x2* y1 = (const u32x2*)(YP + r1 * DM) + lane;
    const f32x4* g2 = (const f32x4*)(modl + (size_t)b * MODW + 5 * DM) + lane;
    f32x4 v[4]; float s = 0.f;
#pragma unroll
    for (int j = 0; j < 4; ++j) { const u32x2 x = xr[64 * j], a = y0[64 * j], c = y1[64 * j]; const f32x4 g = g2[64 * j];
        f32x4 xv, av, cv; xv.x = __uint_as_float(x.x << 16); xv.y = __uint_as_float(x.x & 0xffff0000u); xv.z = __uint_as_float(x.y << 16); xv.w = __uint_as_float(x.y & 0xffff0000u);
        av.x = __uint_as_float(a.x << 16); av.y = __uint_as_float(a.x & 0xffff0000u); av.z = __uint_as_float(a.y << 16); av.w = __uint_as_float(a.y & 0xffff0000u);
        cv.x = __uint_as_float(c.x << 16); cv.y = __uint_as_float(c.x & 0xffff0000u); cv.z = __uint_as_float(c.y << 16); cv.w = __uint_as_float(c.y & 0xffff0000u);
        v[j] = xv * ALPHA + g * (av * w0 + cv * w1); s += (v[j].x + v[j].y) + (v[j].z + v[j].w); }
    float mean = wave_sum(s) * (1.f / DM), s2 = 0.f;
#pragma unroll
    for (int j = 0; j < 4; ++j) { v[j] = v[j] - mean; s2 += (v[j].x * v[j].x + v[j].y * v[j].y) + (v[j].z * v[j].z + v[j].w * v[j].w); }
    float rstd = 1.f / sqrtf(wave_sum(s2) * (1.f / DM) + LN_EPS);
    f32x4* o = (f32x4*)(out + (size_t)row * DM) + lane; s = 0.f;
#pragma unroll
    for (int j = 0; j < 4; ++j) { const f32x4 g = ((const f32x4*)lng)[lane + 64 * j], bb = ((const f32x4*)lnb)[lane + 64 * j]; v[j] = v[j] * rstd * g + bb; o[64 * j] = v[j]; s += (v[j].x + v[j].y) + (v[j].z + v[j].w); }
    if (modn) {
        mean = wave_sum(s) * (1.f / DM); s2 = 0.f;
#pragma unroll
        for (int j = 0; j < 4; ++j) { v[j] = v[j] - mean; s2 += (v[j].x * v[j].x + v[j].y * v[j].y) + (v[j].z * v[j].z + v[j].w * v[j].w); }
        rstd = 1.f / sqrtf(wave_sum(s2) * (1.f / DM) + LN_EPS);
        const f32x4* sh = (const f32x4*)(modn + (size_t)b * MODW) + lane; const f32x4* sc = sh + 256; u32x2* ho = (u32x2*)(H + (size_t)row * DM) + lane;
#pragma unroll
        for (int j = 0; j < 4; ++j) { const f32x4 a = sh[64 * j], m = sc[64 * j]; const f32x4 r = v[j] * rstd * (m + 1.f) + a; u32x2 w; w.x = pk2(r.x, r.y); w.y = pk2(r.z, r.w); ho[64 * j] = w; }
    }
}

#include <hip/hip_bf16.h>
#ifndef RET_FAST
#define RET_FAST 1
#endif
#ifndef ATTN128
#define ATTN128 1
#endif
#ifndef ATTN_THRL
#define ATTN_THRL 8
#endif
#define LAS __attribute__((address_space(3)))
#define GAS __attribute__((address_space(1)))
typedef short bf16x8 __attribute__((ext_vector_type(8)));
typedef GAS unsigned gu32;
#define RLX_AGENT __ATOMIC_RELAXED, __HIP_MEMORY_SCOPE_AGENT
#define LDS_WAIT() asm volatile("s_waitcnt lgkmcnt(0)" ::: "memory")
#define VM_WAIT() asm volatile("s_waitcnt vmcnt(0)" ::: "memory")

constexpr size_t WL_IN = 0, WL_OUT = (size_t)INW * DM, WL_GU = WL_OUT + (size_t)DM * DM, WL_D = WL_GU + (size_t)NE * 1024 * DM, WL_STRIDE = WL_D + (size_t)NE * DM * DE;
static_assert(WL_STRIDE * 2 * 2 <= 114 * MiB, "weights fit");

namespace pg8 {
constexpr int BM = 256, BK = 64, HALF = 128, HTB = HALF * BK * 2, STAGE_BYTES = 8 * HTB, NXCD = 8, WGM = 8;
__host__ __device__ __forceinline__ int lds_byte(int r, int c) { const int st = (r >> 4) * 2 + (c >> 5), rr = r & 15, cc = c & 31, ob = rr * 64 + cc * 2; return st * 1024 + (ob ^ (((ob >> 9) & 1) << 5)); }
__host__ __device__ __forceinline__ void stage_rc(int b, int& R, int& C) { const int st = b / 1024, sb = b % 1024, swz = sb ^ (((sb >> 9) & 1) << 5); R = (st >> 1) * 16 + swz / 64; C = (st & 1) * 32 + (swz % 64) / 2; }
__host__ __device__ __forceinline__ int perm32(int rho) { const int n = rho >> 4, i = rho & 15; return 8 * (i >> 2) + 4 * n + (i & 3); }
struct Unit { int pm, pn; };

struct OrderBase {
    int nM, nN, nwg, G, c;
    __device__ __forceinline__ void init(int nM_, int nN_, int G_, int c_) { nM = nM_; nN = nN_; nwg = nM * nN; G = G_; c = c_; }
    __device__ __forceinline__ bool next(int i, Unit& u) const {
        const long L = (long)i * G + c; if (L >= nwg) return false;
        int wgid = (int)L; { const int q = nwg / NXCD, r = nwg % NXCD, xcd = wgid % NXCD, off = wgid / NXCD; wgid = (xcd < r ? xcd * (q + 1) : r * (q + 1) + (xcd - r) * q) + off; }
        const int nig = WGM * nN, gid = wgid / nig, fm = gid * WGM, gsz = (nM - fm) < WGM ? (nM - fm) : WGM;
        u.pm = fm + ((wgid % nig) % gsz); u.pn = (wgid % nig) / gsz; return true;
    }
    __device__ __forceinline__ void a_ready(const Unit&) const {}
    __device__ __forceinline__ void done(const Unit&) const {}
};
struct PlainSched : OrderBase {
    const bf16* Bt; int K;
    __device__ __forceinline__ void setup(const Unit& u, const int (&Rl)[2], const int (&Cb)[2], unsigned (&off)[2][2], const char*& bptr) const {
#pragma unroll
        for (int h = 0; h < 2; ++h)
#pragma unroll
            for (int i = 0; i < 2; ++i) off[h][i] = (unsigned)((u.pm * 256 + h * 128 + Rl[i]) * K * 2 + Cb[i]);
        bptr = (const char*)Bt + (size_t)u.pn * 256 * K * 2;
    }
};
struct MoeSched : OrderBase {
    const bf16* Bt; int K; const LAS int* tab; const int* cnt; const int* lists; bool gather;
    __device__ __forceinline__ void setup(const Unit& u, const int (&Rl)[2], const int (&Cb)[2], unsigned (&off)[2][2], const char*& bptr) const {
        const int te = tab[1 + u.pm], e = te & 255, s0 = (te >> 8) * 256;
        if (gather) { const int n = cnt[e];
#pragma unroll
            for (int h = 0; h < 2; ++h)
#pragma unroll
                for (int i = 0; i < 2; ++i) { const int s = s0 + h * 128 + Rl[i]; const int tok = lists[(size_t)e * T + (s < n ? s : 0)]; off[h][i] = (unsigned)(tok * K * 2 + Cb[i]); }
        } else {
#pragma unroll
            for (int h = 0; h < 2; ++h)
#pragma unroll
                for (int i = 0; i < 2; ++i) off[h][i] = (unsigned)((u.pm * 256 + h * 128 + Rl[i]) * K * 2 + Cb[i]);
        }
        bptr = (const char*)Bt + (size_t)(e * 4 + u.pn) * 256 * K * 2;
    }
};

__device__ __forceinline__ unsigned cvt_pk_bf16(float lo, float hi) { unsigned r; asm volatile("v_cvt_pk_bf16_f32 %0, %1, %2" : "=v"(r) : "v"(lo), "v"(hi)); return r; }
__device__ __forceinline__ float fsilu(float v) { return v * __builtin_amdgcn_rcpf(1.f + __expf(-v)); }
#ifndef EPI_T
#define EPI_T 1
#endif
__device__ __forceinline__ u32x4 tr4(u32x4 w, int src4) {
#if EPI_T
    u32x4 r; r.x = (unsigned)__builtin_amdgcn_ds_bpermute(src4, (int)w.x); r.y = (unsigned)__builtin_amdgcn_ds_bpermute(src4, (int)w.y);
    r.z = (unsigned)__builtin_amdgcn_ds_bpermute(src4, (int)w.z); r.w = (unsigned)__builtin_amdgcn_ds_bpermute(src4, (int)w.w); return r;
#else
    return w;
#endif
}
#define EPI_T_LANES() const int ln_ = fq * 16 + fr; const int fr2 = EPI_T ? (ln_ >> 2) : fr, fq2 = EPI_T ? (ln_ & 3) : fq, src4 = (fq2 * 16 + fr2) * 4; (void)src4

struct EpiInProj {
    static constexpr bool PERM = true, AFTER_DRAIN = false;
    bf16* P; const float* rot; const float* dtab; bf16* dummy;
    __device__ __forceinline__ void operator()(const f32x4 (&acc)[2][2][4][2], const Unit& u, int wr, int wc, int fr, int fq) const {
        EPI_T_LANES(); const int row0 = u.pm * BM + wr * 64 + fr, row0a = u.pm * BM + wr * 64 + fr2;
        if (u.pn < 4 && !dummy) {
            const float sc0 = u.pn < 2 ? 0.125f : 1.f; const float* dt = dtab ? dtab + (u.pn >> 1) * 1024 + ((u.pn & 1) * 4 + wc) * 128 : nullptr;
#pragma unroll
            for (int ai = 0; ai < 2; ++ai) {
                f32x4 tt[4][4]; float scv[4];
#pragma unroll
                for (int m = 0; m < 4; ++m) { const int pos = (row0 + ai * HALF + m * 16) & (SEQ - 1); const f32x4* rt = (const f32x4*)(rot + (size_t)(pos * 32 + 8 * fq) * 2);
                    tt[m][0] = rt[0]; tt[m][1] = rt[1]; tt[m][2] = rt[2]; tt[m][3] = rt[3]; scv[m] = dt ? dt[pos & 127] : sc0; }
#pragma unroll
                for (int m = 0; m < 4; ++m) { const int row = row0 + ai * HALF + m * 16; const float sc = scv[m];
                    const f32x4 t0 = tt[m][0], t1 = tt[m][1], t2 = tt[m][2], t3 = tt[m][3];
                    const f32x4 xa = acc[ai][0][m][0], xb = acc[ai][0][m][1], ya = acc[ai][1][m][0], yb = acc[ai][1][m][1];
                    u32x4 w1, w2;
                    w1.x = cvt_pk_bf16((xa[0] * t0.x - ya[0] * t0.y) * sc, (xa[1] * t0.z - ya[1] * t0.w) * sc); w1.y = cvt_pk_bf16((xa[2] * t1.x - ya[2] * t1.y) * sc, (xa[3] * t1.z - ya[3] * t1.w) * sc);
                    w1.z = cvt_pk_bf16((xb[0] * t2.x - yb[0] * t2.y) * sc, (xb[1] * t2.z - yb[1] * t2.w) * sc); w1.w = cvt_pk_bf16((xb[2] * t3.x - yb[2] * t3.y) * sc, (xb[3] * t3.z - yb[3] * t3.w) * sc);
                    w2.x = cvt_pk_bf16((xa[0] * t0.y + ya[0] * t0.x) * sc, (xa[1] * t0.w + ya[1] * t0.z) * sc); w2.y = cvt_pk_bf16((xa[2] * t1.y + ya[2] * t1.x) * sc, (xa[3] * t1.w + ya[3] * t1.z) * sc);
                    w2.z = cvt_pk_bf16((xb[0] * t2.y + yb[0] * t2.x) * sc, (xb[1] * t2.w + yb[1] * t2.z) * sc); w2.w = cvt_pk_bf16((xb[2] * t3.y + yb[2] * t3.x) * sc, (xb[3] * t3.w + yb[3] * t3.z) * sc);
                    bf16* o = P + (size_t)(row0a + ai * HALF + m * 16) * INW + u.pn * BM + 64 * wc + 8 * fq2;
                    *(u32x4*)o = tr4(w1, src4); *(u32x4*)(o + 32) = tr4(w2, src4); }
            }
        } else {
            const int region = u.pn >> 1;
#pragma unroll
            for (int ai = 0; ai < 2; ++ai)
#pragma unroll
                for (int m = 0; m < 4; ++m) { bf16* o = (u.pn < 4) ? dummy + (size_t)(row0a + ai * HALF + m * 16) * DM + u.pn * BM + wc * 32 + 8 * fq2 : P + (size_t)(row0a + ai * HALF + m * 16) * INW + u.pn * BM + wc * 32 + 8 * fq2;
#pragma unroll
                    for (int bj = 0; bj < 2; ++bj) { f32x4 v0 = acc[ai][bj][m][0], v1 = acc[ai][bj][m][1];
                        if (region == 3) { v0[0] = fsilu(v0[0]); v0[1] = fsilu(v0[1]); v0[2] = fsilu(v0[2]); v0[3] = fsilu(v0[3]); v1[0] = fsilu(v1[0]); v1[1] = fsilu(v1[1]); v1[2] = fsilu(v1[2]); v1[3] = fsilu(v1[3]); }
                        if (region == 4) { v0 = v0 * C2; v1 = v1 * C2; }
                        u32x4 w; w.x = cvt_pk_bf16(v0[0], v0[1]); w.y = cvt_pk_bf16(v0[2], v0[3]); w.z = cvt_pk_bf16(v1[0], v1[1]); w.w = cvt_pk_bf16(v1[2], v1[3]);
                        *(u32x4*)(o + bj * HALF) = tr4(w, src4); } }
        }
    }
};
struct EpiPlain {
    static constexpr bool PERM = true, AFTER_DRAIN = false;
    bf16* O; int ldc;
    __device__ __forceinline__ void operator()(const f32x4 (&acc)[2][2][4][2], const Unit& u, int wr, int wc, int fr, int fq) const {
        EPI_T_LANES(); const int row0 = u.pm * BM + wr * 64 + fr2, col0 = u.pn * BM + wc * 32 + 8 * fq2;
#pragma unroll
        for (int ai = 0; ai < 2; ++ai)
#pragma unroll
            for (int m = 0; m < 4; ++m) { bf16* o = O + (size_t)(row0 + ai * HALF + m * 16) * ldc + col0;
#pragma unroll
                for (int bj = 0; bj < 2; ++bj) { const f32x4 v0 = acc[ai][bj][m][0], v1 = acc[ai][bj][m][1];
                    u32x4 w; w.x = cvt_pk_bf16(v0[0], v0[1]); w.y = cvt_pk_bf16(v0[2], v0[3]); w.z = cvt_pk_bf16(v1[0], v1[1]); w.w = cvt_pk_bf16(v1[2], v1[3]);
                    *(u32x4*)(o + bj * HALF) = tr4(w, src4); } }
    }
};
struct EpiNone {
    static constexpr bool PERM = true, AFTER_DRAIN = false;
    __device__ __forceinline__ void operator()(const f32x4 (&acc)[2][2][4][2], const Unit& u, int wr, int wc, int fr, int fq) const {
#pragma unroll
        for (int ai = 0; ai < 2; ++ai)
#pragma unroll
            for (int bj = 0; bj < 2; ++bj)
#pragma unroll
                for (int m = 0; m < 4; ++m) { asm volatile("" :: "v"(acc[ai][bj][m][0]), "v"(acc[ai][bj][m][1])); }
    }
};
struct EpiGateUp {
    static constexpr bool PERM = true, AFTER_DRAIN = false;
    bf16* HE;
    __device__ __forceinline__ void operator()(const f32x4 (&acc)[2][2][4][2], const Unit& u, int wr, int wc, int fr, int fq) const {
        EPI_T_LANES(); const int row0 = u.pm * BM + wr * 64 + fr2, col0 = u.pn * 128 + wc * 32 + 8 * fq2;
#pragma unroll
        for (int ai = 0; ai < 2; ++ai)
#pragma unroll
            for (int m = 0; m < 4; ++m) { const f32x4 g0 = acc[ai][0][m][0], g1 = acc[ai][0][m][1], u0 = acc[ai][1][m][0], u1 = acc[ai][1][m][1];
                u32x4 w; w.x = cvt_pk_bf16(fsilu(g0[0]) * u0[0], fsilu(g0[1]) * u0[1]); w.y = cvt_pk_bf16(fsilu(g0[2]) * u0[2], fsilu(g0[3]) * u0[3]);
                w.z = cvt_pk_bf16(fsilu(g1[0]) * u1[0], fsilu(g1[1]) * u1[1]); w.w = cvt_pk_bf16(fsilu(g1[2]) * u1[2], fsilu(g1[3]) * u1[3]);
                *(u32x4*)(HE + (size_t)(row0 + ai * HALF + m * 16) * DE + col0) = tr4(w, src4); }
    }
};

template <class Epi, class Sched, bool ALIGN_EPI>
__device__ __forceinline__ void gemm_phase(LAS unsigned char* lds, const char* gA, int K, const Sched& S, const Epi& E) {
    int tid_ = threadIdx.x; asm volatile("" : "+v"(tid_));
    const int tid = tid_, wid = __builtin_amdgcn_readfirstlane(tid >> 6), lane = tid & 63, wr = wid >> 2, wc = wid & 3, fr = lane & 15, fq = lane >> 4;
    const int nt = K / BK;
    unsigned voffB[2]; int Rl[2], Cb[2];
#pragma unroll
    for (int i = 0; i < 2; ++i) { int R, C; stage_rc(tid * 16 + i * 8192, R, C); const int Rb = Epi::PERM ? ((R & ~31) + perm32(R & 31)) : R;
        voffB[i] = (unsigned)(Rb * K + C) * 2u; Rl[i] = R; Cb[i] = C * 2; }
    const size_t kstep = (size_t)(BK * 2), hstep = (size_t)HALF * K * 2;
    const unsigned ldsw = (unsigned)wid * 1024u;
    const int aoff = lds_byte(wr * 64 + fr, fq * 8), boff = lds_byte(wc * 32 + fr, fq * 8);
#define PG8_SA(b, h) (((b) * 2 + (h)) * HTB)
#define PG8_SB(b, h) ((4 + (b) * 2 + (h)) * HTB)
#define PG8_STAGE(bufoff, gbase, voff) do { _Pragma("unroll") for (int _i = 0; _i < 2; ++_i) \
        __builtin_amdgcn_global_load_lds((const unsigned*)((const char*)(gbase) + (voff)[_i]), (LAS unsigned*)(lds + (bufoff) + ldsw + _i * 8192), 16, 0, 0); } while (0)
#define PG8_LDA(dst, b, h) do { _Pragma("unroll") for (int m = 0; m < 4; ++m) _Pragma("unroll") for (int k = 0; k < 2; ++k) dst[m][k] = *(const LAS bf16x8*)(lds + PG8_SA(b, h) + aoff + m * 2048 + k * 1024); } while (0)
#define PG8_LDB(dst, b, h) do { _Pragma("unroll") for (int n = 0; n < 2; ++n) _Pragma("unroll") for (int k = 0; k < 2; ++k) dst[n][k] = *(const LAS bf16x8*)(lds + PG8_SB(b, h) + boff + n * 2048 + k * 1024); } while (0)
#define PG8_MMA(ai, bj, At, Bt) do { __builtin_amdgcn_s_setprio(1); _Pragma("unroll") for (int m = 0; m < 4; ++m) _Pragma("unroll") for (int n = 0; n < 2; ++n) _Pragma("unroll") for (int k = 0; k < 2; ++k) \
        acc[ai][bj][m][n] = __builtin_amdgcn_mfma_f32_16x16x32_bf16(Bt[n][k], At[m][k], acc[ai][bj][m][n], 0, 0, 0); __builtin_amdgcn_s_setprio(0); } while (0)
#define PG8_WAIT_V(n) asm volatile("s_waitcnt vmcnt(" #n ")" ::: "memory")
#define PG8_WAIT_L(n) asm volatile("s_waitcnt lgkmcnt(" #n ")" ::: "memory")
#define PG8_BAR __builtin_amdgcn_s_barrier()
#define PG8_SCHED __builtin_amdgcn_sched_barrier(0)
    Unit cur, nxt; int ui = 0;
    if (!S.next(0, cur)) return;
    f32x4 acc[2][2][4][2];
#pragma unroll
    for (int a = 0; a < 2; ++a)
#pragma unroll
        for (int b = 0; b < 2; ++b)
#pragma unroll
            for (int m = 0; m < 4; ++m)
#pragma unroll
                for (int n = 0; n < 2; ++n) acc[a][b][m][n] = (f32x4){0.f, 0.f, 0.f, 0.f};
    bf16x8 At[4][2], B0[2][2], B1[2][2];
    unsigned oc[2][2], on[2][2]; const char* cB; const char* nB;
    S.setup(cur, Rl, Cb, oc, cB);
    S.a_ready(cur);
    PG8_STAGE(PG8_SB(0, 0), cB, voffB); PG8_STAGE(PG8_SB(0, 1), cB + hstep, voffB); PG8_STAGE(PG8_SA(0, 0), gA, oc[0]); PG8_STAGE(PG8_SA(0, 1), gA, oc[1]);
    if (wr == 1) PG8_BAR;
    PG8_WAIT_V(2); PG8_BAR;
    PG8_STAGE(PG8_SB(1, 0), cB + kstep, voffB); PG8_STAGE(PG8_SA(1, 0), gA + kstep, oc[0]); PG8_STAGE(PG8_SB(1, 1), cB + hstep + kstep, voffB);
    PG8_WAIT_V(6); PG8_BAR;
    for (;;) {
        const bool has_next = S.next(ui + 1, nxt);
        if (has_next) S.setup(nxt, Rl, Cb, on, nB);
        else { nB = cB;
#pragma unroll
            for (int h = 0; h < 2; ++h)
#pragma unroll
                for (int i = 0; i < 2; ++i) on[h][i] = oc[h][i]; }
        for (int t = 0; t < nt; t += 2) {
            const bool last = (t == nt - 2);
            const char* a1 = gA + (size_t)(t + 1) * kstep;
            const char* a2 = last ? gA : gA + (size_t)(t + 2) * kstep; const char* b2 = last ? nB : cB + (size_t)(t + 2) * kstep;
            const char* a3 = a2 + kstep; const char* b3 = b2 + kstep;
            unsigned o2[2][2];
#pragma unroll
            for (int h = 0; h < 2; ++h)
#pragma unroll
                for (int i = 0; i < 2; ++i) o2[h][i] = last ? on[h][i] : oc[h][i];
            if (last && has_next) S.a_ready(nxt);
            PG8_LDB(B0, 0, 0); PG8_LDB(B1, 0, 1); PG8_SCHED; PG8_LDA(At, 0, 0); PG8_STAGE(PG8_SA(1, 1), a1, oc[1]);
            PG8_WAIT_V(8); PG8_WAIT_L(0); PG8_BAR; PG8_MMA(0, 0, At, B0); PG8_MMA(0, 1, At, B1); PG8_BAR; PG8_SCHED;
            PG8_LDA(At, 0, 1); PG8_STAGE(PG8_SB(0, 0), b2, voffB); PG8_STAGE(PG8_SB(0, 1), b2 + hstep, voffB); PG8_STAGE(PG8_SA(0, 0), a2, o2[0]);
            PG8_WAIT_V(8); PG8_WAIT_L(0); PG8_BAR; PG8_MMA(1, 0, At, B0); PG8_MMA(1, 1, At, B1); PG8_BAR; PG8_SCHED;
            PG8_LDB(B0, 1, 0); PG8_LDB(B1, 1, 1); PG8_SCHED; PG8_LDA(At, 1, 0); PG8_STAGE(PG8_SA(0, 1), a2, o2[1]);
            PG8_WAIT_V(8); PG8_WAIT_L(0); PG8_BAR; PG8_MMA(0, 0, At, B0); PG8_MMA(0, 1, At, B1); PG8_BAR; PG8_SCHED;
            PG8_LDA(At, 1, 1); PG8_STAGE(PG8_SB(1, 0), b3, voffB); PG8_STAGE(PG8_SB(1, 1), b3 + hstep, voffB); PG8_STAGE(PG8_SA(1, 0), a3, o2[0]);
            PG8_WAIT_V(8); PG8_WAIT_L(0); PG8_BAR; PG8_MMA(1, 0, At, B0); PG8_MMA(1, 1, At, B1); PG8_BAR; PG8_SCHED;
        }
        if constexpr (ALIGN_EPI) { if (wr == 0) PG8_BAR; }
        E(acc, cur, wr, wc, fr, fq); S.done(cur);
        if (!has_next) break;
#pragma unroll
        for (int a = 0; a < 2; ++a)
#pragma unroll
            for (int b = 0; b < 2; ++b)
#pragma unroll
                for (int m = 0; m < 4; ++m)
#pragma unroll
                    for (int n = 0; n < 2; ++n) acc[a][b][m][n] = (f32x4){0.f, 0.f, 0.f, 0.f};
        cur = nxt; cB = nB; ++ui;
#pragma unroll
        for (int h = 0; h < 2; ++h)
#pragma unroll
            for (int i = 0; i < 2; ++i) oc[h][i] = on[h][i];
        if constexpr (ALIGN_EPI) { if (wr == 1) PG8_BAR; }
    }
    PG8_WAIT_V(0);
    if constexpr (!ALIGN_EPI) { if (wr == 0) PG8_BAR; }
    PG8_BAR;
#undef PG8_SA
#undef PG8_SB
#undef PG8_STAGE
#undef PG8_LDA
#undef PG8_LDB
#undef PG8_MMA
#undef PG8_WAIT_V
#undef PG8_WAIT_L
#undef PG8_BAR
#undef PG8_SCHED
}
}
#ifndef RS1
#define RS1 13
#define RS2 22
#define RS3 28
#endif
namespace ret {
constexpr int QB0 = 0, KB0 = 32768, VB0 = 65536, ST0 = 98304;
constexpr int RET_LDS_BYTES = ST0 + 2 * 8192;
__device__ __forceinline__ int toff(int row, int c16) { return row * 128 + ((c16 ^ (row & 7)) << 4); }
typedef short v4i16_t __attribute__((ext_vector_type(4)));
__device__ __forceinline__ v4i16_t trd(const LAS unsigned char* p) { return __builtin_amdgcn_ds_read_tr16_b64_v4i16((LAS v4i16_t*)p); }
__device__ __forceinline__ bf16x8 cat8(v4i16_t a, v4i16_t b) { return (bf16x8){a[0], a[1], a[2], a[3], b[0], b[1], b[2], b[3]}; }

#define RET_KEEP(x) asm volatile("" :: "v"(x))
__device__ __forceinline__ float xsum_16_32(float v) {
    { auto rr = __builtin_amdgcn_permlane16_swap(__float_as_uint(v), __float_as_uint(v), false, false); v = __uint_as_float(rr[0]) + __uint_as_float(rr[1]); }
    { auto rr = __builtin_amdgcn_permlane32_swap(__float_as_uint(v), __float_as_uint(v), false, false); v = __uint_as_float(rr[0]) + __uint_as_float(rr[1]); }
    return v;
}
__device__ __forceinline__ void ret_unit(int b, int h, int seg, const bf16* PROJ, bf16* CAT, float gC, LAS unsigned char* lds) {
    int tid_ = threadIdx.x; asm volatile("" : "+v"(tid_));
    const int tid = tid_, lane = tid & 63, w = __builtin_amdgcn_readfirstlane(tid >> 6), g = lane >> 4, c15 = lane & 15;
    const int blk = w < 4 ? w : 11 - w;
    const bf16* base = PROJ + (size_t)b * SEQ * INW;
    const int nfirst = seg == 0 ? 0 : seg == 1 ? RS1 : seg == 2 ? RS2 : RS3, nend = seg == 0 ? RS1 : seg == 1 ? RS2 : seg == 2 ? RS3 : 32;
    const int dr = lane >> 3, dc = (lane & 7) ^ dr;
#define RET_DMA(tileoff, colbase, m) do { _Pragma("unroll") for (int _p = 0; _p < 2; ++_p) { const int pc = w + 8 * _p; \
        __builtin_amdgcn_global_load_lds((const unsigned*)(base + (size_t)((m) * 128 + 8 * pc + dr) * INW + (colbase) + h * 64 + dc * 8), (LAS unsigned*)(lds + (tileoff) + pc * 1024), 16, 0, 0); } } while (0)
    f32x4 sacc[2]; sacc[0] = (f32x4){0.f, 0.f, 0.f, 0.f}; sacc[1] = (f32x4){0.f, 0.f, 0.f, 0.f};
    const int et_s = w >> 1, dt0 = 2 * (w & 1);
    if (nfirst > 0) {
        bf16x8 kprev = (bf16x8){0, 0, 0, 0, 0, 0, 0, 0}, vprev2 = kprev;
        RET_DMA(0, C_RK, 0); RET_DMA(16384, C_RV, 0);
        if (nfirst > 1) { RET_DMA(32768, C_RK, 1); RET_DMA(32768 + 16384, C_RV, 1); }
#pragma unroll 1
        for (int m = 0; m < nfirst; ++m) {
            if (m + 1 < nfirst) asm volatile("s_waitcnt vmcnt(4) lgkmcnt(0)" ::: "memory"); else asm volatile("s_waitcnt vmcnt(0) lgkmcnt(0)" ::: "memory");
            __builtin_amdgcn_s_barrier(); asm volatile("" ::: "memory");
            if (m + 2 < nfirst) { const int s2 = ((m + 2) % 3) * 32768; RET_DMA(s2, C_RK, m + 2); RET_DMA(s2 + 16384, C_RV, m + 2); }
            const LAS unsigned char* Kt = lds + (m % 3) * 32768; const LAS unsigned char* Vt = Kt + 16384;
            sacc[0] = sacc[0] * gC; sacc[1] = sacc[1] * gC;
#pragma unroll
            for (int ks = 0; ks < 4; ++ks) {
                const int q = c15 >> 2, p = c15 & 3, r0 = 32 * ks + 8 * g + q;
                const bf16x8 vf = cat8(trd(Vt + toff(r0, 2 * et_s + (p >> 1)) + (p & 1) * 8), trd(Vt + toff(r0 + 4, 2 * et_s + (p >> 1)) + (p & 1) * 8));
#pragma unroll
                for (int dd = 0; dd < 2; ++dd) { const int c16 = 2 * (dt0 + dd) + (p >> 1);
                    const bf16x8 kf = cat8(trd(Kt + toff(r0, c16) + (p & 1) * 8), trd(Kt + toff(r0 + 4, c16) + (p & 1) * 8));
                    sacc[dd] = __builtin_amdgcn_mfma_f32_16x16x32_bf16(vf, kf, sacc[dd], 0, 0, 0); RET_KEEP(kprev); kprev = kf; }
                RET_KEEP(vprev2); vprev2 = vf;
            }
        }
        RET_KEEP(kprev); RET_KEEP(vprev2);
        asm volatile("s_waitcnt lgkmcnt(0)" ::: "memory"); __builtin_amdgcn_s_barrier(); asm volatile("" ::: "memory");
    }
    { LAS unsigned char* STi = lds + ST0 + (nfirst & 1) * 8192;
#pragma unroll
      for (int dd = 0; dd < 2; ++dd)
#pragma unroll
          for (int rr = 0; rr < 4; ++rr) { const int e = 16 * et_s + 4 * g + rr, d = 16 * (dt0 + dd) + c15;
              *(LAS unsigned short*)(STi + toff(e, d >> 3) + (d & 7) * 2) = (unsigned short)f2bf(sacc[dd][rr]); } }
    RET_DMA(KB0 + (nfirst & 1) * 16384, C_RK, nfirst); RET_DMA(VB0 + (nfirst & 1) * 16384, C_RV, nfirst); RET_DMA(QB0 + (nfirst & 1) * 16384, C_RQ, nfirst);
    __syncthreads();
#define RET_STATE_UPDATE() do { if (m + 1 < nend) { bf16x8 kfp = (bf16x8){0, 0, 0, 0, 0, 0, 0, 0}, vfp = kfp; sacc[0] = sacc[0] * gC; sacc[1] = sacc[1] * gC; _Pragma("unroll") for (int ks = 0; ks < 4; ++ks) { const int q = c15 >> 2, p = c15 & 3, r0 = 32 * ks + 8 * g + q; const bf16x8 vf = cat8(trd(Vt + toff(r0, 2 * et_s + (p >> 1)) + (p & 1) * 8), trd(Vt + toff(r0 + 4, 2 * et_s + (p >> 1)) + (p & 1) * 8)); _Pragma("unroll") for (int dd = 0; dd < 2; ++dd) { const int c16 = 2 * (dt0 + dd) + (p >> 1); const bf16x8 kf = cat8(trd(Kt + toff(r0, c16) + (p & 1) * 8), trd(Kt + toff(r0 + 4, c16) + (p & 1) * 8)); sacc[dd] = __builtin_amdgcn_mfma_f32_16x16x32_bf16(vf, kf, sacc[dd], 0, 0, 0); if (dd == 1) { RET_KEEP(kfp); } kfp = kf; } RET_KEEP(vfp); vfp = vf; } _Pragma("unroll") for (int dd = 0; dd < 2; ++dd) _Pragma("unroll") for (int r = 0; r < 4; ++r) { const int e = 16 * et_s + 4 * g + r, d = 16 * (dt0 + dd) + c15; *(LAS unsigned short*)(STn + toff(e, d >> 3) + (d & 7) * 2) = (unsigned short)f2bf(sacc[dd][r]); } RET_KEEP(kfp); RET_KEEP(vfp); } } while (0)
#pragma unroll 1
    for (int m = nfirst; m < nend; ++m) {
        const int cur = m & 1, nx = cur ^ 1; const bool full = true;
        if (m + 1 < nend) { RET_DMA(KB0 + nx * 16384, C_RK, m + 1); RET_DMA(VB0 + nx * 16384, C_RV, m + 1); RET_DMA(QB0 + nx * 16384, C_RQ, m + 1); }
        const LAS unsigned char* Qt = lds + QB0 + cur * 16384; const LAS unsigned char* Kt = lds + KB0 + cur * 16384; const LAS unsigned char* Vt = lds + VB0 + cur * 16384;
        const LAS unsigned char* STc = lds + ST0 + cur * 8192; LAS unsigned char* STn = lds + ST0 + nx * 8192;
        if (full) {
            const size_t row = (size_t)b * SEQ + m * 128 + 16 * blk + c15;
            u32x2 gg[4];
#pragma unroll
            for (int et = 0; et < 4; ++et) gg[et] = *(const GAS u32x2*)(PROJ + row * INW + C_RG + h * 64 + 16 * et + 4 * g);
            bf16x8 qf[2];
#pragma unroll
            for (int ks = 0; ks < 2; ++ks) qf[ks] = *(const LAS bf16x8*)(Qt + toff(16 * blk + c15, 4 * ks + g));
            bf16x8 pf[4];
#pragma unroll
            for (int ks = 0; ks < 4; ++ks) {
                f32x4 s0 = (f32x4){0.f, 0.f, 0.f, 0.f}, s1 = (f32x4){0.f, 0.f, 0.f, 0.f};
                bf16x8 ka[2], kb[2]; ka[0] = ka[1] = kb[0] = kb[1] = (bf16x8){0, 0, 0, 0, 0, 0, 0, 0};
                if (2 * ks <= blk) {
#pragma unroll
                    for (int kk = 0; kk < 2; ++kk) { ka[kk] = *(const LAS bf16x8*)(Kt + toff(32 * ks + c15, 4 * kk + g)); s0 = __builtin_amdgcn_mfma_f32_16x16x32_bf16(ka[kk], qf[kk], s0, 0, 0, 0); }
                    if (2 * ks == blk) {
#pragma unroll
                        for (int r = 0; r < 4; ++r) if (4 * g + r > c15) s0[r] = 0.f; }
                }
                if (2 * ks + 1 <= blk) {
#pragma unroll
                    for (int kk = 0; kk < 2; ++kk) { kb[kk] = *(const LAS bf16x8*)(Kt + toff(32 * ks + 16 + c15, 4 * kk + g)); s1 = __builtin_amdgcn_mfma_f32_16x16x32_bf16(kb[kk], qf[kk], s1, 0, 0, 0); }
                    if (2 * ks + 1 == blk) {
#pragma unroll
                        for (int r = 0; r < 4; ++r) if (4 * g + r > c15) s1[r] = 0.f; }
                }
                u32x4 pk; pk.x = pk2(s0[0], s0[1]); pk.y = pk2(s0[2], s0[3]); pk.z = pk2(s1[0], s1[1]); pk.w = pk2(s1[2], s1[3]);
                pf[ks] = __builtin_bit_cast(bf16x8, pk);
                RET_KEEP(ka[0]); RET_KEEP(ka[1]); RET_KEEP(kb[0]); RET_KEEP(kb[1]);
            }
            f32x4 o[4];
            bf16x8 vprev[4]; vprev[0] = vprev[1] = vprev[2] = vprev[3] = (bf16x8){0, 0, 0, 0, 0, 0, 0, 0};
#pragma unroll
            for (int et = 0; et < 4; ++et) {
                f32x4 a = (f32x4){0.f, 0.f, 0.f, 0.f};
                bf16x8 sf[2], vcur[4]; vcur[0] = vcur[1] = vcur[2] = vcur[3] = (bf16x8){0, 0, 0, 0, 0, 0, 0, 0};
#pragma unroll
                for (int kk = 0; kk < 2; ++kk) { sf[kk] = *(const LAS bf16x8*)(STc + toff(16 * et + c15, 4 * kk + g)); a = __builtin_amdgcn_mfma_f32_16x16x32_bf16(sf[kk], qf[kk], a, 0, 0, 0); }
                a = a * gC;
#pragma unroll
                for (int ks = 0; ks < 4; ++ks) if (2 * ks <= blk) {
                    const int q = c15 >> 2, p = c15 & 3, r0 = 32 * ks + 4 * g + q, c16 = 2 * et + (p >> 1);
                    const v4i16_t v0 = trd(Vt + toff(r0, c16) + (p & 1) * 8), v1 = trd(Vt + toff(r0 + 16, c16) + (p & 1) * 8);
                    vcur[ks] = cat8(v0, v1);
                    a = __builtin_amdgcn_mfma_f32_16x16x32_bf16(vcur[ks], pf[ks], a, 0, 0, 0);
                }
                o[et] = a;
                RET_KEEP(sf[0]); RET_KEEP(sf[1]);
#pragma unroll
                for (int ks = 0; ks < 4; ++ks) { RET_KEEP(vprev[ks]); vprev[ks] = vcur[ks]; }
            }
            RET_STATE_UPDATE();
#pragma unroll
            for (int ks = 0; ks < 4; ++ks) { RET_KEEP(vprev[ks]); RET_KEEP(pf[ks]); }
            RET_KEEP(qf[0]); RET_KEEP(qf[1]);
            float s = 0.f;
#pragma unroll
            for (int et = 0; et < 4; ++et) s += (o[et][0] + o[et][1]) + (o[et][2] + o[et][3]);
            s = xsum_16_32(s);
            const float mean = s * (1.f / 64.f); float q2 = 0.f;
#pragma unroll
            for (int et = 0; et < 4; ++et) { o[et] = o[et] - mean; q2 += (o[et][0] * o[et][0] + o[et][1] * o[et][1]) + (o[et][2] * o[et][2] + o[et][3] * o[et][3]); }
            q2 = xsum_16_32(q2);
            const float rstd = 1.f / sqrtf(q2 * (1.f / 64.f) + LN_EPS);
#pragma unroll
            for (int et = 0; et < 4; ++et) {
                const float g0 = __uint_as_float(gg[et].x << 16), g1 = __uint_as_float(gg[et].x & 0xffff0000u), g2 = __uint_as_float(gg[et].y << 16), g3 = __uint_as_float(gg[et].y & 0xffff0000u);
                u32x2 wv; wv.x = pk2(o[et][0] * rstd * g0, o[et][1] * rstd * g1); wv.y = pk2(o[et][2] * rstd * g2, o[et][3] * rstd * g3);
                *(GAS u32x2*)(CAT + row * DM + h * 64 + 16 * et + 4 * g) = wv; asm volatile("s_nop 1" :: "v"(wv.x), "v"(wv.y) : "memory"); }
        }
        else { RET_STATE_UPDATE(); }
        __syncthreads();
    }
#undef RET_DMA
#undef RET_STATE_UPDATE
#undef RET_KEEP
}
}
constexpr int MK_TAB_OFF = 131072 + 512, MK_TOKS_OFF = 131072 + 4096, MK_CW_MOEC = 70000;
namespace pg8 {
struct MUnit : Unit { int kind; };
template <int MODE>
struct MoeMk {
    static constexpr int G = 256;
    int nMt, n1, c, l; unsigned need; const LAS unsigned char* ldsb; const bf16* Wgu; const bf16* Wd; gu32* ctl;
    __device__ __forceinline__ const LAS int* tab() const { return (const LAS int*)(ldsb + MK_TAB_OFF); }
    __device__ __forceinline__ const LAS int* toks() const { return (const LAS int*)(ldsb + MK_TOKS_OFF); }
    __device__ __forceinline__ unsigned* ready() const { return (unsigned*)(ctl + MK_CW_MOEC + l * 288 * 64); }
    __device__ __forceinline__ bool next(int i, MUnit& u) const {
        long L = (long)i * G + c; int kind = MODE;
        if (MODE == 2) {
            const int q = n1 / G, rem = n1 % G, q1 = q + (c < rem ? 1 : 0);
            if (i < q1) kind = 0;
            else { kind = 1; const int j = i - q1, light = G - rem, F = (n1 - light) / G, part = (n1 - light) % G; long k;
                if (rem == 0) k = (long)j * G + c;
                else if (c >= rem) { if (j == 0) k = c - rem; else if (j <= F) k = light + (long)(j - 1) * G + c; else if (j == F + 1 && (c - rem) < part) k = light + (long)F * G + (c - rem); else return false; }
                else { if (j < F) k = light + (long)j * G + c; else return false; }
                if (k >= n1) return false; L = k; }
        } else if (L >= n1) return false;
        const int nN = 4, nwg = n1; int wgid = (int)L; { const int q = nwg / NXCD, r = nwg % NXCD, xcd = wgid % NXCD, off = wgid / NXCD; wgid = (xcd < r ? xcd * (q + 1) : r * (q + 1) + (xcd - r) * q) + off; }
        const int nig = WGM * nN, gid = wgid / nig, fm = gid * WGM, gsz = (nMt - fm) < WGM ? (nMt - fm) : WGM;
        u.pm = fm + ((wgid % nig) % gsz); u.pn = (wgid % nig) / gsz; u.kind = kind; return true;
    }
    __device__ __forceinline__ int kdim(const MUnit& u) const { return u.kind ? DE : DM; }
    __device__ __forceinline__ void setup(const MUnit& u, const int (&Rl)[2], const int (&Cb)[2], unsigned (&off)[2][2], const char*& bptr, int ui) const {
        const int e = tab()[1 + u.pm] & 255;
        if (u.kind == 0) {
#pragma unroll
            for (int h = 0; h < 2; ++h)
#pragma unroll
                for (int i = 0; i < 2; ++i) off[h][i] = (unsigned)WS_S1 + (unsigned)(toks()[ui * 256 + h * 128 + Rl[i]] * DM * 2 + Cb[i]);
            bptr = (const char*)Wgu + (size_t)(e * 4 + u.pn) * 256 * DM * 2;
        } else {
#pragma unroll
            for (int h = 0; h < 2; ++h)
#pragma unroll
                for (int i = 0; i < 2; ++i) off[h][i] = (unsigned)WS_HE + (unsigned)((u.pm * 256 + h * 128 + Rl[i]) * DE * 2 + Cb[i]);
            bptr = (const char*)Wd + (size_t)(e * 4 + u.pn) * 256 * DE * 2;
        }
    }
    __device__ __forceinline__ void a_ready(const MUnit& u) const {
        if (MODE != 2 || u.kind == 0) return;
        if (threadIdx.x < 64) {
            unsigned* rd = ready() + 64 * u.pm; unsigned* tmo = (unsigned*)ctl;
            const unsigned long long t0 = __builtin_amdgcn_s_memrealtime(); unsigned polls = 0;
            while ((unsigned)__builtin_amdgcn_readfirstlane(__hip_atomic_load(rd, __ATOMIC_RELAXED, __HIP_MEMORY_SCOPE_AGENT)) < need) {
                if ((++polls & 255u) == 0u && __builtin_amdgcn_readfirstlane(__hip_atomic_load(tmo, __ATOMIC_RELAXED, __HIP_MEMORY_SCOPE_AGENT)) != 0u) break;
                if (__builtin_amdgcn_s_memrealtime() - t0 > 2000000ull) { if (threadIdx.x == 0) __hip_atomic_store(tmo, 1u, __ATOMIC_RELAXED, __HIP_MEMORY_SCOPE_AGENT); break; }
                __builtin_amdgcn_s_sleep(2); }
#if defined(MOE_ACQ) && MOE_ACQ
            __builtin_amdgcn_fence(__ATOMIC_ACQUIRE, "agent");
#endif
            asm volatile("s_waitcnt vmcnt(0)" ::: "memory");
        }
        asm volatile("" ::: "memory"); __builtin_amdgcn_s_barrier(); asm volatile("" ::: "memory");
    }
    __device__ __forceinline__ void done(const MUnit& u) const {
        if (MODE != 2 || u.kind != 0) return;
        asm volatile("s_waitcnt vmcnt(0)" ::: "memory");
        if ((threadIdx.x & 63) == 0) __hip_atomic_fetch_add(ready() + 64 * u.pm, 1u, __ATOMIC_RELAXED, __HIP_MEMORY_SCOPE_AGENT);
    }
};
struct EpiGateUpWT {
    static constexpr bool PERM = true;
    bf16* HE;
    __device__ __forceinline__ void operator()(const f32x4 (&acc)[2][2][4][2], const Unit& u, int wr, int wc, int fr, int fq) const {
        const __amdgpu_buffer_rsrc_t rs = __builtin_amdgcn_make_buffer_rsrc((void*)HE, 0, PAIR_ROWS * DE * 2, 0x00020000);
        EPI_T_LANES(); const int row0 = u.pm * BM + wr * 64 + fr2, col0 = u.pn * 128 + wc * 32 + 8 * fq2;
#pragma unroll
        for (int ai = 0; ai < 2; ++ai)
#pragma unroll
            for (int m = 0; m < 4; ++m) { const f32x4 g0 = acc[ai][0][m][0], g1 = acc[ai][0][m][1], u0 = acc[ai][1][m][0], u1 = acc[ai][1][m][1];
                u32x4 w; w.x = cvt_pk_bf16(fsilu(g0[0]) * u0[0], fsilu(g0[1]) * u0[1]); w.y = cvt_pk_bf16(fsilu(g0[2]) * u0[2], fsilu(g0[3]) * u0[3]);
                w.z = cvt_pk_bf16(fsilu(g1[0]) * u1[0], fsilu(g1[1]) * u1[1]); w.w = cvt_pk_bf16(fsilu(g1[2]) * u1[2], fsilu(g1[3]) * u1[3]);
                __builtin_amdgcn_raw_buffer_store_b128(tr4(w, src4), rs, (int)(((size_t)(row0 + ai * HALF + m * 16) * DE + col0) * 2), 0, 16); }
    }
};

template <class Sched, class Epi0, class Epi1>
__device__ __forceinline__ void gemm_phase_mk(LAS unsigned char* lds, const char* gA, const Sched& S, const Epi0& E0, const Epi1& E1) {
    int tid_ = threadIdx.x; asm volatile("" : "+v"(tid_));
    const int tid = tid_, wid = __builtin_amdgcn_readfirstlane(tid >> 6), lane = tid & 63, wr = wid >> 2, wc = wid & 3, fr = lane & 15, fq = lane >> 4;
    int Rl[2], Cb[2], Rbp[2];
#pragma unroll
    for (int i = 0; i < 2; ++i) { int R, C; stage_rc(tid * 16 + i * 8192, R, C); Rbp[i] = (R & ~31) + perm32(R & 31); Rl[i] = R; Cb[i] = C * 2; }
    const size_t kstep = (size_t)(BK * 2);
    const unsigned ldsw = (unsigned)wid * 1024u;
    const int aoff = lds_byte(wr * 64 + fr, fq * 8), boff = lds_byte(wc * 32 + fr, fq * 8);
#define PG8_SA(b, h) (((b) * 2 + (h)) * HTB)
#define PG8_SB(b, h) ((4 + (b) * 2 + (h)) * HTB)
#define PG8_STAGE(bufoff, gbase, voff) do { _Pragma("unroll") for (int _i = 0; _i < 2; ++_i) \
        __builtin_amdgcn_global_load_lds((const unsigned*)((const char*)(gbase) + (voff)[_i]), (LAS unsigned*)(lds + (bufoff) + ldsw + _i * 8192), 16, 0, 0); } while (0)
#define PG8_LDA(dst, b, h) do { _Pragma("unroll") for (int m = 0; m < 4; ++m) _Pragma("unroll") for (int k = 0; k < 2; ++k) dst[m][k] = *(const LAS bf16x8*)(lds + PG8_SA(b, h) + aoff + m * 2048 + k * 1024); } while (0)
#define PG8_LDB(dst, b, h) do { _Pragma("unroll") for (int n = 0; n < 2; ++n) _Pragma("unroll") for (int k = 0; k < 2; ++k) dst[n][k] = *(const LAS bf16x8*)(lds + PG8_SB(b, h) + boff + n * 2048 + k * 1024); } while (0)
#define PG8_MMA(ai, bj, At, Bt) do { __builtin_amdgcn_s_setprio(1); _Pragma("unroll") for (int m = 0; m < 4; ++m) _Pragma("unroll") for (int n = 0; n < 2; ++n) _Pragma("unroll") for (int k = 0; k < 2; ++k) \
        acc[ai][bj][m][n] = __builtin_amdgcn_mfma_f32_16x16x32_bf16(Bt[n][k], At[m][k], acc[ai][bj][m][n], 0, 0, 0); __builtin_amdgcn_s_setprio(0); } while (0)
#define PG8_WAIT_V(n) asm volatile("s_waitcnt vmcnt(" #n ")" ::: "memory")
#define PG8_WAIT_L(n) asm volatile("s_waitcnt lgkmcnt(" #n ")" ::: "memory")
#define PG8_BAR __builtin_amdgcn_s_barrier()
#define PG8_SCHED __builtin_amdgcn_sched_barrier(0)
    MUnit cur, nxt; int ui = 0;
    if (!S.next(0, cur)) return;
    f32x4 acc[2][2][4][2];
#pragma unroll
    for (int a = 0; a < 2; ++a)
#pragma unroll
        for (int b = 0; b < 2; ++b)
#pragma unroll
            for (int m = 0; m < 4; ++m)
#pragma unroll
                for (int n = 0; n < 2; ++n) acc[a][b][m][n] = (f32x4){0.f, 0.f, 0.f, 0.f};
    bf16x8 At[4][2], B0[2][2], B1[2][2];
    unsigned oc[2][2], on[2][2], vBc[2], vBn[2]; const char* cB; const char* nB; size_t hsc, hsn; int ntc, ntn;
    { const int Kc = S.kdim(cur); ntc = Kc / BK; hsc = (size_t)HALF * Kc * 2;
#pragma unroll
      for (int i = 0; i < 2; ++i) vBc[i] = (unsigned)(Rbp[i] * Kc * 2 + Cb[i]); }
    S.setup(cur, Rl, Cb, oc, cB, 0);
    S.a_ready(cur);
    PG8_STAGE(PG8_SB(0, 0), cB, vBc); PG8_STAGE(PG8_SB(0, 1), cB + hsc, vBc); PG8_STAGE(PG8_SA(0, 0), gA, oc[0]); PG8_STAGE(PG8_SA(0, 1), gA, oc[1]);
    if (wr == 1) PG8_BAR;
    PG8_WAIT_V(2); PG8_BAR;
    PG8_STAGE(PG8_SB(1, 0), cB + kstep, vBc); PG8_STAGE(PG8_SA(1, 0), gA + kstep, oc[0]); PG8_STAGE(PG8_SB(1, 1), cB + hsc + kstep, vBc);
    PG8_WAIT_V(6); PG8_BAR;
    for (;;) {
        const bool has_next = S.next(ui + 1, nxt);
        if (has_next) { S.setup(nxt, Rl, Cb, on, nB, ui + 1); const int Kn = S.kdim(nxt); ntn = Kn / BK; hsn = (size_t)HALF * Kn * 2;
#pragma unroll
            for (int i = 0; i < 2; ++i) vBn[i] = (unsigned)(Rbp[i] * Kn * 2 + Cb[i]); }
        else { nB = cB; hsn = hsc; ntn = ntc;
#pragma unroll
            for (int i = 0; i < 2; ++i) vBn[i] = vBc[i];
#pragma unroll
            for (int h = 0; h < 2; ++h)
#pragma unroll
                for (int i = 0; i < 2; ++i) on[h][i] = oc[h][i]; }
        for (int t = 0; t < ntc; t += 2) {
            const bool last = (t == ntc - 2);
            const char* a1 = gA + (size_t)(t + 1) * kstep;
            const char* a2 = last ? gA : gA + (size_t)(t + 2) * kstep; const char* b2 = last ? nB : cB + (size_t)(t + 2) * kstep;
            const char* a3 = a2 + kstep; const char* b3 = b2 + kstep;
            unsigned o2[2][2], v2[2]; const size_t hs2 = last ? hsn : hsc;
#pragma unroll
            for (int i = 0; i < 2; ++i) v2[i] = last ? vBn[i] : vBc[i];
#pragma unroll
            for (int h = 0; h < 2; ++h)
#pragma unroll
                for (int i = 0; i < 2; ++i) o2[h][i] = last ? on[h][i] : oc[h][i];
            if (last && has_next) S.a_ready(nxt);
            PG8_LDB(B0, 0, 0); PG8_LDB(B1, 0, 1); PG8_SCHED; PG8_LDA(At, 0, 0); PG8_STAGE(PG8_SA(1, 1), a1, oc[1]);
            PG8_WAIT_V(8); PG8_WAIT_L(0); PG8_BAR; PG8_MMA(0, 0, At, B0); PG8_MMA(0, 1, At, B1); PG8_BAR; PG8_SCHED;
            PG8_LDA(At, 0, 1); PG8_STAGE(PG8_SB(0, 0), b2, v2); PG8_STAGE(PG8_SB(0, 1), b2 + hs2, v2); PG8_STAGE(PG8_SA(0, 0), a2, o2[0]);
            PG8_WAIT_V(8); PG8_WAIT_L(0); PG8_BAR; PG8_MMA(1, 0, At, B0); PG8_MMA(1, 1, At, B1); PG8_BAR; PG8_SCHED;
            PG8_LDB(B0, 1, 0); PG8_LDB(B1, 1, 1); PG8_SCHED; PG8_LDA(At, 1, 0); PG8_STAGE(PG8_SA(0, 1), a2, o2[1]);
            PG8_WAIT_V(8); PG8_WAIT_L(0); PG8_BAR; PG8_MMA(0, 0, At, B0); PG8_MMA(0, 1, At, B1); PG8_BAR; PG8_SCHED;
            PG8_LDA(At, 1, 1); PG8_STAGE(PG8_SB(1, 0), b3, v2); PG8_STAGE(PG8_SB(1, 1), b3 + hs2, v2); PG8_STAGE(PG8_SA(1, 0), a3, o2[0]);
            PG8_WAIT_V(8); PG8_WAIT_L(0); PG8_BAR; PG8_MMA(1, 0, At, B0); PG8_MMA(1, 1, At, B1); PG8_BAR; PG8_SCHED;
        }
        if (wr == 0) PG8_BAR;
        if (cur.kind == 0) E0(acc, cur, wr, wc, fr, fq); else E1(acc, cur, wr, wc, fr, fq);
        S.done(cur);
        if (!has_next) break;
#pragma unroll
        for (int a = 0; a < 2; ++a)
#pragma unroll
            for (int b = 0; b < 2; ++b)
#pragma unroll
                for (int m = 0; m < 4; ++m)
#pragma unroll
                    for (int n = 0; n < 2; ++n) acc[a][b][m][n] = (f32x4){0.f, 0.f, 0.f, 0.f};
        cur = nxt; cB = nB; hsc = hsn; ntc = ntn; ++ui;
#pragma unroll
        for (int i = 0; i < 2; ++i) vBc[i] = vBn[i];
#pragma unroll
        for (int h = 0; h < 2; ++h)
#pragma unroll
            for (int i = 0; i < 2; ++i) oc[h][i] = on[h][i];
        if (wr == 1) PG8_BAR;
    }
    PG8_WAIT_V(0);
    PG8_BAR;
#undef PG8_SA
#undef PG8_SB
#undef PG8_STAGE
#undef PG8_LDA
#undef PG8_LDB
#undef PG8_MMA
#undef PG8_WAIT_V
#undef PG8_WAIT_L
#undef PG8_BAR
#undef PG8_SCHED
}
}
namespace attn_body {
using bf16=__hip_bfloat16;
using bf16x8=__attribute__((ext_vector_type(8)))short;
using s16x4=__attribute__((ext_vector_type(4)))short;
using f32x16=__attribute__((ext_vector_type(16)))float;
using u32x4=__attribute__((ext_vector_type(4)))unsigned;
constexpr int SEQ=4096,D=64,PQ=3584,PO=1024;
constexpr int NW=8,QBLK=32,QB=QBLK*NW,KVBLK=64,NQB=SEQ/QB;
constexpr int ATTN_UNIT_ROWS=QB;
__device__ __forceinline__ int crow(int r,int hi){return (r&3)+8*(r>>2)+4*hi;}
#define SBAR() __builtin_amdgcn_sched_barrier(0)
__device__ __forceinline__ void cmask(f32x16&p0,f32x16&p1,int jb,int qrel,int hi){
  const float NEG=-INFINITY; int kb=64*jb+4*hi;
  #pragma unroll
  for(int r=0;r<16;++r){int kv=kb+(r&3)+8*(r>>2); if(kv>qrel)p0[r]=NEG; if(kv+32>qrel)p1[r]=NEG;}
}

constexpr int NSLOT=3, SLOTB=8192;
constexpr int LDS_K=0, LDS_V=NSLOT*SLOTB, LDS_WS=2*NSLOT*SLOTB, LDS_OST=LDS_WS+NW*64*4, LDS_BYTES=LDS_OST+NW*4096;
constexpr float C2=0.125f*1.4426950408889634f;
__device__ __forceinline__ void glds16(const void*gsrc,unsigned lds_dst){unsigned keep;
  asm volatile("s_mov_b32 %0, m0\n\ts_mov_b32 m0, %2\n\ts_nop 0\n\tglobal_load_lds_dwordx4 %1, off\n\ts_mov_b32 m0, %0":"=&s"(keep):"v"(gsrc),"s"(lds_dst):"memory");}
__device__ __forceinline__ float max3f(float a,float b,float c){float r;asm("v_max3_f32 %0, %1, %2, %3":"=v"(r):"v"(a),"v"(b),"v"(c));return r;}
__device__ __forceinline__ float max2f(float a,float b){float r;asm("v_max_f32_e32 %0, %1, %2":"=v"(r):"v"(a),"v"(b));return r;}
__device__ __forceinline__ float fadd_s(float a,float b){float r;asm("v_add_f32_e32 %0, %1, %2":"=v"(r):"v"(a),"v"(b));return r;}
__device__ __forceinline__ float fsub_s(float a,float b){float r;asm("v_sub_f32_e32 %0, %1, %2":"=v"(r):"v"(a),"v"(b));return r;}
typedef float f32x2_t __attribute__((ext_vector_type(2))); typedef __bf16 bf16x2_t __attribute__((ext_vector_type(2)));
__device__ __forceinline__ unsigned cvtpk_s(float lo,float hi){f32x2_t v={lo,hi};bf16x2_t b=__builtin_convertvector(v,bf16x2_t);return __builtin_bit_cast(unsigned,b);}
#define WAIT_BAR(N) asm volatile("s_waitcnt vmcnt(" #N ") lgkmcnt(0)\n\ts_barrier":::"memory")

__device__ __forceinline__ void qkt(f32x16&p0,f32x16&p1,const char*Kslot,const bf16x8*qr,const f32x16&negm,int r32,int hi){
  const char*kb=Kslot+hi*1024+r32*16;
  #pragma unroll
  for(int d0=0;d0<4;++d0){
    const bf16x8 b0=*reinterpret_cast<const bf16x8*>(kb+d0*2048);
    const bf16x8 b1=*reinterpret_cast<const bf16x8*>(kb+d0*2048+512);
    if(d0==0){p0=__builtin_amdgcn_mfma_f32_32x32x16_bf16(b0,qr[0],negm,0,0,0);p1=__builtin_amdgcn_mfma_f32_32x32x16_bf16(b1,qr[0],negm,0,0,0);}
    else{p0=__builtin_amdgcn_mfma_f32_32x32x16_bf16(b0,qr[d0],p0,0,0,0);p1=__builtin_amdgcn_mfma_f32_32x32x16_bf16(b1,qr[d0],p1,0,0,0);}}
}
typedef __attribute__((address_space(3))) const char* lds_cptr;
typedef short v4i16_t __attribute__((ext_vector_type(4)));
__device__ __forceinline__ void kload8(bf16x8*kf,lds_cptr kp){
  kf[0]=*(const __attribute__((address_space(3))) bf16x8*)(kp);      kf[1]=*(const __attribute__((address_space(3))) bf16x8*)(kp+512);
  kf[2]=*(const __attribute__((address_space(3))) bf16x8*)(kp+2048); kf[3]=*(const __attribute__((address_space(3))) bf16x8*)(kp+2560);
  kf[4]=*(const __attribute__((address_space(3))) bf16x8*)(kp+4096); kf[5]=*(const __attribute__((address_space(3))) bf16x8*)(kp+4608);
  kf[6]=*(const __attribute__((address_space(3))) bf16x8*)(kp+6144); kf[7]=*(const __attribute__((address_space(3))) bf16x8*)(kp+6656);
}
__device__ __forceinline__ void kload2(bf16x8*kf,lds_cptr kp,int j){ kf[2*j]=*(const __attribute__((address_space(3))) bf16x8*)(kp+j*2048); kf[2*j+1]=*(const __attribute__((address_space(3))) bf16x8*)(kp+j*2048+512); }
__device__ __forceinline__ s16x4 vtr(lds_cptr p){ return __builtin_bit_cast(s16x4,__builtin_amdgcn_ds_read_tr16_b64_v4i16((__attribute__((address_space(3))) v4i16_t*)p)); }
__device__ __forceinline__ float rowmax(const f32x16&p0,const f32x16&p1){
  float a=max3f(p0[0],p0[1],p1[0]),b=max3f(p0[2],p0[3],p1[1]);a=max3f(a,p1[2],p1[3]);
  #pragma unroll
  for(int r=4;r<16;r+=4){a=max3f(a,p0[r],p0[r+1]);b=max3f(b,p0[r+2],p0[r+3]);a=max3f(a,p1[r],p1[r+1]);b=max3f(b,p1[r+2],p1[r+3]);}
  const float m=max2f(a,b);
  auto rr=__builtin_amdgcn_permlane32_swap(__float_as_uint(m),__float_as_uint(m),false,false);
  return max2f(__uint_as_float(rr[0]),__uint_as_float(rr[1]));
}
__device__ __forceinline__ void pv(f32x16*o,int vb,bf16x8 pa0,bf16x8 pa1,bf16x8 pa2,bf16x8 pa3){
  #pragma unroll
  for(int d0=0;d0<2;++d0){s16x4 lo[4],hi[4];
    #pragma unroll
    for(int ks=0;ks<4;++ks){
      asm volatile("ds_read_b64_tr_b16 %0,%1 offset:%c2":"=&v"(lo[ks]):"v"(vb),"i"(d0*4096+ks*1024):"memory");
      asm volatile("ds_read_b64_tr_b16 %0,%1 offset:%c2":"=&v"(hi[ks]):"v"(vb),"i"(d0*4096+ks*1024+512):"memory");}
    asm volatile("s_waitcnt lgkmcnt(0)":::"memory");SBAR();
    #define PK(k) (bf16x8){lo[k][0],lo[k][1],lo[k][2],lo[k][3],hi[k][0],hi[k][1],hi[k][2],hi[k][3]}
    o[d0]=__builtin_amdgcn_mfma_f32_32x32x16_bf16(pa0,PK(0),o[d0],0,0,0);
    o[d0]=__builtin_amdgcn_mfma_f32_32x32x16_bf16(pa1,PK(1),o[d0],0,0,0);
    o[d0]=__builtin_amdgcn_mfma_f32_32x32x16_bf16(pa2,PK(2),o[d0],0,0,0);
    o[d0]=__builtin_amdgcn_mfma_f32_32x32x16_bf16(pa3,PK(3),o[d0],0,0,0);
    #undef PK
  }
}

#ifndef ATTN_STORE16
#define ATTN_STORE16(p,v) (*(u32x4*)(p)=(v))
#endif
template<int THRL> __device__ __forceinline__ void attn_unit(int qb,const bf16*Qh,const bf16*__restrict__ Kh,const bf16*__restrict__ Vh,bf16*Oh,char*shm){
  int tid_=threadIdx.x; asm volatile("":"+v"(tid_));
  const int tid=tid_,lane=tid&63,r32=lane&31,hi=lane>>5; const int wid=__builtin_amdgcn_readfirstlane(tid>>6);
  const int q0=qb*QB;
  const bf16*Qw=Qh+(long)(q0+wid*QBLK)*PQ;
  const unsigned lds0=(unsigned)(uintptr_t)shm;
  float*wsf=(float*)(shm+LDS_WS)+wid*64;
  const bf16*ksrc=Kh+(long)lane*PQ+wid*8;
  const bf16*vsrc=Vh+(long)(16*(wid&3)+(lane>>2))*PQ+(wid>>2)*32+(lane&3)*8;
  const unsigned kdst=lds0+LDS_K+wid*1024, vdst=lds0+LDS_V+wid*1024;
  #define DMA_K(t,slot) glds16(ksrc+(long)(t)*KVBLK*PQ,(unsigned)__builtin_amdgcn_readfirstlane(kdst+(slot)))
  #define DMA_V(t,slot) glds16(vsrc+(long)(t)*KVBLK*PQ,(unsigned)__builtin_amdgcn_readfirstlane(vdst+(slot)))
  const int vb0=(int)(lds0+LDS_V)+((lane>>4)&1)*32+(lane&3)*8+(4*hi+((lane&15)>>2))*64;
  const char*Kbase=shm+LDS_K; bf16x8 kf[8];
  const lds_cptr shm3=(lds_cptr)shm; const lds_cptr kp0=shm3+LDS_K+hi*1024+r32*16; const lds_cptr vp0=shm3+LDS_V+((lane>>4)&1)*32+(lane&3)*8+(4*hi+((lane&15)>>2))*64;
  const int NT=(q0+QB)/KVBLK;
  DMA_K(0,0);DMA_V(0,0);DMA_K(1,SLOTB);
  bf16x8 qr[4];
  #pragma unroll
  for(int d0=0;d0<4;++d0)qr[d0]=*reinterpret_cast<const bf16x8*>(&Qw[(long)r32*PQ+d0*16+hi*8]);
  float mhat=0.f,l_reg=0.f;f32x16 o[2];o[0]=f32x16{};o[1]=f32x16{};f32x16 negm=f32x16{};asm volatile("":"+v"(negm));
  const int qrel=wid*QBLK+r32;
  #define CMASK(P0,P1,t) do{int jb_=(t)-(NT-4); if(jb_>=0)cmask(P0,P1,jb_,qrel,hi);}while(0)
  bool resc=false;
  #define START(P0,P1) do{ const float rm=rowmax(P0,P1); resc=false; \
    { const float dl=rm; mhat=fadd_s(mhat,dl); \
      _Pragma("unroll") for(int r=0;r<16;++r){P0[r]=fsub_s(P0[r],dl);P1[r]=fsub_s(P1[r],dl);} \
      _Pragma("unroll") for(int r=0;r<16;++r)negm[r]=-mhat; asm volatile("":"+v"(negm)); } \
    _Pragma("unroll") for(int r=0;r<16;++r)P0[r]=__builtin_amdgcn_exp2f(P0[r]); }while(0)
  #define RESC() do{ if(resc){ asm volatile("s_waitcnt lgkmcnt(0)":::"memory"); \
      _Pragma("unroll") for(int d_=0;d_<2;++d_) _Pragma("unroll") for(int r=0;r<16;++r)o[d_][r]*=wsf[crow(r,hi)]; } }while(0)
  f32x16 pA0,pA1,pB0,pB1;
  int sl_prev=0,sl_cur=0,sl_next=SLOTB;
  #define ROT() do{sl_prev=sl_cur;sl_cur=sl_next;sl_next=(sl_next==(NSLOT-1)*SLOTB)?0:sl_next+SLOTB;}while(0)
  DMA_K(2,2*SLOTB);
  WAIT_BAR(3);
  qkt(pA0,pA1,Kbase,qr,negm,r32,hi);asm volatile("s_nop 15\n\ts_nop 7":"+v"(pA0),"+v"(pA1));CMASK(pA0,pA1,0);
  START(pA0,pA1);
  _Pragma("unroll") for(int r=0;r<16;++r)pA1[r]=__builtin_amdgcn_exp2f(pA1[r]);
  WAIT_BAR(0);
  DMA_K(3,0);DMA_V(1,SLOTB);
  ROT();
  kload8(kf,kp0+sl_cur);
  WAIT_BAR(2);
  s16x4 vlo[8],vhi[8]; u32x4 pw0,pw1,pw2,pw3;
  #define PKW(P,B) cvtpk_s(P[B],P[B+1])
  #define PAF(k) __builtin_bit_cast(bf16x8,pw##k)
  #define VFR(i) (bf16x8){vlo[i][0],vlo[i][1],vlo[i][2],vlo[i][3],vhi[i][0],vhi[i][1],vhi[i][2],vhi[i][3]}
  #define PIN(x) asm volatile("":"+v"(x))
  #define MX3(a,b,c) __builtin_fmaxf(__builtin_fmaxf((a),(b)),(c))
  #define GAPA(MF,A0,A1,A2,A3,W0,W1,PW) do{ MF; sacc+=A0; sacc+=A1; sacc+=A2; sacc+=A3; PIN(sacc); W0; W1; PIN(PW); SBAR(); }while(0)
  #define EX(v) __builtin_amdgcn_exp2f(v)
  #define GAPB(MF,X,B) do{ MF; X[B]=EX(X[B]); X[B+1]=EX(X[B+1]); X[B+2]=EX(X[B+2]); X[B+3]=EX(X[B+3]); PIN(X); SBAR(); }while(0)
  #define VRD(i) do{ vlo[i]=vtr(vp_+(((i)>>2)*4096+((i)&3)*1024)); vhi[i]=vtr(vp_+(((i)>>2)*4096+((i)&3)*1024+512)); }while(0)
  #define KRD(G,j) do{ if(G){ kload2(kf,kp0+sl_next,j); SBAR(); } }while(0)
  #define STEP(C0,C1,P0,P1,t,GK,GV,GL) do{ SBAR(); \
    const lds_cptr vp_=vp0+sl_prev; \
    VRD(0); SBAR(); float sacc=(P0[0]+P0[1]); \
    GAPA(C0=__builtin_amdgcn_mfma_f32_32x32x16_bf16(kf[0],qr[0],negm,0,0,0), P0[2],P0[3],P0[4],P0[5],     pw0[0]=PKW(P0,0), pw0[1]=PKW(P0,2), pw0); \
    VRD(4); SBAR(); GAPA(C1=__builtin_amdgcn_mfma_f32_32x32x16_bf16(kf[1],qr[0],negm,0,0,0), P0[6],P0[7],P0[8],P0[9],     pw0[2]=PKW(P0,4), pw0[3]=PKW(P0,6), pw0); \
    VRD(1); SBAR(); GAPA(C0=__builtin_amdgcn_mfma_f32_32x32x16_bf16(kf[2],qr[1],C0,0,0,0),   P0[10],P0[11],P0[12],P0[13], pw1[0]=PKW(P0,8), pw1[1]=PKW(P0,10), pw1); \
    VRD(5); SBAR(); GAPA(C1=__builtin_amdgcn_mfma_f32_32x32x16_bf16(kf[3],qr[1],C1,0,0,0),   P0[14],P0[15],P1[0],P1[1],   pw1[2]=PKW(P0,12),pw1[3]=PKW(P0,14), pw1); \
    VRD(2); SBAR(); GAPA(C0=__builtin_amdgcn_mfma_f32_32x32x16_bf16(kf[4],qr[2],C0,0,0,0),   P1[2],P1[3],P1[4],P1[5],     pw2[0]=PKW(P1,0), pw2[1]=PKW(P1,2), pw2); \
    VRD(6); SBAR(); GAPA(C1=__builtin_amdgcn_mfma_f32_32x32x16_bf16(kf[5],qr[2],C1,0,0,0),   P1[6],P1[7],P1[8],P1[9],     pw2[2]=PKW(P1,4), pw2[3]=PKW(P1,6), pw2); \
    VRD(3); SBAR(); GAPA(C0=__builtin_amdgcn_mfma_f32_32x32x16_bf16(kf[6],qr[3],C0,0,0,0),   P1[10],P1[11],P1[12],P1[13], pw3[0]=PKW(P1,8), pw3[1]=PKW(P1,10), pw3); \
    VRD(7); SBAR(); GAPA(C1=__builtin_amdgcn_mfma_f32_32x32x16_bf16(kf[7],qr[3],C1,0,0,0),   P1[14],P1[15],0.f,0.f,       pw3[2]=PKW(P1,12),pw3[3]=PKW(P1,14), pw3); \
    l_reg+=sacc; \
    if(GK){DMA_K((t)+3,sl_cur);} if(GV){DMA_V((t)+1,sl_next);} \
    CMASK(C0,C1,t); \
    { float a=MX3(C0[0],C0[1],C1[0]),b=MX3(C0[2],C0[3],C1[1]); a=MX3(a,C1[2],C1[3]); \
      _Pragma("unroll") for(int r=4;r<16;r+=4){a=MX3(a,C0[r],C0[r+1]);b=MX3(b,C0[r+2],C0[r+3]);a=MX3(a,C1[r],C1[r+1]);b=MX3(b,C1[r+2],C1[r+3]);} \
      float rm=__builtin_fmaxf(a,b); { auto rr=__builtin_amdgcn_permlane32_swap(__float_as_uint(rm),__float_as_uint(rm),false,false); rm=__builtin_fmaxf(__uint_as_float(rr[0]),__uint_as_float(rr[1])); } \
      resc=false; \
      if(__builtin_expect(__any(rm>(float)THRL),0)){ const float dl=__builtin_fmaxf(rm,0.f); mhat+=dl; \
        _Pragma("unroll") for(int r=0;r<16;++r){C0[r]-=dl;C1[r]-=dl;} \
        _Pragma("unroll") for(int r=0;r<16;++r)negm[r]=-mhat; asm volatile("":"+v"(negm)); \
        const float f=__builtin_amdgcn_exp2f(-dl); l_reg*=f; if(hi==0)wsf[r32]=f; resc=true; } } \
    SBAR(); \
    GAPB(o[0]=__builtin_amdgcn_mfma_f32_32x32x16_bf16(PAF(0),VFR(0),o[0],0,0,0), C0,0); \
    GAPB(o[1]=__builtin_amdgcn_mfma_f32_32x32x16_bf16(PAF(0),VFR(4),o[1],0,0,0), C0,4); \
    KRD(GL,0); GAPB(o[0]=__builtin_amdgcn_mfma_f32_32x32x16_bf16(PAF(1),VFR(1),o[0],0,0,0), C0,8); \
    KRD(GL,1); GAPB(o[1]=__builtin_amdgcn_mfma_f32_32x32x16_bf16(PAF(1),VFR(5),o[1],0,0,0), C0,12); \
    KRD(GL,2); GAPB(o[0]=__builtin_amdgcn_mfma_f32_32x32x16_bf16(PAF(2),VFR(2),o[0],0,0,0), C1,0); \
    KRD(GL,3); GAPB(o[1]=__builtin_amdgcn_mfma_f32_32x32x16_bf16(PAF(2),VFR(6),o[1],0,0,0), C1,4); \
    GAPB(o[0]=__builtin_amdgcn_mfma_f32_32x32x16_bf16(PAF(3),VFR(3),o[0],0,0,0), C1,8); \
    GAPB(o[1]=__builtin_amdgcn_mfma_f32_32x32x16_bf16(PAF(3),VFR(7),o[1],0,0,0), C1,12); \
    }while(0)
  int t=1;
  #undef CMASK
  #define CMASK(P0,P1,t) do{}while(0)
  for(;t+5<NT;t+=2){
    STEP(pB0,pB1,pA0,pA1,t,true,true,true);     WAIT_BAR(2); RESC(); ROT();
    STEP(pA0,pA1,pB0,pB1,t+1,true,true,true);   WAIT_BAR(2); RESC(); ROT();
  }
  #undef CMASK
  #define CMASK(P0,P1,t) do{int jb_=(t)-(NT-4); if(jb_>=0)cmask(P0,P1,jb_,qrel,hi);}while(0)
  #define ENDW(tt) do{ if((tt)+3<NT){WAIT_BAR(2);} else if((tt)+2<NT){WAIT_BAR(1);} else {WAIT_BAR(0);} }while(0)
  for(;t+1<NT;t+=2){
    STEP(pB0,pB1,pA0,pA1,t,(t+3<NT),(t+1<NT),(t+1<NT));       ENDW(t);   RESC(); ROT();
    STEP(pA0,pA1,pB0,pB1,t+1,(t+4<NT),(t+2<NT),(t+2<NT));     ENDW(t+1); RESC(); ROT();
  }
  STEP(pB0,pB1,pA0,pA1,NT-1,false,false,false); RESC();
  { float sacc=pB0[0]+pB0[1]; _Pragma("unroll") for(int r=2;r<16;++r)sacc+=pB0[r]; _Pragma("unroll") for(int r=0;r<16;++r)sacc+=pB1[r]; l_reg+=sacc;
    pw0=(u32x4){PKW(pB0,0),PKW(pB0,2),PKW(pB0,4),PKW(pB0,6)};pw1=(u32x4){PKW(pB0,8),PKW(pB0,10),PKW(pB0,12),PKW(pB0,14)};pw2=(u32x4){PKW(pB1,0),PKW(pB1,2),PKW(pB1,4),PKW(pB1,6)};pw3=(u32x4){PKW(pB1,8),PKW(pB1,10),PKW(pB1,12),PKW(pB1,14)};
    SBAR(); pv(o,vb0+sl_cur,PAF(0),PAF(1),PAF(2),PAF(3)); }
  #undef PKW
  #undef PAF
  #undef VFR
  #undef PIN
  #undef MX3
  #undef GAPA
  #undef GAPB
  #undef EX
  #undef VRD
  #undef KRD
  #undef STEP
  #undef ENDW
  {auto rr=__builtin_amdgcn_permlane32_swap(__float_as_uint(l_reg),__float_as_uint(l_reg),false,false);l_reg=__uint_as_float(rr[0])+__uint_as_float(rr[1]);}
  if(hi==0)wsf[32+r32]=l_reg;asm volatile("s_waitcnt lgkmcnt(0)":::"memory");
  float rli[16];
  #pragma unroll
  for(int r=0;r<16;++r)rli[r]=__builtin_amdgcn_rcpf(wsf[32+crow(r,hi)]);
  bf16*Ow=Oh+(long)(q0+wid*QBLK)*PO;
  { bf16*stg=(bf16*)(shm+LDS_OST)+wid*2048;
    #pragma unroll
    for(int r=0;r<16;++r){const int orow=crow(r,hi);
      #pragma unroll
      for(int d0=0;d0<2;++d0)stg[orow*64+d0*32+r32]=__float2bfloat16(o[d0][r]*rli[r]);}
    asm volatile("s_waitcnt lgkmcnt(0)":::"memory");
    #pragma unroll
    for(int i=0;i<4;++i){const int row=i*8+(lane>>3),ch=lane&7; const u32x4 v=*(const u32x4*)(stg+row*64+ch*8); ATTN_STORE16(Ow+(long)row*PO+ch*8,v);} }
  asm volatile("s_waitcnt lgkmcnt(0)\n\ts_barrier":::"memory");
  #undef DMA_K
  #undef DMA_V
  #undef CMASK
  #undef START
  #undef RESC
  #undef ROT
}
constexpr int ATTN_LDS_BYTES=LDS_BYTES;
#undef SBAR
#undef WAIT_BAR
}
#ifndef ATTN_STAG
#define ATTN_STAG 0
#endif
#ifndef ATTN_MIDPOS
#define ATTN_MIDPOS 0
#endif
namespace attn128 {
using bf16=__hip_bfloat16;
using bf16x8=__attribute__((ext_vector_type(8)))short;
using s16x4=__attribute__((ext_vector_type(4)))short;
using f32x16=__attribute__((ext_vector_type(16)))float;
using u32x4=__attribute__((ext_vector_type(4)))unsigned;
constexpr int SEQ=4096,D=64,PQ=3584,PO=1024;
constexpr int NW=8,QBLK=32,QB=QBLK*NW,KVBLK=64,NQB=SEQ/QB;
constexpr int ATTN_UNIT_ROWS=QB;
__device__ __forceinline__ int crow(int r,int hi){return (r&3)+8*(r>>2)+4*hi;}
#define SBAR() __builtin_amdgcn_sched_barrier(0)
__device__ __forceinline__ void cmask(f32x16&p0,f32x16&p1,int jb,int qrel,int hi){
  const float NEG=-INFINITY; int kb=64*jb+4*hi;
  #pragma unroll
  for(int r=0;r<16;++r){int kv=kb+(r&3)+8*(r>>2); if(kv>qrel)p0[r]=NEG; if(kv+32>qrel)p1[r]=NEG;}
}

constexpr int NSLOT=3, SLOTB=8192;
constexpr int LDS_K=0, LDS_V=NSLOT*SLOTB, LDS_WS=LDS_V+NSLOT*2*SLOTB, LDS_OST=LDS_WS+NW*64*4, LDS_BYTES=LDS_OST+NW*4096;
constexpr float C2=0.125f*1.4426950408889634f;
__device__ __forceinline__ void glds16(const void*gsrc,unsigned lds_dst){unsigned keep;
  asm volatile("s_mov_b32 %0, m0\n\ts_mov_b32 m0, %2\n\ts_nop 0\n\tglobal_load_lds_dwordx4 %1, off\n\ts_mov_b32 m0, %0":"=&s"(keep):"v"(gsrc),"s"(lds_dst):"memory");}
__device__ __forceinline__ float max3f(float a,float b,float c){float r;asm("v_max3_f32 %0, %1, %2, %3":"=v"(r):"v"(a),"v"(b),"v"(c));return r;}
__device__ __forceinline__ float max2f(float a,float b){float r;asm("v_max_f32_e32 %0, %1, %2":"=v"(r):"v"(a),"v"(b));return r;}
__device__ __forceinline__ float fadd_s(float a,float b){float r;asm("v_add_f32_e32 %0, %1, %2":"=v"(r):"v"(a),"v"(b));return r;}
__device__ __forceinline__ float fsub_s(float a,float b){float r;asm("v_sub_f32_e32 %0, %1, %2":"=v"(r):"v"(a),"v"(b));return r;}
typedef float f32x2_t __attribute__((ext_vector_type(2))); typedef __bf16 bf16x2_t __attribute__((ext_vector_type(2)));
__device__ __forceinline__ unsigned cvtpk_s(float lo,float hi){f32x2_t v={lo,hi};bf16x2_t b=__builtin_convertvector(v,bf16x2_t);return __builtin_bit_cast(unsigned,b);}
#define WAIT_BAR(N) asm volatile("s_waitcnt vmcnt(" #N ") lgkmcnt(0)\n\ts_barrier":::"memory")
#define MID_BAR(N) asm volatile("s_waitcnt vmcnt(" #N ")\n\ts_barrier":::"memory")

__device__ __forceinline__ void qkt(f32x16&p0,f32x16&p1,const char*Kslot,const bf16x8*qr,int r32,int hi){ const f32x16 negm=f32x16{};
  const char*kb=Kslot+hi*1024+r32*16;
  #pragma unroll
  for(int d0=0;d0<4;++d0){
    const bf16x8 b0=*reinterpret_cast<const bf16x8*>(kb+d0*2048);
    const bf16x8 b1=*reinterpret_cast<const bf16x8*>(kb+d0*2048+512);
    if(d0==0){p0=__builtin_amdgcn_mfma_f32_32x32x16_bf16(b0,qr[0],negm,0,0,0);p1=__builtin_amdgcn_mfma_f32_32x32x16_bf16(b1,qr[0],negm,0,0,0);}
    else{p0=__builtin_amdgcn_mfma_f32_32x32x16_bf16(b0,qr[d0],p0,0,0,0);p1=__builtin_amdgcn_mfma_f32_32x32x16_bf16(b1,qr[d0],p1,0,0,0);}}
}
typedef __attribute__((address_space(3))) const char* lds_cptr;
typedef short v4i16_t __attribute__((ext_vector_type(4)));
__device__ __forceinline__ void kload8(bf16x8*kf,lds_cptr kp){
  kf[0]=*(const __attribute__((address_space(3))) bf16x8*)(kp);      kf[1]=*(const __attribute__((address_space(3))) bf16x8*)(kp+512);
  kf[2]=*(const __attribute__((address_space(3))) bf16x8*)(kp+2048); kf[3]=*(const __attribute__((address_space(3))) bf16x8*)(kp+2560);
  kf[4]=*(const __attribute__((address_space(3))) bf16x8*)(kp+4096); kf[5]=*(const __attribute__((address_space(3))) bf16x8*)(kp+4608);
  kf[6]=*(const __attribute__((address_space(3))) bf16x8*)(kp+6144); kf[7]=*(const __attribute__((address_space(3))) bf16x8*)(kp+6656);
}
__device__ __forceinline__ void kload2(bf16x8*kf,lds_cptr kp,int j){ kf[2*j]=*(const __attribute__((address_space(3))) bf16x8*)(kp+j*2048); kf[2*j+1]=*(const __attribute__((address_space(3))) bf16x8*)(kp+j*2048+512); }
__device__ __forceinline__ s16x4 vtr(lds_cptr p){ return __builtin_bit_cast(s16x4,__builtin_amdgcn_ds_read_tr16_b64_v4i16((__attribute__((address_space(3))) v4i16_t*)p)); }
__device__ __forceinline__ float rowmax(const f32x16&p0,const f32x16&p1){
  float a=max3f(p0[0],p0[1],p1[0]),b=max3f(p0[2],p0[3],p1[1]);a=max3f(a,p1[2],p1[3]);
  #pragma unroll
  for(int r=4;r<16;r+=4){a=max3f(a,p0[r],p0[r+1]);b=max3f(b,p0[r+2],p0[r+3]);a=max3f(a,p1[r],p1[r+1]);b=max3f(b,p1[r+2],p1[r+3]);}
  const float m=max2f(a,b);
  auto rr=__builtin_amdgcn_permlane32_swap(__float_as_uint(m),__float_as_uint(m),false,false);
  return max2f(__uint_as_float(rr[0]),__uint_as_float(rr[1]));
}
__device__ __forceinline__ void pv(f32x16*o,int vb,bf16x8 pa0,bf16x8 pa1,bf16x8 pa2,bf16x8 pa3){
  #pragma unroll
  for(int d0=0;d0<4;++d0){s16x4 lo[4],hi[4];
    #pragma unroll
    for(int ks=0;ks<4;++ks){
      asm volatile("ds_read_b64_tr_b16 %0,%1 offset:%c2":"=&v"(lo[ks]):"v"(vb),"i"(d0*4096+ks*1024):"memory");
      asm volatile("ds_read_b64_tr_b16 %0,%1 offset:%c2":"=&v"(hi[ks]):"v"(vb),"i"(d0*4096+ks*1024+512):"memory");}
    asm volatile("s_waitcnt lgkmcnt(0)":::"memory");SBAR();
    #define PK(k) (bf16x8){lo[k][0],lo[k][1],lo[k][2],lo[k][3],hi[k][0],hi[k][1],hi[k][2],hi[k][3]}
    o[d0]=__builtin_amdgcn_mfma_f32_32x32x16_bf16(pa0,PK(0),o[d0],0,0,0);
    o[d0]=__builtin_amdgcn_mfma_f32_32x32x16_bf16(pa1,PK(1),o[d0],0,0,0);
    o[d0]=__builtin_amdgcn_mfma_f32_32x32x16_bf16(pa2,PK(2),o[d0],0,0,0);
    o[d0]=__builtin_amdgcn_mfma_f32_32x32x16_bf16(pa3,PK(3),o[d0],0,0,0);
    #undef PK
  }
}

#if 0
#define ATTN_STORE16(p,v) (*(u32x4*)(p)=(v))
#endif
template<int THRL,int DRY=0> __device__ __forceinline__ void attn_unit(int qb,const bf16*Qh,const bf16*__restrict__ Kh,const bf16*__restrict__ Vh,bf16*Oh,char*shm){
  int tid_=threadIdx.x; asm volatile("":"+v"(tid_));
  const int tid=tid_,lane=tid&63,r32=lane&31,hi=lane>>5; const int wid=__builtin_amdgcn_readfirstlane(tid>>6);
  const int q0=qb*QB; const bool grp=ATTN_STAG&&(wid>>2);
  const bf16*Qw=Qh+(long)(q0+wid*QBLK)*PQ;
  const unsigned lds0=(unsigned)(uintptr_t)shm;
  float*wsf=(float*)(shm+LDS_WS)+wid*64;
  const bf16*ksrc=Kh+(long)lane*PQ+wid*8;
  const bf16*vsrc=Vh+(long)(16*(wid&3)+(lane>>2))*PQ+(wid>>2)*32+(lane&3)*8;
  const unsigned kdst=lds0+LDS_K+wid*1024, vdst=lds0+LDS_V+wid*1024;
  #define DMA_K(t,slot) glds16(ksrc+(long)(t)*KVBLK*PQ,(unsigned)__builtin_amdgcn_readfirstlane(kdst+(slot)))
  #define DMA_V(t,slot) do{ glds16(vsrc+(long)(t)*KVBLK*PQ,(unsigned)__builtin_amdgcn_readfirstlane(vdst+2*(slot))); glds16(vsrc+64+(long)(t)*KVBLK*PQ,(unsigned)__builtin_amdgcn_readfirstlane(vdst+2*(slot)+8192)); }while(0)
  const int vb0=(int)(lds0+LDS_V)+((lane>>4)&1)*32+(lane&3)*8+(4*hi+((lane&15)>>2))*64;
  const char*Kbase=shm+LDS_K; bf16x8 kf[8];
  const lds_cptr shm3=(lds_cptr)shm; const lds_cptr kp0=shm3+LDS_K+hi*1024+r32*16; const lds_cptr vp0=shm3+LDS_V+((lane>>4)&1)*32+(lane&3)*8+(4*hi+((lane&15)>>2))*64;
  const int NT=(q0+QB)/KVBLK;
  bf16x8 qr[4];
  #pragma unroll
  for(int d0=0;d0<4;++d0)qr[d0]=*reinterpret_cast<const bf16x8*>(&Qw[(long)r32*PQ+d0*16+hi*8]);
  DMA_K(0,0);DMA_V(0,0);DMA_K(1,SLOTB);DMA_K(2,2*SLOTB);
  { bf16x8* qst=(bf16x8*)(shm+LDS_OST+wid*4096);
    #pragma unroll
    for(int d0=0;d0<4;++d0)qst[(d0*2+hi)*32+r32]=qr[d0]; }
  const lds_cptr qp0=shm3+LDS_OST+wid*4096+(hi*32+r32)*16;
  #define QLD(d0) (*(const __attribute__((address_space(3))) bf16x8*)(qp0+(d0)*1024))
  float mhat=0.f,l_reg=0.f;f32x16 o[4];o[0]=f32x16{};o[1]=f32x16{};o[2]=f32x16{};o[3]=f32x16{};
  const int qrel=wid*QBLK+r32;
  #define CMASK(P0,P1,t) do{int jb_=(t)-(NT-4); if(jb_>=0)cmask(P0,P1,jb_,qrel,hi);}while(0)
  bool resc=false;
  #define START(P0,P1) do{ const float rm=rowmax(P0,P1); resc=false; \
    { const float dl=rm; mhat=fadd_s(mhat,dl); \
      _Pragma("unroll") for(int r=0;r<16;++r){P0[r]=fsub_s(P0[r],dl);P1[r]=fsub_s(P1[r],dl);} \
      } \
    _Pragma("unroll") for(int r=0;r<16;++r)P0[r]=__builtin_amdgcn_exp2f(P0[r]); }while(0)
  #define RESC() do{ if(resc){ asm volatile("s_waitcnt lgkmcnt(0)":::"memory"); \
      _Pragma("unroll") for(int d_=0;d_<4;++d_) _Pragma("unroll") for(int r=0;r<16;++r)o[d_][r]*=wsf[crow(r,hi)]; } }while(0)
  f32x16 pA0,pA1,pB0,pB1;
  int sl_prev=0,sl_cur=0,sl_next=SLOTB;
  #define ROT() do{sl_prev=sl_cur;sl_cur=sl_next;sl_next=(sl_next==(NSLOT-1)*SLOTB)?0:sl_next+SLOTB;}while(0)
  if(grp){ WAIT_BAR(4); WAIT_BAR(0); }
  else WAIT_BAR(4);
  qkt(pA0,pA1,Kbase,qr,r32,hi);asm volatile("s_nop 15\n\ts_nop 7":"+v"(pA0),"+v"(pA1));CMASK(pA0,pA1,0);
  START(pA0,pA1);
  _Pragma("unroll") for(int r=0;r<16;++r)pA1[r]=__builtin_amdgcn_exp2f(pA1[r]);
  WAIT_BAR(0);
  if(!ATTN_STAG||grp){DMA_K(3,0);DMA_V(1,SLOTB);}
  ROT();
  kload8(kf,kp0+sl_cur);
  WAIT_BAR(3);
  if(ATTN_STAG&&!grp){DMA_K(3,0);DMA_V(1,SLOTB);}
  s16x4 vlo[8],vhi[8]; u32x4 pw0,pw1,pw2,pw3;
  #define PKW(P,B) cvtpk_s(P[B],P[B+1])
  #define PAF(k) __builtin_bit_cast(bf16x8,pw##k)
  #define VFR(i) (bf16x8){vlo[i][0],vlo[i][1],vlo[i][2],vlo[i][3],vhi[i][0],vhi[i][1],vhi[i][2],vhi[i][3]}
  #define PIN(x) asm volatile("":"+v"(x))
  #define MX3(a,b,c) __builtin_fmaxf(__builtin_fmaxf((a),(b)),(c))
  #define GAPA(MF,A0,A1,A2,A3,W0,W1,PW) do{ MF; if(!(DRY&1)){ sacc+=A0; sacc+=A1; sacc+=A2; sacc+=A3; PIN(sacc); W0; W1; PIN(PW); } SBAR(); }while(0)
  #define EX(v) __builtin_amdgcn_exp2f(v)
  #define GAPB(MF,X,B) do{ MF; if(!(DRY&2)){ X[B]=X[B]-mhat; X[B+1]=X[B+1]-mhat; PIN(X); X[B]=EX(X[B]); X[B+1]=EX(X[B+1]); PIN(X); } SBAR(); }while(0)
  #define KEEPF(x) asm volatile(""::"v"(x))
  #define KEEPV(i) do{ asm volatile(""::"v"(vlo[i]),"v"(vhi[i])); }while(0)
  #define VRD2(i) do{ if(DRY&4)break; vlo[i]=vtr(vp_+((((i)>>2)+2)*4096+((i)&3)*1024)); vhi[i]=vtr(vp_+((((i)>>2)+2)*4096+((i)&3)*1024+512)); SBAR(); }while(0)
  #define VRD(i) do{ if(DRY&4)break; vlo[i]=vtr(vp_+(((i)>>2)*4096+((i)&3)*1024)); vhi[i]=vtr(vp_+(((i)>>2)*4096+((i)&3)*1024+512)); }while(0)
  #define KRD(G,j) do{ if((G)&&!(DRY&16)){ kload2(kf,kp0+sl_next,j); SBAR(); } }while(0)
  #define MIDB(pos,MW,GK,GV,t) do{ if(ATTN_STAG&&(pos)==ATTN_MIDPOS){ if((MW)==3)MID_BAR(3); else if((MW)==2)MID_BAR(2); else MID_BAR(0); SBAR(); \
      if(!grp){ if(GK&&!(DRY&8)){DMA_K((t)+3,sl_cur);} if(GV&&!(DRY&8)){DMA_V((t)+1,sl_next);} } SBAR(); } }while(0)
  #define STEP(C0,C1,P0,P1,t,GK,GV,GL,MW) do{ SBAR(); const f32x16 zero16=f32x16{}; const bf16x8 ql0=QLD(0),ql1=QLD(1),ql2=QLD(2),ql3=QLD(3); \
    const lds_cptr vp_=vp0+2*sl_prev; \
    VRD(0); SBAR(); float sacc=(P0[0]+P0[1]); \
    GAPA(C0=__builtin_amdgcn_mfma_f32_32x32x16_bf16(kf[0],ql0,zero16,0,0,0), P0[2],P0[3],P0[4],P0[5],     pw0[0]=PKW(P0,0), pw0[1]=PKW(P0,2), pw0); \
    VRD(4); SBAR(); GAPA(C1=__builtin_amdgcn_mfma_f32_32x32x16_bf16(kf[1],ql0,zero16,0,0,0), P0[6],P0[7],P0[8],P0[9],     pw0[2]=PKW(P0,4), pw0[3]=PKW(P0,6), pw0); \
    VRD(1); SBAR(); KEEPF(kf[0]); GAPA(C0=__builtin_amdgcn_mfma_f32_32x32x16_bf16(kf[2],ql1,C0,0,0,0),   P0[10],P0[11],P0[12],P0[13], pw1[0]=PKW(P0,8), pw1[1]=PKW(P0,10), pw1); \
    VRD(5); SBAR(); KEEPF(kf[1]); KEEPF(ql0); GAPA(C1=__builtin_amdgcn_mfma_f32_32x32x16_bf16(kf[3],ql1,C1,0,0,0),   P0[14],P0[15],P1[0],P1[1],   pw1[2]=PKW(P0,12),pw1[3]=PKW(P0,14), pw1); \
    VRD(2); SBAR(); KEEPF(kf[2]); GAPA(C0=__builtin_amdgcn_mfma_f32_32x32x16_bf16(kf[4],ql2,C0,0,0,0),   P1[2],P1[3],P1[4],P1[5],     pw2[0]=PKW(P1,0), pw2[1]=PKW(P1,2), pw2); \
    VRD(6); SBAR(); KEEPF(kf[3]); KEEPF(ql1); GAPA(C1=__builtin_amdgcn_mfma_f32_32x32x16_bf16(kf[5],ql2,C1,0,0,0),   P1[6],P1[7],P1[8],P1[9],     pw2[2]=PKW(P1,4), pw2[3]=PKW(P1,6), pw2); \
    VRD(3); SBAR(); KEEPF(kf[4]); GAPA(C0=__builtin_amdgcn_mfma_f32_32x32x16_bf16(kf[6],ql3,C0,0,0,0),   P1[10],P1[11],P1[12],P1[13], pw3[0]=PKW(P1,8), pw3[1]=PKW(P1,10), pw3); \
    VRD(7); SBAR(); KEEPF(kf[5]); KEEPF(ql2); GAPA(C1=__builtin_amdgcn_mfma_f32_32x32x16_bf16(kf[7],ql3,C1,0,0,0),   P1[14],P1[15],0.f,0.f,       pw3[2]=PKW(P1,12),pw3[3]=PKW(P1,14), pw3); \
    l_reg+=sacc; \
    if(!ATTN_STAG||grp){ if(GK&&!(DRY&8)){DMA_K((t)+3,sl_cur);} if(GV&&!(DRY&8)){DMA_V((t)+1,sl_next);} } \
    CMASK(C0,C1,t); \
    { float a=MX3(C0[0],C0[1],C1[0]),b=MX3(C0[2],C0[3],C1[1]); a=MX3(a,C1[2],C1[3]); \
      _Pragma("unroll") for(int r=4;r<16;r+=4){a=MX3(a,C0[r],C0[r+1]);b=MX3(b,C0[r+2],C0[r+3]);a=MX3(a,C1[r],C1[r+1]);b=MX3(b,C1[r+2],C1[r+3]);} \
      float rm=__builtin_fmaxf(a,b); { auto rr=__builtin_amdgcn_permlane32_swap(__float_as_uint(rm),__float_as_uint(rm),false,false); rm=__builtin_fmaxf(__uint_as_float(rr[0]),__uint_as_float(rr[1])); } \
      resc=false; \
      rm-=mhat; \
      if(__builtin_expect(__any(rm>(float)THRL),0)){ const float dl=__builtin_fmaxf(rm,0.f); mhat+=dl; \
        const float f=__builtin_amdgcn_exp2f(-dl); l_reg*=f; if(hi==0)wsf[r32]=f; resc=true; } } \
    KEEPF(kf[6]); KEEPF(kf[7]); KEEPF(ql3); SBAR(); \
    MIDB(0,MW,GK,GV,t); \
    GAPB(o[0]=__builtin_amdgcn_mfma_f32_32x32x16_bf16(PAF(0),VFR(0),o[0],0,0,0), C0,0); \
    GAPB(o[1]=__builtin_amdgcn_mfma_f32_32x32x16_bf16(PAF(0),VFR(4),o[1],0,0,0), C0,2); \
    MIDB(2,MW,GK,GV,t); \
    KRD(GL,0); GAPB(o[0]=__builtin_amdgcn_mfma_f32_32x32x16_bf16(PAF(1),VFR(1),o[0],0,0,0), C0,4); KEEPV(0); VRD2(0); \
    KRD(GL,1); GAPB(o[1]=__builtin_amdgcn_mfma_f32_32x32x16_bf16(PAF(1),VFR(5),o[1],0,0,0), C0,6); KEEPV(4); VRD2(4); \
    MIDB(4,MW,GK,GV,t); \
    KRD(GL,2); GAPB(o[0]=__builtin_amdgcn_mfma_f32_32x32x16_bf16(PAF(2),VFR(2),o[0],0,0,0), C0,8); KEEPV(1); VRD2(1); \
    KRD(GL,3); GAPB(o[1]=__builtin_amdgcn_mfma_f32_32x32x16_bf16(PAF(2),VFR(6),o[1],0,0,0), C0,10); KEEPV(5); VRD2(5); \
    GAPB(o[0]=__builtin_amdgcn_mfma_f32_32x32x16_bf16(PAF(3),VFR(3),o[0],0,0,0), C0,12); KEEPV(2); VRD2(2); \
    GAPB(o[1]=__builtin_amdgcn_mfma_f32_32x32x16_bf16(PAF(3),VFR(7),o[1],0,0,0), C0,14); KEEPV(6); VRD2(6); \
    GAPB(o[2]=__builtin_amdgcn_mfma_f32_32x32x16_bf16(PAF(0),VFR(0),o[2],0,0,0), C1,0); KEEPV(3); VRD2(3); \
    GAPB(o[3]=__builtin_amdgcn_mfma_f32_32x32x16_bf16(PAF(0),VFR(4),o[3],0,0,0), C1,2); KEEPV(7); VRD2(7); \
    GAPB(o[2]=__builtin_amdgcn_mfma_f32_32x32x16_bf16(PAF(1),VFR(1),o[2],0,0,0), C1,4); \
    GAPB(o[3]=__builtin_amdgcn_mfma_f32_32x32x16_bf16(PAF(1),VFR(5),o[3],0,0,0), C1,6); \
    GAPB(o[2]=__builtin_amdgcn_mfma_f32_32x32x16_bf16(PAF(2),VFR(2),o[2],0,0,0), C1,8); \
    GAPB(o[3]=__builtin_amdgcn_mfma_f32_32x32x16_bf16(PAF(2),VFR(6),o[3],0,0,0), C1,10); \
    GAPB(o[2]=__builtin_amdgcn_mfma_f32_32x32x16_bf16(PAF(3),VFR(3),o[2],0,0,0), C1,12); \
    GAPB(o[3]=__builtin_amdgcn_mfma_f32_32x32x16_bf16(PAF(3),VFR(7),o[3],0,0,0), C1,14); \
    }while(0)
  int t=(DRY&32)?NT-1:1;
  #undef CMASK
  #define CMASK(P0,P1,t) do{}while(0)
  for(;t+5<NT;t+=2){
    STEP(pB0,pB1,pA0,pA1,t,true,true,true,3);     WAIT_BAR(3); RESC(); ROT();
    STEP(pA0,pA1,pB0,pB1,t+1,true,true,true,3);   WAIT_BAR(3); RESC(); ROT();
  }
  #undef CMASK
  #define CMASK(P0,P1,t) do{int jb_=(t)-(NT-4); if(jb_>=0)cmask(P0,P1,jb_,qrel,hi);}while(0)
  #define ENDW(tt) do{ if((tt)+3<NT){WAIT_BAR(3);} else if((tt)+2<NT){WAIT_BAR(2);} else {WAIT_BAR(0);} }while(0)
  for(;t+1<NT;t+=2){
    STEP(pB0,pB1,pA0,pA1,t,(t+3<NT),(t+1<NT),(t+1<NT),((t+3<NT)?3:(t+1<NT)?2:0));       ENDW(t);   RESC(); ROT();
    STEP(pA0,pA1,pB0,pB1,t+1,(t+4<NT),(t+2<NT),(t+2<NT),((t+4<NT)?3:(t+2<NT)?2:0));     ENDW(t+1); RESC(); ROT();
  }
  STEP(pB0,pB1,pA0,pA1,NT-1,false,false,false,0); RESC();
  { float sacc=pB0[0]+pB0[1]; _Pragma("unroll") for(int r=2;r<16;++r)sacc+=pB0[r]; _Pragma("unroll") for(int r=0;r<16;++r)sacc+=pB1[r]; l_reg+=sacc;
    pw0=(u32x4){PKW(pB0,0),PKW(pB0,2),PKW(pB0,4),PKW(pB0,6)};pw1=(u32x4){PKW(pB0,8),PKW(pB0,10),PKW(pB0,12),PKW(pB0,14)};pw2=(u32x4){PKW(pB1,0),PKW(pB1,2),PKW(pB1,4),PKW(pB1,6)};pw3=(u32x4){PKW(pB1,8),PKW(pB1,10),PKW(pB1,12),PKW(pB1,14)};
    SBAR(); pv(o,vb0+2*sl_cur,PAF(0),PAF(1),PAF(2),PAF(3)); }
  #undef PKW
  #undef PAF
  #undef VFR
  #undef PIN
  #undef MX3
  #undef GAPA
  #undef GAPB
  #undef EX
  #undef VRD
  #undef VRD2
  #undef KEEPF
  #undef KEEPV
  #undef KRD
  #undef STEP
  #undef MIDB
  #undef ENDW
  {auto rr=__builtin_amdgcn_permlane32_swap(__float_as_uint(l_reg),__float_as_uint(l_reg),false,false);l_reg=__uint_as_float(rr[0])+__uint_as_float(rr[1]);}
  if(hi==0)wsf[32+r32]=l_reg;asm volatile("s_waitcnt lgkmcnt(0)":::"memory");
  float rli[16];
  #pragma unroll
  for(int r=0;r<16;++r)rli[r]=__builtin_amdgcn_rcpf(wsf[32+crow(r,hi)]);
  bf16*Ow=Oh+(long)(q0+wid*QBLK)*PO;
  { bf16*stg=(bf16*)(shm+LDS_OST)+wid*2048;
    #pragma unroll
    for(int hf=0;hf<2;++hf){
    #pragma unroll
    for(int r=0;r<16;++r){const int orow=crow(r,hi);
      #pragma unroll
      for(int d0=0;d0<2;++d0)stg[orow*64+d0*32+r32]=__float2bfloat16(o[2*hf+d0][r]*rli[r]);}
    asm volatile("s_waitcnt lgkmcnt(0)":::"memory");
    #pragma unroll
    for(int i=0;i<4;++i){const int row=i*8+(lane>>3),ch=lane&7; const u32x4 v=*(const u32x4*)(stg+row*64+ch*8); ATTN_STORE16(Ow+(long)row*PO+hf*64+ch*8,v);}
    asm volatile("s_waitcnt lgkmcnt(0)":::"memory"); } }
  asm volatile("s_waitcnt lgkmcnt(0)\n\ts_barrier":::"memory");
  if(ATTN_STAG&&!grp) asm volatile("s_barrier":::"memory");
  #undef DMA_K
  #undef QLD
  #undef DMA_V
  #undef CMASK
  #undef START
  #undef RESC
  #undef ROT
}
constexpr int ATTN_LDS_BYTES=LDS_BYTES;
#undef SBAR
#undef WAIT_BAR
}
#define ST8(ptr, w) do { *(ptr) = (w); asm volatile("s_nop 1" :: "v"((w).x), "v"((w).y) : "memory"); } while (0)
#define ST4(ptr, w) do { *(ptr) = (w); asm volatile("s_nop 1" :: "v"(w) : "memory"); } while (0)
constexpr int NWAVES = 8;
constexpr int RING_OFF = 0, RING_BYTES = 131072;
constexpr int LDSCTL_OFF = RING_BYTES, MISC_OFF = LDSCTL_OFF;
constexpr int TAB_OFF = LDSCTL_OFF + 512;
constexpr int EB_OFF = LDSCTL_OFF + 2048;
constexpr int LCNT_OFF = LDSCTL_OFF + 2304;
constexpr int TOKS_OFF = LDSCTL_OFF + 4096, TOKS_UNITS = 6;
constexpr int CW_MOEC = 70000;
constexpr int LDS_BYTES = 147456;
constexpr int CW_BAR = 4096;
constexpr int NPHASE = 18;

#define XB_TMO      128
#define XB_XCNT(j)  (256  + 64 * (j))
#define XB_XSUB(j)  (1280 + 64 * (j))
#define XB_XGEN(j)  (2304 + 64 * (j))
#define XB_TOP      3328
#define XB_TOPGEN   3392
#define XCD_BAR_WORDS 3456
#define XB_SPIN_CAP (1u << 18)

__device__ __forceinline__ unsigned xb_ld(unsigned* p)              { return __hip_atomic_load(p, __ATOMIC_RELAXED, __HIP_MEMORY_SCOPE_AGENT); }
__device__ __forceinline__ unsigned xb_add(unsigned* p, unsigned v) { return __hip_atomic_fetch_add(p, v, __ATOMIC_RELAXED, __HIP_MEMORY_SCOPE_AGENT); }
__device__ __forceinline__ unsigned xb_xcc_id() { return (unsigned)__builtin_amdgcn_s_getreg((3 << 11) | 20) & 0xFu; }
#define XB_SPIN(cond, bar) do { unsigned _sp = 0; while (cond) { __builtin_amdgcn_s_sleep(1); \
    if ((++_sp & 255u) == 0u) { if (xb_ld(&(bar)[XB_TMO])) break; if (_sp > XB_SPIN_CAP) { atomicAdd(&(bar)[XB_TMO], 1u); break; } } } } while (0)

struct XcdBarrier {
    unsigned* bar; unsigned x;
    volatile LAS unsigned* st;
};

__device__ __forceinline__ XcdBarrier xcd_barrier_post(unsigned* bar, volatile LAS unsigned* st) {
    XcdBarrier b; b.bar = bar; b.x = xb_xcc_id(); b.st = st;
    if (threadIdx.x == 0) (void)xb_add(&bar[XB_XCNT(b.x)], 1u);
    return b;
}
__device__ __forceinline__ void xcd_barrier_complete(unsigned* bar, unsigned x, unsigned& nloc, unsigned& nx) {
    const unsigned G = gridDim.x * gridDim.y * gridDim.z;
    unsigned sum, cnt, mine, sp = 0u;
    for (;;) {
        sum = 0u; cnt = 0u; mine = 0u;
#pragma unroll
        for (unsigned j = 0; j < 16; ++j) { const unsigned c = xb_ld(&bar[XB_XCNT(j)]); sum += c; cnt += (c > 0u) ? 1u : 0u; mine = (j == x) ? c : mine; }
        if (sum == G) break;
        __builtin_amdgcn_s_sleep(1);
        if ((++sp & 255u) == 0u) { if (xb_ld(&bar[XB_TMO])) break; if (sp > XB_SPIN_CAP) { atomicAdd(&bar[XB_TMO], 1u); break; } }
    }
    nloc = mine > 0u ? mine : 1u; nx = cnt > 0u ? cnt : 1u;
}

__device__ __forceinline__ void xcd_barrier(const XcdBarrier& b) {
    asm volatile("s_waitcnt vmcnt(0)" ::: "memory");
    __syncthreads();
    if (threadIdx.x == 0) {
        unsigned* bar = b.bar;
        __builtin_amdgcn_s_waitcnt(0);
        unsigned nloc = b.st[0], nx = b.st[1];
        if (nloc == 0u) { xcd_barrier_complete(bar, b.x, nloc, nx); b.st[0] = nloc; b.st[1] = nx; }
        const unsigned old = xb_add(&bar[XB_XSUB(b.x)], 1u);
        const unsigned gen = old / nloc;
        if (old + 1u == (gen + 1u) * nloc) {
            __builtin_amdgcn_fence(__ATOMIC_RELEASE, "agent");
            asm volatile("s_waitcnt vmcnt(0)" ::: "memory");
            const unsigned og = xb_add(&bar[XB_TOP], 1u);
            const unsigned tg = og / nx;
            if (og + 1u == (tg + 1u) * nx) xb_add(&bar[XB_TOPGEN], 1u);
            else XB_SPIN(xb_ld(&bar[XB_TOPGEN]) == tg, bar);
            __builtin_amdgcn_fence(__ATOMIC_ACQUIRE, "agent");
            xb_add(&bar[XB_XGEN(b.x)], 1u);
            asm volatile("s_waitcnt vmcnt(0)" ::: "memory");
        } else {
            XB_SPIN(xb_ld(&bar[XB_XGEN(b.x)]) == gen, bar);
            __builtin_amdgcn_fence(__ATOMIC_ACQUIRE, "agent");
            asm volatile("s_waitcnt vmcnt(0)" ::: "memory");
        }
    }
    __syncthreads();
}


struct Frame {
    LAS unsigned char* lds; volatile LAS unsigned* MISC; gu32* ctl;
    int tid, lane, wave, vcu, G;
    const float *x, *c, *w_ada, *b_ada, *w_in, *w_out, *lq1, *lk1, *lq2, *lk2, *subln, *ln_mix_g, *ln_mix_b, *ln_ffn_g, *ln_ffn_b, *router_w, *router_b, *w_gate, *w_up, *w_down;
    float* out; unsigned char* ws;
    float* mod; float* rot; int* tok_e; float* tok_g; int* tok_slot; int* lists; bf16* Wbf;
    bf16 *S1, *S3, *PROJ, *YP, *HE, *MIXED;
};

__device__ __forceinline__ void transpose_item(const float* W, int ldw, int k0, int n0, bf16* WT, int Kdst, int drow0, LAS float* scr, int lane) {
    f32x4 t[8];
#pragma unroll
    for (int i = 0; i < 8; ++i) t[i] = *(const GAS f32x4*)(W + (size_t)(k0 + 8 * i + (lane >> 3)) * ldw + n0 + 4 * (lane & 7));
#pragma unroll
    for (int i = 0; i < 8; ++i) *(LAS f32x4*)(scr + (8 * i + (lane >> 3)) * 36 + 4 * (lane & 7)) = t[i];
    LDS_WAIT(); asm volatile("" ::: "memory");
    const int c = lane & 7;
#pragma unroll
    for (int j = 0; j < 4; ++j) { const int n = (lane >> 3) + 8 * j; const LAS float* s = scr + (8 * c) * 36 + n;
        u32x4 o; o.x = pk2(s[0 * 36], s[1 * 36]); o.y = pk2(s[2 * 36], s[3 * 36]); o.z = pk2(s[4 * 36], s[5 * 36]); o.w = pk2(s[6 * 36], s[7 * 36]);
        *(GAS u32x4*)(WT + (size_t)(drow0 + n) * Kdst + k0 + 8 * c) = o; }
    LDS_WAIT(); asm volatile("" ::: "memory");
}
constexpr int IT_IN = 16 * 112, IT_OUT = 16 * 32, IT_E = 256, IT_LAYER = IT_IN + IT_OUT + 3 * 16 * IT_E;
__device__ __forceinline__ void p0_weight_item(const Frame& F, int it, LAS float* scr) {
    const int l = it / IT_LAYER; int r = it - l * IT_LAYER; bf16* wl = F.Wbf + (size_t)l * WL_STRIDE;
    if (r < IT_IN) { const int kb = r / 112, c0 = (r % 112) * 32; int drow = c0;
        if (c0 < 1024) drow = (c0 & ~255) + ((c0 >> 5) & 1) * 128 + ((c0 >> 6) & 3) * 32;
        transpose_item(F.w_in + (size_t)l * DM * INW, INW, kb * 64, c0, wl + WL_IN, DM, drow, scr, F.lane); return; }
    r -= IT_IN;
    if (r < IT_OUT) { const int kb = r / 32, c0 = (r % 32) * 32; transpose_item(F.w_out + (size_t)l * DM * DM, DM, kb * 64, c0, wl + WL_OUT, DM, c0, scr, F.lane); return; }
    r -= IT_OUT;
    const int which = r / (16 * IT_E), rr = r % (16 * IT_E), e = rr / IT_E, q = rr % IT_E;
    if (which < 2) { const int kb = q / 16, c0 = (q % 16) * 32; const float* W = (which == 0 ? F.w_gate : F.w_up) + (size_t)(l * NE + e) * DM * DE;
        transpose_item(W, DE, kb * 64, c0, wl + WL_GU, DM, e * 1024 + (c0 >> 7) * 256 + which * 128 + (c0 & 127), scr, F.lane); }
    else { const int kb = q / 32, c0 = (q % 32) * 32; transpose_item(F.w_down + (size_t)(l * NE + e) * DE * DM, DM, kb * 64, c0, wl + WL_D, DE, e * 1024 + c0, scr, F.lane); }
}

#ifndef DEFER_W1
#define DEFER_W1 0
#endif
#ifndef W1_CAP1
#define W1_CAP1 4
#endif
#ifndef W1_CAP2
#define W1_CAP2 2
#endif
__device__ __forceinline__ void deferred_weights(Frame& F, int nwg, int stage) {
    LAS float* scr = (LAS float*)(F.lds + RING_OFF + F.wave * 9216);
    const int rem = nwg % F.G, I = rem ? F.G - rem : 0, slots = I * NWAVES, base1 = slots * W1_CAP1, base2 = base1 + slots * W1_CAP2;
    if (stage < 2) { if (!rem || (int)blockIdx.x < rem) return;
        const int r = ((int)blockIdx.x - rem) * NWAVES + F.wave, cap = stage == 0 ? W1_CAP1 : W1_CAP2, base = stage == 0 ? 0 : base1;
        for (int k = 0; k < cap; ++k) { const int idx = base + r + k * slots; if (idx < IT_LAYER) p0_weight_item(F, IT_LAYER + idx, scr); }
    } else { for (int idx = base2 + F.vcu * NWAVES + F.wave; idx < IT_LAYER; idx += F.G * NWAVES) p0_weight_item(F, IT_LAYER + idx, scr); }
}
__device__ __forceinline__ void ph_prologue(Frame& F) {
    LAS float* scr = (LAS float*)(F.lds + RING_OFF + F.wave * 9216);
    LAS float* cond = (LAS float*)(F.lds + RING_OFF + 73728);
    LAS float* part = (LAS float*)(F.lds + RING_OFF + 73728 + 32768);
    if ((int)blockIdx.x < 192) {
        { float cv[16];
#pragma unroll
          for (int j = 0; j < 16; ++j) cv[j] = F.c[F.tid + 512 * j];
#pragma unroll
          for (int j = 0; j < 16; ++j) cond[F.tid + 512 * j] = cv[j] / (1.f + expf(-cv[j])); }
        __syncthreads();
        for (int item = blockIdx.x; item < 192; item += F.G) {
            const int l = item / 96, j0 = (item % 96) * 64;
            float acc[8];
#pragma unroll
            for (int b = 0; b < 8; ++b) acc[b] = 0.f;
            const float* w = F.w_ada + (size_t)l * DM * MODW + (size_t)(F.wave * 128) * MODW + j0 + F.lane;
#pragma unroll 4
            for (int k = 0; k < 128; ++k) { const float wv = w[(size_t)k * MODW];
#pragma unroll
                for (int b = 0; b < 8; ++b) acc[b] += cond[b * 1024 + F.wave * 128 + k] * wv; }
#pragma unroll
            for (int b = 0; b < 8; ++b) part[(F.wave * 8 + b) * 64 + F.lane] = acc[b];
            __syncthreads();
            { const int b = F.tid >> 6, ln = F.tid & 63; float s = 0.f;
#pragma unroll
                for (int w8 = 0; w8 < 8; ++w8) s += part[(w8 * 8 + b) * 64 + ln];
                const float mv = s + F.b_ada[l * MODW + j0 + ln]; ST4(&F.mod[(size_t)(l * 8 + b) * MODW + j0 + ln], mv); }
            __syncthreads();
        }
    }
    if ((int)blockIdx.x == F.G - 1 && F.tid < 2) { const int l = F.tid; float s1 = 0.f, s2 = 0.f;
        for (int i = 0; i < 64; ++i) { s1 += F.lq1[l * 64 + i] * F.lk1[l * 64 + i]; s2 += F.lq2[l * 64 + i] * F.lk2[l * 64 + i]; }
        const float li = 0.8f - 0.6f * expf(-0.3f * (float)l);
        F.mod[2 * 8 * MODW + l] = expf(s1) - expf(s2) + li; F.mod[2 * 8 * MODW + 2 + l] = li; }
    if ((int)blockIdx.x == F.G - 2) {
        float* dt = F.mod + 2 * 8 * MODW + 16;
        for (int i = F.tid; i < 1024; i += NWAVES * 64) { const int hh = i >> 7, pp = i & 127; const double gm = 1.0 - exp2(-5.0 - (double)hh);
            dt[i] = (float)(0.125 * pow(gm, (double)(pp - 127))); dt[1024 + i] = (float)pow(gm, (double)(127 - pp)); if (pp == 0) dt[2048 + hh] = (float)pow(gm, 128.0); }
    }
    for (int idx = blockIdx.x * (NWAVES * 64) + F.tid; idx < 4096 * 32; idx += F.G * NWAVES * 64) { const int pos = idx >> 5, i = idx & 31;
        const double inv = pow(10000.0, -(double)(2 * i) / 64.0), a = (double)pos * inv; F.rot[2 * idx] = (float)cos(a); F.rot[2 * idx + 1] = (float)sin(a); }
    const int gw = F.vcu * NWAVES + F.wave, NGW = F.G * NWAVES;
    for (int it = gw; it < (DEFER_W1 ? 1 : 2) * IT_LAYER; it += NGW) p0_weight_item(F, it, scr);
}
__device__ __forceinline__ void ln_mod_row(const float* xrow, const float* sh_, bf16* orow, int lane) {
    const GAS f32x4* xr = (const GAS f32x4*)xrow + lane;
    f32x4 v[4]; float s = 0.f;
#pragma unroll
    for (int j = 0; j < 4; ++j) { v[j] = xr[64 * j]; s += (v[j].x + v[j].y) + (v[j].z + v[j].w); }
    const float mean = wave_sum(s) * (1.f / DM); float s2 = 0.f;
#pragma unroll
    for (int j = 0; j < 4; ++j) { v[j] = v[j] - mean; s2 += (v[j].x * v[j].x + v[j].y * v[j].y) + (v[j].z * v[j].z + v[j].w * v[j].w); }
    const float rstd = 1.f / sqrtf(wave_sum(s2) * (1.f / DM) + LN_EPS);
    const GAS f32x4* sh = (const GAS f32x4*)sh_ + lane; const GAS f32x4* sc = sh + 256; GAS u32x2* o = (GAS u32x2*)orow + lane;
#pragma unroll
    for (int j = 0; j < 4; ++j) { const f32x4 a = sh[64 * j], m = sc[64 * j]; const f32x4 r = v[j] * rstd * (m + 1.f) + a; u32x2 w; w.x = pk2(r.x, r.y); w.y = pk2(r.z, r.w); ST8(&o[64 * j], w); }
}
__device__ __forceinline__ void ln_mod_regs(f32x4 (&v)[4], const float* sh_, bf16* orow, int lane) {
    float s = 0.f;
#pragma unroll
    for (int j = 0; j < 4; ++j) s += (v[j].x + v[j].y) + (v[j].z + v[j].w);
    const float mean = wave_sum(s) * (1.f / DM); float s2 = 0.f;
#pragma unroll
    for (int j = 0; j < 4; ++j) { v[j] = v[j] - mean; s2 += (v[j].x * v[j].x + v[j].y * v[j].y) + (v[j].z * v[j].z + v[j].w * v[j].w); }
    const float rstd = 1.f / sqrtf(wave_sum(s2) * (1.f / DM) + LN_EPS);
    const GAS f32x4* sh = (const GAS f32x4*)sh_ + lane; const GAS f32x4* sc = sh + 256; GAS u32x2* o = (GAS u32x2*)orow + lane;
    f32x4 a[4], mm[4];
#pragma unroll
    for (int j = 0; j < 4; ++j) { a[j] = sh[64 * j]; mm[j] = sc[64 * j]; }
#pragma unroll
    for (int j = 0; j < 4; ++j) { const f32x4 r = v[j] * rstd * (mm[j] + 1.f) + a[j]; u32x2 w; w.x = pk2(r.x, r.y); w.y = pk2(r.z, r.w); ST8(&o[64 * j], w); }
}
__device__ __forceinline__ void ph_ln0(Frame& F) {
    const int gw = F.vcu * NWAVES + F.wave, NGW = F.G * NWAVES;
#pragma unroll 1
    for (int m = gw; m < T; m += 2 * NGW) { int lane = F.lane; asm volatile("" : "+v"(lane));
        const int m2 = m + NGW;
        const GAS f32x4* xa = (const GAS f32x4*)(F.x + (size_t)m * DM) + lane; const GAS f32x4* xb = (const GAS f32x4*)(F.x + (size_t)m2 * DM) + lane;
        f32x4 va[4], vb[4];
#pragma unroll
        for (int j = 0; j < 4; ++j) { va[j] = xa[64 * j]; vb[j] = xb[64 * j]; }
        ln_mod_regs(va, F.mod + (size_t)(m / SEQ) * MODW, F.S1 + (size_t)m * DM, lane);
        ln_mod_regs(vb, F.mod + (size_t)(m2 / SEQ) * MODW, F.S1 + (size_t)m2 * DM, lane); }
}
__device__ __forceinline__ float sane_c(float v) { return (fabsf(v) < 1e4f) ? v : 0.f; }
__device__ __forceinline__ void ph_combine(Frame& F, int l) {
    const int gw = F.vcu * NWAVES + F.wave, NGW = F.G * NWAVES, lane = F.lane;
    const float lam = F.mod[2 * 8 * MODW + l], li = F.mod[2 * 8 * MODW + 2 + l];
#if ATTN128
    const int h = lane >> 4, q = lane & 15, vh0 = (h * 2 + 0) * 2, vh1 = (h * 2 + 1) * 2, d = 8 * q;
#else
    const int h = lane >> 4, q = lane & 15, vh0 = (h * 2 + 0) * 2 + (q >> 3), vh1 = (h * 2 + 1) * 2 + (q >> 3), d = 8 * (q & 7);
#endif
    const f32x4 g0 = *(const f32x4*)(F.subln + l * 128 + 8 * q), g1 = *(const f32x4*)(F.subln + l * 128 + 8 * q + 4);
#pragma unroll 1
    for (int m0 = gw; m0 < T; m0 += 2 * NGW) {
        u32x4 av[2], bv[2];
#pragma unroll
        for (int t = 0; t < 2; ++t) { const int m = m0 + t * NGW; av[t] = *(const GAS u32x4*)(F.S3 + (size_t)m * DM + vh0 * 64 + d); bv[t] = *(const GAS u32x4*)(F.S3 + (size_t)m * DM + vh1 * 64 + d); }
#pragma unroll
        for (int t = 0; t < 2; ++t) { const int m = m0 + t * NGW; const u32x4 a = av[t], b = bv[t];
        float v[8];
        v[0] = __uint_as_float(a.x << 16) - lam * __uint_as_float(b.x << 16); v[1] = __uint_as_float(a.x & 0xffff0000u) - lam * __uint_as_float(b.x & 0xffff0000u);
        v[2] = __uint_as_float(a.y << 16) - lam * __uint_as_float(b.y << 16); v[3] = __uint_as_float(a.y & 0xffff0000u) - lam * __uint_as_float(b.y & 0xffff0000u);
        v[4] = __uint_as_float(a.z << 16) - lam * __uint_as_float(b.z << 16); v[5] = __uint_as_float(a.z & 0xffff0000u) - lam * __uint_as_float(b.z & 0xffff0000u);
        v[6] = __uint_as_float(a.w << 16) - lam * __uint_as_float(b.w << 16); v[7] = __uint_as_float(a.w & 0xffff0000u) - lam * __uint_as_float(b.w & 0xffff0000u);
#pragma unroll
        for (int i = 0; i < 8; ++i) v[i] = sane_c(v[i]);
        float ss = 0.f;
#pragma unroll
        for (int i = 0; i < 8; ++i) ss += v[i] * v[i];
        ss = row16_sum(ss);
        const float r = (1.f - li) / sqrtf(ss * (1.f / 128.f) + LN_EPS);
        u32x4 w; w.x = pk2(v[0] * r * g0.x, v[1] * r * g0.y); w.y = pk2(v[2] * r * g0.z, v[3] * r * g0.w); w.z = pk2(v[4] * r * g1.x, v[5] * r * g1.y); w.w = pk2(v[6] * r * g1.z, v[7] * r * g1.w);
        *(GAS u32x4*)(F.S1 + (size_t)m * DM + 512 + h * 128 + 8 * q) = w; }
    }
}
__device__ __forceinline__ f32x4 bf4(u32x2 m) { f32x4 r; r.x = __uint_as_float(m.x << 16); r.y = __uint_as_float(m.x & 0xffff0000u); r.z = __uint_as_float(m.y << 16); r.w = __uint_as_float(m.y & 0xffff0000u); return r; }
__device__ __forceinline__ float sane(float v, float lim) { return (fabsf(v) < lim) ? v : 0.f; }
__device__ __forceinline__ f32x4 sane4(f32x4 v, float lim) { v.x = sane(v.x, lim); v.y = sane(v.y, lim); v.z = sane(v.z, lim); v.w = sane(v.w, lim); return v; }
#ifndef X2_BF16
#define X2_BF16 1
#endif
struct PmRaw { f32x4 x[4]; u32x2 xb[4]; u32x2 m[4]; };
template <bool XBF>
__device__ __forceinline__ void pm_load(PmRaw& R, const void* xin, const bf16* MIXED, int row, int lane) {
    const GAS u32x2* mr = (const GAS u32x2*)(MIXED + (size_t)row * DM) + lane;
    if (XBF) { const GAS u32x2* xr = (const GAS u32x2*)((const bf16*)xin + (size_t)row * DM) + lane;
#pragma unroll
        for (int j = 0; j < 4; ++j) { R.xb[j] = xr[64 * j]; R.m[j] = mr[64 * j]; }
    } else { const GAS f32x4* xr = (const GAS f32x4*)((const float*)xin + (size_t)row * DM) + lane;
#pragma unroll
        for (int j = 0; j < 4; ++j) { R.x[j] = xr[64 * j]; R.m[j] = mr[64 * j]; } }
}
template <bool XBF>
__device__ __forceinline__ void pm_row(const PmRaw& R, const f32x4 (&g1)[4], const f32x4 (&lg)[4], const f32x4 (&lb)[4], const f32x4 (&sc2)[4], const f32x4 (&sh2)[4],
                                       bf16* X1, bf16* H, const LAS float* rwT, LAS float* lgs, int row, int r, int lane, bool norouter) {
    f32x4 v[4];
    float s = 0.f;
#pragma unroll
    for (int j = 0; j < 4; ++j) { v[j] = (XBF ? sane4(bf4(R.xb[j]), 1e4f) : R.x[j]) * ALPHA + g1[j] * sane4(bf4(R.m[j]), 1e4f); s += (v[j].x + v[j].y) + (v[j].z + v[j].w); }
    float mean = wave_sum(s) * (1.f / DM), s2 = 0.f;
#pragma unroll
    for (int j = 0; j < 4; ++j) { v[j] = v[j] - mean; s2 += (v[j].x * v[j].x + v[j].y * v[j].y) + (v[j].z * v[j].z + v[j].w * v[j].w); }
    float rstd = 1.f / sqrtf(wave_sum(s2) * (1.f / DM) + LN_EPS);
    GAS u32x2* xo = (GAS u32x2*)(X1 + (size_t)row * DM) + lane; s = 0.f;
#pragma unroll
    for (int j = 0; j < 4; ++j) { v[j] = v[j] * rstd * lg[j] + lb[j];
        u32x2 w; w.x = pk2(v[j].x, v[j].y); w.y = pk2(v[j].z, v[j].w); ST8(&xo[64 * j], w); s += (v[j].x + v[j].y) + (v[j].z + v[j].w); }
    mean = wave_sum(s) * (1.f / DM); s2 = 0.f;
#pragma unroll
    for (int j = 0; j < 4; ++j) { v[j] = v[j] - mean; s2 += (v[j].x * v[j].x + v[j].y * v[j].y) + (v[j].z * v[j].z + v[j].w * v[j].w); }
    rstd = 1.f / sqrtf(wave_sum(s2) * (1.f / DM) + LN_EPS);
    GAS u32x2* ho = (GAS u32x2*)(H + (size_t)row * DM) + lane;
#pragma unroll
    for (int j = 0; j < 4; ++j) { v[j] = v[j] * rstd * (sc2[j] + 1.f) + sh2[j]; u32x2 w; w.x = pk2(v[j].x, v[j].y); w.y = pk2(v[j].z, v[j].w); ST8(&ho[64 * j], w); }
    if (norouter) return;
    float a[16];
#pragma unroll
    for (int e = 0; e < 16; ++e) {
        float s0 = 0.f;
#pragma unroll
        for (int j = 0; j < 4; ++j) { const f32x4 w4 = *(const LAS f32x4*)(rwT + e * 1024 + 4 * lane + 256 * j); s0 += (v[j].x * w4.x + v[j].y * w4.y) + (v[j].z * w4.z + v[j].w * w4.w); }
        a[e] = s0;
    }
    const bool h5 = (lane & 32) != 0, h4 = (lane & 16) != 0, h3 = (lane & 8) != 0, h2 = (lane & 4) != 0;
    float c8[8], d4[4], f2[2];
#define PX32(x) ([&]() { auto rr_ = __builtin_amdgcn_permlane32_swap(__float_as_uint(x), __float_as_uint(x), false, false); return __uint_as_float(h5 ? rr_[0] : rr_[1]); }())
#define PX16(x) ([&]() { auto rr_ = __builtin_amdgcn_permlane16_swap(__float_as_uint(x), __float_as_uint(x), false, false); return __uint_as_float(h4 ? rr_[0] : rr_[1]); }())
#define PDPP(x, ctrl) __builtin_bit_cast(float, __builtin_amdgcn_update_dpp(0, __builtin_bit_cast(int, (x)), (ctrl), 0xf, 0xf, false))
#pragma unroll
    for (int i = 0; i < 8; ++i) { const float mine = h5 ? a[8 + i] : a[i], send = h5 ? a[i] : a[8 + i]; c8[i] = mine + PX32(send); }
#pragma unroll
    for (int i = 0; i < 4; ++i) { const float mine = h4 ? c8[4 + i] : c8[i], send = h4 ? c8[i] : c8[4 + i]; d4[i] = mine + PX16(send); }
#pragma unroll
    for (int i = 0; i < 2; ++i) { const float mine = h3 ? d4[2 + i] : d4[i], send = h3 ? d4[i] : d4[2 + i]; f2[i] = mine + PDPP(send, 0x128); }
    float gsum; { const float mine = h2 ? f2[1] : f2[0], send = h2 ? f2[0] : f2[1]; gsum = mine + PDPP(send, 0x141); }
    gsum += PDPP(gsum, 0x4E); gsum += PDPP(gsum, 0xB1);
#undef PX32
#undef PX16
#undef PDPP
    if ((lane & 3) == 0) lgs[r * 16 + (lane >> 2)] = gsum;
}
#ifndef DRY_SKIP
#define DRY_SKIP 0
#endif
template <bool XBF>
__device__ __forceinline__ void ph_postmix_t(Frame& F, int l, bool dry) {
    LAS float* rwT = (LAS float*)(F.lds + RING_OFF);
    LAS float* lgs = (LAS float*)(F.lds + RING_OFF + 65536) + F.wave * 256;
    LAS int* lcnt = (LAS int*)(F.lds + LCNT_OFF);
    const void* xin = (const void*)(l == 0 ? F.x : F.out); const float* modl     = F.mod + (size_t)l * 8 * MODW; int* cnt = (int*)F.ctl + CW_CNT + 64 * l;
    const float* lng = F.ln_mix_g + l * DM; const float* lnb = F.ln_mix_b + l * DM; const int lane = F.lane;
    const bool norouter = dry && (DRY_SKIP & 1);
    { f32x4 t4[8];
#pragma unroll
      for (int j = 0; j < 8; ++j) t4[j] = ((const GAS f32x4*)F.router_w)[F.tid + 512 * j];
#pragma unroll
      for (int j = 0; j < 8; ++j) { const int i4 = F.tid + 512 * j, k = i4 >> 2, e0 = (i4 & 3) * 4; rwT[(e0 + 0) * 1024 + k] = t4[j].x; rwT[(e0 + 1) * 1024 + k] = t4[j].y; rwT[(e0 + 2) * 1024 + k] = t4[j].z; rwT[(e0 + 3) * 1024 + k] = t4[j].w; } }
#pragma unroll 1
    for (int base = blockIdx.x * 128; base < T; base += F.G * 128) {
        if (F.tid < 16) lcnt[F.tid] = 0;
        __syncthreads();
        const int b = base / SEQ, wrow = base + F.wave * 16;
        f32x4 g1[4], lg[4], lb[4], sc2[4], sh2[4];
        { const GAS f32x4* g1p = (const GAS f32x4*)(modl + (size_t)b * MODW + 2 * DM) + lane; const GAS f32x4* lgp = (const GAS f32x4*)lng + lane; const GAS f32x4* lbp = (const GAS f32x4*)lnb + lane;
#pragma unroll
          for (int j = 0; j < 4; ++j) { g1[j] = g1p[64 * j]; sh2[j] = g1p[256 + 64 * j]; sc2[j] = g1p[512 + 64 * j]; lg[j] = lgp[64 * j]; lb[j] = lbp[64 * j]; } }
        PmRaw A, B, C;
        pm_load<XBF>(A, xin, F.MIXED, wrow, lane); pm_load<XBF>(B, xin, F.MIXED, wrow + 1, lane);
#pragma unroll 1
        for (int it = 0; it < 5; ++it) {
            const int r0 = 3 * it;
            pm_load<XBF>(C, xin, F.MIXED, wrow + r0 + 2, lane);
            pm_row<XBF>(A, g1, lg, lb, sc2, sh2, F.S3, F.S1, rwT, lgs, wrow + r0, r0, lane, norouter);
            pm_load<XBF>(A, xin, F.MIXED, wrow + r0 + 3, lane);
            pm_row<XBF>(B, g1, lg, lb, sc2, sh2, F.S3, F.S1, rwT, lgs, wrow + r0 + 1, r0 + 1, lane, norouter);
            if (it < 4) pm_load<XBF>(B, xin, F.MIXED, wrow + r0 + 4, lane);
            pm_row<XBF>(C, g1, lg, lb, sc2, sh2, F.S3, F.S1, rwT, lgs, wrow + r0 + 2, r0 + 2, lane, norouter);
        }
        pm_row<XBF>(A, g1, lg, lb, sc2, sh2, F.S3, F.S1, rwT, lgs, wrow + 15, 15, lane, norouter);
        LDS_WAIT(); asm volatile("" ::: "memory");
        int my_e1 = 0, my_e2 = 0, my_l1 = 0, my_l2 = 0;
        if (lane < 16) {
            float p[16];
#pragma unroll
            for (int q = 0; q < 4; ++q) { const f32x4 t = *(const LAS f32x4*)(lgs + lane * 16 + 4 * q); p[4 * q] = t.x; p[4 * q + 1] = t.y; p[4 * q + 2] = t.z; p[4 * q + 3] = t.w; }
            float mx = -INFINITY, sum = 0.f;
#pragma unroll
            for (int e = 0; e < 16; ++e) { p[e] += F.router_b[e]; mx = fmaxf(mx, p[e]); }
#pragma unroll
            for (int e = 0; e < 16; ++e) { p[e] = expf(p[e] - mx); sum += p[e]; }
            const float rs = 1.f / sum;
#pragma unroll
            for (int e = 0; e < 16; ++e) p[e] *= rs;
            int bg = 0; float bgs = -1.f;
#pragma unroll
            for (int g = 0; g < 4; ++g) { float m1 = p[4 * g]; int i1 = 0;
#pragma unroll
                for (int i = 1; i < 4; ++i) if (p[4 * g + i] > m1) { m1 = p[4 * g + i]; i1 = i; }
                float m2 = -1.f;
#pragma unroll
                for (int i = 0; i < 4; ++i) if (i != i1 && p[4 * g + i] > m2) m2 = p[4 * g + i];
                const float gs = m1 + m2; if (gs > bgs) { bgs = gs; bg = g; } }
            float q0 = 0.f, q1 = 0.f, q2 = 0.f, q3 = 0.f;
#pragma unroll
            for (int g = 0; g < 4; ++g) if (bg == g) { q0 = p[4 * g]; q1 = p[4 * g + 1]; q2 = p[4 * g + 2]; q3 = p[4 * g + 3]; }
            float m1 = q0; int i1 = 0; if (q1 > m1) { m1 = q1; i1 = 1; } if (q2 > m1) { m1 = q2; i1 = 2; } if (q3 > m1) { m1 = q3; i1 = 3; }
            float m2 = -1.f; int i2 = 0;
            if (i1 != 0 && q0 > m2) { m2 = q0; i2 = 0; } if (i1 != 1 && q1 > m2) { m2 = q1; i2 = 1; } if (i1 != 2 && q2 > m2) { m2 = q2; i2 = 2; } if (i1 != 3 && q3 > m2) { m2 = q3; i2 = 3; }
            my_e1 = bg * 4 + i1; my_e2 = bg * 4 + i2; const int row = wrow + lane; const float den = 1.f / (m1 + m2);
            my_l1 = __hip_atomic_fetch_add(lcnt + my_e1, 1, __ATOMIC_RELAXED, __HIP_MEMORY_SCOPE_WORKGROUP); my_l2 = __hip_atomic_fetch_add(lcnt + my_e2, 1, __ATOMIC_RELAXED, __HIP_MEMORY_SCOPE_WORKGROUP);
            const float gw1 = m1 * den, gw2 = m2 * den; ST4(&F.tok_e[2 * row], my_e1); ST4(&F.tok_e[2 * row + 1], my_e2); ST4(&F.tok_g[2 * row], gw1); ST4(&F.tok_g[2 * row + 1], gw2);
        }
        __syncthreads();
        if (F.tid < 16 && !dry) lcnt[16 + F.tid] = atomicAdd(cnt + F.tid, lcnt[F.tid]);
        __syncthreads();
        if (lane < 16 && !dry) { const int row = wrow + lane, s1 = lcnt[16 + my_e1] + my_l1, s2 = lcnt[16 + my_e2] + my_l2;
            ST4(&F.tok_slot[2 * row], s1); ST4(&F.tok_slot[2 * row + 1], s2); ST4(&F.lists[(size_t)my_e1 * T + s1], row); ST4(&F.lists[(size_t)my_e2 * T + s2], row); }
        __syncthreads();
    }
}
__device__ __forceinline__ void ph_postmix(Frame& F, int l, bool dry = false) { if (X2_BF16 && l > 0) ph_postmix_t<true>(F, l, dry); else ph_postmix_t<false>(F, l, dry); }
__device__ __forceinline__ void moe_table(Frame& F, int l) {
    LAS int* tab = (LAS int*)(F.lds + TAB_OFF); LAS int* eb = (LAS int*)(F.lds + EB_OFF); const int* cnt = (const int*)F.ctl + CW_CNT + 64 * l;
    __syncthreads();
    if (F.tid < 272 || F.tid == 511) {
        int pref = 0, mine = -1;
#pragma unroll
        for (int e = 0; e < 16; ++e) { const int n = __hip_atomic_load(cnt + e, RLX_AGENT), nt = (n + 255) >> 8; if (F.tid < 272 && F.tid >= pref && F.tid < pref + nt) mine = e | ((F.tid - pref) << 8);
            if (F.tid == 511) eb[e] = pref * 256; pref += nt; }
        if (F.tid < 272) tab[1 + F.tid] = mine;
        if (F.tid == 511) tab[0] = pref;
    }
    __syncthreads();
}
struct PfRaw { u32x2 x[4], y0[4], y1[4]; };
__device__ __forceinline__ void pf_load(PfRaw& R, const bf16* X1, const bf16* YP, int row, size_t r0, size_t r1, int lane) {
    const GAS u32x2* xr = (const GAS u32x2*)(X1 + (size_t)row * DM) + lane; const GAS u32x2* y0 = (const GAS u32x2*)(YP + r0 * DM) + lane; const GAS u32x2* y1 = (const GAS u32x2*)(YP + r1 * DM) + lane;
#pragma unroll
    for (int j = 0; j < 4; ++j) { R.x[j] = xr[64 * j]; R.y0[j] = y0[64 * j]; R.y1[j] = y1[64 * j]; }
}
template <bool NEXT>
__device__ __forceinline__ void pf_row(const PfRaw& R, float w0, float w1, const f32x4 (&g2)[4], const f32x4 (&lg)[4], const f32x4 (&lb)[4], const f32x4 (&sh)[4], const f32x4 (&sc)[4], float* out, bf16* X2b, bf16* H, int row, int lane, bool store_h) {
    f32x4 v[4]; float s = 0.f;
#pragma unroll
    for (int j = 0; j < 4; ++j) { v[j] = sane4(bf4(R.x[j]), 1e4f) * ALPHA + g2[j] * sane4(bf4(R.y0[j]) * w0 + bf4(R.y1[j]) * w1, 1e4f);
        s += (v[j].x + v[j].y) + (v[j].z + v[j].w); }
    float mean = wave_sum(s) * (1.f / DM), s2 = 0.f;
#pragma unroll
    for (int j = 0; j < 4; ++j) { v[j] = v[j] - mean; s2 += (v[j].x * v[j].x + v[j].y * v[j].y) + (v[j].z * v[j].z + v[j].w * v[j].w); }
    float rstd = 1.f / sqrtf(wave_sum(s2) * (1.f / DM) + LN_EPS);
    GAS f32x4* o = (GAS f32x4*)(out + (size_t)row * DM) + lane; s = 0.f;
    GAS u32x2* ob = (GAS u32x2*)(X2b + (size_t)row * DM) + lane;
#pragma unroll
    for (int j = 0; j < 4; ++j) { v[j] = v[j] * rstd * lg[j] + lb[j];
        if (X2_BF16 && store_h) { u32x2 w; w.x = pk2(v[j].x, v[j].y); w.y = pk2(v[j].z, v[j].w); ST8(&ob[64 * j], w); } else o[64 * j] = v[j];
        s += (v[j].x + v[j].y) + (v[j].z + v[j].w); }
    if (NEXT) {
        mean = wave_sum(s) * (1.f / DM); s2 = 0.f;
#pragma unroll
        for (int j = 0; j < 4; ++j) { v[j] = v[j] - mean; s2 += (v[j].x * v[j].x + v[j].y * v[j].y) + (v[j].z * v[j].z + v[j].w * v[j].w); }
        rstd = 1.f / sqrtf(wave_sum(s2) * (1.f / DM) + LN_EPS);
        GAS u32x2* ho = (GAS u32x2*)(H + (size_t)row * DM) + lane;
#pragma unroll
        for (int j = 0; j < 4; ++j) { const f32x4 r = v[j] * rstd * (sc[j] + 1.f) + sh[j]; u32x2 w; w.x = pk2(r.x, r.y); w.y = pk2(r.z, r.w); if (store_h) ST8(&ho[64 * j], w); }
    }
}
template <bool NEXT>
__device__ __forceinline__ void ph_postffn_t(Frame& F, int l) {
    const LAS int* eb = (const LAS int*)(F.lds + EB_OFF); const float* modl = F.mod + (size_t)l * 8 * MODW; const float* modn = F.mod + (size_t)(l + 1 < DEPTH ? l + 1 : l) * 8 * MODW;
    const float* lng = F.ln_ffn_g + l * DM; const float* lnb = F.ln_ffn_b + l * DM; const int lane = F.lane;
#pragma unroll 1
    for (int base = (F.vcu * NWAVES + F.wave) * 16; base < T; base += F.G * NWAVES * 16) {
        const int b = base / SEQ;
        const int mrow = base + (lane & 15);
        const int e0 = F.tok_e[2 * mrow], e1 = F.tok_e[2 * mrow + 1]; const float mw0 = F.tok_g[2 * mrow], mw1 = F.tok_g[2 * mrow + 1];
        const int mr0 = eb[e0] + F.tok_slot[2 * mrow], mr1 = eb[e1] + F.tok_slot[2 * mrow + 1];
        f32x4 g2[4], lg[4], lb[4], sh[4], sc[4];
        { const GAS f32x4* g2p = (const GAS f32x4*)(modl + (size_t)b * MODW + 5 * DM) + lane; const GAS f32x4* lgp = (const GAS f32x4*)lng + lane; const GAS f32x4* lbp = (const GAS f32x4*)lnb + lane;
          const GAS f32x4* shp = (const GAS f32x4*)(modn + (size_t)b * MODW) + lane;
#pragma unroll
          for (int j = 0; j < 4; ++j) { g2[j] = g2p[64 * j]; lg[j] = lgp[64 * j]; lb[j] = lbp[64 * j]; if (NEXT) { sh[j] = shp[64 * j]; sc[j] = shp[256 + 64 * j]; } else { sh[j] = (f32x4){0.f, 0.f, 0.f, 0.f}; sc[j] = sh[j]; } } }
        PfRaw A, B;
#define PF_LOAD2(R, r) pf_load(R, F.S3, F.YP, base + (r), (size_t)__builtin_amdgcn_readlane(mr0, (r)), (size_t)__builtin_amdgcn_readlane(mr1, (r)), lane)
#define PF_ROW2(R, r) pf_row<NEXT>(R, __builtin_bit_cast(float, __builtin_amdgcn_readlane(__builtin_bit_cast(int, mw0), (r))), __builtin_bit_cast(float, __builtin_amdgcn_readlane(__builtin_bit_cast(int, mw1), (r))), g2, lg, lb, sh, sc, F.out, (bf16*)F.out, F.S1, base + (r), lane, l + 1 < DEPTH)
        PF_LOAD2(A, 0);
#pragma unroll 1
        for (int it = 0; it < 8; ++it) {
            PF_LOAD2(B, 2 * it + 1);
            PF_ROW2(A, 2 * it);
            if (it < 7) PF_LOAD2(A, 2 * it + 2);
            PF_ROW2(B, 2 * it + 1);
        }
#undef PF_LOAD2
#undef PF_ROW2
    }
}
#ifndef PF_ALWAYS_NEXT
#define PF_ALWAYS_NEXT 1
#endif
__device__ __forceinline__ void ph_postffn(Frame& F, int l) { if (PF_ALWAYS_NEXT || l + 1 < DEPTH) ph_postffn_t<true>(F, l); else ph_postffn_t<false>(F, l); }

typedef __attribute__((address_space(4))) const unsigned char* kaptr_t;
__device__ __forceinline__ void frame_ptrs(Frame& F, kaptr_t ka) {
#define KA_IN(i) (*(const float* __attribute__((address_space(4))) const*)(ka + 8 * (i)))
    F.x = KA_IN(0); F.c = KA_IN(1); F.w_ada = KA_IN(2); F.b_ada = KA_IN(3); F.w_in = KA_IN(4); F.w_out = KA_IN(5); F.lq1 = KA_IN(6); F.lk1 = KA_IN(7); F.lq2 = KA_IN(8); F.lk2 = KA_IN(9);
    F.subln = KA_IN(10); F.ln_mix_g = KA_IN(11); F.ln_mix_b = KA_IN(12); F.ln_ffn_g = KA_IN(13); F.ln_ffn_b = KA_IN(14); F.router_w = KA_IN(15); F.router_b = KA_IN(16);
    F.w_gate = KA_IN(17); F.w_up = KA_IN(18); F.w_down = KA_IN(19);
    F.out = *(float* __attribute__((address_space(4))) const*)(ka + 160);
    unsigned char* ws = *(unsigned char* __attribute__((address_space(4))) const*)(ka + 168);
#undef KA_IN
    F.ws = ws; F.ctl = (gu32*)(ws + WS_CTL);
    F.mod = (float*)(ws + WS_MOD); F.rot = (float*)(ws + WS_ROT); F.tok_e = (int*)(ws + WS_TOK); F.tok_g = (float*)(ws + WS_TOK + 256 * 1024); F.tok_slot = (int*)(ws + WS_TOK + 512 * 1024);
    F.lists = (int*)(ws + WS_LIST); F.Wbf = (bf16*)(ws + WS_W);
    F.S1 = (bf16*)(ws + WS_S1); F.S3 = (bf16*)(ws + WS_S3); F.PROJ = (bf16*)(ws + WS_S2); F.YP = (bf16*)(ws + WS_YP); F.HE = (bf16*)(ws + WS_HE); F.MIXED = (bf16*)(ws + WS_MIXED);
}
struct Args { const float* in[20]; float* out; unsigned char* ws; int ph_lo, ph_hi, li, pad; };
__global__ void __launch_bounds__(NWAVES * 64, 2) mega(Args args) {
    extern __shared__ __attribute__((aligned(16))) unsigned char lds[];
    Frame F;
    F.lds = (LAS unsigned char*)lds; F.MISC = (volatile LAS unsigned*)(F.lds + MISC_OFF);
    F.tid = threadIdx.x; F.lane = F.tid & 63; F.wave = __builtin_amdgcn_readfirstlane(F.tid >> 6);
    F.G = gridDim.x; { const int bx = blockIdx.x; F.vcu = (F.G % 8 == 0) ? (bx % 8) * (F.G / 8) + bx / 8 : bx; }
    F.ctl = (gu32*)(args.ws + WS_CTL);
    for (int u = F.tid; u < (LDS_BYTES - LDSCTL_OFF) / 4; u += NWAVES * 64) ((LAS unsigned*)(F.lds + LDSCTL_OFF))[u] = 0u;
    __syncthreads();
    const int lo = args.ph_lo, hi = args.ph_hi;
    XcdBarrier bar; bar.bar = (unsigned*)(F.ctl + CW_BAR) + args.li * XCD_BAR_WORDS; bar.x = 0; bar.st = nullptr;
    if (hi - lo > 1) bar = xcd_barrier_post((unsigned*)(F.ctl + CW_BAR) + args.li * XCD_BAR_WORDS, F.MISC + 8);
#ifndef KIND_MASK
#define KIND_MASK 0x3ffu
#endif
#define KEN(k) ((KIND_MASK >> (k)) & 1u)
#ifndef REP_KIND
#define REP_KIND -1
#endif
#ifndef REP_N
#define REP_N 1
#endif
#define REPS(k) for (int rep_ = 0; rep_ < ((REP_KIND == (k)) ? REP_N : 1); ++rep_)
#define IN(k) (lo <= (k) && (k) < hi)
#define FRESH() do { int t_ = threadIdx.x; asm volatile("" : "+v"(t_)); F.tid = t_; F.lane = t_ & 63; kaptr_t ka_ = (kaptr_t)__builtin_amdgcn_kernarg_segment_ptr(); asm volatile("" : "+s"(ka_)); frame_ptrs(F, ka_); } while (0)
#ifndef BAR_REP
#define BAR_REP 1
#endif
#define SEAM(k) do { if (IN(k) && IN((k) + 1)) for (int br_ = 0; br_ < BAR_REP; ++br_) xcd_barrier(bar); } while (0)

    if (KEN(8) && IN(0)) REPS(8) { FRESH(); ph_prologue(F); } SEAM(0);
    if (KEN(9) && IN(1)) REPS(9) { FRESH(); ph_ln0(F); } SEAM(1);
    for (int l = 0; l < DEPTH; ++l) {
        const int pb = 2 + 8 * l;
#define wl (F.Wbf + (size_t)l * WL_STRIDE)
        if (KEN(0) && IN(pb + 0)) REPS(0) { FRESH();
            pg8::PlainSched S; S.init(T / 256, INW / 256, F.G, (int)blockIdx.x); S.Bt = wl + WL_IN; S.K = DM;
#ifndef ROT_EXP
#define ROT_EXP 0
#endif
            pg8::EpiInProj E{F.PROJ, F.rot, RET_FAST ? F.mod + 2 * 8 * MODW + 16 : nullptr, (ROT_EXP && rep_ > 0) ? F.S3 : nullptr};
            pg8::gemm_phase<pg8::EpiInProj, pg8::PlainSched, true>(F.lds + RING_OFF, (const char*)F.S1, DM, S, E);
        }
        SEAM(pb + 0);
        if (KEN(1) && IN(pb + 1)) REPS(1) { FRESH();
            if (RET_FAST) REPS(10) { const int bh = F.vcu >> 2, hh = bh & 7; ret::ret_unit(bh >> 3, hh, F.vcu & 3, F.PROJ, F.S1, F.mod[2 * 8 * MODW + 16 + 2048 + hh], F.lds + RING_OFF); }
#if ATTN128
            { const int bhc = F.vcu >> 2, b = bhc >> 3, hc = bhc & 7, h = hc >> 1, c = hc & 1, s = F.vcu & 3;
              const attn128::bf16* base = (const attn128::bf16*)(F.PROJ + (size_t)b * SEQ * INW);
#pragma unroll 1
              for (int i = 0; i < 4; ++i) { const int qb = i == 0 ? s : i == 1 ? 7 - s : i == 2 ? 8 + s : 15 - s;
                  #ifdef ATTN_DRY
                  if (rep_ + 1 < REP_N) attn128::attn_unit<ATTN_THRL, ATTN_DRY>(qb, base + C_DQ + h * 128 + c * 64, base + C_DK + h * 128 + c * 64, base + C_DV + h * 128,
                                        (attn128::bf16*)(F.S3 + (size_t)b * SEQ * DM + hc * 128), (char*)lds + RING_OFF); else
#endif
                  attn128::attn_unit<ATTN_THRL>(qb, base + C_DQ + h * 128 + c * 64, base + C_DK + h * 128 + c * 64, base + C_DV + h * 128,
                                        (attn128::bf16*)(F.S3 + (size_t)b * SEQ * DM + hc * 128), (char*)lds + RING_OFF); } }
        }
#else
            const int pr = F.vcu >> 1, b = pr >> 4, vh = pr & 15, h = vh >> 2, c = (vh >> 1) & 1, vhalf = vh & 1;
            const attn_body::bf16* base = (const attn_body::bf16*)(F.PROJ + (size_t)b * SEQ * INW);
#pragma unroll 1
            for (int i = 0; i < 8; ++i) { const int s = 2 * (i >> 1) + (F.vcu & 1), qb = (i & 1) ? 15 - s : s;
                attn_body::attn_unit<8>(qb, base + C_DQ + h * 128 + c * 64, base + C_DK + h * 128 + c * 64, base + C_DV + h * 128 + vhalf * 64,
                                        (attn_body::bf16*)(F.S3 + (size_t)b * SEQ * DM + vh * 64), (char*)lds + RING_OFF); }
        }
#endif
        SEAM(pb + 1);
        if (KEN(2) && IN(pb + 2)) REPS(2) { FRESH(); ph_combine(F, l); }
        SEAM(pb + 2);
        if (KEN(3) && IN(pb + 3)) REPS(3) { FRESH();
            pg8::PlainSched S; S.init(T / 256, DM / 256, F.G, (int)blockIdx.x); S.Bt = wl + WL_OUT; S.K = DM;
            pg8::EpiPlain E{F.MIXED, DM};
#ifdef EPI_DRY
            if (rep_ + 1 < REP_N) { pg8::EpiNone E0; pg8::gemm_phase<pg8::EpiNone, pg8::PlainSched, true>(F.lds + RING_OFF, (const char*)F.S1, DM, S, E0); } else
#endif
            pg8::gemm_phase<pg8::EpiPlain, pg8::PlainSched, true>(F.lds + RING_OFF, (const char*)F.S1, DM, S, E);
        }
        SEAM(pb + 3);
        if (KEN(4) && IN(pb + 4)) REPS(4) { FRESH(); ph_postmix(F, l, rep_ > 0); }
        SEAM(pb + 4);
#ifndef MOE_MODE
#define MOE_MODE 1
#endif
#define MOE_SCHED(S_, mode_) pg8::MoeMk<mode_> S_; S_.nMt = ((const LAS int*)(F.lds + TAB_OFF))[0]; S_.n1 = S_.nMt * 4; S_.c = (int)blockIdx.x; S_.l = l; S_.ldsb = F.lds; S_.Wgu = wl + WL_GU; S_.Wd = wl + WL_D; S_.ctl = F.ctl;
#if MOE_MODE == 2 || (defined(GU_WT) && GU_WT)
#define EPI_GU pg8::EpiGateUpWT
#else
#define EPI_GU pg8::EpiGateUp
#endif
#define MOE_STAGE_TOKS(S_) do { LAS int* toks_ = (LAS int*)(F.lds + TOKS_OFF); const int* cnt_ = (const int*)F.ctl + CW_CNT + 64 * l; \
            _Pragma("unroll 1") for (int i_ = 0; i_ < TOKS_UNITS; ++i_) { pg8::MUnit u_; if (!S_.next(i_, u_) || u_.kind != 0) break; const int pm_ = __builtin_amdgcn_readfirstlane(u_.pm); \
                if (F.tid < 256) { const int te_ = S_.tab()[1 + pm_], e_ = te_ & 255, s_ = (te_ >> 8) * 256 + F.tid, n_ = cnt_[e_]; toks_[i_ * 256 + F.tid] = F.lists[(size_t)e_ * T + (s_ < n_ ? s_ : 0)]; } } \
            __syncthreads(); } while (0)
        if (KEN(5) && IN(pb + 5)) REPS(5) {
            FRESH(); moe_table(F, l);
#if MOE_MODE == 0
            pg8::MoeSched S; S.init(((const LAS int*)(F.lds + TAB_OFF))[0], 4, F.G, (int)blockIdx.x); S.Bt = wl + WL_GU; S.K = DM; S.tab = (const LAS int*)(F.lds + TAB_OFF);
            S.cnt = (const int*)F.ctl + CW_CNT + 64 * l; S.lists = F.lists; S.gather = true;
            pg8::EpiGateUp E{F.HE};
            pg8::gemm_phase<pg8::EpiGateUp, pg8::MoeSched, true>(F.lds + RING_OFF, (const char*)F.S1, DM, S, E);
#else
            MOE_SCHED(S, MOE_MODE == 2 ? 2 : 0); MOE_STAGE_TOKS(S);
            EPI_GU E0{F.HE}; pg8::EpiPlain E1{F.YP, DM};
            pg8::gemm_phase_mk<pg8::MoeMk<(MOE_MODE == 2 ? 2 : 0)>, EPI_GU, pg8::EpiPlain>(F.lds + RING_OFF, (const char*)F.ws, S, E0, E1);
#endif
        }
#if MOE_MODE != 2
        SEAM(pb + 5);
#endif
        if (KEN(6) && IN(pb + 6)) REPS(6) {
#if MOE_MODE == 0
            FRESH(); moe_table(F, l);
            pg8::MoeSched S; S.init(((const LAS int*)(F.lds + TAB_OFF))[0], 4, F.G, (int)blockIdx.x); S.Bt = wl + WL_D; S.K = DE; S.tab = (const LAS int*)(F.lds + TAB_OFF);
            S.cnt = (const int*)F.ctl + CW_CNT + 64 * l; S.lists = F.lists; S.gather = false;
            pg8::EpiPlain E{F.YP, DM};
            pg8::gemm_phase<pg8::EpiPlain, pg8::MoeSched, true>(F.lds + RING_OFF, (const char*)F.HE, DE, S, E);
#elif MOE_MODE == 1
            FRESH(); moe_table(F, l);
            MOE_SCHED(S, 1);
            EPI_GU E0{F.HE}; pg8::EpiPlain E1{F.YP, DM};
            pg8::gemm_phase_mk<pg8::MoeMk<1>, EPI_GU, pg8::EpiPlain>(F.lds + RING_OFF, (const char*)F.ws, S, E0, E1);
#endif
        }
        SEAM(pb + 6);
        if (KEN(7) && IN(pb + 7)) REPS(7) { FRESH(); moe_table(F, l); if (DEFER_W1 && l == 0) { deferred_weights(F, 4 * ((const LAS int*)(F.lds + TAB_OFF))[0], 2); } ph_postffn(F, l); }
        SEAM(pb + 7);
#undef wl
#undef MOE_SCHED
#undef MOE_STAGE_TOKS
    }
#undef IN
#undef SEAM
}
#ifndef FAST_MASK
#define FAST_MASK 0x3ffffu
#endif
extern "C" void kernel_launch(void* const* d_in, const int* in_sizes, int n_in, void* d_out, int out_size, void* d_ws, size_t ws_size, hipStream_t stream) {
    static int grid = 0;
    if (grid == 0) {
        if (n_in != 20 || out_size != T * DM || ws_size < WS_END) { fprintf(stderr, "kernel_launch: unexpected shapes (n_in %d out %d ws %zu)\n", n_in, out_size, ws_size); grid = -1; return; }
        int dev = 0, cus = 0, per_cu = 0;
        if (hipGetDevice(&dev) != hipSuccess || hipDeviceGetAttribute(&cus, hipDeviceAttributeMultiprocessorCount, dev) != hipSuccess) { grid = -1; return; }
        if (hipFuncSetAttribute((const void*)mega, hipFuncAttributeMaxDynamicSharedMemorySize, LDS_BYTES) != hipSuccess) { fprintf(stderr, "kernel_launch: hipFuncSetAttribute failed\n"); grid = -1; return; }
        if (hipOccupancyMaxActiveBlocksPerMultiprocessor(&per_cu, (const void*)mega, NWAVES * 64, LDS_BYTES) != hipSuccess || per_cu < 1) fprintf(stderr, "kernel_launch: occupancy query says %d\n", per_cu);
        (void)hipGetLastError();
        grid = cus;
        if (grid != 256) { fprintf(stderr, "kernel_launch: built for 256 CUs, found %d\n", grid); grid = -1; return; }
    }
    if (grid < 0) return;
    const float* x = (const float*)d_in[0];
    const float* w_in = (const float*)d_in[4]; const float* w_out = (const float*)d_in[5];
    const float* subln = (const float*)d_in[10]; const float* ln_mix_g = (const float*)d_in[11]; const float* ln_mix_b = (const float*)d_in[12];
    const float* ln_ffn_g = (const float*)d_in[13]; const float* ln_ffn_b = (const float*)d_in[14]; const float* router_w = (const float*)d_in[15]; const float* router_b = (const float*)d_in[16];
    const float* w_gate = (const float*)d_in[17]; const float* w_up = (const float*)d_in[18]; const float* w_down = (const float*)d_in[19];
    unsigned char* ws = (unsigned char*)d_ws; float* out = (float*)d_out;
    float* mod = (float*)(ws + WS_MOD); float* rot = (float*)(ws + WS_ROT);
    int* tok_e = (int*)(ws + WS_TOK); float* tok_g = (float*)(ws + WS_TOK + 256 * 1024); int* tok_slot = (int*)(ws + WS_TOK + 512 * 1024); int* lists = (int*)(ws + WS_LIST);
    bf16* S1 = (bf16*)(ws + WS_S1); bf16* X1 = (bf16*)(ws + WS_S3); bf16* PROJ = (bf16*)(ws + WS_S2); bf16* YP = (bf16*)(ws + WS_YP); bf16* HE = (bf16*)(ws + WS_HE); bf16* MIXED = (bf16*)(ws + WS_MIXED);
    int* ctl = (int*)(ws + WS_CTL);
    (void)hipMemsetAsync(ws + WS_CTL, 0, 1 * MiB, stream);
    Args a{};
    for (int i = 0; i < 20; ++i) a.in[i] = (const float*)d_in[i];
    a.out = out; a.ws = ws;
    int li = 0, lo = -1;
    auto flush = [&](int hi) { if (lo >= 0) { a.ph_lo = lo; a.ph_hi = hi; a.li = li++; hipLaunchKernelGGL(mega, dim3(grid), dim3(NWAVES * 64), LDS_BYTES, stream, a); lo = -1; } };
    for (int p = 0; p < NPHASE; ++p) {
        const bool fast = (FAST_MASK >> p) & 1u;
        const int l = p < 2 ? 0 : (p - 2) / 8, k = p < 2 ? -1 : (p - 2) % 8;
        const float* modl = mod + (size_t)l * 8 * MODW; int* cnt = ctl + CW_CNT + 64 * l;
        if (fast) { if (lo < 0) lo = p; }
        else {
            flush(p);
            if (p == 0) { k_mod<<<dim3(MODW / 256, 2), 256, 0, stream>>>((const float*)d_in[1], (const float*)d_in[2], (const float*)d_in[3], (const float*)d_in[6], (const float*)d_in[7], (const float*)d_in[8], (const float*)d_in[9], mod);
                          k_rot<<<512, 256, 0, stream>>>(rot); }
            else if (p == 1) k_ln_mod<<<T / 4, 256, 0, stream>>>(x, mod, 0, S1);
            else if (k == 0) k_ngemm_inproj<<<dim3(INW / 64, T / 128), 256, 0, stream>>>(S1, w_in + (size_t)l * DM * INW, rot, PROJ);
            else if (k == 1) k_ndiff<<<dim3(SEQ / 64, 4, NB), 256, 0, stream>>>(PROJ, mod + 2 * 8 * MODW, subln, l, S1);
            else if (k == 2) {   }
            else if (k == 3) k_ngemm_plain<<<dim3(DM / 64, T / 128), 256, 0, stream>>>(S1, DM, w_out + (size_t)l * DM * DM, DM, DM, MIXED, DM);
            else if (k == 4) k_post_mix<<<T / 4, 256, 0, stream>>>(l == 0 ? x : out, MIXED, modl, ln_mix_g + l * DM, ln_mix_b + l * DM, router_w, router_b, X1, S1, tok_e, tok_g, tok_slot, lists, cnt);
            else if (k == 5) k_moe1<<<dim3(DE / 64, T / 128, NE), 256, 0, stream>>>(S1, w_gate + (size_t)l * NE * DM * DE, w_up + (size_t)l * NE * DM * DE, cnt, lists, HE);
            else if (k == 6) k_moe2<<<dim3(DM / 64, T / 128, NE), 256, 0, stream>>>(HE, w_down + (size_t)l * NE * DE * DM, cnt, YP);
            else if (k == 7) k_post_ffn<<<T / 4, 256, 0, stream>>>(X1, YP, modl, ln_ffn_g + l * DM, ln_ffn_b + l * DM, tok_e, tok_g, tok_slot, cnt, out, l + 1 < DEPTH ? mod + (size_t)(l + 1) * 8 * MODW : nullptr, S1);
        }
        if (!RET_FAST && k == 2) { flush(p + 1); k_nret<<<dim3(SEQ / 64, 8, NB), 256, 0, stream>>>(PROJ, S1); }
    }
    flush(NPHASE);
}
```

```cpp
#include <hip/hip_runtime.h>
#include <cstdio>
#include <cstdint>
#include <cmath>

typedef unsigned short bf16;
typedef float f32x4 __attribute__((ext_vector_type(4)));
typedef unsigned u32x4 __attribute__((ext_vector_type(4)));
typedef unsigned u32x2 __attribute__((ext_vector_type(2)));

constexpr int NB = 8, SEQ = 4096, DM = 1024, T = NB * SEQ, DEPTH = 2;
constexpr int INW = 3584, NE = 16, DE = 512;
constexpr int C_RQ = 0, C_RK = 512, C_RV = 1024, C_RG = 1536, C_DQ = 2048, C_DK = 2560, C_DV = 3072;
constexpr float ALPHA = 1.41421356237309515f;
constexpr float LN_EPS = 1e-5f;
constexpr float C2 = 0.125f * 1.4426950408889634f;
constexpr int MODW = 6 * DM;
constexpr int PAIR_ROWS = 69632;

constexpr size_t MiB = 1u << 20;
constexpr size_t WS_CTL = 0;
constexpr size_t WS_MOD = 1 * MiB;
constexpr size_t WS_ROT = 2 * MiB;
constexpr size_t WS_TOK = 3 * MiB;
constexpr size_t WS_LIST = 4 * MiB;
constexpr size_t WS_W = 8 * MiB;
constexpr size_t WS_S1 = 122 * MiB;
constexpr size_t WS_S3 = 186 * MiB;
constexpr size_t WS_S2 = 250 * MiB;
constexpr size_t WS_YP = WS_S2, WS_HE = WS_S2 + 136 * MiB, WS_MIXED = WS_HE;
constexpr size_t WS_END = 474 * MiB;
constexpr int CW_CNT = 64;

__device__ __forceinline__ float bf2f(bf16 v) { return __uint_as_float((unsigned)v << 16); }
__device__ __forceinline__ unsigned f2bf(float f) { unsigned u = __float_as_uint(f); return (u + 0x7fffu + ((u >> 16) & 1u)) >> 16; }
typedef float pk_f32x2_t __attribute__((ext_vector_type(2))); typedef __bf16 pk_bf16x2_t __attribute__((ext_vector_type(2)));
__device__ __forceinline__ unsigned pk2(float lo, float hi) { pk_f32x2_t v = {lo, hi}; pk_bf16x2_t b = __builtin_convertvector(v, pk_bf16x2_t); return __builtin_bit_cast(unsigned, b); }
__device__ __forceinline__ float dpp_add(float v, const int ctrl_tag) { return v; }
#define WS_DPP(v, ctrl) ((v) + __builtin_bit_cast(float, __builtin_amdgcn_update_dpp(0, __builtin_bit_cast(int, (v)), (ctrl), 0xf, 0xf, false)))
__device__ __forceinline__ float wave_sum(float v) {
    v = WS_DPP(v, 0xB1);
    v = WS_DPP(v, 0x4E);
    v = WS_DPP(v, 0x141);
    v = WS_DPP(v, 0x140);
    { auto rr = __builtin_amdgcn_permlane16_swap(__float_as_uint(v), __float_as_uint(v), false, false); v = __uint_as_float(rr[0]) + __uint_as_float(rr[1]); }
    { auto rr = __builtin_amdgcn_permlane32_swap(__float_as_uint(v), __float_as_uint(v), false, false); v = __uint_as_float(rr[0]) + __uint_as_float(rr[1]); }
    return v;
}
__device__ __forceinline__ float row16_sum(float v) {
    v = WS_DPP(v, 0xB1); v = WS_DPP(v, 0x4E); v = WS_DPP(v, 0x141); v = WS_DPP(v, 0x140); return v;
}
__device__ __forceinline__ float silu_f(float v) { return v / (1.f + __expf(-v)); }

__global__ void __launch_bounds__(256) k_mod(const float* c, const float* w_ada, const float* b_ada, const float* lq1, const float* lk1, const float* lq2, const float* lk2, float* mod) {
    __shared__ float cond[8][1024];
    const int l = blockIdx.y, j = blockIdx.x * 256 + threadIdx.x;
    for (int i = threadIdx.x; i < 8192; i += 256) { const float v = c[i]; cond[i >> 10][i & 1023] = v / (1.f + expf(-v)); }
    __syncthreads();
    float acc[8];
#pragma unroll
    for (int b = 0; b < 8; ++b) acc[b] = 0.f;
    const float* w = w_ada + (size_t)l * 1024 * MODW + j;
    for (int k = 0; k < 1024; ++k) { const float wv = w[(size_t)k * MODW];
#pragma unroll
        for (int b = 0; b < 8; ++b) acc[b] += cond[b][k] * wv; }
#pragma unroll
    for (int b = 0; b < 8; ++b) mod[(size_t)(l * 8 + b) * MODW + j] = acc[b] + b_ada[l * MODW + j];
    if (blockIdx.x == 0 && threadIdx.x == 0) {
        float s1 = 0.f, s2 = 0.f;
        for (int i = 0; i < 64; ++i) { s1 += lq1[l * 64 + i] * lk1[l * 64 + i]; s2 += lq2[l * 64 + i] * lk2[l * 64 + i]; }
        const float li = 0.8f - 0.6f * expf(-0.3f * (float)l);
        mod[2 * 8 * MODW + l] = expf(s1) - expf(s2) + li;
        mod[2 * 8 * MODW + 2 + l] = li;
    }
}
__global__ void k_rot(float* rot) {
    const int idx = blockIdx.x * 256 + threadIdx.x; if (idx >= 4096 * 32) return;
    const int pos = idx >> 5, i = idx & 31;
    const double inv = pow(10000.0, -(double)(2 * i) / 64.0), a = (double)pos * inv;
    rot[2 * idx] = (float)cos(a); rot[2 * idx + 1] = (float)sin(a);
}

__global__ void __launch_bounds__(256) k_ln_mod(const float* x, const float* modl, int sh_off, bf16* H) {
    const int row = blockIdx.x * 4 + (threadIdx.x >> 6), lane = threadIdx.x & 63, b = row / SEQ;
    const f32x4* xr = (const f32x4*)(x + (size_t)row * DM) + lane;
    f32x4 v[4]; float s = 0.f;
#pragma unroll
    for (int j = 0; j < 4; ++j) { v[j] = xr[64 * j]; s += (v[j].x + v[j].y) + (v[j].z + v[j].w); }
    const float mean = wave_sum(s) * (1.f / DM); float s2 = 0.f;
#pragma unroll
    for (int j = 0; j < 4; ++j) { v[j] = v[j] - mean; s2 += (v[j].x * v[j].x + v[j].y * v[j].y) + (v[j].z * v[j].z + v[j].w * v[j].w); }
    const float rstd = 1.f / sqrtf(wave_sum(s2) * (1.f / DM) + LN_EPS);
    const f32x4* sh = (const f32x4*)(modl + (size_t)b * MODW + sh_off) + lane; const f32x4* sc = sh + 256;
    u32x2* o = (u32x2*)(H + (size_t)row * DM) + lane;
#pragma unroll
    for (int j = 0; j < 4; ++j) { const f32x4 a = sh[64 * j], m = sc[64 * j]; const f32x4 r = v[j] * rstd * (m + 1.f) + a; u32x2 w; w.x = pk2(r.x, r.y); w.y = pk2(r.z, r.w); o[64 * j] = w; }
}

template <bool DUAL>
__device__ __forceinline__ void ngemm_core(const bf16* arow, const float* W0, const float* W1, int ldw, int K, float (&acc0)[8][4], float (&acc1)[8][4], float* As, float* Ws0, float* Ws1) {
    const int tid = threadIdx.x, tx = tid & 15, ty = tid >> 4;
#pragma unroll
    for (int i = 0; i < 8; ++i)
#pragma unroll
        for (int j = 0; j < 4; ++j) { acc0[i][j] = 0.f; acc1[i][j] = 0.f; }
    const int ar = tid >> 1, ak = (tid & 1) * 8, wk = tid >> 4, wn = (tid & 15) * 4;
    for (int k0 = 0; k0 < K; k0 += 16) {
        const u32x4 av = *(const u32x4*)(arow + k0);
        const f32x4 w0 = *(const f32x4*)(W0 + (size_t)(k0 + wk) * ldw + wn);
        f32x4 w1 = {0.f, 0.f, 0.f, 0.f}; if (DUAL) w1 = *(const f32x4*)(W1 + (size_t)(k0 + wk) * ldw + wn);
        __syncthreads();
        As[(ak + 0) * 129 + ar] = __uint_as_float(av.x << 16); As[(ak + 1) * 129 + ar] = __uint_as_float(av.x & 0xffff0000u);
        As[(ak + 2) * 129 + ar] = __uint_as_float(av.y << 16); As[(ak + 3) * 129 + ar] = __uint_as_float(av.y & 0xffff0000u);
        As[(ak + 4) * 129 + ar] = __uint_as_float(av.z << 16); As[(ak + 5) * 129 + ar] = __uint_as_float(av.z & 0xffff0000u);
        As[(ak + 6) * 129 + ar] = __uint_as_float(av.w << 16); As[(ak + 7) * 129 + ar] = __uint_as_float(av.w & 0xffff0000u);
        *(f32x4*)(Ws0 + wk * 64 + wn) = w0; if (DUAL) *(f32x4*)(Ws1 + wk * 64 + wn) = w1;
        __syncthreads();
#pragma unroll
        for (int k = 0; k < 16; ++k) {
            float a[8], b0[4], b1[4];
#pragma unroll
            for (int i = 0; i < 8; ++i) a[i] = As[k * 129 + ty + 16 * i];
#pragma unroll
            for (int j = 0; j < 4; ++j) { b0[j] = Ws0[k * 64 + tx + 16 * j]; if (DUAL) b1[j] = Ws1[k * 64 + tx + 16 * j]; }
#pragma unroll
            for (int i = 0; i < 8; ++i)
#pragma unroll
                for (int j = 0; j < 4; ++j) { acc0[i][j] += a[i] * b0[j]; if (DUAL) acc1[i][j] += a[i] * b1[j]; }
        }
    }
}

__global__ void __launch_bounds__(256) k_ngemm_inproj(const bf16* H, const float* Win, const float* rot, bf16* PROJ) {
    __shared__ float As[16 * 129], Ws0[16 * 64];
    const int tid = threadIdx.x, tx = tid & 15, ty = tid >> 4, col0 = blockIdx.x * 64, row0 = blockIdx.y * 128;
    float acc[8][4], dummy[8][4];
    ngemm_core<false>(H + (size_t)(row0 + (tid >> 1)) * DM + (tid & 1) * 8, Win + col0, nullptr, INW, DM, acc, dummy, As, Ws0, nullptr);
    const int region = col0 / 512;
#pragma unroll
    for (int i = 0; i < 8; ++i) {
        const int row = row0 + ty + 16 * i, pos = row % SEQ; bf16* o = PROJ + (size_t)row * INW + col0;
        if (region < 2) {
            const float sc = region == 0 ? 0.125f : 1.f;
#pragma unroll
            for (int j = 0; j < 2; ++j) { const int ic = tx + 16 * j; const float cs = rot[(pos * 32 + ic) * 2], sn = rot[(pos * 32 + ic) * 2 + 1];
                const float x1 = acc[i][j], x2 = acc[i][j + 2]; o[ic] = (bf16)f2bf((x1 * cs - x2 * sn) * sc); o[ic + 32] = (bf16)f2bf((x1 * sn + x2 * cs) * sc); }
        } else {
#pragma unroll
            for (int j = 0; j < 4; ++j) { float v = acc[i][j]; if (region == 3) v = silu_f(v); if (region == 4) v *= C2; o[tx + 16 * j] = (bf16)f2bf(v); }
        }
    }
}
__global__ void __launch_bounds__(256) k_ngemm_plain(const bf16* A, int lda, const float* W, int ldw, int K, bf16* C, int ldc) {
    __shared__ float As[16 * 129], Ws0[16 * 64];
    const int tid = threadIdx.x, tx = tid & 15, ty = tid >> 4, col0 = blockIdx.x * 64, row0 = blockIdx.y * 128;
    float acc[8][4], dummy[8][4];
    ngemm_core<false>(A + (size_t)(row0 + (tid >> 1)) * lda + (tid & 1) * 8, W + col0, nullptr, ldw, K, acc, dummy, As, Ws0, nullptr);
#pragma unroll
    for (int i = 0; i < 8; ++i)
#pragma unroll
        for (int j = 0; j < 4; ++j) C[(size_t)(row0 + ty + 16 * i) * ldc + col0 + tx + 16 * j] = (bf16)f2bf(acc[i][j]);
}

__global__ void __launch_bounds__(256) k_nret(const bf16* PROJ, bf16* CAT) {
    __shared__ float Qs[64 * 65], Ks[64 * 65], Vs[64 * 64], st[128]; float* Ss = Ks;
    const int tid = threadIdx.x, tx = tid & 15, ty = tid >> 4;
    const int qt = (gridDim.x - 1) - blockIdx.x, h = blockIdx.y, b = blockIdx.z, q0 = qt * 64;
    const float log_g = logf(1.f - exp2f(-5.f - (float)h));
    const bf16* base = PROJ + (size_t)b * SEQ * INW;
    for (int i = tid; i < 64 * 64; i += 256) { const int r = i >> 6, d = i & 63; Qs[r * 65 + d] = bf2f(base[(size_t)(q0 + r) * INW + C_RQ + h * 64 + d]); }
    float o[4][4];
#pragma unroll
    for (int i = 0; i < 4; ++i)
#pragma unroll
        for (int j = 0; j < 4; ++j) o[i][j] = 0.f;
    for (int kt = 0; kt <= qt; ++kt) {
        const int k0 = kt * 64;
        __syncthreads();
        for (int i = tid; i < 64 * 64; i += 256) { const int r = i >> 6, d = i & 63; Ks[r * 65 + d] = bf2f(base[(size_t)(k0 + r) * INW + C_RK + h * 64 + d]); Vs[r * 64 + d] = bf2f(base[(size_t)(k0 + r) * INW + C_RV + h * 64 + d]); }
        __syncthreads();
        float s[4][4];
#pragma unroll
        for (int i = 0; i < 4; ++i)
#pragma unroll
            for (int j = 0; j < 4; ++j) s[i][j] = 0.f;
        for (int d = 0; d < 64; ++d) { float a[4], k[4];
#pragma unroll
            for (int i = 0; i < 4; ++i) { a[i] = Qs[(ty + 16 * i) * 65 + d]; k[i] = Ks[(tx + 16 * i) * 65 + d]; }
#pragma unroll
            for (int i = 0; i < 4; ++i)
#pragma unroll
                for (int j = 0; j < 4; ++j) s[i][j] += a[i] * k[j]; }
        __syncthreads();
#pragma unroll
        for (int i = 0; i < 4; ++i)
#pragma unroll
            for (int j = 0; j < 4; ++j) { const int t = q0 + ty + 16 * i, m = k0 + tx + 16 * j; Ss[(ty + 16 * i) * 65 + tx + 16 * j] = (m <= t) ? s[i][j] * expf(log_g * (float)(t - m)) : 0.f; }
        __syncthreads();
        for (int m = 0; m < 64; ++m) { float p[4], v[4];
#pragma unroll
            for (int i = 0; i < 4; ++i) { p[i] = Ss[(ty + 16 * i) * 65 + m]; v[i] = Vs[m * 64 + tx + 16 * i]; }
#pragma unroll
            for (int i = 0; i < 4; ++i)
#pragma unroll
                for (int j = 0; j < 4; ++j) o[i][j] += p[i] * v[j]; }
    }
    __syncthreads();
#pragma unroll
    for (int i = 0; i < 4; ++i)
#pragma unroll
        for (int j = 0; j < 4; ++j) Ss[(ty + 16 * i) * 65 + tx + 16 * j] = o[i][j];
    __syncthreads();
    if (tid < 64) { float s = 0.f; for (int d = 0; d < 64; ++d) s += Ss[tid * 65 + d]; const float mean = s * (1.f / 64.f); float q = 0.f; for (int d = 0; d < 64; ++d) { const float e = Ss[tid * 65 + d] - mean; q += e * e; }
        st[tid] = mean; st[64 + tid] = 1.f / sqrtf(q * (1.f / 64.f) + LN_EPS); }
    __syncthreads();
#pragma unroll
    for (int i = 0; i < 4; ++i)
#pragma unroll
        for (int j = 0; j < 4; ++j) { const int r = ty + 16 * i, cc = tx + 16 * j; const size_t row = (size_t)b * SEQ + q0 + r;
            const float g = bf2f(PROJ[row * INW + C_RG + h * 64 + cc]);
            CAT[row * DM + h * 64 + cc] = (bf16)f2bf((o[i][j] - st[r]) * st[64 + r] * g); }
}

__global__ void __launch_bounds__(256) k_ndiff(const bf16* PROJ, const float* modx  , const float* subln, int l, bf16* CAT) {
    __shared__ float Qs[64 * 65], Ks[32 * 65], Vs[32 * 128], Ps[64 * 33], mrow[64], lrow[64], srow[64];
    const int tid = threadIdx.x, tx = tid & 15, ty = tid >> 4;
    const int qt = (gridDim.x - 1) - blockIdx.x, h = blockIdx.y, b = blockIdx.z, q0 = qt * 64;
    const float lam = modx[l], li = modx[2 + l];
    const bf16* base = PROJ + (size_t)b * SEQ * INW;
    float res[4][8];
    for (int c = 0; c < 2; ++c) {
        __syncthreads();
        for (int i = tid; i < 64 * 64; i += 256) { const int r = i >> 6, d = i & 63; Qs[r * 65 + d] = bf2f(base[(size_t)(q0 + r) * INW + C_DQ + h * 128 + c * 64 + d]); }
        if (tid < 64) { mrow[tid] = -INFINITY; lrow[tid] = 0.f; }
        float o[4][8];
#pragma unroll
        for (int i = 0; i < 4; ++i)
#pragma unroll
            for (int j = 0; j < 8; ++j) o[i][j] = 0.f;
        const int nkt = (q0 + 64) / 32;
        for (int kt = 0; kt < nkt; ++kt) {
            const int k0 = kt * 32;
            __syncthreads();
            for (int i = tid; i < 32 * 64; i += 256) { const int r = i >> 6, d = i & 63; Ks[r * 65 + d] = bf2f(base[(size_t)(k0 + r) * INW + C_DK + h * 128 + c * 64 + d]); }
            for (int i = tid; i < 32 * 128; i += 256) { const int r = i >> 7, d = i & 127; Vs[r * 128 + d] = bf2f(base[(size_t)(k0 + r) * INW + C_DV + h * 128 + d]); }
            __syncthreads();
            float s[4][2];
#pragma unroll
            for (int i = 0; i < 4; ++i) { s[i][0] = 0.f; s[i][1] = 0.f; }
            for (int d = 0; d < 64; ++d) { float a[4], k[2];
#pragma unroll
                for (int i = 0; i < 4; ++i) a[i] = Qs[(ty + 16 * i) * 65 + d];
                k[0] = Ks[tx * 65 + d]; k[1] = Ks[(tx + 16) * 65 + d];
#pragma unroll
                for (int i = 0; i < 4; ++i) { s[i][0] += a[i] * k[0]; s[i][1] += a[i] * k[1]; } }
#pragma unroll
            for (int i = 0; i < 4; ++i)
#pragma unroll
                for (int j = 0; j < 2; ++j) { const int t = q0 + ty + 16 * i, m = k0 + tx + 16 * j; Ps[(ty + 16 * i) * 33 + tx + 16 * j] = (m <= t) ? s[i][j] : -INFINITY; }
            __syncthreads();
            if (tid < 64) { float mx = mrow[tid]; for (int m = 0; m < 32; ++m) mx = fmaxf(mx, Ps[tid * 33 + m]);
                const float sc = exp2f(mrow[tid] - mx); float sum = 0.f;
                for (int m = 0; m < 32; ++m) { const float p = exp2f(Ps[tid * 33 + m] - mx); Ps[tid * 33 + m] = p; sum += p; }
                lrow[tid] = lrow[tid] * sc + sum; mrow[tid] = mx; srow[tid] = sc; }
            __syncthreads();
#pragma unroll
            for (int i = 0; i < 4; ++i) { const float sc = srow[ty + 16 * i];
#pragma unroll
                for (int j = 0; j < 8; ++j) o[i][j] *= sc; }
            for (int m = 0; m < 32; ++m) { float p[4], v[8];
#pragma unroll
                for (int i = 0; i < 4; ++i) p[i] = Ps[(ty + 16 * i) * 33 + m];
#pragma unroll
                for (int j = 0; j < 8; ++j) v[j] = Vs[m * 128 + tx + 16 * j];
#pragma unroll
                for (int i = 0; i < 4; ++i)
#pragma unroll
                    for (int j = 0; j < 8; ++j) o[i][j] += p[i] * v[j]; }
        }
        __syncthreads();
#pragma unroll
        for (int i = 0; i < 4; ++i) { const float inv = 1.f / lrow[ty + 16 * i];
#pragma unroll
            for (int j = 0; j < 8; ++j) { if (c == 0) res[i][j] = o[i][j] * inv; else res[i][j] -= lam * o[i][j] * inv; } }
    }
    __syncthreads();
#pragma unroll
    for (int i = 0; i < 4; ++i) { float q = 0.f;
#pragma unroll
        for (int j = 0; j < 8; ++j) q += res[i][j] * res[i][j];
        Ps[(ty + 16 * i) * 33 + tx] = q; }
    __syncthreads();
    if (tid < 64) { float q = 0.f; for (int m = 0; m < 16; ++m) q += Ps[tid * 33 + m]; srow[tid] = 1.f / sqrtf(q * (1.f / 128.f) + LN_EPS); }
    __syncthreads();
#pragma unroll
    for (int i = 0; i < 4; ++i)
#pragma unroll
        for (int j = 0; j < 8; ++j) { const int r = ty + 16 * i, cc = tx + 16 * j; const size_t row = (size_t)b * SEQ + q0 + r;
            CAT[row * DM + 512 + h * 128 + cc] = (bf16)f2bf(res[i][j] * srow[r] * subln[l * 128 + cc] * (1.f - li)); }
}

__global__ void __launch_bounds__(256) k_post_mix(const float* xin, const bf16* MIXED, const float* modl, const float* lng, const float* lnb, const float* rw, const float* rb,
                                                  bf16* X1, bf16* H, int* tok_e, float* tok_g, int* tok_slot, int* lists, int* cnt) {
    const int row = blockIdx.x * 4 + (threadIdx.x >> 6), lane = threadIdx.x & 63, b = row / SEQ;
    const f32x4* xr = (const f32x4*)(xin + (size_t)row * DM) + lane; const u32x2* mr = (const u32x2*)(MIXED + (size_t)row * DM) + lane;
    const f32x4* g1 = (const f32x4*)(modl + (size_t)b * MODW + 2 * DM) + lane; const f32x4* sh2 = g1 + 256; const f32x4* sc2 = g1 + 512;
    f32x4 v[4]; float s = 0.f;
#pragma unroll
    for (int j = 0; j < 4; ++j) { const f32x4 x = xr[64 * j], g = g1[64 * j]; const u32x2 m = mr[64 * j];
        f32x4 mv; mv.x = __uint_as_float(m.x << 16); mv.y = __uint_as_float(m.x & 0xffff0000u); mv.z = __uint_as_float(m.y << 16); mv.w = __uint_as_float(m.y & 0xffff0000u);
        v[j] = x * ALPHA + g * mv; s += (v[j].x + v[j].y) + (v[j].z + v[j].w); }
    float mean = wave_sum(s) * (1.f / DM), s2 = 0.f;
#pragma unroll
    for (int j = 0; j < 4; ++j) { v[j] = v[j] - mean; s2 += (v[j].x * v[j].x + v[j].y * v[j].y) + (v[j].z * v[j].z + v[j].w * v[j].w); }
    float rstd = 1.f / sqrtf(wave_sum(s2) * (1.f / DM) + LN_EPS);
    u32x2* xo = (u32x2*)(X1 + (size_t)row * DM) + lane; s = 0.f;
#pragma unroll
    for (int j = 0; j < 4; ++j) { const f32x4 g = ((const f32x4*)lng)[lane + 64 * j], bb = ((const f32x4*)lnb)[lane + 64 * j]; v[j] = v[j] * rstd * g + bb;
        u32x2 w; w.x = pk2(v[j].x, v[j].y); w.y = pk2(v[j].z, v[j].w); xo[64 * j] = w; s += (v[j].x + v[j].y) + (v[j].z + v[j].w); }
    mean = wave_sum(s) * (1.f / DM); s2 = 0.f;
#pragma unroll
    for (int j = 0; j < 4; ++j) { v[j] = v[j] - mean; s2 += (v[j].x * v[j].x + v[j].y * v[j].y) + (v[j].z * v[j].z + v[j].w * v[j].w); }
    rstd = 1.f / sqrtf(wave_sum(s2) * (1.f / DM) + LN_EPS);
    u32x2* ho = (u32x2*)(H + (size_t)row * DM) + lane;
    float lg[16];
#pragma unroll
    for (int e = 0; e < 16; ++e) lg[e] = 0.f;
#pragma unroll
    for (int j = 0; j < 4; ++j) { const f32x4 a = sh2[64 * j], m = sc2[64 * j]; v[j] = v[j] * rstd * (m + 1.f) + a;
        u32x2 w; w.x = pk2(v[j].x, v[j].y); w.y = pk2(v[j].z, v[j].w); ho[64 * j] = w;
        const f32x4* wr = (const f32x4*)(rw + (size_t)(4 * lane + 256 * j) * 16);
#pragma unroll
        for (int q = 0; q < 4; ++q) { const float hv = q == 0 ? v[j].x : q == 1 ? v[j].y : q == 2 ? v[j].z : v[j].w;
#pragma unroll
            for (int e4 = 0; e4 < 4; ++e4) { const f32x4 w4 = wr[q * 4 + e4]; lg[e4 * 4 + 0] += hv * w4.x; lg[e4 * 4 + 1] += hv * w4.y; lg[e4 * 4 + 2] += hv * w4.z; lg[e4 * 4 + 3] += hv * w4.w; } } }
    float mx = -INFINITY;
#pragma unroll
    for (int e = 0; e < 16; ++e) { lg[e] = wave_sum(lg[e]) + rb[e]; mx = fmaxf(mx, lg[e]); }
    float p[16], sum = 0.f;
#pragma unroll
    for (int e = 0; e < 16; ++e) { p[e] = expf(lg[e] - mx); sum += p[e]; }
    const float rs = 1.f / sum;
#pragma unroll
    for (int e = 0; e < 16; ++e) p[e] *= rs;
    int bg = 0; float bgs = -1.f;
#pragma unroll
    for (int g = 0; g < 4; ++g) { float m1 = p[4 * g]; int i1 = 0;
#pragma unroll
        for (int i = 1; i < 4; ++i) if (p[4 * g + i] > m1) { m1 = p[4 * g + i]; i1 = i; }
        float m2 = -1.f;
#pragma unroll
        for (int i = 0; i < 4; ++i) if (i != i1 && p[4 * g + i] > m2) m2 = p[4 * g + i];
        const float gs = m1 + m2; if (gs > bgs) { bgs = gs; bg = g; } }
    float q0 = 0.f, q1 = 0.f, q2 = 0.f, q3 = 0.f;
#pragma unroll
    for (int g = 0; g < 4; ++g) if (bg == g) { q0 = p[4 * g]; q1 = p[4 * g + 1]; q2 = p[4 * g + 2]; q3 = p[4 * g + 3]; }
    float m1 = q0; int i1 = 0; if (q1 > m1) { m1 = q1; i1 = 1; } if (q2 > m1) { m1 = q2; i1 = 2; } if (q3 > m1) { m1 = q3; i1 = 3; }
    float m2 = -1.f; int i2 = 0;
    if (i1 != 0 && q0 > m2) { m2 = q0; i2 = 0; } if (i1 != 1 && q1 > m2) { m2 = q1; i2 = 1; } if (i1 != 2 && q2 > m2) { m2 = q2; i2 = 2; } if (i1 != 3 && q3 > m2) { m2 = q3; i2 = 3; }
    if (lane == 0) {
        const int e1 = bg * 4 + i1, e2 = bg * 4 + i2; const float den = 1.f / (m1 + m2);
        const int s1 = atomicAdd(cnt + e1, 1), s2_ = atomicAdd(cnt + e2, 1);
        lists[(size_t)e1 * T + s1] = row; lists[(size_t)e2 * T + s2_] = row;
        tok_e[2 * row] = e1; tok_e[2 * row + 1] = e2; tok_g[2 * row] = m1 * den; tok_g[2 * row + 1] = m2 * den; tok_slot[2 * row] = s1; tok_slot[2 * row + 1] = s2_;
    }
}

__device__ __forceinline__ int expert_base(const int* cnt, int e) { int bs = 0; for (int i = 0; i < 16; ++i) if (i < e) bs += (cnt[i] + 255) & ~255; return bs; }
__global__ void __launch_bounds__(256) k_moe1(const bf16* H, const float* wg, const float* wu, const int* cnt, const int* lists, bf16* HE) {
    __shared__ float As[16 * 129], Ws0[16 * 64], Ws1[16 * 64];
    const int e = blockIdx.z, rt = blockIdx.y, ct = blockIdx.x, n = cnt[e]; if (rt * 128 >= n) return;
    const int tid = threadIdx.x, tx = tid & 15, ty = tid >> 4, base = expert_base(cnt, e);
    const int sl = rt * 128 + (tid >> 1), tok = lists[(size_t)e * T + (sl < n ? sl : 0)];
    float g[8][4], u[8][4];
    ngemm_core<true>(H + (size_t)tok * DM + (tid & 1) * 8, wg + (size_t)e * DM * DE + ct * 64, wu + (size_t)e * DM * DE + ct * 64, DE, DM, g, u, As, Ws0, Ws1);
#pragma unroll
    for (int i = 0; i < 8; ++i) { const int s = rt * 128 + ty + 16 * i; if (s < n) {
#pragma unroll
        for (int j = 0; j < 4; ++j) HE[(size_t)(base + s) * DE + ct * 64 + tx + 16 * j] = (bf16)f2bf(silu_f(g[i][j]) * u[i][j]); } }
}
__global__ void __launch_bounds__(256) k_moe2(const bf16* HE, const float* wd, const int* cnt, bf16* YP) {
    __shared__ float As[16 * 129], Ws0[16 * 64];
    const int e = blockIdx.z, rt = blockIdx.y, ct = blockIdx.x, n = cnt[e]; if (rt * 128 >= n) return;
    const int tid = threadIdx.x, tx = tid & 15, ty = tid >> 4, base = expert_base(cnt, e);
    const int sl = rt * 128 + (tid >> 1);
    float acc[8][4], dummy[8][4];
    ngemm_core<false>(HE + (size_t)(base + (sl < n ? sl : 0)) * DE + (tid & 1) * 8, wd + (size_t)e * DE * DM + ct * 64, nullptr, DM, DE, acc, dummy, As, Ws0, nullptr);
#pragma unroll
    for (int i = 0; i < 8; ++i) { const int s = rt * 128 + ty + 16 * i; if (s < n) {
#pragma unroll
        for (int j = 0; j < 4; ++j) YP[(size_t)(base + s) * DM + ct * 64 + tx + 16 * j] = (bf16)f2bf(acc[i][j]); } }
}

__global__ void __launch_bounds__(256) k_post_ffn(const bf16* X1, const bf16* YP, const float* modl, const float* lng, const float* lnb, const int* tok_e, const float* tok_g, const int* tok_slot, const int* cnt,
                                                  float* out, const float* modn, bf16* H) {
    const int row = blockIdx.x * 4 + (threadIdx.x >> 6), lane = threadIdx.x & 63, b = row / SEQ;
    const int e0 = tok_e[2 * row], e1 = tok_e[2 * row + 1]; const float w0 = tok_g[2 * row], w1 = tok_g[2 * row + 1];
    const size_t r0 = (size_t)expert_base(cnt, e0) + tok_slot[2 * row], r1 = (size_t)expert_base(cnt, e1) + tok_slot[2 * row + 1];
    const u32x2* xr = (const u32x2*)(X1 + (size_t)row * DM) + lane; const u32x2* y0 = (const u32x2*)(YP + r0 * DM) + lane; const u32x2* y1 = (const u32x2*)(YP + r1 * DM) + lane;
    const f32x4* g2 = (const f32x4*)(modl + (size_t)b * MODW + 5 * DM) + lane;
    f32x4 v[4]; float s = 0.f;
#pragma unroll
    for (int j = 0; j < 4; ++j) { const u32x2 x = xr[64 * j], a = y0[64 * j], c = y1[64 * j]; const f32x4 g = g2[64 * j];
        f32x4 xv, av, cv; xv.x = __uint_as_float(x.x << 16); xv.y = __uint_as_float(x.x & 0xffff0000u); xv.z = __uint_as_float(x.y << 16); xv.w = __uint_as_float(x.y & 0xffff0000u);
        av.x = __uint_as_float(a.x << 16); av.y = __uint_as_float(a.x & 0xffff0000u); av.z = __uint_as_float(a.y << 16); av.w = __uint_as_float(a.y & 0xffff0000u);
        cv.x = __uint_as_float(c.x << 16); cv.y = __uint_as_float(c.x & 0xffff0000u); cv.z = __uint_as_float(c.y << 16); cv.w = __uint_as_float(c.y & 0xffff0000u);
        v[j] = xv * ALPHA + g * (av * w0 + cv * w1); s += (v[j].x + v[j].y) + (v[j].z + v[j].w); }
    float mean = wave_sum(s) * (1.f / DM), s2 = 0.f;
#pragma unroll
    for (int j = 0; j < 4; ++j) { v[j] = v[j] - mean; s2 += (v[j].x * v[j].x + v[j].y * v[j].y) + (v[j].z * v[j].z + v[j].w * v[j].w); }
    float rstd = 1.f / sqrtf(wave_sum(s2) * (1.f / DM) + LN_EPS);
    f32x4* o = (f32x4*)(out + (size_t)row * DM) + lane; s = 0.f;
#pragma unroll
    for (int j = 0; j < 4; ++j) { const f32x4 g = ((const f32x4*)lng)[lane + 64 * j], bb = ((const f32x4*)lnb)[lane + 64 * j]; v[j] = v[j] * rstd * g + bb; o[64 * j] = v[j]; s += (v[j].x + v[j].y) + (v[j].z + v[j].w); }
    if (modn) {
        mean = wave_sum(s) * (1.f / DM); s2 = 0.f;
#pragma unroll
        for (int j = 0; j < 4; ++j) { v[j] = v[j] - mean; s2 += (v[j].x * v[j].x + v[j].y * v[j].y) + (v[j].z * v[j].z + v[j].w * v[j].w); }
        rstd = 1.f / sqrtf(wave_sum(s2) * (1.f / DM) + LN_EPS);
        const f32x4* sh = (const f32x4*)(modn + (size_t)b * MODW) + lane; const f32x4* sc = sh + 256; u32x2* ho = (u32x2*)(H + (size_t)row * DM) + lane;
#pragma unroll
        for (int j = 0; j < 4; ++j) { const f32x4 a = sh[64 * j], m = sc[64 * j]; const f32x4 r = v[j] * rstd * (m + 1.f) + a; u32x2 w; w.x = pk2(r.x, r.y); w.y = pk2(r.z, r.w); ho[64 * j] = w; }
    }
}

#include <hip/hip_bf16.h>
#ifndef RET_FAST
#define RET_FAST 1
#endif
#ifndef ATTN128
#define ATTN128 1
#endif
#ifndef ATTN_THRL
#define ATTN_THRL 8
#endif
#define LAS __attribute__((address_space(3)))
#define GAS __attribute__((address_space(1)))
typedef short bf16x8 __attribute__((ext_vector_type(8)));
typedef GAS unsigned gu32;
#define RLX_AGENT __ATOMIC_RELAXED, __HIP_MEMORY_SCOPE_AGENT
#define LDS_WAIT() asm volatile("s_waitcnt lgkmcnt(0)" ::: "memory")
#define VM_WAIT() asm volatile("s_waitcnt vmcnt(0)" ::: "memory")

constexpr size_t WL_IN = 0, WL_OUT = (size_t)INW * DM, WL_GU = WL_OUT + (size_t)DM * DM, WL_D = WL_GU + (size_t)NE * 1024 * DM, WL_STRIDE = WL_D + (size_t)NE * DM * DE;
static_assert(WL_STRIDE * 2 * 2 <= 114 * MiB, "weights fit");

namespace pg8 {
constexpr int BM = 256, BK = 64, HALF = 128, HTB = HALF * BK * 2, STAGE_BYTES = 8 * HTB, NXCD = 8, WGM = 8;
__host__ __device__ __forceinline__ int lds_byte(int r, int c) { const int st = (r >> 4) * 2 + (c >> 5), rr = r & 15, cc = c & 31, ob = rr * 64 + cc * 2; return st * 1024 + (ob ^ (((ob >> 9) & 1) << 5)); }
__host__ __device__ __forceinline__ void stage_rc(int b, int& R, int& C) { const int st = b / 1024, sb = b % 1024, swz = sb ^ (((sb >> 9) & 1) << 5); R = (st >> 1) * 16 + swz / 64; C = (st & 1) * 32 + (swz % 64) / 2; }
__host__ __device__ __forceinline__ int perm32(int rho) { const int n = rho >> 4, i = rho & 15; return 8 * (i >> 2) + 4 * n + (i & 3); }
struct Unit { int pm, pn; };

struct OrderBase {
    int nM, nN, nwg, G, c;
    __device__ __forceinline__ void init(int nM_, int nN_, int G_, int c_) { nM = nM_; nN = nN_; nwg = nM * nN; G = G_; c = c_; }
    __device__ __forceinline__ bool next(int i, Unit& u) const {
        const long L = (long)i * G + c; if (L >= nwg) return false;
        int wgid = (int)L; { const int q = nwg / NXCD, r = nwg % NXCD, xcd = wgid % NXCD, off = wgid / NXCD; wgid = (xcd < r ? xcd * (q + 1) : r * (q + 1) + (xcd - r) * q) + off; }
        const int nig = WGM * nN, gid = wgid / nig, fm = gid * WGM, gsz = (nM - fm) < WGM ? (nM - fm) : WGM;
        u.pm = fm + ((wgid % nig) % gsz); u.pn = (wgid % nig) / gsz; return true;
    }
    __device__ __forceinline__ void a_ready(const Unit&) const {}
    __device__ __forceinline__ void done(const Unit&) const {}
};
struct PlainSched : OrderBase {
    const bf16* Bt; int K;
    __device__ __forceinline__ void setup(const Unit& u, const int (&Rl)[2], const int (&Cb)[2], unsigned (&off)[2][2], const char*& bptr) const {
#pragma unroll
        for (int h = 0; h < 2; ++h)
#pragma unroll
            for (int i = 0; i < 2; ++i) off[h][i] = (unsigned)((u.pm * 256 + h * 128 + Rl[i]) * K * 2 + Cb[i]);
        bptr = (const char*)Bt + (size_t)u.pn * 256 * K * 2;
    }
};
struct MoeSched : OrderBase {
    const bf16* Bt; int K; const LAS int* tab; const int* cnt; const int* lists; bool gather;
    __device__ __forceinline__ void setup(const Unit& u, const int (&Rl)[2], const int (&Cb)[2], unsigned (&off)[2][2], const char*& bptr) const {
        const int te = tab[1 + u.pm], e = te & 255, s0 = (te >> 8) * 256;
        if (gather) { const int n = cnt[e];
#pragma unroll
            for (int h = 0; h < 2; ++h)
#pragma unroll
                for (int i = 0; i < 2; ++i) { const int s = s0 + h * 128 + Rl[i]; const int tok = lists[(size_t)e * T + (s < n ? s : 0)]; off[h][i] = (unsigned)(tok * K * 2 + Cb[i]); }
        } else {
#pragma unroll
            for (int h = 0; h < 2; ++h)
#pragma unroll
                for (int i = 0; i < 2; ++i) off[h][i] = (unsigned)((u.pm * 256 + h * 128 + Rl[i]) * K * 2 + Cb[i]);
        }
        bptr = (const char*)Bt + (size_t)(e * 4 + u.pn) * 256 * K * 2;
    }
};

__device__ __forceinline__ unsigned cvt_pk_bf16(float lo, float hi) { unsigned r; asm volatile("v_cvt_pk_bf16_f32 %0, %1, %2" : "=v"(r) : "v"(lo), "v"(hi)); return r; }
__device__ __forceinline__ float fsilu(float v) { return v * __builtin_amdgcn_rcpf(1.f + __expf(-v)); }
#ifndef W_SILUFOLD
#define W_SILUFOLD 1
#endif
typedef float f32x2v __attribute__((ext_vector_type(2)));
__device__ __forceinline__ unsigned gu2(float a0, float a1, float u0, float u1) {
    const f32x2v a = (f32x2v){a0, a1}, u = (f32x2v){u0, u1};
    f32x2v d = (f32x2v){__builtin_amdgcn_exp2f(a0), __builtin_amdgcn_exp2f(a1)} + 1.f;
    const f32x2v r = (f32x2v){__builtin_amdgcn_rcpf(d.x), __builtin_amdgcn_rcpf(d.y)};
    const f32x2v o = (a * r) * u;
    return cvt_pk_bf16(o.x, o.y);
}
#ifndef EPI_T
#define EPI_T 1
#endif
#ifndef ROT_EXP_PATH
#define ROT_EXP_PATH 0
#endif
#ifndef W_C2FOLD
#define W_C2FOLD 1
#endif
#ifndef ROT_T
#define ROT_T 1
#endif
__device__ __forceinline__ u32x4 tr4(u32x4 w, int src4) {
#if EPI_T
    u32x4 r; r.x = (unsigned)__builtin_amdgcn_ds_bpermute(src4, (int)w.x); r.y = (unsigned)__builtin_amdgcn_ds_bpermute(src4, (int)w.y);
    r.z = (unsigned)__builtin_amdgcn_ds_bpermute(src4, (int)w.z); r.w = (unsigned)__builtin_amdgcn_ds_bpermute(src4, (int)w.w); return r;
#else
    return w;
#endif
}
#define EPI_T_LANES() const int ln_ = fq * 16 + fr; const int fr2 = EPI_T ? (ln_ >> 2) : fr, fq2 = EPI_T ? (ln_ & 3) : fq, src4 = (fq2 * 16 + fr2) * 4; (void)src4

struct EpiInProj {
    static constexpr bool PERM = true, AFTER_DRAIN = false;
    bf16* P; const float* rot; const float* dtab; bf16* dummy;
    __device__ __forceinline__ void operator()(const f32x4 (&acc)[2][2][4][2], const Unit& u, int wr, int wc, int fr, int fq) const {
        EPI_T_LANES(); const int row0 = u.pm * BM + wr * 64 + fr, row0a = u.pm * BM + wr * 64 + fr2;
        if (u.pn < 4 && !(ROT_EXP_PATH && dummy)) {
            const float sc0 = u.pn < 2 ? 0.125f : 1.f; const float* dt = dtab ? dtab + (u.pn >> 1) * 1024 + ((u.pn & 1) * 4 + wc) * 128 : nullptr;
#if ROT_T
#define ROT_LOAD(ai, tt, scv) _Pragma("unroll") for (int m = 0; m < 4; ++m) { const int pos = (row0 + (ai) * HALF + m * 16) & (SEQ - 1); const f32x4* rt = (const f32x4*)rot + (size_t)(4 * fq) * SEQ + pos; \
                tt[m][0] = rt[0]; tt[m][1] = rt[SEQ]; tt[m][2] = rt[2 * SEQ]; tt[m][3] = rt[3 * SEQ]; scv[m] = dt ? dt[pos & 127] : sc0; }
#else
#define ROT_LOAD(ai, tt, scv) _Pragma("unroll") for (int m = 0; m < 4; ++m) { const int pos = (row0 + (ai) * HALF + m * 16) & (SEQ - 1); const f32x4* rt = (const f32x4*)(rot + (size_t)(pos * 32 + 8 * fq) * 2); \
                tt[m][0] = rt[0]; tt[m][1] = rt[1]; tt[m][2] = rt[2]; tt[m][3] = rt[3]; scv[m] = dt ? dt[pos & 127] : sc0; }
#endif
#define ROT_COMP(ai, m, tt, scv, W1, W2) do { const float sc = scv[m]; const f32x4 t0 = tt[m][0], t1 = tt[m][1], t2 = tt[m][2], t3 = tt[m][3]; \
                const f32x4 xa = acc[ai][0][m][0], xb = acc[ai][0][m][1], ya = acc[ai][1][m][0], yb = acc[ai][1][m][1]; u32x4 w1, w2; \
                w1.x = cvt_pk_bf16((xa[0] * t0.x - ya[0] * t0.y) * sc, (xa[1] * t0.z - ya[1] * t0.w) * sc); w1.y = cvt_pk_bf16((xa[2] * t1.x - ya[2] * t1.y) * sc, (xa[3] * t1.z - ya[3] * t1.w) * sc); \
                w1.z = cvt_pk_bf16((xb[0] * t2.x - yb[0] * t2.y) * sc, (xb[1] * t2.z - yb[1] * t2.w) * sc); w1.w = cvt_pk_bf16((xb[2] * t3.x - yb[2] * t3.y) * sc, (xb[3] * t3.z - yb[3] * t3.w) * sc); \
                w2.x = cvt_pk_bf16((xa[0] * t0.y + ya[0] * t0.x) * sc, (xa[1] * t0.w + ya[1] * t0.z) * sc); w2.y = cvt_pk_bf16((xa[2] * t1.y + ya[2] * t1.x) * sc, (xa[3] * t1.w + ya[3] * t1.z) * sc); \
                w2.z = cvt_pk_bf16((xb[0] * t2.y + yb[0] * t2.x) * sc, (xb[1] * t2.w + yb[1] * t2.z) * sc); w2.w = cvt_pk_bf16((xb[2] * t3.y + yb[2] * t3.x) * sc, (xb[3] * t3.w + yb[3] * t3.z) * sc); \
                W1 = tr4(w1, src4); W2 = tr4(w2, src4); } while (0)
            bf16* ob = P + (size_t)row0a * INW + u.pn * BM + 64 * wc + 8 * fq2;
            f32x4 ta[4][4]; float sa[4]; ROT_LOAD(0, ta, sa)
            u32x4 p1[4], p2[4];
#pragma unroll
            for (int m = 0; m < 4; ++m) ROT_COMP(0, m, ta, sa, p1[m], p2[m]);
            f32x4 tb[4][4]; float sb[4]; ROT_LOAD(1, tb, sb)
            asm volatile("" ::: "memory");
#pragma unroll
            for (int m = 0; m < 4; ++m) { bf16* o = ob + (size_t)(m * 16) * INW; *(u32x4*)o = p1[m]; *(u32x4*)(o + 32) = p2[m]; }
#pragma unroll
            for (int m = 0; m < 4; ++m) { u32x4 q1, q2; ROT_COMP(1, m, tb, sb, q1, q2); bf16* o = ob + (size_t)(HALF + m * 16) * INW; *(u32x4*)o = q1; *(u32x4*)(o + 32) = q2; }
#undef ROT_LOAD
#undef ROT_COMP
        } else {
            const int region = u.pn >> 1;
            bf16* obase = ((ROT_EXP_PATH && u.pn < 4) ? dummy + (size_t)row0a * DM : P + (size_t)row0a * INW) + u.pn * BM + wc * 32 + 8 * fq2;
            const int ldo = (ROT_EXP_PATH && u.pn < 4) ? DM : INW;
            if (region == 3) {
#pragma unroll
                for (int ai = 0; ai < 2; ++ai)
#pragma unroll
                    for (int m = 0; m < 4; ++m) { bf16* o = obase + (size_t)(ai * HALF + m * 16) * ldo;
#pragma unroll
                        for (int bj = 0; bj < 2; ++bj) { const f32x4 a0 = acc[ai][bj][m][0], a1 = acc[ai][bj][m][1];
                            u32x4 w; w.x = cvt_pk_bf16(fsilu(a0[0]), fsilu(a0[1])); w.y = cvt_pk_bf16(fsilu(a0[2]), fsilu(a0[3])); w.z = cvt_pk_bf16(fsilu(a1[0]), fsilu(a1[1])); w.w = cvt_pk_bf16(fsilu(a1[2]), fsilu(a1[3]));
                            *(u32x4*)(o + bj * HALF) = tr4(w, src4); } }
            } else {
                const float sc = (!W_C2FOLD && region == 4) ? C2 : 1.f;
#pragma unroll
                for (int ai = 0; ai < 2; ++ai)
#pragma unroll
                    for (int m = 0; m < 4; ++m) { bf16* o = obase + (size_t)(ai * HALF + m * 16) * ldo;
#pragma unroll
                        for (int bj = 0; bj < 2; ++bj) { const f32x4 a0 = acc[ai][bj][m][0], a1 = acc[ai][bj][m][1];
                            u32x4 w;
                            if (W_C2FOLD) { w.x = cvt_pk_bf16(a0[0], a0[1]); w.y = cvt_pk_bf16(a0[2], a0[3]); w.z = cvt_pk_bf16(a1[0], a1[1]); w.w = cvt_pk_bf16(a1[2], a1[3]); }
                            else { w.x = cvt_pk_bf16(a0[0] * sc, a0[1] * sc); w.y = cvt_pk_bf16(a0[2] * sc, a0[3] * sc); w.z = cvt_pk_bf16(a1[0] * sc, a1[1] * sc); w.w = cvt_pk_bf16(a1[2] * sc, a1[3] * sc); }
                            *(u32x4*)(o + bj * HALF) = tr4(w, src4); } }
            }
        }
    }
};
struct EpiPlain {
    static constexpr bool PERM = true, AFTER_DRAIN = false;
    bf16* O; int ldc;
    __device__ __forceinline__ void operator()(const f32x4 (&acc)[2][2][4][2], const Unit& u, int wr, int wc, int fr, int fq, int hm = 0) const {
        EPI_T_LANES(); const int row0 = u.pm * BM + wr * 64 + fr2, col0 = u.pn * BM + wc * 32 + 8 * fq2;
#pragma unroll
        for (int ai = 0; ai < 2; ++ai) if (hm == 0 || hm == 1 + ai)
#pragma unroll
            for (int m = 0; m < 4; ++m) { bf16* o = O + (size_t)(row0 + ai * HALF + m * 16) * ldc + col0;
#pragma unroll
                for (int bj = 0; bj < 2; ++bj) { const f32x4 v0 = acc[ai][bj][m][0], v1 = acc[ai][bj][m][1];
                    u32x4 w; w.x = cvt_pk_bf16(v0[0], v0[1]); w.y = cvt_pk_bf16(v0[2], v0[3]); w.z = cvt_pk_bf16(v1[0], v1[1]); w.w = cvt_pk_bf16(v1[2], v1[3]);
                    *(u32x4*)(o + bj * HALF) = tr4(w, src4); } }
    }
};
struct EpiNone {
    static constexpr bool PERM = true, AFTER_DRAIN = false;
    __device__ __forceinline__ void operator()(const f32x4 (&acc)[2][2][4][2], const Unit& u, int wr, int wc, int fr, int fq) const {
#pragma unroll
        for (int ai = 0; ai < 2; ++ai)
#pragma unroll
            for (int bj = 0; bj < 2; ++bj)
#pragma unroll
                for (int m = 0; m < 4; ++m) { asm volatile("" :: "v"(acc[ai][bj][m][0]), "v"(acc[ai][bj][m][1])); }
    }
};
struct EpiGateUp {
    static constexpr bool PERM = true, AFTER_DRAIN = false;
    bf16* HE;
    __device__ __forceinline__ void operator()(const f32x4 (&acc)[2][2][4][2], const Unit& u, int wr, int wc, int fr, int fq, int hm = 0) const {
        EPI_T_LANES(); const int row0 = u.pm * BM + wr * 64 + fr2, col0 = u.pn * 128 + wc * 32 + 8 * fq2;
#pragma unroll
        for (int ai = 0; ai < 2; ++ai) if (hm == 0 || hm == 1 + ai)
#pragma unroll
            for (int m = 0; m < 4; ++m) { const f32x4 g0 = acc[ai][0][m][0], g1 = acc[ai][0][m][1], u0 = acc[ai][1][m][0], u1 = acc[ai][1][m][1];
                u32x4 w;
#if W_SILUFOLD
                w.x = gu2(g0[0], g0[1], u0[0], u0[1]); w.y = gu2(g0[2], g0[3], u0[2], u0[3]); w.z = gu2(g1[0], g1[1], u1[0], u1[1]); w.w = gu2(g1[2], g1[3], u1[2], u1[3]);
#else
                w.x = cvt_pk_bf16(fsilu(g0[0]) * u0[0], fsilu(g0[1]) * u0[1]); w.y = cvt_pk_bf16(fsilu(g0[2]) * u0[2], fsilu(g0[3]) * u0[3]);
                w.z = cvt_pk_bf16(fsilu(g1[0]) * u1[0], fsilu(g1[1]) * u1[1]); w.w = cvt_pk_bf16(fsilu(g1[2]) * u1[2], fsilu(g1[3]) * u1[3]);
#endif
                *(u32x4*)(HE + (size_t)(row0 + ai * HALF + m * 16) * DE + col0) = tr4(w, src4); }
    }
};

template <class Epi, class Sched, bool ALIGN_EPI>
__device__ __forceinline__ void gemm_phase(LAS unsigned char* lds, const char* gA, int K, const Sched& S, const Epi& E) {
    int tid_ = threadIdx.x; asm volatile("" : "+v"(tid_));
    const int tid = tid_, wid = __builtin_amdgcn_readfirstlane(tid >> 6), lane = tid & 63, wr = wid >> 2, wc = wid & 3, fr = lane & 15, fq = lane >> 4;
    const int nt = K / BK;
    unsigned voffB[2]; int Rl[2], Cb[2];
#pragma unroll
    for (int i = 0; i < 2; ++i) { int R, C; stage_rc(tid * 16 + i * 8192, R, C); const int Rb = Epi::PERM ? ((R & ~31) + perm32(R & 31)) : R;
        voffB[i] = (unsigned)(Rb * K + C) * 2u; Rl[i] = R; Cb[i] = C * 2; }
    const size_t kstep = (size_t)(BK * 2), hstep = (size_t)HALF * K * 2;
    const unsigned ldsw = (unsigned)wid * 1024u;
    const int aoff = lds_byte(wr * 64 + fr, fq * 8), boff = lds_byte(wc * 32 + fr, fq * 8);
#define PG8_SA(b, h) (((b) * 2 + (h)) * HTB)
#define PG8_SB(b, h) ((4 + (b) * 2 + (h)) * HTB)
#define PG8_STAGE(bufoff, gbase, voff) do { _Pragma("unroll") for (int _i = 0; _i < 2; ++_i) \
        __builtin_amdgcn_global_load_lds((const unsigned*)((const char*)(gbase) + (voff)[_i]), (LAS unsigned*)(lds + (bufoff) + ldsw + _i * 8192), 16, 0, 0); } while (0)
#define PG8_LDA(dst, b, h) do { _Pragma("unroll") for (int m = 0; m < 4; ++m) _Pragma("unroll") for (int k = 0; k < 2; ++k) dst[m][k] = *(const LAS bf16x8*)(lds + PG8_SA(b, h) + aoff + m * 2048 + k * 1024); } while (0)
#define PG8_LDB(dst, b, h) do { _Pragma("unroll") for (int n = 0; n < 2; ++n) _Pragma("unroll") for (int k = 0; k < 2; ++k) dst[n][k] = *(const LAS bf16x8*)(lds + PG8_SB(b, h) + boff + n * 2048 + k * 1024); } while (0)
#define PG8_MMA(ai, bj, At, Bt) do { __builtin_amdgcn_s_setprio(1); _Pragma("unroll") for (int m = 0; m < 4; ++m) _Pragma("unroll") for (int n = 0; n < 2; ++n) _Pragma("unroll") for (int k = 0; k < 2; ++k) \
        acc[ai][bj][m][n] = __builtin_amdgcn_mfma_f32_16x16x32_bf16(Bt[n][k], At[m][k], acc[ai][bj][m][n], 0, 0, 0); __builtin_amdgcn_s_setprio(0); } while (0)
#define PG8_WAIT_V(n) asm volatile("s_waitcnt vmcnt(" #n ")" ::: "memory")
#define PG8_WAIT_L(n) asm volatile("s_waitcnt lgkmcnt(" #n ")" ::: "memory")
#define PG8_BAR __builtin_amdgcn_s_barrier()
#define PG8_SCHED __builtin_amdgcn_sched_barrier(0)
    Unit cur, nxt; int ui = 0;
    if (!S.next(0, cur)) return;
    f32x4 acc[2][2][4][2];
#pragma unroll
    for (int a = 0; a < 2; ++a)
#pragma unroll
        for (int b = 0; b < 2; ++b)
#pragma unroll
            for (int m = 0; m < 4; ++m)
#pragma unroll
                for (int n = 0; n < 2; ++n) acc[a][b][m][n] = (f32x4){0.f, 0.f, 0.f, 0.f};
    bf16x8 At[4][2], B0[2][2], B1[2][2];
    unsigned oc[2][2], on[2][2]; const char* cB; const char* nB;
    S.setup(cur, Rl, Cb, oc, cB);
    S.a_ready(cur);
    PG8_STAGE(PG8_SB(0, 0), cB, voffB); PG8_STAGE(PG8_SB(0, 1), cB + hstep, voffB); PG8_STAGE(PG8_SA(0, 0), gA, oc[0]); PG8_STAGE(PG8_SA(0, 1), gA, oc[1]);
    if (wr == 1) PG8_BAR;
    PG8_WAIT_V(2); PG8_BAR;
    PG8_STAGE(PG8_SB(1, 0), cB + kstep, voffB); PG8_STAGE(PG8_SA(1, 0), gA + kstep, oc[0]); PG8_STAGE(PG8_SB(1, 1), cB + hstep + kstep, voffB);
    PG8_WAIT_V(6); PG8_BAR;
    for (;;) {
        const bool has_next = S.next(ui + 1, nxt);
        if (has_next) S.setup(nxt, Rl, Cb, on, nB);
        else { nB = cB;
#pragma unroll
            for (int h = 0; h < 2; ++h)
#pragma unroll
                for (int i = 0; i < 2; ++i) on[h][i] = oc[h][i]; }
        for (int t = 0; t < nt; t += 2) {
            const bool last = (t == nt - 2);
            const char* a1 = gA + (size_t)(t + 1) * kstep;
            const char* a2 = last ? gA : gA + (size_t)(t + 2) * kstep; const char* b2 = last ? nB : cB + (size_t)(t + 2) * kstep;
            const char* a3 = a2 + kstep; const char* b3 = b2 + kstep;
            unsigned o2[2][2];
#pragma unroll
            for (int h = 0; h < 2; ++h)
#pragma unroll
                for (int i = 0; i < 2; ++i) o2[h][i] = last ? on[h][i] : oc[h][i];
            if (last && has_next) S.a_ready(nxt);
            PG8_LDB(B0, 0, 0); PG8_LDB(B1, 0, 1); PG8_SCHED; PG8_LDA(At, 0, 0); PG8_STAGE(PG8_SA(1, 1), a1, oc[1]);
            PG8_WAIT_V(8); PG8_WAIT_L(0); PG8_BAR; PG8_MMA(0, 0, At, B0); PG8_MMA(0, 1, At, B1); PG8_BAR; PG8_SCHED;
            PG8_LDA(At, 0, 1); PG8_STAGE(PG8_SB(0, 0), b2, voffB); PG8_STAGE(PG8_SB(0, 1), b2 + hstep, voffB); PG8_STAGE(PG8_SA(0, 0), a2, o2[0]);
            PG8_WAIT_V(8); PG8_WAIT_L(0); PG8_BAR; PG8_MMA(1, 0, At, B0); PG8_MMA(1, 1, At, B1); PG8_BAR; PG8_SCHED;
            PG8_LDB(B0, 1, 0); PG8_LDB(B1, 1, 1); PG8_SCHED; PG8_LDA(At, 1, 0); PG8_STAGE(PG8_SA(0, 1), a2, o2[1]);
            PG8_WAIT_V(8); PG8_WAIT_L(0); PG8_BAR; PG8_MMA(0, 0, At, B0); PG8_MMA(0, 1, At, B1); PG8_BAR; PG8_SCHED;
            PG8_LDA(At, 1, 1); PG8_STAGE(PG8_SB(1, 0), b3, voffB); PG8_STAGE(PG8_SB(1, 1), b3 + hstep, voffB); PG8_STAGE(PG8_SA(1, 0), a3, o2[0]);
            PG8_WAIT_V(8); PG8_WAIT_L(0); PG8_BAR; PG8_MMA(1, 0, At, B0); PG8_MMA(1, 1, At, B1); PG8_BAR; PG8_SCHED;
        }
        if constexpr (ALIGN_EPI) { if (wr == 0) PG8_BAR; }
        E(acc, cur, wr, wc, fr, fq); S.done(cur);
        if (!has_next) break;
#pragma unroll
        for (int a = 0; a < 2; ++a)
#pragma unroll
            for (int b = 0; b < 2; ++b)
#pragma unroll
                for (int m = 0; m < 4; ++m)
#pragma unroll
                    for (int n = 0; n < 2; ++n) acc[a][b][m][n] = (f32x4){0.f, 0.f, 0.f, 0.f};
        cur = nxt; cB = nB; ++ui;
#pragma unroll
        for (int h = 0; h < 2; ++h)
#pragma unroll
            for (int i = 0; i < 2; ++i) oc[h][i] = on[h][i];
        if constexpr (ALIGN_EPI) { if (wr == 1) PG8_BAR; }
    }
    PG8_WAIT_V(0);
    if constexpr (!ALIGN_EPI) { if (wr == 0) PG8_BAR; }
    PG8_BAR;
#undef PG8_SA
#undef PG8_SB
#undef PG8_STAGE
#undef PG8_LDA
#undef PG8_LDB
#undef PG8_MMA
#undef PG8_WAIT_V
#undef PG8_WAIT_L
#undef PG8_BAR
#undef PG8_SCHED
}
}
#ifndef RET_RING4
#define RET_RING4 1
#endif
#ifndef RS1
#define RS1 13
#define RS2 22
#define RS3 28
#endif
namespace ret {
constexpr int QB0 = 0, KB0 = 32768, VB0 = 65536, ST0 = 98304;
constexpr int RET_LDS_BYTES = ST0 + 2 * 8192;
__device__ __forceinline__ int toff(int row, int c16) { return row * 128 + ((c16 ^ (row & 7)) << 4); }
typedef short v4i16_t __attribute__((ext_vector_type(4)));
__device__ __forceinline__ v4i16_t trd(const LAS unsigned char* p) { return __builtin_amdgcn_ds_read_tr16_b64_v4i16((LAS v4i16_t*)p); }
__device__ __forceinline__ bf16x8 cat8(v4i16_t a, v4i16_t b) { return (bf16x8){a[0], a[1], a[2], a[3], b[0], b[1], b[2], b[3]}; }

#define RET_KEEP(x) asm volatile("" :: "v"(x))
__device__ __forceinline__ float xsum_16_32(float v) {
    { auto rr = __builtin_amdgcn_permlane16_swap(__float_as_uint(v), __float_as_uint(v), false, false); v = __uint_as_float(rr[0]) + __uint_as_float(rr[1]); }
    { auto rr = __builtin_amdgcn_permlane32_swap(__float_as_uint(v), __float_as_uint(v), false, false); v = __uint_as_float(rr[0]) + __uint_as_float(rr[1]); }
    return v;
}
__device__ __forceinline__ void ret_unit(int b, int h, int seg, const bf16* PROJ, bf16* CAT, float gC, LAS unsigned char* lds) {
    int tid_ = threadIdx.x; asm volatile("" : "+v"(tid_));
    const int tid = tid_, lane = tid & 63, w = __builtin_amdgcn_readfirstlane(tid >> 6), g = lane >> 4, c15 = lane & 15;
    const int blk = w < 4 ? w : 11 - w;
    const bf16* base = PROJ + (size_t)b * SEQ * INW;
    const int nfirst = seg == 0 ? 0 : seg == 1 ? RS1 : seg == 2 ? RS2 : RS3, nend = seg == 0 ? RS1 : seg == 1 ? RS2 : seg == 2 ? RS3 : 32;
    const int dr = lane >> 3, dc = (lane & 7) ^ dr;
#define RET_DMA(tileoff, colbase, m) do { _Pragma("unroll") for (int _p = 0; _p < 2; ++_p) { const int pc = w + 8 * _p; \
        __builtin_amdgcn_global_load_lds((const unsigned*)(base + (size_t)((m) * 128 + 8 * pc + dr) * INW + (colbase) + h * 64 + dc * 8), (LAS unsigned*)(lds + (tileoff) + pc * 1024), 16, 0, 0); } } while (0)
    f32x4 sacc[2]; sacc[0] = (f32x4){0.f, 0.f, 0.f, 0.f}; sacc[1] = (f32x4){0.f, 0.f, 0.f, 0.f};
    const int et_s = w >> 1, dt0 = 2 * (w & 1);
    if (nfirst > 0) {
        bf16x8 kprev = (bf16x8){0, 0, 0, 0, 0, 0, 0, 0}, vprev2 = kprev;
#if RET_RING4
        RET_DMA(0, C_RK, 0); RET_DMA(16384, C_RV, 0);
        if (nfirst > 1) { RET_DMA(32768, C_RK, 1); RET_DMA(32768 + 16384, C_RV, 1); }
        if (nfirst > 2) { RET_DMA(65536, C_RK, 2); RET_DMA(65536 + 16384, C_RV, 2); }
#pragma unroll 1
        for (int m = 0; m < nfirst; ++m) {
            if (m + 2 < nfirst) asm volatile("s_waitcnt vmcnt(8) lgkmcnt(0)" ::: "memory"); else if (m + 1 < nfirst) asm volatile("s_waitcnt vmcnt(4) lgkmcnt(0)" ::: "memory"); else asm volatile("s_waitcnt vmcnt(0) lgkmcnt(0)" ::: "memory");
            __builtin_amdgcn_s_barrier(); asm volatile("" ::: "memory");
            if (m + 3 < nfirst) { const int s2 = ((m + 3) & 3) * 32768; RET_DMA(s2, C_RK, m + 3); RET_DMA(s2 + 16384, C_RV, m + 3); }
            const LAS unsigned char* Kt = lds + (m & 3) * 32768; const LAS unsigned char* Vt = Kt + 16384;
#else
        RET_DMA(0, C_RK, 0); RET_DMA(16384, C_RV, 0);
        if (nfirst > 1) { RET_DMA(32768, C_RK, 1); RET_DMA(32768 + 16384, C_RV, 1); }
#pragma unroll 1
        for (int m = 0; m < nfirst; ++m) {
            if (m + 1 < nfirst) asm volatile("s_waitcnt vmcnt(4) lgkmcnt(0)" ::: "memory"); else asm volatile("s_waitcnt vmcnt(0) lgkmcnt(0)" ::: "memory");
            __builtin_amdgcn_s_barrier(); asm volatile("" ::: "memory");
            if (m + 2 < nfirst) { const int s2 = ((m + 2) % 3) * 32768; RET_DMA(s2, C_RK, m + 2); RET_DMA(s2 + 16384, C_RV, m + 2); }
            const LAS unsigned char* Kt = lds + (m % 3) * 32768; const LAS unsigned char* Vt = Kt + 16384;
#endif
            sacc[0] = sacc[0] * gC; sacc[1] = sacc[1] * gC;
#pragma unroll
            for (int ks = 0; ks < 4; ++ks) {
                const int q = c15 >> 2, p = c15 & 3, r0 = 32 * ks + 8 * g + q;
                const bf16x8 vf = cat8(trd(Vt + toff(r0, 2 * et_s + (p >> 1)) + (p & 1) * 8), trd(Vt + toff(r0 + 4, 2 * et_s + (p >> 1)) + (p & 1) * 8));
#pragma unroll
                for (int dd = 0; dd < 2; ++dd) { const int c16 = 2 * (dt0 + dd) + (p >> 1);
                    const bf16x8 kf = cat8(trd(Kt + toff(r0, c16) + (p & 1) * 8), trd(Kt + toff(r0 + 4, c16) + (p & 1) * 8));
                    sacc[dd] = __builtin_amdgcn_mfma_f32_16x16x32_bf16(vf, kf, sacc[dd], 0, 0, 0); RET_KEEP(kprev); kprev = kf; }
                RET_KEEP(vprev2); vprev2 = vf;
            }
        }
        RET_KEEP(kprev); RET_KEEP(vprev2);
        asm volatile("s_waitcnt lgkmcnt(0)" ::: "memory"); __builtin_amdgcn_s_barrier(); asm volatile("" ::: "memory");
    }
    { LAS unsigned char* STi = lds + ST0 + (nfirst & 1) * 8192;
#pragma unroll
      for (int dd = 0; dd < 2; ++dd)
#pragma unroll
          for (int rr = 0; rr < 4; ++rr) { const int e = 16 * et_s + 4 * g + rr, d = 16 * (dt0 + dd) + c15;
              *(LAS unsigned short*)(STi + toff(e, d >> 3) + (d & 7) * 2) = (unsigned short)f2bf(sacc[dd][rr]); } }
    RET_DMA(KB0 + (nfirst & 1) * 16384, C_RK, nfirst); RET_DMA(VB0 + (nfirst & 1) * 16384, C_RV, nfirst); RET_DMA(QB0 + (nfirst & 1) * 16384, C_RQ, nfirst);
    __syncthreads();
#define RET_STATE_UPDATE() do { if (m + 1 < nend) { bf16x8 kfp = (bf16x8){0, 0, 0, 0, 0, 0, 0, 0}, vfp = kfp; sacc[0] = sacc[0] * gC; sacc[1] = sacc[1] * gC; _Pragma("unroll") for (int ks = 0; ks < 4; ++ks) { const int q = c15 >> 2, p = c15 & 3, r0 = 32 * ks + 8 * g + q; const bf16x8 vf = cat8(trd(Vt + toff(r0, 2 * et_s + (p >> 1)) + (p & 1) * 8), trd(Vt + toff(r0 + 4, 2 * et_s + (p >> 1)) + (p & 1) * 8)); _Pragma("unroll") for (int dd = 0; dd < 2; ++dd) { const int c16 = 2 * (dt0 + dd) + (p >> 1); const bf16x8 kf = cat8(trd(Kt + toff(r0, c16) + (p & 1) * 8), trd(Kt + toff(r0 + 4, c16) + (p & 1) * 8)); sacc[dd] = __builtin_amdgcn_mfma_f32_16x16x32_bf16(vf, kf, sacc[dd], 0, 0, 0); if (dd == 1) { RET_KEEP(kfp); } kfp = kf; } RET_KEEP(vfp); vfp = vf; } _Pragma("unroll") for (int dd = 0; dd < 2; ++dd) _Pragma("unroll") for (int r = 0; r < 4; ++r) { const int e = 16 * et_s + 4 * g + r, d = 16 * (dt0 + dd) + c15; *(LAS unsigned short*)(STn + toff(e, d >> 3) + (d & 7) * 2) = (unsigned short)f2bf(sacc[dd][r]); } RET_KEEP(kfp); RET_KEEP(vfp); } } while (0)
#pragma unroll 1
    for (int m = nfirst; m < nend; ++m) {
        const int cur = m & 1, nx = cur ^ 1; const bool full = true;
        if (m + 1 < nend) { RET_DMA(KB0 + nx * 16384, C_RK, m + 1); RET_DMA(VB0 + nx * 16384, C_RV, m + 1); RET_DMA(QB0 + nx * 16384, C_RQ, m + 1); }
        const LAS unsigned char* Qt = lds + QB0 + cur * 16384; const LAS unsigned char* Kt = lds + KB0 + cur * 16384; const LAS unsigned char* Vt = lds + VB0 + cur * 16384;
        const LAS unsigned char* STc = lds + ST0 + cur * 8192; LAS unsigned char* STn = lds + ST0 + nx * 8192;
        if (full) {
            const size_t row = (size_t)b * SEQ + m * 128 + 16 * blk + c15;
            u32x2 gg[4];
#pragma unroll
            for (int et = 0; et < 4; ++et) gg[et] = *(const GAS u32x2*)(PROJ + row * INW + C_RG + h * 64 + 16 * et + 4 * g);
            bf16x8 qf[2];
#pragma unroll
            for (int ks = 0; ks < 2; ++ks) qf[ks] = *(const LAS bf16x8*)(Qt + toff(16 * blk + c15, 4 * ks + g));
            bf16x8 pf[4];
#pragma unroll
            for (int ks = 0; ks < 4; ++ks) {
                f32x4 s0 = (f32x4){0.f, 0.f, 0.f, 0.f}, s1 = (f32x4){0.f, 0.f, 0.f, 0.f};
                bf16x8 ka[2], kb[2]; ka[0] = ka[1] = kb[0] = kb[1] = (bf16x8){0, 0, 0, 0, 0, 0, 0, 0};
                if (2 * ks <= blk) {
#pragma unroll
                    for (int kk = 0; kk < 2; ++kk) { ka[kk] = *(const LAS bf16x8*)(Kt + toff(32 * ks + c15, 4 * kk + g)); s0 = __builtin_amdgcn_mfma_f32_16x16x32_bf16(ka[kk], qf[kk], s0, 0, 0, 0); }
                    if (2 * ks == blk) {
#pragma unroll
                        for (int r = 0; r < 4; ++r) if (4 * g + r > c15) s0[r] = 0.f; }
                }
                if (2 * ks + 1 <= blk) {
#pragma unroll
                    for (int kk = 0; kk < 2; ++kk) { kb[kk] = *(const LAS bf16x8*)(Kt + toff(32 * ks + 16 + c15, 4 * kk + g)); s1 = __builtin_amdgcn_mfma_f32_16x16x32_bf16(kb[kk], qf[kk], s1, 0, 0, 0); }
                    if (2 * ks + 1 == blk) {
#pragma unroll
                        for (int r = 0; r < 4; ++r) if (4 * g + r > c15) s1[r] = 0.f; }
                }
                u32x4 pk; pk.x = pk2(s0[0], s0[1]); pk.y = pk2(s0[2], s0[3]); pk.z = pk2(s1[0], s1[1]); pk.w = pk2(s1[2], s1[3]);
                pf[ks] = __builtin_bit_cast(bf16x8, pk);
                RET_KEEP(ka[0]); RET_KEEP(ka[1]); RET_KEEP(kb[0]); RET_KEEP(kb[1]);
            }
            f32x4 o[4];
            bf16x8 vprev[4]; vprev[0] = vprev[1] = vprev[2] = vprev[3] = (bf16x8){0, 0, 0, 0, 0, 0, 0, 0};
#pragma unroll
            for (int et = 0; et < 4; ++et) {
                f32x4 a = (f32x4){0.f, 0.f, 0.f, 0.f};
                bf16x8 sf[2], vcur[4]; vcur[0] = vcur[1] = vcur[2] = vcur[3] = (bf16x8){0, 0, 0, 0, 0, 0, 0, 0};
#pragma unroll
                for (int kk = 0; kk < 2; ++kk) { sf[kk] = *(const LAS bf16x8*)(STc + toff(16 * et + c15, 4 * kk + g)); a = __builtin_amdgcn_mfma_f32_16x16x32_bf16(sf[kk], qf[kk], a, 0, 0, 0); }
                a = a * gC;
#pragma unroll
                for (int ks = 0; ks < 4; ++ks) {
                    const int q = c15 >> 2, p = c15 & 3, r0 = 32 * ks + 4 * g + q, c16 = 2 * et + (p >> 1);
                    const v4i16_t v0 = trd(Vt + toff(r0, c16) + (p & 1) * 8), v1 = trd(Vt + toff(r0 + 16, c16) + (p & 1) * 8);
                    vcur[ks] = cat8(v0, v1); }
#pragma unroll
                for (int ks = 0; ks < 4; ++ks) if (2 * ks <= blk) a = __builtin_amdgcn_mfma_f32_16x16x32_bf16(vcur[ks], pf[ks], a, 0, 0, 0);
                o[et] = a;
                RET_KEEP(sf[0]); RET_KEEP(sf[1]);
#pragma unroll
                for (int ks = 0; ks < 4; ++ks) { RET_KEEP(vprev[ks]); vprev[ks] = vcur[ks]; }
            }
            RET_STATE_UPDATE();
#pragma unroll
            for (int ks = 0; ks < 4; ++ks) { RET_KEEP(vprev[ks]); RET_KEEP(pf[ks]); }
            RET_KEEP(qf[0]); RET_KEEP(qf[1]);
            float s = 0.f;
#pragma unroll
            for (int et = 0; et < 4; ++et) s += (o[et][0] + o[et][1]) + (o[et][2] + o[et][3]);
            s = xsum_16_32(s);
            const float mean = s * (1.f / 64.f); float q2 = 0.f;
#pragma unroll
            for (int et = 0; et < 4; ++et) { o[et] = o[et] - mean; q2 += (o[et][0] * o[et][0] + o[et][1] * o[et][1]) + (o[et][2] * o[et][2] + o[et][3] * o[et][3]); }
            q2 = xsum_16_32(q2);
            const float rstd = 1.f / sqrtf(q2 * (1.f / 64.f) + LN_EPS);
#pragma unroll
            for (int et = 0; et < 4; ++et) {
                const float g0 = __uint_as_float(gg[et].x << 16), g1 = __uint_as_float(gg[et].x & 0xffff0000u), g2 = __uint_as_float(gg[et].y << 16), g3 = __uint_as_float(gg[et].y & 0xffff0000u);
                u32x2 wv; wv.x = pk2(o[et][0] * rstd * g0, o[et][1] * rstd * g1); wv.y = pk2(o[et][2] * rstd * g2, o[et][3] * rstd * g3);
                *(GAS u32x2*)(CAT + row * DM + h * 64 + 16 * et + 4 * g) = wv; asm volatile("s_nop 1" :: "v"(wv.x), "v"(wv.y) : "memory"); }
        }
        else { RET_STATE_UPDATE(); }
        __syncthreads();
    }
#undef RET_DMA
#undef RET_STATE_UPDATE
#undef RET_KEEP
}
}
#ifndef MOE_TAILSPLIT
#define MOE_TAILSPLIT 1
#endif
constexpr int MK_TAB_OFF = 131072 + 512, MK_TOKS_OFF = 131072 + 4096, MK_CW_MOEC = 70000;
namespace pg8 {
struct MUnit : Unit { int kind, hm; };
template <int MODE>
struct MoeMk {
    static constexpr int G = 256;
    int nMt, n1, c, l; unsigned need; const LAS unsigned char* ldsb; const bf16* Wgu; const bf16* Wd; gu32* ctl;
    __device__ __forceinline__ const LAS int* tab() const { return (const LAS int*)(ldsb + MK_TAB_OFF); }
    __device__ __forceinline__ const LAS int* toks() const { return (const LAS int*)(ldsb + MK_TOKS_OFF); }
    __device__ __forceinline__ unsigned* ready() const { return (unsigned*)(ctl + MK_CW_MOEC + l * 288 * 64); }
    __device__ __forceinline__ bool next(int i, MUnit& u) const {
        long L = (long)i * G + c; int kind = MODE; u.hm = 0;
        if (MODE == 2) {
            const int q = n1 / G, rem = n1 % G, q1 = q + (c < rem ? 1 : 0);
            if (i < q1) kind = 0;
            else { kind = 1; const int j = i - q1, light = G - rem, F = (n1 - light) / G, part = (n1 - light) % G; long k;
                if (rem == 0) k = (long)j * G + c;
                else if (c >= rem) { if (j == 0) k = c - rem; else if (j <= F) k = light + (long)(j - 1) * G + c; else if (j == F + 1 && (c - rem) < part) k = light + (long)F * G + (c - rem); else return false; }
                else { if (j < F) k = light + (long)j * G + c; else return false; }
                if (k >= n1) return false; L = k; }
        } else if (MOE_TAILSPLIT && MODE == 0) {
            const int NF = (n1 / G) * G;
            if (L >= NF) { const long hidx = L - NF; if (hidx >= 2L * (n1 - NF)) return false; L = NF + (hidx >> 1); u.hm = 1 + (int)(hidx & 1); }
        } else if (L >= n1) return false;
        const int nN = 4, nwg = n1; int wgid = (int)L; { const int q = nwg / NXCD, r = nwg % NXCD, xcd = wgid % NXCD, off = wgid / NXCD; wgid = (xcd < r ? xcd * (q + 1) : r * (q + 1) + (xcd - r) * q) + off; }
        const int nig = WGM * nN, gid = wgid / nig, fm = gid * WGM, gsz = (nMt - fm) < WGM ? (nMt - fm) : WGM;
        u.pm = fm + ((wgid % nig) % gsz); u.pn = (wgid % nig) / gsz; u.kind = kind; return true;
    }
    __device__ __forceinline__ int kdim(const MUnit& u) const { return u.kind ? DE : DM; }
    __device__ __forceinline__ void setup(const MUnit& u, const int (&Rl)[2], const int (&Cb)[2], unsigned (&off)[2][2], const char*& bptr, int ui) const {
        const int e = tab()[1 + u.pm] & 255;
        if (u.kind == 0) {
#pragma unroll
            for (int h = 0; h < 2; ++h)
#pragma unroll
                for (int i = 0; i < 2; ++i) off[h][i] = (unsigned)WS_S1 + (unsigned)(toks()[ui * 256 + h * 128 + Rl[i]] * DM * 2 + Cb[i]);
            bptr = (const char*)Wgu + (size_t)(e * 4 + u.pn) * 256 * DM * 2;
        } else {
#pragma unroll
            for (int h = 0; h < 2; ++h)
#pragma unroll
                for (int i = 0; i < 2; ++i) off[h][i] = (unsigned)WS_HE + (unsigned)((u.pm * 256 + h * 128 + Rl[i]) * DE * 2 + Cb[i]);
            bptr = (const char*)Wd + (size_t)(e * 4 + u.pn) * 256 * DE * 2;
        }
    }
    __device__ __forceinline__ void a_ready(const MUnit& u) const {
        if (MODE != 2 || u.kind == 0) return;
        if (threadIdx.x < 64) {
            unsigned* rd = ready() + 64 * u.pm; unsigned* tmo = (unsigned*)ctl;
            const unsigned long long t0 = __builtin_amdgcn_s_memrealtime(); unsigned polls = 0;
            while ((unsigned)__builtin_amdgcn_readfirstlane(__hip_atomic_load(rd, __ATOMIC_RELAXED, __HIP_MEMORY_SCOPE_AGENT)) < need) {
                if ((++polls & 255u) == 0u && __builtin_amdgcn_readfirstlane(__hip_atomic_load(tmo, __ATOMIC_RELAXED, __HIP_MEMORY_SCOPE_AGENT)) != 0u) break;
                if (__builtin_amdgcn_s_memrealtime() - t0 > 2000000ull) { if (threadIdx.x == 0) __hip_atomic_store(tmo, 1u, __ATOMIC_RELAXED, __HIP_MEMORY_SCOPE_AGENT); break; }
                __builtin_amdgcn_s_sleep(2); }
#if defined(MOE_ACQ) && MOE_ACQ
            __builtin_amdgcn_fence(__ATOMIC_ACQUIRE, "agent");
#endif
            asm volatile("s_waitcnt vmcnt(0)" ::: "memory");
        }
        asm volatile("" ::: "memory"); __builtin_amdgcn_s_barrier(); asm volatile("" ::: "memory");
    }
    __device__ __forceinline__ void done(const MUnit& u) const {
        if (MODE != 2 || u.kind != 0) return;
        asm volatile("s_waitcnt vmcnt(0)" ::: "memory");
        if ((threadIdx.x & 63) == 0) __hip_atomic_fetch_add(ready() + 64 * u.pm, 1u, __ATOMIC_RELAXED, __HIP_MEMORY_SCOPE_AGENT);
    }
};
struct EpiGateUpWT {
    static constexpr bool PERM = true;
    bf16* HE;
    __device__ __forceinline__ void operator()(const f32x4 (&acc)[2][2][4][2], const Unit& u, int wr, int wc, int fr, int fq, int hm = 0) const {
        const __amdgpu_buffer_rsrc_t rs = __builtin_amdgcn_make_buffer_rsrc((void*)HE, 0, PAIR_ROWS * DE * 2, 0x00020000);
        EPI_T_LANES(); const int row0 = u.pm * BM + wr * 64 + fr2, col0 = u.pn * 128 + wc * 32 + 8 * fq2;
#pragma unroll
        for (int ai = 0; ai < 2; ++ai) if (hm == 0 || hm == 1 + ai)
#pragma unroll
            for (int m = 0; m < 4; ++m) { const f32x4 g0 = acc[ai][0][m][0], g1 = acc[ai][0][m][1], u0 = acc[ai][1][m][0], u1 = acc[ai][1][m][1];
                u32x4 w;
#if W_SILUFOLD
                w.x = gu2(g0[0], g0[1], u0[0], u0[1]); w.y = gu2(g0[2], g0[3], u0[2], u0[3]); w.z = gu2(g1[0], g1[1], u1[0], u1[1]); w.w = gu2(g1[2], g1[3], u1[2], u1[3]);
#else
                w.x = cvt_pk_bf16(fsilu(g0[0]) * u0[0], fsilu(g0[1]) * u0[1]); w.y = cvt_pk_bf16(fsilu(g0[2]) * u0[2], fsilu(g0[3]) * u0[3]);
                w.z = cvt_pk_bf16(fsilu(g1[0]) * u1[0], fsilu(g1[1]) * u1[1]); w.w = cvt_pk_bf16(fsilu(g1[2]) * u1[2], fsilu(g1[3]) * u1[3]);
#endif
                __builtin_amdgcn_raw_buffer_store_b128(tr4(w, src4), rs, (int)(((size_t)(row0 + ai * HALF + m * 16) * DE + col0) * 2), 0, 16); }
    }
};

template <class Sched, class Epi0, class Epi1>
__device__ __forceinline__ void gemm_phase_mk(LAS unsigned char* lds, const char* gA, const Sched& S, const Epi0& E0, const Epi1& E1) {
    int tid_ = threadIdx.x; asm volatile("" : "+v"(tid_));
    const int tid = tid_, wid = __builtin_amdgcn_readfirstlane(tid >> 6), lane = tid & 63, wr = wid >> 2, wc = wid & 3, fr = lane & 15, fq = lane >> 4;
    int Rl[2], Cb[2], Rbp[2];
#pragma unroll
    for (int i = 0; i < 2; ++i) { int R, C; stage_rc(tid * 16 + i * 8192, R, C); Rbp[i] = (R & ~31) + perm32(R & 31); Rl[i] = R; Cb[i] = C * 2; }
    const size_t kstep = (size_t)(BK * 2);
    const unsigned ldsw = (unsigned)wid * 1024u;
    const int aoff = lds_byte(wr * 64 + fr, fq * 8), boff = lds_byte(wc * 32 + fr, fq * 8);
#define PG8_SA(b, h) (((b) * 2 + (h)) * HTB)
#define PG8_SB(b, h) ((4 + (b) * 2 + (h)) * HTB)
#define PG8_STAGE(bufoff, gbase, voff) do { _Pragma("unroll") for (int _i = 0; _i < 2; ++_i) \
        __builtin_amdgcn_global_load_lds((const unsigned*)((const char*)(gbase) + (voff)[_i]), (LAS unsigned*)(lds + (bufoff) + ldsw + _i * 8192), 16, 0, 0); } while (0)
#define PG8_LDA(dst, b, h) do { _Pragma("unroll") for (int m = 0; m < 4; ++m) _Pragma("unroll") for (int k = 0; k < 2; ++k) dst[m][k] = *(const LAS bf16x8*)(lds + PG8_SA(b, h) + aoff + m * 2048 + k * 1024); } while (0)
#define PG8_LDB(dst, b, h) do { _Pragma("unroll") for (int n = 0; n < 2; ++n) _Pragma("unroll") for (int k = 0; k < 2; ++k) dst[n][k] = *(const LAS bf16x8*)(lds + PG8_SB(b, h) + boff + n * 2048 + k * 1024); } while (0)
#define PG8_MMA(ai, bj, At, Bt) do { __builtin_amdgcn_s_setprio(1); _Pragma("unroll") for (int m = 0; m < 4; ++m) _Pragma("unroll") for (int n = 0; n < 2; ++n) _Pragma("unroll") for (int k = 0; k < 2; ++k) \
        acc[ai][bj][m][n] = __builtin_amdgcn_mfma_f32_16x16x32_bf16(Bt[n][k], At[m][k], acc[ai][bj][m][n], 0, 0, 0); __builtin_amdgcn_s_setprio(0); } while (0)
#define PG8_WAIT_V(n) asm volatile("s_waitcnt vmcnt(" #n ")" ::: "memory")
#define PG8_WAIT_L(n) asm volatile("s_waitcnt lgkmcnt(" #n ")" ::: "memory")
#define PG8_BAR __builtin_amdgcn_s_barrier()
#define PG8_SCHED __builtin_amdgcn_sched_barrier(0)
    MUnit cur, nxt; int ui = 0;
    if (!S.next(0, cur)) return;
    f32x4 acc[2][2][4][2];
#pragma unroll
    for (int a = 0; a < 2; ++a)
#pragma unroll
        for (int b = 0; b < 2; ++b)
#pragma unroll
            for (int m = 0; m < 4; ++m)
#pragma unroll
                for (int n = 0; n < 2; ++n) acc[a][b][m][n] = (f32x4){0.f, 0.f, 0.f, 0.f};
    bf16x8 At[4][2], B0[2][2], B1[2][2];
    unsigned oc[2][2], on[2][2], vBc[2], vBn[2]; const char* cB; const char* nB; size_t hsc, hsn; int ntc, ntn;
    { const int Kc = S.kdim(cur); ntc = Kc / BK; hsc = (size_t)HALF * Kc * 2;
#pragma unroll
      for (int i = 0; i < 2; ++i) vBc[i] = (unsigned)(Rbp[i] * Kc * 2 + Cb[i]); }
    S.setup(cur, Rl, Cb, oc, cB, 0);
    S.a_ready(cur);
    PG8_STAGE(PG8_SB(0, 0), cB, vBc); PG8_STAGE(PG8_SB(0, 1), cB + hsc, vBc); PG8_STAGE(PG8_SA(0, 0), gA, oc[0]); PG8_STAGE(PG8_SA(0, 1), gA, oc[1]);
    if (wr == 1) PG8_BAR;
    PG8_WAIT_V(2); PG8_BAR;
    PG8_STAGE(PG8_SB(1, 0), cB + kstep, vBc); PG8_STAGE(PG8_SA(1, 0), gA + kstep, oc[0]); PG8_STAGE(PG8_SB(1, 1), cB + hsc + kstep, vBc);
    PG8_WAIT_V(6); PG8_BAR;
    for (;;) {
        const bool has_next = S.next(ui + 1, nxt);
        if (has_next) { S.setup(nxt, Rl, Cb, on, nB, ui + 1); const int Kn = S.kdim(nxt); ntn = Kn / BK; hsn = (size_t)HALF * Kn * 2;
#pragma unroll
            for (int i = 0; i < 2; ++i) vBn[i] = (unsigned)(Rbp[i] * Kn * 2 + Cb[i]); }
        else { nB = cB; hsn = hsc; ntn = ntc;
#pragma unroll
            for (int i = 0; i < 2; ++i) vBn[i] = vBc[i];
#pragma unroll
            for (int h = 0; h < 2; ++h)
#pragma unroll
                for (int i = 0; i < 2; ++i) on[h][i] = oc[h][i]; }
        const bool do0 = cur.hm != 2, do1 = cur.hm != 1;
        for (int t = 0; t < ntc; t += 2) {
            const bool last = (t == ntc - 2);
            const char* a1 = gA + (size_t)(t + 1) * kstep;
            const char* a2 = last ? gA : gA + (size_t)(t + 2) * kstep; const char* b2 = last ? nB : cB + (size_t)(t + 2) * kstep;
            const char* a3 = a2 + kstep; const char* b3 = b2 + kstep;
            unsigned o2[2][2], v2[2]; const size_t hs2 = last ? hsn : hsc;
#pragma unroll
            for (int i = 0; i < 2; ++i) v2[i] = last ? vBn[i] : vBc[i];
#pragma unroll
            for (int h = 0; h < 2; ++h)
#pragma unroll
                for (int i = 0; i < 2; ++i) o2[h][i] = last ? on[h][i] : oc[h][i];
            if (last && has_next) S.a_ready(nxt);
            PG8_LDB(B0, 0, 0); PG8_LDB(B1, 0, 1); PG8_SCHED; if (do0) PG8_LDA(At, 0, 0); PG8_STAGE(PG8_SA(1, 1), a1, oc[1]);
            PG8_WAIT_V(8); PG8_WAIT_L(0); PG8_BAR; if (do0) { PG8_MMA(0, 0, At, B0); PG8_MMA(0, 1, At, B1); } PG8_BAR; PG8_SCHED;
            if (do1) PG8_LDA(At, 0, 1); PG8_STAGE(PG8_SB(0, 0), b2, v2); PG8_STAGE(PG8_SB(0, 1), b2 + hs2, v2); PG8_STAGE(PG8_SA(0, 0), a2, o2[0]);
            PG8_WAIT_V(8); PG8_WAIT_L(0); PG8_BAR; if (do1) { PG8_MMA(1, 0, At, B0); PG8_MMA(1, 1, At, B1); } PG8_BAR; PG8_SCHED;
            PG8_LDB(B0, 1, 0); PG8_LDB(B1, 1, 1); PG8_SCHED; if (do0) PG8_LDA(At, 1, 0); PG8_STAGE(PG8_SA(0, 1), a2, o2[1]);
            PG8_WAIT_V(8); PG8_WAIT_L(0); PG8_BAR; if (do0) { PG8_MMA(0, 0, At, B0); PG8_MMA(0, 1, At, B1); } PG8_BAR; PG8_SCHED;
            if (do1) PG8_LDA(At, 1, 1); PG8_STAGE(PG8_SB(1, 0), b3, v2); PG8_STAGE(PG8_SB(1, 1), b3 + hs2, v2); PG8_STAGE(PG8_SA(1, 0), a3, o2[0]);
            PG8_WAIT_V(8); PG8_WAIT_L(0); PG8_BAR; if (do1) { PG8_MMA(1, 0, At, B0); PG8_MMA(1, 1, At, B1); } PG8_BAR; PG8_SCHED;
        }
        if (wr == 0) PG8_BAR;
        if (cur.kind == 0) E0(acc, cur, wr, wc, fr, fq, cur.hm); else E1(acc, cur, wr, wc, fr, fq, cur.hm);
        S.done(cur);
        if (!has_next) break;
#pragma unroll
        for (int a = 0; a < 2; ++a)
#pragma unroll
            for (int b = 0; b < 2; ++b)
#pragma unroll
                for (int m = 0; m < 4; ++m)
#pragma unroll
                    for (int n = 0; n < 2; ++n) acc[a][b][m][n] = (f32x4){0.f, 0.f, 0.f, 0.f};
        cur = nxt; cB = nB; hsc = hsn; ntc = ntn; ++ui;
#pragma unroll
        for (int i = 0; i < 2; ++i) vBc[i] = vBn[i];
#pragma unroll
        for (int h = 0; h < 2; ++h)
#pragma unroll
            for (int i = 0; i < 2; ++i) oc[h][i] = on[h][i];
        if (wr == 1) PG8_BAR;
    }
    PG8_WAIT_V(0);
    PG8_BAR;
#undef PG8_SA
#undef PG8_SB
#undef PG8_STAGE
#undef PG8_LDA
#undef PG8_LDB
#undef PG8_MMA
#undef PG8_WAIT_V
#undef PG8_WAIT_L
#undef PG8_BAR
#undef PG8_SCHED
}
}
namespace attn_body {
using bf16=__hip_bfloat16;
using bf16x8=__attribute__((ext_vector_type(8)))short;
using s16x4=__attribute__((ext_vector_type(4)))short;
using f32x16=__attribute__((ext_vector_type(16)))float;
using u32x4=__attribute__((ext_vector_type(4)))unsigned;
constexpr int SEQ=4096,D=64,PQ=3584,PO=1024;
constexpr int NW=8,QBLK=32,QB=QBLK*NW,KVBLK=64,NQB=SEQ/QB;
constexpr int ATTN_UNIT_ROWS=QB;
__device__ __forceinline__ int crow(int r,int hi){return (r&3)+8*(r>>2)+4*hi;}
#define SBAR() __builtin_amdgcn_sched_barrier(0)
__device__ __forceinline__ void cmask(f32x16&p0,f32x16&p1,int jb,int qrel,int hi){
  const float NEG=-INFINITY; int kb=64*jb+4*hi;
  #pragma unroll
  for(int r=0;r<16;++r){int kv=kb+(r&3)+8*(r>>2); if(kv>qrel)p0[r]=NEG; if(kv+32>qrel)p1[r]=NEG;}
}

constexpr int NSLOT=3, SLOTB=8192;
constexpr int LDS_K=0, LDS_V=NSLOT*SLOTB, LDS_WS=2*NSLOT*SLOTB, LDS_OST=LDS_WS+NW*64*4, LDS_BYTES=LDS_OST+NW*4096;
constexpr float C2=0.125f*1.4426950408889634f;
__device__ __forceinline__ void glds16(const void*gsrc,unsigned lds_dst){unsigned keep;
  asm volatile("s_mov_b32 %0, m0\n\ts_mov_b32 m0, %2\n\ts_nop 0\n\tglobal_load_lds_dwordx4 %1, off\n\ts_mov_b32 m0, %0":"=&s"(keep):"v"(gsrc),"s"(lds_dst):"memory");}
__device__ __forceinline__ float max3f(float a,float b,float c){float r;asm("v_max3_f32 %0, %1, %2, %3":"=v"(r):"v"(a),"v"(b),"v"(c));return r;}
__device__ __forceinline__ float max2f(float a,float b){float r;asm("v_max_f32_e32 %0, %1, %2":"=v"(r):"v"(a),"v"(b));return r;}
__device__ __forceinline__ float fadd_s(float a,float b){float r;asm("v_add_f32_e32 %0, %1, %2":"=v"(r):"v"(a),"v"(b));return r;}
__device__ __forceinline__ float fsub_s(float a,float b){float r;asm("v_sub_f32_e32 %0, %1, %2":"=v"(r):"v"(a),"v"(b));return r;}
typedef float f32x2_t __attribute__((ext_vector_type(2))); typedef __bf16 bf16x2_t __attribute__((ext_vector_type(2)));
__device__ __forceinline__ unsigned cvtpk_s(float lo,float hi){f32x2_t v={lo,hi};bf16x2_t b=__builtin_convertvector(v,bf16x2_t);return __builtin_bit_cast(unsigned,b);}
#define WAIT_BAR(N) asm volatile("s_waitcnt vmcnt(" #N ") lgkmcnt(0)\n\ts_barrier":::"memory")

__device__ __forceinline__ void qkt(f32x16&p0,f32x16&p1,const char*Kslot,const bf16x8*qr,const f32x16&negm,int r32,int hi){
  const char*kb=Kslot+hi*1024+r32*16;
  #pragma unroll
  for(int d0=0;d0<4;++d0){
    const bf16x8 b0=*reinterpret_cast<const bf16x8*>(kb+d0*2048);
    const bf16x8 b1=*reinterpret_cast<const bf16x8*>(kb+d0*2048+512);
    if(d0==0){p0=__builtin_amdgcn_mfma_f32_32x32x16_bf16(b0,qr[0],negm,0,0,0);p1=__builtin_amdgcn_mfma_f32_32x32x16_bf16(b1,qr[0],negm,0,0,0);}
    else{p0=__builtin_amdgcn_mfma_f32_32x32x16_bf16(b0,qr[d0],p0,0,0,0);p1=__builtin_amdgcn_mfma_f32_32x32x16_bf16(b1,qr[d0],p1,0,0,0);}}
}
typedef __attribute__((address_space(3))) const char* lds_cptr;
typedef short v4i16_t __attribute__((ext_vector_type(4)));
__device__ __forceinline__ void kload8(bf16x8*kf,lds_cptr kp){
  kf[0]=*(const __attribute__((address_space(3))) bf16x8*)(kp);      kf[1]=*(const __attribute__((address_space(3))) bf16x8*)(kp+512);
  kf[2]=*(const __attribute__((address_space(3))) bf16x8*)(kp+2048); kf[3]=*(const __attribute__((address_space(3))) bf16x8*)(kp+2560);
  kf[4]=*(const __attribute__((address_space(3))) bf16x8*)(kp+4096); kf[5]=*(const __attribute__((address_space(3))) bf16x8*)(kp+4608);
  kf[6]=*(const __attribute__((address_space(3))) bf16x8*)(kp+6144); kf[7]=*(const __attribute__((address_space(3))) bf16x8*)(kp+6656);
}
__device__ __forceinline__ void kload2(bf16x8*kf,lds_cptr kp,int j){ kf[2*j]=*(const __attribute__((address_space(3))) bf16x8*)(kp+j*2048); kf[2*j+1]=*(const __attribute__((address_space(3))) bf16x8*)(kp+j*2048+512); }
__device__ __forceinline__ s16x4 vtr(lds_cptr p){ return __builtin_bit_cast(s16x4,__builtin_amdgcn_ds_read_tr16_b64_v4i16((__attribute__((address_space(3))) v4i16_t*)p)); }
__device__ __forceinline__ float rowmax(const f32x16&p0,const f32x16&p1){
  float a=max3f(p0[0],p0[1],p1[0]),b=max3f(p0[2],p0[3],p1[1]);a=max3f(a,p1[2],p1[3]);
  #pragma unroll
  for(int r=4;r<16;r+=4){a=max3f(a,p0[r],p0[r+1]);b=max3f(b,p0[r+2],p0[r+3]);a=max3f(a,p1[r],p1[r+1]);b=max3f(b,p1[r+2],p1[r+3]);}
  const float m=max2f(a,b);
  auto rr=__builtin_amdgcn_permlane32_swap(__float_as_uint(m),__float_as_uint(m),false,false);
  return max2f(__uint_as_float(rr[0]),__uint_as_float(rr[1]));
}
__device__ __forceinline__ void pv(f32x16*o,int vb,bf16x8 pa0,bf16x8 pa1,bf16x8 pa2,bf16x8 pa3){
  #pragma unroll
  for(int d0=0;d0<2;++d0){s16x4 lo[4],hi[4];
    #pragma unroll
    for(int ks=0;ks<4;++ks){
      asm volatile("ds_read_b64_tr_b16 %0,%1 offset:%c2":"=&v"(lo[ks]):"v"(vb),"i"(d0*4096+ks*1024):"memory");
      asm volatile("ds_read_b64_tr_b16 %0,%1 offset:%c2":"=&v"(hi[ks]):"v"(vb),"i"(d0*4096+ks*1024+512):"memory");}
    asm volatile("s_waitcnt lgkmcnt(0)":::"memory");SBAR();
    #define PK(k) (bf16x8){lo[k][0],lo[k][1],lo[k][2],lo[k][3],hi[k][0],hi[k][1],hi[k][2],hi[k][3]}
    o[d0]=__builtin_amdgcn_mfma_f32_32x32x16_bf16(pa0,PK(0),o[d0],0,0,0);
    o[d0]=__builtin_amdgcn_mfma_f32_32x32x16_bf16(pa1,PK(1),o[d0],0,0,0);
    o[d0]=__builtin_amdgcn_mfma_f32_32x32x16_bf16(pa2,PK(2),o[d0],0,0,0);
    o[d0]=__builtin_amdgcn_mfma_f32_32x32x16_bf16(pa3,PK(3),o[d0],0,0,0);
    #undef PK
  }
}

#ifndef ATTN_STORE16
#define ATTN_STORE16(p,v) (*(u32x4*)(p)=(v))
#endif
template<int THRL> __device__ __forceinline__ void attn_unit(int qb,const bf16*Qh,const bf16*__restrict__ Kh,const bf16*__restrict__ Vh,bf16*Oh,char*shm){
  int tid_=threadIdx.x; asm volatile("":"+v"(tid_));
  const int tid=tid_,lane=tid&63,r32=lane&31,hi=lane>>5; const int wid=__builtin_amdgcn_readfirstlane(tid>>6);
  const int q0=qb*QB;
  const bf16*Qw=Qh+(long)(q0+wid*QBLK)*PQ;
  const unsigned lds0=(unsigned)(uintptr_t)shm;
  float*wsf=(float*)(shm+LDS_WS)+wid*64;
  const bf16*ksrc=Kh+(long)lane*PQ+wid*8;
  const bf16*vsrc=Vh+(long)(16*(wid&3)+(lane>>2))*PQ+(wid>>2)*32+(lane&3)*8;
  const unsigned kdst=lds0+LDS_K+wid*1024, vdst=lds0+LDS_V+wid*1024;
  #define DMA_K(t,slot) glds16(ksrc+(long)(t)*KVBLK*PQ,(unsigned)__builtin_amdgcn_readfirstlane(kdst+(slot)))
  #define DMA_V(t,slot) glds16(vsrc+(long)(t)*KVBLK*PQ,(unsigned)__builtin_amdgcn_readfirstlane(vdst+(slot)))
  const int vb0=(int)(lds0+LDS_V)+((lane>>4)&1)*32+(lane&3)*8+(4*hi+((lane&15)>>2))*64;
  const char*Kbase=shm+LDS_K; bf16x8 kf[8];
  const lds_cptr shm3=(lds_cptr)shm; const lds_cptr kp0=shm3+LDS_K+hi*1024+r32*16; const lds_cptr vp0=shm3+LDS_V+((lane>>4)&1)*32+(lane&3)*8+(4*hi+((lane&15)>>2))*64;
  const int NT=(q0+QB)/KVBLK;
  DMA_K(0,0);DMA_V(0,0);DMA_K(1,SLOTB);
  bf16x8 qr[4];
  #pragma unroll
  for(int d0=0;d0<4;++d0)qr[d0]=*reinterpret_cast<const bf16x8*>(&Qw[(long)r32*PQ+d0*16+hi*8]);
  float mhat=0.f,l_reg=0.f;f32x16 o[2];o[0]=f32x16{};o[1]=f32x16{};f32x16 negm=f32x16{};asm volatile("":"+v"(negm));
  const int qrel=wid*QBLK+r32;
  #define CMASK(P0,P1,t) do{int jb_=(t)-(NT-4); if(jb_>=0)cmask(P0,P1,jb_,qrel,hi);}while(0)
  bool resc=false;
  #define START(P0,P1) do{ const float rm=rowmax(P0,P1); resc=false; \
    { const float dl=rm; mhat=fadd_s(mhat,dl); \
      _Pragma("unroll") for(int r=0;r<16;++r){P0[r]=fsub_s(P0[r],dl);P1[r]=fsub_s(P1[r],dl);} \
      _Pragma("unroll") for(int r=0;r<16;++r)negm[r]=-mhat; asm volatile("":"+v"(negm)); } \
    _Pragma("unroll") for(int r=0;r<16;++r)P0[r]=__builtin_amdgcn_exp2f(P0[r]); }while(0)
  #define RESC() do{ if(resc){ asm volatile("s_waitcnt lgkmcnt(0)":::"memory"); \
      _Pragma("unroll") for(int d_=0;d_<2;++d_) _Pragma("unroll") for(int r=0;r<16;++r)o[d_][r]*=wsf[crow(r,hi)]; } }while(0)
  f32x16 pA0,pA1,pB0,pB1;
  int sl_prev=0,sl_cur=0,sl_next=SLOTB;
  #define ROT() do{sl_prev=sl_cur;sl_cur=sl_next;sl_next=(sl_next==(NSLOT-1)*SLOTB)?0:sl_next+SLOTB;}while(0)
  DMA_K(2,2*SLOTB);
  WAIT_BAR(3);
  qkt(pA0,pA1,Kbase,qr,negm,r32,hi);asm volatile("s_nop 15\n\ts_nop 7":"+v"(pA0),"+v"(pA1));CMASK(pA0,pA1,0);
  START(pA0,pA1);
  _Pragma("unroll") for(int r=0;r<16;++r)pA1[r]=__builtin_amdgcn_exp2f(pA1[r]);
  WAIT_BAR(0);
  DMA_K(3,0);DMA_V(1,SLOTB);
  ROT();
  kload8(kf,kp0+sl_cur);
  WAIT_BAR(2);
  s16x4 vlo[8],vhi[8]; u32x4 pw0,pw1,pw2,pw3;
  #define PKW(P,B) cvtpk_s(P[B],P[B+1])
  #define PAF(k) __builtin_bit_cast(bf16x8,pw##k)
  #define VFR(i) (bf16x8){vlo[i][0],vlo[i][1],vlo[i][2],vlo[i][3],vhi[i][0],vhi[i][1],vhi[i][2],vhi[i][3]}
  #define PIN(x) asm volatile("":"+v"(x))
  #define MX3(a,b,c) __builtin_fmaxf(__builtin_fmaxf((a),(b)),(c))
  #define GAPA(MF,A0,A1,A2,A3,W0,W1,PW) do{ MF; sacc+=A0; sacc+=A1; sacc+=A2; sacc+=A3; PIN(sacc); W0; W1; PIN(PW); SBAR(); }while(0)
  #define EX(v) __builtin_amdgcn_exp2f(v)
  #define GAPB(MF,X,B) do{ MF; X[B]=EX(X[B]); X[B+1]=EX(X[B+1]); X[B+2]=EX(X[B+2]); X[B+3]=EX(X[B+3]); PIN(X); SBAR(); }while(0)
  #define VRD(i) do{ vlo[i]=vtr(vp_+(((i)>>2)*4096+((i)&3)*1024)); vhi[i]=vtr(vp_+(((i)>>2)*4096+((i)&3)*1024+512)); }while(0)
  #define KRD(G,j) do{ if(G){ kload2(kf,kp0+sl_next,j); SBAR(); } }while(0)
  #define STEP(C0,C1,P0,P1,t,GK,GV,GL) do{ SBAR(); \
    const lds_cptr vp_=vp0+sl_prev; \
    VRD(0); SBAR(); float sacc=(P0[0]+P0[1]); \
    GAPA(C0=__builtin_amdgcn_mfma_f32_32x32x16_bf16(kf[0],qr[0],negm,0,0,0), P0[2],P0[3],P0[4],P0[5],     pw0[0]=PKW(P0,0), pw0[1]=PKW(P0,2), pw0); \
    VRD(4); SBAR(); GAPA(C1=__builtin_amdgcn_mfma_f32_32x32x16_bf16(kf[1],qr[0],negm,0,0,0), P0[6],P0[7],P0[8],P0[9],     pw0[2]=PKW(P0,4), pw0[3]=PKW(P0,6), pw0); \
    VRD(1); SBAR(); GAPA(C0=__builtin_amdgcn_mfma_f32_32x32x16_bf16(kf[2],qr[1],C0,0,0,0),   P0[10],P0[11],P0[12],P0[13], pw1[0]=PKW(P0,8), pw1[1]=PKW(P0,10), pw1); \
    VRD(5); SBAR(); GAPA(C1=__builtin_amdgcn_mfma_f32_32x32x16_bf16(kf[3],qr[1],C1,0,0,0),   P0[14],P0[15],P1[0],P1[1],   pw1[2]=PKW(P0,12),pw1[3]=PKW(P0,14), pw1); \
    VRD(2); SBAR(); GAPA(C0=__builtin_amdgcn_mfma_f32_32x32x16_bf16(kf[4],qr[2],C0,0,0,0),   P1[2],P1[3],P1[4],P1[5],     pw2[0]=PKW(P1,0), pw2[1]=PKW(P1,2), pw2); \
    VRD(6); SBAR(); GAPA(C1=__builtin_amdgcn_mfma_f32_32x32x16_bf16(kf[5],qr[2],C1,0,0,0),   P1[6],P1[7],P1[8],P1[9],     pw2[2]=PKW(P1,4), pw2[3]=PKW(P1,6), pw2); \
    VRD(3); SBAR(); GAPA(C0=__builtin_amdgcn_mfma_f32_32x32x16_bf16(kf[6],qr[3],C0,0,0,0),   P1[10],P1[11],P1[12],P1[13], pw3[0]=PKW(P1,8), pw3[1]=PKW(P1,10), pw3); \
    VRD(7); SBAR(); GAPA(C1=__builtin_amdgcn_mfma_f32_32x32x16_bf16(kf[7],qr[3],C1,0,0,0),   P1[14],P1[15],0.f,0.f,       pw3[2]=PKW(P1,12),pw3[3]=PKW(P1,14), pw3); \
    l_reg+=sacc; \
    if(GK){DMA_K((t)+3,sl_cur);} if(GV){DMA_V((t)+1,sl_next);} \
    CMASK(C0,C1,t); \
    { float a=MX3(C0[0],C0[1],C1[0]),b=MX3(C0[2],C0[3],C1[1]); a=MX3(a,C1[2],C1[3]); \
      _Pragma("unroll") for(int r=4;r<16;r+=4){a=MX3(a,C0[r],C0[r+1]);b=MX3(b,C0[r+2],C0[r+3]);a=MX3(a,C1[r],C1[r+1]);b=MX3(b,C1[r+2],C1[r+3]);} \
      float rm=__builtin_fmaxf(a,b); { auto rr=__builtin_amdgcn_permlane32_swap(__float_as_uint(rm),__float_as_uint(rm),false,false); rm=__builtin_fmaxf(__uint_as_float(rr[0]),__uint_as_float(rr[1])); } \
      resc=false; \
      if(__builtin_expect(__any(rm>(float)THRL),0)){ const float dl=__builtin_fmaxf(rm,0.f); mhat+=dl; \
        _Pragma("unroll") for(int r=0;r<16;++r){C0[r]-=dl;C1[r]-=dl;} \
        _Pragma("unroll") for(int r=0;r<16;++r)negm[r]=-mhat; asm volatile("":"+v"(negm)); \
        const float f=__builtin_amdgcn_exp2f(-dl); l_reg*=f; if(hi==0)wsf[r32]=f; resc=true; } } \
    SBAR(); \
    GAPB(o[0]=__builtin_amdgcn_mfma_f32_32x32x16_bf16(PAF(0),VFR(0),o[0],0,0,0), C0,0); \
    GAPB(o[1]=__builtin_amdgcn_mfma_f32_32x32x16_bf16(PAF(0),VFR(4),o[1],0,0,0), C0,4); \
    KRD(GL,0); GAPB(o[0]=__builtin_amdgcn_mfma_f32_32x32x16_bf16(PAF(1),VFR(1),o[0],0,0,0), C0,8); \
    KRD(GL,1); GAPB(o[1]=__builtin_amdgcn_mfma_f32_32x32x16_bf16(PAF(1),VFR(5),o[1],0,0,0), C0,12); \
    KRD(GL,2); GAPB(o[0]=__builtin_amdgcn_mfma_f32_32x32x16_bf16(PAF(2),VFR(2),o[0],0,0,0), C1,0); \
    KRD(GL,3); GAPB(o[1]=__builtin_amdgcn_mfma_f32_32x32x16_bf16(PAF(2),VFR(6),o[1],0,0,0), C1,4); \
    GAPB(o[0]=__builtin_amdgcn_mfma_f32_32x32x16_bf16(PAF(3),VFR(3),o[0],0,0,0), C1,8); \
    GAPB(o[1]=__builtin_amdgcn_mfma_f32_32x32x16_bf16(PAF(3),VFR(7),o[1],0,0,0), C1,12); \
    }while(0)
  int t=1;
  #undef CMASK
  #define CMASK(P0,P1,t) do{}while(0)
  for(;t+5<NT;t+=2){
    STEP(pB0,pB1,pA0,pA1,t,true,true,true);     WAIT_BAR(2); RESC(); ROT();
    STEP(pA0,pA1,pB0,pB1,t+1,true,true,true);   WAIT_BAR(2); RESC(); ROT();
  }
  #undef CMASK
  #define CMASK(P0,P1,t) do{int jb_=(t)-(NT-4); if(jb_>=0)cmask(P0,P1,jb_,qrel,hi);}while(0)
  #define ENDW(tt) do{ if((tt)+3<NT){WAIT_BAR(2);} else if((tt)+2<NT){WAIT_BAR(1);} else {WAIT_BAR(0);} }while(0)
  for(;t+1<NT;t+=2){
    STEP(pB0,pB1,pA0,pA1,t,(t+3<NT),(t+1<NT),(t+1<NT));       ENDW(t);   RESC(); ROT();
    STEP(pA0,pA1,pB0,pB1,t+1,(t+4<NT),(t+2<NT),(t+2<NT));     ENDW(t+1); RESC(); ROT();
  }
  STEP(pB0,pB1,pA0,pA1,NT-1,false,false,false); RESC();
  { float sacc=pB0[0]+pB0[1]; _Pragma("unroll") for(int r=2;r<16;++r)sacc+=pB0[r]; _Pragma("unroll") for(int r=0;r<16;++r)sacc+=pB1[r]; l_reg+=sacc;
    pw0=(u32x4){PKW(pB0,0),PKW(pB0,2),PKW(pB0,4),PKW(pB0,6)};pw1=(u32x4){PKW(pB0,8),PKW(pB0,10),PKW(pB0,12),PKW(pB0,14)};pw2=(u32x4){PKW(pB1,0),PKW(pB1,2),PKW(pB1,4),PKW(pB1,6)};pw3=(u32x4){PKW(pB1,8),PKW(pB1,10),PKW(pB1,12),PKW(pB1,14)};
    SBAR(); pv(o,vb0+sl_cur,PAF(0),PAF(1),PAF(2),PAF(3)); }
  #undef PKW
  #undef PAF
  #undef VFR
  #undef PIN
  #undef MX3
  #undef GAPA
  #undef GAPB
  #undef EX
  #undef VRD
  #undef KRD
  #undef STEP
  #undef ENDW
  {auto rr=__builtin_amdgcn_permlane32_swap(__float_as_uint(l_reg),__float_as_uint(l_reg),false,false);l_reg=__uint_as_float(rr[0])+__uint_as_float(rr[1]);}
  if(hi==0)wsf[32+r32]=l_reg;asm volatile("s_waitcnt lgkmcnt(0)":::"memory");
  float rli[16];
  #pragma unroll
  for(int r=0;r<16;++r)rli[r]=__builtin_amdgcn_rcpf(wsf[32+crow(r,hi)]);
  bf16*Ow=Oh+(long)(q0+wid*QBLK)*PO;
  { bf16*stg=(bf16*)(shm+LDS_OST)+wid*2048;
    #pragma unroll
    for(int r=0;r<16;++r){const int orow=crow(r,hi);
      #pragma unroll
      for(int d0=0;d0<2;++d0)stg[orow*64+d0*32+r32]=__float2bfloat16(o[d0][r]*rli[r]);}
    asm volatile("s_waitcnt lgkmcnt(0)":::"memory");
    #pragma unroll
    for(int i=0;i<4;++i){const int row=i*8+(lane>>3),ch=lane&7; const u32x4 v=*(const u32x4*)(stg+row*64+ch*8); ATTN_STORE16(Ow+(long)row*PO+ch*8,v);} }
  asm volatile("s_waitcnt lgkmcnt(0)\n\ts_barrier":::"memory");
  #undef DMA_K
  #undef DMA_V
  #undef CMASK
  #undef START
  #undef RESC
  #undef ROT
}
constexpr int ATTN_LDS_BYTES=LDS_BYTES;
#undef SBAR
#undef WAIT_BAR
}
#ifndef ATTN_PRIO
#define ATTN_PRIO 1
#endif
#ifndef ATTN_STAG
#define ATTN_STAG 0
#endif
#ifndef ATTN_MIDPOS
#define ATTN_MIDPOS 0
#endif
namespace attn128 {
using bf16=__hip_bfloat16;
using bf16x8=__attribute__((ext_vector_type(8)))short;
using s16x4=__attribute__((ext_vector_type(4)))short;
using f32x16=__attribute__((ext_vector_type(16)))float;
using u32x4=__attribute__((ext_vector_type(4)))unsigned;
constexpr int SEQ=4096,D=64,PQ=3584,PO=1024;
constexpr int NW=8,QBLK=32,QB=QBLK*NW,KVBLK=64,NQB=SEQ/QB;
constexpr int ATTN_UNIT_ROWS=QB;
__device__ __forceinline__ int crow(int r,int hi){return (r&3)+8*(r>>2)+4*hi;}
#define SBAR() __builtin_amdgcn_sched_barrier(0)
__device__ __forceinline__ void cmask(f32x16&p0,f32x16&p1,int jb,int qrel,int hi){
  const float NEG=-INFINITY; int kb=64*jb+4*hi;
  #pragma unroll
  for(int r=0;r<16;++r){int kv=kb+(r&3)+8*(r>>2); if(kv>qrel)p0[r]=NEG; if(kv+32>qrel)p1[r]=NEG;}
}

constexpr int NSLOT=3, SLOTB=8192;
constexpr int LDS_K=0, LDS_V=NSLOT*SLOTB, LDS_WS=LDS_V+NSLOT*2*SLOTB, LDS_OST=LDS_WS+NW*64*4, LDS_BYTES=LDS_OST+NW*4096;
constexpr float C2=0.125f*1.4426950408889634f;
__device__ __forceinline__ void glds16(const void*gsrc,unsigned lds_dst){unsigned keep;
  asm volatile("s_mov_b32 %0, m0\n\ts_mov_b32 m0, %2\n\ts_nop 0\n\tglobal_load_lds_dwordx4 %1, off\n\ts_mov_b32 m0, %0":"=&s"(keep):"v"(gsrc),"s"(lds_dst):"memory");}
__device__ __forceinline__ float max3f(float a,float b,float c){float r;asm("v_max3_f32 %0, %1, %2, %3":"=v"(r):"v"(a),"v"(b),"v"(c));return r;}
__device__ __forceinline__ float max2f(float a,float b){float r;asm("v_max_f32_e32 %0, %1, %2":"=v"(r):"v"(a),"v"(b));return r;}
__device__ __forceinline__ float fadd_s(float a,float b){float r;asm("v_add_f32_e32 %0, %1, %2":"=v"(r):"v"(a),"v"(b));return r;}
__device__ __forceinline__ float fsub_s(float a,float b){float r;asm("v_sub_f32_e32 %0, %1, %2":"=v"(r):"v"(a),"v"(b));return r;}
typedef float f32x2_t __attribute__((ext_vector_type(2))); typedef __bf16 bf16x2_t __attribute__((ext_vector_type(2)));
__device__ __forceinline__ unsigned cvtpk_s(float lo,float hi){f32x2_t v={lo,hi};bf16x2_t b=__builtin_convertvector(v,bf16x2_t);return __builtin_bit_cast(unsigned,b);}
#define WAIT_BAR(N) asm volatile("s_waitcnt vmcnt(" #N ") lgkmcnt(0)\n\ts_barrier":::"memory")
#define MID_BAR(N) asm volatile("s_waitcnt vmcnt(" #N ")\n\ts_barrier":::"memory")

__device__ __forceinline__ void qkt(f32x16&p0,f32x16&p1,const char*Kslot,const bf16x8*qr,int r32,int hi){ const f32x16 negm=f32x16{};
  const char*kb=Kslot+hi*1024+r32*16;
  #pragma unroll
  for(int d0=0;d0<4;++d0){
    const bf16x8 b0=*reinterpret_cast<const bf16x8*>(kb+d0*2048);
    const bf16x8 b1=*reinterpret_cast<const bf16x8*>(kb+d0*2048+512);
    if(d0==0){p0=__builtin_amdgcn_mfma_f32_32x32x16_bf16(b0,qr[0],negm,0,0,0);p1=__builtin_amdgcn_mfma_f32_32x32x16_bf16(b1,qr[0],negm,0,0,0);}
    else{p0=__builtin_amdgcn_mfma_f32_32x32x16_bf16(b0,qr[d0],p0,0,0,0);p1=__builtin_amdgcn_mfma_f32_32x32x16_bf16(b1,qr[d0],p1,0,0,0);}}
}
typedef __attribute__((address_space(3))) const char* lds_cptr;
typedef short v4i16_t __attribute__((ext_vector_type(4)));
__device__ __forceinline__ void kload8(bf16x8*kf,lds_cptr kp){
  kf[0]=*(const __attribute__((address_space(3))) bf16x8*)(kp);      kf[1]=*(const __attribute__((address_space(3))) bf16x8*)(kp+512);
  kf[2]=*(const __attribute__((address_space(3))) bf16x8*)(kp+2048); kf[3]=*(const __attribute__((address_space(3))) bf16x8*)(kp+2560);
  kf[4]=*(const __attribute__((address_space(3))) bf16x8*)(kp+4096); kf[5]=*(const __attribute__((address_space(3))) bf16x8*)(kp+4608);
  kf[6]=*(const __attribute__((address_space(3))) bf16x8*)(kp+6144); kf[7]=*(const __attribute__((address_space(3))) bf16x8*)(kp+6656);
}
__device__ __forceinline__ void kload2(bf16x8*kf,lds_cptr kp,int j){ kf[2*j]=*(const __attribute__((address_space(3))) bf16x8*)(kp+j*2048); kf[2*j+1]=*(const __attribute__((address_space(3))) bf16x8*)(kp+j*2048+512); }
__device__ __forceinline__ s16x4 vtr(lds_cptr p){ return __builtin_bit_cast(s16x4,__builtin_amdgcn_ds_read_tr16_b64_v4i16((__attribute__((address_space(3))) v4i16_t*)p)); }
__device__ __forceinline__ float rowmax(const f32x16&p0,const f32x16&p1){
  float a=max3f(p0[0],p0[1],p1[0]),b=max3f(p0[2],p0[3],p1[1]);a=max3f(a,p1[2],p1[3]);
  #pragma unroll
  for(int r=4;r<16;r+=4){a=max3f(a,p0[r],p0[r+1]);b=max3f(b,p0[r+2],p0[r+3]);a=max3f(a,p1[r],p1[r+1]);b=max3f(b,p1[r+2],p1[r+3]);}
  const float m=max2f(a,b);
  auto rr=__builtin_amdgcn_permlane32_swap(__float_as_uint(m),__float_as_uint(m),false,false);
  return max2f(__uint_as_float(rr[0]),__uint_as_float(rr[1]));
}
__device__ __forceinline__ void pv(f32x16*o,int vb,bf16x8 pa0,bf16x8 pa1,bf16x8 pa2,bf16x8 pa3){
  #pragma unroll
  for(int d0=0;d0<4;++d0){s16x4 lo[4],hi[4];
    #pragma unroll
    for(int ks=0;ks<4;++ks){
      asm volatile("ds_read_b64_tr_b16 %0,%1 offset:%c2":"=&v"(lo[ks]):"v"(vb),"i"(d0*4096+ks*1024):"memory");
      asm volatile("ds_read_b64_tr_b16 %0,%1 offset:%c2":"=&v"(hi[ks]):"v"(vb),"i"(d0*4096+ks*1024+512):"memory");}
    asm volatile("s_waitcnt lgkmcnt(0)":::"memory");SBAR();
    #define PK(k) (bf16x8){lo[k][0],lo[k][1],lo[k][2],lo[k][3],hi[k][0],hi[k][1],hi[k][2],hi[k][3]}
    o[d0]=__builtin_amdgcn_mfma_f32_32x32x16_bf16(pa0,PK(0),o[d0],0,0,0);
    o[d0]=__builtin_amdgcn_mfma_f32_32x32x16_bf16(pa1,PK(1),o[d0],0,0,0);
    o[d0]=__builtin_amdgcn_mfma_f32_32x32x16_bf16(pa2,PK(2),o[d0],0,0,0);
    o[d0]=__builtin_amdgcn_mfma_f32_32x32x16_bf16(pa3,PK(3),o[d0],0,0,0);
    #undef PK
  }
}

#if 0
#define ATTN_STORE16(p,v) (*(u32x4*)(p)=(v))
#endif
template<int THRL,int DRY=0> __device__ __forceinline__ void attn_unit(int qb,const bf16*Qh,const bf16*__restrict__ Kh,const bf16*__restrict__ Vh,bf16*Oh,char*shm){
  int tid_=threadIdx.x; asm volatile("":"+v"(tid_));
  const int tid=tid_,lane=tid&63,r32=lane&31,hi=lane>>5; const int wid=__builtin_amdgcn_readfirstlane(tid>>6);
  const int q0=qb*QB; const bool grp=ATTN_STAG&&(wid>>2);
  const bf16*Qw=Qh+(long)(q0+wid*QBLK)*PQ;
  const unsigned lds0=(unsigned)(uintptr_t)shm;
  float*wsf=(float*)(shm+LDS_WS)+wid*64;
  const bf16*ksrc=Kh+(long)lane*PQ+wid*8;
  const bf16*vsrc=Vh+(long)(16*(wid&3)+(lane>>2))*PQ+(wid>>2)*32+(lane&3)*8;
  const unsigned kdst=lds0+LDS_K+wid*1024, vdst=lds0+LDS_V+wid*1024;
  #define DMA_K(t,slot) glds16(ksrc+(long)(t)*KVBLK*PQ,(unsigned)__builtin_amdgcn_readfirstlane(kdst+(slot)))
  #define DMA_V(t,slot) do{ glds16(vsrc+(long)(t)*KVBLK*PQ,(unsigned)__builtin_amdgcn_readfirstlane(vdst+2*(slot))); glds16(vsrc+64+(long)(t)*KVBLK*PQ,(unsigned)__builtin_amdgcn_readfirstlane(vdst+2*(slot)+8192)); }while(0)
  const int vb0=(int)(lds0+LDS_V)+((lane>>4)&1)*32+(lane&3)*8+(4*hi+((lane&15)>>2))*64;
  const char*Kbase=shm+LDS_K; bf16x8 kf[8];
  const lds_cptr shm3=(lds_cptr)shm; const lds_cptr kp0=shm3+LDS_K+hi*1024+r32*16; const lds_cptr vp0=shm3+LDS_V+((lane>>4)&1)*32+(lane&3)*8+(4*hi+((lane&15)>>2))*64;
  const int NT=(q0+QB)/KVBLK;
  bf16x8 qr[4];
  #pragma unroll
  for(int d0=0;d0<4;++d0)qr[d0]=*reinterpret_cast<const bf16x8*>(&Qw[(long)r32*PQ+d0*16+hi*8]);
  DMA_K(0,0);DMA_V(0,0);DMA_K(1,SLOTB);DMA_K(2,2*SLOTB);
  { bf16x8* qst=(bf16x8*)(shm+LDS_OST+wid*4096);
    #pragma unroll
    for(int d0=0;d0<4;++d0)qst[(d0*2+hi)*32+r32]=qr[d0]; }
  const lds_cptr qp0=shm3+LDS_OST+wid*4096+(hi*32+r32)*16;
  #define QLD(d0) (*(const __attribute__((address_space(3))) bf16x8*)(qp0+(d0)*1024))
  float mhat=0.f,l_reg=0.f;f32x16 o[4];o[0]=f32x16{};o[1]=f32x16{};o[2]=f32x16{};o[3]=f32x16{};
  const int qrel=wid*QBLK+r32;
  #define CMASK(P0,P1,t) do{int jb_=(t)-(NT-4); if(jb_>=0)cmask(P0,P1,jb_,qrel,hi);}while(0)
  bool resc=false;
  #define START(P0,P1) do{ const float rm=rowmax(P0,P1); resc=false; \
    { const float dl=rm; mhat=fadd_s(mhat,dl); \
      _Pragma("unroll") for(int r=0;r<16;++r){P0[r]=fsub_s(P0[r],dl);P1[r]=fsub_s(P1[r],dl);} \
      } \
    _Pragma("unroll") for(int r=0;r<16;++r)P0[r]=__builtin_amdgcn_exp2f(P0[r]); }while(0)
  #define RESC() do{ if(resc){ asm volatile("s_waitcnt lgkmcnt(0)":::"memory"); \
      _Pragma("unroll") for(int d_=0;d_<4;++d_) _Pragma("unroll") for(int r=0;r<16;++r)o[d_][r]*=wsf[crow(r,hi)]; } }while(0)
  f32x16 pA0,pA1,pB0,pB1;
  int sl_prev=0,sl_cur=0,sl_next=SLOTB;
  #define ROT() do{sl_prev=sl_cur;sl_cur=sl_next;sl_next=(sl_next==(NSLOT-1)*SLOTB)?0:sl_next+SLOTB;}while(0)
  if(grp){ WAIT_BAR(4); WAIT_BAR(0); }
  else WAIT_BAR(4);
  qkt(pA0,pA1,Kbase,qr,r32,hi);asm volatile("s_nop 15\n\ts_nop 7":"+v"(pA0),"+v"(pA1));CMASK(pA0,pA1,0);
  START(pA0,pA1);
  _Pragma("unroll") for(int r=0;r<16;++r)pA1[r]=__builtin_amdgcn_exp2f(pA1[r]);
  WAIT_BAR(0);
  if(!ATTN_STAG||grp){DMA_K(3,0);DMA_V(1,SLOTB);}
  ROT();
  kload8(kf,kp0+sl_cur);
  WAIT_BAR(3);
  if(ATTN_STAG&&!grp){DMA_K(3,0);DMA_V(1,SLOTB);}
  s16x4 vlo[8],vhi[8]; u32x4 pw0,pw1,pw2,pw3;
  #define PKW(P,B) cvtpk_s(P[B],P[B+1])
  #define PAF(k) __builtin_bit_cast(bf16x8,pw##k)
  #define VFR(i) (bf16x8){vlo[i][0],vlo[i][1],vlo[i][2],vlo[i][3],vhi[i][0],vhi[i][1],vhi[i][2],vhi[i][3]}
  #define PIN(x) asm volatile("":"+v"(x))
  #define MX3(a,b,c) __builtin_fmaxf(__builtin_fmaxf((a),(b)),(c))
  #define GAPA(MF,A0,A1,A2,A3,W0,W1,PW) do{ MF; if(!(DRY&1)){ sacc+=A0; sacc+=A1; sacc+=A2; sacc+=A3; PIN(sacc); W0; W1; PIN(PW); } SBAR(); }while(0)
  #define EX(v) __builtin_amdgcn_exp2f(v)
  #define GAPB(MF,X,B) do{ MF; if(!(DRY&2)){ X[B]=X[B]-mhat; X[B+1]=X[B+1]-mhat; PIN(X); X[B]=EX(X[B]); X[B+1]=EX(X[B+1]); PIN(X); } SBAR(); }while(0)
  #define KEEPF(x) asm volatile(""::"v"(x))
  #define KEEPV(i) do{ asm volatile(""::"v"(vlo[i]),"v"(vhi[i])); }while(0)
  #define VRD2(i) do{ if(DRY&4)break; vlo[i]=vtr(vp_+((((i)>>2)+2)*4096+((i)&3)*1024)); vhi[i]=vtr(vp_+((((i)>>2)+2)*4096+((i)&3)*1024+512)); SBAR(); }while(0)
  #define VRD(i) do{ if(DRY&4)break; vlo[i]=vtr(vp_+(((i)>>2)*4096+((i)&3)*1024)); vhi[i]=vtr(vp_+(((i)>>2)*4096+((i)&3)*1024+512)); }while(0)
  #define KRD(G,j) do{ if((G)&&!(DRY&16)){ kload2(kf,kp0+sl_next,j); SBAR(); } }while(0)
  #define MIDB(pos,MW,GK,GV,t) do{ if(ATTN_STAG&&(pos)==ATTN_MIDPOS){ if((MW)==3)MID_BAR(3); else if((MW)==2)MID_BAR(2); else MID_BAR(0); SBAR(); \
      if(!grp){ if(GK&&!(DRY&8)){DMA_K((t)+3,sl_cur);} if(GV&&!(DRY&8)){DMA_V((t)+1,sl_next);} } SBAR(); } }while(0)
  #define STEP(C0,C1,P0,P1,t,GK,GV,GL,MW) do{ SBAR(); const f32x16 zero16=f32x16{}; const bf16x8 ql0=QLD(0),ql1=QLD(1),ql2=QLD(2),ql3=QLD(3); \
    const lds_cptr vp_=vp0+2*sl_prev; \
    VRD(0); SBAR(); float sacc=(P0[0]+P0[1]); \
    GAPA(C0=__builtin_amdgcn_mfma_f32_32x32x16_bf16(kf[0],ql0,zero16,0,0,0), P0[2],P0[3],P0[4],P0[5],     pw0[0]=PKW(P0,0), pw0[1]=PKW(P0,2), pw0); \
    VRD(4); SBAR(); GAPA(C1=__builtin_amdgcn_mfma_f32_32x32x16_bf16(kf[1],ql0,zero16,0,0,0), P0[6],P0[7],P0[8],P0[9],     pw0[2]=PKW(P0,4), pw0[3]=PKW(P0,6), pw0); \
    VRD(1); SBAR(); KEEPF(kf[0]); GAPA(C0=__builtin_amdgcn_mfma_f32_32x32x16_bf16(kf[2],ql1,C0,0,0,0),   P0[10],P0[11],P0[12],P0[13], pw1[0]=PKW(P0,8), pw1[1]=PKW(P0,10), pw1); \
    VRD(5); SBAR(); KEEPF(kf[1]); KEEPF(ql0); GAPA(C1=__builtin_amdgcn_mfma_f32_32x32x16_bf16(kf[3],ql1,C1,0,0,0),   P0[14],P0[15],P1[0],P1[1],   pw1[2]=PKW(P0,12),pw1[3]=PKW(P0,14), pw1); \
    VRD(2); SBAR(); KEEPF(kf[2]); GAPA(C0=__builtin_amdgcn_mfma_f32_32x32x16_bf16(kf[4],ql2,C0,0,0,0),   P1[2],P1[3],P1[4],P1[5],     pw2[0]=PKW(P1,0), pw2[1]=PKW(P1,2), pw2); \
    VRD(6); SBAR(); KEEPF(kf[3]); KEEPF(ql1); GAPA(C1=__builtin_amdgcn_mfma_f32_32x32x16_bf16(kf[5],ql2,C1,0,0,0),   P1[6],P1[7],P1[8],P1[9],     pw2[2]=PKW(P1,4), pw2[3]=PKW(P1,6), pw2); \
    VRD(3); SBAR(); KEEPF(kf[4]); GAPA(C0=__builtin_amdgcn_mfma_f32_32x32x16_bf16(kf[6],ql3,C0,0,0,0),   P1[10],P1[11],P1[12],P1[13], pw3[0]=PKW(P1,8), pw3[1]=PKW(P1,10), pw3); \
    VRD(7); SBAR(); KEEPF(kf[5]); KEEPF(ql2); GAPA(C1=__builtin_amdgcn_mfma_f32_32x32x16_bf16(kf[7],ql3,C1,0,0,0),   P1[14],P1[15],0.f,0.f,       pw3[2]=PKW(P1,12),pw3[3]=PKW(P1,14), pw3); \
    l_reg+=sacc; \
    if(!ATTN_STAG||grp){ if(GK&&!(DRY&8)){DMA_K((t)+3,sl_cur);} if(GV&&!(DRY&8)){DMA_V((t)+1,sl_next);} } \
    CMASK(C0,C1,t); \
    { float a=MX3(C0[0],C0[1],C1[0]),b=MX3(C0[2],C0[3],C1[1]); a=MX3(a,C1[2],C1[3]); \
      _Pragma("unroll") for(int r=4;r<16;r+=4){a=MX3(a,C0[r],C0[r+1]);b=MX3(b,C0[r+2],C0[r+3]);a=MX3(a,C1[r],C1[r+1]);b=MX3(b,C1[r+2],C1[r+3]);} \
      float rm=__builtin_fmaxf(a,b); { auto rr=__builtin_amdgcn_permlane32_swap(__float_as_uint(rm),__float_as_uint(rm),false,false); rm=__builtin_fmaxf(__uint_as_float(rr[0]),__uint_as_float(rr[1])); } \
      resc=false; \
      rm-=mhat; \
      if(__builtin_expect(__any(rm>(float)THRL),0)){ const float dl=__builtin_fmaxf(rm,0.f); mhat+=dl; \
        const float f=__builtin_amdgcn_exp2f(-dl); l_reg*=f; if(hi==0)wsf[r32]=f; resc=true; } } \
    KEEPF(kf[6]); KEEPF(kf[7]); KEEPF(ql3); SBAR(); \
    MIDB(0,MW,GK,GV,t); \
    GAPB(o[0]=__builtin_amdgcn_mfma_f32_32x32x16_bf16(PAF(0),VFR(0),o[0],0,0,0), C0,0); \
    GAPB(o[1]=__builtin_amdgcn_mfma_f32_32x32x16_bf16(PAF(0),VFR(4),o[1],0,0,0), C0,2); \
    MIDB(2,MW,GK,GV,t); \
    KRD(GL,0); GAPB(o[0]=__builtin_amdgcn_mfma_f32_32x32x16_bf16(PAF(1),VFR(1),o[0],0,0,0), C0,4); KEEPV(0); VRD2(0); \
    KRD(GL,1); GAPB(o[1]=__builtin_amdgcn_mfma_f32_32x32x16_bf16(PAF(1),VFR(5),o[1],0,0,0), C0,6); KEEPV(4); VRD2(4); \
    MIDB(4,MW,GK,GV,t); \
    KRD(GL,2); GAPB(o[0]=__builtin_amdgcn_mfma_f32_32x32x16_bf16(PAF(2),VFR(2),o[0],0,0,0), C0,8); KEEPV(1); VRD2(1); \
    KRD(GL,3); GAPB(o[1]=__builtin_amdgcn_mfma_f32_32x32x16_bf16(PAF(2),VFR(6),o[1],0,0,0), C0,10); KEEPV(5); VRD2(5); \
    GAPB(o[0]=__builtin_amdgcn_mfma_f32_32x32x16_bf16(PAF(3),VFR(3),o[0],0,0,0), C0,12); KEEPV(2); VRD2(2); \
    GAPB(o[1]=__builtin_amdgcn_mfma_f32_32x32x16_bf16(PAF(3),VFR(7),o[1],0,0,0), C0,14); KEEPV(6); VRD2(6); \
    GAPB(o[2]=__builtin_amdgcn_mfma_f32_32x32x16_bf16(PAF(0),VFR(0),o[2],0,0,0), C1,0); KEEPV(3); VRD2(3); \
    GAPB(o[3]=__builtin_amdgcn_mfma_f32_32x32x16_bf16(PAF(0),VFR(4),o[3],0,0,0), C1,2); KEEPV(7); VRD2(7); \
    GAPB(o[2]=__builtin_amdgcn_mfma_f32_32x32x16_bf16(PAF(1),VFR(1),o[2],0,0,0), C1,4); \
    GAPB(o[3]=__builtin_amdgcn_mfma_f32_32x32x16_bf16(PAF(1),VFR(5),o[3],0,0,0), C1,6); \
    GAPB(o[2]=__builtin_amdgcn_mfma_f32_32x32x16_bf16(PAF(2),VFR(2),o[2],0,0,0), C1,8); \
    GAPB(o[3]=__builtin_amdgcn_mfma_f32_32x32x16_bf16(PAF(2),VFR(6),o[3],0,0,0), C1,10); \
    GAPB(o[2]=__builtin_amdgcn_mfma_f32_32x32x16_bf16(PAF(3),VFR(3),o[2],0,0,0), C1,12); \
    GAPB(o[3]=__builtin_amdgcn_mfma_f32_32x32x16_bf16(PAF(3),VFR(7),o[3],0,0,0), C1,14); \
    }while(0)
  if(ATTN_PRIO&&wid>=4)__builtin_amdgcn_s_setprio(1);
  int t=(DRY&32)?NT-1:1;
  #undef CMASK
  #define CMASK(P0,P1,t) do{}while(0)
  for(;t+5<NT;t+=2){
    STEP(pB0,pB1,pA0,pA1,t,true,true,true,3);     WAIT_BAR(3); RESC(); ROT();
    STEP(pA0,pA1,pB0,pB1,t+1,true,true,true,3);   WAIT_BAR(3); RESC(); ROT();
  }
  #undef CMASK
  #define CMASK(P0,P1,t) do{int jb_=(t)-(NT-4); if(jb_>=0)cmask(P0,P1,jb_,qrel,hi);}while(0)
  #define ENDW(tt) do{ if((tt)+3<NT){WAIT_BAR(3);} else if((tt)+2<NT){WAIT_BAR(2);} else {WAIT_BAR(0);} }while(0)
  for(;t+1<NT;t+=2){
    STEP(pB0,pB1,pA0,pA1,t,(t+3<NT),(t+1<NT),(t+1<NT),((t+3<NT)?3:(t+1<NT)?2:0));       ENDW(t);   RESC(); ROT();
    STEP(pA0,pA1,pB0,pB1,t+1,(t+4<NT),(t+2<NT),(t+2<NT),((t+4<NT)?3:(t+2<NT)?2:0));     ENDW(t+1); RESC(); ROT();
  }
  STEP(pB0,pB1,pA0,pA1,NT-1,false,false,false,0); RESC();
  { float sacc=pB0[0]+pB0[1]; _Pragma("unroll") for(int r=2;r<16;++r)sacc+=pB0[r]; _Pragma("unroll") for(int r=0;r<16;++r)sacc+=pB1[r]; l_reg+=sacc;
    pw0=(u32x4){PKW(pB0,0),PKW(pB0,2),PKW(pB0,4),PKW(pB0,6)};pw1=(u32x4){PKW(pB0,8),PKW(pB0,10),PKW(pB0,12),PKW(pB0,14)};pw2=(u32x4){PKW(pB1,0),PKW(pB1,2),PKW(pB1,4),PKW(pB1,6)};pw3=(u32x4){PKW(pB1,8),PKW(pB1,10),PKW(pB1,12),PKW(pB1,14)};
    SBAR(); pv(o,vb0+2*sl_cur,PAF(0),PAF(1),PAF(2),PAF(3)); }
  #undef PKW
  #undef PAF
  #undef VFR
  #undef PIN
  #undef MX3
  #undef GAPA
  #undef GAPB
  #undef EX
  #undef VRD
  #undef VRD2
  #undef KEEPF
  #undef KEEPV
  #undef KRD
  #undef STEP
  #undef MIDB
  #undef ENDW
  if(ATTN_PRIO&&wid>=4)__builtin_amdgcn_s_setprio(0);
  {auto rr=__builtin_amdgcn_permlane32_swap(__float_as_uint(l_reg),__float_as_uint(l_reg),false,false);l_reg=__uint_as_float(rr[0])+__uint_as_float(rr[1]);}
  if(hi==0)wsf[32+r32]=l_reg;asm volatile("s_waitcnt lgkmcnt(0)":::"memory");
  float rli[16];
  #pragma unroll
  for(int r=0;r<16;++r)rli[r]=__builtin_amdgcn_rcpf(wsf[32+crow(r,hi)]);
  bf16*Ow=Oh+(long)(q0+wid*QBLK)*PO;
  { bf16*stg=(bf16*)(shm+LDS_OST)+wid*2048;
    #pragma unroll
    for(int hf=0;hf<2;++hf){
    #pragma unroll
    for(int r=0;r<16;++r){const int orow=crow(r,hi);
      #pragma unroll
      for(int d0=0;d0<2;++d0)stg[orow*64+d0*32+r32]=__float2bfloat16(o[2*hf+d0][r]*rli[r]);}
    asm volatile("s_waitcnt lgkmcnt(0)":::"memory");
    #pragma unroll
    for(int i=0;i<4;++i){const int row=i*8+(lane>>3),ch=lane&7; const u32x4 v=*(const u32x4*)(stg+row*64+ch*8); ATTN_STORE16(Ow+(long)row*PO+hf*64+ch*8,v);}
    asm volatile("s_waitcnt lgkmcnt(0)":::"memory"); } }
  asm volatile("s_waitcnt lgkmcnt(0)\n\ts_barrier":::"memory");
  if(ATTN_STAG&&!grp) asm volatile("s_barrier":::"memory");
  #undef DMA_K
  #undef QLD
  #undef DMA_V
  #undef CMASK
  #undef START
  #undef RESC
  #undef ROT
}
constexpr int ATTN_LDS_BYTES=LDS_BYTES;
#undef SBAR
#undef WAIT_BAR
}
#define ST8(ptr, w) do { *(ptr) = (w); asm volatile("s_nop 1" :: "v"((w).x), "v"((w).y) : "memory"); } while (0)
#define ST4(ptr, w) do { *(ptr) = (w); asm volatile("s_nop 1" :: "v"(w) : "memory"); } while (0)
constexpr int NWAVES = 8;
constexpr int RING_OFF = 0, RING_BYTES = 131072;
constexpr int LDSCTL_OFF = RING_BYTES, MISC_OFF = LDSCTL_OFF;
constexpr int TAB_OFF = LDSCTL_OFF + 512;
constexpr int EB_OFF = LDSCTL_OFF + 2048;
constexpr int LCNT_OFF = LDSCTL_OFF + 2304;
constexpr int TOKS_OFF = LDSCTL_OFF + 4096, TOKS_UNITS = 6;
constexpr int CW_MOEC = 70000;
constexpr int LDS_BYTES = 147456;
constexpr int CW_BAR = 4096;
constexpr int NPHASE = 18;

#define XB_TMO      128
#define XB_XCNT(j)  (256  + 64 * (j))
#define XB_XSUB(j)  (1280 + 64 * (j))
#define XB_XGEN(j)  (2304 + 64 * (j))
#define XB_TOP      3328
#define XB_TOPGEN   3392
#define XCD_BAR_WORDS 3456
#define XB_SPIN_CAP (1u << 18)

__device__ __forceinline__ unsigned xb_ld(unsigned* p)              { return __hip_atomic_load(p, __ATOMIC_RELAXED, __HIP_MEMORY_SCOPE_AGENT); }
__device__ __forceinline__ unsigned xb_add(unsigned* p, unsigned v) { return __hip_atomic_fetch_add(p, v, __ATOMIC_RELAXED, __HIP_MEMORY_SCOPE_AGENT); }
__device__ __forceinline__ unsigned xb_xcc_id() { return (unsigned)__builtin_amdgcn_s_getreg((3 << 11) | 20) & 0xFu; }
#define XB_SPIN(cond, bar) do { unsigned _sp = 0; while (cond) { __builtin_amdgcn_s_sleep(1); \
    if ((++_sp & 255u) == 0u) { if (xb_ld(&(bar)[XB_TMO])) break; if (_sp > XB_SPIN_CAP) { atomicAdd(&(bar)[XB_TMO], 1u); break; } } } } while (0)

struct XcdBarrier {
    unsigned* bar; unsigned x;
    volatile LAS unsigned* st;
};

__device__ __forceinline__ XcdBarrier xcd_barrier_post(unsigned* bar, volatile LAS unsigned* st) {
    XcdBarrier b; b.bar = bar; b.x = xb_xcc_id(); b.st = st;
    if (threadIdx.x == 0) (void)xb_add(&bar[XB_XCNT(b.x)], 1u);
    return b;
}
__device__ __forceinline__ void xcd_barrier_complete(unsigned* bar, unsigned x, unsigned& nloc, unsigned& nx) {
    const unsigned G = gridDim.x * gridDim.y * gridDim.z;
    unsigned sum, cnt, mine, sp = 0u;
    for (;;) {
        sum = 0u; cnt = 0u; mine = 0u;
#pragma unroll
        for (unsigned j = 0; j < 16; ++j) { const unsigned c = xb_ld(&bar[XB_XCNT(j)]); sum += c; cnt += (c > 0u) ? 1u : 0u; mine = (j == x) ? c : mine; }
        if (sum == G) break;
        __builtin_amdgcn_s_sleep(1);
        if ((++sp & 255u) == 0u) { if (xb_ld(&bar[XB_TMO])) break; if (sp > XB_SPIN_CAP) { atomicAdd(&bar[XB_TMO], 1u); break; } }
    }
    nloc = mine > 0u ? mine : 1u; nx = cnt > 0u ? cnt : 1u;
}

__device__ __forceinline__ void xcd_barrier(const XcdBarrier& b) {
    asm volatile("s_waitcnt vmcnt(0)" ::: "memory");
    __syncthreads();
    if (threadIdx.x == 0) {
        unsigned* bar = b.bar;
        __builtin_amdgcn_s_waitcnt(0);
        unsigned nloc = b.st[0], nx = b.st[1];
        if (nloc == 0u) { xcd_barrier_complete(bar, b.x, nloc, nx); b.st[0] = nloc; b.st[1] = nx; }
        const unsigned old = xb_add(&bar[XB_XSUB(b.x)], 1u);
        const unsigned gen = old / nloc;
        if (old + 1u == (gen + 1u) * nloc) {
            __builtin_amdgcn_fence(__ATOMIC_RELEASE, "agent");
            asm volatile("s_waitcnt vmcnt(0)" ::: "memory");
            const unsigned og = xb_add(&bar[XB_TOP], 1u);
            const unsigned tg = og / nx;
            if (og + 1u == (tg + 1u) * nx) xb_add(&bar[XB_TOPGEN], 1u);
            else XB_SPIN(xb_ld(&bar[XB_TOPGEN]) == tg, bar);
            __builtin_amdgcn_fence(__ATOMIC_ACQUIRE, "agent");
            xb_add(&bar[XB_XGEN(b.x)], 1u);
            asm volatile("s_waitcnt vmcnt(0)" ::: "memory");
        } else {
            XB_SPIN(xb_ld(&bar[XB_XGEN(b.x)]) == gen, bar);
            __builtin_amdgcn_fence(__ATOMIC_ACQUIRE, "agent");
            asm volatile("s_waitcnt vmcnt(0)" ::: "memory");
        }
    }
    __syncthreads();
}


struct Frame {
    LAS unsigned char* lds; volatile LAS unsigned* MISC; gu32* ctl;
    int tid, lane, wave, vcu, G;
    const float *x, *c, *w_ada, *b_ada, *w_in, *w_out, *lq1, *lk1, *lq2, *lk2, *subln, *ln_mix_g, *ln_mix_b, *ln_ffn_g, *ln_ffn_b, *router_w, *router_b, *w_gate, *w_up, *w_down;
    float* out; unsigned char* ws;
    float* mod; float* rot; int* tok_e; float* tok_g; int* tok_slot; int* lists; bf16* Wbf;
    bf16 *S1, *S3, *PROJ, *YP, *HE, *MIXED;
};

__device__ __forceinline__ void transpose_item(const float* W, int ldw, int k0, int n0, bf16* WT, int Kdst, int drow0, LAS float* scr, int lane, float wsc = 1.f) {
    f32x4 t[8];
#pragma unroll
    for (int i = 0; i < 8; ++i) t[i] = *(const GAS f32x4*)(W + (size_t)(k0 + 8 * i + (lane >> 3)) * ldw + n0 + 4 * (lane & 7));
#pragma unroll
    for (int i = 0; i < 8; ++i) *(LAS f32x4*)(scr + (8 * i + (lane >> 3)) * 36 + 4 * (lane & 7)) = t[i];
    LDS_WAIT(); asm volatile("" ::: "memory");
    const int c = lane & 7;
#pragma unroll
    for (int j = 0; j < 4; ++j) { const int n = (lane >> 3) + 8 * j; const LAS float* s = scr + (8 * c) * 36 + n;
        u32x4 o; o.x = pk2(s[0 * 36] * wsc, s[1 * 36] * wsc); o.y = pk2(s[2 * 36] * wsc, s[3 * 36] * wsc); o.z = pk2(s[4 * 36] * wsc, s[5 * 36] * wsc); o.w = pk2(s[6 * 36] * wsc, s[7 * 36] * wsc);
        *(GAS u32x4*)(WT + (size_t)(drow0 + n) * Kdst + k0 + 8 * c) = o; }
    LDS_WAIT(); asm volatile("" ::: "memory");
}
constexpr int IT_IN = 16 * 112, IT_OUT = 16 * 32, IT_E = 256, IT_LAYER = IT_IN + IT_OUT + 3 * 16 * IT_E;
__device__ __forceinline__ void p0_weight_item(const Frame& F, int it, LAS float* scr) {
    const int l = it / IT_LAYER; int r = it - l * IT_LAYER; bf16* wl = F.Wbf + (size_t)l * WL_STRIDE;
    if (r < IT_IN) { const int kb = r / 112, c0 = (r % 112) * 32; int drow = c0;
        if (c0 < 1024) drow = (c0 & ~255) + ((c0 >> 5) & 1) * 128 + ((c0 >> 6) & 3) * 32;
        transpose_item(F.w_in + (size_t)l * DM * INW, INW, kb * 64, c0, wl + WL_IN, DM, drow, scr, F.lane, (W_C2FOLD && c0 >= C_DQ && c0 < C_DK) ? C2 : 1.f); return; }
    r -= IT_IN;
    if (r < IT_OUT) { const int kb = r / 32, c0 = (r % 32) * 32; transpose_item(F.w_out + (size_t)l * DM * DM, DM, kb * 64, c0, wl + WL_OUT, DM, c0, scr, F.lane); return; }
    r -= IT_OUT;
    const int which = r / (16 * IT_E), rr = r % (16 * IT_E), e = rr / IT_E, q = rr % IT_E;
    if (which < 2) { const int kb = q / 16, c0 = (q % 16) * 32; const float* W = (which == 0 ? F.w_gate : F.w_up) + (size_t)(l * NE + e) * DM * DE;
        transpose_item(W, DE, kb * 64, c0, wl + WL_GU, DM, e * 1024 + (c0 >> 7) * 256 + which * 128 + (c0 & 127), scr, F.lane, W_SILUFOLD ? (which == 0 ? -1.4426950408889634f : -0.6931471805599453f) : 1.f); }
    else { const int kb = q / 32, c0 = (q % 32) * 32; transpose_item(F.w_down + (size_t)(l * NE + e) * DE * DM, DM, kb * 64, c0, wl + WL_D, DE, e * 1024 + c0, scr, F.lane); }
}

#ifndef DEFER_W1
#define DEFER_W1 0
#endif
#ifndef W1_CAP1
#define W1_CAP1 4
#endif
#ifndef W1_CAP2
#define W1_CAP2 2
#endif
__device__ __forceinline__ void deferred_weights(Frame& F, int nwg, int stage) {
    LAS float* scr = (LAS float*)(F.lds + RING_OFF + F.wave * 9216);
    const int rem = nwg % F.G, I = rem ? F.G - rem : 0, slots = I * NWAVES, base1 = slots * W1_CAP1, base2 = base1 + slots * W1_CAP2;
    if (stage < 2) { if (!rem || (int)blockIdx.x < rem) return;
        const int r = ((int)blockIdx.x - rem) * NWAVES + F.wave, cap = stage == 0 ? W1_CAP1 : W1_CAP2, base = stage == 0 ? 0 : base1;
        for (int k = 0; k < cap; ++k) { const int idx = base + r + k * slots; if (idx < IT_LAYER) p0_weight_item(F, IT_LAYER + idx, scr); }
    } else { for (int idx = base2 + F.vcu * NWAVES + F.wave; idx < IT_LAYER; idx += F.G * NWAVES) p0_weight_item(F, IT_LAYER + idx, scr); }
}
__device__ __forceinline__ void ph_prologue(Frame& F) {
    LAS float* scr = (LAS float*)(F.lds + RING_OFF + F.wave * 9216);
    LAS float* cond = (LAS float*)(F.lds + RING_OFF + 73728);
    LAS float* part = (LAS float*)(F.lds + RING_OFF + 73728 + 32768);
    if ((int)blockIdx.x < 192) {
        { float cv[16];
#pragma unroll
          for (int j = 0; j < 16; ++j) cv[j] = F.c[F.tid + 512 * j];
#pragma unroll
          for (int j = 0; j < 16; ++j) cond[F.tid + 512 * j] = cv[j] / (1.f + expf(-cv[j])); }
        __syncthreads();
        for (int item = blockIdx.x; item < 192; item += F.G) {
            const int l = item / 96, j0 = (item % 96) * 64;
            float acc[8];
#pragma unroll
            for (int b = 0; b < 8; ++b) acc[b] = 0.f;
            const float* w = F.w_ada + (size_t)l * DM * MODW + (size_t)(F.wave * 128) * MODW + j0 + F.lane;
#pragma unroll 4
            for (int k = 0; k < 128; ++k) { const float wv = w[(size_t)k * MODW];
#pragma unroll
                for (int b = 0; b < 8; ++b) acc[b] += cond[b * 1024 + F.wave * 128 + k] * wv; }
#pragma unroll
            for (int b = 0; b < 8; ++b) part[(F.wave * 8 + b) * 64 + F.lane] = acc[b];
            __syncthreads();
            { const int b = F.tid >> 6, ln = F.tid & 63; float s = 0.f;
#pragma unroll
                for (int w8 = 0; w8 < 8; ++w8) s += part[(w8 * 8 + b) * 64 + ln];
                const float mv = s + F.b_ada[l * MODW + j0 + ln]; ST4(&F.mod[(size_t)(l * 8 + b) * MODW + j0 + ln], mv); }
            __syncthreads();
        }
    }
    if ((int)blockIdx.x == F.G - 1 && F.tid < 2) { const int l = F.tid; float s1 = 0.f, s2 = 0.f;
        for (int i = 0; i < 64; ++i) { s1 += F.lq1[l * 64 + i] * F.lk1[l * 64 + i]; s2 += F.lq2[l * 64 + i] * F.lk2[l * 64 + i]; }
        const float li = 0.8f - 0.6f * expf(-0.3f * (float)l);
        F.mod[2 * 8 * MODW + l] = expf(s1) - expf(s2) + li; F.mod[2 * 8 * MODW + 2 + l] = li; }
    if ((int)blockIdx.x == F.G - 2) {
        float* dt = F.mod + 2 * 8 * MODW + 16;
        for (int i = F.tid; i < 1024; i += NWAVES * 64) { const int hh = i >> 7, pp = i & 127; const double gm = 1.0 - exp2(-5.0 - (double)hh);
            dt[i] = (float)(0.125 * pow(gm, (double)(pp - 127))); dt[1024 + i] = (float)pow(gm, (double)(127 - pp)); if (pp == 0) dt[2048 + hh] = (float)pow(gm, 128.0); }
    }
    for (int idx = blockIdx.x * (NWAVES * 64) + F.tid; idx < 4096 * 32; idx += F.G * NWAVES * 64) { const int pos = idx >> 5, i = idx & 31;
        const double inv = pow(10000.0, -(double)(2 * i) / 64.0), a = (double)pos * inv;
#if ROT_T
        { const int f0 = 2 * i; F.rot[((size_t)(f0 >> 2) * SEQ + pos) * 4 + (f0 & 3)] = (float)cos(a); F.rot[((size_t)(f0 >> 2) * SEQ + pos) * 4 + (f0 & 3) + 1] = (float)sin(a); } }
#else
        F.rot[2 * idx] = (float)cos(a); F.rot[2 * idx + 1] = (float)sin(a); }
#endif

    const int gw = F.vcu * NWAVES + F.wave, NGW = F.G * NWAVES;
    for (int it = gw; it < (DEFER_W1 ? 1 : 2) * IT_LAYER; it += NGW) p0_weight_item(F, it, scr);
}
__device__ __forceinline__ void ln_mod_row(const float* xrow, const float* sh_, bf16* orow, int lane) {
    const GAS f32x4* xr = (const GAS f32x4*)xrow + lane;
    f32x4 v[4]; float s = 0.f;
#pragma unroll
    for (int j = 0; j < 4; ++j) { v[j] = xr[64 * j]; s += (v[j].x + v[j].y) + (v[j].z + v[j].w); }
    const float mean = wave_sum(s) * (1.f / DM); float s2 = 0.f;
#pragma unroll
    for (int j = 0; j < 4; ++j) { v[j] = v[j] - mean; s2 += (v[j].x * v[j].x + v[j].y * v[j].y) + (v[j].z * v[j].z + v[j].w * v[j].w); }
    const float rstd = 1.f / sqrtf(wave_sum(s2) * (1.f / DM) + LN_EPS);
    const GAS f32x4* sh = (const GAS f32x4*)sh_ + lane; const GAS f32x4* sc = sh + 256; GAS u32x2* o = (GAS u32x2*)orow + lane;
#pragma unroll
    for (int j = 0; j < 4; ++j) { const f32x4 a = sh[64 * j], m = sc[64 * j]; const f32x4 r = v[j] * rstd * (m + 1.f) + a; u32x2 w; w.x = pk2(r.x, r.y); w.y = pk2(r.z, r.w); ST8(&o[64 * j], w); }
}
__device__ __forceinline__ void ln_mod_regs(f32x4 (&v)[4], const float* sh_, bf16* orow, int lane) {
    float s = 0.f;
#pragma unroll
    for (int j = 0; j < 4; ++j) s += (v[j].x + v[j].y) + (v[j].z + v[j].w);
    const float mean = wave_sum(s) * (1.f / DM); float s2 = 0.f;
#pragma unroll
    for (int j = 0; j < 4; ++j) { v[j] = v[j] - mean; s2 += (v[j].x * v[j].x + v[j].y * v[j].y) + (v[j].z * v[j].z + v[j].w * v[j].w); }
    const float rstd = 1.f / sqrtf(wave_sum(s2) * (1.f / DM) + LN_EPS);
    const GAS f32x4* sh = (const GAS f32x4*)sh_ + lane; const GAS f32x4* sc = sh + 256; GAS u32x2* o = (GAS u32x2*)orow + lane;
    f32x4 a[4], mm[4];
#pragma unroll
    for (int j = 0; j < 4; ++j) { a[j] = sh[64 * j]; mm[j] = sc[64 * j]; }
#pragma unroll
    for (int j = 0; j < 4; ++j) { const f32x4 r = v[j] * rstd * (mm[j] + 1.f) + a[j]; u32x2 w; w.x = pk2(r.x, r.y); w.y = pk2(r.z, r.w); ST8(&o[64 * j], w); }
}
__device__ __forceinline__ void ph_ln0(Frame& F) {
    const int gw = F.vcu * NWAVES + F.wave, NGW = F.G * NWAVES;
#pragma unroll 1
    for (int m = gw; m < T; m += 2 * NGW) { int lane = F.lane; asm volatile("" : "+v"(lane));
        const int m2 = m + NGW;
        const GAS f32x4* xa = (const GAS f32x4*)(F.x + (size_t)m * DM) + lane; const GAS f32x4* xb = (const GAS f32x4*)(F.x + (size_t)m2 * DM) + lane;
        f32x4 va[4], vb[4];
#pragma unroll
        for (int j = 0; j < 4; ++j) { va[j] = xa[64 * j]; vb[j] = xb[64 * j]; }
        ln_mod_regs(va, F.mod + (size_t)(m / SEQ) * MODW, F.S1 + (size_t)m * DM, lane);
        ln_mod_regs(vb, F.mod + (size_t)(m2 / SEQ) * MODW, F.S1 + (size_t)m2 * DM, lane); }
}
__device__ __forceinline__ float sane_c(float v) { return (fabsf(v) < 1e4f) ? v : 0.f; }
__device__ __forceinline__ void ph_combine(Frame& F, int l) {
    const int gw = F.vcu * NWAVES + F.wave, NGW = F.G * NWAVES, lane = F.lane;
    const float lam = F.mod[2 * 8 * MODW + l], li = F.mod[2 * 8 * MODW + 2 + l];
#if ATTN128
    const int h = lane >> 4, q = lane & 15, vh0 = (h * 2 + 0) * 2, vh1 = (h * 2 + 1) * 2, d = 8 * q;
#else
    const int h = lane >> 4, q = lane & 15, vh0 = (h * 2 + 0) * 2 + (q >> 3), vh1 = (h * 2 + 1) * 2 + (q >> 3), d = 8 * (q & 7);
#endif
    const f32x4 g0 = *(const f32x4*)(F.subln + l * 128 + 8 * q), g1 = *(const f32x4*)(F.subln + l * 128 + 8 * q + 4);
#pragma unroll 1
    for (int m0 = gw; m0 < T; m0 += 2 * NGW) {
        u32x4 av[2], bv[2];
#pragma unroll
        for (int t = 0; t < 2; ++t) { const int m = m0 + t * NGW; av[t] = *(const GAS u32x4*)(F.S3 + (size_t)m * DM + vh0 * 64 + d); bv[t] = *(const GAS u32x4*)(F.S3 + (size_t)m * DM + vh1 * 64 + d); }
#pragma unroll
        for (int t = 0; t < 2; ++t) { const int m = m0 + t * NGW; const u32x4 a = av[t], b = bv[t];
        float v[8];
        v[0] = __uint_as_float(a.x << 16) - lam * __uint_as_float(b.x << 16); v[1] = __uint_as_float(a.x & 0xffff0000u) - lam * __uint_as_float(b.x & 0xffff0000u);
        v[2] = __uint_as_float(a.y << 16) - lam * __uint_as_float(b.y << 16); v[3] = __uint_as_float(a.y & 0xffff0000u) - lam * __uint_as_float(b.y & 0xffff0000u);
        v[4] = __uint_as_float(a.z << 16) - lam * __uint_as_float(b.z << 16); v[5] = __uint_as_float(a.z & 0xffff0000u) - lam * __uint_as_float(b.z & 0xffff0000u);
        v[6] = __uint_as_float(a.w << 16) - lam * __uint_as_float(b.w << 16); v[7] = __uint_as_float(a.w & 0xffff0000u) - lam * __uint_as_float(b.w & 0xffff0000u);
#pragma unroll
        for (int i = 0; i < 8; ++i) v[i] = sane_c(v[i]);
        float ss = 0.f;
#pragma unroll
        for (int i = 0; i < 8; ++i) ss += v[i] * v[i];
        ss = row16_sum(ss);
        const float r = (1.f - li) / sqrtf(ss * (1.f / 128.f) + LN_EPS);
        u32x4 w; w.x = pk2(v[0] * r * g0.x, v[1] * r * g0.y); w.y = pk2(v[2] * r * g0.z, v[3] * r * g0.w); w.z = pk2(v[4] * r * g1.x, v[5] * r * g1.y); w.w = pk2(v[6] * r * g1.z, v[7] * r * g1.w);
        *(GAS u32x4*)(F.S1 + (size_t)m * DM + 512 + h * 128 + 8 * q) = w; }
    }
}
#ifndef FUSE_COMBINE
#define FUSE_COMBINE 1
#endif
__device__ __forceinline__ void attn_combine(Frame& F, int l, int b, int h, int qb) {
    int lane = threadIdx.x & 63; asm volatile("" : "+v"(lane));
    const int wave = __builtin_amdgcn_readfirstlane((int)(threadIdx.x >> 6)), rr = lane >> 4, q = lane & 15;
    const float lam = F.mod[2 * 8 * MODW + l], li = F.mod[2 * 8 * MODW + 2 + l];
    const f32x4 g0 = *(const f32x4*)(F.subln + l * 128 + 8 * q), g1 = *(const f32x4*)(F.subln + l * 128 + 8 * q + 4);
    const size_t row0 = (size_t)b * SEQ + (size_t)qb * 256 + wave * 32 + rr;
    asm volatile("s_waitcnt vmcnt(0)" ::: "memory");
#pragma unroll
    for (int half = 0; half < 2; ++half) {
        u32x4 av[4], bv[4];
#pragma unroll
        for (int t = 0; t < 4; ++t) { const size_t m = row0 + 4 * (4 * half + t);
            av[t] = *(const GAS u32x4*)(F.S3 + m * DM + (h * 2 + 0) * 128 + 8 * q); bv[t] = *(const GAS u32x4*)(F.S3 + m * DM + (h * 2 + 1) * 128 + 8 * q); }
#pragma unroll
        for (int t = 0; t < 4; ++t) { const size_t m = row0 + 4 * (4 * half + t); const u32x4 a = av[t], bb = bv[t];
            float v[8];
            v[0] = __uint_as_float(a.x << 16) - lam * __uint_as_float(bb.x << 16); v[1] = __uint_as_float(a.x & 0xffff0000u) - lam * __uint_as_float(bb.x & 0xffff0000u);
            v[2] = __uint_as_float(a.y << 16) - lam * __uint_as_float(bb.y << 16); v[3] = __uint_as_float(a.y & 0xffff0000u) - lam * __uint_as_float(bb.y & 0xffff0000u);
            v[4] = __uint_as_float(a.z << 16) - lam * __uint_as_float(bb.z << 16); v[5] = __uint_as_float(a.z & 0xffff0000u) - lam * __uint_as_float(bb.z & 0xffff0000u);
            v[6] = __uint_as_float(a.w << 16) - lam * __uint_as_float(bb.w << 16); v[7] = __uint_as_float(a.w & 0xffff0000u) - lam * __uint_as_float(bb.w & 0xffff0000u);
#pragma unroll
            for (int i = 0; i < 8; ++i) v[i] = sane_c(v[i]);
            float ss = 0.f;
#pragma unroll
            for (int i = 0; i < 8; ++i) ss += v[i] * v[i];
            ss = row16_sum(ss);
            const float r = (1.f - li) / sqrtf(ss * (1.f / 128.f) + LN_EPS);
            u32x4 w; w.x = pk2(v[0] * r * g0.x, v[1] * r * g0.y); w.y = pk2(v[2] * r * g0.z, v[3] * r * g0.w); w.z = pk2(v[4] * r * g1.x, v[5] * r * g1.y); w.w = pk2(v[6] * r * g1.z, v[7] * r * g1.w);
            *(GAS u32x4*)(F.S1 + m * DM + 512 + h * 128 + 8 * q) = w; }
    }
}
__device__ __forceinline__ f32x4 bf4(u32x2 m) { f32x4 r; r.x = __uint_as_float(m.x << 16); r.y = __uint_as_float(m.x & 0xffff0000u); r.z = __uint_as_float(m.y << 16); r.w = __uint_as_float(m.y & 0xffff0000u); return r; }
__device__ __forceinline__ float sane(float v, float lim) { return (fabsf(v) < lim) ? v : 0.f; }
__device__ __forceinline__ f32x4 sane4(f32x4 v, float lim) { v.x = sane(v.x, lim); v.y = sane(v.y, lim); v.z = sane(v.z, lim); v.w = sane(v.w, lim); return v; }
#ifndef X2_BF16
#define X2_BF16 1
#endif
typedef float f32x2 __attribute__((ext_vector_type(2)));
struct PmRaw { f32x4 x[4]; u32x2 xb[4]; u32x2 m[4]; };
template <bool XBF>
__device__ __forceinline__ void pm_load(PmRaw& R, const void* xin, const bf16* MIXED, int row, int lane) {
    const GAS u32x2* mr = (const GAS u32x2*)(MIXED + (size_t)row * DM) + lane;
    if (XBF) { const GAS u32x2* xr = (const GAS u32x2*)((const bf16*)xin + (size_t)row * DM) + lane;
#pragma unroll
        for (int j = 0; j < 4; ++j) { R.xb[j] = xr[64 * j]; R.m[j] = mr[64 * j]; }
    } else { const GAS f32x4* xr = (const GAS f32x4*)((const float*)xin + (size_t)row * DM) + lane;
#pragma unroll
        for (int j = 0; j < 4; ++j) { R.x[j] = xr[64 * j]; R.m[j] = mr[64 * j]; } }
}
template <bool XBF>
__device__ __forceinline__ void pm_row(const PmRaw& R, const f32x4 (&g1)[4], const f32x4 (&lg)[4], const f32x4 (&lb)[4], const f32x4 (&sc2)[4], const f32x4 (&sh2)[4],
                                       bf16* X1, bf16* H, const LAS float* rwT, LAS float* lgs, int row, int r, int lane, bool norouter) {
    f32x4 v[4];
    float s = 0.f;
#pragma unroll
    for (int j = 0; j < 4; ++j) { v[j] = (XBF ? sane4(bf4(R.xb[j]), 1e4f) : R.x[j]) * ALPHA + g1[j] * sane4(bf4(R.m[j]), 1e4f); s += (v[j].x + v[j].y) + (v[j].z + v[j].w); }
    float mean = wave_sum(s) * (1.f / DM), s2 = 0.f;
#pragma unroll
    for (int j = 0; j < 4; ++j) { v[j] = v[j] - mean; s2 += (v[j].x * v[j].x + v[j].y * v[j].y) + (v[j].z * v[j].z + v[j].w * v[j].w); }
    float rstd = 1.f / sqrtf(wave_sum(s2) * (1.f / DM) + LN_EPS);
    GAS u32x2* xo = (GAS u32x2*)(X1 + (size_t)row * DM) + lane; s = 0.f;
#pragma unroll
    for (int j = 0; j < 4; ++j) { v[j] = v[j] * rstd * lg[j] + lb[j];
        u32x2 w; w.x = pk2(v[j].x, v[j].y); w.y = pk2(v[j].z, v[j].w); ST8(&xo[64 * j], w); s += (v[j].x + v[j].y) + (v[j].z + v[j].w); }
    mean = wave_sum(s) * (1.f / DM); s2 = 0.f;
#pragma unroll
    for (int j = 0; j < 4; ++j) { v[j] = v[j] - mean; s2 += (v[j].x * v[j].x + v[j].y * v[j].y) + (v[j].z * v[j].z + v[j].w * v[j].w); }
    rstd = 1.f / sqrtf(wave_sum(s2) * (1.f / DM) + LN_EPS);
    GAS u32x2* ho = (GAS u32x2*)(H + (size_t)row * DM) + lane;
#pragma unroll
    for (int j = 0; j < 4; ++j) { v[j] = v[j] * rstd * (sc2[j] + 1.f) + sh2[j]; u32x2 w; w.x = pk2(v[j].x, v[j].y); w.y = pk2(v[j].z, v[j].w); ST8(&ho[64 * j], w); }
    if (norouter) return;
    float a[16];
#pragma unroll
    for (int eg = 0; eg < 4; ++eg) {
        f32x2 s2[4];
#pragma unroll
        for (int i = 0; i < 4; ++i) s2[i] = (f32x2){0.f, 0.f};
#pragma unroll
        for (int j = 0; j < 4; ++j) {
            f32x4 w4[4];
#pragma unroll
            for (int i = 0; i < 4; ++i) w4[i] = *(const LAS f32x4*)(rwT + (4 * eg + i) * 1024 + 4 * lane + 256 * j);
            asm volatile("" : "+v"(w4[0]), "+v"(w4[1]), "+v"(w4[2]), "+v"(w4[3]));
#pragma unroll
            for (int i = 0; i < 4; ++i) { s2[i] = __builtin_elementwise_fma((f32x2){v[j].x, v[j].y}, (f32x2){w4[i].x, w4[i].y}, s2[i]); s2[i] = __builtin_elementwise_fma((f32x2){v[j].z, v[j].w}, (f32x2){w4[i].z, w4[i].w}, s2[i]); }
        }
#pragma unroll
        for (int i = 0; i < 4; ++i) a[4 * eg + i] = s2[i].x + s2[i].y;
    }
    const bool h5 = (lane & 32) != 0, h4 = (lane & 16) != 0, h3 = (lane & 8) != 0, h2 = (lane & 4) != 0;
    float c8[8], d4[4], f2[2];
#define PX32(x) ([&]() { auto rr_ = __builtin_amdgcn_permlane32_swap(__float_as_uint(x), __float_as_uint(x), false, false); return __uint_as_float(h5 ? rr_[0] : rr_[1]); }())
#define PX16(x) ([&]() { auto rr_ = __builtin_amdgcn_permlane16_swap(__float_as_uint(x), __float_as_uint(x), false, false); return __uint_as_float(h4 ? rr_[0] : rr_[1]); }())
#define PDPP(x, ctrl) __builtin_bit_cast(float, __builtin_amdgcn_update_dpp(0, __builtin_bit_cast(int, (x)), (ctrl), 0xf, 0xf, false))
#pragma unroll
    for (int i = 0; i < 8; ++i) { const float mine = h5 ? a[8 + i] : a[i], send = h5 ? a[i] : a[8 + i]; c8[i] = mine + PX32(send); }
#pragma unroll
    for (int i = 0; i < 4; ++i) { const float mine = h4 ? c8[4 + i] : c8[i], send = h4 ? c8[i] : c8[4 + i]; d4[i] = mine + PX16(send); }
#pragma unroll
    for (int i = 0; i < 2; ++i) { const float mine = h3 ? d4[2 + i] : d4[i], send = h3 ? d4[i] : d4[2 + i]; f2[i] = mine + PDPP(send, 0x128); }
    float gsum; { const float mine = h2 ? f2[1] : f2[0], send = h2 ? f2[0] : f2[1]; gsum = mine + PDPP(send, 0x141); }
    gsum += PDPP(gsum, 0x4E); gsum += PDPP(gsum, 0xB1);
#undef PX32
#undef PX16
#undef PDPP
    if ((lane & 3) == 0) lgs[r * 16 + (lane >> 2)] = gsum;
}
#ifndef DRY_SKIP
#define DRY_SKIP 0
#endif
template <bool XBF>
__device__ __forceinline__ void ph_postmix_t(Frame& F, int l, bool dry) {
    LAS float* rwT = (LAS float*)(F.lds + RING_OFF);
    LAS float* lgs = (LAS float*)(F.lds + RING_OFF + 65536) + F.wave * 256;
    LAS int* lcnt = (LAS int*)(F.lds + LCNT_OFF);
    const void* xin = (const void*)(l == 0 ? F.x : F.out); const float* modl     = F.mod + (size_t)l * 8 * MODW; int* cnt = (int*)F.ctl + CW_CNT + 64 * l;
    const float* lng = F.ln_mix_g + l * DM; const float* lnb = F.ln_mix_b + l * DM; const int lane = F.lane;
    const bool norouter = dry && (DRY_SKIP & 1);
    { f32x4 t4[8];
#pragma unroll
      for (int j = 0; j < 8; ++j) t4[j] = ((const GAS f32x4*)F.router_w)[F.tid + 512 * j];
#pragma unroll
      for (int j = 0; j < 8; ++j) { const int i4 = F.tid + 512 * j, k = i4 >> 2, e0 = (i4 & 3) * 4; rwT[(e0 + 0) * 1024 + k] = t4[j].x; rwT[(e0 + 1) * 1024 + k] = t4[j].y; rwT[(e0 + 2) * 1024 + k] = t4[j].z; rwT[(e0 + 3) * 1024 + k] = t4[j].w; } }
#pragma unroll 1
    for (int base = blockIdx.x * 128; base < T; base += F.G * 128) {
        if (F.tid < 16) lcnt[F.tid] = 0;
        __syncthreads();
        const int b = base / SEQ, wrow = base + F.wave * 16;
        f32x4 g1[4], lg[4], lb[4], sc2[4], sh2[4];
        { const GAS f32x4* g1p = (const GAS f32x4*)(modl + (size_t)b * MODW + 2 * DM) + lane; const GAS f32x4* lgp = (const GAS f32x4*)lng + lane; const GAS f32x4* lbp = (const GAS f32x4*)lnb + lane;
#pragma unroll
          for (int j = 0; j < 4; ++j) { g1[j] = g1p[64 * j]; sh2[j] = g1p[256 + 64 * j]; sc2[j] = g1p[512 + 64 * j]; lg[j] = lgp[64 * j]; lb[j] = lbp[64 * j]; } }
        PmRaw A, B, C;
        pm_load<XBF>(A, xin, F.MIXED, wrow, lane); pm_load<XBF>(B, xin, F.MIXED, wrow + 1, lane);
#pragma unroll 1
        for (int it = 0; it < 5; ++it) {
            const int r0 = 3 * it;
            pm_load<XBF>(C, xin, F.MIXED, wrow + r0 + 2, lane);
            pm_row<XBF>(A, g1, lg, lb, sc2, sh2, F.S3, F.S1, rwT, lgs, wrow + r0, r0, lane, norouter);
            pm_load<XBF>(A, xin, F.MIXED, wrow + r0 + 3, lane);
            pm_row<XBF>(B, g1, lg, lb, sc2, sh2, F.S3, F.S1, rwT, lgs, wrow + r0 + 1, r0 + 1, lane, norouter);
            if (it < 4) pm_load<XBF>(B, xin, F.MIXED, wrow + r0 + 4, lane);
            pm_row<XBF>(C, g1, lg, lb, sc2, sh2, F.S3, F.S1, rwT, lgs, wrow + r0 + 2, r0 + 2, lane, norouter);
        }
        pm_row<XBF>(A, g1, lg, lb, sc2, sh2, F.S3, F.S1, rwT, lgs, wrow + 15, 15, lane, norouter);
        LDS_WAIT(); asm volatile("" ::: "memory");
        int my_e1 = 0, my_e2 = 0, my_l1 = 0, my_l2 = 0;
        if (lane < 16) {
            float p[16];
#pragma unroll
            for (int q = 0; q < 4; ++q) { const f32x4 t = *(const LAS f32x4*)(lgs + lane * 16 + 4 * q); p[4 * q] = t.x; p[4 * q + 1] = t.y; p[4 * q + 2] = t.z; p[4 * q + 3] = t.w; }
            float mx = -INFINITY, sum = 0.f;
#pragma unroll
            for (int e = 0; e < 16; ++e) { p[e] += F.router_b[e]; mx = fmaxf(mx, p[e]); }
#pragma unroll
            for (int e = 0; e < 16; ++e) { p[e] = expf(p[e] - mx); sum += p[e]; }
            const float rs = 1.f / sum;
#pragma unroll
            for (int e = 0; e < 16; ++e) p[e] *= rs;
            int bg = 0; float bgs = -1.f;
#pragma unroll
            for (int g = 0; g < 4; ++g) { float m1 = p[4 * g]; int i1 = 0;
#pragma unroll
                for (int i = 1; i < 4; ++i) if (p[4 * g + i] > m1) { m1 = p[4 * g + i]; i1 = i; }
                float m2 = -1.f;
#pragma unroll
                for (int i = 0; i < 4; ++i) if (i != i1 && p[4 * g + i] > m2) m2 = p[4 * g + i];
                const float gs = m1 + m2; if (gs > bgs) { bgs = gs; bg = g; } }
            float q0 = 0.f, q1 = 0.f, q2 = 0.f, q3 = 0.f;
#pragma unroll
            for (int g = 0; g < 4; ++g) if (bg == g) { q0 = p[4 * g]; q1 = p[4 * g + 1]; q2 = p[4 * g + 2]; q3 = p[4 * g + 3]; }
            float m1 = q0; int i1 = 0; if (q1 > m1) { m1 = q1; i1 = 1; } if (q2 > m1) { m1 = q2; i1 = 2; } if (q3 > m1) { m1 = q3; i1 = 3; }
            float m2 = -1.f; int i2 = 0;
            if (i1 != 0 && q0 > m2) { m2 = q0; i2 = 0; } if (i1 != 1 && q1 > m2) { m2 = q1; i2 = 1; } if (i1 != 2 && q2 > m2) { m2 = q2; i2 = 2; } if (i1 != 3 && q3 > m2) { m2 = q3; i2 = 3; }
            my_e1 = bg * 4 + i1; my_e2 = bg * 4 + i2; const int row = wrow + lane; const float den = 1.f / (m1 + m2);
            my_l1 = __hip_atomic_fetch_add(lcnt + my_e1, 1, __ATOMIC_RELAXED, __HIP_MEMORY_SCOPE_WORKGROUP); my_l2 = __hip_atomic_fetch_add(lcnt + my_e2, 1, __ATOMIC_RELAXED, __HIP_MEMORY_SCOPE_WORKGROUP);
            const float gw1 = m1 * den, gw2 = m2 * den; ST4(&F.tok_e[2 * row], my_e1); ST4(&F.tok_e[2 * row + 1], my_e2); ST4(&F.tok_g[2 * row], gw1); ST4(&F.tok_g[2 * row + 1], gw2);
        }
        __syncthreads();
        if (F.tid < 16 && !dry) lcnt[16 + F.tid] = atomicAdd(cnt + F.tid, lcnt[F.tid]);
        __syncthreads();
        if (lane < 16 && !dry) { const int row = wrow + lane, s1 = lcnt[16 + my_e1] + my_l1, s2 = lcnt[16 + my_e2] + my_l2;
            ST4(&F.tok_slot[2 * row], s1); ST4(&F.tok_slot[2 * row + 1], s2); ST4(&F.lists[(size_t)my_e1 * T + s1], row); ST4(&F.lists[(size_t)my_e2 * T + s2], row); }
        __syncthreads();
    }
}
__device__ __forceinline__ void ph_postmix(Frame& F, int l, bool dry = false) { if (X2_BF16 && l > 0) ph_postmix_t<true>(F, l, dry); else ph_postmix_t<false>(F, l, dry); }
__device__ __forceinline__ void moe_table(Frame& F, int l) {
    LAS int* tab = (LAS int*)(F.lds + TAB_OFF); LAS int* eb = (LAS int*)(F.lds + EB_OFF); const int* cnt = (const int*)F.ctl + CW_CNT + 64 * l;
    __syncthreads();
    if (F.tid < 272 || F.tid == 511) {
        int pref = 0, mine = -1;
#pragma unroll
        for (int e = 0; e < 16; ++e) { const int n = __hip_atomic_load(cnt + e, RLX_AGENT), nt = (n + 255) >> 8; if (F.tid < 272 && F.tid >= pref && F.tid < pref + nt) mine = e | ((F.tid - pref) << 8);
            if (F.tid == 511) eb[e] = pref * 256; pref += nt; }
        if (F.tid < 272) tab[1 + F.tid] = mine;
        if (F.tid == 511) tab[0] = pref;
    }
    __syncthreads();
}
struct PfRaw { u32x2 x[4], y0[4], y1[4]; };
__device__ __forceinline__ void pf_load(PfRaw& R, const bf16* X1, const bf16* YP, int row, size_t r0, size_t r1, int lane) {
    const GAS u32x2* xr = (const GAS u32x2*)(X1 + (size_t)row * DM) + lane; const GAS u32x2* y0 = (const GAS u32x2*)(YP + r0 * DM) + lane; const GAS u32x2* y1 = (const GAS u32x2*)(YP + r1 * DM) + lane;
#pragma unroll
    for (int j = 0; j < 4; ++j) { R.x[j] = xr[64 * j]; R.y0[j] = y0[64 * j]; R.y1[j] = y1[64 * j]; }
}
template <bool NEXT>
__device__ __forceinline__ void pf_row(const PfRaw& R, float w0, float w1, const f32x4 (&g2)[4], const f32x4 (&lg)[4], const f32x4 (&lb)[4], const f32x4 (&sh)[4], const f32x4 (&sc)[4], float* out, bf16* X2b, bf16* H, int row, int lane, bool store_h) {
    f32x4 v[4]; float s = 0.f;
#pragma unroll
    for (int j = 0; j < 4; ++j) { v[j] = sane4(bf4(R.x[j]), 1e4f) * ALPHA + g2[j] * sane4(bf4(R.y0[j]) * w0 + bf4(R.y1[j]) * w1, 1e4f);
        s += (v[j].x + v[j].y) + (v[j].z + v[j].w); }
    float mean = wave_sum(s) * (1.f / DM), s2 = 0.f;
#pragma unroll
    for (int j = 0; j < 4; ++j) { v[j] = v[j] - mean; s2 += (v[j].x * v[j].x + v[j].y * v[j].y) + (v[j].z * v[j].z + v[j].w * v[j].w); }
    float rstd = 1.f / sqrtf(wave_sum(s2) * (1.f / DM) + LN_EPS);
    GAS f32x4* o = (GAS f32x4*)(out + (size_t)row * DM) + lane; s = 0.f;
    GAS u32x2* ob = (GAS u32x2*)(X2b + (size_t)row * DM) + lane;
#pragma unroll
    for (int j = 0; j < 4; ++j) { v[j] = v[j] * rstd * lg[j] + lb[j];
        if (X2_BF16 && store_h) { u32x2 w; w.x = pk2(v[j].x, v[j].y); w.y = pk2(v[j].z, v[j].w); ST8(&ob[64 * j], w); } else o[64 * j] = v[j];
        s += (v[j].x + v[j].y) + (v[j].z + v[j].w); }
    if (NEXT) {
        mean = wave_sum(s) * (1.f / DM); s2 = 0.f;
#pragma unroll
        for (int j = 0; j < 4; ++j) { v[j] = v[j] - mean; s2 += (v[j].x * v[j].x + v[j].y * v[j].y) + (v[j].z * v[j].z + v[j].w * v[j].w); }
        rstd = 1.f / sqrtf(wave_sum(s2) * (1.f / DM) + LN_EPS);
        GAS u32x2* ho = (GAS u32x2*)(H + (size_t)row * DM) + lane;
#pragma unroll
        for (int j = 0; j < 4; ++j) { const f32x4 r = v[j] * rstd * (sc[j] + 1.f) + sh[j]; u32x2 w; w.x = pk2(r.x, r.y); w.y = pk2(r.z, r.w); if (store_h) ST8(&ho[64 * j], w); }
    }
}
template <bool NEXT>
__device__ __forceinline__ void ph_postffn_t(Frame& F, int l) {
    const LAS int* eb = (const LAS int*)(F.lds + EB_OFF); const float* modl = F.mod + (size_t)l * 8 * MODW; const float* modn = F.mod + (size_t)(l + 1 < DEPTH ? l + 1 : l) * 8 * MODW;
    const float* lng = F.ln_ffn_g + l * DM; const float* lnb = F.ln_ffn_b + l * DM; const int lane = F.lane;
#pragma unroll 1
    for (int base = (F.vcu * NWAVES + F.wave) * 16; base < T; base += F.G * NWAVES * 16) {
        const int b = base / SEQ;
        const int mrow = base + (lane & 15);
        const int e0 = F.tok_e[2 * mrow], e1 = F.tok_e[2 * mrow + 1]; const float mw0 = F.tok_g[2 * mrow], mw1 = F.tok_g[2 * mrow + 1];
        const int mr0 = eb[e0] + F.tok_slot[2 * mrow], mr1 = eb[e1] + F.tok_slot[2 * mrow + 1];
        f32x4 g2[4], lg[4], lb[4], sh[4], sc[4];
        { const GAS f32x4* g2p = (const GAS f32x4*)(modl + (size_t)b * MODW + 5 * DM) + lane; const GAS f32x4* lgp = (const GAS f32x4*)lng + lane; const GAS f32x4* lbp = (const GAS f32x4*)lnb + lane;
          const GAS f32x4* shp = (const GAS f32x4*)(modn + (size_t)b * MODW) + lane;
#pragma unroll
          for (int j = 0; j < 4; ++j) { g2[j] = g2p[64 * j]; lg[j] = lgp[64 * j]; lb[j] = lbp[64 * j]; if (NEXT) { sh[j] = shp[64 * j]; sc[j] = shp[256 + 64 * j]; } else { sh[j] = (f32x4){0.f, 0.f, 0.f, 0.f}; sc[j] = sh[j]; } } }
        PfRaw A, B;
#define PF_LOAD2(R, r) pf_load(R, F.S3, F.YP, base + (r), (size_t)__builtin_amdgcn_readlane(mr0, (r)), (size_t)__builtin_amdgcn_readlane(mr1, (r)), lane)
#define PF_ROW2(R, r) pf_row<NEXT>(R, __builtin_bit_cast(float, __builtin_amdgcn_readlane(__builtin_bit_cast(int, mw0), (r))), __builtin_bit_cast(float, __builtin_amdgcn_readlane(__builtin_bit_cast(int, mw1), (r))), g2, lg, lb, sh, sc, F.out, (bf16*)F.out, F.S1, base + (r), lane, l + 1 < DEPTH)
        PF_LOAD2(A, 0);
#pragma unroll 1
        for (int it = 0; it < 8; ++it) {
            PF_LOAD2(B, 2 * it + 1);
            PF_ROW2(A, 2 * it);
            if (it < 7) PF_LOAD2(A, 2 * it + 2);
            PF_ROW2(B, 2 * it + 1);
        }
#undef PF_LOAD2
#undef PF_ROW2
    }
}
#ifndef PF_ALWAYS_NEXT
#define PF_ALWAYS_NEXT 1
#endif
__device__ __forceinline__ void ph_postffn(Frame& F, int l) { if (PF_ALWAYS_NEXT || l + 1 < DEPTH) ph_postffn_t<true>(F, l); else ph_postffn_t<false>(F, l); }

typedef __attribute__((address_space(4))) const unsigned char* kaptr_t;
__device__ __forceinline__ void frame_ptrs(Frame& F, kaptr_t ka) {
#define KA_IN(i) (*(const float* __attribute__((address_space(4))) const*)(ka + 8 * (i)))
    F.x = KA_IN(0); F.c = KA_IN(1); F.w_ada = KA_IN(2); F.b_ada = KA_IN(3); F.w_in = KA_IN(4); F.w_out = KA_IN(5); F.lq1 = KA_IN(6); F.lk1 = KA_IN(7); F.lq2 = KA_IN(8); F.lk2 = KA_IN(9);
    F.subln = KA_IN(10); F.ln_mix_g = KA_IN(11); F.ln_mix_b = KA_IN(12); F.ln_ffn_g = KA_IN(13); F.ln_ffn_b = KA_IN(14); F.router_w = KA_IN(15); F.router_b = KA_IN(16);
    F.w_gate = KA_IN(17); F.w_up = KA_IN(18); F.w_down = KA_IN(19);
    F.out = *(float* __attribute__((address_space(4))) const*)(ka + 160);
    unsigned char* ws = *(unsigned char* __attribute__((address_space(4))) const*)(ka + 168);
#undef KA_IN
    F.ws = ws; F.ctl = (gu32*)(ws + WS_CTL);
    F.mod = (float*)(ws + WS_MOD); F.rot = (float*)(ws + WS_ROT); F.tok_e = (int*)(ws + WS_TOK); F.tok_g = (float*)(ws + WS_TOK + 256 * 1024); F.tok_slot = (int*)(ws + WS_TOK + 512 * 1024);
    F.lists = (int*)(ws + WS_LIST); F.Wbf = (bf16*)(ws + WS_W);
    F.S1 = (bf16*)(ws + WS_S1); F.S3 = (bf16*)(ws + WS_S3); F.PROJ = (bf16*)(ws + WS_S2); F.YP = (bf16*)(ws + WS_YP); F.HE = (bf16*)(ws + WS_HE); F.MIXED = (bf16*)(ws + WS_MIXED);
}
struct Args { const float* in[20]; float* out; unsigned char* ws; int ph_lo, ph_hi, li, pad; };
__global__ void __launch_bounds__(NWAVES * 64, 2) mega(Args args) {
    extern __shared__ __attribute__((aligned(16))) unsigned char lds[];
    Frame F;
    F.lds = (LAS unsigned char*)lds; F.MISC = (volatile LAS unsigned*)(F.lds + MISC_OFF);
    F.tid = threadIdx.x; F.lane = F.tid & 63; F.wave = __builtin_amdgcn_readfirstlane(F.tid >> 6);
    F.G = gridDim.x; { const int bx = blockIdx.x; F.vcu = (F.G % 8 == 0) ? (bx % 8) * (F.G / 8) + bx / 8 : bx; }
    F.ctl = (gu32*)(args.ws + WS_CTL);
    for (int u = F.tid; u < (LDS_BYTES - LDSCTL_OFF) / 4; u += NWAVES * 64) ((LAS unsigned*)(F.lds + LDSCTL_OFF))[u] = 0u;
    __syncthreads();
    const int lo = args.ph_lo, hi = args.ph_hi;
    XcdBarrier bar; bar.bar = (unsigned*)(F.ctl + CW_BAR) + args.li * XCD_BAR_WORDS; bar.x = 0; bar.st = nullptr;
    if (hi - lo > 1) bar = xcd_barrier_post((unsigned*)(F.ctl + CW_BAR) + args.li * XCD_BAR_WORDS, F.MISC + 8);
#ifndef KIND_MASK
#define KIND_MASK 0x3ffu
#endif
#define KEN(k) ((KIND_MASK >> (k)) & 1u)
#ifndef REP_KIND
#define REP_KIND -1
#endif
#ifndef REP_N
#define REP_N 1
#endif
#define REPS(k) for (int rep_ = 0; rep_ < ((REP_KIND == (k)) ? REP_N : 1); ++rep_)
#define IN(k) (lo <= (k) && (k) < hi)
#define FRESH() do { int t_ = threadIdx.x; asm volatile("" : "+v"(t_)); F.tid = t_; F.lane = t_ & 63; kaptr_t ka_ = (kaptr_t)__builtin_amdgcn_kernarg_segment_ptr(); asm volatile("" : "+s"(ka_)); frame_ptrs(F, ka_); } while (0)
#ifndef BAR_REP
#define BAR_REP 1
#endif
#define SEAM(k) do { if (IN(k) && IN((k) + 1)) for (int br_ = 0; br_ < BAR_REP; ++br_) xcd_barrier(bar); } while (0)

    if (KEN(8) && IN(0)) REPS(8) { FRESH(); ph_prologue(F); } SEAM(0);
    if (KEN(9) && IN(1)) REPS(9) { FRESH(); ph_ln0(F); } SEAM(1);
    for (int l = 0; l < DEPTH; ++l) {
        const int pb = 2 + 8 * l;
#define wl (F.Wbf + (size_t)l * WL_STRIDE)
        if (KEN(0) && IN(pb + 0)) REPS(0) { FRESH();
            pg8::PlainSched S; S.init(T / 256, INW / 256, F.G, (int)blockIdx.x); S.Bt = wl + WL_IN; S.K = DM;
#ifndef ROT_EXP
#define ROT_EXP 0
#endif
            pg8::EpiInProj E{F.PROJ, F.rot, RET_FAST ? F.mod + 2 * 8 * MODW + 16 : nullptr, (ROT_EXP && rep_ > 0) ? F.S3 : nullptr};
            pg8::gemm_phase<pg8::EpiInProj, pg8::PlainSched, true>(F.lds + RING_OFF, (const char*)F.S1, DM, S, E);
        }
        SEAM(pb + 0);
        if (KEN(1) && IN(pb + 1)) REPS(1) { FRESH();
            if (RET_FAST) REPS(10) { const int bh = F.vcu >> 2, hh = bh & 7; ret::ret_unit(bh >> 3, hh, F.vcu & 3, F.PROJ, F.S1, F.mod[2 * 8 * MODW + 16 + 2048 + hh], F.lds + RING_OFF); }
#if ATTN128
#if FUSE_COMBINE
            { const int bh_ = F.vcu >> 3, b = bh_ >> 2, h = bh_ & 3, s = F.vcu & 7;
              const attn128::bf16* base = (const attn128::bf16*)(F.PROJ + (size_t)b * SEQ * INW);
#pragma unroll 1
              for (int i = 0; i < 4; ++i) { const int c = i & 1, hc = h * 2 + c, qb = (i >> 1) ? 15 - s : s;
#else
            { const int bhc = F.vcu >> 2, b = bhc >> 3, hc = bhc & 7, h = hc >> 1, c = hc & 1, s = F.vcu & 3;
              const attn128::bf16* base = (const attn128::bf16*)(F.PROJ + (size_t)b * SEQ * INW);
#pragma unroll 1
              for (int i = 0; i < 4; ++i) { const int qb = i == 0 ? s : i == 1 ? 7 - s : i == 2 ? 8 + s : 15 - s;
#endif
                  #ifdef ATTN_DRY
                  if (rep_ + 1 < REP_N) attn128::attn_unit<ATTN_THRL, ATTN_DRY>(qb, base + C_DQ + h * 128 + c * 64, base + C_DK + h * 128 + c * 64, base + C_DV + h * 128,
                                        (attn128::bf16*)(F.S3 + (size_t)b * SEQ * DM + hc * 128), (char*)lds + RING_OFF); else
#endif
                  attn128::attn_unit<ATTN_THRL>(qb, base + C_DQ + h * 128 + c * 64, base + C_DK + h * 128 + c * 64, base + C_DV + h * 128,
                                        (attn128::bf16*)(F.S3 + (size_t)b * SEQ * DM + hc * 128), (char*)lds + RING_OFF);
#if FUSE_COMBINE
                  if (c == 1) attn_combine(F, l, b, h, qb);
#endif
              } }
        }
#else
            const int pr = F.vcu >> 1, b = pr >> 4, vh = pr & 15, h = vh >> 2, c = (vh >> 1) & 1, vhalf = vh & 1;
            const attn_body::bf16* base = (const attn_body::bf16*)(F.PROJ + (size_t)b * SEQ * INW);
#pragma unroll 1
            for (int i = 0; i < 8; ++i) { const int s = 2 * (i >> 1) + (F.vcu & 1), qb = (i & 1) ? 15 - s : s;
                attn_body::attn_unit<8>(qb, base + C_DQ + h * 128 + c * 64, base + C_DK + h * 128 + c * 64, base + C_DV + h * 128 + vhalf * 64,
                                        (attn_body::bf16*)(F.S3 + (size_t)b * SEQ * DM + vh * 64), (char*)lds + RING_OFF); }
        }
#endif
        SEAM(pb + 1);
#if !(FUSE_COMBINE && ATTN128)
        if (KEN(2) && IN(pb + 2)) REPS(2) { FRESH(); ph_combine(F, l); }
        SEAM(pb + 2);
#endif
        if (KEN(3) && IN(pb + 3)) REPS(3) { FRESH();
            pg8::PlainSched S; S.init(T / 256, DM / 256, F.G, (int)blockIdx.x); S.Bt = wl + WL_OUT; S.K = DM;
            pg8::EpiPlain E{F.MIXED, DM};
#ifdef EPI_DRY
            if (rep_ + 1 < REP_N) { pg8::EpiNone E0; pg8::gemm_phase<pg8::EpiNone, pg8::PlainSched, true>(F.lds + RING_OFF, (const char*)F.S1, DM, S, E0); } else
#endif
            pg8::gemm_phase<pg8::EpiPlain, pg8::PlainSched, true>(F.lds + RING_OFF, (const char*)F.S1, DM, S, E);
        }
        SEAM(pb + 3);
        if (KEN(4) && IN(pb + 4)) REPS(4) { FRESH(); ph_postmix(F, l, rep_ > 0); }
        SEAM(pb + 4);
#ifndef MOE_MODE
#define MOE_MODE 1
#endif
#define MOE_SCHED(S_, mode_) pg8::MoeMk<mode_> S_; S_.nMt = ((const LAS int*)(F.lds + TAB_OFF))[0]; S_.n1 = S_.nMt * 4; S_.c = (int)blockIdx.x; S_.l = l; S_.ldsb = F.lds; S_.Wgu = wl + WL_GU; S_.Wd = wl + WL_D; S_.ctl = F.ctl;
#if MOE_MODE == 2 || (defined(GU_WT) && GU_WT)
#define EPI_GU pg8::EpiGateUpWT
#else
#define EPI_GU pg8::EpiGateUp
#endif
#define MOE_STAGE_TOKS(S_) do { LAS int* toks_ = (LAS int*)(F.lds + TOKS_OFF); const int* cnt_ = (const int*)F.ctl + CW_CNT + 64 * l; \
            if (F.tid < 256) { int tk_[TOKS_UNITS]; \
                _Pragma("unroll") for (int i_ = 0; i_ < TOKS_UNITS; ++i_) { pg8::MUnit u_; const bool ok_ = S_.next(i_, u_) && u_.kind == 0; const int pm_ = __builtin_amdgcn_readfirstlane(ok_ ? u_.pm : 0); \
                    const int te_ = S_.tab()[1 + pm_], e_ = te_ & 15, s_ = ((te_ >> 8) & 31) * 256 + F.tid, n_ = cnt_[e_]; tk_[i_] = F.lists[(size_t)e_ * T + (s_ < n_ ? s_ : 0)]; } \
                _Pragma("unroll") for (int i_ = 0; i_ < TOKS_UNITS; ++i_) toks_[i_ * 256 + F.tid] = tk_[i_]; } \
            __syncthreads(); } while (0)
        if (KEN(5) && IN(pb + 5)) REPS(5) {
            FRESH(); moe_table(F, l);
#if MOE_MODE == 0
            pg8::MoeSched S; S.init(((const LAS int*)(F.lds + TAB_OFF))[0], 4, F.G, (int)blockIdx.x); S.Bt = wl + WL_GU; S.K = DM; S.tab = (const LAS int*)(F.lds + TAB_OFF);
            S.cnt = (const int*)F.ctl + CW_CNT + 64 * l; S.lists = F.lists; S.gather = true;
            pg8::EpiGateUp E{F.HE};
            pg8::gemm_phase<pg8::EpiGateUp, pg8::MoeSched, true>(F.lds + RING_OFF, (const char*)F.S1, DM, S, E);
#else
            MOE_SCHED(S, MOE_MODE == 2 ? 2 : 0); MOE_STAGE_TOKS(S);
            EPI_GU E0{F.HE}; pg8::EpiPlain E1{F.YP, DM};
            pg8::gemm_phase_mk<pg8::MoeMk<(MOE_MODE == 2 ? 2 : 0)>, EPI_GU, pg8::EpiPlain>(F.lds + RING_OFF, (const char*)F.ws, S, E0, E1);
#endif
        }
#if MOE_MODE != 2
        SEAM(pb + 5);
#endif
        if (KEN(6) && IN(pb + 6)) REPS(6) {
#if MOE_MODE == 0
            FRESH(); moe_table(F, l);
            pg8::MoeSched S; S.init(((const LAS int*)(F.lds + TAB_OFF))[0], 4, F.G, (int)blockIdx.x); S.Bt = wl + WL_D; S.K = DE; S.tab = (const LAS int*)(F.lds + TAB_OFF);
            S.cnt = (const int*)F.ctl + CW_CNT + 64 * l; S.lists = F.lists; S.gather = false;
            pg8::EpiPlain E{F.YP, DM};
            pg8::gemm_phase<pg8::EpiPlain, pg8::MoeSched, true>(F.lds + RING_OFF, (const char*)F.HE, DE, S, E);
#elif MOE_MODE == 1
            FRESH(); moe_table(F, l);
            MOE_SCHED(S, 1);
            EPI_GU E0{F.HE}; pg8::EpiPlain E1{F.YP, DM};
            pg8::gemm_phase_mk<pg8::MoeMk<1>, EPI_GU, pg8::EpiPlain>(F.lds + RING_OFF, (const char*)F.ws, S, E0, E1);
#endif
        }
        SEAM(pb + 6);
        if (KEN(7) && IN(pb + 7)) REPS(7) { FRESH(); moe_table(F, l); if (DEFER_W1 && l == 0) { deferred_weights(F, 4 * ((const LAS int*)(F.lds + TAB_OFF))[0], 2); } ph_postffn(F, l); }
        SEAM(pb + 7);
#undef wl
#undef MOE_SCHED
#undef MOE_STAGE_TOKS
    }
#undef IN
#undef SEAM
}
#ifndef FAST_MASK
#define FAST_MASK 0x3ffffu
#endif
extern "C" void kernel_launch(void* const* d_in, const int* in_sizes, int n_in, void* d_out, int out_size, void* d_ws, size_t ws_size, hipStream_t stream) {
    static int grid = 0;
    if (grid == 0) {
        if (n_in != 20 || out_size != T * DM || ws_size < WS_END) { fprintf(stderr, "kernel_launch: unexpected shapes (n_in %d out %d ws %zu)\n", n_in, out_size, ws_size); grid = -1; return; }
        int dev = 0, cus = 0, per_cu = 0;
        if (hipGetDevice(&dev) != hipSuccess || hipDeviceGetAttribute(&cus, hipDeviceAttributeMultiprocessorCount, dev) != hipSuccess) { grid = -1; return; }
        if (hipFuncSetAttribute((const void*)mega, hipFuncAttributeMaxDynamicSharedMemorySize, LDS_BYTES) != hipSuccess) { fprintf(stderr, "kernel_launch: hipFuncSetAttribute failed\n"); grid = -1; return; }
        if (hipOccupancyMaxActiveBlocksPerMultiprocessor(&per_cu, (const void*)mega, NWAVES * 64, LDS_BYTES) != hipSuccess || per_cu < 1) fprintf(stderr, "kernel_launch: occupancy query says %d\n", per_cu);
        (void)hipGetLastError();
        grid = cus;
        if (grid != 256) { fprintf(stderr, "kernel_launch: built for 256 CUs, found %d\n", grid); grid = -1; return; }
    }
    if (grid < 0) return;
    const float* x = (const float*)d_in[0];
    const float* w_in = (const float*)d_in[4]; const float* w_out = (const float*)d_in[5];
    const float* subln = (const float*)d_in[10]; const float* ln_mix_g = (const float*)d_in[11]; const float* ln_mix_b = (const float*)d_in[12];
    const float* ln_ffn_g = (const float*)d_in[13]; const float* ln_ffn_b = (const float*)d_in[14]; const float* router_w = (const float*)d_in[15]; const float* router_b = (const float*)d_in[16];
    const float* w_gate = (const float*)d_in[17]; const float* w_up = (const float*)d_in[18]; const float* w_down = (const float*)d_in[19];
    unsigned char* ws = (unsigned char*)d_ws; float* out = (float*)d_out;
    float* mod = (float*)(ws + WS_MOD); float* rot = (float*)(ws + WS_ROT);
    int* tok_e = (int*)(ws + WS_TOK); float* tok_g = (float*)(ws + WS_TOK + 256 * 1024); int* tok_slot = (int*)(ws + WS_TOK + 512 * 1024); int* lists = (int*)(ws + WS_LIST);
    bf16* S1 = (bf16*)(ws + WS_S1); bf16* X1 = (bf16*)(ws + WS_S3); bf16* PROJ = (bf16*)(ws + WS_S2); bf16* YP = (bf16*)(ws + WS_YP); bf16* HE = (bf16*)(ws + WS_HE); bf16* MIXED = (bf16*)(ws + WS_MIXED);
    int* ctl = (int*)(ws + WS_CTL);
    (void)hipMemsetAsync(ws + WS_CTL, 0, 1 * MiB, stream);
    Args a{};
    for (int i = 0; i < 20; ++i) a.in[i] = (const float*)d_in[i];
    a.out = out; a.ws = ws;
    int li = 0, lo = -1;
    auto flush = [&](int hi) { if (lo >= 0) { a.ph_lo = lo; a.ph_hi = hi; a.li = li++; hipLaunchKernelGGL(mega, dim3(grid), dim3(NWAVES * 64), LDS_BYTES, stream, a); lo = -1; } };
    for (int p = 0; p < NPHASE; ++p) {
        const bool fast = (FAST_MASK >> p) & 1u;
        const int l = p < 2 ? 0 : (p - 2) / 8, k = p < 2 ? -1 : (p - 2) % 8;
        const float* modl = mod + (size_t)l * 8 * MODW; int* cnt = ctl + CW_CNT + 64 * l;
        if (fast) { if (lo < 0) lo = p; }
        else {
            flush(p);
            if (p == 0) { k_mod<<<dim3(MODW / 256, 2), 256, 0, stream>>>((const float*)d_in[1], (const float*)d_in[2], (const float*)d_in[3], (const float*)d_in[6], (const float*)d_in[7], (const float*)d_in[8], (const float*)d_in[9], mod);
                          k_rot<<<512, 256, 0, stream>>>(rot); }
            else if (p == 1) k_ln_mod<<<T / 4, 256, 0, stream>>>(x, mod, 0, S1);
            else if (k == 0) k_ngemm_inproj<<<dim3(INW / 64, T / 128), 256, 0, stream>>>(S1, w_in + (size_t)l * DM * INW, rot, PROJ);
            else if (k == 1) k_ndiff<<<dim3(SEQ / 64, 4, NB), 256, 0, stream>>>(PROJ, mod + 2 * 8 * MODW, subln, l, S1);
            else if (k == 2) {   }
            else if (k == 3) k_ngemm_plain<<<dim3(DM / 64, T / 128), 256, 0, stream>>>(S1, DM, w_out + (size_t)l * DM * DM, DM, DM, MIXED, DM);
            else if (k == 4) k_post_mix<<<T / 4, 256, 0, stream>>>(l == 0 ? x : out, MIXED, modl, ln_mix_g + l * DM, ln_mix_b + l * DM, router_w, router_b, X1, S1, tok_e, tok_g, tok_slot, lists, cnt);
            else if (k == 5) k_moe1<<<dim3(DE / 64, T / 128, NE), 256, 0, stream>>>(S1, w_gate + (size_t)l * NE * DM * DE, w_up + (size_t)l * NE * DM * DE, cnt, lists, HE);
            else if (k == 6) k_moe2<<<dim3(DM / 64, T / 128, NE), 256, 0, stream>>>(HE, w_down + (size_t)l * NE * DE * DM, cnt, YP);
            else if (k == 7) k_post_ffn<<<T / 4, 256, 0, stream>>>(X1, YP, modl, ln_ffn_g + l * DM, ln_ffn_b + l * DM, tok_e, tok_g, tok_slot, cnt, out, l + 1 < DEPTH ? mod + (size_t)(l + 1) * 8 * MODW : nullptr, S1);
        }
        if (!RET_FAST && k == 2) { flush(p + 1); k_nret<<<dim3(SEQ / 64, 8, NB), 256, 0, stream>>>(PROJ, S1); }
    }
    flush(NPHASE);
}
```
